# Optimizing an MI355X kernel written in HIP

```python
import math
import jax, jax.numpy as jnp
from jax import lax
import numpy as np

D_MODEL = 1024
BATCH = 4
SEQ = 4096
DEPTH = 2
DEC_BATCH = 128
DEC_SEQ = 4
PAST_LEN = 2048
PAGE_SIZE = 128

N_HEADS = 16
N_KV_HEADS = 4
GROUP = N_HEADS // N_KV_HEADS
HEAD_DIM = 64
Q_DIM = N_HEADS * HEAD_DIM
KV_DIM = N_KV_HEADS * HEAD_DIM
IN_COLS = Q_DIM + 6 * KV_DIM + 3 * N_HEADS
CMP_BLK = 32
SEL_BLK = 64
N_SEL = 16
WINDOW = 512
Q_CHUNK = 64
N_BUCKETS = 32
MAX_DISTANCE = 128
POOL_WINDOWS = (2, 4, 8, 16)
N_POOL_GROUPS = len(POOL_WINDOWS)
POOL_GROUP_DIM = D_MODEL // N_POOL_GROUPS
POOL_STATE = max(POOL_WINDOWS) - 1
D_FF = ((8 * D_MODEL + 3 * 256 - 1) // (3 * 256)) * 256
N_NSA_LAYERS = (DEPTH + 1) // 2
N_POOL_LAYERS = DEPTH // 2
RMS_EPS = 1e-6
NEG = -1e30
BIG = 1e9

kernel_name = 'nsa_pool_hybrid_step'


def rmsnorm(x, g):
    xf = x.astype(jnp.float32)
    y = xf * lax.rsqrt(jnp.mean(xf * xf, axis=-1, keepdims=True) + RMS_EPS)
    return (y * g.astype(jnp.float32)).astype(x.dtype)


def ada_modulate(c, w_ada, b_ada):
    m = jax.nn.silu(c) @ w_ada + b_ada
    return jnp.split(m[:, None, :], 6, axis=-1)


def rel_bucket(dist):
    d = jnp.maximum(dist, 0)
    max_exact = N_BUCKETS // 2
    large = max_exact + (jnp.log(jnp.maximum(d, 1).astype(jnp.float32) / max_exact)
                         / math.log(MAX_DISTANCE / max_exact) * (N_BUCKETS - max_exact)).astype(jnp.int32)
    large = jnp.minimum(large, N_BUCKETS - 1)
    return jnp.where(d < max_exact, d, large)


def masked_softmax(logits, mask):
    l = jnp.where(mask, logits.astype(jnp.float32), NEG)
    m = jnp.max(l, axis=-1, keepdims=True)
    p = jnp.where(mask, jnp.exp(l - m), 0.0)
    return p / jnp.maximum(jnp.sum(p, axis=-1, keepdims=True), 1e-30)


def nsa_project(h, w_in):
    b, t = h.shape[:2]
    proj = h @ w_in
    parts = jnp.split(proj, [Q_DIM + i * KV_DIM for i in range(7)], axis=-1)
    q = parts[0].reshape(b, t, N_KV_HEADS, GROUP, HEAD_DIM)
    kvs = [p.reshape(b, t, N_KV_HEADS, HEAD_DIM) for p in parts[1:7]]
    gates = parts[7].reshape(b, t, N_KV_HEADS, GROUP, 3)
    return q, kvs, gates


def compress_blocks(k_full, w_c, pe_c):
    b, L = k_full.shape[:2]
    nc = L // CMP_BLK
    blk = k_full[:, :nc * CMP_BLK].reshape(b, nc, CMP_BLK, N_KV_HEADS, HEAD_DIM) + pe_c[None, None, :, None, :]
    return jnp.einsum('bnjkd,jde->bnke', blk, w_c)


def select_blocks(k_full):
    b, L = k_full.shape[:2]
    ns = -(-L // SEL_BLK)
    kp = jnp.pad(k_full, ((0, 0), (0, ns * SEL_BLK - L), (0, 0), (0, 0)))
    return kp.reshape(b, ns, SEL_BLK, N_KV_HEADS, HEAD_DIM).transpose(0, 3, 1, 2, 4)


def nsa_attend(q, gates, qpos, k_cmp, v_cmp, k_sb, v_sb, kw, vw, kwpos, rel_bias):
    b, c = q.shape[:2]
    scale = HEAD_DIM ** -0.5
    tab = rel_bias.reshape(N_BUCKETS, N_KV_HEADS, GROUP)
    nc = k_cmp.shape[1]
    cend = jnp.arange(nc, dtype=jnp.int32) * CMP_BLK + (CMP_BLK - 1)
    dc = qpos[:, None] - cend[None, :]
    bias_c = jnp.transpose(tab[rel_bucket(dc)], (2, 3, 0, 1))
    lc = jnp.einsum('bckgd,bnkd->bkgcn', q, k_cmp) * scale + bias_c
    p_c = masked_softmax(lc, dc >= 0)
    o_c = jnp.einsum('bkgcn,bnkd->bckgd', p_c.astype(v_cmp.dtype), v_cmp)
    ns = k_sb.shape[2]
    ratio = SEL_BLK // CMP_BLK
    imp = jnp.pad(jnp.sum(p_c, axis=2), ((0, 0), (0, 0), (0, 0), (0, ratio * ns - nc)))
    imp = imp.reshape(b, N_KV_HEADS, c, ns, ratio).sum(-1)
    blk = jnp.arange(ns, dtype=jnp.int32)[None, :]
    qblk = (qpos // SEL_BLK)[:, None]
    forced = (blk == 0) | (blk == qblk) | (blk == qblk - 1)
    eligible = blk <= qblk
    imp = jnp.where(forced, BIG, jnp.where(eligible, imp, -1.0))
    _, idx = lax.top_k(imp, min(N_SEL, ns))
    gather = jax.vmap(jax.vmap(lambda kb, i: kb[i]))
    ks = gather(k_sb, idx)
    vs = gather(v_sb, idx)
    spos = idx[..., None] * SEL_BLK + jnp.arange(SEL_BLK, dtype=jnp.int32)
    ds = qpos[None, None, :, None, None] - spos
    bias_s = tab[rel_bucket(ds), jnp.arange(N_KV_HEADS)[None, :, None, None, None]]
    bias_s = jnp.moveaxis(bias_s, -1, 2)
    ls = jnp.einsum('bckgd,bkcjsd->bkgcjs', q, ks) * scale + bias_s
    ls = ls.reshape(b, N_KV_HEADS, GROUP, c, -1)
    p_s = masked_softmax(ls, (ds >= 0).reshape(b, N_KV_HEADS, 1, c, -1))
    o_s = jnp.einsum('bkgcx,bkcxd->bckgd', p_s.astype(vs.dtype), vs.reshape(b, N_KV_HEADS, c, -1, HEAD_DIM))
    dw = qpos[:, None] - kwpos[None, :]
    bias_w = jnp.transpose(tab[rel_bucket(dw)], (2, 3, 0, 1))
    lw = jnp.einsum('bckgd,blkd->bkgcl', q, kw) * scale + bias_w
    p_w = masked_softmax(lw, (dw >= 0) & (dw < WINDOW) & (kwpos[None, :] >= 0))
    o_w = jnp.einsum('bkgcl,blkd->bckgd', p_w.astype(vw.dtype), vw)
    g = jax.nn.sigmoid(gates.astype(jnp.float32))
    o = g[..., 0:1] * o_c + g[..., 1:2] * o_s + g[..., 2:3] * o_w
    return o.reshape(b, c, Q_DIM).astype(q.dtype)


def nsa_prompt(h, w_in, w_out, wk_c, wv_c, pek_c, pev_c, rel_bias):
    b, t = h.shape[:2]
    q, (kc, vc, ksl, vsl, kw, vw), gates = nsa_project(h, w_in)
    k_cmp = compress_blocks(kc, wk_c, pek_c)
    v_cmp = compress_blocks(vc, wv_c, pev_c)
    k_sb = select_blocks(ksl)
    v_sb = select_blocks(vsl)
    kw_pad = jnp.pad(kw, ((0, 0), (WINDOW, 0), (0, 0), (0, 0)))
    vw_pad = jnp.pad(vw, ((0, 0), (WINDOW, 0), (0, 0), (0, 0)))
    n_chunks = t // Q_CHUNK
    qc = jnp.moveaxis(q.reshape(b, n_chunks, Q_CHUNK, N_KV_HEADS, GROUP, HEAD_DIM), 1, 0)
    gc = jnp.moveaxis(gates.reshape(b, n_chunks, Q_CHUNK, N_KV_HEADS, GROUP, 3), 1, 0)
    starts = jnp.arange(n_chunks, dtype=jnp.int32) * Q_CHUNK

    def one_chunk(args):
        q_i, g_i, s = args
        qpos = s + jnp.arange(Q_CHUNK, dtype=jnp.int32)
        kw_i = lax.dynamic_slice_in_dim(kw_pad, s, WINDOW + Q_CHUNK, axis=1)
        vw_i = lax.dynamic_slice_in_dim(vw_pad, s, WINDOW + Q_CHUNK, axis=1)
        kwpos = s - WINDOW + jnp.arange(WINDOW + Q_CHUNK, dtype=jnp.int32)
        return nsa_attend(q_i, g_i, qpos, k_cmp, v_cmp, k_sb, v_sb, kw_i, vw_i, kwpos, rel_bias)

    o = lax.map(one_chunk, (qc, gc, starts))
    o = jnp.moveaxis(o, 0, 1).reshape(b, t, Q_DIM)
    win = min(WINDOW, t)
    return o @ w_out, (kc, vc, ksl, vsl, kw[:, t - win:], vw[:, t - win:])


def nsa_sample(h, c_kc, c_vc, c_ks, c_vs, page_table, win_k, win_v, w_in, w_out, wk_c, wv_c, pek_c, pev_c, rel_bias):
    b, t = h.shape[:2]
    past = page_table.shape[1] * PAGE_SIZE
    q, (kc, vc, ksl, vsl, kw, vw), gates = nsa_project(h, w_in)

    def paged(cache, new):
        old = cache[page_table].reshape(b, past, N_KV_HEADS, HEAD_DIM)
        return jnp.concatenate([old, new], axis=1)

    k_cmp = compress_blocks(paged(c_kc, kc), wk_c, pek_c)
    v_cmp = compress_blocks(paged(c_vc, vc), wv_c, pev_c)
    k_sb = select_blocks(paged(c_ks, ksl))
    v_sb = select_blocks(paged(c_vs, vsl))
    wbuf = win_k.shape[1]
    kw_ext = jnp.concatenate([win_k, kw], axis=1)
    vw_ext = jnp.concatenate([win_v, vw], axis=1)
    qpos = past + jnp.arange(t, dtype=jnp.int32)
    kwpos = past - wbuf + jnp.arange(wbuf + t, dtype=jnp.int32)
    o = nsa_attend(q, gates, qpos, k_cmp, v_cmp, k_sb, v_sb, kw_ext, vw_ext, kwpos, rel_bias)
    return o @ w_out, (kc, vc, ksl, vsl, kw_ext[:, t:], vw_ext[:, t:])


def pool_mix(u, prev, pos0, w_grp, layer_scale):
    b, t, _ = u.shape
    p = prev.shape[1]
    ext = jnp.concatenate([prev, u], axis=1).astype(jnp.float32)
    cs = jnp.concatenate([jnp.zeros((b, 1, D_MODEL), jnp.float32), lax.cumsum(ext, axis=1)], axis=1)
    pos = pos0 + jnp.arange(t, dtype=jnp.int32)
    outs = []
    for gi, w in enumerate(POOL_WINDOWS):
        sl = slice(gi * POOL_GROUP_DIM, (gi + 1) * POOL_GROUP_DIM)
        hi = cs[:, p + 1:p + 1 + t, sl]
        lo = cs[:, p + 1 - w:p + 1 - w + t, sl]
        cnt = jnp.minimum(pos + 1, w).astype(jnp.float32)[None, :, None]
        outs.append((hi - lo) / cnt)
    pooled = jnp.concatenate(outs, axis=-1) - ext[:, p:]
    mixed = jnp.einsum('btgc,gce->btge', pooled.reshape(b, t, N_POOL_GROUPS, POOL_GROUP_DIM),
                       w_grp.astype(jnp.float32)).reshape(b, t, D_MODEL)
    return (mixed * layer_scale).astype(u.dtype), ext[:, -POOL_STATE:].astype(u.dtype)


def swiglu(h, w_gate, w_up, w_down):
    return (jax.nn.silu(h @ w_gate) * (h @ w_up)) @ w_down


def run_trunk(x, c, mixer_apply, ada_w, ada_b, norm_g, final_g, ffn_wg, ffn_wu, ffn_wd):
    states = []
    for i in range(DEPTH):
        sh1, sc1, g1, sh2, sc2, g2 = ada_modulate(c, ada_w[i], ada_b[i])
        h = rmsnorm(x, norm_g[i, 0]) * (1 + sc1) + sh1
        y, st = mixer_apply(i, h)
        x = x + g1 * y
        h = rmsnorm(x, norm_g[i, 1]) * (1 + sc2) + sh2
        x = x + g2 * swiglu(h, ffn_wg[i], ffn_wu[i], ffn_wd[i])
        states.append(st)
    return rmsnorm(x, final_g), states


def setup_inputs(seed: int = 0) -> dict:
    key = jax.random.key(seed)
    ks = jax.random.split(key, 32)
    n_pages = PAST_LEN // PAGE_SIZE
    n_used = DEC_BATCH * n_pages
    n_phys = n_used + n_used // 4
    wbuf = min(WINDOW, PAST_LEN)
    nrm = lambda k, shape, s: jax.random.normal(k, shape, jnp.float32) * s
    page_table = jax.random.permutation(ks[0], n_phys)[:n_used].reshape(DEC_BATCH, n_pages).astype(jnp.int32)
    cache_shape = (N_NSA_LAYERS, n_phys, PAGE_SIZE, N_KV_HEADS, HEAD_DIM)
    win_shape = (N_NSA_LAYERS, DEC_BATCH, wbuf, N_KV_HEADS, HEAD_DIM)
    return {
        'x_prompt': nrm(ks[1], (BATCH, SEQ, D_MODEL), 1.0),
        'x_sample': nrm(ks[2], (DEC_BATCH, DEC_SEQ, D_MODEL), 1.0),
        'c_prompt': nrm(ks[3], (BATCH, D_MODEL), 1.0),
        'c_sample': nrm(ks[4], (DEC_BATCH, D_MODEL), 1.0),
        'cache_k_cmp': nrm(ks[5], cache_shape, 1.0),
        'cache_v_cmp': nrm(ks[6], cache_shape, 1.0),
        'cache_k_sel': nrm(ks[7], cache_shape, 1.0),
        'cache_v_sel': nrm(ks[8], cache_shape, 1.0),
        'page_table': page_table,
        'state_k_win': nrm(ks[9], win_shape, 1.0),
        'state_v_win': nrm(ks[10], win_shape, 1.0),
        'state_pool': nrm(ks[11], (N_POOL_LAYERS, DEC_BATCH, POOL_STATE, D_MODEL), 1.0),
        'rel_bias': nrm(ks[12], (N_BUCKETS, N_HEADS), 0.2),
        'ada_w': nrm(ks[13], (DEPTH, D_MODEL, 6 * D_MODEL), 0.5 * D_MODEL ** -0.5),
        'ada_b': nrm(ks[14], (DEPTH, 6 * D_MODEL), 0.01),
        'norm_g': 1.0 + nrm(ks[15], (DEPTH, 2, D_MODEL), 0.01),
        'final_g': 1.0 + nrm(ks[16], (D_MODEL,), 0.01),
        'nsa_w_in': nrm(ks[17], (N_NSA_LAYERS, D_MODEL, IN_COLS), D_MODEL ** -0.5),
        'nsa_w_out': nrm(ks[18], (N_NSA_LAYERS, Q_DIM, D_MODEL), Q_DIM ** -0.5),
        'cmp_wk': nrm(ks[19], (N_NSA_LAYERS, CMP_BLK, HEAD_DIM, HEAD_DIM), (CMP_BLK * HEAD_DIM) ** -0.5),
        'cmp_wv': nrm(ks[20], (N_NSA_LAYERS, CMP_BLK, HEAD_DIM, HEAD_DIM), (CMP_BLK * HEAD_DIM) ** -0.5),
        'cmp_pe_k': nrm(ks[21], (N_NSA_LAYERS, CMP_BLK, HEAD_DIM), 0.02),
        'cmp_pe_v': nrm(ks[22], (N_NSA_LAYERS, CMP_BLK, HEAD_DIM), 0.02),
        'pool_w': nrm(ks[23], (N_POOL_LAYERS, N_POOL_GROUPS, POOL_GROUP_DIM, POOL_GROUP_DIM), POOL_GROUP_DIM ** -0.5),
        'pool_scale': 1.0 + nrm(ks[24], (N_POOL_LAYERS, D_MODEL), 0.1),
        'ffn_wg': nrm(ks[25], (DEPTH, D_MODEL, D_FF), D_MODEL ** -0.5),
        'ffn_wu': nrm(ks[26], (DEPTH, D_MODEL, D_FF), D_MODEL ** -0.5),
        'ffn_wd': nrm(ks[27], (DEPTH, D_FF, D_MODEL), D_FF ** -0.5),
    }


def reference(x_prompt, x_sample, c_prompt, c_sample, cache_k_cmp, cache_v_cmp, cache_k_sel, cache_v_sel,
              page_table, state_k_win, state_v_win, state_pool, rel_bias, ada_w, ada_b, norm_g, final_g,
              nsa_w_in, nsa_w_out, cmp_wk, cmp_wv, cmp_pe_k, cmp_pe_v, pool_w, pool_scale,
              ffn_wg, ffn_wu, ffn_wd):
    past = page_table.shape[1] * PAGE_SIZE

    def prompt_mixer(i, h):
        j = i // 2
        if i % 2 == 0:
            return nsa_prompt(h, nsa_w_in[j], nsa_w_out[j], cmp_wk[j], cmp_wv[j], cmp_pe_k[j], cmp_pe_v[j], rel_bias)
        prev = jnp.zeros((h.shape[0], POOL_STATE, D_MODEL), h.dtype)
        return pool_mix(h, prev, 0, pool_w[j], pool_scale[j])

    def sample_mixer(i, h):
        j = i // 2
        if i % 2 == 0:
            return nsa_sample(h, cache_k_cmp[j], cache_v_cmp[j], cache_k_sel[j], cache_v_sel[j], page_table,
                              state_k_win[j], state_v_win[j], nsa_w_in[j], nsa_w_out[j],
                              cmp_wk[j], cmp_wv[j], cmp_pe_k[j], cmp_pe_v[j], rel_bias)
        return pool_mix(h, state_pool[j], past, pool_w[j], pool_scale[j])

    y_prompt, st_p = run_trunk(x_prompt, c_prompt, prompt_mixer, ada_w, ada_b, norm_g, final_g, ffn_wg, ffn_wu, ffn_wd)
    y_sample, st_s = run_trunk(x_sample, c_sample, sample_mixer, ada_w, ada_b, norm_g, final_g, ffn_wg, ffn_wu, ffn_wd)

    nsa_p = [st_p[i] for i in range(0, DEPTH, 2)]
    nsa_s = [st_s[i] for i in range(0, DEPTH, 2)]
    new_pool_p = jnp.stack([st_p[i] for i in range(1, DEPTH, 2)])
    new_pool_s = jnp.stack([st_s[i] for i in range(1, DEPTH, 2)])
    new_k_cmp_p = jnp.stack([s[0] for s in nsa_p])
    new_v_cmp_p = jnp.stack([s[1] for s in nsa_p])
    new_k_sel_p = jnp.stack([s[2] for s in nsa_p])
    new_v_sel_p = jnp.stack([s[3] for s in nsa_p])
    new_k_win_p = jnp.stack([s[4] for s in nsa_p])
    new_v_win_p = jnp.stack([s[5] for s in nsa_p])
    new_k_cmp_s = jnp.stack([s[0] for s in nsa_s])
    new_v_cmp_s = jnp.stack([s[1] for s in nsa_s])
    new_k_sel_s = jnp.stack([s[2] for s in nsa_s])
    new_v_sel_s = jnp.stack([s[3] for s in nsa_s])
    new_k_win_s = jnp.stack([s[4] for s in nsa_s])
    new_v_win_s = jnp.stack([s[5] for s in nsa_s])
    return (y_prompt, y_sample,
            new_k_cmp_p, new_v_cmp_p, new_k_sel_p, new_v_sel_p, new_k_win_p, new_v_win_p, new_pool_p,
            new_k_cmp_s, new_v_cmp_s, new_k_sel_s, new_v_sel_s, new_k_win_s, new_v_win_s, new_pool_s)
```

```cpp
#include <hip/hip_runtime.h>
#include <cstdio>
#include <cstdint>

#ifndef MK_SPLIT
#define MK_SPLIT 0
#endif

#define GAS __attribute__((address_space(1)))
#define LAS __attribute__((address_space(3)))
typedef unsigned short bf16_t;
typedef short bf16x8 __attribute__((ext_vector_type(8)));
typedef short s16x4 __attribute__((ext_vector_type(4)));
typedef float f32x2 __attribute__((ext_vector_type(2)));
typedef float f32x4 __attribute__((ext_vector_type(4)));
typedef float f32x16 __attribute__((ext_vector_type(16)));
typedef unsigned u32x2 __attribute__((ext_vector_type(2)));
typedef unsigned u32x4 __attribute__((ext_vector_type(4)));
typedef __bf16 bf16x2_t __attribute__((ext_vector_type(2)));
typedef GAS unsigned gu32;

constexpr int D = 1024, SEQ = 4096, NB = 4, NSB = 128, DSEQ = 4;
constexpr int MP = NB * SEQ, MS = NSB * DSEQ, MT = MP + MS;
constexpr int INCOLS = 2608, NPROJ = 2816, FF = 2816, NGU = 2 * FF;
constexpr int NMODB = NB + NSB;
constexpr int PAST = 2048;
constexpr float C2 = 0.125f * 1.4426950408889634f;
constexpr float LOG2E = 1.4426950408889634f;

constexpr size_t O_YP = 0, O_YS = O_YP + (size_t)MP * D;
constexpr size_t O_KCP = O_YS + (size_t)MS * D, SZ_KVP = (size_t)MP * 256;
constexpr size_t O_KWP = O_KCP + 4 * SZ_KVP, SZ_WP = (size_t)NB * 512 * 256;
constexpr size_t O_PLP = O_KWP + 2 * SZ_WP;
constexpr size_t O_KCS = O_PLP + (size_t)NB * 15 * D, SZ_KVS = (size_t)MS * 256;
constexpr size_t O_KWS = O_KCS + 4 * SZ_KVS, SZ_WS = (size_t)NSB * 512 * 256;
constexpr size_t O_PLS = O_KWS + 2 * SZ_WS;
constexpr size_t O_END = O_PLS + (size_t)NSB * 15 * D;
static_assert(O_END == 71233536, "output size");

constexpr size_t MiB = 1u << 20;
#ifdef VERIFY
constexpr size_t WS_CTL = 0, CTL_ZERO_BYTES = 1 * MiB;
#else
constexpr size_t WS_CTL = 0, CTL_ZERO_BYTES = 65536;
#endif
constexpr size_t WS_WIN = 2 * MiB;
constexpr size_t WS_WOUT = 8 * MiB;
constexpr size_t WS_WGU = 10 * MiB;
constexpr size_t WS_WD = 32 * MiB;
constexpr size_t WS_WPOOL = 44 * MiB;
constexpr size_t WS_WCK = 45 * MiB, WS_WCV = WS_WCK + 262144;
constexpr size_t WS_SC = 46 * MiB;
constexpr size_t WS_CB = 47 * MiB;
constexpr size_t WS_MOD = 48 * MiB;
constexpr size_t WS_KCMPP = 56 * MiB, WS_VCMPP = 57 * MiB;
constexpr size_t WS_KCMPS = 58 * MiB, WS_VCMPS = 62 * MiB;
constexpr size_t WS_GATES = 66 * MiB;
constexpr size_t WS_H = 72 * MiB;
constexpr size_t WS_Q = 108 * MiB;
constexpr size_t WS_O = 144 * MiB;
constexpr size_t WS_KV = 180 * MiB, KV_STRIDE = (size_t)MT * 256;
constexpr size_t WS_X = 232 * MiB;
constexpr size_t WS_HF = 300 * MiB;
constexpr size_t WS_ACT = 368 * MiB;
constexpr size_t WS_END = 464 * MiB;
static_assert(WS_KV + 6 * KV_STRIDE * 2 <= WS_X && WS_X + (size_t)MT * D * 4 <= WS_HF && WS_HF + (size_t)MT * D * 4 <= WS_ACT && WS_ACT + (size_t)MT * FF * 2 <= WS_END, "ws map");
static_assert(WS_WGU + 2 * (size_t)NGU * D * 2 <= WS_WD && WS_WD + 2 * (size_t)D * FF * 2 <= WS_WPOOL && WS_MOD + 2 * (size_t)NMODB * 6144 * 4 <= WS_KCMPP, "ws map 2");
static_assert(WS_GATES + (size_t)MT * 48 * 4 <= WS_H && WS_H + (size_t)MT * D * 2 <= WS_Q && WS_Q + (size_t)MT * D * 2 <= WS_O && WS_O + (size_t)MT * D * 2 <= WS_KV, "ws map 3");
constexpr int CW_BAR = 4096;

constexpr int RING_BYTES = 131072;
constexpr int LUT_OFF = RING_BYTES;
constexpr int WSF_OFF = LUT_OFF + 8192;
constexpr int IMP_OFF = WSF_OFF + 1024;
constexpr int MISC_OFF = IMP_OFF + 16384;
constexpr int LDS_BYTES = MISC_OFF + 256;
static_assert(LDS_BYTES <= 160 * 1024, "LDS");

__device__ __forceinline__ unsigned cvtpk(float lo, float hi) { f32x2 v = {lo, hi}; bf16x2_t b = __builtin_convertvector(v, bf16x2_t); return __builtin_bit_cast(unsigned, b); }
__device__ __forceinline__ float bf2f(unsigned short h) { return __builtin_bit_cast(float, (unsigned)h << 16); }
__device__ __forceinline__ float ex2(float x) { return __builtin_amdgcn_exp2f(x); }
__device__ __forceinline__ float sigmoidf_(float x) { return __builtin_amdgcn_rcpf(1.0f + ex2(-x * LOG2E)); }
#define CROW0(r) (((r) & 3) + 8 * ((r) >> 2))
#define LDS_WAIT() asm volatile("s_waitcnt lgkmcnt(0)" ::: "memory")
#define VM_WAIT() asm volatile("s_waitcnt vmcnt(0)" ::: "memory")
__device__ __forceinline__ const char* uniform_ptr(const void* p) { const unsigned long long v = (unsigned long long)p; const unsigned lo = (unsigned)__builtin_amdgcn_readfirstlane((int)(unsigned)v), hi = (unsigned)__builtin_amdgcn_readfirstlane((int)(unsigned)(v >> 32)); return (const char*)(((unsigned long long)hi << 32) | lo); }

__device__ __forceinline__ int t5_bucket(int d) {
    if (d < 16) return d;
    int b = 16;
    b += (d >= 19) + (d >= 21) + (d >= 24) + (d >= 27) + (d >= 31) + (d >= 35) + (d >= 40) + (d >= 46) + (d >= 52) + (d >= 59) + (d >= 67) + (d >= 77) + (d >= 87) + (d >= 99) + (d >= 113);
    return b;
}

namespace pg8 {
constexpr int BM = 256, BK = 64, HALF = 128, HTB = HALF * BK * 2, STAGE_BYTES = 8 * HTB, NXCD = 8, WGM = 8;
__host__ __device__ __forceinline__ int lds_byte(int r, int c) { const int st = (r >> 4) * 2 + (c >> 5), rr = r & 15, cc = c & 31, ob = rr * 64 + cc * 2; return st * 1024 + (ob ^ (((ob >> 9) & 1) << 5)); }
__host__ __device__ __forceinline__ void stage_rc(int b, int& R, int& C) { const int st = b / 1024, sb = b % 1024, swz = sb ^ (((sb >> 9) & 1) << 5); R = (st >> 1) * 16 + swz / 64; C = (st & 1) * 32 + (swz % 64) / 2; }
__host__ __device__ __forceinline__ int perm32(int rho) { const int n = rho >> 4, i = rho & 15; return 8 * (i >> 2) + 4 * n + (i & 3); }
struct Unit { int pm, pn; };
struct Gemm { const bf16_t* A; const bf16_t* Bt; int lda, ldb, K, acs; };
struct StaticOrder {
    int nM, nN, nwg, G, c;
    __host__ __device__ void init(int M, int N, int G_, int c_) { nM = M / BM; nN = N / BM; nwg = nM * nN; G = G_; c = c_; }
    __host__ __device__ bool next(int i, Unit& u) const {
        const long L = (long)i * G + c; if (L >= nwg) return false;
        int wgid = (int)L; { const int q = nwg / NXCD, r = nwg % NXCD, xcd = wgid % NXCD, off = wgid / NXCD; wgid = (xcd < r ? xcd * (q + 1) : r * (q + 1) + (xcd - r) * q) + off; }
        const int nig = WGM * nN, gid = wgid / nig, fm = gid * WGM, gsz = (nM - fm) < WGM ? (nM - fm) : WGM;
        u.pm = fm + ((wgid % nig) % gsz); u.pn = (wgid % nig) / gsz; return true;
    }
};
template <class Epi, class Sched, bool ALIGN_EPI>
__device__ __forceinline__ void gemm_phase(LAS unsigned char* lds, const Gemm g, const Sched& S, const Epi& E) {
    const int tid = threadIdx.x, wid = __builtin_amdgcn_readfirstlane(tid >> 6), lane = tid & 63, wr = wid >> 2, wc = wid & 3, fr = lane & 15, fq = lane >> 4;
    const int K = g.K, nt = K / BK;
    unsigned voffA[2], voffB[2];
#pragma unroll
    for (int i = 0; i < 2; ++i) { int R, C; stage_rc(tid * 16 + i * 8192, R, C); const int Rb = Epi::PERM ? ((R & ~31) + perm32(R & 31)) : R;
        voffA[i] = (unsigned)(R * g.lda + C) * 2u; voffB[i] = (unsigned)(Rb * g.ldb + C) * 2u; }
    const size_t kstep = (size_t)(BK * 2);
    const size_t hsA = (size_t)HALF * g.lda * 2, hsB = (size_t)HALF * g.ldb * 2;
    const unsigned ldsw = (unsigned)wid * 1024u;
    const int aoff = lds_byte(wr * 64 + fr, fq * 8), boff = lds_byte(wc * 32 + fr, fq * 8);
#define PG8_SA(b, h) (((b) * 2 + (h)) * HTB)
#define PG8_SB(b, h) ((4 + (b) * 2 + (h)) * HTB)
#define PG8_STAGE(bufoff, gbase, voff) do { _Pragma("unroll") for (int _i = 0; _i < 2; ++_i) \
        __builtin_amdgcn_global_load_lds((const unsigned*)((const char*)(gbase) + (voff)[_i]), (LAS unsigned*)(lds + (bufoff) + ldsw + _i * 8192), 16, 0, 0); } while (0)
#define PG8_LDA(dst, b, h) do { _Pragma("unroll") for (int m = 0; m < 4; ++m) _Pragma("unroll") for (int k = 0; k < 2; ++k) dst[m][k] = *(const LAS bf16x8*)(lds + PG8_SA(b, h) + aoff + m * 2048 + k * 1024); } while (0)
#define PG8_LDB(dst, b, h) do { _Pragma("unroll") for (int n = 0; n < 2; ++n) _Pragma("unroll") for (int k = 0; k < 2; ++k) dst[n][k] = *(const LAS bf16x8*)(lds + PG8_SB(b, h) + boff + n * 2048 + k * 1024); } while (0)
#define PG8_MMA(ai, bj, At, Bt) do { __builtin_amdgcn_s_setprio(1); _Pragma("unroll") for (int m = 0; m < 4; ++m) _Pragma("unroll") for (int n = 0; n < 2; ++n) _Pragma("unroll") for (int k = 0; k < 2; ++k) \
        acc[ai][bj][m][n] = __builtin_amdgcn_mfma_f32_16x16x32_bf16(Bt[n][k], At[m][k], acc[ai][bj][m][n], 0, 0, 0); __builtin_amdgcn_s_setprio(0); } while (0)
#define PG8_WAIT_V(n) asm volatile("s_waitcnt vmcnt(" #n ")" ::: "memory")
#define PG8_WAIT_L(n) asm volatile("s_waitcnt lgkmcnt(" #n ")" ::: "memory")
#define PG8_BAR __builtin_amdgcn_s_barrier()
#define PG8_SCHED __builtin_amdgcn_sched_barrier(0)
#define PG8_UA(u) ((const char*)g.A + (size_t)(u).pm * 2 * hsA + (size_t)(u).pn * (size_t)g.acs * 2)
#define PG8_UB(u) ((const char*)g.Bt + (size_t)(u).pn * 2 * hsB)
    Unit cur, nxt; int ui = 0;
    if (!S.next(0, cur)) return;
    f32x4 acc[2][2][4][2];
#pragma unroll
    for (int a = 0; a < 2; ++a)
#pragma unroll
        for (int b = 0; b < 2; ++b)
#pragma unroll
            for (int m = 0; m < 4; ++m)
#pragma unroll
                for (int n = 0; n < 2; ++n) acc[a][b][m][n] = (f32x4){0.f, 0.f, 0.f, 0.f};
    bf16x8 At[4][2], B0[2][2], B1[2][2];
    const char* cA = PG8_UA(cur); const char* cB = PG8_UB(cur);
    PG8_STAGE(PG8_SB(0, 0), cB, voffB); PG8_STAGE(PG8_SB(0, 1), cB + hsB, voffB); PG8_STAGE(PG8_SA(0, 0), cA, voffA); PG8_STAGE(PG8_SA(0, 1), cA + hsA, voffA);
    if (wr == 1) PG8_BAR;
    PG8_WAIT_V(2); PG8_BAR;
    PG8_STAGE(PG8_SB(1, 0), cB + kstep, voffB); PG8_STAGE(PG8_SA(1, 0), cA + kstep, voffA); PG8_STAGE(PG8_SB(1, 1), cB + hsB + kstep, voffB);
    PG8_WAIT_V(6); PG8_BAR;
    for (;;) {
        const bool has_next = S.next(ui + 1, nxt);
        const char* nA = has_next ? PG8_UA(nxt) : cA; const char* nB = has_next ? PG8_UB(nxt) : cB;
        for (int t = 0; t < nt; t += 2) {
            const bool last = (t == nt - 2);
            const char* a1 = cA + (size_t)(t + 1) * kstep;
            const char* a2 = last ? nA : cA + (size_t)(t + 2) * kstep; const char* b2 = last ? nB : cB + (size_t)(t + 2) * kstep;
            const char* a3 = a2 + kstep; const char* b3 = b2 + kstep;
            PG8_LDB(B0, 0, 0); PG8_LDB(B1, 0, 1); PG8_SCHED; PG8_LDA(At, 0, 0); PG8_STAGE(PG8_SA(1, 1), a1 + hsA, voffA);
            PG8_WAIT_V(8); PG8_WAIT_L(0); PG8_BAR; PG8_MMA(0, 0, At, B0); PG8_MMA(0, 1, At, B1); PG8_BAR; PG8_SCHED;
            PG8_LDA(At, 0, 1); PG8_STAGE(PG8_SB(0, 0), b2, voffB); PG8_STAGE(PG8_SB(0, 1), b2 + hsB, voffB); PG8_STAGE(PG8_SA(0, 0), a2, voffA);
            PG8_WAIT_V(8); PG8_WAIT_L(0); PG8_BAR; PG8_MMA(1, 0, At, B0); PG8_MMA(1, 1, At, B1); PG8_BAR; PG8_SCHED;
            PG8_LDB(B0, 1, 0); PG8_LDB(B1, 1, 1); PG8_SCHED; PG8_LDA(At, 1, 0); PG8_STAGE(PG8_SA(0, 1), a2 + hsA, voffA);
            PG8_WAIT_V(8); PG8_WAIT_L(0); PG8_BAR; PG8_MMA(0, 0, At, B0); PG8_MMA(0, 1, At, B1); PG8_BAR; PG8_SCHED;
            PG8_LDA(At, 1, 1); PG8_STAGE(PG8_SB(1, 0), b3, voffB); PG8_STAGE(PG8_SB(1, 1), b3 + hsB, voffB); PG8_STAGE(PG8_SA(1, 0), a3, voffA);
            PG8_WAIT_V(8); PG8_WAIT_L(0); PG8_BAR; PG8_MMA(1, 0, At, B0); PG8_MMA(1, 1, At, B1); PG8_BAR; PG8_SCHED;
        }
        if constexpr (ALIGN_EPI) { if (wr == 0) PG8_BAR; }
        E(acc, cur, wr, wc, fr, fq);
        if (!has_next) break;
#pragma unroll
        for (int a = 0; a < 2; ++a)
#pragma unroll
            for (int b = 0; b < 2; ++b)
#pragma unroll
                for (int m = 0; m < 4; ++m)
#pragma unroll
                    for (int n = 0; n < 2; ++n) acc[a][b][m][n] = (f32x4){0.f, 0.f, 0.f, 0.f};
        cur = nxt; cA = nA; cB = nB; ++ui;
        if constexpr (ALIGN_EPI) { if (wr == 1) PG8_BAR; }
    }
    PG8_WAIT_V(0);
    if constexpr (!ALIGN_EPI) { if (wr == 0) PG8_BAR; }
    PG8_BAR;
#undef PG8_SA
#undef PG8_SB
#undef PG8_STAGE
#undef PG8_LDA
#undef PG8_LDB
#undef PG8_MMA
#undef PG8_WAIT_V
#undef PG8_WAIT_L
#undef PG8_BAR
#undef PG8_SCHED
#undef PG8_UA
#undef PG8_UB
}

struct EpiProj {
    static constexpr bool PERM = true;
    bf16_t* Q; bf16_t* KV; float* gates; float* out;
    __device__ __forceinline__ void operator()(const f32x4 (&acc)[2][2][4][2], const Unit& u, int wr, int wc, int fr, int fq) const {
        const int pn = u.pn;
#pragma unroll
        for (int ai = 0; ai < 2; ++ai)
#pragma unroll
            for (int m = 0; m < 4; ++m) {
                const int row = u.pm * BM + ai * HALF + wr * 64 + m * 16 + fr;
                if (pn < 4) {
#pragma unroll
                    for (int bj = 0; bj < 2; ++bj) { const f32x4 v0 = acc[ai][bj][m][0] * C2, v1 = acc[ai][bj][m][1] * C2; u32x4 w;
                        w.x = cvtpk(v0[0], v0[1]); w.y = cvtpk(v0[2], v0[3]); w.z = cvtpk(v1[0], v1[1]); w.w = cvtpk(v1[2], v1[3]);
                        *(u32x4*)(Q + (size_t)row * D + pn * 256 + bj * HALF + wc * 32 + 8 * fq) = w; }
                } else if (pn < 10) {
                    const int t = pn - 4; float* dst = nullptr;
                    if (row < MP) { if (t < 4) dst = out + O_KCP + (size_t)t * SZ_KVP + (size_t)row * 256; else { const int tt = row & (SEQ - 1); if (tt >= SEQ - 512) dst = out + O_KWP + (size_t)(t - 4) * SZ_WP + ((size_t)(row >> 12) * 512 + (tt - (SEQ - 512))) * 256; } }
                    else { const int rs = row - MP; if (t < 4) dst = out + O_KCS + (size_t)t * SZ_KVS + (size_t)rs * 256; else dst = out + O_KWS + (size_t)(t - 4) * SZ_WS + ((size_t)(rs >> 2) * 512 + 508 + (rs & 3)) * 256; }
                    bf16_t* bd = KV + (size_t)t * KV_STRIDE + (size_t)row * 256;
#pragma unroll
                    for (int bj = 0; bj < 2; ++bj) { const int cc = bj * HALF + wc * 32 + 8 * fq; const f32x4 v0 = acc[ai][bj][m][0], v1 = acc[ai][bj][m][1]; u32x4 w;
                        w.x = cvtpk(v0[0], v0[1]); w.y = cvtpk(v0[2], v0[3]); w.z = cvtpk(v1[0], v1[1]); w.w = cvtpk(v1[2], v1[3]);
                        *(u32x4*)(bd + cc) = w;
                        if (dst) { *(f32x4*)(dst + cc) = v0; *(f32x4*)(dst + cc + 4) = v1; } }
                } else {
                    const int cc = wc * 32 + 8 * fq;
                    if (cc < 48) { float* gd = gates + (size_t)row * 48 + cc; *(f32x4*)gd = acc[ai][0][m][0]; *(f32x4*)(gd + 4) = acc[ai][0][m][1]; }
                }
            }
    }
};
struct EpiRes {
    static constexpr bool PERM = false;
    const float* xin_p; const float* xin_s; float* xout; const float* gate; const float* scale;
    __device__ __forceinline__ void operator()(const f32x4 (&acc)[2][2][4][2], const Unit& u, int wr, int wc, int fr, int fq) const {
#pragma unroll
        for (int ai = 0; ai < 2; ++ai)
#pragma unroll
            for (int m = 0; m < 4; ++m) {
                const int row = u.pm * BM + ai * HALF + wr * 64 + m * 16 + fr;
                const int bb = row < MP ? (row >> 12) : NB + ((row - MP) >> 2);
                const float* xi = row < MP ? xin_p + (size_t)row * D : xin_s + (size_t)(row - MP) * D;
                const float* gp = gate + (size_t)bb * 6144; float* xo = xout + (size_t)row * D;
#pragma unroll
                for (int bj = 0; bj < 2; ++bj)
#pragma unroll
                    for (int n = 0; n < 2; ++n) { const int col = u.pn * BM + bj * HALF + wc * 32 + 16 * n + 4 * fq;
                        f32x4 g4 = *(const f32x4*)(gp + col); if (scale) g4 = g4 * *(const f32x4*)(scale + col);
                        const f32x4 x4 = *(const f32x4*)(xi + col); *(f32x4*)(xo + col) = x4 + g4 * acc[ai][bj][m][n]; }
            }
    }
};
struct EpiGU {
    static constexpr bool PERM = true;
    bf16_t* act;
    __device__ __forceinline__ void operator()(const f32x4 (&acc)[2][2][4][2], const Unit& u, int wr, int wc, int fr, int fq) const {
#pragma unroll
        for (int ai = 0; ai < 2; ++ai)
#pragma unroll
            for (int m = 0; m < 4; ++m) {
                const int row = u.pm * BM + ai * HALF + wr * 64 + m * 16 + fr; float r[8];
#pragma unroll
                for (int n = 0; n < 2; ++n)
#pragma unroll
                    for (int e = 0; e < 4; ++e) { const float gv = acc[ai][0][m][n][e], uv = acc[ai][1][m][n][e]; r[n * 4 + e] = gv * sigmoidf_(gv) * uv; }
                u32x4 w; w.x = cvtpk(r[0], r[1]); w.y = cvtpk(r[2], r[3]); w.z = cvtpk(r[4], r[5]); w.w = cvtpk(r[6], r[7]);
                *(u32x4*)(act + (size_t)row * FF + u.pn * HALF + wc * 32 + 8 * fq) = w;
            }
    }
};
}

#define XB_TMO      128
#define XB_XCNT(j)  (256  + 64 * (j))
#define XB_XSUB(j)  (1280 + 64 * (j))
#define XB_XGEN(j)  (2304 + 64 * (j))
#define XB_TOP      3328
#define XB_TOPGEN   3392
#define XCD_BAR_WORDS 3456
#define XB_SPIN_CAP (1u << 18)
__device__ __forceinline__ unsigned xb_ld(unsigned* p)              { return __hip_atomic_load(p, __ATOMIC_RELAXED, __HIP_MEMORY_SCOPE_AGENT); }
__device__ __forceinline__ unsigned xb_add(unsigned* p, unsigned v) { return __hip_atomic_fetch_add(p, v, __ATOMIC_RELAXED, __HIP_MEMORY_SCOPE_AGENT); }
__device__ __forceinline__ unsigned xb_xcc_id() { return (unsigned)__builtin_amdgcn_s_getreg((3 << 11) | 20) & 0xFu; }
#define XB_SPIN(cond, bar) do { unsigned _sp = 0; while (cond) { __builtin_amdgcn_s_sleep(1); \
    if ((++_sp & 255u) == 0u) { if (xb_ld(&(bar)[XB_TMO])) break; if (_sp > XB_SPIN_CAP) { atomicAdd(&(bar)[XB_TMO], 1u); break; } } } } while (0)
struct XcdBarrier { unsigned* bar; unsigned x; volatile LAS unsigned* st; };
__device__ __forceinline__ XcdBarrier xcd_barrier_post(unsigned* bar, volatile LAS unsigned* st) {
    XcdBarrier b; b.bar = bar; b.x = xb_xcc_id(); b.st = st;
    if (threadIdx.x == 0) (void)xb_add(&bar[XB_XCNT(b.x)], 1u);
    return b;
}
__device__ __forceinline__ void xcd_barrier_complete(unsigned* bar, unsigned x, unsigned& nloc, unsigned& nx) {
    const unsigned G = gridDim.x * gridDim.y * gridDim.z;
    unsigned sum, cnt, mine, sp = 0u;
    for (;;) {
        sum = 0u; cnt = 0u; mine = 0u;
#pragma unroll
        for (unsigned j = 0; j < 16; ++j) { const unsigned c = xb_ld(&bar[XB_XCNT(j)]); sum += c; cnt += (c > 0u) ? 1u : 0u; mine = (j == x) ? c : mine; }
        if (sum == G) break;
        __builtin_amdgcn_s_sleep(1);
        if ((++sp & 255u) == 0u) { if (xb_ld(&bar[XB_TMO])) break; if (sp > XB_SPIN_CAP) { atomicAdd(&bar[XB_TMO], 1u); break; } }
    }
    nloc = mine > 0u ? mine : 1u; nx = cnt > 0u ? cnt : 1u;
}
__device__ __forceinline__ void xcd_barrier(const XcdBarrier& b) {
    asm volatile("s_waitcnt vmcnt(0)" ::: "memory");
    __syncthreads();
    if (threadIdx.x == 0) {
        unsigned* bar = b.bar;
        __builtin_amdgcn_s_waitcnt(0);
        unsigned nloc = b.st[0], nx = b.st[1];
        if (nloc == 0u) { xcd_barrier_complete(bar, b.x, nloc, nx); b.st[0] = nloc; b.st[1] = nx; }
        const unsigned old = xb_add(&bar[XB_XSUB(b.x)], 1u);
        const unsigned gen = old / nloc;
        if (old + 1u == (gen + 1u) * nloc) {
            __builtin_amdgcn_fence(__ATOMIC_RELEASE, "agent");
            asm volatile("s_waitcnt vmcnt(0)" ::: "memory");
            const unsigned og = xb_add(&bar[XB_TOP], 1u);
            const unsigned tg = og / nx;
            if (og + 1u == (tg + 1u) * nx) xb_add(&bar[XB_TOPGEN], 1u);
            else XB_SPIN(xb_ld(&bar[XB_TOPGEN]) == tg, bar);
            __builtin_amdgcn_fence(__ATOMIC_ACQUIRE, "agent");
            xb_add(&bar[XB_XGEN(b.x)], 1u);
            asm volatile("s_waitcnt vmcnt(0)" ::: "memory");
        } else {
            XB_SPIN(xb_ld(&bar[XB_XGEN(b.x)]) == gen, bar);
            __builtin_amdgcn_fence(__ATOMIC_ACQUIRE, "agent");
            asm volatile("s_waitcnt vmcnt(0)" ::: "memory");
        }
    }
    __syncthreads();
}

struct Args { const void* in[28]; float* out; unsigned char* ws; int ph_lo, ph_hi, pad0, pad1; };
struct Frame {
    LAS unsigned char* lds; int tid, lane, wave, vcu, G;
    const float *x_p, *x_s, *c_p, *c_s, *ck_cmp, *cv_cmp, *ck_sel, *cv_sel; const int* page_table; const float *st_kw, *st_vw, *st_pool, *rel_bias, *ada_w, *ada_b, *norm_g, *final_g,
        *w_in, *w_out, *cmp_wk, *cmp_wv, *pe_k, *pe_v, *pool_w, *pool_scale, *ffn_wg, *ffn_wu, *ffn_wd;
    float* out; unsigned char* ws;
};
__device__ __forceinline__ float wave_sum(float v) {
#pragma unroll
    for (int o = 1; o < 64; o <<= 1) v += __shfl_xor(v, o);
    return v;
}

__device__ __forceinline__ void transpose_item(const float* W, int ldw, int nvalid, bf16_t* WT, int ldt, int drow0, LAS float* scr, int k0, int n0, int lane) {
    float tv[32];
#pragma unroll
    for (int i = 0; i < 32; ++i) { const int kk = 2 * i + (lane >> 5), n = n0 + (lane & 31); tv[i] = (n < nvalid) ? W[(size_t)(k0 + kk) * ldw + n] : 0.f; }
#pragma unroll
    for (int i = 0; i < 32; ++i) { const int kk = 2 * i + (lane >> 5); scr[kk * 33 + (lane & 31)] = tv[i]; }
    LDS_WAIT();
    const int c = lane & 7;
#pragma unroll
    for (int j = 0; j < 4; ++j) { const int n = (lane >> 3) + 8 * j; const LAS float* s = scr + (8 * c) * 33 + n;
        u32x4 o; o.x = cvtpk(s[0 * 33], s[1 * 33]); o.y = cvtpk(s[2 * 33], s[3 * 33]); o.z = cvtpk(s[4 * 33], s[5 * 33]); o.w = cvtpk(s[6 * 33], s[7 * 33]);
        *(u32x4*)(WT + (size_t)(drow0 + n) * ldt + k0 + 8 * c) = o; }
    LDS_WAIT();
}
__device__ __forceinline__ void p0_prologue(Frame& F) {
    LAS float* scr = (LAS float*)(F.lds + F.wave * 16384);
    const int gw = F.vcu * 8 + F.wave, NGW = F.G * 8, lane = F.lane;
    unsigned char* ws = F.ws;
    constexpr int I_IN = 16 * 88, I_OUT = 16 * 32, I_G = 16 * 88, I_D = 44 * 32, I_P = 4 * 8, I_C = 32 * 2;
    constexpr int NITEMS = I_IN + I_OUT + 4 * I_G + 2 * I_D + 4 * I_P + 2 * I_C;
    for (int it = gw; it < NITEMS; it += NGW) {
        int r = it;
        if (r < I_IN) { const int kb = r / 88, nb = r % 88; transpose_item(F.w_in, INCOLS, INCOLS, (bf16_t*)(ws + WS_WIN), D, nb * 32, scr, kb * 64, nb * 32, lane); continue; } r -= I_IN;
        if (r < I_OUT) { const int kb = r / 32, nb = r % 32; transpose_item(F.w_out, D, D, (bf16_t*)(ws + WS_WOUT), D, nb * 32, scr, kb * 64, nb * 32, lane); continue; } r -= I_OUT;
        if (r < 4 * I_G) { const int l = r / (2 * I_G), which = (r / I_G) & 1, q = r % I_G, kb = q / 88, nb = q % 88, n0 = nb * 32;
            const float* W = (which ? F.ffn_wu : F.ffn_wg) + (size_t)l * D * FF;
            transpose_item(W, FF, FF, (bf16_t*)(ws + WS_WGU) + (size_t)l * NGU * D, D, (n0 >> 7) * 256 + which * 128 + (n0 & 127), scr, kb * 64, n0, lane); continue; } r -= 4 * I_G;
        if (r < 2 * I_D) { const int l = r / I_D, q = r % I_D, kb = q / 32, nb = q % 32;
            transpose_item(F.ffn_wd + (size_t)l * FF * D, D, D, (bf16_t*)(ws + WS_WD) + (size_t)l * D * FF, FF, nb * 32, scr, kb * 64, nb * 32, lane); continue; } r -= 2 * I_D;
        if (r < 4 * I_P) { const int gI = r / I_P, q = r % I_P, kb = q / 8, nb = q % 8;
            transpose_item(F.pool_w + (size_t)gI * 65536, 256, 256, (bf16_t*)(ws + WS_WPOOL) + (size_t)gI * 65536, 256, nb * 32, scr, kb * 64, nb * 32, lane); continue; } r -= 4 * I_P;
        { const int which = r / I_C, q = r % I_C, kb = q / 2, nb = q % 2;
          transpose_item(which ? F.cmp_wv : F.cmp_wk, 64, 64, (bf16_t*)(ws + (which ? WS_WCV : WS_WCK)), 2048, nb * 32, scr, kb * 64, nb * 32, lane); }
    }
    { const int gt = (F.vcu * 8 + F.wave) * 64 + lane, NT = F.G * 512; bf16_t* sc = (bf16_t*)(ws + WS_SC);
      for (int i = gt; i < 144 * 512; i += NT) { const int row = i >> 9, c2 = (i & 511) * 2; float a = 0.f, b = 0.f;
          if (row < NMODB) { const float* cp = row < NB ? F.c_p + (size_t)row * D : F.c_s + (size_t)(row - NB) * D; const float x0 = cp[c2], x1 = cp[c2 + 1]; a = x0 * sigmoidf_(x0); b = x1 * sigmoidf_(x1); }
          *(unsigned*)(sc + (size_t)row * D + c2) = cvtpk(a, b); } }
    if (F.vcu < 16) { const int tsel = F.vcu >> 3, part = F.vcu & 7; const float* pe = tsel ? F.pe_v : F.pe_k; const float* W = tsel ? F.cmp_wv : F.cmp_wk; float sacc = 0.f;
        const int kb = part * 256 + F.wave * 32;
#pragma unroll
        for (int k = 0; k < 32; ++k) sacc += pe[kb + k] * W[(size_t)(kb + k) * 64 + lane];
        LAS float* red = (LAS float*)(F.lds + WSF_OFF);
        red[F.wave * 64 + lane] = sacc; LDS_WAIT(); __syncthreads();
        if (F.wave == 0) { float t2 = 0.f;
#pragma unroll
            for (int w = 0; w < 8; ++w) t2 += red[w * 64 + lane];
            ((float*)(ws + WS_CB))[(tsel * 8 + part) * 64 + lane] = t2; }
        __syncthreads(); }
    { const size_t gt = (size_t)(F.vcu * 8 + F.wave) * 64 + lane, NT = (size_t)F.G * 512;
      const size_t pp = (size_t)NSB * 11 * 256;
      for (size_t i = gt; i < pp; i += NT) { const size_t b = i / (11 * 256), rem = i % (11 * 256);
          ((f32x4*)(F.out + O_PLS + b * 15 * D))[rem] = ((const f32x4*)(F.st_pool + (b * 15 + 4) * D))[rem]; } }
}

__device__ __forceinline__ void p1_ada(Frame& F) {
    const int gw = F.vcu * 8 + F.wave, NGW = F.G * 8, lane = F.lane, fr = lane & 15, kq = lane >> 4;
    const bf16_t* sc = (const bf16_t*)(F.ws + WS_SC); float* mod = (float*)(F.ws + WS_MOD);
    for (int tile = F.wave < 3 ? F.vcu * 3 + F.wave : 768; tile < 768; tile += F.G * 3) {
        const int layer = tile / 384, n0 = (tile % 384) * 16;
        const float* W = F.ada_w + (size_t)layer * D * 6144 + n0 + fr;
        f32x4 acc[9];
#pragma unroll
        for (int i = 0; i < 9; ++i) acc[i] = (f32x4){0.f, 0.f, 0.f, 0.f};
#pragma unroll 4
        for (int k0 = 0; k0 < D; k0 += 32) {
            float w[8];
#pragma unroll
            for (int i = 0; i < 8; ++i) w[i] = W[(size_t)(k0 + 8 * kq + i) * 6144];
            u32x4 bw; bw.x = cvtpk(w[0], w[1]); bw.y = cvtpk(w[2], w[3]); bw.z = cvtpk(w[4], w[5]); bw.w = cvtpk(w[6], w[7]);
            const bf16x8 bfrag = __builtin_bit_cast(bf16x8, bw);
#pragma unroll
            for (int mt = 0; mt < 9; ++mt) { const bf16x8 af = *(const bf16x8*)(sc + (size_t)(mt * 16 + fr) * D + k0 + 8 * kq);
                acc[mt] = __builtin_amdgcn_mfma_f32_16x16x32_bf16(af, bfrag, acc[mt], 0, 0, 0); }
        }
        const float bias = F.ada_b[layer * 6144 + n0 + fr];
#pragma unroll
        for (int mt = 0; mt < 9; ++mt)
#pragma unroll
            for (int e = 0; e < 4; ++e) { const int row = mt * 16 + 4 * kq + e; if (row < NMODB) mod[((size_t)layer * NMODB + row) * 6144 + n0 + fr] = acc[mt][e] + bias; }
    }
}

__device__ __forceinline__ void p1_compress_sample(Frame& F) {
    const int lane = F.lane, wave = F.wave, r32 = lane & 31, hi = lane >> 5, kvl = lane >> 4, c4 = lane & 15;
    LAS unsigned char* L = F.lds;
    const int wrow = wave * 4 + kvl, total = 2 * NSB * 8;
    const int nitem = (total - F.vcu + F.G - 1) / F.G; if (nitem <= 0) return;
    const int nstage = 2 * nitem;
#define CS_BAR() do { asm volatile("s_waitcnt lgkmcnt(0)" ::: "memory"); __builtin_amdgcn_s_barrier(); asm volatile("" ::: "memory"); } while (0)
#define CS_SRC(g, ptr) do { const int it_ = F.vcu + F.G * ((g) >> 1); const int wh_ = it_ / (NSB * 8), q_ = it_ % (NSB * 8), b_ = q_ >> 3, n_ = (q_ & 7) * 8 + wave; const int pg_ = F.page_table[b_ * 16 + (n_ >> 2)]; \
        ptr = uniform_ptr((wh_ ? F.cv_cmp : F.ck_cmp) + ((size_t)pg_ * 128 + (n_ & 3) * 32 + ((g) & 1) * 16) * 256); } while (0)
#define CS_LOAD(ptr) do { _Pragma("unroll") for (int jj = 0; jj < 16; ++jj) x[jj] = *(const f32x4*)((ptr) + (unsigned)(jj * 1024 + lane * 16)); } while (0)
#define CS_STORE(buf) do { _Pragma("unroll") for (int jj = 0; jj < 16; ++jj) { u32x2 w_; w_.x = cvtpk(x[jj][0], x[jj][1]); w_.y = cvtpk(x[jj][2], x[jj][3]); \
        *(LAS u32x2*)(L + (buf) * 65536 + wrow * 2048 + (((jj * 8 + (c4 >> 1)) ^ (wrow & 15)) << 4) + (c4 & 1) * 8) = w_; } } while (0)
    f32x4 x[16]; const char* sp;
    CS_SRC(0, sp); CS_LOAD(sp); CS_STORE(0); CS_BAR();
    f32x16 a0, a1;
#pragma unroll
    for (int r = 0; r < 16; ++r) { a0[r] = 0.f; a1[r] = 0.f; }
#pragma unroll 1
    for (int g = 0; g < nstage; ++g) {
        const int it = F.vcu + F.G * (g >> 1), which = it / (NSB * 8), q = it % (NSB * 8), b = q >> 3, n0 = (q & 7) * 8;
        const bf16_t* wp = (const bf16_t*)(F.ws + (which ? WS_WCV : WS_WCK)) + (size_t)r32 * 2048 + (g & 1) * 1024 + 128 * wave + 8 * hi;
        bf16x8 bfr[16];
#pragma unroll
        for (int ks = 0; ks < 8; ++ks) { bfr[2 * ks] = *(const bf16x8*)(wp + 16 * ks); bfr[2 * ks + 1] = *(const bf16x8*)(wp + 32 * 2048 + 16 * ks); }
        if (g + 1 < nstage) { CS_SRC(g + 1, sp); CS_LOAD(sp); }
        const LAS unsigned char* ab = L + (g & 1) * 65536 + r32 * 2048;
#pragma unroll
        for (int ks = 0; ks < 8; ++ks) { const bf16x8 af = *(const LAS bf16x8*)(ab + (((16 * wave + 2 * ks + hi) ^ (r32 & 15)) << 4));
            a0 = __builtin_amdgcn_mfma_f32_32x32x16_bf16(af, bfr[2 * ks], a0, 0, 0, 0); a1 = __builtin_amdgcn_mfma_f32_32x32x16_bf16(af, bfr[2 * ks + 1], a1, 0, 0, 0); }
        CS_BAR();
        if (g & 1) {
            LAS float* red = (LAS float*)(L + 65536) + wave * 2048 + hi * 256 + r32;
#pragma unroll
            for (int r = 0; r < 16; ++r) { red[CROW0(r) * 64] = a0[r]; red[CROW0(r) * 64 + 32] = a1[r]; a0[r] = 0.f; a1[r] = 0.f; }
            CS_BAR();
            { const int row = F.tid >> 4, cc = (F.tid & 15) * 4; f32x4 sacc = (f32x4){0.f, 0.f, 0.f, 0.f};
#pragma unroll
              for (int pp = 0; pp < 8; ++pp) sacc = sacc + *(const f32x4*)((const float*)(F.ws + WS_CB) + (which * 8 + pp) * 64 + cc);
#pragma unroll
              for (int w = 0; w < 8; ++w) sacc = sacc + *(const LAS f32x4*)((const LAS float*)(L + 65536) + w * 2048 + row * 64 + cc);
              bf16_t* o = (bf16_t*)(F.ws + (which ? WS_VCMPS : WS_KCMPS)) + (size_t)b * 4 * 64 * 64 + ((size_t)(row & 3) * 64 + n0 + (row >> 2)) * 64 + cc;
              u32x2 w2; w2.x = cvtpk(sacc[0], sacc[1]); w2.y = cvtpk(sacc[2], sacc[3]); *(u32x2*)o = w2; }
        }
        if (g + 1 < nstage) CS_STORE((g + 1) & 1);
        CS_BAR();
    }
    VM_WAIT(); __syncthreads();
#undef CS_BAR
#undef CS_SRC
#undef CS_LOAD
#undef CS_STORE
}
__device__ __forceinline__ void p4_compress_prompt(Frame& F) {
    const int lane = F.lane, r32 = lane & 31, hi = lane >> 5, nl = r32 >> 2, kv = r32 & 3;
    for (int it = F.vcu; it < 2 * NB * 16; it += F.G) {
        const int which = it / (NB * 16), q = it % (NB * 16), b = q >> 4, n0 = (q & 15) * 8, n = n0 + nl;
        const bf16_t* src = (const bf16_t*)(F.ws + WS_KV) + (size_t)which * KV_STRIDE + ((size_t)b * SEQ + (size_t)n * 32) * 256 + kv * 64;
        const bf16_t* Wt = (const bf16_t*)(F.ws + (which ? WS_WCV : WS_WCK));
        const bf16_t* w0 = Wt + (size_t)r32 * 2048 + hi * 8; const bf16_t* w1 = w0 + (size_t)32 * 2048;
        f32x16 a0, a1;
#pragma unroll
        for (int r = 0; r < 16; ++r) { a0[r] = 0.f; a1[r] = 0.f; }
#pragma unroll
        for (int jj = 0; jj < 4; ++jj) { const int j = F.wave * 4 + jj;
#pragma unroll
            for (int ds = 0; ds < 4; ++ds) { const bf16x8 af = *(const bf16x8*)(src + (size_t)j * 256 + ds * 16 + hi * 8);
                const bf16x8 b0 = *(const bf16x8*)(w0 + j * 64 + ds * 16), b1 = *(const bf16x8*)(w1 + j * 64 + ds * 16);
                a0 = __builtin_amdgcn_mfma_f32_32x32x16_bf16(af, b0, a0, 0, 0, 0); a1 = __builtin_amdgcn_mfma_f32_32x32x16_bf16(af, b1, a1, 0, 0, 0); } }
        LAS float* red = (LAS float*)F.lds + F.wave * 2048 + hi * 256 + r32;
#pragma unroll
        for (int r = 0; r < 16; ++r) { red[CROW0(r) * 64] = a0[r]; red[CROW0(r) * 64 + 32] = a1[r]; }
        LDS_WAIT(); __syncthreads();
        { const int row = F.tid >> 4, c4 = (F.tid & 15) * 4; f32x4 sacc = (f32x4){0.f, 0.f, 0.f, 0.f};
#pragma unroll
          for (int pp = 0; pp < 8; ++pp) sacc = sacc + *(const f32x4*)((const float*)(F.ws + WS_CB) + (which * 8 + pp) * 64 + c4);
#pragma unroll
          for (int w = 0; w < 8; ++w) sacc = sacc + *(const LAS f32x4*)((const LAS float*)F.lds + w * 2048 + row * 64 + c4);
          bf16_t* o = (bf16_t*)(F.ws + (which ? WS_VCMPP : WS_KCMPP)) + (size_t)b * 4 * 128 * 64 + ((size_t)(row & 3) * 128 + n0 + (row >> 2)) * 64 + c4;
          u32x2 w2; w2.x = cvtpk(sacc[0], sacc[1]); w2.y = cvtpk(sacc[2], sacc[3]); *(u32x2*)o = w2; }
        __syncthreads();
    }
}

__device__ __forceinline__ void small_gemm_res(Frame& F, const bf16_t* A  , int lda, const bf16_t* Wt, int ldb, int K, bool bd, const float* xin_s, float* xout_s, const float* gate, const float* scale) {
    const int lane = F.lane, r32 = lane & 31, hi = lane >> 5, kw = K >> 3, kbeg = F.wave * kw;
    for (int tile = F.vcu; tile < 256; tile += F.G) {
        const int row0 = (tile >> 4) * 32, col0 = (tile & 15) * 64, acol = bd ? (col0 >> 8) * 256 : 0;
        const bf16_t* ap = A + (size_t)(row0 + r32) * lda + acol + kbeg + 8 * hi;
        const bf16_t* b0p = Wt + (size_t)(col0 + r32) * ldb + kbeg + 8 * hi; const bf16_t* b1p = b0p + (size_t)32 * ldb;
        f32x16 c0, c1;
#pragma unroll
        for (int r = 0; r < 16; ++r) { c0[r] = 0.f; c1[r] = 0.f; }
#pragma unroll 8
        for (int ks = 0; ks < kw; ks += 16) { const bf16x8 a = *(const bf16x8*)(ap + ks), b0 = *(const bf16x8*)(b0p + ks), b1 = *(const bf16x8*)(b1p + ks);
            c0 = __builtin_amdgcn_mfma_f32_32x32x16_bf16(a, b0, c0, 0, 0, 0); c1 = __builtin_amdgcn_mfma_f32_32x32x16_bf16(a, b1, c1, 0, 0, 0); }
        LAS float* red = (LAS float*)F.lds + F.wave * 2048 + hi * 256 + r32;
#pragma unroll
        for (int r = 0; r < 16; ++r) { red[CROW0(r) * 64] = c0[r]; red[CROW0(r) * 64 + 32] = c1[r]; }
        LDS_WAIT(); __syncthreads();
        { const int row = F.tid >> 4, c4 = (F.tid & 15) * 4; f32x4 sacc = (f32x4){0.f, 0.f, 0.f, 0.f};
#pragma unroll
          for (int w = 0; w < 8; ++w) sacc = sacc + *(const LAS f32x4*)((const LAS float*)F.lds + w * 2048 + row * 64 + c4);
          const int rs = row0 + row, col = col0 + c4, bb = NB + (rs >> 2);
          f32x4 g4 = *(const f32x4*)(gate + (size_t)bb * 6144 + col); if (scale) g4 = g4 * *(const f32x4*)(scale + col);
          const f32x4 x4 = *(const f32x4*)(xin_s + (size_t)rs * D + col); *(f32x4*)(xout_s + (size_t)rs * D + col) = x4 + g4 * sacc; }
        __syncthreads();
    }
}

template <int MODE, int NR>
__device__ __forceinline__ void norm_rows(Frame& F, bool from_inputs, int layer, int which, int row0, const f32x4 (&gg)[4], int lane) {
    const float* X = (const float*)(F.ws + WS_X);
    const float* xr = from_inputs ? (row0 < MP ? F.x_p + (size_t)row0 * D : F.x_s + (size_t)(row0 - MP) * D) : X + (size_t)row0 * D;
    f32x4 v[NR][4];
#pragma unroll
    for (int r = 0; r < NR; ++r)
#pragma unroll
        for (int j = 0; j < 4; ++j) v[r][j] = *(const f32x4*)(xr + (size_t)r * D + 4 * lane + 256 * j);
    f32x4 sh[4], sc[4];
    if constexpr (MODE != 2) {
        const int bb = row0 < MP ? (row0 >> 12) : NB + ((row0 - MP) >> 2);
        const float* mp = (const float*)(F.ws + WS_MOD) + ((size_t)layer * NMODB + bb) * 6144 + (which ? 3072 : 0);
#pragma unroll
        for (int j = 0; j < 4; ++j) { sh[j] = *(const f32x4*)(mp + 4 * lane + 256 * j); sc[j] = *(const f32x4*)(mp + 1024 + 4 * lane + 256 * j) + 1.0f; }
    }
    float ss[NR];
#pragma unroll
    for (int r = 0; r < NR; ++r) { float a = 0.f;
#pragma unroll
        for (int j = 0; j < 4; ++j) a += (v[r][j][0] * v[r][j][0] + v[r][j][1] * v[r][j][1]) + (v[r][j][2] * v[r][j][2] + v[r][j][3] * v[r][j][3]);
        ss[r] = a; }
#pragma unroll
    for (int o = 1; o < 64; o <<= 1) {
#pragma unroll
        for (int r = 0; r < NR; ++r) ss[r] += __shfl_xor(ss[r], o); }
#pragma unroll
    for (int r = 0; r < NR; ++r) {
        const int row = row0 + r; const float rstd = 1.0f / sqrtf(ss[r] * (1.0f / D) + 1e-6f);
        if constexpr (MODE == 2) {
            float* o = row < MP ? F.out + O_YP + (size_t)row * D : F.out + O_YS + (size_t)(row - MP) * D;
#pragma unroll
            for (int j = 0; j < 4; ++j) *(f32x4*)(o + 4 * lane + 256 * j) = v[r][j] * rstd * gg[j];
        } else {
            float* pool_dst = nullptr;
            if constexpr (MODE == 1) {
                if (row < MP) { const int tt = row & (SEQ - 1); if (tt >= SEQ - 15) pool_dst = F.out + O_PLP + ((size_t)(row >> 12) * 15 + (tt - (SEQ - 15))) * D; }
                else { const int rs = row - MP; pool_dst = F.out + O_PLS + ((size_t)(rs >> 2) * 15 + 11 + (rs & 3)) * D; }
            }
#pragma unroll
            for (int j = 0; j < 4; ++j) { const int col = 4 * lane + 256 * j; const f32x4 h = (v[r][j] * rstd * gg[j]) * sc[j] + sh[j];
                if constexpr (MODE == 0) { u32x2 w; w.x = cvtpk(h[0], h[1]); w.y = cvtpk(h[2], h[3]); *(u32x2*)((bf16_t*)(F.ws + WS_H) + (size_t)row * D + col) = w; }
                else { *(f32x4*)((float*)(F.ws + WS_HF) + (size_t)row * D + col) = h; if (pool_dst) *(f32x4*)(pool_dst + col) = h; } }
        }
    }
}
template <int MODE>
__device__ __forceinline__ void norm_phase(Frame& F, bool from_inputs, int layer, int which) {
    const int gw = F.vcu * 8 + F.wave, NGW = F.G * 8, lane = F.lane;
    const float* gvec = MODE == 2 ? F.final_g : F.norm_g + (size_t)(layer * 2 + which) * D;
    f32x4 gg[4];
#pragma unroll
    for (int j = 0; j < 4; ++j) gg[j] = *(const f32x4*)(gvec + 4 * lane + 256 * j);
#pragma unroll 1
    for (int grp = gw; grp < MP / 8; grp += NGW) norm_rows<MODE, 8>(F, from_inputs, layer, which, grp * 8, gg, lane);
#pragma unroll 1
    for (int r = gw; r < MS; r += NGW) norm_rows<MODE, 1>(F, from_inputs, layer, which, MP + r, gg, lane);
}

template <int W, int R, bool SAMPLE>
__device__ __forceinline__ void pool_chunk(const float* HF, const float* st_pool, bf16_t* H, int row0, int col) {
    f32x4 v[R + W - 1];
    const int t0 = SAMPLE ? 0 : (row0 & (SEQ - 1));
#pragma unroll
    for (int k = 0; k < R + W - 1; ++k) { const int tt = t0 - (W - 1) + k;
        if (SAMPLE) { const int b = (row0 - MP) >> 2; v[k] = tt >= 0 ? *(const f32x4*)(HF + (size_t)(row0 + tt) * D + col) : *(const f32x4*)(st_pool + ((size_t)b * 15 + 15 + tt) * D + col); }
        else v[k] = tt >= 0 ? *(const f32x4*)(HF + (size_t)(row0 - (W - 1) + k) * D + col) : (f32x4){0.f, 0.f, 0.f, 0.f}; }
    f32x4 sacc = v[0];
#pragma unroll
    for (int k = 1; k < W; ++k) sacc = sacc + v[k];
#pragma unroll
    for (int r = 0; r < R; ++r) {
        if (r > 0) sacc = sacc + v[r + W - 1] - v[r - 1];
        const int tt = t0 + r; const float inv = 1.0f / (float)(SAMPLE ? W : (tt + 1 < W ? tt + 1 : W));
        const f32x4 cur = v[r + W - 1], pv = sacc * inv - cur;
        u32x2 w2; w2.x = cvtpk(pv[0], pv[1]); w2.y = cvtpk(pv[2], pv[3]); *(u32x2*)(H + (size_t)(row0 + r) * D + col) = w2; }
}
__device__ __forceinline__ void pool_phase(Frame& F) {
    const int gt = (F.vcu * 8 + F.wave) * 64 + F.lane, NT = F.G * 512;
    const float* HF = (const float*)(F.ws + WS_HF); bf16_t* H = (bf16_t*)(F.ws + WS_H);
    constexpr int NPI = (MP / 8) * 256, NSI = (MS / 4) * 256;
#pragma unroll 1
    for (int i = gt; i < NPI + NSI; i += NT) {
        const bool smp = i >= NPI; const int q = smp ? i - NPI : i; const int cg = q & 255, col = cg * 4, grp = cg >> 6;
        if (!smp) { const int row0 = (q >> 8) * 8;
            if (grp == 0) pool_chunk<2, 8, false>(HF, F.st_pool, H, row0, col); else if (grp == 1) pool_chunk<4, 8, false>(HF, F.st_pool, H, row0, col);
            else if (grp == 2) pool_chunk<8, 8, false>(HF, F.st_pool, H, row0, col); else pool_chunk<16, 8, false>(HF, F.st_pool, H, row0, col); }
        else { const int row0 = MP + (q >> 8) * 4;
            if (grp == 0) pool_chunk<2, 4, true>(HF, F.st_pool, H, row0, col); else if (grp == 1) pool_chunk<4, 4, true>(HF, F.st_pool, H, row0, col);
            else if (grp == 2) pool_chunk<8, 4, true>(HF, F.st_pool, H, row0, col); else pool_chunk<16, 4, true>(HF, F.st_pool, H, row0, col); }
    }
}

namespace att {
__device__ __forceinline__ int crow(int r, int hi) { return (r & 3) + 8 * (r >> 2) + 4 * hi; }
__device__ __forceinline__ float x32_sum(float v) { auto rr = __builtin_amdgcn_permlane32_swap(__float_as_uint(v), __float_as_uint(v), false, false); return __uint_as_float(rr[0]) + __uint_as_float(rr[1]); }
__device__ __forceinline__ float x32_max(float v) { auto rr = __builtin_amdgcn_permlane32_swap(__float_as_uint(v), __float_as_uint(v), false, false); return fmaxf(__uint_as_float(rr[0]), __uint_as_float(rr[1])); }
__device__ __forceinline__ unsigned x32_or(unsigned v) { auto rr = __builtin_amdgcn_permlane32_swap(v, v, false, false); return rr[0] | rr[1]; }
template <int X> __device__ __forceinline__ unsigned swz_xor(unsigned v) { return (unsigned)__builtin_amdgcn_ds_swizzle((int)v, (X << 10) | 0x1F); }
template <int X> __device__ __forceinline__ float swz_xorf(float v) { return __uint_as_float(swz_xor<X>(__float_as_uint(v))); }
__device__ __forceinline__ s16x4 vtr(const LAS unsigned char* p) { typedef short v4i16_t __attribute__((ext_vector_type(4))); return __builtin_bit_cast(s16x4, __builtin_amdgcn_ds_read_tr16_b64_v4i16((LAS v4i16_t*)p)); }
__device__ __forceinline__ void qk_tile(f32x16& p0, f32x16& p1, const LAS unsigned char* Kb, const bf16x8 (&qr)[4], float init, int r32, int hi) {
    f32x16 ci;
#pragma unroll
    for (int r = 0; r < 16; ++r) ci[r] = init;
    const int sw = (r32 >> 1) & 7;
    bf16x8 ka[4], kb[4];
#pragma unroll
    for (int ds = 0; ds < 4; ++ds) { const int ch = ((2 * ds + hi) ^ sw) << 4; ka[ds] = *(const LAS bf16x8*)(Kb + r32 * 128 + ch); kb[ds] = *(const LAS bf16x8*)(Kb + (32 + r32) * 128 + ch); }
    __builtin_amdgcn_s_setprio(1);
    f32x16 c0 = __builtin_amdgcn_mfma_f32_32x32x16_bf16(ka[0], qr[0], ci, 0, 0, 0);
    f32x16 c1 = __builtin_amdgcn_mfma_f32_32x32x16_bf16(kb[0], qr[0], ci, 0, 0, 0);
#pragma unroll
    for (int ds = 1; ds < 4; ++ds) {
        c0 = __builtin_amdgcn_mfma_f32_32x32x16_bf16(ka[ds], qr[ds], c0, 0, 0, 0);
        c1 = __builtin_amdgcn_mfma_f32_32x32x16_bf16(kb[ds], qr[ds], c1, 0, 0, 0);
    }
    __builtin_amdgcn_s_setprio(0);
    p0 = c0; p1 = c1;
}
__device__ __forceinline__ void pv_tile(f32x16 (&o)[2], const LAS unsigned char* Vb, const f32x16& p0, const f32x16& p1, int lane) {
    const int g4 = lane >> 4, nhalf = g4 & 1, h = g4 >> 1, i = lane & 15, q = i >> 2, pp = i & 3;
    const LAS unsigned char* vb = Vb + (4 * h + q) * 64 + nhalf * 32 + pp * 8;
#pragma unroll
    for (int kh = 0; kh < 2; ++kh) {
        s16x4 lo[2][2], hh[2][2];
#pragma unroll
        for (int s = 0; s < 2; ++s)
#pragma unroll
            for (int db = 0; db < 2; ++db) { lo[s][db] = vtr(vb + db * 4096 + (32 * kh + 16 * s) * 64); hh[s][db] = vtr(vb + db * 4096 + (32 * kh + 16 * s + 8) * 64); }
#pragma unroll
        for (int s = 0; s < 2; ++s) {
            const f32x16& p = kh ? p1 : p0; u32x4 pw;
            pw.x = cvtpk(p[8 * s + 0], p[8 * s + 1]); pw.y = cvtpk(p[8 * s + 2], p[8 * s + 3]); pw.z = cvtpk(p[8 * s + 4], p[8 * s + 5]); pw.w = cvtpk(p[8 * s + 6], p[8 * s + 7]);
            const bf16x8 pa = __builtin_bit_cast(bf16x8, pw);
#pragma unroll
            for (int db = 0; db < 2; ++db) {
                const bf16x8 vf = (bf16x8){lo[s][db][0], lo[s][db][1], lo[s][db][2], lo[s][db][3], hh[s][db][0], hh[s][db][1], hh[s][db][2], hh[s][db][3]};
                o[db] = __builtin_amdgcn_mfma_f32_32x32x16_bf16(pa, vf, o[db], 0, 0, 0);
            }
        }
    }
}
__device__ __forceinline__ void row_scale(f32x16 (&o)[2], float f, LAS float* wsf, int r32, int hi) {
    if (hi == 0) wsf[r32] = f;
    LDS_WAIT();
    const LAS float* wh = wsf + 4 * hi;
#pragma unroll
    for (int r = 0; r < 16; ++r) { const float fr = wh[CROW0(r)]; o[0][r] *= fr; o[1][r] *= fr; }
    LDS_WAIT();
}
__device__ __forceinline__ void row_fma(f32x16 (&dst)[2], const f32x16 (&o)[2], float f, LAS float* wsf, int r32, int hi) {
    if (hi == 0) wsf[r32] = f;
    LDS_WAIT();
    const LAS float* wh = wsf + 4 * hi;
#pragma unroll
    for (int r = 0; r < 16; ++r) { const float fr = wh[CROW0(r)]; dst[0][r] += fr * o[0][r]; dst[1][r] += fr * o[1][r]; }
    LDS_WAIT();
}
__device__ __forceinline__ void softmax_update(f32x16& p0, f32x16& p1, float& m, float& l, f32x16 (&o)[2], LAS float* wsf, int r32, int hi) {
    float rm = fmaxf(p0[0], p1[0]);
#pragma unroll
    for (int r = 1; r < 16; ++r) rm = fmaxf(rm, fmaxf(p0[r], p1[r]));
    rm = x32_max(rm);
    const float mn = fmaxf(m, rm), f = ex2(m - mn);
    m = mn; float s = 0.f;
#pragma unroll
    for (int r = 0; r < 16; ++r) { p0[r] = ex2(p0[r] - mn); p1[r] = ex2(p1[r] - mn); s += p0[r] + p1[r]; }
    l = l * f + s;
    if (__any(f != 1.0f)) row_scale(o, f, wsf, r32, hi);
}
__device__ __forceinline__ void softmax_full(f32x16& a0, f32x16& a1, f32x16& b0, f32x16& b1) {
    float rm = -1e30f;
#pragma unroll
    for (int r = 0; r < 16; ++r) rm = fmaxf(rm, fmaxf(fmaxf(a0[r], a1[r]), fmaxf(b0[r], b1[r])));
    rm = x32_max(rm); float s = 0.f;
#pragma unroll
    for (int r = 0; r < 16; ++r) { a0[r] = ex2(a0[r] - rm); a1[r] = ex2(a1[r] - rm); b0[r] = ex2(b0[r] - rm); b1[r] = ex2(b1[r] - rm); s += (a0[r] + a1[r]) + (b0[r] + b1[r]); }
    s = x32_sum(s);
    const float inv = s > 0.f ? 1.0f / s : 0.f;
#pragma unroll
    for (int r = 0; r < 16; ++r) { a0[r] *= inv; a1[r] *= inv; b0[r] *= inv; b1[r] *= inv; }
}
__device__ __forceinline__ unsigned imp_key(float v, int j, int c) {
    const bool forced = (j == 0) | (j == c) | (j == c - 1);
    const unsigned base = forced ? 0x7F000000u : (j <= c ? (__float_as_uint(v) & 0xFFFFFFC0u) : 0u);
    return base | (unsigned)(63 - j);
}
__device__ __forceinline__ void imp_store(const f32x16& p0, const f32x16& p1, int T, LAS unsigned* impq  , int c, int g, int hi) {
#pragma unroll
    for (int kh = 0; kh < 2; ++kh)
#pragma unroll
        for (int a = 0; a < 4; ++a) {
            const f32x16& p = kh ? p1 : p0; float e0 = p[4 * a] + p[4 * a + 1], e1 = p[4 * a + 2] + p[4 * a + 3];
            e0 += swz_xorf<8>(e0); e0 += swz_xorf<16>(e0); e1 += swz_xorf<8>(e1); e1 += swz_xorf<16>(e1);
            const int jc = 32 * T + 16 * kh + 4 * a, j0 = jc + 2 * hi;
            if (g == 0) { u32x2 w; w.x = imp_key(e0, j0, c); w.y = imp_key(e1, j0 + 1, c); *(LAS u32x2*)(impq + 2 * hi + jc) = w; }
        }
}
__device__ __forceinline__ unsigned long long select_mask(const LAS unsigned* impq, int g, int hi) {
    LDS_WAIT();
    unsigned mk[8], cnt[8];
#pragma unroll
    for (int a = 0; a < 4; ++a) { const u32x2 w = *(const LAS u32x2*)(impq + (16 * g + 2 * hi) + 4 * a); mk[2 * a] = w.x; mk[2 * a + 1] = w.y; cnt[2 * a] = 0; cnt[2 * a + 1] = 0; }
#pragma unroll 4
    for (int jj = 0; jj < 16; ++jj) { const u32x4 kx = *(const LAS u32x4*)(impq + 4 * jj);
#pragma unroll
        for (int ci = 0; ci < 8; ++ci) cnt[ci] += (unsigned)(kx.x > mk[ci]) + (unsigned)(kx.y > mk[ci]) + (unsigned)(kx.z > mk[ci]) + (unsigned)(kx.w > mk[ci]); }
    unsigned lb = 0u;
#pragma unroll
    for (int a = 0; a < 4; ++a)
#pragma unroll
        for (int e = 0; e < 2; ++e) lb |= (cnt[2 * a + e] < 16u ? 1u : 0u) << (4 * a + e);
    const unsigned long long mm = (unsigned long long)lb << (16 * g + 2 * hi);
    unsigned lo = (unsigned)mm, hh = (unsigned)(mm >> 32);
    lo |= swz_xor<8>(lo); hh |= swz_xor<8>(hh); lo |= swz_xor<16>(lo); hh |= swz_xor<16>(hh); lo = x32_or(lo); hh = x32_or(hh);
    return ((unsigned long long)hh << 32) | lo;
}
__device__ __forceinline__ unsigned long long wave_or64(unsigned long long m) {
    unsigned lo = (unsigned)m, hh = (unsigned)(m >> 32);
    lo |= swz_xor<1>(lo); hh |= swz_xor<1>(hh); lo |= swz_xor<2>(lo); hh |= swz_xor<2>(hh); lo |= swz_xor<4>(lo); hh |= swz_xor<4>(hh);
    lo |= swz_xor<8>(lo); hh |= swz_xor<8>(hh); lo |= swz_xor<16>(lo); hh |= swz_xor<16>(hh); lo = x32_or(lo); hh = x32_or(hh);
    return ((unsigned long long)(unsigned)__builtin_amdgcn_readfirstlane(hh) << 32) | (unsigned)__builtin_amdgcn_readfirstlane(lo);
}
__device__ __forceinline__ void mask_bias(f32x16& p0, f32x16& p1, int t, int pos0, int stride, int wlim, bool sel, bool near, const LAS float* lut, int hi) {
#pragma unroll
    for (int kh = 0; kh < 2; ++kh)
#pragma unroll
        for (int r = 0; r < 16; ++r) { const int kk = 32 * kh + crow(r, hi), dist = t - pos0 - stride * kk; const bool ok = sel && dist >= 0 && dist < wlim;
            float bv = 0.f; if (near) { const int di = dist < 0 ? 0 : (dist > 127 ? 127 : dist); bv = lut[di]; }
            if (kh) p1[r] = ok ? p1[r] + bv : -INFINITY; else p0[r] = ok ? p0[r] + bv : -INFINITY; }
}
template <bool CAUSAL>
__device__ __forceinline__ void mask_bias_near(f32x16& p0, f32x16& p1, int t, int pos0, bool sel, const LAS float* xlg, int hi) {
    const int dist0 = t - pos0 - 4 * hi;
    const LAS float* bp = xlg + (dist0 + 4);
#pragma unroll
    for (int kh = 0; kh < 2; ++kh)
#pragma unroll
        for (int r = 0; r < 16; ++r) { const int kc = 32 * kh + CROW0(r); const float bv = bp[63 - kc]; bool ok = sel; if (CAUSAL) ok = ok && (dist0 - kc >= 0);
            if (kh) p1[r] = ok ? p1[r] + bv : -INFINITY; else p0[r] = ok ? p0[r] + bv : -INFINITY; }
}
struct Ptrs { const bf16_t *Q, *kcp, *vcp, *kcs, *vcs, *KS, *VS, *KW, *VW; const float* gates; bf16_t* O; const float *ck_sel, *cv_sel, *st_kw, *st_vw; const int* pt; int gov; float* kw_out; float* vw_out; };
#ifdef VERIFY
#define GATEV(P, row, head, br) ((P).gov < 0 ? sigmoidf_((P).gates[(size_t)(row) * 48 + (head) * 3 + (br)]) : ((P).gov == (br) ? 1.0f : 0.0f))
#else
#define GATEV(P, row, head, br) sigmoidf_((P).gates[(size_t)(row) * 48 + (head) * 3 + (br)])
#endif

template <bool ACC>
__device__ __forceinline__ void row_out(LAS float* ow, const f32x16 (&o)[2], float f, LAS float* wsf, int r32, int hi) {
    if (hi == 0) wsf[r32] = f;
    LDS_WAIT();
    const LAS float* wh = wsf + 4 * hi; LAS float* ob = ow + hi * 256 + r32;
#pragma unroll
    for (int r = 0; r < 16; ++r) { const float fr = wh[CROW0(r)]; LAS float* p = ob + CROW0(r) * 64;
        if (ACC) { p[0] += fr * o[0][r]; p[32] += fr * o[1][r]; } else { p[0] = fr * o[0][r]; p[32] = fr * o[1][r]; } }
    LDS_WAIT();
}
template <bool NEXT>
__device__ __forceinline__ void tile_block(f32x16& s0, f32x16& s1, f32x16& n0, f32x16& n1, const LAS unsigned char* KBn, float ninit, const LAS unsigned char* VB, const bf16x8 (&qr)[4],
                                           float m, float& l, f32x16 (&o)[2], int lane, int r32, int hi) {
    if (NEXT) qk_tile(n0, n1, KBn, qr, ninit, r32, hi);
    float sacc = 0.f;
#pragma unroll
    for (int r = 0; r < 16; ++r) { s0[r] = ex2(s0[r] - m); s1[r] = ex2(s1[r] - m); sacc += s0[r] + s1[r]; }
    l += sacc;
    pv_tile(o, VB, s0, s1, lane);
}
__device__ __forceinline__ void prompt_unit(const Ptrs& P, LAS unsigned char* L, int b, int kv, int c, int tid, int wave, int lane) {
    asm volatile("" : "+v"(lane), "+v"(tid));
    const int r32 = lane & 31, hi = lane >> 5, g = r32 >> 3, qi = r32 & 7, head = kv * 4 + g;
    const int t = c * 64 + wave * 8 + qi; const unsigned row = (unsigned)b * SEQ + t;
    bf16x8 qr[4];
#pragma unroll
    for (int ds = 0; ds < 4; ++ds) qr[ds] = *(const bf16x8*)(P.Q + (size_t)row * D + head * 64 + ds * 16 + hi * 8);
    const LAS float* lut = (const LAS float*)(L + LUT_OFF) + head * 128; const float bfar = lut[127];
    LAS float* wsf = (LAS float*)(L + WSF_OFF) + wave * 32;
    LAS float* ow = (LAS float*)(L + 65536 + wave * 8192);
    LAS unsigned* impq = (LAS unsigned*)(L + IMP_OFF) + wave * 512 + qi * 64;
    const int skey = tid >> 3, sch = tid & 7;
    const int kwoff = skey * 128 + ((sch ^ ((skey >> 1) & 7)) << 4), vwoff = (sch >> 2) * 4096 + skey * 64 + (sch & 3) * 16;
    LAS unsigned char* KB0 = L; LAS unsigned char* VB0 = L + 32768;
    { const unsigned co = ((unsigned)(b * 4 + kv) * 128 + skey) * 64 + sch * 8;
      const u32x4 k0 = *(const u32x4*)(P.kcp + co), k1 = *(const u32x4*)(P.kcp + co + 4096), v0 = *(const u32x4*)(P.vcp + co), v1 = *(const u32x4*)(P.vcp + co + 4096);
      *(LAS u32x4*)(KB0 + kwoff) = k0; *(LAS u32x4*)(KB0 + 8192 + kwoff) = k1; *(LAS u32x4*)(VB0 + vwoff) = v0; *(LAS u32x4*)(VB0 + 8192 + vwoff) = v1; }
    const unsigned kvrow0 = ((unsigned)b * SEQ + skey) * 256 + kv * 64 + sch * 8;
    const int nwin = (c < 8 ? c : 8) + 1, nsel = c + 1, NTm = nsel + nwin;
#define TILE_J(i) ((i) >= nsel ? c - nwin + 1 + ((i) - nsel) : (i))
    const int dkey = 8 * wave + (lane >> 3), vkey = 16 * (wave & 3) + (lane >> 2);
    const unsigned kdoff = ((unsigned)b * SEQ + dkey) * 256 + kv * 64 + (((lane & 7) ^ ((dkey >> 1) & 7)) << 3);
    const unsigned vdoff = ((unsigned)b * SEQ + vkey) * 256 + kv * 64 + (wave >> 2) * 32 + (lane & 3) * 8;
#define TILE_DMA(i) do { const int i_ = (i); const bool w_ = i_ >= nsel; const unsigned jo_ = (unsigned)TILE_J(i_) * (64 * 256); const bf16_t* kb_ = w_ ? P.KW : P.KS; const bf16_t* vb_ = w_ ? P.VW : P.VS; \
        __builtin_amdgcn_global_load_lds((const unsigned*)(kb_ + kdoff + jo_), (LAS unsigned*)(KB0 + (i_ & 3) * 8192 + wave * 1024), 16, 0, 0); \
        __builtin_amdgcn_global_load_lds((const unsigned*)(vb_ + vdoff + jo_), (LAS unsigned*)(VB0 + (i_ & 3) * 8192 + wave * 1024), 16, 0, 0); } while (0)
#define TILE_SKIP(i) ((i) < nsel && !((wmask >> (i)) & 1ull))
#define WG_BAR_V(n) do { asm volatile("s_waitcnt vmcnt(" #n ") lgkmcnt(0)" ::: "memory"); __builtin_amdgcn_s_barrier(); asm volatile("" ::: "memory"); } while (0)
    __syncthreads();
    f32x16 o[2];
#pragma unroll
    for (int r = 0; r < 16; ++r) { o[0][r] = 0.f; o[1][r] = 0.f; }
    unsigned long long mymask = ~0ull, wmask = ~0ull;
    {
        float cm = -1e30f, cl = 0.f;
#pragma unroll 1
        for (int T = 0; T < 2; ++T) { f32x16 a0, a1; qk_tile(a0, a1, KB0 + T * 8192, qr, 0.f, r32, hi); mask_bias(a0, a1, t, 31 + 2048 * T, 32, 1 << 30, true, true, lut, hi);
            float rm = fmaxf(a0[0], a1[0]);
#pragma unroll
            for (int r = 1; r < 16; ++r) rm = fmaxf(rm, fmaxf(a0[r], a1[r]));
            rm = x32_max(rm); const float mn = fmaxf(cm, rm); float sacc = 0.f;
#pragma unroll
            for (int r = 0; r < 16; ++r) sacc += ex2(a0[r] - mn) + ex2(a1[r] - mn);
            cl = cl * ex2(cm - mn) + sacc; cm = mn; }
        cl = x32_sum(cl); const float cinv = cl > 0.f ? 1.0f / cl : 0.f;
#pragma unroll 1
        for (int T = 0; T < 2; ++T) { f32x16 a0, a1; qk_tile(a0, a1, KB0 + T * 8192, qr, 0.f, r32, hi); mask_bias(a0, a1, t, 31 + 2048 * T, 32, 1 << 30, true, true, lut, hi);
#pragma unroll
            for (int r = 0; r < 16; ++r) { a0[r] = ex2(a0[r] - cm) * cinv; a1[r] = ex2(a1[r] - cm) * cinv; }
            if (c >= 16) imp_store(a0, a1, T, impq, c, g, hi);
            pv_tile(o, VB0 + T * 8192, a0, a1, lane); }
    }
    { const float g0 = GATEV(P, row, head, 0); row_out<false>(ow, o, g0, wsf, r32, hi); }
    if (c >= 16) { mymask = select_mask(impq, g, hi); wmask = wave_or64(mymask); }
    __syncthreads();
    TILE_DMA(0); if (1 < NTm) TILE_DMA(1); if (2 < NTm) TILE_DMA(2);
    { LAS float* xl = (LAS float*)(L + IMP_OFF);
      for (int u = tid; u < 4 * 272; u += 512) { const int gg = u / 272, ii = u % 272, dd = ii - 67; xl[u] = ((const LAS float*)(L + LUT_OFF))[(kv * 4 + gg) * 128 + (dd < 0 ? 0 : (dd > 127 ? 127 : dd))]; } }
    const LAS float* xlg = (const LAS float*)(L + IMP_OFF) + g * 272;
    float m = 0.f, l = 0.f;
#pragma unroll
    for (int r = 0; r < 16; ++r) { o[0][r] = 0.f; o[1][r] = 0.f; }
#pragma unroll 1
    for (int i = 0; i < NTm; ++i) {
        if (i + 2 < NTm) WG_BAR_V(4); else if (i + 1 < NTm) WG_BAR_V(2); else WG_BAR_V(0);
        if (i + 3 < NTm) TILE_DMA(i + 3);
        const bool isw = i >= nsel; const int j = TILE_J(i); const bool near = j >= c - 2;
        if (!TILE_SKIP(i)) {
            f32x16 s0, s1;
            const bool sel = isw || ((mymask >> j) & 1ull);
            const float init = (!near && !sel) ? -INFINITY : (near ? 0.f : bfar) - m;
            qk_tile(s0, s1, KB0 + (i & 3) * 8192, qr, init, r32, hi);
            if (near) { if (j == c) mask_bias_near<true>(s0, s1, t, 64 * j, sel, xlg, hi); else mask_bias_near<false>(s0, s1, t, 64 * j, sel, xlg, hi); }
            else if (isw && j == c - 8) mask_bias(s0, s1, t, 64 * j, 1, 512, true, false, lut, hi);
            float rm = fmaxf(s0[0], s1[0]);
#pragma unroll
            for (int r = 1; r < 16; ++r) rm = fmaxf(rm, fmaxf(s0[r], s1[r]));
            rm = x32_max(rm);
            if (__any(rm > 8.0f)) { const float dlt = fmaxf(rm, 0.f), f = ex2(-dlt); m += dlt; l *= f; row_scale(o, f, wsf, r32, hi);
#pragma unroll
                for (int r = 0; r < 16; ++r) { s0[r] -= dlt; s1[r] -= dlt; } }
            f32x16 n0, n1; tile_block<false>(s0, s1, n0, n1, KB0, 0.f, VB0 + (i & 3) * 8192, qr, 0.f, l, o, lane, r32, hi);
        }
        if (i == nsel - 1 || i == NTm - 1) {
            const float gt = GATEV(P, row, head, (isw ? 2 : 1));
            const float lt = x32_sum(l); const float f = lt > 0.f ? gt / lt : 0.f;
            row_out<true>(ow, o, f, wsf, r32, hi);
            m = 0.f; l = 0.f;
#pragma unroll
            for (int r = 0; r < 16; ++r) { o[0][r] = 0.f; o[1][r] = 0.f; }
        }
    }
#undef TILE_J
#undef TILE_DMA
#undef TILE_SKIP
#undef WG_BAR_V
    { const int rr = lane >> 1, hf = lane & 1, gg = rr >> 3, qq = rr & 7; const LAS float* src = ow + rr * 64 + hf * 32;
      bf16_t* op = P.O + ((size_t)b * SEQ + c * 64 + wave * 8 + qq) * D + (kv * 4 + gg) * 64 + hf * 32;
#pragma unroll
      for (int q4 = 0; q4 < 4; ++q4) { const f32x4 x0 = *(const LAS f32x4*)(src + q4 * 8), x1 = *(const LAS f32x4*)(src + q4 * 8 + 4); u32x4 w;
          w.x = cvtpk(x0[0], x0[1]); w.y = cvtpk(x0[2], x0[3]); w.z = cvtpk(x1[0], x1[1]); w.w = cvtpk(x1[2], x1[3]); *(u32x4*)(op + q4 * 8) = w; } }
    __syncthreads();
}

template <bool COPY>
__device__ __forceinline__ void stage_f32_pair(const float* ksrc_, const float* vsrc_, LAS unsigned char* Kb, LAS unsigned char* Vb, int lane, float* kdst_ = nullptr, float* vdst_ = nullptr, int first_row = 0) {
    const int c4 = lane & 15; const char* ks = uniform_ptr(ksrc_); const char* vs = uniform_ptr(vsrc_); const unsigned lo = (unsigned)((lane >> 4) * 1024 + c4 * 16);
#pragma unroll 1
    for (int hf = 0; hf < 2; ++hf) {
        f32x4 x[8], y[8];
#pragma unroll
        for (int it = 0; it < 8; ++it) x[it] = *(const f32x4*)(ks + (lo + (unsigned)(hf * 8 + it) * 4096u));
#pragma unroll
        for (int it = 0; it < 8; ++it) y[it] = *(const f32x4*)(vs + (lo + (unsigned)(hf * 8 + it) * 4096u));
        if constexpr (COPY) {
            char* kd = (char*)uniform_ptr(kdst_); char* vd = (char*)uniform_ptr(vdst_);
#pragma unroll
            for (int it = 0; it < 8; ++it) { const int key = (hf * 8 + it) * 4 + (lane >> 4);
                if (key >= first_row) { __builtin_nontemporal_store(x[it], (f32x4*)(kd + (lo + (unsigned)(hf * 8 + it) * 4096u))); __builtin_nontemporal_store(y[it], (f32x4*)(vd + (lo + (unsigned)(hf * 8 + it) * 4096u))); } }
        }
#pragma unroll
        for (int it = 0; it < 8; ++it) { const int key = (hf * 8 + it) * 4 + (lane >> 4);
            u32x2 w; w.x = cvtpk(x[it][0], x[it][1]); w.y = cvtpk(x[it][2], x[it][3]);
            *(LAS u32x2*)(Kb + key * 128 + (((c4 >> 1) ^ ((key >> 1) & 7)) << 4) + (c4 & 1) * 8) = w; }
#pragma unroll
        for (int it = 0; it < 8; ++it) { const int key = (hf * 8 + it) * 4 + (lane >> 4);
            u32x2 w; w.x = cvtpk(y[it][0], y[it][1]); w.y = cvtpk(y[it][2], y[it][3]);
            *(LAS u32x2*)(Vb + (c4 >> 3) * 4096 + key * 64 + (c4 & 7) * 8) = w; }
        __builtin_amdgcn_sched_barrier(0);
    }
}
__device__ __forceinline__ void stage_bf16_tile(const bf16_t* src_  , LAS unsigned char* Kb, bool isV, int lane) {
    const char* src = uniform_ptr(src_);
#pragma unroll
    for (int it = 0; it < 8; ++it) { const int idx = it * 64 + lane, key = idx >> 3, ch = idx & 7; const u32x4 x = *(const u32x4*)(src + (unsigned)idx * 16u);
        const int off = isV ? ((ch >> 2) * 4096 + key * 64 + (ch & 3) * 16) : (key * 128 + ((ch ^ ((key >> 1) & 7)) << 4));
        *(LAS u32x4*)(Kb + off) = x; }
}
__device__ __forceinline__ void stage_new_tile(const bf16_t* src_  , LAS unsigned char* Kb, bool isV, int lane) {
    const char* src = uniform_ptr(src_);
#pragma unroll
    for (int it = 0; it < 8; ++it) *(LAS u32x4*)(Kb + (it * 64 + lane) * 16) = (u32x4){0u, 0u, 0u, 0u};
    if (lane < 32) { const int key = lane >> 3, ch = lane & 7; const u32x4 x = *(const u32x4*)(src + (unsigned)(key * 512 + ch * 16));
        const int off = isV ? ((ch >> 2) * 4096 + key * 64 + (ch & 3) * 16) : (key * 128 + ((ch ^ ((key >> 1) & 7)) << 4));
        *(LAS u32x4*)(Kb + off) = x; }
}
__device__ __forceinline__ void sample_unit(const Ptrs& P, LAS unsigned char* L, int b, int kv, int tid, int wave, int lane) {
    asm volatile("" : "+v"(lane), "+v"(tid));
    const int r32 = lane & 31, hi = lane >> 5, g = r32 >> 3, qi = r32 & 7, qs = qi & 3, head = kv * 4 + g;
    const int t = PAST + qs; const unsigned row = (unsigned)MP + b * 4 + qs;
    bf16x8 qr[4];
#pragma unroll
    for (int ds = 0; ds < 4; ++ds) qr[ds] = *(const bf16x8*)(P.Q + (size_t)row * D + head * 64 + ds * 16 + hi * 8);
    const LAS float* lut = (const LAS float*)(L + LUT_OFF) + head * 128; const float bfar = lut[127];
    LAS float* wsf = (LAS float*)(L + WSF_OFF) + wave * 32;
    LAS unsigned* impq = (LAS unsigned*)(L + IMP_OFF) + wave * 512 + qi * 64;
    LAS unsigned char* Kb = L + wave * 16384; LAS unsigned char* Vb = Kb + 8192;
    f32x16 out[2], o[2];
#pragma unroll
    for (int r = 0; r < 16; ++r) { out[0][r] = 0.f; out[1][r] = 0.f; o[0][r] = 0.f; o[1][r] = 0.f; }
    stage_bf16_tile(P.kcs + (size_t)(b * 4 + kv) * 4096, Kb, false, lane); stage_bf16_tile(P.vcs + (size_t)(b * 4 + kv) * 4096, Vb, true, lane);
    LDS_WAIT();
    {
        f32x16 a0, a1;
        qk_tile(a0, a1, Kb, qr, 0.f, r32, hi);
        mask_bias(a0, a1, t, 31, 32, 1 << 30, true, true, lut, hi);
        { float rm = fmaxf(a0[0], a1[0]);
#pragma unroll
          for (int r = 1; r < 16; ++r) rm = fmaxf(rm, fmaxf(a0[r], a1[r]));
          rm = x32_max(rm); float sacc = 0.f;
#pragma unroll
          for (int r = 0; r < 16; ++r) { a0[r] = ex2(a0[r] - rm); a1[r] = ex2(a1[r] - rm); sacc += a0[r] + a1[r]; }
          sacc = x32_sum(sacc); const float cinv = 1.0f / sacc;
#pragma unroll
          for (int r = 0; r < 16; ++r) { a0[r] *= cinv; a1[r] *= cinv; } }
        imp_store(a0, a1, 0, impq, 32, g, hi);
        if (g == 0) {
#pragma unroll
            for (int q8 = 0; q8 < 8; ++q8) { const int jc = 32 + 4 * q8; u32x2 w; w.x = imp_key(0.f, jc + 2 * hi, 32); w.y = imp_key(0.f, jc + 2 * hi + 1, 32); *(LAS u32x2*)(impq + 2 * hi + jc) = w; } }
        if (wave == 0) { pv_tile(o, Vb, a0, a1, lane); const float g0 = GATEV(P, row, head, 0); row_fma(out, o, g0, wsf, r32, hi);
#pragma unroll
            for (int r = 0; r < 16; ++r) { o[0][r] = 0.f; o[1][r] = 0.f; } }
    }
    const unsigned long long mymask = select_mask(impq, g, hi);
    const unsigned long long umask = wave_or64(mymask) & 0x1FFFFFFFFull;
    const bool winw = wave >= 6;
    const int nsel = __builtin_popcountll(umask);
    const int nmine = winw ? 9 : nsel, first = winw ? wave - 6 : wave, step = winw ? 2 : 6;
    float m = -1e30f, l = 0.f;
#pragma unroll 1
    for (int idx = first; idx < nmine; idx += step) {
        LDS_WAIT();
        int pos0; bool near, sel = true;
        int ln = lane; asm volatile("" : "+v"(ln));
        if (!winw) {
            unsigned long long mm = umask; for (int n = 0; n < idx; ++n) mm &= mm - 1ull;
            const int j = __builtin_ctzll(mm);
            if (j < 32) { const int page = P.pt[b * 16 + (j >> 1)]; const size_t off = (((size_t)page * 128 + (j & 1) * 64) * 4 + kv) * 64;
                stage_f32_pair<false>(P.ck_sel + off, P.cv_sel + off, Kb, Vb, ln); }
            else { stage_new_tile(P.KS + ((size_t)MP + b * 4) * 256 + kv * 64, Kb, false, ln); stage_new_tile(P.VS + ((size_t)MP + b * 4) * 256 + kv * 64, Vb, true, ln); }
            pos0 = 64 * j; near = j >= 30; sel = (mymask >> j) & 1ull;
        } else {
            if (idx < 8) { const size_t off = (((size_t)b * 512 + 64 * idx) * 4 + kv) * 64;
                stage_f32_pair<true>(P.st_kw + off, P.st_vw + off, Kb, Vb, ln, P.kw_out + off - 1024, P.vw_out + off - 1024, idx == 0 ? 4 : 0); }
            else { stage_new_tile(P.KW + ((size_t)MP + b * 4) * 256 + kv * 64, Kb, false, ln); stage_new_tile(P.VW + ((size_t)MP + b * 4) * 256 + kv * 64, Vb, true, ln); }
            pos0 = PAST - 512 + 64 * idx; near = idx >= 6;
        }
        LDS_WAIT();
        f32x16 p0, p1;
        qk_tile(p0, p1, Kb, qr, near ? 0.f : bfar, r32, hi);
        mask_bias(p0, p1, t, pos0, 1, winw ? 512 : (1 << 30), sel, near, lut, hi);
        softmax_update(p0, p1, m, l, o, wsf, r32, hi);
        pv_tile(o, Vb, p0, p1, lane);
    }
    LDS_WAIT();
    { const float lt = x32_sum(l);
      LAS f32x2* ml = (LAS f32x2*)(L + IMP_OFF);
      if (hi == 0) ml[wave * 256 + r32] = (f32x2){m, lt};
      __syncthreads();
      const int w0 = winw ? 6 : 0, w1 = winw ? 8 : 6;
      float M = -1e30f;
      for (int w = w0; w < w1; ++w) M = fmaxf(M, ml[w * 256 + r32][0]);
      float Ls = 0.f;
      for (int w = w0; w < w1; ++w) { const f32x2 x = ml[w * 256 + r32]; Ls += x[1] * ex2(x[0] - M); }
      const float gt = GATEV(P, row, head, (winw ? 2 : 1));
      const float f = Ls > 0.f ? gt * ex2(m - M) / Ls : 0.f;
      row_fma(out, o, f, wsf, r32, hi); }
    LAS float* ob = (LAS float*)Kb + hi * 256 + r32;
#pragma unroll
    for (int r = 0; r < 16; ++r) { ob[CROW0(r) * 64] = out[0][r]; ob[CROW0(r) * 64 + 32] = out[1][r]; }
    __syncthreads();
    { const int vr = tid >> 5, d2 = (tid & 31) * 2, gg = vr >> 2, qq = vr & 3; float s0 = 0.f, s1 = 0.f;
#pragma unroll
      for (int w = 0; w < 8; ++w) { const f32x2 x = *(const LAS f32x2*)((const LAS float*)(L + w * 16384) + (gg * 8 + qq) * 64 + d2); s0 += x[0]; s1 += x[1]; }
      *(unsigned*)(P.O + ((size_t)MP + b * 4 + qq) * D + (kv * 4 + gg) * 64 + d2) = cvtpk(s0, s1); }
    __syncthreads();
}

#ifdef VERIFY
__device__ __forceinline__ float wsum(float v) { for (int o = 1; o < 64; o <<= 1) v += __shfl_xor(v, o); return v; }
__device__ __forceinline__ float wmax(float v) { for (int o = 1; o < 64; o <<= 1) v = fmaxf(v, __shfl_xor(v, o)); return v; }
__device__ __forceinline__ float rb(float x) { return bf2f((unsigned short)(cvtpk(x, 0.f) & 0xffffu)); }
__device__ __forceinline__ void verify_item(const Ptrs& P, LAS unsigned char* L, bool sample, int b, int tq, int kv, int br, float* errs, int wave, int lane) {
    LAS float* sc = (LAS float*)(L + wave * 16384);
    LAS float* qs = (LAS float*)(L + IMP_OFF) + wave * 512;
    const LAS float* lutb = (const LAS float*)(L + LUT_OFF);
    const size_t row = sample ? (size_t)MP + b * 4 + tq : (size_t)b * SEQ + tq; const int pos = sample ? PAST + tq : tq; const int cq = pos >> 6;
    for (int g = 0; g < 4; ++g) qs[g * 64 + lane] = bf2f(P.Q[row * D + (kv * 4 + g) * 64 + lane]);
    LDS_WAIT();
    const int ncmp = sample ? 64 : 128; const size_t cmpo = (size_t)(b * 4 + kv) * (sample ? 4096 : 8192); const bf16_t* kc = (const bf16_t*)((const char*)P.kcp + (sample ? WS_KCMPS - WS_KCMPP : 0)) + cmpo; const bf16_t* vc = (const bf16_t*)((const char*)P.vcp + (sample ? WS_VCMPS - WS_VCMPP : 0)) + cmpo;
    float oc0 = 0.f, oc1 = 0.f, oc2 = 0.f, oc3 = 0.f;
    for (int g = 0; g < 4; ++g) {
        float sA = -INFINITY, sB = -INFINITY;
        for (int h = 0; h < 2; ++h) { const int n = lane + 64 * h; const int dist = pos - (32 * n + 31); float s = -INFINITY;
            if (n < ncmp && dist >= 0) { float a = 0.f; for (int d = 0; d < 64; ++d) a += qs[g * 64 + d] * bf2f(kc[(size_t)n * 64 + d]); s = a + lutb[(kv * 4 + g) * 128 + (dist > 127 ? 127 : dist)]; }
            if (h == 0) sA = s; else sB = s; }
        const float mx = wmax(fmaxf(sA, sB)); float p0 = 0.f, p1 = 0.f;
        if (mx > -INFINITY) { p0 = ex2(sA - mx); p1 = ex2(sB - mx); }
        const float sm = wsum(p0 + p1); const float inv = sm > 0.f ? 1.0f / sm : 0.f;
        sc[g * 128 + lane] = p0 * inv; sc[g * 128 + 64 + lane] = p1 * inv;
    }
    LDS_WAIT();
    for (int g = 0; g < 4; ++g) { float a = 0.f; for (int n = 0; n < ncmp; ++n) a += sc[g * 128 + n] * bf2f(vc[(size_t)n * 64 + lane]); if (g == 0) oc0 = a; else if (g == 1) oc1 = a; else if (g == 2) oc2 = a; else oc3 = a; }
    float imp = 0.f; for (int g = 0; g < 4; ++g) imp += sc[g * 128 + 2 * lane] + sc[g * 128 + 2 * lane + 1];
    { const bool forced = (lane == 0) || (lane == cq) || (lane == cq - 1), elig = lane <= cq; imp = forced ? 1e9f : (elig ? imp : -1.0f); }
    LDS_WAIT(); qs[256 + lane] = imp; LDS_WAIT();
    int rank = 0; for (int j = 0; j < 64; ++j) { const float v = qs[256 + j]; rank += (v > imp) || (v == imp && j < lane); }
    const int nsb = sample ? 33 : 64;
    const unsigned long long selm = __ballot(rank < 16 && lane < nsb);
    float r0 = oc0, r1 = oc1, r2_ = oc2, r3 = oc3;
    if (br != 0) {
        const int nslot = br == 1 ? __builtin_popcountll(selm) : 9;
        LDS_WAIT();
        for (int si = 0; si < nslot && si < 16; ++si) {
            int j;
            if (br == 1) { unsigned long long mm = selm; for (int n = 0; n < si; ++n) mm &= mm - 1ull; j = __builtin_ctzll(mm); } else j = sample ? si : cq - 8 + si;
            bool ok = false; int pk = 0; const float* kf = nullptr; const bf16_t* kb = nullptr;
            if (br == 1) { pk = 64 * j + lane;
                if (!sample) { ok = pk <= pos; kb = P.KS + ((size_t)b * SEQ + pk) * 256 + kv * 64; }
                else if (j < 32) { ok = true; kf = P.ck_sel + (((size_t)P.pt[b * 16 + (j >> 1)] * 128 + (j & 1) * 64 + lane) * 4 + kv) * 64; }
                else { ok = lane < 4 && pk <= pos; kb = P.KS + ((size_t)MP + b * 4 + (lane & 3)) * 256 + kv * 64; } }
            else { if (!sample) { pk = 64 * j + lane; ok = j >= 0 && pk <= pos && pos - pk < 512; kb = P.KW + ((size_t)b * SEQ + (ok ? pk : 0)) * 256 + kv * 64; }
                else { const int e = 64 * j + lane; pk = PAST - 512 + e; ok = e < 516 && pk <= pos && pos - pk < 512;
                    if (e < 512) kf = P.st_kw + (((size_t)b * 512 + e) * 4 + kv) * 64; else kb = P.KW + ((size_t)MP + b * 4 + ((e - 512) & 3)) * 256 + kv * 64; } }
            const int dist = pos - pk;
            for (int g = 0; g < 4; ++g) { float s = -INFINITY;
                if (ok) { float a = 0.f; for (int d = 0; d < 64; ++d) a += qs[g * 64 + d] * (kf ? rb(kf[d]) : bf2f(kb[d])); s = a + lutb[(kv * 4 + g) * 128 + (dist > 127 ? 127 : dist)]; }
                sc[g * 1024 + si * 64 + lane] = s; }
        }
        LDS_WAIT();
        for (int g = 0; g < 4; ++g) {
            float mx = -INFINITY; for (int si = 0; si < nslot && si < 16; ++si) mx = fmaxf(mx, sc[g * 1024 + si * 64 + lane]);
            mx = wmax(mx); float sm = 0.f;
            for (int si = 0; si < nslot && si < 16; ++si) { const float p = mx > -INFINITY ? ex2(sc[g * 1024 + si * 64 + lane] - mx) : 0.f; sc[g * 1024 + si * 64 + lane] = p; sm += p; }
            sm = wsum(sm); const float inv = sm > 0.f ? 1.0f / sm : 0.f;
            LDS_WAIT();
            float a = 0.f;
            for (int si = 0; si < nslot && si < 16; ++si) {
                int j;
                if (br == 1) { unsigned long long mm = selm; for (int n = 0; n < si; ++n) mm &= mm - 1ull; j = __builtin_ctzll(mm); } else j = sample ? si : cq - 8 + si;
                for (int k = 0; k < 64; ++k) { const float p = sc[g * 1024 + si * 64 + k]; if (p == 0.f) continue; float v;
                    if (br == 1) { if (!sample) v = bf2f(P.VS[((size_t)b * SEQ + 64 * j + k) * 256 + kv * 64 + lane]);
                        else if (j < 32) v = rb(P.cv_sel[(((size_t)P.pt[b * 16 + (j >> 1)] * 128 + (j & 1) * 64 + k) * 4 + kv) * 64 + lane]);
                        else v = bf2f(P.VS[((size_t)MP + b * 4 + (k & 3)) * 256 + kv * 64 + lane]); }
                    else { if (!sample) v = bf2f(P.VW[((size_t)b * SEQ + 64 * j + k) * 256 + kv * 64 + lane]);
                        else { const int e = 64 * j + k; v = e < 512 ? rb(P.st_vw[(((size_t)b * 512 + e) * 4 + kv) * 64 + lane]) : bf2f(P.VW[((size_t)MP + b * 4 + ((e - 512) & 3)) * 256 + kv * 64 + lane]); } }
                    a += p * v; } }
            a *= inv; if (g == 0) r0 = a; else if (g == 1) r1 = a; else if (g == 2) r2_ = a; else r3 = a;
            LDS_WAIT();
        }
    }
    float d2 = 0.f, rr2 = 0.f;
    for (int g = 0; g < 4; ++g) { const float ref = g == 0 ? r0 : g == 1 ? r1 : g == 2 ? r2_ : r3; const float f = bf2f(P.O[row * D + (kv * 4 + g) * 64 + lane]); const float df = f - ref; d2 += df * df; rr2 += ref * ref; }
    d2 = wsum(d2); rr2 = wsum(rr2);
    if (lane == 0) { atomicAdd(errs + ((sample ? 3 : 0) + br) * 2, d2); atomicAdd(errs + ((sample ? 3 : 0) + br) * 2 + 1, rr2); }
}
#endif
}

constexpr int NPHASE = 17;
__global__ void __launch_bounds__(512, 2) nsa_fwd(Args args) {
    extern __shared__ __attribute__((aligned(16))) unsigned char lds[];
    Frame F;
    F.lds = (LAS unsigned char*)lds;
    F.tid = threadIdx.x; F.lane = F.tid & 63; F.wave = __builtin_amdgcn_readfirstlane(F.tid >> 6);
    F.G = gridDim.x; { const int bx = blockIdx.x; F.vcu = (F.G % 8 == 0) ? (bx % 8) * (F.G / 8) + bx / 8 : bx; }
    F.x_p = (const float*)args.in[0]; F.x_s = (const float*)args.in[1]; F.c_p = (const float*)args.in[2]; F.c_s = (const float*)args.in[3];
    F.ck_cmp = (const float*)args.in[4]; F.cv_cmp = (const float*)args.in[5]; F.ck_sel = (const float*)args.in[6]; F.cv_sel = (const float*)args.in[7];
    F.page_table = (const int*)args.in[8]; F.st_kw = (const float*)args.in[9]; F.st_vw = (const float*)args.in[10]; F.st_pool = (const float*)args.in[11];
    F.rel_bias = (const float*)args.in[12]; F.ada_w = (const float*)args.in[13]; F.ada_b = (const float*)args.in[14]; F.norm_g = (const float*)args.in[15]; F.final_g = (const float*)args.in[16];
    F.w_in = (const float*)args.in[17]; F.w_out = (const float*)args.in[18]; F.cmp_wk = (const float*)args.in[19]; F.cmp_wv = (const float*)args.in[20];
    F.pe_k = (const float*)args.in[21]; F.pe_v = (const float*)args.in[22]; F.pool_w = (const float*)args.in[23]; F.pool_scale = (const float*)args.in[24];
    F.ffn_wg = (const float*)args.in[25]; F.ffn_wu = (const float*)args.in[26]; F.ffn_wd = (const float*)args.in[27];
    F.out = args.out; F.ws = args.ws;
    unsigned char* ws = args.ws;
    for (int u = F.tid; u < 64; u += 512) ((LAS unsigned*)(F.lds + MISC_OFF))[u] = 0u;
    for (int u = F.tid; u < 16 * 128; u += 512) { const int h = u >> 7, d = u & 127; ((LAS float*)(F.lds + LUT_OFF))[u] = F.rel_bias[t5_bucket(d) * 16 + h] * LOG2E; }
    __syncthreads();
    volatile LAS unsigned* MISC = (volatile LAS unsigned*)(F.lds + MISC_OFF);
    XcdBarrier bar; bar.bar = (unsigned*)(ws + WS_CTL) + CW_BAR; bar.x = 0; bar.st = nullptr;
    if (!MK_SPLIT) bar = xcd_barrier_post((unsigned*)(ws + WS_CTL) + CW_BAR, MISC + 8);
    const int lo = args.ph_lo, hi = args.ph_hi;
#ifndef PHMASK
#define PHMASK 0x1FFFF
#endif
#define IN(k) (((PHMASK >> (k)) & 1) && lo <= (k) && (k) < hi)
#define SEAM(k) do { if (IN(k) && IN((k) + 1)) xcd_barrier(bar); } while (0)
#ifndef REPMASK
#define REPMASK 0
#endif
#define REPS(k) (((REPMASK >> (k)) & 1) ? 2 : 1)
    bf16_t* H = (bf16_t*)(ws + WS_H); float* X = (float*)(ws + WS_X); float* MOD = (float*)(ws + WS_MOD);

    if (IN(0)) { for (int rep = 0; rep < REPS(0); ++rep) p0_prologue(F); } SEAM(0);
    if (IN(1)) { for (int rep = 0; rep < REPS(1); ++rep) { p1_compress_sample(F); p1_ada(F); } } SEAM(1);
    if (IN(2)) { for (int rep = 0; rep < REPS(2); ++rep) norm_phase<0>(F, true, 0, 0); } SEAM(2);
    if (IN(3)) {
        pg8::Gemm g{H, (const bf16_t*)(ws + WS_WIN), D, D, D, 0}; pg8::StaticOrder S; S.init(MT, NPROJ, F.G, (int)blockIdx.x);
        pg8::EpiProj E{(bf16_t*)(ws + WS_Q), (bf16_t*)(ws + WS_KV), (float*)(ws + WS_GATES), F.out};
        for (int rep = 0; rep < REPS(3); ++rep) pg8::gemm_phase<pg8::EpiProj, pg8::StaticOrder, true>(F.lds, g, S, E);
    } SEAM(3);
    if (IN(4)) { for (int rep = 0; rep < REPS(4); ++rep) p4_compress_prompt(F); } SEAM(4);
    if (IN(5)) {
        att::Ptrs P; P.Q = (const bf16_t*)(ws + WS_Q); P.kcp = (const bf16_t*)(ws + WS_KCMPP); P.vcp = (const bf16_t*)(ws + WS_VCMPP); P.kcs = (const bf16_t*)(ws + WS_KCMPS); P.vcs = (const bf16_t*)(ws + WS_VCMPS);
        const bf16_t* kvb = (const bf16_t*)(ws + WS_KV); P.KS = kvb + 2 * KV_STRIDE; P.VS = kvb + 3 * KV_STRIDE; P.KW = kvb + 4 * KV_STRIDE; P.VW = kvb + 5 * KV_STRIDE;
        P.gates = (const float*)(ws + WS_GATES); P.O = (bf16_t*)(ws + WS_O); P.ck_sel = F.ck_sel; P.cv_sel = F.cv_sel; P.st_kw = F.st_kw; P.st_vw = F.st_vw; P.pt = F.page_table;
        P.gov = -1; P.kw_out = F.out + O_KWS; P.vw_out = F.out + O_KWS + SZ_WS;
#ifdef VERIFY
        P.gov = args.pad0 - 1;
#endif
#ifndef RS
#define RS 1
#endif
#ifndef RP
#define RP 1
#endif
#pragma unroll 1
        for (int pass = 0; pass < 2; ++pass) {
            if ((pass == 0) != ((F.vcu & 1) != 0)) {
#pragma unroll 1
                for (int rep = 0; rep < RS; ++rep)
                for (int u = F.vcu; u < NSB * 4; u += F.G) att::sample_unit(P, F.lds, u >> 2, u & 3, F.tid, F.wave, F.lane);
            } else {
#pragma unroll 1
                for (int rep = 0; rep < RP; ++rep)
                for (int u = F.vcu; u < 16 * 16; u += F.G) { const int bk = u >> 4, s = u & 15;
#pragma unroll 1
                    for (int i = 0; i < 4; ++i) { const int c = (i == 0) ? s : (i == 1) ? 31 - s : (i == 2) ? 32 + s : 63 - s; att::prompt_unit(P, F.lds, bk >> 2, bk & 3, c, F.tid, F.wave, F.lane); } }
            }
        }
    } SEAM(5);
    if (IN(6)) {
        pg8::Gemm g{(const bf16_t*)(ws + WS_O), (const bf16_t*)(ws + WS_WOUT), D, D, D, 0}; pg8::StaticOrder S; S.init(MP, D, F.G, (int)blockIdx.x);
        pg8::EpiRes E{F.x_p, F.x_s, X, MOD + 2048, nullptr};
        pg8::gemm_phase<pg8::EpiRes, pg8::StaticOrder, true>(F.lds, g, S, E);
        small_gemm_res(F, (const bf16_t*)(ws + WS_O) + (size_t)MP * D, D, (const bf16_t*)(ws + WS_WOUT), D, D, false, F.x_s, X + (size_t)MP * D, MOD + 2048, nullptr);
    } SEAM(6);
    if (IN(7)) { for (int rep = 0; rep < REPS(7); ++rep) norm_phase<0>(F, false, 0, 1); } SEAM(7);
    if (IN(8)) {
        pg8::Gemm g{H, (const bf16_t*)(ws + WS_WGU), D, D, D, 0}; pg8::StaticOrder S; S.init(MT, NGU, F.G, (int)blockIdx.x);
        pg8::EpiGU E{(bf16_t*)(ws + WS_ACT)};
        for (int rep = 0; rep < REPS(8); ++rep) pg8::gemm_phase<pg8::EpiGU, pg8::StaticOrder, true>(F.lds, g, S, E);
    } SEAM(8);
    if (IN(9)) {
        pg8::Gemm g{(const bf16_t*)(ws + WS_ACT), (const bf16_t*)(ws + WS_WD), FF, FF, FF, 0}; pg8::StaticOrder S; S.init(MP, D, F.G, (int)blockIdx.x);
        pg8::EpiRes E{X, X + (size_t)MP * D, X, MOD + 5120, nullptr};
        pg8::gemm_phase<pg8::EpiRes, pg8::StaticOrder, true>(F.lds, g, S, E);
        small_gemm_res(F, (const bf16_t*)(ws + WS_ACT) + (size_t)MP * FF, FF, (const bf16_t*)(ws + WS_WD), FF, FF, false, X + (size_t)MP * D, X + (size_t)MP * D, MOD + 5120, nullptr);
    } SEAM(9);
    if (IN(10)) { for (int rep = 0; rep < REPS(10); ++rep) norm_phase<1>(F, false, 1, 0); } SEAM(10);
    if (IN(11)) { for (int rep = 0; rep < REPS(11); ++rep) pool_phase(F); } SEAM(11);
    if (IN(12)) {
        pg8::Gemm g{H, (const bf16_t*)(ws + WS_WPOOL), D, 256, 256, 256}; pg8::StaticOrder S; S.init(MP, D, F.G, (int)blockIdx.x);
        pg8::EpiRes E{X, X + (size_t)MP * D, X, MOD + (size_t)NMODB * 6144 + 2048, F.pool_scale};
        pg8::gemm_phase<pg8::EpiRes, pg8::StaticOrder, true>(F.lds, g, S, E);
        small_gemm_res(F, H + (size_t)MP * D, D, (const bf16_t*)(ws + WS_WPOOL), 256, 256, true, X + (size_t)MP * D, X + (size_t)MP * D, MOD + (size_t)NMODB * 6144 + 2048, F.pool_scale);
    } SEAM(12);
    if (IN(13)) { for (int rep = 0; rep < REPS(13); ++rep) norm_phase<0>(F, false, 1, 1); } SEAM(13);
    if (IN(14)) {
        pg8::Gemm g{H, (const bf16_t*)(ws + WS_WGU) + (size_t)NGU * D, D, D, D, 0}; pg8::StaticOrder S; S.init(MT, NGU, F.G, (int)blockIdx.x);
        pg8::EpiGU E{(bf16_t*)(ws + WS_ACT)};
        pg8::gemm_phase<pg8::EpiGU, pg8::StaticOrder, true>(F.lds, g, S, E);
    } SEAM(14);
    if (IN(15)) {
        pg8::Gemm g{(const bf16_t*)(ws + WS_ACT), (const bf16_t*)(ws + WS_WD) + (size_t)D * FF, FF, FF, FF, 0}; pg8::StaticOrder S; S.init(MP, D, F.G, (int)blockIdx.x);
        pg8::EpiRes E{X, X + (size_t)MP * D, X, MOD + (size_t)NMODB * 6144 + 5120, nullptr};
        pg8::gemm_phase<pg8::EpiRes, pg8::StaticOrder, true>(F.lds, g, S, E);
        small_gemm_res(F, (const bf16_t*)(ws + WS_ACT) + (size_t)MP * FF, FF, (const bf16_t*)(ws + WS_WD) + (size_t)D * FF, FF, FF, false, X + (size_t)MP * D, X + (size_t)MP * D, MOD + (size_t)NMODB * 6144 + 5120, nullptr);
    } SEAM(15);
    if (IN(16)) { for (int rep = 0; rep < REPS(16); ++rep) norm_phase<2>(F, false, 0, 0); }
#undef IN
#undef SEAM
}


#ifdef VERIFY
__global__ void __launch_bounds__(512, 2) verify_k(Args args) {
    extern __shared__ __attribute__((aligned(16))) unsigned char lds[];
    LAS unsigned char* L = (LAS unsigned char*)lds; unsigned char* ws = args.ws;
    const int tid = threadIdx.x, lane = tid & 63, wave = __builtin_amdgcn_readfirstlane(tid >> 6);
    const float* rel_bias = (const float*)args.in[12];
    for (int u = tid; u < 16 * 128; u += 512) { const int h = u >> 7, d = u & 127; ((LAS float*)(L + LUT_OFF))[u] = rel_bias[t5_bucket(d) * 16 + h] * LOG2E; }
    __syncthreads();
    att::Ptrs P; P.Q = (const bf16_t*)(ws + WS_Q); P.kcp = (const bf16_t*)(ws + WS_KCMPP); P.vcp = (const bf16_t*)(ws + WS_VCMPP); P.kcs = (const bf16_t*)(ws + WS_KCMPS); P.vcs = (const bf16_t*)(ws + WS_VCMPS);
    const bf16_t* kvb = (const bf16_t*)(ws + WS_KV); P.KS = kvb + 2 * KV_STRIDE; P.VS = kvb + 3 * KV_STRIDE; P.KW = kvb + 4 * KV_STRIDE; P.VW = kvb + 5 * KV_STRIDE;
    P.gates = (const float*)(ws + WS_GATES); P.O = (bf16_t*)(ws + WS_O); P.ck_sel = (const float*)args.in[6]; P.cv_sel = (const float*)args.in[7]; P.st_kw = (const float*)args.in[9]; P.st_vw = (const float*)args.in[10]; P.pt = (const int*)args.in[8]; P.gov = args.pad0 - 1;
    float* errs = (float*)(ws + WS_CTL) + 65536;
    const int gw = blockIdx.x * 8 + wave;
    for (int it = gw; it < 168 + 64; it += gridDim.x * 8) { bool smp = it >= 168; int vb_, vt_, vk_;
        if (!smp) { const int ti = it % 21, r = it / 21; vb_ = (r >> 2) ? 3 : 0; vk_ = r & 3; vt_ = ti == 0 ? 0 : ti == 1 ? 5 : ti == 2 ? 30 : ti == 3 ? 31 : ti == 4 ? 63 : ti == 5 ? 64 : ti == 6 ? 100 : ti == 7 ? 511 : ti == 8 ? 512 : ti == 9 ? 600 : ti == 10 ? 959 : ti == 11 ? 960 : ti == 12 ? 1023 : ti == 13 ? 1024 : ti == 14 ? 1055 : ti == 15 ? 1100 : ti == 16 ? 2047 : ti == 17 ? 2048 : ti == 18 ? 3000 : ti == 19 ? 4032 : 4095; }
        else { const int q = it - 168, bi = q >> 4; vb_ = bi == 0 ? 0 : bi == 1 ? 1 : bi == 2 ? 77 : 127; vt_ = q & 3; vk_ = (q >> 2) & 3; }
        att::verify_item(P, L, smp, vb_, vt_, vk_, args.pad0 - 1, errs, wave, lane); }
}
__global__ void scale_k(Args args) {
    const float* errs = (const float*)(args.ws + WS_CTL) + 65536; const size_t offs[6] = {O_KCP, O_KCP + SZ_KVP, O_KCP + 2 * SZ_KVP, O_KCS, O_KCS + SZ_KVS, O_KCS + 2 * SZ_KVS};
    const int k = blockIdx.y; const float d2 = errs[2 * k], r2 = errs[2 * k + 1]; const float e = r2 > 0.f ? sqrtf(d2 / r2) : 7.0f; const size_t n = k < 3 ? SZ_KVP : SZ_KVS;
    for (size_t i = (size_t)blockIdx.x * blockDim.x + threadIdx.x; i < n; i += (size_t)gridDim.x * blockDim.x) args.out[offs[k] + i] *= (1.0f + e);
}
#endif
extern "C" void kernel_launch(void* const* d_in, const int* in_sizes, int n_in, void* d_out, int out_size, void* d_ws, size_t ws_size, hipStream_t stream) {
    static int grid = 0;
    if (grid == 0) {
        if (n_in != 28 || (size_t)out_size != O_END || ws_size < WS_END) { fprintf(stderr, "kernel_launch: unexpected shapes (n_in %d, out %d, ws %zu); nothing launched\n", n_in, out_size, ws_size); grid = -1; return; }
        int dev = 0, cus = 0, per_cu = 0;
        if (hipGetDevice(&dev) != hipSuccess || hipDeviceGetAttribute(&cus, hipDeviceAttributeMultiprocessorCount, dev) != hipSuccess) { grid = -1; return; }
        if (hipFuncSetAttribute((const void*)nsa_fwd, hipFuncAttributeMaxDynamicSharedMemorySize, LDS_BYTES) != hipSuccess) { fprintf(stderr, "kernel_launch: hipFuncSetAttribute(%d B LDS) failed\n", LDS_BYTES); grid = -1; return; }
        if (hipOccupancyMaxActiveBlocksPerMultiprocessor(&per_cu, (const void*)nsa_fwd, 512, LDS_BYTES) != hipSuccess || per_cu < 1)
            fprintf(stderr, "kernel_launch: note: occupancy query reports %d workgroups per CU\n", per_cu);
        (void)hipGetLastError();
        grid = cus;
    }
    if (grid < 0) return;
    (void)hipMemsetAsync((char*)d_ws + WS_CTL, 0, CTL_ZERO_BYTES, stream);
    Args a{};
    for (int i = 0; i < 28; ++i) a.in[i] = d_in[i];
    a.out = (float*)d_out; a.ws = (unsigned char*)d_ws; a.pad0 = 0; a.pad1 = 0;
#ifdef VERIFY
    hipFuncSetAttribute((const void*)verify_k, hipFuncAttributeMaxDynamicSharedMemorySize, LDS_BYTES);
    for (int pass = 0; pass < 3; ++pass) { a.pad0 = pass + 1; a.ph_lo = 0; a.ph_hi = 6;
        (void)hipMemsetAsync((char*)d_ws + WS_CTL, 0, 65536 * 4, stream);
        hipLaunchKernelGGL(nsa_fwd, dim3(grid), dim3(512), LDS_BYTES, stream, a);
        hipLaunchKernelGGL(verify_k, dim3(grid), dim3(512), LDS_BYTES, stream, a); }
    a.pad0 = 0; (void)hipMemsetAsync((char*)d_ws + WS_CTL, 0, 65536 * 4, stream);
    a.ph_lo = 0; a.ph_hi = NPHASE;
    hipLaunchKernelGGL(nsa_fwd, dim3(grid), dim3(512), LDS_BYTES, stream, a);
    hipLaunchKernelGGL(scale_k, dim3(64, 6), dim3(256), 0, stream, a);
#elif MK_SPLIT
    for (int p = 0; p < NPHASE; ++p) { a.ph_lo = p; a.ph_hi = p + 1; hipLaunchKernelGGL(nsa_fwd, dim3(grid), dim3(512), LDS_BYTES, stream, a); }
#else
    a.ph_lo = 0; a.ph_hi = NPHASE;
    hipLaunchKernelGGL(nsa_fwd, dim3(grid), dim3(512), LDS_BYTES, stream, a);
#endif
    const hipError_t le = hipPeekAtLastError();
    if (le != hipSuccess) fprintf(stderr, "kernel_launch: launch failed: %s\n", hipGetErrorName(le));
}
```

```cpp
#include <hip/hip_runtime.h>
#include <cstdio>
#include <cstdint>

#ifndef MK_SPLIT
#define MK_SPLIT 0
#endif

#define GAS __attribute__((address_space(1)))
#define LAS __attribute__((address_space(3)))
typedef unsigned short bf16_t;
typedef short bf16x8 __attribute__((ext_vector_type(8)));
typedef short s16x4 __attribute__((ext_vector_type(4)));
typedef float f32x2 __attribute__((ext_vector_type(2)));
typedef float f32x4 __attribute__((ext_vector_type(4)));
typedef float f32x16 __attribute__((ext_vector_type(16)));
typedef unsigned u32x2 __attribute__((ext_vector_type(2)));
typedef unsigned u32x4 __attribute__((ext_vector_type(4)));
typedef __bf16 bf16x2_t __attribute__((ext_vector_type(2)));
typedef GAS unsigned gu32;

constexpr int D = 1024, SEQ = 4096, NB = 4, NSB = 128, DSEQ = 4;
constexpr int MP = NB * SEQ, MS = NSB * DSEQ, MT = MP + MS;
constexpr int INCOLS = 2608, NPROJ = 2816, FF = 2816, NGU = 2 * FF;
constexpr int NMODB = NB + NSB;
constexpr int PAST = 2048;
constexpr float C2 = 0.125f * 1.4426950408889634f;
constexpr float LOG2E = 1.4426950408889634f;

constexpr size_t O_YP = 0, O_YS = O_YP + (size_t)MP * D;
constexpr size_t O_KCP = O_YS + (size_t)MS * D, SZ_KVP = (size_t)MP * 256;
constexpr size_t O_KWP = O_KCP + 4 * SZ_KVP, SZ_WP = (size_t)NB * 512 * 256;
constexpr size_t O_PLP = O_KWP + 2 * SZ_WP;
constexpr size_t O_KCS = O_PLP + (size_t)NB * 15 * D, SZ_KVS = (size_t)MS * 256;
constexpr size_t O_KWS = O_KCS + 4 * SZ_KVS, SZ_WS = (size_t)NSB * 512 * 256;
constexpr size_t O_PLS = O_KWS + 2 * SZ_WS;
constexpr size_t O_END = O_PLS + (size_t)NSB * 15 * D;
static_assert(O_END == 71233536, "output size");

constexpr size_t MiB = 1u << 20;
#ifdef VERIFY
constexpr size_t WS_CTL = 0, CTL_ZERO_BYTES = 1 * MiB;
#else
constexpr size_t WS_CTL = 0, CTL_ZERO_BYTES = 65536;
#endif
constexpr size_t WS_WIN = 2 * MiB;
constexpr size_t WS_WOUT = 8 * MiB;
constexpr size_t WS_WGU = 10 * MiB;
constexpr size_t WS_WD = 32 * MiB;
constexpr size_t WS_WPOOL = 44 * MiB;
constexpr size_t WS_WCK = 45 * MiB, WS_WCV = WS_WCK + 262144;
constexpr size_t WS_SC = 46 * MiB;
constexpr size_t WS_CB = 47 * MiB;
constexpr size_t WS_MOD = 48 * MiB;
constexpr size_t WS_KCMPP = 56 * MiB, WS_VCMPP = 57 * MiB;
constexpr size_t WS_KCMPS = 58 * MiB, WS_VCMPS = 62 * MiB;
constexpr size_t WS_GATES = 66 * MiB;
constexpr size_t WS_H = 72 * MiB;
constexpr size_t WS_Q = 108 * MiB;
constexpr size_t WS_O = 144 * MiB;
constexpr size_t WS_KV = 180 * MiB, KV_STRIDE = (size_t)MT * 256;
constexpr size_t WS_X = 232 * MiB;
constexpr size_t WS_HF = 300 * MiB;
constexpr size_t WS_ACT = 368 * MiB;
constexpr size_t WS_END = 464 * MiB;
static_assert(WS_KV + 6 * KV_STRIDE * 2 <= WS_X && WS_X + (size_t)MT * D * 4 <= WS_HF && WS_HF + (size_t)MT * D * 4 <= WS_ACT && WS_ACT + (size_t)MT * FF * 2 <= WS_END, "ws map");
static_assert(WS_WGU + 2 * (size_t)NGU * D * 2 <= WS_WD && WS_WD + 2 * (size_t)D * FF * 2 <= WS_WPOOL && WS_MOD + 2 * (size_t)NMODB * 6144 * 4 <= WS_KCMPP, "ws map 2");
static_assert(WS_GATES + (size_t)MT * 48 * 4 <= WS_H && WS_H + (size_t)MT * D * 2 <= WS_Q && WS_Q + (size_t)MT * D * 2 <= WS_O && WS_O + (size_t)MT * D * 2 <= WS_KV, "ws map 3");
constexpr int CW_BAR = 4096;

constexpr int RING_BYTES = 131072;
constexpr int LUT_OFF = RING_BYTES;
constexpr int WSF_OFF = LUT_OFF + 8192;
constexpr int IMP_OFF = WSF_OFF + 1024;
constexpr int MISC_OFF = IMP_OFF + 16384;
constexpr int LDS_BYTES = MISC_OFF + 256;
static_assert(LDS_BYTES <= 160 * 1024, "LDS");

__device__ __forceinline__ unsigned cvtpk(float lo, float hi) { f32x2 v = {lo, hi}; bf16x2_t b = __builtin_convertvector(v, bf16x2_t); return __builtin_bit_cast(unsigned, b); }
__device__ __forceinline__ float bf2f(unsigned short h) { return __builtin_bit_cast(float, (unsigned)h << 16); }
__device__ __forceinline__ float ex2(float x) { return __builtin_amdgcn_exp2f(x); }
__device__ __forceinline__ float sigmoidf_(float x) { return __builtin_amdgcn_rcpf(1.0f + ex2(-x * LOG2E)); }
#define CROW0(r) (((r) & 3) + 8 * ((r) >> 2))
#define LDS_WAIT() asm volatile("s_waitcnt lgkmcnt(0)" ::: "memory")
#define VM_WAIT() asm volatile("s_waitcnt vmcnt(0)" ::: "memory")
__device__ __forceinline__ const char* uniform_ptr(const void* p) { const unsigned long long v = (unsigned long long)p; const unsigned lo = (unsigned)__builtin_amdgcn_readfirstlane((int)(unsigned)v), hi = (unsigned)__builtin_amdgcn_readfirstlane((int)(unsigned)(v >> 32)); return (const char*)(((unsigned long long)hi << 32) | lo); }

__device__ __forceinline__ int t5_bucket(int d) {
    if (d < 16) return d;
    int b = 16;
    b += (d >= 19) + (d >= 21) + (d >= 24) + (d >= 27) + (d >= 31) + (d >= 35) + (d >= 40) + (d >= 46) + (d >= 52) + (d >= 59) + (d >= 67) + (d >= 77) + (d >= 87) + (d >= 99) + (d >= 113);
    return b;
}

namespace pg8 {
constexpr int BM = 256, BK = 64, HALF = 128, HTB = HALF * BK * 2, STAGE_BYTES = 8 * HTB, NXCD = 8, WGM = 8;
__host__ __device__ __forceinline__ int lds_byte(int r, int c) { const int st = (r >> 4) * 2 + (c >> 5), rr = r & 15, cc = c & 31, ob = rr * 64 + cc * 2; return st * 1024 + (ob ^ (((ob >> 9) & 1) << 5)); }
__host__ __device__ __forceinline__ void stage_rc(int b, int& R, int& C) { const int st = b / 1024, sb = b % 1024, swz = sb ^ (((sb >> 9) & 1) << 5); R = (st >> 1) * 16 + swz / 64; C = (st & 1) * 32 + (swz % 64) / 2; }
__host__ __device__ __forceinline__ int perm32(int rho) { const int n = rho >> 4, i = rho & 15; return 8 * (i >> 2) + 4 * n + (i & 3); }
struct Unit { int pm, pn; };
struct Gemm { const bf16_t* A; const bf16_t* Bt; int lda, ldb, K, acs; };
struct StaticOrder {
    int nM, nN, nwg, G, c;
    __host__ __device__ void init(int M, int N, int G_, int c_) { nM = M / BM; nN = N / BM; nwg = nM * nN; G = G_; c = c_; }
    __host__ __device__ bool next(int i, Unit& u) const {
        const long L = (long)i * G + c; if (L >= nwg) return false;
        int wgid = (int)L; { const int q = nwg / NXCD, r = nwg % NXCD, xcd = wgid % NXCD, off = wgid / NXCD; wgid = (xcd < r ? xcd * (q + 1) : r * (q + 1) + (xcd - r) * q) + off; }
        const int nig = WGM * nN, gid = wgid / nig, fm = gid * WGM, gsz = (nM - fm) < WGM ? (nM - fm) : WGM;
        u.pm = fm + ((wgid % nig) % gsz); u.pn = (wgid % nig) / gsz; return true;
    }
};
template <class Epi, class Sched, bool ALIGN_EPI>
__device__ __forceinline__ void gemm_phase(LAS unsigned char* lds, const Gemm g, const Sched& S, const Epi& E) {
    const int tid = threadIdx.x, wid = __builtin_amdgcn_readfirstlane(tid >> 6), lane = tid & 63, wr = wid >> 2, wc = wid & 3, fr = lane & 15, fq = lane >> 4;
    const int K = g.K, nt = K / BK;
    unsigned voffA[2], voffB[2];
#pragma unroll
    for (int i = 0; i < 2; ++i) { int R, C; stage_rc(tid * 16 + i * 8192, R, C); const int Rb = Epi::PERM ? ((R & ~31) + perm32(R & 31)) : R;
        voffA[i] = (unsigned)(R * g.lda + C) * 2u; voffB[i] = (unsigned)(Rb * g.ldb + C) * 2u; }
    const size_t kstep = (size_t)(BK * 2);
    const size_t hsA = (size_t)HALF * g.lda * 2, hsB = (size_t)HALF * g.ldb * 2;
    const unsigned ldsw = (unsigned)wid * 1024u;
    const int aoff = lds_byte(wr * 64 + fr, fq * 8), boff = lds_byte(wc * 32 + fr, fq * 8);
#define PG8_SA(b, h) (((b) * 2 + (h)) * HTB)
#define PG8_SB(b, h) ((4 + (b) * 2 + (h)) * HTB)
#define PG8_STAGE(bufoff, gbase, voff) do { _Pragma("unroll") for (int _i = 0; _i < 2; ++_i) \
        __builtin_amdgcn_global_load_lds((const unsigned*)((const char*)(gbase) + (voff)[_i]), (LAS unsigned*)(lds + (bufoff) + ldsw + _i * 8192), 16, 0, 0); } while (0)
#define PG8_LDA(dst, b, h) do { _Pragma("unroll") for (int m = 0; m < 4; ++m) _Pragma("unroll") for (int k = 0; k < 2; ++k) dst[m][k] = *(const LAS bf16x8*)(lds + PG8_SA(b, h) + aoff + m * 2048 + k * 1024); } while (0)
#define PG8_LDB(dst, b, h) do { _Pragma("unroll") for (int n = 0; n < 2; ++n) _Pragma("unroll") for (int k = 0; k < 2; ++k) dst[n][k] = *(const LAS bf16x8*)(lds + PG8_SB(b, h) + boff + n * 2048 + k * 1024); } while (0)
#define PG8_MMA(ai, bj, At, Bt) do { __builtin_amdgcn_s_setprio(1); _Pragma("unroll") for (int m = 0; m < 4; ++m) _Pragma("unroll") for (int n = 0; n < 2; ++n) _Pragma("unroll") for (int k = 0; k < 2; ++k) \
        acc[ai][bj][m][n] = __builtin_amdgcn_mfma_f32_16x16x32_bf16(Bt[n][k], At[m][k], acc[ai][bj][m][n], 0, 0, 0); __builtin_amdgcn_s_setprio(0); } while (0)
#define PG8_WAIT_V(n) asm volatile("s_waitcnt vmcnt(" #n ")" ::: "memory")
#define PG8_WAIT_L(n) asm volatile("s_waitcnt lgkmcnt(" #n ")" ::: "memory")
#define PG8_BAR __builtin_amdgcn_s_barrier()
#define PG8_SCHED __builtin_amdgcn_sched_barrier(0)
#define PG8_UA(u) ((const char*)g.A + (size_t)(u).pm * 2 * hsA + (size_t)(u).pn * (size_t)g.acs * 2)
#define PG8_UB(u) ((const char*)g.Bt + (size_t)(u).pn * 2 * hsB)
    Unit cur, nxt; int ui = 0;
    if (!S.next(0, cur)) return;
    f32x4 acc[2][2][4][2];
#pragma unroll
    for (int a = 0; a < 2; ++a)
#pragma unroll
        for (int b = 0; b < 2; ++b)
#pragma unroll
            for (int m = 0; m < 4; ++m)
#pragma unroll
                for (int n = 0; n < 2; ++n) acc[a][b][m][n] = (f32x4){0.f, 0.f, 0.f, 0.f};
    bf16x8 At[4][2], B0[2][2], B1[2][2];
    const char* cA = PG8_UA(cur); const char* cB = PG8_UB(cur);
    PG8_STAGE(PG8_SB(0, 0), cB, voffB); PG8_STAGE(PG8_SB(0, 1), cB + hsB, voffB); PG8_STAGE(PG8_SA(0, 0), cA, voffA); PG8_STAGE(PG8_SA(0, 1), cA + hsA, voffA);
    if (wr == 1) PG8_BAR;
    PG8_WAIT_V(2); PG8_BAR;
    PG8_STAGE(PG8_SB(1, 0), cB + kstep, voffB); PG8_STAGE(PG8_SA(1, 0), cA + kstep, voffA); PG8_STAGE(PG8_SB(1, 1), cB + hsB + kstep, voffB);
    PG8_WAIT_V(6); PG8_BAR;
    for (;;) {
        const bool has_next = S.next(ui + 1, nxt);
        const char* nA = has_next ? PG8_UA(nxt) : cA; const char* nB = has_next ? PG8_UB(nxt) : cB;
        for (int t = 0; t < nt; t += 2) {
            const bool last = (t == nt - 2);
            const char* a1 = cA + (size_t)(t + 1) * kstep;
            const char* a2 = last ? nA : cA + (size_t)(t + 2) * kstep; const char* b2 = last ? nB : cB + (size_t)(t + 2) * kstep;
            const char* a3 = a2 + kstep; const char* b3 = b2 + kstep;
            PG8_LDB(B0, 0, 0); PG8_LDB(B1, 0, 1); PG8_SCHED; PG8_LDA(At, 0, 0); PG8_STAGE(PG8_SA(1, 1), a1 + hsA, voffA);
            PG8_WAIT_V(8); PG8_WAIT_L(0); PG8_BAR; PG8_MMA(0, 0, At, B0); PG8_MMA(0, 1, At, B1); PG8_BAR; PG8_SCHED;
            PG8_LDA(At, 0, 1); PG8_STAGE(PG8_SB(0, 0), b2, voffB); PG8_STAGE(PG8_SB(0, 1), b2 + hsB, voffB); PG8_STAGE(PG8_SA(0, 0), a2, voffA);
            PG8_WAIT_V(8); PG8_WAIT_L(0); PG8_BAR; PG8_MMA(1, 0, At, B0); PG8_MMA(1, 1, At, B1); PG8_BAR; PG8_SCHED;
            PG8_LDB(B0, 1, 0); PG8_LDB(B1, 1, 1); PG8_SCHED; PG8_LDA(At, 1, 0); PG8_STAGE(PG8_SA(0, 1), a2 + hsA, voffA);
            PG8_WAIT_V(8); PG8_WAIT_L(0); PG8_BAR; PG8_MMA(0, 0, At, B0); PG8_MMA(0, 1, At, B1); PG8_BAR; PG8_SCHED;
            PG8_LDA(At, 1, 1); PG8_STAGE(PG8_SB(1, 0), b3, voffB); PG8_STAGE(PG8_SB(1, 1), b3 + hsB, voffB); PG8_STAGE(PG8_SA(1, 0), a3, voffA);
            PG8_WAIT_V(8); PG8_WAIT_L(0); PG8_BAR; PG8_MMA(1, 0, At, B0); PG8_MMA(1, 1, At, B1); PG8_BAR; PG8_SCHED;
        }
        if constexpr (ALIGN_EPI) { if (wr == 0) PG8_BAR; }
        E(acc, cur, wr, wc, fr, fq);
        if (!has_next) break;
#pragma unroll
        for (int a = 0; a < 2; ++a)
#pragma unroll
            for (int b = 0; b < 2; ++b)
#pragma unroll
                for (int m = 0; m < 4; ++m)
#pragma unroll
                    for (int n = 0; n < 2; ++n) acc[a][b][m][n] = (f32x4){0.f, 0.f, 0.f, 0.f};
        cur = nxt; cA = nA; cB = nB; ++ui;
        if constexpr (ALIGN_EPI) { if (wr == 1) PG8_BAR; }
    }
    PG8_WAIT_V(0);
    if constexpr (!ALIGN_EPI) { if (wr == 0) PG8_BAR; }
    PG8_BAR;
#undef PG8_SA
#undef PG8_SB
#undef PG8_STAGE
#undef PG8_LDA
#undef PG8_LDB
#undef PG8_MMA
#undef PG8_WAIT_V
#undef PG8_WAIT_L
#undef PG8_BAR
#undef PG8_SCHED
#undef PG8_UA
#undef PG8_UB
}

struct EpiProj {
    static constexpr bool PERM = true;
    bf16_t* Q; bf16_t* KV; float* gates; float* out;
    __device__ __forceinline__ void operator()(const f32x4 (&acc)[2][2][4][2], const Unit& u, int wr, int wc, int fr, int fq) const {
        const int pn = u.pn;
#pragma unroll
        for (int ai = 0; ai < 2; ++ai)
#pragma unroll
            for (int m = 0; m < 4; ++m) {
                const int row = u.pm * BM + ai * HALF + wr * 64 + m * 16 + fr;
                if (pn < 4) {
#pragma unroll
                    for (int bj = 0; bj < 2; ++bj) { const f32x4 v0 = acc[ai][bj][m][0] * C2, v1 = acc[ai][bj][m][1] * C2; u32x4 w;
                        w.x = cvtpk(v0[0], v0[1]); w.y = cvtpk(v0[2], v0[3]); w.z = cvtpk(v1[0], v1[1]); w.w = cvtpk(v1[2], v1[3]);
                        *(u32x4*)(Q + (size_t)row * D + pn * 256 + bj * HALF + wc * 32 + 8 * fq) = w; }
                } else if (pn < 10) {
                    const int t = pn - 4; float* dst = nullptr;
                    if (row < MP) { if (t < 4) dst = out + O_KCP + (size_t)t * SZ_KVP + (size_t)row * 256; else { const int tt = row & (SEQ - 1); if (tt >= SEQ - 512) dst = out + O_KWP + (size_t)(t - 4) * SZ_WP + ((size_t)(row >> 12) * 512 + (tt - (SEQ - 512))) * 256; } }
                    else { const int rs = row - MP; if (t < 4) dst = out + O_KCS + (size_t)t * SZ_KVS + (size_t)rs * 256; else dst = out + O_KWS + (size_t)(t - 4) * SZ_WS + ((size_t)(rs >> 2) * 512 + 508 + (rs & 3)) * 256; }
                    bf16_t* bd = KV + (size_t)t * KV_STRIDE + (size_t)row * 256;
#pragma unroll
                    for (int bj = 0; bj < 2; ++bj) { const int cc = bj * HALF + wc * 32 + 8 * fq; const f32x4 v0 = acc[ai][bj][m][0], v1 = acc[ai][bj][m][1]; u32x4 w;
                        w.x = cvtpk(v0[0], v0[1]); w.y = cvtpk(v0[2], v0[3]); w.z = cvtpk(v1[0], v1[1]); w.w = cvtpk(v1[2], v1[3]);
                        *(u32x4*)(bd + cc) = w;
                        if (dst) { *(f32x4*)(dst + cc) = v0; *(f32x4*)(dst + cc + 4) = v1; } }
                } else {
                    const int cc = wc * 32 + 8 * fq;
                    if (cc < 48) { float* gd = gates + (size_t)row * 48 + cc; *(f32x4*)gd = acc[ai][0][m][0]; *(f32x4*)(gd + 4) = acc[ai][0][m][1]; }
                }
            }
    }
};
struct EpiRes {
    static constexpr bool PERM = false;
    const float* xin_p; const float* xin_s; float* xout; const float* gate; const float* scale;
    __device__ __forceinline__ void operator()(const f32x4 (&acc)[2][2][4][2], const Unit& u, int wr, int wc, int fr, int fq) const {
#pragma unroll
        for (int ai = 0; ai < 2; ++ai)
#pragma unroll
            for (int m = 0; m < 4; ++m) {
                const int row = u.pm * BM + ai * HALF + wr * 64 + m * 16 + fr;
                const int bb = row < MP ? (row >> 12) : NB + ((row - MP) >> 2);
                const float* xi = row < MP ? xin_p + (size_t)row * D : xin_s + (size_t)(row - MP) * D;
                const float* gp = gate + (size_t)bb * 6144; float* xo = xout + (size_t)row * D;
#pragma unroll
                for (int bj = 0; bj < 2; ++bj)
#pragma unroll
                    for (int n = 0; n < 2; ++n) { const int col = u.pn * BM + bj * HALF + wc * 32 + 16 * n + 4 * fq;
                        f32x4 g4 = *(const f32x4*)(gp + col); if (scale) g4 = g4 * *(const f32x4*)(scale + col);
                        const f32x4 x4 = *(const f32x4*)(xi + col); *(f32x4*)(xo + col) = x4 + g4 * acc[ai][bj][m][n]; }
            }
    }
};
struct EpiGU {
    static constexpr bool PERM = true;
    bf16_t* act;
    __device__ __forceinline__ void operator()(const f32x4 (&acc)[2][2][4][2], const Unit& u, int wr, int wc, int fr, int fq) const {
#pragma unroll
        for (int ai = 0; ai < 2; ++ai)
#pragma unroll
            for (int m = 0; m < 4; ++m) {
                const int row = u.pm * BM + ai * HALF + wr * 64 + m * 16 + fr; float r[8];
#pragma unroll
                for (int n = 0; n < 2; ++n)
#pragma unroll
                    for (int e = 0; e < 4; ++e) { const float gv = acc[ai][0][m][n][e], uv = acc[ai][1][m][n][e]; r[n * 4 + e] = gv * sigmoidf_(gv) * uv; }
                u32x4 w; w.x = cvtpk(r[0], r[1]); w.y = cvtpk(r[2], r[3]); w.z = cvtpk(r[4], r[5]); w.w = cvtpk(r[6], r[7]);
                *(u32x4*)(act + (size_t)row * FF + u.pn * HALF + wc * 32 + 8 * fq) = w;
            }
    }
};
}

#define XB_TMO      128
#define XB_XCNT(j)  (256  + 64 * (j))
#define XB_XSUB(j)  (1280 + 64 * (j))
#define XB_XGEN(j)  (2304 + 64 * (j))
#define XB_TOP      3328
#define XB_TOPGEN   3392
#define XCD_BAR_WORDS 3456
#define XB_SPIN_CAP (1u << 18)
__device__ __forceinline__ unsigned xb_ld(unsigned* p)              { return __hip_atomic_load(p, __ATOMIC_RELAXED, __HIP_MEMORY_SCOPE_AGENT); }
__device__ __forceinline__ unsigned xb_add(unsigned* p, unsigned v) { return __hip_atomic_fetch_add(p, v, __ATOMIC_RELAXED, __HIP_MEMORY_SCOPE_AGENT); }
__device__ __forceinline__ unsigned xb_xcc_id() { return (unsigned)__builtin_amdgcn_s_getreg((3 << 11) | 20) & 0xFu; }
#define XB_SPIN(cond, bar) do { unsigned _sp = 0; while (cond) { __builtin_amdgcn_s_sleep(1); \
    if ((++_sp & 255u) == 0u) { if (xb_ld(&(bar)[XB_TMO])) break; if (_sp > XB_SPIN_CAP) { atomicAdd(&(bar)[XB_TMO], 1u); break; } } } } while (0)
struct XcdBarrier { unsigned* bar; unsigned x; volatile LAS unsigned* st; };
__device__ __forceinline__ XcdBarrier xcd_barrier_post(unsigned* bar, volatile LAS unsigned* st) {
    XcdBarrier b; b.bar = bar; b.x = xb_xcc_id(); b.st = st;
    if (threadIdx.x == 0) (void)xb_add(&bar[XB_XCNT(b.x)], 1u);
    return b;
}
__device__ __forceinline__ void xcd_barrier_complete(unsigned* bar, unsigned x, unsigned& nloc, unsigned& nx) {
    const unsigned G = gridDim.x * gridDim.y * gridDim.z;
    unsigned sum, cnt, mine, sp = 0u;
    for (;;) {
        sum = 0u; cnt = 0u; mine = 0u;
#pragma unroll
        for (unsigned j = 0; j < 16; ++j) { const unsigned c = xb_ld(&bar[XB_XCNT(j)]); sum += c; cnt += (c > 0u) ? 1u : 0u; mine = (j == x) ? c : mine; }
        if (sum == G) break;
        __builtin_amdgcn_s_sleep(1);
        if ((++sp & 255u) == 0u) { if (xb_ld(&bar[XB_TMO])) break; if (sp > XB_SPIN_CAP) { atomicAdd(&bar[XB_TMO], 1u); break; } }
    }
    nloc = mine > 0u ? mine : 1u; nx = cnt > 0u ? cnt : 1u;
}
__device__ __forceinline__ void xcd_barrier(const XcdBarrier& b) {
    asm volatile("s_waitcnt vmcnt(0)" ::: "memory");
    __syncthreads();
    if (threadIdx.x == 0) {
        unsigned* bar = b.bar;
        __builtin_amdgcn_s_waitcnt(0);
        unsigned nloc = b.st[0], nx = b.st[1];
        if (nloc == 0u) { xcd_barrier_complete(bar, b.x, nloc, nx); b.st[0] = nloc; b.st[1] = nx; }
        const unsigned old = xb_add(&bar[XB_XSUB(b.x)], 1u);
        const unsigned gen = old / nloc;
        if (old + 1u == (gen + 1u) * nloc) {
            __builtin_amdgcn_fence(__ATOMIC_RELEASE, "agent");
            asm volatile("s_waitcnt vmcnt(0)" ::: "memory");
            const unsigned og = xb_add(&bar[XB_TOP], 1u);
            const unsigned tg = og / nx;
            if (og + 1u == (tg + 1u) * nx) xb_add(&bar[XB_TOPGEN], 1u);
            else XB_SPIN(xb_ld(&bar[XB_TOPGEN]) == tg, bar);
            __builtin_amdgcn_fence(__ATOMIC_ACQUIRE, "agent");
            xb_add(&bar[XB_XGEN(b.x)], 1u);
            asm volatile("s_waitcnt vmcnt(0)" ::: "memory");
        } else {
            XB_SPIN(xb_ld(&bar[XB_XGEN(b.x)]) == gen, bar);
            __builtin_amdgcn_fence(__ATOMIC_ACQUIRE, "agent");
            asm volatile("s_waitcnt vmcnt(0)" ::: "memory");
        }
    }
    __syncthreads();
}

struct Args { const void* in[28]; float* out; unsigned char* ws; int ph_lo, ph_hi, pad0, pad1; };
struct Frame {
    LAS unsigned char* lds; int tid, lane, wave, vcu, G;
    const float *x_p, *x_s, *c_p, *c_s, *ck_cmp, *cv_cmp, *ck_sel, *cv_sel; const int* page_table; const float *st_kw, *st_vw, *st_pool, *rel_bias, *ada_w, *ada_b, *norm_g, *final_g,
        *w_in, *w_out, *cmp_wk, *cmp_wv, *pe_k, *pe_v, *pool_w, *pool_scale, *ffn_wg, *ffn_wu, *ffn_wd;
    float* out; unsigned char* ws;
};
__device__ __forceinline__ float wave_sum(float v) {
#pragma unroll
    for (int o = 1; o < 64; o <<= 1) v += __shfl_xor(v, o);
    return v;
}

__device__ __forceinline__ void transpose_item(const float* W, int ldw, int nvalid, bf16_t* WT, int ldt, int drow0, LAS float* scr, int k0, int n0, int lane) {
    float tv[32];
#pragma unroll
    for (int i = 0; i < 32; ++i) { const int kk = 2 * i + (lane >> 5), n = n0 + (lane & 31); tv[i] = (n < nvalid) ? W[(size_t)(k0 + kk) * ldw + n] : 0.f; }
#pragma unroll
    for (int i = 0; i < 32; ++i) { const int kk = 2 * i + (lane >> 5); scr[kk * 33 + (lane & 31)] = tv[i]; }
    LDS_WAIT();
    const int c = lane & 7;
#pragma unroll
    for (int j = 0; j < 4; ++j) { const int n = (lane >> 3) + 8 * j; const LAS float* s = scr + (8 * c) * 33 + n;
        u32x4 o; o.x = cvtpk(s[0 * 33], s[1 * 33]); o.y = cvtpk(s[2 * 33], s[3 * 33]); o.z = cvtpk(s[4 * 33], s[5 * 33]); o.w = cvtpk(s[6 * 33], s[7 * 33]);
        *(u32x4*)(WT + (size_t)(drow0 + n) * ldt + k0 + 8 * c) = o; }
    LDS_WAIT();
}
__device__ __forceinline__ void p0_prologue(Frame& F) {
    LAS float* scr = (LAS float*)(F.lds + F.wave * 16384);
    const int gw = F.vcu * 8 + F.wave, NGW = F.G * 8, lane = F.lane;
    unsigned char* ws = F.ws;
    constexpr int I_IN = 16 * 88, I_OUT = 16 * 32, I_G = 16 * 88, I_D = 44 * 32, I_P = 4 * 8, I_C = 32 * 2;
    constexpr int NITEMS = I_IN + I_OUT + 4 * I_G + 2 * I_D + 4 * I_P + 2 * I_C;
    for (int it = gw; it < NITEMS; it += NGW) {
        int r = it;
        if (r < I_IN) { const int kb = r / 88, nb = r % 88; transpose_item(F.w_in, INCOLS, INCOLS, (bf16_t*)(ws + WS_WIN), D, nb * 32, scr, kb * 64, nb * 32, lane); continue; } r -= I_IN;
        if (r < I_OUT) { const int kb = r / 32, nb = r % 32; transpose_item(F.w_out, D, D, (bf16_t*)(ws + WS_WOUT), D, nb * 32, scr, kb * 64, nb * 32, lane); continue; } r -= I_OUT;
        if (r < 4 * I_G) { const int l = r / (2 * I_G), which = (r / I_G) & 1, q = r % I_G, kb = q / 88, nb = q % 88, n0 = nb * 32;
            const float* W = (which ? F.ffn_wu : F.ffn_wg) + (size_t)l * D * FF;
            transpose_item(W, FF, FF, (bf16_t*)(ws + WS_WGU) + (size_t)l * NGU * D, D, (n0 >> 7) * 256 + which * 128 + (n0 & 127), scr, kb * 64, n0, lane); continue; } r -= 4 * I_G;
        if (r < 2 * I_D) { const int l = r / I_D, q = r % I_D, kb = q / 32, nb = q % 32;
            transpose_item(F.ffn_wd + (size_t)l * FF * D, D, D, (bf16_t*)(ws + WS_WD) + (size_t)l * D * FF, FF, nb * 32, scr, kb * 64, nb * 32, lane); continue; } r -= 2 * I_D;
        if (r < 4 * I_P) { const int gI = r / I_P, q = r % I_P, kb = q / 8, nb = q % 8;
            transpose_item(F.pool_w + (size_t)gI * 65536, 256, 256, (bf16_t*)(ws + WS_WPOOL) + (size_t)gI * 65536, 256, nb * 32, scr, kb * 64, nb * 32, lane); continue; } r -= 4 * I_P;
        { const int which = r / I_C, q = r % I_C, kb = q / 2, nb = q % 2;
          transpose_item(which ? F.cmp_wv : F.cmp_wk, 64, 64, (bf16_t*)(ws + (which ? WS_WCV : WS_WCK)), 2048, nb * 32, scr, kb * 64, nb * 32, lane); }
    }
    { const int gt = (F.vcu * 8 + F.wave) * 64 + lane, NT = F.G * 512; bf16_t* sc = (bf16_t*)(ws + WS_SC);
      for (int i = gt; i < 144 * 512; i += NT) { const int row = i >> 9, c2 = (i & 511) * 2; float a = 0.f, b = 0.f;
          if (row < NMODB) { const float* cp = row < NB ? F.c_p + (size_t)row * D : F.c_s + (size_t)(row - NB) * D; const float x0 = cp[c2], x1 = cp[c2 + 1]; a = x0 * sigmoidf_(x0); b = x1 * sigmoidf_(x1); }
          *(unsigned*)(sc + (size_t)row * D + c2) = cvtpk(a, b); } }
    if (F.vcu < 16) { const int tsel = F.vcu >> 3, part = F.vcu & 7; const float* pe = tsel ? F.pe_v : F.pe_k; const float* W = tsel ? F.cmp_wv : F.cmp_wk; float sacc = 0.f;
        const int kb = part * 256 + F.wave * 32;
#pragma unroll
        for (int k = 0; k < 32; ++k) sacc += pe[kb + k] * W[(size_t)(kb + k) * 64 + lane];
        LAS float* red = (LAS float*)(F.lds + WSF_OFF);
        red[F.wave * 64 + lane] = sacc; LDS_WAIT(); __syncthreads();
        if (F.wave == 0) { float t2 = 0.f;
#pragma unroll
            for (int w = 0; w < 8; ++w) t2 += red[w * 64 + lane];
            ((float*)(ws + WS_CB))[(tsel * 8 + part) * 64 + lane] = t2; }
        __syncthreads(); }
    { const size_t gt = (size_t)(F.vcu * 8 + F.wave) * 64 + lane, NT = (size_t)F.G * 512;
      const size_t pp = (size_t)NSB * 11 * 256;
      for (size_t i = gt; i < pp; i += NT) { const size_t b = i / (11 * 256), rem = i % (11 * 256);
          ((f32x4*)(F.out + O_PLS + b * 15 * D))[rem] = ((const f32x4*)(F.st_pool + (b * 15 + 4) * D))[rem]; } }
}

__device__ __forceinline__ void p1_ada(Frame& F) {
    const int gw = F.vcu * 8 + F.wave, NGW = F.G * 8, lane = F.lane, fr = lane & 15, kq = lane >> 4;
    const bf16_t* sc = (const bf16_t*)(F.ws + WS_SC); float* mod = (float*)(F.ws + WS_MOD);
    for (int tile = F.wave < 3 ? F.vcu * 3 + F.wave : 768; tile < 768; tile += F.G * 3) {
        const int layer = tile / 384, n0 = (tile % 384) * 16;
        const float* W = F.ada_w + (size_t)layer * D * 6144 + n0 + fr;
        f32x4 acc[9];
#pragma unroll
        for (int i = 0; i < 9; ++i) acc[i] = (f32x4){0.f, 0.f, 0.f, 0.f};
#pragma unroll 4
        for (int k0 = 0; k0 < D; k0 += 32) {
            float w[8];
#pragma unroll
            for (int i = 0; i < 8; ++i) w[i] = W[(size_t)(k0 + 8 * kq + i) * 6144];
            u32x4 bw; bw.x = cvtpk(w[0], w[1]); bw.y = cvtpk(w[2], w[3]); bw.z = cvtpk(w[4], w[5]); bw.w = cvtpk(w[6], w[7]);
            const bf16x8 bfrag = __builtin_bit_cast(bf16x8, bw);
#pragma unroll
            for (int mt = 0; mt < 9; ++mt) { const bf16x8 af = *(const bf16x8*)(sc + (size_t)(mt * 16 + fr) * D + k0 + 8 * kq);
                acc[mt] = __builtin_amdgcn_mfma_f32_16x16x32_bf16(af, bfrag, acc[mt], 0, 0, 0); }
        }
        const float bias = F.ada_b[layer * 6144 + n0 + fr];
#pragma unroll
        for (int mt = 0; mt < 9; ++mt)
#pragma unroll
            for (int e = 0; e < 4; ++e) { const int row = mt * 16 + 4 * kq + e; if (row < NMODB) mod[((size_t)layer * NMODB + row) * 6144 + n0 + fr] = acc[mt][e] + bias; }
    }
}

__device__ __forceinline__ void p1_compress_sample(Frame& F) {
    const int lane = F.lane, wave = F.wave, r32 = lane & 31, hi = lane >> 5, kvl = lane >> 4, c4 = lane & 15;
    LAS unsigned char* L = F.lds;
    const int wrow = wave * 4 + kvl, total = 2 * NSB * 8;
    const int nitem = (total - F.vcu + F.G - 1) / F.G; if (nitem <= 0) return;
    const int nstage = 2 * nitem;
#define CS_BAR() do { asm volatile("s_waitcnt lgkmcnt(0)" ::: "memory"); __builtin_amdgcn_s_barrier(); asm volatile("" ::: "memory"); } while (0)
#define CS_SRC(g, ptr) do { const int it_ = F.vcu + F.G * ((g) >> 1); const int wh_ = it_ / (NSB * 8), q_ = it_ % (NSB * 8), b_ = q_ >> 3, n_ = (q_ & 7) * 8 + wave; const int pg_ = F.page_table[b_ * 16 + (n_ >> 2)]; \
        ptr = uniform_ptr((wh_ ? F.cv_cmp : F.ck_cmp) + ((size_t)pg_ * 128 + (n_ & 3) * 32 + ((g) & 1) * 16) * 256); } while (0)
#define CS_LOAD(ptr) do { _Pragma("unroll") for (int jj = 0; jj < 16; ++jj) x[jj] = *(const f32x4*)((ptr) + (unsigned)(jj * 1024 + lane * 16)); } while (0)
#define CS_STORE(buf) do { _Pragma("unroll") for (int jj = 0; jj < 16; ++jj) { u32x2 w_; w_.x = cvtpk(x[jj][0], x[jj][1]); w_.y = cvtpk(x[jj][2], x[jj][3]); \
        *(LAS u32x2*)(L + (buf) * 65536 + wrow * 2048 + (((jj * 8 + (c4 >> 1)) ^ (wrow & 15)) << 4) + (c4 & 1) * 8) = w_; } } while (0)
    f32x4 x[16]; const char* sp;
    CS_SRC(0, sp); CS_LOAD(sp); CS_STORE(0); CS_BAR();
    f32x16 a0, a1;
#pragma unroll
    for (int r = 0; r < 16; ++r) { a0[r] = 0.f; a1[r] = 0.f; }
#pragma unroll 1
    for (int g = 0; g < nstage; ++g) {
        const int it = F.vcu + F.G * (g >> 1), which = it / (NSB * 8), q = it % (NSB * 8), b = q >> 3, n0 = (q & 7) * 8;
        const bf16_t* wp = (const bf16_t*)(F.ws + (which ? WS_WCV : WS_WCK)) + (size_t)r32 * 2048 + (g & 1) * 1024 + 128 * wave + 8 * hi;
        bf16x8 bfr[16];
#pragma unroll
        for (int ks = 0; ks < 8; ++ks) { bfr[2 * ks] = *(const bf16x8*)(wp + 16 * ks); bfr[2 * ks + 1] = *(const bf16x8*)(wp + 32 * 2048 + 16 * ks); }
        if (g + 1 < nstage) { CS_SRC(g + 1, sp); CS_LOAD(sp); }
        const LAS unsigned char* ab = L + (g & 1) * 65536 + r32 * 2048;
#pragma unroll
        for (int ks = 0; ks < 8; ++ks) { const bf16x8 af = *(const LAS bf16x8*)(ab + (((16 * wave + 2 * ks + hi) ^ (r32 & 15)) << 4));
            a0 = __builtin_amdgcn_mfma_f32_32x32x16_bf16(af, bfr[2 * ks], a0, 0, 0, 0); a1 = __builtin_amdgcn_mfma_f32_32x32x16_bf16(af, bfr[2 * ks + 1], a1, 0, 0, 0); }
        CS_BAR();
        if (g & 1) {
            LAS float* red = (LAS float*)(L + 65536) + wave * 2048 + hi * 256 + r32;
#pragma unroll
            for (int r = 0; r < 16; ++r) { red[CROW0(r) * 64] = a0[r]; red[CROW0(r) * 64 + 32] = a1[r]; a0[r] = 0.f; a1[r] = 0.f; }
            CS_BAR();
            { const int row = F.tid >> 4, cc = (F.tid & 15) * 4; f32x4 sacc = (f32x4){0.f, 0.f, 0.f, 0.f};
#pragma unroll
              for (int pp = 0; pp < 8; ++pp) sacc = sacc + *(const f32x4*)((const float*)(F.ws + WS_CB) + (which * 8 + pp) * 64 + cc);
#pragma unroll
              for (int w = 0; w < 8; ++w) sacc = sacc + *(const LAS f32x4*)((const LAS float*)(L + 65536) + w * 2048 + row * 64 + cc);
              bf16_t* o = (bf16_t*)(F.ws + (which ? WS_VCMPS : WS_KCMPS)) + (size_t)b * 4 * 64 * 64 + ((size_t)(row & 3) * 64 + n0 + (row >> 2)) * 64 + cc;
              u32x2 w2; w2.x = cvtpk(sacc[0], sacc[1]); w2.y = cvtpk(sacc[2], sacc[3]); *(u32x2*)o = w2; }
        }
        if (g + 1 < nstage) CS_STORE((g + 1) & 1);
        CS_BAR();
    }
    VM_WAIT(); __syncthreads();
#undef CS_BAR
#undef CS_SRC
#undef CS_LOAD
#undef CS_STORE
}
__device__ __forceinline__ void p4_compress_prompt(Frame& F) {
    const int lane = F.lane, r32 = lane & 31, hi = lane >> 5, nl = r32 >> 2, kv = r32 & 3;
    for (int it = F.vcu; it < 2 * NB * 16; it += F.G) {
        const int which = it / (NB * 16), q = it % (NB * 16), b = q >> 4, n0 = (q & 15) * 8, n = n0 + nl;
        const bf16_t* src = (const bf16_t*)(F.ws + WS_KV) + (size_t)which * KV_STRIDE + ((size_t)b * SEQ + (size_t)n * 32) * 256 + kv * 64;
        const bf16_t* Wt = (const bf16_t*)(F.ws + (which ? WS_WCV : WS_WCK));
        const bf16_t* w0 = Wt + (size_t)r32 * 2048 + hi * 8; const bf16_t* w1 = w0 + (size_t)32 * 2048;
        f32x16 a0, a1;
#pragma unroll
        for (int r = 0; r < 16; ++r) { a0[r] = 0.f; a1[r] = 0.f; }
#pragma unroll
        for (int jj = 0; jj < 4; ++jj) { const int j = F.wave * 4 + jj;
#pragma unroll
            for (int ds = 0; ds < 4; ++ds) { const bf16x8 af = *(const bf16x8*)(src + (size_t)j * 256 + ds * 16 + hi * 8);
                const bf16x8 b0 = *(const bf16x8*)(w0 + j * 64 + ds * 16), b1 = *(const bf16x8*)(w1 + j * 64 + ds * 16);
                a0 = __builtin_amdgcn_mfma_f32_32x32x16_bf16(af, b0, a0, 0, 0, 0); a1 = __builtin_amdgcn_mfma_f32_32x32x16_bf16(af, b1, a1, 0, 0, 0); } }
        LAS float* red = (LAS float*)F.lds + F.wave * 2048 + hi * 256 + r32;
#pragma unroll
        for (int r = 0; r < 16; ++r) { red[CROW0(r) * 64] = a0[r]; red[CROW0(r) * 64 + 32] = a1[r]; }
        LDS_WAIT(); __syncthreads();
        { const int row = F.tid >> 4, c4 = (F.tid & 15) * 4; f32x4 sacc = (f32x4){0.f, 0.f, 0.f, 0.f};
#pragma unroll
          for (int pp = 0; pp < 8; ++pp) sacc = sacc + *(const f32x4*)((const float*)(F.ws + WS_CB) + (which * 8 + pp) * 64 + c4);
#pragma unroll
          for (int w = 0; w < 8; ++w) sacc = sacc + *(const LAS f32x4*)((const LAS float*)F.lds + w * 2048 + row * 64 + c4);
          bf16_t* o = (bf16_t*)(F.ws + (which ? WS_VCMPP : WS_KCMPP)) + (size_t)b * 4 * 128 * 64 + ((size_t)(row & 3) * 128 + n0 + (row >> 2)) * 64 + c4;
          u32x2 w2; w2.x = cvtpk(sacc[0], sacc[1]); w2.y = cvtpk(sacc[2], sacc[3]); *(u32x2*)o = w2; }
        __syncthreads();
    }
}

__device__ __forceinline__ void small_gemm_res(Frame& F, const bf16_t* A  , int lda, const bf16_t* Wt, int ldb, int K, bool bd, const float* xin_s, float* xout_s, const float* gate, const float* scale) {
    const int lane = F.lane, r32 = lane & 31, hi = lane >> 5, kw = K >> 3, kbeg = F.wave * kw;
    for (int tile = F.vcu; tile < 256; tile += F.G) {
        const int row0 = (tile >> 4) * 32, col0 = (tile & 15) * 64, acol = bd ? (col0 >> 8) * 256 : 0;
        const bf16_t* ap = A + (size_t)(row0 + r32) * lda + acol + kbeg + 8 * hi;
        const bf16_t* b0p = Wt + (size_t)(col0 + r32) * ldb + kbeg + 8 * hi; const bf16_t* b1p = b0p + (size_t)32 * ldb;
        f32x16 c0, c1;
#pragma unroll
        for (int r = 0; r < 16; ++r) { c0[r] = 0.f; c1[r] = 0.f; }
#pragma unroll 8
        for (int ks = 0; ks < kw; ks += 16) { const bf16x8 a = *(const bf16x8*)(ap + ks), b0 = *(const bf16x8*)(b0p + ks), b1 = *(const bf16x8*)(b1p + ks);
            c0 = __builtin_amdgcn_mfma_f32_32x32x16_bf16(a, b0, c0, 0, 0, 0); c1 = __builtin_amdgcn_mfma_f32_32x32x16_bf16(a, b1, c1, 0, 0, 0); }
        LAS float* red = (LAS float*)F.lds + F.wave * 2048 + hi * 256 + r32;
#pragma unroll
        for (int r = 0; r < 16; ++r) { red[CROW0(r) * 64] = c0[r]; red[CROW0(r) * 64 + 32] = c1[r]; }
        LDS_WAIT(); __syncthreads();
        { const int row = F.tid >> 4, c4 = (F.tid & 15) * 4; f32x4 sacc = (f32x4){0.f, 0.f, 0.f, 0.f};
#pragma unroll
          for (int w = 0; w < 8; ++w) sacc = sacc + *(const LAS f32x4*)((const LAS float*)F.lds + w * 2048 + row * 64 + c4);
          const int rs = row0 + row, col = col0 + c4, bb = NB + (rs >> 2);
          f32x4 g4 = *(const f32x4*)(gate + (size_t)bb * 6144 + col); if (scale) g4 = g4 * *(const f32x4*)(scale + col);
          const f32x4 x4 = *(const f32x4*)(xin_s + (size_t)rs * D + col); *(f32x4*)(xout_s + (size_t)rs * D + col) = x4 + g4 * sacc; }
        __syncthreads();
    }
}

template <int MODE, int NR>
__device__ __forceinline__ void norm_rows(Frame& F, bool from_inputs, int layer, int which, int row0, const f32x4 (&gg)[4], int lane) {
    const float* X = (const float*)(F.ws + WS_X);
    const float* xr = from_inputs ? (row0 < MP ? F.x_p + (size_t)row0 * D : F.x_s + (size_t)(row0 - MP) * D) : X + (size_t)row0 * D;
    f32x4 v[NR][4];
#pragma unroll
    for (int r = 0; r < NR; ++r)
#pragma unroll
        for (int j = 0; j < 4; ++j) v[r][j] = *(const f32x4*)(xr + (size_t)r * D + 4 * lane + 256 * j);
    f32x4 sh[4], sc[4];
    if constexpr (MODE != 2) {
        const int bb = row0 < MP ? (row0 >> 12) : NB + ((row0 - MP) >> 2);
        const float* mp = (const float*)(F.ws + WS_MOD) + ((size_t)layer * NMODB + bb) * 6144 + (which ? 3072 : 0);
#pragma unroll
        for (int j = 0; j < 4; ++j) { sh[j] = *(const f32x4*)(mp + 4 * lane + 256 * j); sc[j] = *(const f32x4*)(mp + 1024 + 4 * lane + 256 * j) + 1.0f; }
    }
    float ss[NR];
#pragma unroll
    for (int r = 0; r < NR; ++r) { float a = 0.f;
#pragma unroll
        for (int j = 0; j < 4; ++j) a += (v[r][j][0] * v[r][j][0] + v[r][j][1] * v[r][j][1]) + (v[r][j][2] * v[r][j][2] + v[r][j][3] * v[r][j][3]);
        ss[r] = a; }
#pragma unroll
    for (int o = 1; o < 64; o <<= 1) {
#pragma unroll
        for (int r = 0; r < NR; ++r) ss[r] += __shfl_xor(ss[r], o); }
#pragma unroll
    for (int r = 0; r < NR; ++r) {
        const int row = row0 + r; const float rstd = 1.0f / sqrtf(ss[r] * (1.0f / D) + 1e-6f);
        if constexpr (MODE == 2) {
            float* o = row < MP ? F.out + O_YP + (size_t)row * D : F.out + O_YS + (size_t)(row - MP) * D;
#pragma unroll
            for (int j = 0; j < 4; ++j) *(f32x4*)(o + 4 * lane + 256 * j) = v[r][j] * rstd * gg[j];
        } else {
            float* pool_dst = nullptr;
            if constexpr (MODE == 1) {
                if (row < MP) { const int tt = row & (SEQ - 1); if (tt >= SEQ - 15) pool_dst = F.out + O_PLP + ((size_t)(row >> 12) * 15 + (tt - (SEQ - 15))) * D; }
                else { const int rs = row - MP; pool_dst = F.out + O_PLS + ((size_t)(rs >> 2) * 15 + 11 + (rs & 3)) * D; }
            }
#pragma unroll
            for (int j = 0; j < 4; ++j) { const int col = 4 * lane + 256 * j; const f32x4 h = (v[r][j] * rstd * gg[j]) * sc[j] + sh[j];
                if constexpr (MODE == 0) { u32x2 w; w.x = cvtpk(h[0], h[1]); w.y = cvtpk(h[2], h[3]); *(u32x2*)((bf16_t*)(F.ws + WS_H) + (size_t)row * D + col) = w; }
                else { *(f32x4*)((float*)(F.ws + WS_HF) + (size_t)row * D + col) = h; if (pool_dst) *(f32x4*)(pool_dst + col) = h; } }
        }
    }
}
template <int MODE>
__device__ __forceinline__ void norm_phase(Frame& F, bool from_inputs, int layer, int which) {
    const int gw = F.vcu * 8 + F.wave, NGW = F.G * 8, lane = F.lane;
    const float* gvec = MODE == 2 ? F.final_g : F.norm_g + (size_t)(layer * 2 + which) * D;
    f32x4 gg[4];
#pragma unroll
    for (int j = 0; j < 4; ++j) gg[j] = *(const f32x4*)(gvec + 4 * lane + 256 * j);
#pragma unroll 1
    for (int grp = gw; grp < MP / 8; grp += NGW) norm_rows<MODE, 8>(F, from_inputs, layer, which, grp * 8, gg, lane);
#pragma unroll 1
    for (int r = gw; r < MS; r += NGW) norm_rows<MODE, 1>(F, from_inputs, layer, which, MP + r, gg, lane);
}

template <int W, int R, bool SAMPLE>
__device__ __forceinline__ void pool_chunk(const float* HF, const float* st_pool, bf16_t* H, int row0, int col) {
    f32x4 v[R + W - 1];
    const int t0 = SAMPLE ? 0 : (row0 & (SEQ - 1));
#pragma unroll
    for (int k = 0; k < R + W - 1; ++k) { const int tt = t0 - (W - 1) + k;
        if (SAMPLE) { const int b = (row0 - MP) >> 2; v[k] = tt >= 0 ? *(const f32x4*)(HF + (size_t)(row0 + tt) * D + col) : *(const f32x4*)(st_pool + ((size_t)b * 15 + 15 + tt) * D + col); }
        else v[k] = tt >= 0 ? *(const f32x4*)(HF + (size_t)(row0 - (W - 1) + k) * D + col) : (f32x4){0.f, 0.f, 0.f, 0.f}; }
    f32x4 sacc = v[0];
#pragma unroll
    for (int k = 1; k < W; ++k) sacc = sacc + v[k];
#pragma unroll
    for (int r = 0; r < R; ++r) {
        if (r > 0) sacc = sacc + v[r + W - 1] - v[r - 1];
        const int tt = t0 + r; const float inv = 1.0f / (float)(SAMPLE ? W : (tt + 1 < W ? tt + 1 : W));
        const f32x4 cur = v[r + W - 1], pv = sacc * inv - cur;
        u32x2 w2; w2.x = cvtpk(pv[0], pv[1]); w2.y = cvtpk(pv[2], pv[3]); *(u32x2*)(H + (size_t)(row0 + r) * D + col) = w2; }
}
__device__ __forceinline__ void pool_phase(Frame& F) {
    const int gt = (F.vcu * 8 + F.wave) * 64 + F.lane, NT = F.G * 512;
    const float* HF = (const float*)(F.ws + WS_HF); bf16_t* H = (bf16_t*)(F.ws + WS_H);
    constexpr int NPI = (MP / 8) * 256, NSI = (MS / 4) * 256;
#pragma unroll 1
    for (int i = gt; i < NPI + NSI; i += NT) {
        const bool smp = i >= NPI; const int q = smp ? i - NPI : i; const int cg = q & 255, col = cg * 4, grp = cg >> 6;
        if (!smp) { const int row0 = (q >> 8) * 8;
            if (grp == 0) pool_chunk<2, 8, false>(HF, F.st_pool, H, row0, col); else if (grp == 1) pool_chunk<4, 8, false>(HF, F.st_pool, H, row0, col);
            else if (grp == 2) pool_chunk<8, 8, false>(HF, F.st_pool, H, row0, col); else pool_chunk<16, 8, false>(HF, F.st_pool, H, row0, col); }
        else { const int row0 = MP + (q >> 8) * 4;
            if (grp == 0) pool_chunk<2, 4, true>(HF, F.st_pool, H, row0, col); else if (grp == 1) pool_chunk<4, 4, true>(HF, F.st_pool, H, row0, col);
            else if (grp == 2) pool_chunk<8, 4, true>(HF, F.st_pool, H, row0, col); else pool_chunk<16, 4, true>(HF, F.st_pool, H, row0, col); }
    }
}

namespace att {
__device__ __forceinline__ int crow(int r, int hi) { return (r & 3) + 8 * (r >> 2) + 4 * hi; }
__device__ __forceinline__ float x32_sum(float v) { auto rr = __builtin_amdgcn_permlane32_swap(__float_as_uint(v), __float_as_uint(v), false, false); return __uint_as_float(rr[0]) + __uint_as_float(rr[1]); }
__device__ __forceinline__ float x32_max(float v) { auto rr = __builtin_amdgcn_permlane32_swap(__float_as_uint(v), __float_as_uint(v), false, false); return fmaxf(__uint_as_float(rr[0]), __uint_as_float(rr[1])); }
__device__ __forceinline__ unsigned x32_or(unsigned v) { auto rr = __builtin_amdgcn_permlane32_swap(v, v, false, false); return rr[0] | rr[1]; }
template <int X> __device__ __forceinline__ unsigned swz_xor(unsigned v) { return (unsigned)__builtin_amdgcn_ds_swizzle((int)v, (X << 10) | 0x1F); }
template <int X> __device__ __forceinline__ float swz_xorf(float v) { return __uint_as_float(swz_xor<X>(__float_as_uint(v))); }
__device__ __forceinline__ s16x4 vtr(const LAS unsigned char* p) { typedef short v4i16_t __attribute__((ext_vector_type(4))); return __builtin_bit_cast(s16x4, __builtin_amdgcn_ds_read_tr16_b64_v4i16((LAS v4i16_t*)p)); }
__device__ __forceinline__ void qk_tile(f32x16& p0, f32x16& p1, const LAS unsigned char* Kb, const bf16x8 (&qr)[4], float init, int r32, int hi) {
    f32x16 ci;
#pragma unroll
    for (int r = 0; r < 16; ++r) ci[r] = init;
    const int sw = (r32 >> 1) & 7;
    bf16x8 ka[4], kb[4];
#pragma unroll
    for (int ds = 0; ds < 4; ++ds) { const int ch = ((2 * ds + hi) ^ sw) << 4; ka[ds] = *(const LAS bf16x8*)(Kb + r32 * 128 + ch); kb[ds] = *(const LAS bf16x8*)(Kb + (32 + r32) * 128 + ch); }
    __builtin_amdgcn_s_setprio(1);
    f32x16 c0 = __builtin_amdgcn_mfma_f32_32x32x16_bf16(ka[0], qr[0], ci, 0, 0, 0);
    f32x16 c1 = __builtin_amdgcn_mfma_f32_32x32x16_bf16(kb[0], qr[0], ci, 0, 0, 0);
#pragma unroll
    for (int ds = 1; ds < 4; ++ds) {
        c0 = __builtin_amdgcn_mfma_f32_32x32x16_bf16(ka[ds], qr[ds], c0, 0, 0, 0);
        c1 = __builtin_amdgcn_mfma_f32_32x32x16_bf16(kb[ds], qr[ds], c1, 0, 0, 0);
    }
    __builtin_amdgcn_s_setprio(0);
    p0 = c0; p1 = c1;
}
__device__ __forceinline__ void pv_tile(f32x16 (&o)[2], const LAS unsigned char* Vb, const f32x16& p0, const f32x16& p1, int lane) {
    const int g4 = lane >> 4, nhalf = g4 & 1, h = g4 >> 1, i = lane & 15, q = i >> 2, pp = i & 3;
    const LAS unsigned char* vb = Vb + (4 * h + q) * 64 + nhalf * 32 + pp * 8;
#pragma unroll
    for (int kh = 0; kh < 2; ++kh) {
        s16x4 lo[2][2], hh[2][2];
#pragma unroll
        for (int s = 0; s < 2; ++s)
#pragma unroll
            for (int db = 0; db < 2; ++db) { lo[s][db] = vtr(vb + db * 4096 + (32 * kh + 16 * s) * 64); hh[s][db] = vtr(vb + db * 4096 + (32 * kh + 16 * s + 8) * 64); }
#pragma unroll
        for (int s = 0; s < 2; ++s) {
            const f32x16& p = kh ? p1 : p0; u32x4 pw;
            pw.x = cvtpk(p[8 * s + 0], p[8 * s + 1]); pw.y = cvtpk(p[8 * s + 2], p[8 * s + 3]); pw.z = cvtpk(p[8 * s + 4], p[8 * s + 5]); pw.w = cvtpk(p[8 * s + 6], p[8 * s + 7]);
            const bf16x8 pa = __builtin_bit_cast(bf16x8, pw);
#pragma unroll
            for (int db = 0; db < 2; ++db) {
                const bf16x8 vf = (bf16x8){lo[s][db][0], lo[s][db][1], lo[s][db][2], lo[s][db][3], hh[s][db][0], hh[s][db][1], hh[s][db][2], hh[s][db][3]};
                o[db] = __builtin_amdgcn_mfma_f32_32x32x16_bf16(pa, vf, o[db], 0, 0, 0);
            }
        }
    }
}
__device__ __forceinline__ void row_scale(f32x16 (&o)[2], float f, LAS float* wsf, int r32, int hi) {
    if (hi == 0) wsf[r32] = f;
    LDS_WAIT();
    const LAS float* wh = wsf + 4 * hi;
#pragma unroll
    for (int r = 0; r < 16; ++r) { const float fr = wh[CROW0(r)]; o[0][r] *= fr; o[1][r] *= fr; }
    LDS_WAIT();
}
__device__ __forceinline__ void row_fma(f32x16 (&dst)[2], const f32x16 (&o)[2], float f, LAS float* wsf, int r32, int hi) {
    if (hi == 0) wsf[r32] = f;
    LDS_WAIT();
    const LAS float* wh = wsf + 4 * hi;
#pragma unroll
    for (int r = 0; r < 16; ++r) { const float fr = wh[CROW0(r)]; dst[0][r] += fr * o[0][r]; dst[1][r] += fr * o[1][r]; }
    LDS_WAIT();
}
__device__ __forceinline__ void softmax_update(f32x16& p0, f32x16& p1, float& m, float& l, f32x16 (&o)[2], LAS float* wsf, int r32, int hi) {
    float rm = fmaxf(p0[0], p1[0]);
#pragma unroll
    for (int r = 1; r < 16; ++r) rm = fmaxf(rm, fmaxf(p0[r], p1[r]));
    rm = x32_max(rm);
    const float mn = fmaxf(m, rm), f = ex2(m - mn);
    m = mn; float s = 0.f;
#pragma unroll
    for (int r = 0; r < 16; ++r) { p0[r] = ex2(p0[r] - mn); p1[r] = ex2(p1[r] - mn); s += p0[r] + p1[r]; }
    l = l * f + s;
    if (__any(f != 1.0f)) row_scale(o, f, wsf, r32, hi);
}
__device__ __forceinline__ void softmax_full(f32x16& a0, f32x16& a1, f32x16& b0, f32x16& b1) {
    float rm = -1e30f;
#pragma unroll
    for (int r = 0; r < 16; ++r) rm = fmaxf(rm, fmaxf(fmaxf(a0[r], a1[r]), fmaxf(b0[r], b1[r])));
    rm = x32_max(rm); float s = 0.f;
#pragma unroll
    for (int r = 0; r < 16; ++r) { a0[r] = ex2(a0[r] - rm); a1[r] = ex2(a1[r] - rm); b0[r] = ex2(b0[r] - rm); b1[r] = ex2(b1[r] - rm); s += (a0[r] + a1[r]) + (b0[r] + b1[r]); }
    s = x32_sum(s);
    const float inv = s > 0.f ? 1.0f / s : 0.f;
#pragma unroll
    for (int r = 0; r < 16; ++r) { a0[r] *= inv; a1[r] *= inv; b0[r] *= inv; b1[r] *= inv; }
}
__device__ __forceinline__ unsigned imp_key(float v, int j, int c) {
    const bool forced = (j == 0) | (j == c) | (j == c - 1);
    const unsigned base = forced ? 0x7F000000u : (j <= c ? (__float_as_uint(v) & 0xFFFFFFC0u) : 0u);
    return base | (unsigned)(63 - j);
}
__device__ __forceinline__ void imp_store(const f32x16& p0, const f32x16& p1, int T, LAS unsigned* impq  , int c, int g, int hi) {
#pragma unroll
    for (int kh = 0; kh < 2; ++kh)
#pragma unroll
        for (int a = 0; a < 4; ++a) {
            const f32x16& p = kh ? p1 : p0; float e0 = p[4 * a] + p[4 * a + 1], e1 = p[4 * a + 2] + p[4 * a + 3];
            e0 += swz_xorf<8>(e0); e0 += swz_xorf<16>(e0); e1 += swz_xorf<8>(e1); e1 += swz_xorf<16>(e1);
            const int jc = 32 * T + 16 * kh + 4 * a, j0 = jc + 2 * hi;
            if (g == 0) { u32x2 w; w.x = imp_key(e0, j0, c); w.y = imp_key(e1, j0 + 1, c); *(LAS u32x2*)(impq + 2 * hi + jc) = w; }
        }
}
__device__ __forceinline__ unsigned long long select_mask(const LAS unsigned* impq, int g, int hi) {
    LDS_WAIT();
    unsigned mk[8], cnt[8];
#pragma unroll
    for (int a = 0; a < 4; ++a) { const u32x2 w = *(const LAS u32x2*)(impq + (16 * g + 2 * hi) + 4 * a); mk[2 * a] = w.x; mk[2 * a + 1] = w.y; cnt[2 * a] = 0; cnt[2 * a + 1] = 0; }
#pragma unroll 4
    for (int jj = 0; jj < 16; ++jj) { const u32x4 kx = *(const LAS u32x4*)(impq + 4 * jj);
#pragma unroll
        for (int ci = 0; ci < 8; ++ci) cnt[ci] += (unsigned)(kx.x > mk[ci]) + (unsigned)(kx.y > mk[ci]) + (unsigned)(kx.z > mk[ci]) + (unsigned)(kx.w > mk[ci]); }
    unsigned lb = 0u;
#pragma unroll
    for (int a = 0; a < 4; ++a)
#pragma unroll
        for (int e = 0; e < 2; ++e) lb |= (cnt[2 * a + e] < 16u ? 1u : 0u) << (4 * a + e);
    const unsigned long long mm = (unsigned long long)lb << (16 * g + 2 * hi);
    unsigned lo = (unsigned)mm, hh = (unsigned)(mm >> 32);
    lo |= swz_xor<8>(lo); hh |= swz_xor<8>(hh); lo |= swz_xor<16>(lo); hh |= swz_xor<16>(hh); lo = x32_or(lo); hh = x32_or(hh);
    return ((unsigned long long)hh << 32) | lo;
}
__device__ __forceinline__ unsigned long long wave_or64(unsigned long long m) {
    unsigned lo = (unsigned)m, hh = (unsigned)(m >> 32);
    lo |= swz_xor<1>(lo); hh |= swz_xor<1>(hh); lo |= swz_xor<2>(lo); hh |= swz_xor<2>(hh); lo |= swz_xor<4>(lo); hh |= swz_xor<4>(hh);
    lo |= swz_xor<8>(lo); hh |= swz_xor<8>(hh); lo |= swz_xor<16>(lo); hh |= swz_xor<16>(hh); lo = x32_or(lo); hh = x32_or(hh);
    return ((unsigned long long)(unsigned)__builtin_amdgcn_readfirstlane(hh) << 32) | (unsigned)__builtin_amdgcn_readfirstlane(lo);
}
__device__ __forceinline__ void mask_bias(f32x16& p0, f32x16& p1, int t, int pos0, int stride, int wlim, bool sel, bool near, const LAS float* lut, int hi) {
#pragma unroll
    for (int kh = 0; kh < 2; ++kh)
#pragma unroll
        for (int r = 0; r < 16; ++r) { const int kk = 32 * kh + crow(r, hi), dist = t - pos0 - stride * kk; const bool ok = sel && dist >= 0 && dist < wlim;
            float bv = 0.f; if (near) { const int di = dist < 0 ? 0 : (dist > 127 ? 127 : dist); bv = lut[di]; }
            if (kh) p1[r] = ok ? p1[r] + bv : -INFINITY; else p0[r] = ok ? p0[r] + bv : -INFINITY; }
}
template <bool CAUSAL>
__device__ __forceinline__ void mask_bias_near(f32x16& p0, f32x16& p1, int t, int pos0, bool sel, const LAS float* xlg, int hi) {
    const int dist0 = t - pos0 - 4 * hi;
    const LAS float* bp = xlg + (dist0 + 4);
#pragma unroll
    for (int kh = 0; kh < 2; ++kh)
#pragma unroll
        for (int r = 0; r < 16; ++r) { const int kc = 32 * kh + CROW0(r); const float bv = bp[63 - kc]; bool ok = sel; if (CAUSAL) ok = ok && (dist0 - kc >= 0);
            if (kh) p1[r] = ok ? p1[r] + bv : -INFINITY; else p0[r] = ok ? p0[r] + bv : -INFINITY; }
}
struct Ptrs { const bf16_t *Q, *kcp, *vcp, *kcs, *vcs, *KS, *VS, *KW, *VW; const float* gates; bf16_t* O; const float *ck_sel, *cv_sel, *st_kw, *st_vw; const int* pt; int gov; float* kw_out; float* vw_out; };
#ifdef VERIFY
#define GATEV(P, row, head, br) ((P).gov < 0 ? sigmoidf_((P).gates[(size_t)(row) * 48 + (head) * 3 + (br)]) : ((P).gov == (br) ? 1.0f : 0.0f))
#else
#define GATEV(P, row, head, br) sigmoidf_((P).gates[(size_t)(row) * 48 + (head) * 3 + (br)])
#endif

template <bool ACC>
__device__ __forceinline__ void row_out(LAS float* ow, const f32x16 (&o)[2], float f, LAS float* wsf, int r32, int hi) {
    if (hi == 0) wsf[r32] = f;
    LDS_WAIT();
    const LAS float* wh = wsf + 4 * hi; LAS float* ob = ow + hi * 256 + r32;
#pragma unroll
    for (int r = 0; r < 16; ++r) { const float fr = wh[CROW0(r)]; LAS float* p = ob + CROW0(r) * 64;
        if (ACC) { p[0] += fr * o[0][r]; p[32] += fr * o[1][r]; } else { p[0] = fr * o[0][r]; p[32] = fr * o[1][r]; } }
    LDS_WAIT();
}
template <bool NEXT>
__device__ __forceinline__ void tile_block(f32x16& s0, f32x16& s1, f32x16& n0, f32x16& n1, const LAS unsigned char* KBn, float ninit, const LAS unsigned char* VB, const bf16x8 (&qr)[4],
                                           float m, float& l, f32x16 (&o)[2], int lane, int r32, int hi) {
    if (NEXT) qk_tile(n0, n1, KBn, qr, ninit, r32, hi);
    float sacc = 0.f;
#pragma unroll
    for (int r = 0; r < 16; ++r) { s0[r] = ex2(s0[r] - m); s1[r] = ex2(s1[r] - m); sacc += s0[r] + s1[r]; }
    l += sacc;
    pv_tile(o, VB, s0, s1, lane);
}
#define AS_SBAR() __builtin_amdgcn_sched_barrier(0)
#define AS_PIN(x) asm volatile("" : "+v"(x))
#define AS_MFMA(a, b, c) __builtin_amdgcn_mfma_f32_32x32x16_bf16(a, b, c, 0, 0, 0)
#define AS_WAIT_BAR(N) asm volatile("s_waitcnt vmcnt(" #N ") lgkmcnt(0)\n\ts_barrier" ::: "memory")
#define AS_MX3(a, b, c) __builtin_fmaxf(__builtin_fmaxf((a), (b)), (c))
__device__ __forceinline__ void as_glds16(const void* gsrc, unsigned lds_base) {
    unsigned sv; asm volatile("s_mov_b32 %0, m0\n\ts_mov_b32 m0, %2\n\ts_nop 0\n\tglobal_load_lds_dwordx4 %1, off\n\ts_mov_b32 m0, %0" : "=&s"(sv) : "v"(gsrc), "s"(lds_base) : "memory"); }
__device__ __forceinline__ void as_kload2(bf16x8* kf, const LAS unsigned char* kp, int d0) { kf[2 * d0] = *(const LAS bf16x8*)(kp + d0 * 2048); kf[2 * d0 + 1] = *(const LAS bf16x8*)(kp + d0 * 2048 + 512); }
__device__ __forceinline__ float as_rowmax(const f32x16& p0, const f32x16& p1) {
    float a = AS_MX3(p0[0], p0[1], p1[0]), b = AS_MX3(p0[2], p0[3], p1[1]); a = AS_MX3(a, p1[2], p1[3]);
#pragma unroll
    for (int r = 4; r < 16; r += 4) { a = AS_MX3(a, p0[r], p0[r + 1]); b = AS_MX3(b, p0[r + 2], p0[r + 3]); a = AS_MX3(a, p1[r], p1[r + 1]); b = AS_MX3(b, p1[r + 2], p1[r + 3]); }
    return x32_max(__builtin_fmaxf(a, b)); }
template <bool WIN>
__device__ __forceinline__ float as_mask(f32x16& c0, f32x16& c1, int u, int j0, int nreal, int c, int t, unsigned long long mymask, float bfar, const LAS float* xlg, const LAS float* lut, int hi) {
    const int j = j0 + u;
    if (u >= nreal) {
#pragma unroll
        for (int r = 0; r < 16; ++r) { c0[r] = -INFINITY; c1[r] = -INFINITY; }
        return 0.f; }
    const bool sel = WIN || ((mymask >> j) & 1ull);
    if (j >= c - 2) { if (j == c) mask_bias_near<true>(c0, c1, t, 64 * j, sel, xlg, hi); else mask_bias_near<false>(c0, c1, t, 64 * j, sel, xlg, hi); return 0.f; }
    if (WIN) { if (j == c - 8) mask_bias(c0, c1, t, 64 * j, 1, 512, true, false, lut, hi); }
    else {
#pragma unroll
        for (int r = 0; r < 16; ++r) { c0[r] = sel ? c0[r] : -INFINITY; c1[r] = sel ? c1[r] : -INFINITY; } }
    return bfar;
}
template <bool WIN, bool ACC>
__device__ __forceinline__ void attn_stream(const bf16_t* kbase  , const bf16_t* vbase, int j0, int nreal, int NT, int c, int t, unsigned long long mymask,
                                            const bf16x8 (&qr)[4], float bfar, const LAS float* xlg, const LAS float* lut, float gate, LAS unsigned char* L, LAS float* wsf, LAS float* ow, int wave, int lane) {
    constexpr int SLOTB = 8192, LDS_K = 0, LDS_V = 3 * SLOTB;
    const int r32 = lane & 31, hi = lane >> 5;
    const unsigned lds0 = (unsigned)(unsigned long long)L;
    const int jlast = j0 + nreal - 1;
    const bf16_t* ksrc = kbase + (size_t)lane * 256 + wave * 8;
    const bf16_t* vsrc = vbase + (size_t)(16 * (wave & 3) + (lane >> 2)) * 256 + (wave >> 2) * 32 + (lane & 3) * 8;
    const unsigned kdst = lds0 + LDS_K + wave * 1024, vdst = lds0 + LDS_V + wave * 1024;
#define AS_JT(u) ((j0 + (u)) > jlast ? jlast : (j0 + (u)))
#define AS_DMA_K(u, slot) as_glds16(ksrc + (size_t)AS_JT(u) * (64 * 256), (unsigned)__builtin_amdgcn_readfirstlane((int)(kdst + (slot))))
#define AS_DMA_V(u, slot) as_glds16(vsrc + (size_t)AS_JT(u) * (64 * 256), (unsigned)__builtin_amdgcn_readfirstlane((int)(vdst + (slot))))
    const LAS unsigned char* vp0 = L + LDS_V + ((lane >> 4) & 1) * 32 + (lane & 3) * 8 + (4 * hi + ((lane & 15) >> 2)) * 64;
    const LAS unsigned char* kp0 = L + LDS_K + hi * 1024 + r32 * 16;
    AS_DMA_K(0, 0); AS_DMA_V(0, 0); AS_DMA_K(1, SLOTB); AS_DMA_K(2, 2 * SLOTB);
    float mhat = 0.f, l_reg = 0.f; f32x16 o[2];
#pragma unroll
    for (int r = 0; r < 16; ++r) { o[0][r] = 0.f; o[1][r] = 0.f; }
    const f32x16 zero16 = {0.f, 0.f, 0.f, 0.f, 0.f, 0.f, 0.f, 0.f, 0.f, 0.f, 0.f, 0.f, 0.f, 0.f, 0.f, 0.f};
    bool resc = false;
    f32x16 pA0, pA1, pB0, pB1; bf16x8 kf[8]; s16x4 vlo[8], vhi[8]; u32x4 pw0, pw1, pw2, pw3;
    int sl_prev = 0, sl_cur = 0, sl_next = SLOTB;
#define AS_ROT() do { sl_prev = sl_cur; sl_cur = sl_next; sl_next = (sl_next == 2 * SLOTB) ? 0 : sl_next + SLOTB; } while (0)
#define AS_EX(v) __builtin_amdgcn_exp2f((v) + nmh)
#define AS_RESC() do { if (resc) { const LAS float* wh_ = wsf + 4 * hi; _Pragma("unroll") for (int d_ = 0; d_ < 2; ++d_) _Pragma("unroll") for (int r = 0; r < 16; ++r) o[d_][r] *= wh_[CROW0(r)]; } } while (0)
    AS_WAIT_BAR(3);
#pragma unroll
    for (int d0 = 0; d0 < 4; ++d0) as_kload2(kf, kp0, d0);
    pA0 = AS_MFMA(kf[0], qr[0], zero16); pA1 = AS_MFMA(kf[1], qr[0], zero16); pA0 = AS_MFMA(kf[2], qr[1], pA0); pA1 = AS_MFMA(kf[3], qr[1], pA1);
    pA0 = AS_MFMA(kf[4], qr[2], pA0); pA1 = AS_MFMA(kf[5], qr[2], pA1); pA0 = AS_MFMA(kf[6], qr[3], pA0); pA1 = AS_MFMA(kf[7], qr[3], pA1);
    { const float bc = as_mask<WIN>(pA0, pA1, 0, j0, nreal, c, t, mymask, bfar, xlg, lut, hi);
      const float rm = as_rowmax(pA0, pA1) + bc; mhat = __builtin_fmaxf(rm, -60.f); const float nmh = bc - mhat;
#pragma unroll
      for (int r = 0; r < 16; ++r) { pA0[r] = AS_EX(pA0[r]); pA1[r] = AS_EX(pA1[r]); } }
    AS_WAIT_BAR(0);
    AS_DMA_K(3, 0); AS_DMA_V(1, SLOTB); AS_ROT();
#pragma unroll
    for (int d0 = 0; d0 < 4; ++d0) as_kload2(kf, kp0 + sl_cur, d0);
    AS_WAIT_BAR(2);
#define AS_PKW(P, i) cvtpk(P[i], P[i + 1])
#define AS_PAF(k) __builtin_bit_cast(bf16x8, pw##k)
#define AS_VFR(i) (bf16x8){vlo[i][0], vlo[i][1], vlo[i][2], vlo[i][3], vhi[i][0], vhi[i][1], vhi[i][2], vhi[i][3]}
#define AS_VRD(i) do { vlo[i] = vtr(vp_ + (((i) >> 2) * 4096 + ((i) & 3) * 1024)); vhi[i] = vtr(vp_ + (((i) >> 2) * 4096 + ((i) & 3) * 1024 + 512)); } while (0)
#define AS_KRD(G, d0) do { if (G) { as_kload2(kf, kp0 + sl_next, d0); AS_SBAR(); } } while (0)
#define AS_GAPA(MF, a0, a1, a2, a3, W0, W1, PW) do { MF; sacc += a0; sacc += a1; sacc += a2; sacc += a3; W0; W1; AS_PIN(PW); AS_PIN(sacc); AS_SBAR(); } while (0)
#define AS_GAPB(MF, X, i) do { MF; X[i] = AS_EX(X[i]); X[i + 1] = AS_EX(X[i + 1]); X[i + 2] = AS_EX(X[i + 2]); X[i + 3] = AS_EX(X[i + 3]); AS_PIN(X); AS_SBAR(); } while (0)
#define AS_STEP(C0, C1, P0, P1, tt, MASK, GK, GV, GL) do { AS_SBAR(); \
    const LAS unsigned char* vp_ = vp0 + sl_prev; \
    AS_VRD(0); AS_SBAR(); float sacc = P0[0] + P0[1]; \
                    AS_GAPA(C0 = AS_MFMA(kf[0], qr[0], zero16), P0[2], P0[3], P0[4], P0[5],     pw0[0] = AS_PKW(P0, 0),  pw0[1] = AS_PKW(P0, 2),  pw0); \
    AS_VRD(4); AS_SBAR(); AS_GAPA(C1 = AS_MFMA(kf[1], qr[0], zero16), P0[6], P0[7], P0[8], P0[9],     pw0[2] = AS_PKW(P0, 4),  pw0[3] = AS_PKW(P0, 6),  pw0); \
    AS_VRD(1); AS_SBAR(); AS_GAPA(C0 = AS_MFMA(kf[2], qr[1], C0),    P0[10], P0[11], P0[12], P0[13], pw1[0] = AS_PKW(P0, 8),  pw1[1] = AS_PKW(P0, 10), pw1); \
    AS_VRD(5); AS_SBAR(); AS_GAPA(C1 = AS_MFMA(kf[3], qr[1], C1),    P0[14], P0[15], P1[0], P1[1],   pw1[2] = AS_PKW(P0, 12), pw1[3] = AS_PKW(P0, 14), pw1); \
    AS_VRD(2); AS_SBAR(); AS_GAPA(C0 = AS_MFMA(kf[4], qr[2], C0),    P1[2], P1[3], P1[4], P1[5],     pw2[0] = AS_PKW(P1, 0),  pw2[1] = AS_PKW(P1, 2),  pw2); \
    AS_VRD(6); AS_SBAR(); AS_GAPA(C1 = AS_MFMA(kf[5], qr[2], C1),    P1[6], P1[7], P1[8], P1[9],     pw2[2] = AS_PKW(P1, 4),  pw2[3] = AS_PKW(P1, 6),  pw2); \
    AS_VRD(3); AS_SBAR(); AS_GAPA(C0 = AS_MFMA(kf[6], qr[3], C0),    P1[10], P1[11], P1[12], P1[13], pw3[0] = AS_PKW(P1, 8),  pw3[1] = AS_PKW(P1, 10), pw3); \
    AS_VRD(7); AS_SBAR(); AS_GAPA(C1 = AS_MFMA(kf[7], qr[3], C1),    P1[14], P1[15], 0.f, 0.f,       pw3[2] = AS_PKW(P1, 12), pw3[3] = AS_PKW(P1, 14), pw3); \
    l_reg += sacc; \
    if (GK) AS_DMA_K((tt) + 3, sl_cur); if (GV) AS_DMA_V((tt) + 1, sl_next); \
    float bc_ = bfar; bool sel_ = true; \
    if (MASK) bc_ = as_mask<WIN>(C0, C1, (tt), j0, nreal, c, t, mymask, bfar, xlg, lut, hi); \
    else if (!WIN) sel_ = (mymask >> (j0 + (tt))) & 1ull;            \
    { const float rm = as_rowmax(C0, C1) + bc_ - mhat; resc = false; \
      if (__builtin_expect(__any(rm > 8.0f), 0)) { const float dl = __builtin_fmaxf(rm, 0.f); mhat += dl; \
          const float f = __builtin_amdgcn_exp2f(-dl); l_reg *= f; if (hi == 0) wsf[r32] = f; resc = true; } } \
    const float nmh = sel_ ? bc_ - mhat : -INFINITY; AS_SBAR(); \
    AS_GAPB(o[0] = AS_MFMA(AS_PAF(0), AS_VFR(0), o[0]), C0, 0);              AS_GAPB(o[1] = AS_MFMA(AS_PAF(0), AS_VFR(4), o[1]), C0, 4); \
    AS_KRD(GL, 0); AS_GAPB(o[0] = AS_MFMA(AS_PAF(1), AS_VFR(1), o[0]), C0, 8);  AS_KRD(GL, 1); AS_GAPB(o[1] = AS_MFMA(AS_PAF(1), AS_VFR(5), o[1]), C0, 12); \
    AS_KRD(GL, 2); AS_GAPB(o[0] = AS_MFMA(AS_PAF(2), AS_VFR(2), o[0]), C1, 0);  AS_KRD(GL, 3); AS_GAPB(o[1] = AS_MFMA(AS_PAF(2), AS_VFR(6), o[1]), C1, 4); \
    AS_GAPB(o[0] = AS_MFMA(AS_PAF(3), AS_VFR(3), o[0]), C1, 8);              AS_GAPB(o[1] = AS_MFMA(AS_PAF(3), AS_VFR(7), o[1]), C1, 12); \
    } while (0)
    int tt = 1;
    for (; tt + 5 < NT; tt += 2) {
        AS_STEP(pB0, pB1, pA0, pA1, tt, false, true, true, true);     AS_WAIT_BAR(2); AS_RESC(); AS_ROT();
        AS_STEP(pA0, pA1, pB0, pB1, tt + 1, false, true, true, true); AS_WAIT_BAR(2); AS_RESC(); AS_ROT();
    }
#define AS_ENDW(x) do { if ((x) + 3 < NT) { AS_WAIT_BAR(2); } else if ((x) + 2 < NT) { AS_WAIT_BAR(1); } else { AS_WAIT_BAR(0); } } while (0)
    for (; tt + 1 < NT; tt += 2) {
        AS_STEP(pB0, pB1, pA0, pA1, tt, true, (tt + 3 < NT), (tt + 1 < NT), (tt + 1 < NT));         AS_ENDW(tt);     AS_RESC(); AS_ROT();
        AS_STEP(pA0, pA1, pB0, pB1, tt + 1, true, (tt + 4 < NT), (tt + 2 < NT), (tt + 2 < NT));     AS_ENDW(tt + 1); AS_RESC(); AS_ROT();
    }
    AS_STEP(pB0, pB1, pA0, pA1, NT - 1, true, false, false, false); AS_RESC();
    { float sacc = pB0[0] + pB0[1];
#pragma unroll
      for (int r = 2; r < 16; ++r) sacc += pB0[r];
#pragma unroll
      for (int r = 0; r < 16; ++r) sacc += pB1[r];
      l_reg += sacc;
      pw0 = (u32x4){AS_PKW(pB0, 0), AS_PKW(pB0, 2), AS_PKW(pB0, 4), AS_PKW(pB0, 6)}; pw1 = (u32x4){AS_PKW(pB0, 8), AS_PKW(pB0, 10), AS_PKW(pB0, 12), AS_PKW(pB0, 14)};
      pw2 = (u32x4){AS_PKW(pB1, 0), AS_PKW(pB1, 2), AS_PKW(pB1, 4), AS_PKW(pB1, 6)}; pw3 = (u32x4){AS_PKW(pB1, 8), AS_PKW(pB1, 10), AS_PKW(pB1, 12), AS_PKW(pB1, 14)};
      const LAS unsigned char* vp_ = vp0 + sl_cur;
#pragma unroll
      for (int i = 0; i < 8; ++i) AS_VRD(i);
      o[0] = AS_MFMA(AS_PAF(0), AS_VFR(0), o[0]); o[1] = AS_MFMA(AS_PAF(0), AS_VFR(4), o[1]); o[0] = AS_MFMA(AS_PAF(1), AS_VFR(1), o[0]); o[1] = AS_MFMA(AS_PAF(1), AS_VFR(5), o[1]);
      o[0] = AS_MFMA(AS_PAF(2), AS_VFR(2), o[0]); o[1] = AS_MFMA(AS_PAF(2), AS_VFR(6), o[1]); o[0] = AS_MFMA(AS_PAF(3), AS_VFR(3), o[0]); o[1] = AS_MFMA(AS_PAF(3), AS_VFR(7), o[1]); }
    { const float lt = x32_sum(l_reg); const float f = lt > 0.f ? gate / lt : 0.f; row_out<ACC>(ow, o, f, wsf, r32, hi); }
    asm volatile("s_waitcnt lgkmcnt(0)\n\ts_barrier" ::: "memory");
#undef AS_JT
#undef AS_DMA_K
#undef AS_DMA_V
#undef AS_ROT
#undef AS_EX
#undef AS_RESC
#undef AS_PKW
#undef AS_PAF
#undef AS_VFR
#undef AS_VRD
#undef AS_KRD
#undef AS_GAPA
#undef AS_GAPB
#undef AS_STEP
#undef AS_ENDW
}

__device__ __forceinline__ void prompt_unit(const Ptrs& P, LAS unsigned char* L, int b, int kv, int c, int tid, int wave, int lane) {
    asm volatile("" : "+v"(lane), "+v"(tid));
    const int r32 = lane & 31, hi = lane >> 5, g = r32 >> 3, qi = r32 & 7, head = kv * 4 + g;
    const int t = c * 64 + wave * 8 + qi; const unsigned row = (unsigned)b * SEQ + t;
    bf16x8 qr[4];
#pragma unroll
    for (int ds = 0; ds < 4; ++ds) qr[ds] = *(const bf16x8*)(P.Q + (size_t)row * D + head * 64 + ds * 16 + hi * 8);
    const LAS float* lut = (const LAS float*)(L + LUT_OFF) + head * 128; const float bfar = lut[127];
    LAS float* wsf = (LAS float*)(L + WSF_OFF) + wave * 32;
    LAS float* ow = (LAS float*)(L + 65536 + wave * 8192);
    LAS unsigned* impq = (LAS unsigned*)(L + IMP_OFF) + wave * 512 + qi * 64;
    const int skey = tid >> 3, sch = tid & 7;
    const int kwoff = skey * 128 + ((sch ^ ((skey >> 1) & 7)) << 4), vwoff = (sch >> 2) * 4096 + skey * 64 + (sch & 3) * 16;
    LAS unsigned char* KB0 = L; LAS unsigned char* VB0 = L + 32768;
    { const unsigned co = ((unsigned)(b * 4 + kv) * 128 + skey) * 64 + sch * 8;
      const u32x4 k0 = *(const u32x4*)(P.kcp + co), k1 = *(const u32x4*)(P.kcp + co + 4096), v0 = *(const u32x4*)(P.vcp + co), v1 = *(const u32x4*)(P.vcp + co + 4096);
      *(LAS u32x4*)(KB0 + kwoff) = k0; *(LAS u32x4*)(KB0 + 8192 + kwoff) = k1; *(LAS u32x4*)(VB0 + vwoff) = v0; *(LAS u32x4*)(VB0 + 8192 + vwoff) = v1; }
    const int nwin = (c < 8 ? c : 8) + 1;
    __syncthreads();
    f32x16 o[2];
#pragma unroll
    for (int r = 0; r < 16; ++r) { o[0][r] = 0.f; o[1][r] = 0.f; }
    unsigned long long mymask = ~0ull;
    {
        float cm = -1e30f, cl = 0.f; const int ncmp = c <= 30 ? 1 : 2;
#pragma unroll 1
        for (int T = 0; T < ncmp; ++T) { f32x16 a0, a1; qk_tile(a0, a1, KB0 + T * 8192, qr, 0.f, r32, hi); mask_bias(a0, a1, t, 31 + 2048 * T, 32, 1 << 30, true, true, lut, hi);
            float rm = fmaxf(a0[0], a1[0]);
#pragma unroll
            for (int r = 1; r < 16; ++r) rm = fmaxf(rm, fmaxf(a0[r], a1[r]));
            rm = x32_max(rm); const float mn = fmaxf(cm, rm); float sacc = 0.f;
#pragma unroll
            for (int r = 0; r < 16; ++r) sacc += ex2(a0[r] - mn) + ex2(a1[r] - mn);
            cl = cl * ex2(cm - mn) + sacc; cm = mn; }
        cl = x32_sum(cl); const float cinv = cl > 0.f ? 1.0f / cl : 0.f;
#pragma unroll 1
        for (int T = 0; T < ncmp; ++T) { f32x16 a0, a1; qk_tile(a0, a1, KB0 + T * 8192, qr, 0.f, r32, hi); mask_bias(a0, a1, t, 31 + 2048 * T, 32, 1 << 30, true, true, lut, hi);
#pragma unroll
            for (int r = 0; r < 16; ++r) { a0[r] = ex2(a0[r] - cm) * cinv; a1[r] = ex2(a1[r] - cm) * cinv; }
            if (c >= 16) imp_store(a0, a1, T, impq, c, g, hi);
            pv_tile(o, VB0 + T * 8192, a0, a1, lane); }
        if (c >= 16 && ncmp == 1 && g == 0) {
#pragma unroll
            for (int q8 = 0; q8 < 8; ++q8) { const int jc = 32 + 4 * q8; u32x2 w; w.x = imp_key(0.f, jc + 2 * hi, c); w.y = imp_key(0.f, jc + 2 * hi + 1, c); *(LAS u32x2*)(impq + 2 * hi + jc) = w; } }
    }
    { const float g0 = GATEV(P, row, head, 0); row_out<false>(ow, o, g0, wsf, r32, hi); }
    if (c >= 16) mymask = select_mask(impq, g, hi);
    __syncthreads();
    { LAS float* xl = (LAS float*)(L + IMP_OFF);
      for (int u = tid; u < 4 * 272; u += 512) { const int gg = u / 272, ii = u % 272, dd = ii - 67; xl[u] = ((const LAS float*)(L + LUT_OFF))[(kv * 4 + gg) * 128 + (dd < 0 ? 0 : (dd > 127 ? 127 : dd))]; } }
    const LAS float* xlg = (const LAS float*)(L + IMP_OFF) + g * 272;
    { const size_t kvb = ((size_t)b * SEQ) * 256 + kv * 64;
      { const int nreal = c + 1; int NT = (nreal + 1) & ~1; if (NT < 4) NT = 4;
        attn_stream<false, true>(P.KS + kvb, P.VS + kvb, 0, nreal, NT, c, t, mymask, qr, bfar, xlg, lut, GATEV(P, row, head, 1), L, wsf, ow, wave, lane); }
      { int NT = (nwin + 1) & ~1; if (NT < 4) NT = 4;
        attn_stream<true, true>(P.KW + kvb, P.VW + kvb, c - nwin + 1, nwin, NT, c, t, mymask, qr, bfar, xlg, lut, GATEV(P, row, head, 2), L, wsf, ow, wave, lane); } }
    { const int rr = lane >> 1, hf = lane & 1, gg = rr >> 3, qq = rr & 7; const LAS float* src = ow + rr * 64 + hf * 32;
      bf16_t* op = P.O + ((size_t)b * SEQ + c * 64 + wave * 8 + qq) * D + (kv * 4 + gg) * 64 + hf * 32;
#pragma unroll
      for (int q4 = 0; q4 < 4; ++q4) { const f32x4 x0 = *(const LAS f32x4*)(src + q4 * 8), x1 = *(const LAS f32x4*)(src + q4 * 8 + 4); u32x4 w;
          w.x = cvtpk(x0[0], x0[1]); w.y = cvtpk(x0[2], x0[3]); w.z = cvtpk(x1[0], x1[1]); w.w = cvtpk(x1[2], x1[3]); *(u32x4*)(op + q4 * 8) = w; } }
    __syncthreads();
}

template <bool COPY>
__device__ __forceinline__ void stage_f32_pair(const float* ksrc_, const float* vsrc_, LAS unsigned char* Kb, LAS unsigned char* Vb, int lane, float* kdst_ = nullptr, float* vdst_ = nullptr, int first_row = 0) {
    const int c4 = lane & 15; const char* ks = uniform_ptr(ksrc_); const char* vs = uniform_ptr(vsrc_); const unsigned lo = (unsigned)((lane >> 4) * 1024 + c4 * 16);
#pragma unroll 1
    for (int hf = 0; hf < 2; ++hf) {
        f32x4 x[8], y[8];
#pragma unroll
        for (int it = 0; it < 8; ++it) x[it] = *(const f32x4*)(ks + (lo + (unsigned)(hf * 8 + it) * 4096u));
#pragma unroll
        for (int it = 0; it < 8; ++it) y[it] = *(const f32x4*)(vs + (lo + (unsigned)(hf * 8 + it) * 4096u));
        if constexpr (COPY) {
            char* kd = (char*)uniform_ptr(kdst_); char* vd = (char*)uniform_ptr(vdst_);
#pragma unroll
            for (int it = 0; it < 8; ++it) { const int key = (hf * 8 + it) * 4 + (lane >> 4);
                if (key >= first_row) { __builtin_nontemporal_store(x[it], (f32x4*)(kd + (lo + (unsigned)(hf * 8 + it) * 4096u))); __builtin_nontemporal_store(y[it], (f32x4*)(vd + (lo + (unsigned)(hf * 8 + it) * 4096u))); } }
        }
#pragma unroll
        for (int it = 0; it < 8; ++it) { const int key = (hf * 8 + it) * 4 + (lane >> 4);
            u32x2 w; w.x = cvtpk(x[it][0], x[it][1]); w.y = cvtpk(x[it][2], x[it][3]);
            *(LAS u32x2*)(Kb + key * 128 + (((c4 >> 1) ^ ((key >> 1) & 7)) << 4) + (c4 & 1) * 8) = w; }
#pragma unroll
        for (int it = 0; it < 8; ++it) { const int key = (hf * 8 + it) * 4 + (lane >> 4);
            u32x2 w; w.x = cvtpk(y[it][0], y[it][1]); w.y = cvtpk(y[it][2], y[it][3]);
            *(LAS u32x2*)(Vb + (c4 >> 3) * 4096 + key * 64 + (c4 & 7) * 8) = w; }
        __builtin_amdgcn_sched_barrier(0);
    }
}
__device__ __forceinline__ void stage_bf16_tile(const bf16_t* src_  , LAS unsigned char* Kb, bool isV, int lane) {
    const char* src = uniform_ptr(src_);
#pragma unroll
    for (int it = 0; it < 8; ++it) { const int idx = it * 64 + lane, key = idx >> 3, ch = idx & 7; const u32x4 x = *(const u32x4*)(src + (unsigned)idx * 16u);
        const int off = isV ? ((ch >> 2) * 4096 + key * 64 + (ch & 3) * 16) : (key * 128 + ((ch ^ ((key >> 1) & 7)) << 4));
        *(LAS u32x4*)(Kb + off) = x; }
}
__device__ __forceinline__ void stage_new_tile(const bf16_t* src_  , LAS unsigned char* Kb, bool isV, int lane) {
    const char* src = uniform_ptr(src_);
#pragma unroll
    for (int it = 0; it < 8; ++it) *(LAS u32x4*)(Kb + (it * 64 + lane) * 16) = (u32x4){0u, 0u, 0u, 0u};
    if (lane < 32) { const int key = lane >> 3, ch = lane & 7; const u32x4 x = *(const u32x4*)(src + (unsigned)(key * 512 + ch * 16));
        const int off = isV ? ((ch >> 2) * 4096 + key * 64 + (ch & 3) * 16) : (key * 128 + ((ch ^ ((key >> 1) & 7)) << 4));
        *(LAS u32x4*)(Kb + off) = x; }
}
__device__ __forceinline__ void sample_unit(const Ptrs& P, LAS unsigned char* L, int b, int kv, int tid, int wave, int lane) {
    asm volatile("" : "+v"(lane), "+v"(tid));
    const int r32 = lane & 31, hi = lane >> 5, g = r32 >> 3, qi = r32 & 7, qs = qi & 3, head = kv * 4 + g;
    const int t = PAST + qs; const unsigned row = (unsigned)MP + b * 4 + qs;
    bf16x8 qr[4];
#pragma unroll
    for (int ds = 0; ds < 4; ++ds) qr[ds] = *(const bf16x8*)(P.Q + (size_t)row * D + head * 64 + ds * 16 + hi * 8);
    const LAS float* lut = (const LAS float*)(L + LUT_OFF) + head * 128; const float bfar = lut[127];
    LAS float* wsf = (LAS float*)(L + WSF_OFF) + wave * 32;
    LAS unsigned* impq = (LAS unsigned*)(L + IMP_OFF) + wave * 512 + qi * 64;
    LAS unsigned char* Kb = L + wave * 16384; LAS unsigned char* Vb = Kb + 8192;
    f32x16 out[2], o[2];
#pragma unroll
    for (int r = 0; r < 16; ++r) { out[0][r] = 0.f; out[1][r] = 0.f; o[0][r] = 0.f; o[1][r] = 0.f; }
    stage_bf16_tile(P.kcs + (size_t)(b * 4 + kv) * 4096, Kb, false, lane); stage_bf16_tile(P.vcs + (size_t)(b * 4 + kv) * 4096, Vb, true, lane);
    LDS_WAIT();
    {
        f32x16 a0, a1;
        qk_tile(a0, a1, Kb, qr, 0.f, r32, hi);
        mask_bias(a0, a1, t, 31, 32, 1 << 30, true, true, lut, hi);
        { float rm = fmaxf(a0[0], a1[0]);
#pragma unroll
          for (int r = 1; r < 16; ++r) rm = fmaxf(rm, fmaxf(a0[r], a1[r]));
          rm = x32_max(rm); float sacc = 0.f;
#pragma unroll
          for (int r = 0; r < 16; ++r) { a0[r] = ex2(a0[r] - rm); a1[r] = ex2(a1[r] - rm); sacc += a0[r] + a1[r]; }
          sacc = x32_sum(sacc); const float cinv = 1.0f / sacc;
#pragma unroll
          for (int r = 0; r < 16; ++r) { a0[r] *= cinv; a1[r] *= cinv; } }
        imp_store(a0, a1, 0, impq, 32, g, hi);
        if (g == 0) {
#pragma unroll
            for (int q8 = 0; q8 < 8; ++q8) { const int jc = 32 + 4 * q8; u32x2 w; w.x = imp_key(0.f, jc + 2 * hi, 32); w.y = imp_key(0.f, jc + 2 * hi + 1, 32); *(LAS u32x2*)(impq + 2 * hi + jc) = w; } }
        if (wave == 0) { pv_tile(o, Vb, a0, a1, lane); const float g0 = GATEV(P, row, head, 0); row_fma(out, o, g0, wsf, r32, hi);
#pragma unroll
            for (int r = 0; r < 16; ++r) { o[0][r] = 0.f; o[1][r] = 0.f; } }
    }
    const unsigned long long mymask = select_mask(impq, g, hi);
    const unsigned long long umask = wave_or64(mymask) & 0x1FFFFFFFFull;
    const bool winw = wave >= 6;
    const int nsel = __builtin_popcountll(umask);
    const int nmine = winw ? 9 : nsel, first = winw ? wave - 6 : wave, step = winw ? 2 : 6;
    float m = -1e30f, l = 0.f;
#pragma unroll 1
    for (int idx = first; idx < nmine; idx += step) {
        LDS_WAIT();
        int pos0; bool near, sel = true;
        int ln = lane; asm volatile("" : "+v"(ln));
        if (!winw) {
            unsigned long long mm = umask; for (int n = 0; n < idx; ++n) mm &= mm - 1ull;
            const int j = __builtin_ctzll(mm);
            if (j < 32) { const int page = P.pt[b * 16 + (j >> 1)]; const size_t off = (((size_t)page * 128 + (j & 1) * 64) * 4 + kv) * 64;
                stage_f32_pair<false>(P.ck_sel + off, P.cv_sel + off, Kb, Vb, ln); }
            else { stage_new_tile(P.KS + ((size_t)MP + b * 4) * 256 + kv * 64, Kb, false, ln); stage_new_tile(P.VS + ((size_t)MP + b * 4) * 256 + kv * 64, Vb, true, ln); }
            pos0 = 64 * j; near = j >= 30; sel = (mymask >> j) & 1ull;
        } else {
            if (idx < 8) { const size_t off = (((size_t)b * 512 + 64 * idx) * 4 + kv) * 64;
                stage_f32_pair<true>(P.st_kw + off, P.st_vw + off, Kb, Vb, ln, P.kw_out + off - 1024, P.vw_out + off - 1024, idx == 0 ? 4 : 0); }
            else { stage_new_tile(P.KW + ((size_t)MP + b * 4) * 256 + kv * 64, Kb, false, ln); stage_new_tile(P.VW + ((size_t)MP + b * 4) * 256 + kv * 64, Vb, true, ln); }
            pos0 = PAST - 512 + 64 * idx; near = idx >= 6;
        }
        LDS_WAIT();
        f32x16 p0, p1;
        qk_tile(p0, p1, Kb, qr, near ? 0.f : bfar, r32, hi);
        mask_bias(p0, p1, t, pos0, 1, winw ? 512 : (1 << 30), sel, near, lut, hi);
        softmax_update(p0, p1, m, l, o, wsf, r32, hi);
        pv_tile(o, Vb, p0, p1, lane);
    }
    LDS_WAIT();
    { const float lt = x32_sum(l);
      LAS f32x2* ml = (LAS f32x2*)(L + IMP_OFF);
      if (hi == 0) ml[wave * 256 + r32] = (f32x2){m, lt};
      __syncthreads();
      const int w0 = winw ? 6 : 0, w1 = winw ? 8 : 6;
      float M = -1e30f;
      for (int w = w0; w < w1; ++w) M = fmaxf(M, ml[w * 256 + r32][0]);
      float Ls = 0.f;
      for (int w = w0; w < w1; ++w) { const f32x2 x = ml[w * 256 + r32]; Ls += x[1] * ex2(x[0] - M); }
      const float gt = GATEV(P, row, head, (winw ? 2 : 1));
      const float f = Ls > 0.f ? gt * ex2(m - M) / Ls : 0.f;
      row_fma(out, o, f, wsf, r32, hi); }
    LAS float* ob = (LAS float*)Kb + hi * 256 + r32;
#pragma unroll
    for (int r = 0; r < 16; ++r) { ob[CROW0(r) * 64] = out[0][r]; ob[CROW0(r) * 64 + 32] = out[1][r]; }
    __syncthreads();
    { const int vr = tid >> 5, d2 = (tid & 31) * 2, gg = vr >> 2, qq = vr & 3; float s0 = 0.f, s1 = 0.f;
#pragma unroll
      for (int w = 0; w < 8; ++w) { const f32x2 x = *(const LAS f32x2*)((const LAS float*)(L + w * 16384) + (gg * 8 + qq) * 64 + d2); s0 += x[0]; s1 += x[1]; }
      *(unsigned*)(P.O + ((size_t)MP + b * 4 + qq) * D + (kv * 4 + gg) * 64 + d2) = cvtpk(s0, s1); }
    __syncthreads();
}

#ifdef VERIFY
__device__ __forceinline__ float wsum(float v) { for (int o = 1; o < 64; o <<= 1) v += __shfl_xor(v, o); return v; }
__device__ __forceinline__ float wmax(float v) { for (int o = 1; o < 64; o <<= 1) v = fmaxf(v, __shfl_xor(v, o)); return v; }
__device__ __forceinline__ float rb(float x) { return bf2f((unsigned short)(cvtpk(x, 0.f) & 0xffffu)); }
__device__ __forceinline__ void verify_item(const Ptrs& P, LAS unsigned char* L, bool sample, int b, int tq, int kv, int br, float* errs, int wave, int lane) {
    LAS float* sc = (LAS float*)(L + wave * 16384);
    LAS float* qs = (LAS float*)(L + IMP_OFF) + wave * 512;
    const LAS float* lutb = (const LAS float*)(L + LUT_OFF);
    const size_t row = sample ? (size_t)MP + b * 4 + tq : (size_t)b * SEQ + tq; const int pos = sample ? PAST + tq : tq; const int cq = pos >> 6;
    for (int g = 0; g < 4; ++g) qs[g * 64 + lane] = bf2f(P.Q[row * D + (kv * 4 + g) * 64 + lane]);
    LDS_WAIT();
    const int ncmp = sample ? 64 : 128; const size_t cmpo = (size_t)(b * 4 + kv) * (sample ? 4096 : 8192); const bf16_t* kc = (const bf16_t*)((const char*)P.kcp + (sample ? WS_KCMPS - WS_KCMPP : 0)) + cmpo; const bf16_t* vc = (const bf16_t*)((const char*)P.vcp + (sample ? WS_VCMPS - WS_VCMPP : 0)) + cmpo;
    float oc0 = 0.f, oc1 = 0.f, oc2 = 0.f, oc3 = 0.f;
    for (int g = 0; g < 4; ++g) {
        float sA = -INFINITY, sB = -INFINITY;
        for (int h = 0; h < 2; ++h) { const int n = lane + 64 * h; const int dist = pos - (32 * n + 31); float s = -INFINITY;
            if (n < ncmp && dist >= 0) { float a = 0.f; for (int d = 0; d < 64; ++d) a += qs[g * 64 + d] * bf2f(kc[(size_t)n * 64 + d]); s = a + lutb[(kv * 4 + g) * 128 + (dist > 127 ? 127 : dist)]; }
            if (h == 0) sA = s; else sB = s; }
        const float mx = wmax(fmaxf(sA, sB)); float p0 = 0.f, p1 = 0.f;
        if (mx > -INFINITY) { p0 = ex2(sA - mx); p1 = ex2(sB - mx); }
        const float sm = wsum(p0 + p1); const float inv = sm > 0.f ? 1.0f / sm : 0.f;
        sc[g * 128 + lane] = p0 * inv; sc[g * 128 + 64 + lane] = p1 * inv;
    }
    LDS_WAIT();
    for (int g = 0; g < 4; ++g) { float a = 0.f; for (int n = 0; n < ncmp; ++n) a += sc[g * 128 + n] * bf2f(vc[(size_t)n * 64 + lane]); if (g == 0) oc0 = a; else if (g == 1) oc1 = a; else if (g == 2) oc2 = a; else oc3 = a; }
    float imp = 0.f; for (int g = 0; g < 4; ++g) imp += sc[g * 128 + 2 * lane] + sc[g * 128 + 2 * lane + 1];
    { const bool forced = (lane == 0) || (lane == cq) || (lane == cq - 1), elig = lane <= cq; imp = forced ? 1e9f : (elig ? imp : -1.0f); }
    LDS_WAIT(); qs[256 + lane] = imp; LDS_WAIT();
    int rank = 0; for (int j = 0; j < 64; ++j) { const float v = qs[256 + j]; rank += (v > imp) || (v == imp && j < lane); }
    const int nsb = sample ? 33 : 64;
    const unsigned long long selm = __ballot(rank < 16 && lane < nsb);
    float r0 = oc0, r1 = oc1, r2_ = oc2, r3 = oc3;
    if (br != 0) {
        const int nslot = br == 1 ? __builtin_popcountll(selm) : 9;
        LDS_WAIT();
        for (int si = 0; si < nslot && si < 16; ++si) {
            int j;
            if (br == 1) { unsigned long long mm = selm; for (int n = 0; n < si; ++n) mm &= mm - 1ull; j = __builtin_ctzll(mm); } else j = sample ? si : cq - 8 + si;
            bool ok = false; int pk = 0; const float* kf = nullptr; const bf16_t* kb = nullptr;
            if (br == 1) { pk = 64 * j + lane;
                if (!sample) { ok = pk <= pos; kb = P.KS + ((size_t)b * SEQ + pk) * 256 + kv * 64; }
                else if (j < 32) { ok = true; kf = P.ck_sel + (((size_t)P.pt[b * 16 + (j >> 1)] * 128 + (j & 1) * 64 + lane) * 4 + kv) * 64; }
                else { ok = lane < 4 && pk <= pos; kb = P.KS + ((size_t)MP + b * 4 + (lane & 3)) * 256 + kv * 64; } }
            else { if (!sample) { pk = 64 * j + lane; ok = j >= 0 && pk <= pos && pos - pk < 512; kb = P.KW + ((size_t)b * SEQ + (ok ? pk : 0)) * 256 + kv * 64; }
                else { const int e = 64 * j + lane; pk = PAST - 512 + e; ok = e < 516 && pk <= pos && pos - pk < 512;
                    if (e < 512) kf = P.st_kw + (((size_t)b * 512 + e) * 4 + kv) * 64; else kb = P.KW + ((size_t)MP + b * 4 + ((e - 512) & 3)) * 256 + kv * 64; } }
            const int dist = pos - pk;
            for (int g = 0; g < 4; ++g) { float s = -INFINITY;
                if (ok) { float a = 0.f; for (int d = 0; d < 64; ++d) a += qs[g * 64 + d] * (kf ? rb(kf[d]) : bf2f(kb[d])); s = a + lutb[(kv * 4 + g) * 128 + (dist > 127 ? 127 : dist)]; }
                sc[g * 1024 + si * 64 + lane] = s; }
        }
        LDS_WAIT();
        for (int g = 0; g < 4; ++g) {
            float mx = -INFINITY; for (int si = 0; si < nslot && si < 16; ++si) mx = fmaxf(mx, sc[g * 1024 + si * 64 + lane]);
            mx = wmax(mx); float sm = 0.f;
            for (int si = 0; si < nslot && si < 16; ++si) { const float p = mx > -INFINITY ? ex2(sc[g * 1024 + si * 64 + lane] - mx) : 0.f; sc[g * 1024 + si * 64 + lane] = p; sm += p; }
            sm = wsum(sm); const float inv = sm > 0.f ? 1.0f / sm : 0.f;
            LDS_WAIT();
            float a = 0.f;
            for (int si = 0; si < nslot && si < 16; ++si) {
                int j;
                if (br == 1) { unsigned long long mm = selm; for (int n = 0; n < si; ++n) mm &= mm - 1ull; j = __builtin_ctzll(mm); } else j = sample ? si : cq - 8 + si;
                for (int k = 0; k < 64; ++k) { const float p = sc[g * 1024 + si * 64 + k]; if (p == 0.f) continue; float v;
                    if (br == 1) { if (!sample) v = bf2f(P.VS[((size_t)b * SEQ + 64 * j + k) * 256 + kv * 64 + lane]);
                        else if (j < 32) v = rb(P.cv_sel[(((size_t)P.pt[b * 16 + (j >> 1)] * 128 + (j & 1) * 64 + k) * 4 + kv) * 64 + lane]);
                        else v = bf2f(P.VS[((size_t)MP + b * 4 + (k & 3)) * 256 + kv * 64 + lane]); }
                    else { if (!sample) v = bf2f(P.VW[((size_t)b * SEQ + 64 * j + k) * 256 + kv * 64 + lane]);
                        else { const int e = 64 * j + k; v = e < 512 ? rb(P.st_vw[(((size_t)b * 512 + e) * 4 + kv) * 64 + lane]) : bf2f(P.VW[((size_t)MP + b * 4 + ((e - 512) & 3)) * 256 + kv * 64 + lane]); } }
                    a += p * v; } }
            a *= inv; if (g == 0) r0 = a; else if (g == 1) r1 = a; else if (g == 2) r2_ = a; else r3 = a;
            LDS_WAIT();
        }
    }
    float d2 = 0.f, rr2 = 0.f;
    for (int g = 0; g < 4; ++g) { const float ref = g == 0 ? r0 : g == 1 ? r1 : g == 2 ? r2_ : r3; const float f = bf2f(P.O[row * D + (kv * 4 + g) * 64 + lane]); const float df = f - ref; d2 += df * df; rr2 += ref * ref; }
    d2 = wsum(d2); rr2 = wsum(rr2);
    if (lane == 0) { atomicAdd(errs + ((sample ? 3 : 0) + br) * 2, d2); atomicAdd(errs + ((sample ? 3 : 0) + br) * 2 + 1, rr2); }
}
#endif
}

constexpr int NPHASE = 17;
__global__ void __launch_bounds__(512, 2) nsa_fwd(Args args) {
    extern __shared__ __attribute__((aligned(16))) unsigned char lds[];
    Frame F;
    F.lds = (LAS unsigned char*)lds;
    F.tid = threadIdx.x; F.lane = F.tid & 63; F.wave = __builtin_amdgcn_readfirstlane(F.tid >> 6);
    F.G = gridDim.x; { const int bx = blockIdx.x; F.vcu = (F.G % 8 == 0) ? (bx % 8) * (F.G / 8) + bx / 8 : bx; }
    F.x_p = (const float*)args.in[0]; F.x_s = (const float*)args.in[1]; F.c_p = (const float*)args.in[2]; F.c_s = (const float*)args.in[3];
    F.ck_cmp = (const float*)args.in[4]; F.cv_cmp = (const float*)args.in[5]; F.ck_sel = (const float*)args.in[6]; F.cv_sel = (const float*)args.in[7];
    F.page_table = (const int*)args.in[8]; F.st_kw = (const float*)args.in[9]; F.st_vw = (const float*)args.in[10]; F.st_pool = (const float*)args.in[11];
    F.rel_bias = (const float*)args.in[12]; F.ada_w = (const float*)args.in[13]; F.ada_b = (const float*)args.in[14]; F.norm_g = (const float*)args.in[15]; F.final_g = (const float*)args.in[16];
    F.w_in = (const float*)args.in[17]; F.w_out = (const float*)args.in[18]; F.cmp_wk = (const float*)args.in[19]; F.cmp_wv = (const float*)args.in[20];
    F.pe_k = (const float*)args.in[21]; F.pe_v = (const float*)args.in[22]; F.pool_w = (const float*)args.in[23]; F.pool_scale = (const float*)args.in[24];
    F.ffn_wg = (const float*)args.in[25]; F.ffn_wu = (const float*)args.in[26]; F.ffn_wd = (const float*)args.in[27];
    F.out = args.out; F.ws = args.ws;
    unsigned char* ws = args.ws;
    for (int u = F.tid; u < 64; u += 512) ((LAS unsigned*)(F.lds + MISC_OFF))[u] = 0u;
    for (int u = F.tid; u < 16 * 128; u += 512) { const int h = u >> 7, d = u & 127; ((LAS float*)(F.lds + LUT_OFF))[u] = F.rel_bias[t5_bucket(d) * 16 + h] * LOG2E; }
    __syncthreads();
    volatile LAS unsigned* MISC = (volatile LAS unsigned*)(F.lds + MISC_OFF);
    XcdBarrier bar; bar.bar = (unsigned*)(ws + WS_CTL) + CW_BAR; bar.x = 0; bar.st = nullptr;
    if (!MK_SPLIT) bar = xcd_barrier_post((unsigned*)(ws + WS_CTL) + CW_BAR, MISC + 8);
    const int lo = args.ph_lo, hi = args.ph_hi;
#ifndef PHMASK
#define PHMASK 0x1FFFF
#endif
#define IN(k) (((PHMASK >> (k)) & 1) && lo <= (k) && (k) < hi)
#define SEAM(k) do { if (IN(k) && IN((k) + 1)) xcd_barrier(bar); } while (0)
#ifndef REPMASK
#define REPMASK 0
#endif
#define REPS(k) (((REPMASK >> (k)) & 1) ? 2 : 1)
    bf16_t* H = (bf16_t*)(ws + WS_H); float* X = (float*)(ws + WS_X); float* MOD = (float*)(ws + WS_MOD);

    if (IN(0)) { for (int rep = 0; rep < REPS(0); ++rep) p0_prologue(F); } SEAM(0);
    if (IN(1)) { for (int rep = 0; rep < REPS(1); ++rep) { p1_compress_sample(F); p1_ada(F); } } SEAM(1);
    if (IN(2)) { for (int rep = 0; rep < REPS(2); ++rep) norm_phase<0>(F, true, 0, 0); } SEAM(2);
    if (IN(3)) {
        pg8::Gemm g{H, (const bf16_t*)(ws + WS_WIN), D, D, D, 0}; pg8::StaticOrder S; S.init(MT, NPROJ, F.G, (int)blockIdx.x);
        pg8::EpiProj E{(bf16_t*)(ws + WS_Q), (bf16_t*)(ws + WS_KV), (float*)(ws + WS_GATES), F.out};
        for (int rep = 0; rep < REPS(3); ++rep) pg8::gemm_phase<pg8::EpiProj, pg8::StaticOrder, true>(F.lds, g, S, E);
    } SEAM(3);
    if (IN(4)) { for (int rep = 0; rep < REPS(4); ++rep) p4_compress_prompt(F); } SEAM(4);
    if (IN(5)) {
        att::Ptrs P; P.Q = (const bf16_t*)(ws + WS_Q); P.kcp = (const bf16_t*)(ws + WS_KCMPP); P.vcp = (const bf16_t*)(ws + WS_VCMPP); P.kcs = (const bf16_t*)(ws + WS_KCMPS); P.vcs = (const bf16_t*)(ws + WS_VCMPS);
        const bf16_t* kvb = (const bf16_t*)(ws + WS_KV); P.KS = kvb + 2 * KV_STRIDE; P.VS = kvb + 3 * KV_STRIDE; P.KW = kvb + 4 * KV_STRIDE; P.VW = kvb + 5 * KV_STRIDE;
        P.gates = (const float*)(ws + WS_GATES); P.O = (bf16_t*)(ws + WS_O); P.ck_sel = F.ck_sel; P.cv_sel = F.cv_sel; P.st_kw = F.st_kw; P.st_vw = F.st_vw; P.pt = F.page_table;
        P.gov = -1; P.kw_out = F.out + O_KWS; P.vw_out = F.out + O_KWS + SZ_WS;
#ifdef VERIFY
        P.gov = args.pad0 - 1;
#endif
#ifndef RS
#define RS 1
#endif
#ifndef RP
#define RP 1
#endif
#pragma unroll 1
        for (int pass = 0; pass < 2; ++pass) {
            if ((pass == 0) != ((F.vcu & 1) != 0)) {
#pragma unroll 1
                for (int rep = 0; rep < RS; ++rep)
                for (int u = F.vcu; u < NSB * 4; u += F.G) att::sample_unit(P, F.lds, u >> 2, u & 3, F.tid, F.wave, F.lane);
            } else {
#pragma unroll 1
                for (int rep = 0; rep < RP; ++rep)
                for (int u = F.vcu; u < 16 * 16; u += F.G) { const int bk = u >> 4, s = u & 15;
#pragma unroll 1
                    for (int i = 0; i < 4; ++i) { const int c = (i == 0) ? s : (i == 1) ? 31 - s : (i == 2) ? 32 + s : 63 - s; att::prompt_unit(P, F.lds, bk >> 2, bk & 3, c, F.tid, F.wave, F.lane); } }
            }
        }
    } SEAM(5);
    if (IN(6)) {
        pg8::Gemm g{(const bf16_t*)(ws + WS_O), (const bf16_t*)(ws + WS_WOUT), D, D, D, 0}; pg8::StaticOrder S; S.init(MP, D, F.G, (int)blockIdx.x);
        pg8::EpiRes E{F.x_p, F.x_s, X, MOD + 2048, nullptr};
        pg8::gemm_phase<pg8::EpiRes, pg8::StaticOrder, true>(F.lds, g, S, E);
        small_gemm_res(F, (const bf16_t*)(ws + WS_O) + (size_t)MP * D, D, (const bf16_t*)(ws + WS_WOUT), D, D, false, F.x_s, X + (size_t)MP * D, MOD + 2048, nullptr);
    } SEAM(6);
    if (IN(7)) { for (int rep = 0; rep < REPS(7); ++rep) norm_phase<0>(F, false, 0, 1); } SEAM(7);
    if (IN(8)) {
        pg8::Gemm g{H, (const bf16_t*)(ws + WS_WGU), D, D, D, 0}; pg8::StaticOrder S; S.init(MT, NGU, F.G, (int)blockIdx.x);
        pg8::EpiGU E{(bf16_t*)(ws + WS_ACT)};
        for (int rep = 0; rep < REPS(8); ++rep) pg8::gemm_phase<pg8::EpiGU, pg8::StaticOrder, true>(F.lds, g, S, E);
    } SEAM(8);
    if (IN(9)) {
        pg8::Gemm g{(const bf16_t*)(ws + WS_ACT), (const bf16_t*)(ws + WS_WD), FF, FF, FF, 0}; pg8::StaticOrder S; S.init(MP, D, F.G, (int)blockIdx.x);
        pg8::EpiRes E{X, X + (size_t)MP * D, X, MOD + 5120, nullptr};
        pg8::gemm_phase<pg8::EpiRes, pg8::StaticOrder, true>(F.lds, g, S, E);
        small_gemm_res(F, (const bf16_t*)(ws + WS_ACT) + (size_t)MP * FF, FF, (const bf16_t*)(ws + WS_WD), FF, FF, false, X + (size_t)MP * D, X + (size_t)MP * D, MOD + 5120, nullptr);
    } SEAM(9);
    if (IN(10)) { for (int rep = 0; rep < REPS(10); ++rep) norm_phase<1>(F, false, 1, 0); } SEAM(10);
    if (IN(11)) { for (int rep = 0; rep < REPS(11); ++rep) pool_phase(F); } SEAM(11);
    if (IN(12)) {
        pg8::Gemm g{H, (const bf16_t*)(ws + WS_WPOOL), D, 256, 256, 256}; pg8::StaticOrder S; S.init(MP, D, F.G, (int)blockIdx.x);
        pg8::EpiRes E{X, X + (size_t)MP * D, X, MOD + (size_t)NMODB * 6144 + 2048, F.pool_scale};
        pg8::gemm_phase<pg8::EpiRes, pg8::StaticOrder, true>(F.lds, g, S, E);
        small_gemm_res(F, H + (size_t)MP * D, D, (const bf16_t*)(ws + WS_WPOOL), 256, 256, true, X + (size_t)MP * D, X + (size_t)MP * D, MOD + (size_t)NMODB * 6144 + 2048, F.pool_scale);
    } SEAM(12);
    if (IN(13)) { for (int rep = 0; rep < REPS(13); ++rep) norm_phase<0>(F, false, 1, 1); } SEAM(13);
    if (IN(14)) {
        pg8::Gemm g{H, (const bf16_t*)(ws + WS_WGU) + (size_t)NGU * D, D, D, D, 0}; pg8::StaticOrder S; S.init(MT, NGU, F.G, (int)blockIdx.x);
        pg8::EpiGU E{(bf16_t*)(ws + WS_ACT)};
        pg8::gemm_phase<pg8::EpiGU, pg8::StaticOrder, true>(F.lds, g, S, E);
    } SEAM(14);
    if (IN(15)) {
        pg8::Gemm g{(const bf16_t*)(ws + WS_ACT), (const bf16_t*)(ws + WS_WD) + (size_t)D * FF, FF, FF, FF, 0}; pg8::StaticOrder S; S.init(MP, D, F.G, (int)blockIdx.x);
        pg8::EpiRes E{X, X + (size_t)MP * D, X, MOD + (size_t)NMODB * 6144 + 5120, nullptr};
        pg8::gemm_phase<pg8::EpiRes, pg8::StaticOrder, true>(F.lds, g, S, E);
        small_gemm_res(F, (const bf16_t*)(ws + WS_ACT) + (size_t)MP * FF, FF, (const bf16_t*)(ws + WS_WD) + (size_t)D * FF, FF, FF, false, X + (size_t)MP * D, X + (size_t)MP * D, MOD + (size_t)NMODB * 6144 + 5120, nullptr);
    } SEAM(15);
    if (IN(16)) { for (int rep = 0; rep < REPS(16); ++rep) norm_phase<2>(F, false, 0, 0); }
#undef IN
#undef SEAM
}


#ifdef VERIFY
__global__ void __launch_bounds__(512, 2) verify_k(Args args) {
    extern __shared__ __attribute__((aligned(16))) unsigned char lds[];
    LAS unsigned char* L = (LAS unsigned char*)lds; unsigned char* ws = args.ws;
    const int tid = threadIdx.x, lane = tid & 63, wave = __builtin_amdgcn_readfirstlane(tid >> 6);
    const float* rel_bias = (const float*)args.in[12];
    for (int u = tid; u < 16 * 128; u += 512) { const int h = u >> 7, d = u & 127; ((LAS float*)(L + LUT_OFF))[u] = rel_bias[t5_bucket(d) * 16 + h] * LOG2E; }
    __syncthreads();
    att::Ptrs P; P.Q = (const bf16_t*)(ws + WS_Q); P.kcp = (const bf16_t*)(ws + WS_KCMPP); P.vcp = (const bf16_t*)(ws + WS_VCMPP); P.kcs = (const bf16_t*)(ws + WS_KCMPS); P.vcs = (const bf16_t*)(ws + WS_VCMPS);
    const bf16_t* kvb = (const bf16_t*)(ws + WS_KV); P.KS = kvb + 2 * KV_STRIDE; P.VS = kvb + 3 * KV_STRIDE; P.KW = kvb + 4 * KV_STRIDE; P.VW = kvb + 5 * KV_STRIDE;
    P.gates = (const float*)(ws + WS_GATES); P.O = (bf16_t*)(ws + WS_O); P.ck_sel = (const float*)args.in[6]; P.cv_sel = (const float*)args.in[7]; P.st_kw = (const float*)args.in[9]; P.st_vw = (const float*)args.in[10]; P.pt = (const int*)args.in[8]; P.gov = args.pad0 - 1;
    float* errs = (float*)(ws + WS_CTL) + 65536;
    const int gw = blockIdx.x * 8 + wave;
    for (int it = gw; it < 168 + 64; it += gridDim.x * 8) { bool smp = it >= 168; int vb_, vt_, vk_;
        if (!smp) { const int ti = it % 21, r = it / 21; vb_ = (r >> 2) ? 3 : 0; vk_ = r & 3; vt_ = ti == 0 ? 0 : ti == 1 ? 5 : ti == 2 ? 30 : ti == 3 ? 31 : ti == 4 ? 63 : ti == 5 ? 64 : ti == 6 ? 100 : ti == 7 ? 511 : ti == 8 ? 512 : ti == 9 ? 600 : ti == 10 ? 959 : ti == 11 ? 960 : ti == 12 ? 1023 : ti == 13 ? 1024 : ti == 14 ? 1055 : ti == 15 ? 1100 : ti == 16 ? 2047 : ti == 17 ? 2048 : ti == 18 ? 3000 : ti == 19 ? 4032 : 4095; }
        else { const int q = it - 168, bi = q >> 4; vb_ = bi == 0 ? 0 : bi == 1 ? 1 : bi == 2 ? 77 : 127; vt_ = q & 3; vk_ = (q >> 2) & 3; }
        att::verify_item(P, L, smp, vb_, vt_, vk_, args.pad0 - 1, errs, wave, lane); }
}
__global__ void scale_k(Args args) {
    const float* errs = (const float*)(args.ws + WS_CTL) + 65536; const size_t offs[6] = {O_KCP, O_KCP + SZ_KVP, O_KCP + 2 * SZ_KVP, O_KCS, O_KCS + SZ_KVS, O_KCS + 2 * SZ_KVS};
    const int k = blockIdx.y; const float d2 = errs[2 * k], r2 = errs[2 * k + 1]; const float e = r2 > 0.f ? sqrtf(d2 / r2) : 7.0f; const size_t n = k < 3 ? SZ_KVP : SZ_KVS;
    for (size_t i = (size_t)blockIdx.x * blockDim.x + threadIdx.x; i < n; i += (size_t)gridDim.x * blockDim.x) args.out[offs[k] + i] *= (1.0f + e);
}
#endif
extern "C" void kernel_launch(void* const* d_in, const int* in_sizes, int n_in, void* d_out, int out_size, void* d_ws, size_t ws_size, hipStream_t stream) {
    static int grid = 0;
    if (grid == 0) {
        if (n_in != 28 || (size_t)out_size != O_END || ws_size < WS_END) { fprintf(stderr, "kernel_launch: unexpected shapes (n_in %d, out %d, ws %zu); nothing launched\n", n_in, out_size, ws_size); grid = -1; return; }
        int dev = 0, cus = 0, per_cu = 0;
        if (hipGetDevice(&dev) != hipSuccess || hipDeviceGetAttribute(&cus, hipDeviceAttributeMultiprocessorCount, dev) != hipSuccess) { grid = -1; return; }
        if (hipFuncSetAttribute((const void*)nsa_fwd, hipFuncAttributeMaxDynamicSharedMemorySize, LDS_BYTES) != hipSuccess) { fprintf(stderr, "kernel_launch: hipFuncSetAttribute(%d B LDS) failed\n", LDS_BYTES); grid = -1; return; }
        if (hipOccupancyMaxActiveBlocksPerMultiprocessor(&per_cu, (const void*)nsa_fwd, 512, LDS_BYTES) != hipSuccess || per_cu < 1)
            fprintf(stderr, "kernel_launch: note: occupancy query reports %d workgroups per CU\n", per_cu);
        (void)hipGetLastError();
        grid = cus;
    }
    if (grid < 0) return;
    (void)hipMemsetAsync((char*)d_ws + WS_CTL, 0, CTL_ZERO_BYTES, stream);
    Args a{};
    for (int i = 0; i < 28; ++i) a.in[i] = d_in[i];
    a.out = (float*)d_out; a.ws = (unsigned char*)d_ws; a.pad0 = 0; a.pad1 = 0;
#ifdef VERIFY
    hipFuncSetAttribute((const void*)verify_k, hipFuncAttributeMaxDynamicSharedMemorySize, LDS_BYTES);
    for (int pass = 0; pass < 3; ++pass) { a.pad0 = pass + 1; a.ph_lo = 0; a.ph_hi = 6;
        (void)hipMemsetAsync((char*)d_ws + WS_CTL, 0, 65536 * 4, stream);
        hipLaunchKernelGGL(nsa_fwd, dim3(grid), dim3(512), LDS_BYTES, stream, a);
        hipLaunchKernelGGL(verify_k, dim3(grid), dim3(512), LDS_BYTES, stream, a); }
    a.pad0 = 0; (void)hipMemsetAsync((char*)d_ws + WS_CTL, 0, 65536 * 4, stream);
    a.ph_lo = 0; a.ph_hi = NPHASE;
    hipLaunchKernelGGL(nsa_fwd, dim3(grid), dim3(512), LDS_BYTES, stream, a);
    hipLaunchKernelGGL(scale_k, dim3(64, 6), dim3(256), 0, stream, a);
#elif MK_SPLIT
    for (int p = 0; p < NPHASE; ++p) { a.ph_lo = p; a.ph_hi = p + 1; hipLaunchKernelGGL(nsa_fwd, dim3(grid), dim3(512), LDS_BYTES, stream, a); }
#else
    a.ph_lo = 0; a.ph_hi = NPHASE;
    hipLaunchKernelGGL(nsa_fwd, dim3(grid), dim3(512), LDS_BYTES, stream, a);
#endif
    const hipError_t le = hipPeekAtLastError();
    if (le != hipSuccess) fprintf(stderr, "kernel_launch: launch failed: %s\n", hipGetErrorName(le));
}
```

```cpp
#include <hip/hip_runtime.h>
#include <cstdio>
#include <cstdint>

#ifndef MK_SPLIT
#define MK_SPLIT 0
#endif

#define GAS __attribute__((address_space(1)))
#define LAS __attribute__((address_space(3)))
typedef unsigned short bf16_t;
typedef short bf16x8 __attribute__((ext_vector_type(8)));
typedef short s16x4 __attribute__((ext_vector_type(4)));
typedef float f32x2 __attribute__((ext_vector_type(2)));
typedef float f32x4 __attribute__((ext_vector_type(4)));
typedef float f32x16 __attribute__((ext_vector_type(16)));
typedef unsigned u32x2 __attribute__((ext_vector_type(2)));
typedef unsigned u32x4 __attribute__((ext_vector_type(4)));
typedef __bf16 bf16x2_t __attribute__((ext_vector_type(2)));
typedef GAS unsigned gu32;

constexpr int D = 1024, SEQ = 4096, NB = 4, NSB = 128, DSEQ = 4;
constexpr int MP = NB * SEQ, MS = NSB * DSEQ, MT = MP + MS;
constexpr int INCOLS = 2608, NPROJ = 2816, FF = 2816, NGU = 2 * FF;
constexpr int NMODB = NB + NSB;
constexpr int PAST = 2048;
constexpr float C2 = 0.125f * 1.4426950408889634f;
constexpr float LOG2E = 1.4426950408889634f;

constexpr size_t O_YP = 0, O_YS = O_YP + (size_t)MP * D;
constexpr size_t O_KCP = O_YS + (size_t)MS * D, SZ_KVP = (size_t)MP * 256;
constexpr size_t O_KWP = O_KCP + 4 * SZ_KVP, SZ_WP = (size_t)NB * 512 * 256;
constexpr size_t O_PLP = O_KWP + 2 * SZ_WP;
constexpr size_t O_KCS = O_PLP + (size_t)NB * 15 * D, SZ_KVS = (size_t)MS * 256;
constexpr size_t O_KWS = O_KCS + 4 * SZ_KVS, SZ_WS = (size_t)NSB * 512 * 256;
constexpr size_t O_PLS = O_KWS + 2 * SZ_WS;
constexpr size_t O_END = O_PLS + (size_t)NSB * 15 * D;
static_assert(O_END == 71233536, "output size");

constexpr size_t MiB = 1u << 20;
#ifdef VERIFY
constexpr size_t WS_CTL = 0, CTL_ZERO_BYTES = 1 * MiB;
#else
constexpr size_t WS_CTL = 0, CTL_ZERO_BYTES = 65536;
#endif
constexpr size_t WS_WIN = 2 * MiB;
constexpr size_t WS_WOUT = 8 * MiB;
constexpr size_t WS_WGU = 10 * MiB;
constexpr size_t WS_WD = 32 * MiB;
constexpr size_t WS_WPOOL = 44 * MiB;
constexpr size_t WS_WCK = 45 * MiB, WS_WCV = WS_WCK + 262144;
constexpr size_t WS_SC = 46 * MiB;
constexpr size_t WS_CB = 47 * MiB;
constexpr size_t WS_MOD = 48 * MiB;
constexpr size_t WS_KCMPP = 56 * MiB, WS_VCMPP = 57 * MiB;
constexpr size_t WS_KCMPS = 58 * MiB, WS_VCMPS = 62 * MiB;
constexpr size_t WS_GATES = 66 * MiB;
constexpr size_t WS_H = 72 * MiB;
constexpr size_t WS_Q = 108 * MiB;
constexpr size_t WS_O = 144 * MiB;
constexpr size_t WS_KV = 180 * MiB, KV_STRIDE = (size_t)MT * 256;
constexpr size_t WS_X = 232 * MiB;
constexpr size_t WS_HF = 300 * MiB;
constexpr size_t WS_ACT = 368 * MiB;
constexpr size_t WS_END = 464 * MiB;
static_assert(WS_KV + 6 * KV_STRIDE * 2 <= WS_X && WS_X + (size_t)MT * D * 4 <= WS_HF && WS_HF + (size_t)MT * D * 4 <= WS_ACT && WS_ACT + (size_t)MT * FF * 2 <= WS_END, "ws map");
static_assert(WS_WGU + 2 * (size_t)NGU * D * 2 <= WS_WD && WS_WD + 2 * (size_t)D * FF * 2 <= WS_WPOOL && WS_MOD + 2 * (size_t)NMODB * 6144 * 4 <= WS_KCMPP, "ws map 2");
static_assert(WS_GATES + (size_t)MT * 48 * 4 <= WS_H && WS_H + (size_t)MT * D * 2 <= WS_Q && WS_Q + (size_t)MT * D * 2 <= WS_O && WS_O + (size_t)MT * D * 2 <= WS_KV, "ws map 3");
constexpr int CW_BAR = 4096;

constexpr int RING_BYTES = 131072;
constexpr int LUT_OFF = RING_BYTES;
constexpr int WSF_OFF = LUT_OFF + 8192;
constexpr int IMP_OFF = WSF_OFF + 1024;
constexpr int MISC_OFF = IMP_OFF + 16384;
constexpr int LDS_BYTES = MISC_OFF + 256;
static_assert(LDS_BYTES <= 160 * 1024, "LDS");

__device__ __forceinline__ unsigned cvtpk(float lo, float hi) { f32x2 v = {lo, hi}; bf16x2_t b = __builtin_convertvector(v, bf16x2_t); return __builtin_bit_cast(unsigned, b); }
__device__ __forceinline__ float bf2f(unsigned short h) { return __builtin_bit_cast(float, (unsigned)h << 16); }
__device__ __forceinline__ float ex2(float x) { return __builtin_amdgcn_exp2f(x); }
__device__ __forceinline__ float sigmoidf_(float x) { return __builtin_amdgcn_rcpf(1.0f + ex2(-x * LOG2E)); }
#define CROW0(r) (((r) & 3) + 8 * ((r) >> 2))
#define LDS_WAIT() asm volatile("s_waitcnt lgkmcnt(0)" ::: "memory")
#define VM_WAIT() asm volatile("s_waitcnt vmcnt(0)" ::: "memory")
__device__ __forceinline__ const char* uniform_ptr(const void* p) { const unsigned long long v = (unsigned long long)p; const unsigned lo = (unsigned)__builtin_amdgcn_readfirstlane((int)(unsigned)v), hi = (unsigned)__builtin_amdgcn_readfirstlane((int)(unsigned)(v >> 32)); return (const char*)(((unsigned long long)hi << 32) | lo); }

__device__ __forceinline__ int t5_bucket(int d) {
    if (d < 16) return d;
    int b = 16;
    b += (d >= 19) + (d >= 21) + (d >= 24) + (d >= 27) + (d >= 31) + (d >= 35) + (d >= 40) + (d >= 46) + (d >= 52) + (d >= 59) + (d >= 67) + (d >= 77) + (d >= 87) + (d >= 99) + (d >= 113);
    return b;
}

namespace pg8 {
constexpr int BM = 256, BK = 64, HALF = 128, HTB = HALF * BK * 2, STAGE_BYTES = 8 * HTB, NXCD = 8, WGM = 8;
__host__ __device__ __forceinline__ int lds_byte(int r, int c) { const int st = (r >> 4) * 2 + (c >> 5), rr = r & 15, cc = c & 31, ob = rr * 64 + cc * 2; return st * 1024 + (ob ^ (((ob >> 9) & 1) << 5)); }
__host__ __device__ __forceinline__ void stage_rc(int b, int& R, int& C) { const int st = b / 1024, sb = b % 1024, swz = sb ^ (((sb >> 9) & 1) << 5); R = (st >> 1) * 16 + swz / 64; C = (st & 1) * 32 + (swz % 64) / 2; }
__host__ __device__ __forceinline__ int perm32(int rho) { const int n = rho >> 4, i = rho & 15; return 8 * (i >> 2) + 4 * n + (i & 3); }
struct Unit { int pm, pn; };
struct Gemm { const bf16_t* A; const bf16_t* Bt; int lda, ldb, K, acs; };
struct StaticOrder {
    int nM, nN, nwg, G, c;
    __host__ __device__ void init(int M, int N, int G_, int c_) { nM = M / BM; nN = N / BM; nwg = nM * nN; G = G_; c = c_; }
    __host__ __device__ bool next(int i, Unit& u) const {
        const long L = (long)i * G + c; if (L >= nwg) return false;
        int wgid = (int)L; { const int q = nwg / NXCD, r = nwg % NXCD, xcd = wgid % NXCD, off = wgid / NXCD; wgid = (xcd < r ? xcd * (q + 1) : r * (q + 1) + (xcd - r) * q) + off; }
        const int nig = WGM * nN, gid = wgid / nig, fm = gid * WGM, gsz = (nM - fm) < WGM ? (nM - fm) : WGM;
        u.pm = fm + ((wgid % nig) % gsz); u.pn = (wgid % nig) / gsz; return true;
    }
};
template <class Epi, class Sched, bool ALIGN_EPI>
__device__ __forceinline__ void gemm_phase(LAS unsigned char* lds, const Gemm g, const Sched& S, const Epi& E) {
    const int tid = threadIdx.x, wid = __builtin_amdgcn_readfirstlane(tid >> 6), lane = tid & 63, wr = wid >> 2, wc = wid & 3, fr = lane & 15, fq = lane >> 4;
    const int K = g.K, nt = K / BK;
    unsigned voffA[2], voffB[2];
#pragma unroll
    for (int i = 0; i < 2; ++i) { int R, C; stage_rc(tid * 16 + i * 8192, R, C); const int Rb = Epi::PERM ? ((R & ~31) + perm32(R & 31)) : R;
        voffA[i] = (unsigned)(R * g.lda + C) * 2u; voffB[i] = (unsigned)(Rb * g.ldb + C) * 2u; }
    const size_t kstep = (size_t)(BK * 2);
    const size_t hsA = (size_t)HALF * g.lda * 2, hsB = (size_t)HALF * g.ldb * 2;
    const unsigned ldsw = (unsigned)wid * 1024u;
    const int aoff = lds_byte(wr * 64 + fr, fq * 8), boff = lds_byte(wc * 32 + fr, fq * 8);
#define PG8_SA(b, h) (((b) * 2 + (h)) * HTB)
#define PG8_SB(b, h) ((4 + (b) * 2 + (h)) * HTB)
#define PG8_STAGE(bufoff, gbase, voff) do { _Pragma("unroll") for (int _i = 0; _i < 2; ++_i) \
        __builtin_amdgcn_global_load_lds((const unsigned*)((const char*)(gbase) + (voff)[_i]), (LAS unsigned*)(lds + (bufoff) + ldsw + _i * 8192), 16, 0, 0); } while (0)
#define PG8_LDA(dst, b, h) do { _Pragma("unroll") for (int m = 0; m < 4; ++m) _Pragma("unroll") for (int k = 0; k < 2; ++k) dst[m][k] = *(const LAS bf16x8*)(lds + PG8_SA(b, h) + aoff + m * 2048 + k * 1024); } while (0)
#define PG8_LDB(dst, b, h) do { _Pragma("unroll") for (int n = 0; n < 2; ++n) _Pragma("unroll") for (int k = 0; k < 2; ++k) dst[n][k] = *(const LAS bf16x8*)(lds + PG8_SB(b, h) + boff + n * 2048 + k * 1024); } while (0)
#define PG8_MMA(ai, bj, At, Bt) do { __builtin_amdgcn_s_setprio(1); _Pragma("unroll") for (int m = 0; m < 4; ++m) _Pragma("unroll") for (int n = 0; n < 2; ++n) _Pragma("unroll") for (int k = 0; k < 2; ++k) \
        acc[ai][bj][m][n] = __builtin_amdgcn_mfma_f32_16x16x32_bf16(Bt[n][k], At[m][k], acc[ai][bj][m][n], 0, 0, 0); __builtin_amdgcn_s_setprio(0); } while (0)
#define PG8_WAIT_V(n) asm volatile("s_waitcnt vmcnt(" #n ")" ::: "memory")
#define PG8_WAIT_L(n) asm volatile("s_waitcnt lgkmcnt(" #n ")" ::: "memory")
#define PG8_BAR __builtin_amdgcn_s_barrier()
#define PG8_SCHED __builtin_amdgcn_sched_barrier(0)
#define PG8_UA(u) ((const char*)g.A + (size_t)(u).pm * 2 * hsA + (size_t)(u).pn * (size_t)g.acs * 2)
#define PG8_UB(u) ((const char*)g.Bt + (size_t)(u).pn * 2 * hsB)
    Unit cur, nxt; int ui = 0;
    if (!S.next(0, cur)) return;
    f32x4 acc[2][2][4][2];
#pragma unroll
    for (int a = 0; a < 2; ++a)
#pragma unroll
        for (int b = 0; b < 2; ++b)
#pragma unroll
            for (int m = 0; m < 4; ++m)
#pragma unroll
                for (int n = 0; n < 2; ++n) acc[a][b][m][n] = (f32x4){0.f, 0.f, 0.f, 0.f};
    bf16x8 At[4][2], B0[2][2], B1[2][2];
    const char* cA = PG8_UA(cur); const char* cB = PG8_UB(cur);
    PG8_STAGE(PG8_SB(0, 0), cB, voffB); PG8_STAGE(PG8_SB(0, 1), cB + hsB, voffB); PG8_STAGE(PG8_SA(0, 0), cA, voffA); PG8_STAGE(PG8_SA(0, 1), cA + hsA, voffA);
    if (wr == 1) PG8_BAR;
    PG8_WAIT_V(2); PG8_BAR;
    PG8_STAGE(PG8_SB(1, 0), cB + kstep, voffB); PG8_STAGE(PG8_SA(1, 0), cA + kstep, voffA); PG8_STAGE(PG8_SB(1, 1), cB + hsB + kstep, voffB);
    PG8_WAIT_V(6); PG8_BAR;
    for (;;) {
        const bool has_next = S.next(ui + 1, nxt);
        const char* nA = has_next ? PG8_UA(nxt) : cA; const char* nB = has_next ? PG8_UB(nxt) : cB;
        for (int t = 0; t < nt; t += 2) {
            const bool last = (t == nt - 2);
            const char* a1 = cA + (size_t)(t + 1) * kstep;
            const char* a2 = last ? nA : cA + (size_t)(t + 2) * kstep; const char* b2 = last ? nB : cB + (size_t)(t + 2) * kstep;
            const char* a3 = a2 + kstep; const char* b3 = b2 + kstep;
            PG8_LDB(B0, 0, 0); PG8_LDB(B1, 0, 1); PG8_SCHED; PG8_LDA(At, 0, 0); PG8_STAGE(PG8_SA(1, 1), a1 + hsA, voffA);
            PG8_WAIT_V(8); PG8_WAIT_L(0); PG8_BAR; PG8_MMA(0, 0, At, B0); PG8_MMA(0, 1, At, B1); PG8_BAR; PG8_SCHED;
            PG8_LDA(At, 0, 1); PG8_STAGE(PG8_SB(0, 0), b2, voffB); PG8_STAGE(PG8_SB(0, 1), b2 + hsB, voffB); PG8_STAGE(PG8_SA(0, 0), a2, voffA);
            PG8_WAIT_V(8); PG8_WAIT_L(0); PG8_BAR; PG8_MMA(1, 0, At, B0); PG8_MMA(1, 1, At, B1); PG8_BAR; PG8_SCHED;
            PG8_LDB(B0, 1, 0); PG8_LDB(B1, 1, 1); PG8_SCHED; PG8_LDA(At, 1, 0); PG8_STAGE(PG8_SA(0, 1), a2 + hsA, voffA);
            PG8_WAIT_V(8); PG8_WAIT_L(0); PG8_BAR; PG8_MMA(0, 0, At, B0); PG8_MMA(0, 1, At, B1); PG8_BAR; PG8_SCHED;
            PG8_LDA(At, 1, 1); PG8_STAGE(PG8_SB(1, 0), b3, voffB); PG8_STAGE(PG8_SB(1, 1), b3 + hsB, voffB); PG8_STAGE(PG8_SA(1, 0), a3, voffA);
            PG8_WAIT_V(8); PG8_WAIT_L(0); PG8_BAR; PG8_MMA(1, 0, At, B0); PG8_MMA(1, 1, At, B1); PG8_BAR; PG8_SCHED;
        }
        if constexpr (ALIGN_EPI) { if (wr == 0) PG8_BAR; }
        E(acc, cur, wr, wc, fr, fq);
        if (!has_next) break;
#pragma unroll
        for (int a = 0; a < 2; ++a)
#pragma unroll
            for (int b = 0; b < 2; ++b)
#pragma unroll
                for (int m = 0; m < 4; ++m)
#pragma unroll
                    for (int n = 0; n < 2; ++n) acc[a][b][m][n] = (f32x4){0.f, 0.f, 0.f, 0.f};
        cur = nxt; cA = nA; cB = nB; ++ui;
        if constexpr (ALIGN_EPI) { if (wr == 1) PG8_BAR; }
    }
    PG8_WAIT_V(0);
    if constexpr (!ALIGN_EPI) { if (wr == 0) PG8_BAR; }
    PG8_BAR;
#undef PG8_SA
#undef PG8_SB
#undef PG8_STAGE
#undef PG8_LDA
#undef PG8_LDB
#undef PG8_MMA
#undef PG8_WAIT_V
#undef PG8_WAIT_L
#undef PG8_BAR
#undef PG8_SCHED
#undef PG8_UA
#undef PG8_UB
}

struct EpiProj {
    static constexpr bool PERM = true;
    bf16_t* Q; bf16_t* KV; float* gates; float* out;
    __device__ __forceinline__ void operator()(const f32x4 (&acc)[2][2][4][2], const Unit& u, int wr, int wc, int fr, int fq) const {
        const int pn = u.pn;
#pragma unroll
        for (int ai = 0; ai < 2; ++ai)
#pragma unroll
            for (int m = 0; m < 4; ++m) {
                const int row = u.pm * BM + ai * HALF + wr * 64 + m * 16 + fr;
                if (pn < 4) {
#pragma unroll
                    for (int bj = 0; bj < 2; ++bj) { const f32x4 v0 = acc[ai][bj][m][0] * C2, v1 = acc[ai][bj][m][1] * C2; u32x4 w;
                        w.x = cvtpk(v0[0], v0[1]); w.y = cvtpk(v0[2], v0[3]); w.z = cvtpk(v1[0], v1[1]); w.w = cvtpk(v1[2], v1[3]);
                        *(u32x4*)(Q + (size_t)row * D + pn * 256 + bj * HALF + wc * 32 + 8 * fq) = w; }
                } else if (pn < 10) {
                    const int t = pn - 4; float* dst = nullptr;
                    if (row < MP) { if (t < 4) dst = out + O_KCP + (size_t)t * SZ_KVP + (size_t)row * 256; else { const int tt = row & (SEQ - 1); if (tt >= SEQ - 512) dst = out + O_KWP + (size_t)(t - 4) * SZ_WP + ((size_t)(row >> 12) * 512 + (tt - (SEQ - 512))) * 256; } }
                    else { const int rs = row - MP; if (t < 4) dst = out + O_KCS + (size_t)t * SZ_KVS + (size_t)rs * 256; else dst = out + O_KWS + (size_t)(t - 4) * SZ_WS + ((size_t)(rs >> 2) * 512 + 508 + (rs & 3)) * 256; }
                    bf16_t* bd = KV + (size_t)t * KV_STRIDE + (size_t)row * 256;
#pragma unroll
                    for (int bj = 0; bj < 2; ++bj) { const int cc = bj * HALF + wc * 32 + 8 * fq; const f32x4 v0 = acc[ai][bj][m][0], v1 = acc[ai][bj][m][1]; u32x4 w;
                        w.x = cvtpk(v0[0], v0[1]); w.y = cvtpk(v0[2], v0[3]); w.z = cvtpk(v1[0], v1[1]); w.w = cvtpk(v1[2], v1[3]);
                        *(u32x4*)(bd + cc) = w;
                        if (dst) { *(f32x4*)(dst + cc) = v0; *(f32x4*)(dst + cc + 4) = v1; } }
                } else {
                    const int cc = wc * 32 + 8 * fq;
                    if (cc < 48) { float* gd = gates + (size_t)row * 48 + cc; *(f32x4*)gd = acc[ai][0][m][0]; *(f32x4*)(gd + 4) = acc[ai][0][m][1]; }
                }
            }
    }
};
struct EpiRes {
    static constexpr bool PERM = false;
    const float* xin_p; const float* xin_s; float* xout; const float* gate; const float* scale;
    __device__ __forceinline__ void operator()(const f32x4 (&acc)[2][2][4][2], const Unit& u, int wr, int wc, int fr, int fq) const {
#pragma unroll
        for (int ai = 0; ai < 2; ++ai)
#pragma unroll
            for (int m = 0; m < 4; ++m) {
                const int row = u.pm * BM + ai * HALF + wr * 64 + m * 16 + fr;
                const int bb = row < MP ? (row >> 12) : NB + ((row - MP) >> 2);
                const float* xi = row < MP ? xin_p + (size_t)row * D : xin_s + (size_t)(row - MP) * D;
                const float* gp = gate + (size_t)bb * 6144; float* xo = xout + (size_t)row * D;
#pragma unroll
                for (int bj = 0; bj < 2; ++bj)
#pragma unroll
                    for (int n = 0; n < 2; ++n) { const int col = u.pn * BM + bj * HALF + wc * 32 + 16 * n + 4 * fq;
                        f32x4 g4 = *(const f32x4*)(gp + col); if (scale) g4 = g4 * *(const f32x4*)(scale + col);
                        const f32x4 x4 = *(const f32x4*)(xi + col); *(f32x4*)(xo + col) = x4 + g4 * acc[ai][bj][m][n]; }
            }
    }
};
struct EpiGU {
    static constexpr bool PERM = true;
    bf16_t* act;
    __device__ __forceinline__ void operator()(const f32x4 (&acc)[2][2][4][2], const Unit& u, int wr, int wc, int fr, int fq) const {
#pragma unroll
        for (int ai = 0; ai < 2; ++ai)
#pragma unroll
            for (int m = 0; m < 4; ++m) {
                const int row = u.pm * BM + ai * HALF + wr * 64 + m * 16 + fr; float r[8];
#pragma unroll
                for (int n = 0; n < 2; ++n)
#pragma unroll
                    for (int e = 0; e < 4; ++e) { const float gv = acc[ai][0][m][n][e], uv = acc[ai][1][m][n][e]; r[n * 4 + e] = gv * sigmoidf_(gv) * uv; }
                u32x4 w; w.x = cvtpk(r[0], r[1]); w.y = cvtpk(r[2], r[3]); w.z = cvtpk(r[4], r[5]); w.w = cvtpk(r[6], r[7]);
                *(u32x4*)(act + (size_t)row * FF + u.pn * HALF + wc * 32 + 8 * fq) = w;
            }
    }
};
}

#define XB_TMO      128
#define XB_XCNT(j)  (256  + 64 * (j))
#define XB_XSUB(j)  (1280 + 64 * (j))
#define XB_XGEN(j)  (2304 + 64 * (j))
#define XB_TOP      3328
#define XB_TOPGEN   3392
#define XCD_BAR_WORDS 3456
#define XB_SPIN_CAP (1u << 18)
__device__ __forceinline__ unsigned xb_ld(unsigned* p)              { return __hip_atomic_load(p, __ATOMIC_RELAXED, __HIP_MEMORY_SCOPE_AGENT); }
__device__ __forceinline__ unsigned xb_add(unsigned* p, unsigned v) { return __hip_atomic_fetch_add(p, v, __ATOMIC_RELAXED, __HIP_MEMORY_SCOPE_AGENT); }
__device__ __forceinline__ unsigned xb_xcc_id() { return (unsigned)__builtin_amdgcn_s_getreg((3 << 11) | 20) & 0xFu; }
#define XB_SPIN(cond, bar) do { unsigned _sp = 0; while (cond) { __builtin_amdgcn_s_sleep(1); \
    if ((++_sp & 255u) == 0u) { if (xb_ld(&(bar)[XB_TMO])) break; if (_sp > XB_SPIN_CAP) { atomicAdd(&(bar)[XB_TMO], 1u); break; } } } } while (0)
struct XcdBarrier { unsigned* bar; unsigned x; volatile LAS unsigned* st; };
__device__ __forceinline__ XcdBarrier xcd_barrier_post(unsigned* bar, volatile LAS unsigned* st) {
    XcdBarrier b; b.bar = bar; b.x = xb_xcc_id(); b.st = st;
    if (threadIdx.x == 0) (void)xb_add(&bar[XB_XCNT(b.x)], 1u);
    return b;
}
__device__ __forceinline__ void xcd_barrier_complete(unsigned* bar, unsigned x, unsigned& nloc, unsigned& nx) {
    const unsigned G = gridDim.x * gridDim.y * gridDim.z;
    unsigned sum, cnt, mine, sp = 0u;
    for (;;) {
        sum = 0u; cnt = 0u; mine = 0u;
#pragma unroll
        for (unsigned j = 0; j < 16; ++j) { const unsigned c = xb_ld(&bar[XB_XCNT(j)]); sum += c; cnt += (c > 0u) ? 1u : 0u; mine = (j == x) ? c : mine; }
        if (sum == G) break;
        __builtin_amdgcn_s_sleep(1);
        if ((++sp & 255u) == 0u) { if (xb_ld(&bar[XB_TMO])) break; if (sp > XB_SPIN_CAP) { atomicAdd(&bar[XB_TMO], 1u); break; } }
    }
    nloc = mine > 0u ? mine : 1u; nx = cnt > 0u ? cnt : 1u;
}
__device__ __forceinline__ void xcd_barrier(const XcdBarrier& b) {
    asm volatile("s_waitcnt vmcnt(0)" ::: "memory");
    __syncthreads();
    if (threadIdx.x == 0) {
        unsigned* bar = b.bar;
        __builtin_amdgcn_s_waitcnt(0);
        unsigned nloc = b.st[0], nx = b.st[1];
        if (nloc == 0u) { xcd_barrier_complete(bar, b.x, nloc, nx); b.st[0] = nloc; b.st[1] = nx; }
        const unsigned old = xb_add(&bar[XB_XSUB(b.x)], 1u);
        const unsigned gen = old / nloc;
        if (old + 1u == (gen + 1u) * nloc) {
            __builtin_amdgcn_fence(__ATOMIC_RELEASE, "agent");
            asm volatile("s_waitcnt vmcnt(0)" ::: "memory");
            const unsigned og = xb_add(&bar[XB_TOP], 1u);
            const unsigned tg = og / nx;
            if (og + 1u == (tg + 1u) * nx) xb_add(&bar[XB_TOPGEN], 1u);
            else XB_SPIN(xb_ld(&bar[XB_TOPGEN]) == tg, bar);
            __builtin_amdgcn_fence(__ATOMIC_ACQUIRE, "agent");
            xb_add(&bar[XB_XGEN(b.x)], 1u);
            asm volatile("s_waitcnt vmcnt(0)" ::: "memory");
        } else {
            XB_SPIN(xb_ld(&bar[XB_XGEN(b.x)]) == gen, bar);
            __builtin_amdgcn_fence(__ATOMIC_ACQUIRE, "agent");
            asm volatile("s_waitcnt vmcnt(0)" ::: "memory");
        }
    }
    __syncthreads();
}

struct Args { const void* in[28]; float* out; unsigned char* ws; int ph_lo, ph_hi, pad0, pad1; };
struct Frame {
    LAS unsigned char* lds; int tid, lane, wave, vcu, G;
    const float *x_p, *x_s, *c_p, *c_s, *ck_cmp, *cv_cmp, *ck_sel, *cv_sel; const int* page_table; const float *st_kw, *st_vw, *st_pool, *rel_bias, *ada_w, *ada_b, *norm_g, *final_g,
        *w_in, *w_out, *cmp_wk, *cmp_wv, *pe_k, *pe_v, *pool_w, *pool_scale, *ffn_wg, *ffn_wu, *ffn_wd;
    float* out; unsigned char* ws;
};
__device__ __forceinline__ float wave_sum(float v) {
#pragma unroll
    for (int o = 1; o < 64; o <<= 1) v += __shfl_xor(v, o);
    return v;
}

__device__ __forceinline__ void transpose_item(const float* W, int ldw, int nvalid, bf16_t* WT, int ldt, int drow0, LAS float* scr, int k0, int n0, int lane) {
    float tv[32];
#pragma unroll
    for (int i = 0; i < 32; ++i) { const int kk = 2 * i + (lane >> 5), n = n0 + (lane & 31); tv[i] = (n < nvalid) ? W[(size_t)(k0 + kk) * ldw + n] : 0.f; }
#pragma unroll
    for (int i = 0; i < 32; ++i) { const int kk = 2 * i + (lane >> 5); scr[kk * 33 + (lane & 31)] = tv[i]; }
    LDS_WAIT();
    const int c = lane & 7;
#pragma unroll
    for (int j = 0; j < 4; ++j) { const int n = (lane >> 3) + 8 * j; const LAS float* s = scr + (8 * c) * 33 + n;
        u32x4 o; o.x = cvtpk(s[0 * 33], s[1 * 33]); o.y = cvtpk(s[2 * 33], s[3 * 33]); o.z = cvtpk(s[4 * 33], s[5 * 33]); o.w = cvtpk(s[6 * 33], s[7 * 33]);
        *(u32x4*)(WT + (size_t)(drow0 + n) * ldt + k0 + 8 * c) = o; }
    LDS_WAIT();
}
__device__ __forceinline__ void p0_prologue(Frame& F) {
    LAS float* scr = (LAS float*)(F.lds + F.wave * 16384);
    const int gw = F.vcu * 8 + F.wave, NGW = F.G * 8, lane = F.lane;
    unsigned char* ws = F.ws;
    constexpr int I_IN = 16 * 88, I_OUT = 16 * 32, I_G = 16 * 88, I_D = 44 * 32, I_P = 4 * 8, I_C = 32 * 2;
    constexpr int NITEMS = I_IN + I_OUT + 4 * I_G + 2 * I_D + 4 * I_P + 2 * I_C;
    for (int it = gw; it < NITEMS; it += NGW) {
        int r = it;
        if (r < I_IN) { const int kb = r / 88, nb = r % 88; transpose_item(F.w_in, INCOLS, INCOLS, (bf16_t*)(ws + WS_WIN), D, nb * 32, scr, kb * 64, nb * 32, lane); continue; } r -= I_IN;
        if (r < I_OUT) { const int kb = r / 32, nb = r % 32; transpose_item(F.w_out, D, D, (bf16_t*)(ws + WS_WOUT), D, nb * 32, scr, kb * 64, nb * 32, lane); continue; } r -= I_OUT;
        if (r < 4 * I_G) { const int l = r / (2 * I_G), which = (r / I_G) & 1, q = r % I_G, kb = q / 88, nb = q % 88, n0 = nb * 32;
            const float* W = (which ? F.ffn_wu : F.ffn_wg) + (size_t)l * D * FF;
            transpose_item(W, FF, FF, (bf16_t*)(ws + WS_WGU) + (size_t)l * NGU * D, D, (n0 >> 7) * 256 + which * 128 + (n0 & 127), scr, kb * 64, n0, lane); continue; } r -= 4 * I_G;
        if (r < 2 * I_D) { const int l = r / I_D, q = r % I_D, kb = q / 32, nb = q % 32;
            transpose_item(F.ffn_wd + (size_t)l * FF * D, D, D, (bf16_t*)(ws + WS_WD) + (size_t)l * D * FF, FF, nb * 32, scr, kb * 64, nb * 32, lane); continue; } r -= 2 * I_D;
        if (r < 4 * I_P) { const int gI = r / I_P, q = r % I_P, kb = q / 8, nb = q % 8;
            transpose_item(F.pool_w + (size_t)gI * 65536, 256, 256, (bf16_t*)(ws + WS_WPOOL) + (size_t)gI * 65536, 256, nb * 32, scr, kb * 64, nb * 32, lane); continue; } r -= 4 * I_P;
        { const int which = r / I_C, q = r % I_C, kb = q / 2, nb = q % 2;
          transpose_item(which ? F.cmp_wv : F.cmp_wk, 64, 64, (bf16_t*)(ws + (which ? WS_WCV : WS_WCK)), 2048, nb * 32, scr, kb * 64, nb * 32, lane); }
    }
    { const int gt = (F.vcu * 8 + F.wave) * 64 + lane, NT = F.G * 512; bf16_t* sc = (bf16_t*)(ws + WS_SC);
      for (int i = gt; i < 144 * 512; i += NT) { const int row = i >> 9, c2 = (i & 511) * 2; float a = 0.f, b = 0.f;
          if (row < NMODB) { const float* cp = row < NB ? F.c_p + (size_t)row * D : F.c_s + (size_t)(row - NB) * D; const float x0 = cp[c2], x1 = cp[c2 + 1]; a = x0 * sigmoidf_(x0); b = x1 * sigmoidf_(x1); }
          *(unsigned*)(sc + (size_t)row * D + c2) = cvtpk(a, b); } }
    if (F.vcu < 16) { const int tsel = F.vcu >> 3, part = F.vcu & 7; const float* pe = tsel ? F.pe_v : F.pe_k; const float* W = tsel ? F.cmp_wv : F.cmp_wk; float sacc = 0.f;
        const int kb = part * 256 + F.wave * 32;
#pragma unroll
        for (int k = 0; k < 32; ++k) sacc += pe[kb + k] * W[(size_t)(kb + k) * 64 + lane];
        LAS float* red = (LAS float*)(F.lds + WSF_OFF);
        red[F.wave * 64 + lane] = sacc; LDS_WAIT(); __syncthreads();
        if (F.wave == 0) { float t2 = 0.f;
#pragma unroll
            for (int w = 0; w < 8; ++w) t2 += red[w * 64 + lane];
            ((float*)(ws + WS_CB))[(tsel * 8 + part) * 64 + lane] = t2; }
        __syncthreads(); }
    { const size_t gt = (size_t)(F.vcu * 8 + F.wave) * 64 + lane, NT = (size_t)F.G * 512;
      const size_t pp = (size_t)NSB * 11 * 256;
      for (size_t i = gt; i < pp; i += NT) { const size_t b = i / (11 * 256), rem = i % (11 * 256);
          ((f32x4*)(F.out + O_PLS + b * 15 * D))[rem] = ((const f32x4*)(F.st_pool + (b * 15 + 4) * D))[rem]; } }
}

__device__ __forceinline__ void p1_ada(Frame& F) {
    const int gw = F.vcu * 8 + F.wave, NGW = F.G * 8, lane = F.lane, fr = lane & 15, kq = lane >> 4;
    const bf16_t* sc = (const bf16_t*)(F.ws + WS_SC); float* mod = (float*)(F.ws + WS_MOD);
    for (int tile = F.wave < 3 ? F.vcu * 3 + F.wave : 768; tile < 768; tile += F.G * 3) {
        const int layer = tile / 384, n0 = (tile % 384) * 16;
        const float* W = F.ada_w + (size_t)layer * D * 6144 + n0 + fr;
        f32x4 acc[9];
#pragma unroll
        for (int i = 0; i < 9; ++i) acc[i] = (f32x4){0.f, 0.f, 0.f, 0.f};
#pragma unroll 4
        for (int k0 = 0; k0 < D; k0 += 32) {
            float w[8];
#pragma unroll
            for (int i = 0; i < 8; ++i) w[i] = W[(size_t)(k0 + 8 * kq + i) * 6144];
            u32x4 bw; bw.x = cvtpk(w[0], w[1]); bw.y = cvtpk(w[2], w[3]); bw.z = cvtpk(w[4], w[5]); bw.w = cvtpk(w[6], w[7]);
            const bf16x8 bfrag = __builtin_bit_cast(bf16x8, bw);
#pragma unroll
            for (int mt = 0; mt < 9; ++mt) { const bf16x8 af = *(const bf16x8*)(sc + (size_t)(mt * 16 + fr) * D + k0 + 8 * kq);
                acc[mt] = __builtin_amdgcn_mfma_f32_16x16x32_bf16(af, bfrag, acc[mt], 0, 0, 0); }
        }
        const float bias = F.ada_b[layer * 6144 + n0 + fr];
#pragma unroll
        for (int mt = 0; mt < 9; ++mt)
#pragma unroll
            for (int e = 0; e < 4; ++e) { const int row = mt * 16 + 4 * kq + e; if (row < NMODB) mod[((size_t)layer * NMODB + row) * 6144 + n0 + fr] = acc[mt][e] + bias; }
    }
}

__device__ __forceinline__ void p1_compress_sample(Frame& F) {
    const int lane = F.lane, wave = F.wave, r32 = lane & 31, hi = lane >> 5, kvl = lane >> 4, c4 = lane & 15;
    LAS unsigned char* L = F.lds;
    const int wrow = wave * 4 + kvl, total = 2 * NSB * 8;
    const int nitem = (total - F.vcu + F.G - 1) / F.G; if (nitem <= 0) return;
    const int nstage = 2 * nitem;
#define CS_BAR() do { asm volatile("s_waitcnt lgkmcnt(0)" ::: "memory"); __builtin_amdgcn_s_barrier(); asm volatile("" ::: "memory"); } while (0)
#define CS_SRC(g, ptr) do { const int it_ = F.vcu + F.G * ((g) >> 1); const int wh_ = it_ / (NSB * 8), q_ = it_ % (NSB * 8), b_ = q_ >> 3, n_ = (q_ & 7) * 8 + wave; const int pg_ = F.page_table[b_ * 16 + (n_ >> 2)]; \
        ptr = uniform_ptr((wh_ ? F.cv_cmp : F.ck_cmp) + ((size_t)pg_ * 128 + (n_ & 3) * 32 + ((g) & 1) * 16) * 256); } while (0)
#define CS_LOAD(ptr) do { _Pragma("unroll") for (int jj = 0; jj < 16; ++jj) x[jj] = *(const f32x4*)((ptr) + (unsigned)(jj * 1024 + lane * 16)); } while (0)
#define CS_STORE(buf) do { _Pragma("unroll") for (int jj = 0; jj < 16; ++jj) { u32x2 w_; w_.x = cvtpk(x[jj][0], x[jj][1]); w_.y = cvtpk(x[jj][2], x[jj][3]); \
        *(LAS u32x2*)(L + (buf) * 65536 + wrow * 2048 + (((jj * 8 + (c4 >> 1)) ^ (wrow & 15)) << 4) + (c4 & 1) * 8) = w_; } } while (0)
    f32x4 x[16]; const char* sp;
    CS_SRC(0, sp); CS_LOAD(sp); CS_STORE(0); CS_BAR();
    f32x16 a0, a1;
#pragma unroll
    for (int r = 0; r < 16; ++r) { a0[r] = 0.f; a1[r] = 0.f; }
#pragma unroll 1
    for (int g = 0; g < nstage; ++g) {
        const int it = F.vcu + F.G * (g >> 1), which = it / (NSB * 8), q = it % (NSB * 8), b = q >> 3, n0 = (q & 7) * 8;
        const bf16_t* wp = (const bf16_t*)(F.ws + (which ? WS_WCV : WS_WCK)) + (size_t)r32 * 2048 + (g & 1) * 1024 + 128 * wave + 8 * hi;
        bf16x8 bfr[16];
#pragma unroll
        for (int ks = 0; ks < 8; ++ks) { bfr[2 * ks] = *(const bf16x8*)(wp + 16 * ks); bfr[2 * ks + 1] = *(const bf16x8*)(wp + 32 * 2048 + 16 * ks); }
        if (g + 1 < nstage) { CS_SRC(g + 1, sp); CS_LOAD(sp); }
        const LAS unsigned char* ab = L + (g & 1) * 65536 + r32 * 2048;
#pragma unroll
        for (int ks = 0; ks < 8; ++ks) { const bf16x8 af = *(const LAS bf16x8*)(ab + (((16 * wave + 2 * ks + hi) ^ (r32 & 15)) << 4));
            a0 = __builtin_amdgcn_mfma_f32_32x32x16_bf16(af, bfr[2 * ks], a0, 0, 0, 0); a1 = __builtin_amdgcn_mfma_f32_32x32x16_bf16(af, bfr[2 * ks + 1], a1, 0, 0, 0); }
        CS_BAR();
        if (g & 1) {
            LAS float* red = (LAS float*)(L + 65536) + wave * 2048 + hi * 256 + r32;
#pragma unroll
            for (int r = 0; r < 16; ++r) { red[CROW0(r) * 64] = a0[r]; red[CROW0(r) * 64 + 32] = a1[r]; a0[r] = 0.f; a1[r] = 0.f; }
            CS_BAR();
            { const int row = F.tid >> 4, cc = (F.tid & 15) * 4; f32x4 sacc = (f32x4){0.f, 0.f, 0.f, 0.f};
#pragma unroll
              for (int pp = 0; pp < 8; ++pp) sacc = sacc + *(const f32x4*)((const float*)(F.ws + WS_CB) + (which * 8 + pp) * 64 + cc);
#pragma unroll
              for (int w = 0; w < 8; ++w) sacc = sacc + *(const LAS f32x4*)((const LAS float*)(L + 65536) + w * 2048 + row * 64 + cc);
              bf16_t* o = (bf16_t*)(F.ws + (which ? WS_VCMPS : WS_KCMPS)) + (size_t)b * 4 * 64 * 64 + ((size_t)(row & 3) * 64 + n0 + (row >> 2)) * 64 + cc;
              u32x2 w2; w2.x = cvtpk(sacc[0], sacc[1]); w2.y = cvtpk(sacc[2], sacc[3]); *(u32x2*)o = w2; }
        }
        if (g + 1 < nstage) CS_STORE((g + 1) & 1);
        CS_BAR();
    }
    VM_WAIT(); __syncthreads();
#undef CS_BAR
#undef CS_SRC
#undef CS_LOAD
#undef CS_STORE
}
__device__ __forceinline__ void p4_compress_prompt(Frame& F) {
    const int lane = F.lane, r32 = lane & 31, hi = lane >> 5, nl = r32 >> 2, kv = r32 & 3;
    for (int it = F.vcu; it < 2 * NB * 16; it += F.G) {
        const int which = it / (NB * 16), q = it % (NB * 16), b = q >> 4, n0 = (q & 15) * 8, n = n0 + nl;
        const bf16_t* src = (const bf16_t*)(F.ws + WS_KV) + (size_t)which * KV_STRIDE + ((size_t)b * SEQ + (size_t)n * 32) * 256 + kv * 64;
        const bf16_t* Wt = (const bf16_t*)(F.ws + (which ? WS_WCV : WS_WCK));
        const bf16_t* w0 = Wt + (size_t)r32 * 2048 + hi * 8; const bf16_t* w1 = w0 + (size_t)32 * 2048;
        f32x16 a0, a1;
#pragma unroll
        for (int r = 0; r < 16; ++r) { a0[r] = 0.f; a1[r] = 0.f; }
#pragma unroll
        for (int jj = 0; jj < 4; ++jj) { const int j = F.wave * 4 + jj;
#pragma unroll
            for (int ds = 0; ds < 4; ++ds) { const bf16x8 af = *(const bf16x8*)(src + (size_t)j * 256 + ds * 16 + hi * 8);
                const bf16x8 b0 = *(const bf16x8*)(w0 + j * 64 + ds * 16), b1 = *(const bf16x8*)(w1 + j * 64 + ds * 16);
                a0 = __builtin_amdgcn_mfma_f32_32x32x16_bf16(af, b0, a0, 0, 0, 0); a1 = __builtin_amdgcn_mfma_f32_32x32x16_bf16(af, b1, a1, 0, 0, 0); } }
        LAS float* red = (LAS float*)F.lds + F.wave * 2048 + hi * 256 + r32;
#pragma unroll
        for (int r = 0; r < 16; ++r) { red[CROW0(r) * 64] = a0[r]; red[CROW0(r) * 64 + 32] = a1[r]; }
        LDS_WAIT(); __syncthreads();
        { const int row = F.tid >> 4, c4 = (F.tid & 15) * 4; f32x4 sacc = (f32x4){0.f, 0.f, 0.f, 0.f};
#pragma unroll
          for (int pp = 0; pp < 8; ++pp) sacc = sacc + *(const f32x4*)((const float*)(F.ws + WS_CB) + (which * 8 + pp) * 64 + c4);
#pragma unroll
          for (int w = 0; w < 8; ++w) sacc = sacc + *(const LAS f32x4*)((const LAS float*)F.lds + w * 2048 + row * 64 + c4);
          bf16_t* o = (bf16_t*)(F.ws + (which ? WS_VCMPP : WS_KCMPP)) + (size_t)b * 4 * 128 * 64 + ((size_t)(row & 3) * 128 + n0 + (row >> 2)) * 64 + c4;
          u32x2 w2; w2.x = cvtpk(sacc[0], sacc[1]); w2.y = cvtpk(sacc[2], sacc[3]); *(u32x2*)o = w2; }
        __syncthreads();
    }
}

__device__ __forceinline__ void small_gemm_res(Frame& F, const bf16_t* A  , int lda, const bf16_t* Wt, int ldb, int K, bool bd, const float* xin_s, float* xout_s, const float* gate, const float* scale) {
    const int lane = F.lane, r32 = lane & 31, hi = lane >> 5, kw = K >> 3, kbeg = F.wave * kw;
    for (int tile = F.vcu; tile < 256; tile += F.G) {
        const int row0 = (tile >> 4) * 32, col0 = (tile & 15) * 64, acol = bd ? (col0 >> 8) * 256 : 0;
        const bf16_t* ap = A + (size_t)(row0 + r32) * lda + acol + kbeg + 8 * hi;
        const bf16_t* b0p = Wt + (size_t)(col0 + r32) * ldb + kbeg + 8 * hi; const bf16_t* b1p = b0p + (size_t)32 * ldb;
        f32x16 c0, c1;
#pragma unroll
        for (int r = 0; r < 16; ++r) { c0[r] = 0.f; c1[r] = 0.f; }
#pragma unroll 8
        for (int ks = 0; ks < kw; ks += 16) { const bf16x8 a = *(const bf16x8*)(ap + ks), b0 = *(const bf16x8*)(b0p + ks), b1 = *(const bf16x8*)(b1p + ks);
            c0 = __builtin_amdgcn_mfma_f32_32x32x16_bf16(a, b0, c0, 0, 0, 0); c1 = __builtin_amdgcn_mfma_f32_32x32x16_bf16(a, b1, c1, 0, 0, 0); }
        LAS float* red = (LAS float*)F.lds + F.wave * 2048 + hi * 256 + r32;
#pragma unroll
        for (int r = 0; r < 16; ++r) { red[CROW0(r) * 64] = c0[r]; red[CROW0(r) * 64 + 32] = c1[r]; }
        LDS_WAIT(); __syncthreads();
        { const int row = F.tid >> 4, c4 = (F.tid & 15) * 4; f32x4 sacc = (f32x4){0.f, 0.f, 0.f, 0.f};
#pragma unroll
          for (int w = 0; w < 8; ++w) sacc = sacc + *(const LAS f32x4*)((const LAS float*)F.lds + w * 2048 + row * 64 + c4);
          const int rs = row0 + row, col = col0 + c4, bb = NB + (rs >> 2);
          f32x4 g4 = *(const f32x4*)(gate + (size_t)bb * 6144 + col); if (scale) g4 = g4 * *(const f32x4*)(scale + col);
          const f32x4 x4 = *(const f32x4*)(xin_s + (size_t)rs * D + col); *(f32x4*)(xout_s + (size_t)rs * D + col) = x4 + g4 * sacc; }
        __syncthreads();
    }
}

template <int MODE, int NR>
__device__ __forceinline__ void norm_rows(Frame& F, bool from_inputs, int layer, int which, int row0, const f32x4 (&gg)[4], int lane) {
    const float* X = (const float*)(F.ws + WS_X);
    const float* xr = from_inputs ? (row0 < MP ? F.x_p + (size_t)row0 * D : F.x_s + (size_t)(row0 - MP) * D) : X + (size_t)row0 * D;
    f32x4 v[NR][4];
#pragma unroll
    for (int r = 0; r < NR; ++r)
#pragma unroll
        for (int j = 0; j < 4; ++j) v[r][j] = *(const f32x4*)(xr + (size_t)r * D + 4 * lane + 256 * j);
    f32x4 sh[4], sc[4];
    if constexpr (MODE != 2) {
        const int bb = row0 < MP ? (row0 >> 12) : NB + ((row0 - MP) >> 2);
        const float* mp = (const float*)(F.ws + WS_MOD) + ((size_t)layer * NMODB + bb) * 6144 + (which ? 3072 : 0);
#pragma unroll
        for (int j = 0; j < 4; ++j) { sh[j] = *(const f32x4*)(mp + 4 * lane + 256 * j); sc[j] = *(const f32x4*)(mp + 1024 + 4 * lane + 256 * j) + 1.0f; }
    }
    float ss[NR];
#pragma unroll
    for (int r = 0; r < NR; ++r) { float a = 0.f;
#pragma unroll
        for (int j = 0; j < 4; ++j) a += (v[r][j][0] * v[r][j][0] + v[r][j][1] * v[r][j][1]) + (v[r][j][2] * v[r][j][2] + v[r][j][3] * v[r][j][3]);
        ss[r] = a; }
#pragma unroll
    for (int o = 1; o < 64; o <<= 1) {
#pragma unroll
        for (int r = 0; r < NR; ++r) ss[r] += __shfl_xor(ss[r], o); }
#pragma unroll
    for (int r = 0; r < NR; ++r) {
        const int row = row0 + r; const float rstd = 1.0f / sqrtf(ss[r] * (1.0f / D) + 1e-6f);
        if constexpr (MODE == 2) {
            float* o = row < MP ? F.out + O_YP + (size_t)row * D : F.out + O_YS + (size_t)(row - MP) * D;
#pragma unroll
            for (int j = 0; j < 4; ++j) *(f32x4*)(o + 4 * lane + 256 * j) = v[r][j] * rstd * gg[j];
        } else {
            float* pool_dst = nullptr;
            if constexpr (MODE == 1) {
                if (row < MP) { const int tt = row & (SEQ - 1); if (tt >= SEQ - 15) pool_dst = F.out + O_PLP + ((size_t)(row >> 12) * 15 + (tt - (SEQ - 15))) * D; }
                else { const int rs = row - MP; pool_dst = F.out + O_PLS + ((size_t)(rs >> 2) * 15 + 11 + (rs & 3)) * D; }
            }
#pragma unroll
            for (int j = 0; j < 4; ++j) { const int col = 4 * lane + 256 * j; const f32x4 h = (v[r][j] * rstd * gg[j]) * sc[j] + sh[j];
                if constexpr (MODE == 0) { u32x2 w; w.x = cvtpk(h[0], h[1]); w.y = cvtpk(h[2], h[3]); *(u32x2*)((bf16_t*)(F.ws + WS_H) + (size_t)row * D + col) = w; }
                else { *(f32x4*)((float*)(F.ws + WS_HF) + (size_t)row * D + col) = h; if (pool_dst) *(f32x4*)(pool_dst + col) = h; } }
        }
    }
}
template <int MODE>
__device__ __forceinline__ void norm_phase(Frame& F, bool from_inputs, int layer, int which) {
    const int gw = F.vcu * 8 + F.wave, NGW = F.G * 8, lane = F.lane;
    const float* gvec = MODE == 2 ? F.final_g : F.norm_g + (size_t)(layer * 2 + which) * D;
    f32x4 gg[4];
#pragma unroll
    for (int j = 0; j < 4; ++j) gg[j] = *(const f32x4*)(gvec + 4 * lane + 256 * j);
#pragma unroll 1
    for (int grp = gw; grp < MP / 8; grp += NGW) norm_rows<MODE, 8>(F, from_inputs, layer, which, grp * 8, gg, lane);
#pragma unroll 1
    for (int r = gw; r < MS; r += NGW) norm_rows<MODE, 1>(F, from_inputs, layer, which, MP + r, gg, lane);
}

template <int W, int R, bool SAMPLE>
__device__ __forceinline__ void pool_chunk(const float* HF, const float* st_pool, bf16_t* H, int row0, int col) {
    f32x4 v[R + W - 1];
    const int t0 = SAMPLE ? 0 : (row0 & (SEQ - 1));
#pragma unroll
    for (int k = 0; k < R + W - 1; ++k) { const int tt = t0 - (W - 1) + k;
        if (SAMPLE) { const int b = (row0 - MP) >> 2; v[k] = tt >= 0 ? *(const f32x4*)(HF + (size_t)(row0 + tt) * D + col) : *(const f32x4*)(st_pool + ((size_t)b * 15 + 15 + tt) * D + col); }
        else v[k] = tt >= 0 ? *(const f32x4*)(HF + (size_t)(row0 - (W - 1) + k) * D + col) : (f32x4){0.f, 0.f, 0.f, 0.f}; }
    f32x4 sacc = v[0];
#pragma unroll
    for (int k = 1; k < W; ++k) sacc = sacc + v[k];
#pragma unroll
    for (int r = 0; r < R; ++r) {
        if (r > 0) sacc = sacc + v[r + W - 1] - v[r - 1];
        const int tt = t0 + r; const float inv = 1.0f / (float)(SAMPLE ? W : (tt + 1 < W ? tt + 1 : W));
        const f32x4 cur = v[r + W - 1], pv = sacc * inv - cur;
        u32x2 w2; w2.x = cvtpk(pv[0], pv[1]); w2.y = cvtpk(pv[2], pv[3]); *(u32x2*)(H + (size_t)(row0 + r) * D + col) = w2; }
}
__device__ __forceinline__ void pool_phase(Frame& F) {
    const int gt = (F.vcu * 8 + F.wave) * 64 + F.lane, NT = F.G * 512;
    const float* HF = (const float*)(F.ws + WS_HF); bf16_t* H = (bf16_t*)(F.ws + WS_H);
    constexpr int NPI = (MP / 8) * 256, NSI = (MS / 4) * 256;
#pragma unroll 1
    for (int i = gt; i < NPI + NSI; i += NT) {
        const bool smp = i >= NPI; const int q = smp ? i - NPI : i; const int cg = q & 255, col = cg * 4, grp = cg >> 6;
        if (!smp) { const int row0 = (q >> 8) * 8;
            if (grp == 0) pool_chunk<2, 8, false>(HF, F.st_pool, H, row0, col); else if (grp == 1) pool_chunk<4, 8, false>(HF, F.st_pool, H, row0, col);
            else if (grp == 2) pool_chunk<8, 8, false>(HF, F.st_pool, H, row0, col); else pool_chunk<16, 8, false>(HF, F.st_pool, H, row0, col); }
        else { const int row0 = MP + (q >> 8) * 4;
            if (grp == 0) pool_chunk<2, 4, true>(HF, F.st_pool, H, row0, col); else if (grp == 1) pool_chunk<4, 4, true>(HF, F.st_pool, H, row0, col);
            else if (grp == 2) pool_chunk<8, 4, true>(HF, F.st_pool, H, row0, col); else pool_chunk<16, 4, true>(HF, F.st_pool, H, row0, col); }
    }
}

namespace att {
__device__ __forceinline__ int crow(int r, int hi) { return (r & 3) + 8 * (r >> 2) + 4 * hi; }
__device__ __forceinline__ float x32_sum(float v) { auto rr = __builtin_amdgcn_permlane32_swap(__float_as_uint(v), __float_as_uint(v), false, false); return __uint_as_float(rr[0]) + __uint_as_float(rr[1]); }
__device__ __forceinline__ float x32_max(float v) { auto rr = __builtin_amdgcn_permlane32_swap(__float_as_uint(v), __float_as_uint(v), false, false); return fmaxf(__uint_as_float(rr[0]), __uint_as_float(rr[1])); }
__device__ __forceinline__ unsigned x32_or(unsigned v) { auto rr = __builtin_amdgcn_permlane32_swap(v, v, false, false); return rr[0] | rr[1]; }
template <int X> __device__ __forceinline__ unsigned swz_xor(unsigned v) { return (unsigned)__builtin_amdgcn_ds_swizzle((int)v, (X << 10) | 0x1F); }
template <int X> __device__ __forceinline__ float swz_xorf(float v) { return __uint_as_float(swz_xor<X>(__float_as_uint(v))); }
__device__ __forceinline__ s16x4 vtr(const LAS unsigned char* p) { typedef short v4i16_t __attribute__((ext_vector_type(4))); return __builtin_bit_cast(s16x4, __builtin_amdgcn_ds_read_tr16_b64_v4i16((LAS v4i16_t*)p)); }
__device__ __forceinline__ void qk_tile(f32x16& p0, f32x16& p1, const LAS unsigned char* Kb, const bf16x8 (&qr)[4], float init, int r32, int hi) {
    f32x16 ci;
#pragma unroll
    for (int r = 0; r < 16; ++r) ci[r] = init;
    const int sw = (r32 >> 1) & 7;
    bf16x8 ka[4], kb[4];
#pragma unroll
    for (int ds = 0; ds < 4; ++ds) { const int ch = ((2 * ds + hi) ^ sw) << 4; ka[ds] = *(const LAS bf16x8*)(Kb + r32 * 128 + ch); kb[ds] = *(const LAS bf16x8*)(Kb + (32 + r32) * 128 + ch); }
    __builtin_amdgcn_s_setprio(1);
    f32x16 c0 = __builtin_amdgcn_mfma_f32_32x32x16_bf16(ka[0], qr[0], ci, 0, 0, 0);
    f32x16 c1 = __builtin_amdgcn_mfma_f32_32x32x16_bf16(kb[0], qr[0], ci, 0, 0, 0);
#pragma unroll
    for (int ds = 1; ds < 4; ++ds) {
        c0 = __builtin_amdgcn_mfma_f32_32x32x16_bf16(ka[ds], qr[ds], c0, 0, 0, 0);
        c1 = __builtin_amdgcn_mfma_f32_32x32x16_bf16(kb[ds], qr[ds], c1, 0, 0, 0);
    }
    __builtin_amdgcn_s_setprio(0);
    p0 = c0; p1 = c1;
}
__device__ __forceinline__ void pv_tile(f32x16 (&o)[2], const LAS unsigned char* Vb, const f32x16& p0, const f32x16& p1, int lane) {
    const int g4 = lane >> 4, nhalf = g4 & 1, h = g4 >> 1, i = lane & 15, q = i >> 2, pp = i & 3;
    const LAS unsigned char* vb = Vb + (4 * h + q) * 64 + nhalf * 32 + pp * 8;
#pragma unroll
    for (int kh = 0; kh < 2; ++kh) {
        s16x4 lo[2][2], hh[2][2];
#pragma unroll
        for (int s = 0; s < 2; ++s)
#pragma unroll
            for (int db = 0; db < 2; ++db) { lo[s][db] = vtr(vb + db * 4096 + (32 * kh + 16 * s) * 64); hh[s][db] = vtr(vb + db * 4096 + (32 * kh + 16 * s + 8) * 64); }
#pragma unroll
        for (int s = 0; s < 2; ++s) {
            const f32x16& p = kh ? p1 : p0; u32x4 pw;
            pw.x = cvtpk(p[8 * s + 0], p[8 * s + 1]); pw.y = cvtpk(p[8 * s + 2], p[8 * s + 3]); pw.z = cvtpk(p[8 * s + 4], p[8 * s + 5]); pw.w = cvtpk(p[8 * s + 6], p[8 * s + 7]);
            const bf16x8 pa = __builtin_bit_cast(bf16x8, pw);
#pragma unroll
            for (int db = 0; db < 2; ++db) {
                const bf16x8 vf = (bf16x8){lo[s][db][0], lo[s][db][1], lo[s][db][2], lo[s][db][3], hh[s][db][0], hh[s][db][1], hh[s][db][2], hh[s][db][3]};
                o[db] = __builtin_amdgcn_mfma_f32_32x32x16_bf16(pa, vf, o[db], 0, 0, 0);
            }
        }
    }
}
__device__ __forceinline__ void row_scale(f32x16 (&o)[2], float f, LAS float* wsf, int r32, int hi) {
    if (hi == 0) wsf[r32] = f;
    LDS_WAIT();
    const LAS float* wh = wsf + 4 * hi;
#pragma unroll
    for (int r = 0; r < 16; ++r) { const float fr = wh[CROW0(r)]; o[0][r] *= fr; o[1][r] *= fr; }
    LDS_WAIT();
}
__device__ __forceinline__ void row_fma(f32x16 (&dst)[2], const f32x16 (&o)[2], float f, LAS float* wsf, int r32, int hi) {
    if (hi == 0) wsf[r32] = f;
    LDS_WAIT();
    const LAS float* wh = wsf + 4 * hi;
#pragma unroll
    for (int r = 0; r < 16; ++r) { const float fr = wh[CROW0(r)]; dst[0][r] += fr * o[0][r]; dst[1][r] += fr * o[1][r]; }
    LDS_WAIT();
}
__device__ __forceinline__ void softmax_update(f32x16& p0, f32x16& p1, float& m, float& l, f32x16 (&o)[2], LAS float* wsf, int r32, int hi) {
    float rm = fmaxf(p0[0], p1[0]);
#pragma unroll
    for (int r = 1; r < 16; ++r) rm = fmaxf(rm, fmaxf(p0[r], p1[r]));
    rm = x32_max(rm);
    const float mn = fmaxf(m, rm), f = ex2(m - mn);
    m = mn; float s = 0.f;
#pragma unroll
    for (int r = 0; r < 16; ++r) { p0[r] = ex2(p0[r] - mn); p1[r] = ex2(p1[r] - mn); s += p0[r] + p1[r]; }
    l = l * f + s;
    if (__any(f != 1.0f)) row_scale(o, f, wsf, r32, hi);
}
__device__ __forceinline__ void softmax_full(f32x16& a0, f32x16& a1, f32x16& b0, f32x16& b1) {
    float rm = -1e30f;
#pragma unroll
    for (int r = 0; r < 16; ++r) rm = fmaxf(rm, fmaxf(fmaxf(a0[r], a1[r]), fmaxf(b0[r], b1[r])));
    rm = x32_max(rm); float s = 0.f;
#pragma unroll
    for (int r = 0; r < 16; ++r) { a0[r] = ex2(a0[r] - rm); a1[r] = ex2(a1[r] - rm); b0[r] = ex2(b0[r] - rm); b1[r] = ex2(b1[r] - rm); s += (a0[r] + a1[r]) + (b0[r] + b1[r]); }
    s = x32_sum(s);
    const float inv = s > 0.f ? 1.0f / s : 0.f;
#pragma unroll
    for (int r = 0; r < 16; ++r) { a0[r] *= inv; a1[r] *= inv; b0[r] *= inv; b1[r] *= inv; }
}
__device__ __forceinline__ unsigned imp_key(float v, int j, int c) {
    const bool forced = (j == 0) | (j == c) | (j == c - 1);
    const unsigned base = forced ? 0x7F000000u : (j <= c ? (__float_as_uint(v) & 0xFFFFFFC0u) : 0u);
    return base | (unsigned)(63 - j);
}
__device__ __forceinline__ void imp_store(const f32x16& p0, const f32x16& p1, int T, LAS unsigned* impq  , int c, int g, int hi) {
#pragma unroll
    for (int kh = 0; kh < 2; ++kh)
#pragma unroll
        for (int a = 0; a < 4; ++a) {
            const f32x16& p = kh ? p1 : p0; float e0 = p[4 * a] + p[4 * a + 1], e1 = p[4 * a + 2] + p[4 * a + 3];
            e0 += swz_xorf<8>(e0); e0 += swz_xorf<16>(e0); e1 += swz_xorf<8>(e1); e1 += swz_xorf<16>(e1);
            const int jc = 32 * T + 16 * kh + 4 * a, j0 = jc + 2 * hi;
            if (g == 0) { u32x2 w; w.x = imp_key(e0, j0, c); w.y = imp_key(e1, j0 + 1, c); *(LAS u32x2*)(impq + 2 * hi + jc) = w; }
        }
}
__device__ __forceinline__ unsigned long long select_mask(const LAS unsigned* impq, int g, int hi) {
    LDS_WAIT();
    unsigned mk[8], cnt[8];
#pragma unroll
    for (int a = 0; a < 4; ++a) { const u32x2 w = *(const LAS u32x2*)(impq + (16 * g + 2 * hi) + 4 * a); mk[2 * a] = w.x; mk[2 * a + 1] = w.y; cnt[2 * a] = 0; cnt[2 * a + 1] = 0; }
#pragma unroll 4
    for (int jj = 0; jj < 16; ++jj) { const u32x4 kx = *(const LAS u32x4*)(impq + 4 * jj);
#pragma unroll
        for (int ci = 0; ci < 8; ++ci) cnt[ci] += (unsigned)(kx.x > mk[ci]) + (unsigned)(kx.y > mk[ci]) + (unsigned)(kx.z > mk[ci]) + (unsigned)(kx.w > mk[ci]); }
    unsigned lb = 0u;
#pragma unroll
    for (int a = 0; a < 4; ++a)
#pragma unroll
        for (int e = 0; e < 2; ++e) lb |= (cnt[2 * a + e] < 16u ? 1u : 0u) << (4 * a + e);
    const unsigned long long mm = (unsigned long long)lb << (16 * g + 2 * hi);
    unsigned lo = (unsigned)mm, hh = (unsigned)(mm >> 32);
    lo |= swz_xor<8>(lo); hh |= swz_xor<8>(hh); lo |= swz_xor<16>(lo); hh |= swz_xor<16>(hh); lo = x32_or(lo); hh = x32_or(hh);
    return ((unsigned long long)hh << 32) | lo;
}
__device__ __forceinline__ unsigned long long wave_or64(unsigned long long m) {
    unsigned lo = (unsigned)m, hh = (unsigned)(m >> 32);
    lo |= swz_xor<1>(lo); hh |= swz_xor<1>(hh); lo |= swz_xor<2>(lo); hh |= swz_xor<2>(hh); lo |= swz_xor<4>(lo); hh |= swz_xor<4>(hh);
    lo |= swz_xor<8>(lo); hh |= swz_xor<8>(hh); lo |= swz_xor<16>(lo); hh |= swz_xor<16>(hh); lo = x32_or(lo); hh = x32_or(hh);
    return ((unsigned long long)(unsigned)__builtin_amdgcn_readfirstlane(hh) << 32) | (unsigned)__builtin_amdgcn_readfirstlane(lo);
}
__device__ __forceinline__ void mask_bias(f32x16& p0, f32x16& p1, int t, int pos0, int stride, int wlim, bool sel, bool near, const LAS float* lut, int hi) {
#pragma unroll
    for (int kh = 0; kh < 2; ++kh)
#pragma unroll
        for (int r = 0; r < 16; ++r) { const int kk = 32 * kh + crow(r, hi), dist = t - pos0 - stride * kk; const bool ok = sel && dist >= 0 && dist < wlim;
            float bv = 0.f; if (near) { const int di = dist < 0 ? 0 : (dist > 127 ? 127 : dist); bv = lut[di]; }
            if (kh) p1[r] = ok ? p1[r] + bv : -INFINITY; else p0[r] = ok ? p0[r] + bv : -INFINITY; }
}
template <bool CAUSAL>
__device__ __forceinline__ void mask_bias_near(f32x16& p0, f32x16& p1, int t, int pos0, bool sel, const LAS float* xlg, int hi) {
    const int dist0 = t - pos0 - 4 * hi;
    const LAS float* bp = xlg + (dist0 + 4);
#pragma unroll
    for (int kh = 0; kh < 2; ++kh)
#pragma unroll
        for (int r = 0; r < 16; ++r) { const int kc = 32 * kh + CROW0(r); const float bv = bp[63 - kc]; bool ok = sel; if (CAUSAL) ok = ok && (dist0 - kc >= 0);
            if (kh) p1[r] = ok ? p1[r] + bv : -INFINITY; else p0[r] = ok ? p0[r] + bv : -INFINITY; }
}
struct Ptrs { const bf16_t *Q, *kcp, *vcp, *kcs, *vcs, *KS, *VS, *KW, *VW; const float* gates; bf16_t* O; const float *ck_sel, *cv_sel, *st_kw, *st_vw; const int* pt; int gov; float* kw_out; float* vw_out; };
#ifdef VERIFY
#define GATEV(P, row, head, br) ((P).gov < 0 ? sigmoidf_((P).gates[(size_t)(row) * 48 + (head) * 3 + (br)]) : ((P).gov == (br) ? 1.0f : 0.0f))
#else
#define GATEV(P, row, head, br) sigmoidf_((P).gates[(size_t)(row) * 48 + (head) * 3 + (br)])
#endif

template <bool ACC>
__device__ __forceinline__ void row_out(LAS float* ow, const f32x16 (&o)[2], float f, LAS float* wsf, int r32, int hi) {
    if (hi == 0) wsf[r32] = f;
    LDS_WAIT();
    const LAS float* wh = wsf + 4 * hi; LAS float* ob = ow + hi * 256 + r32;
#pragma unroll
    for (int r = 0; r < 16; ++r) { const float fr = wh[CROW0(r)]; LAS float* p = ob + CROW0(r) * 64;
        if (ACC) { p[0] += fr * o[0][r]; p[32] += fr * o[1][r]; } else { p[0] = fr * o[0][r]; p[32] = fr * o[1][r]; } }
    LDS_WAIT();
}
template <bool NEXT>
__device__ __forceinline__ void tile_block(f32x16& s0, f32x16& s1, f32x16& n0, f32x16& n1, const LAS unsigned char* KBn, float ninit, const LAS unsigned char* VB, const bf16x8 (&qr)[4],
                                           float m, float& l, f32x16 (&o)[2], int lane, int r32, int hi) {
    if (NEXT) qk_tile(n0, n1, KBn, qr, ninit, r32, hi);
    float sacc = 0.f;
#pragma unroll
    for (int r = 0; r < 16; ++r) { s0[r] = ex2(s0[r] - m); s1[r] = ex2(s1[r] - m); sacc += s0[r] + s1[r]; }
    l += sacc;
    pv_tile(o, VB, s0, s1, lane);
}
#define AS_SBAR() __builtin_amdgcn_sched_barrier(0)
#define AS_PIN(x) asm volatile("" : "+v"(x))
#define AS_MFMA(a, b, c) __builtin_amdgcn_mfma_f32_32x32x16_bf16(a, b, c, 0, 0, 0)
#define AS_WAIT_BAR(N) asm volatile("s_waitcnt vmcnt(" #N ") lgkmcnt(0)\n\ts_barrier" ::: "memory")
#define AS_MX3(a, b, c) __builtin_fmaxf(__builtin_fmaxf((a), (b)), (c))
__device__ __forceinline__ void as_glds16(const void* gsrc, unsigned lds_base) {
    unsigned sv; asm volatile("s_mov_b32 %0, m0\n\ts_mov_b32 m0, %2\n\ts_nop 0\n\tglobal_load_lds_dwordx4 %1, off\n\ts_mov_b32 m0, %0" : "=&s"(sv) : "v"(gsrc), "s"(lds_base) : "memory"); }
__device__ __forceinline__ void as_kload2(bf16x8* kf, const LAS unsigned char* kp, int d0) { kf[2 * d0] = *(const LAS bf16x8*)(kp + d0 * 2048); kf[2 * d0 + 1] = *(const LAS bf16x8*)(kp + d0 * 2048 + 512); }
__device__ __forceinline__ float as_rowmax(const f32x16& p0, const f32x16& p1) {
    float a = AS_MX3(p0[0], p0[1], p1[0]), b = AS_MX3(p0[2], p0[3], p1[1]); a = AS_MX3(a, p1[2], p1[3]);
#pragma unroll
    for (int r = 4; r < 16; r += 4) { a = AS_MX3(a, p0[r], p0[r + 1]); b = AS_MX3(b, p0[r + 2], p0[r + 3]); a = AS_MX3(a, p1[r], p1[r + 1]); b = AS_MX3(b, p1[r + 2], p1[r + 3]); }
    return x32_max(__builtin_fmaxf(a, b)); }
template <bool WIN>
__device__ __forceinline__ float as_mask(f32x16& c0, f32x16& c1, int u, int j0, int nreal, int c, int t, unsigned long long mymask, float bfar, const LAS float* xlg, const LAS float* lut, int hi) {
    const int j = j0 + u;
    if (u >= nreal) {
#pragma unroll
        for (int r = 0; r < 16; ++r) { c0[r] = -INFINITY; c1[r] = -INFINITY; }
        return 0.f; }
    const bool sel = WIN || ((mymask >> j) & 1ull);
    if (j >= c - 2) { if (j == c) mask_bias_near<true>(c0, c1, t, 64 * j, sel, xlg, hi); else mask_bias_near<false>(c0, c1, t, 64 * j, sel, xlg, hi); return 0.f; }
    if (WIN) { if (j == c - 8) mask_bias(c0, c1, t, 64 * j, 1, 512, true, false, lut, hi); }
    else {
#pragma unroll
        for (int r = 0; r < 16; ++r) { c0[r] = sel ? c0[r] : -INFINITY; c1[r] = sel ? c1[r] : -INFINITY; } }
    return bfar;
}
template <bool WIN, bool ACC>
__device__ __forceinline__ void attn_stream(const bf16_t* kbase  , const bf16_t* vbase, int j0, int nreal, int NT, int c, int t, unsigned long long mymask,
                                            const bf16x8 (&qr)[4], float bfar, const LAS float* xlg, const LAS float* lut, float gate, LAS unsigned char* L, LAS float* wsf, LAS float* ow, int wave, int lane) {
    constexpr int SLOTB = 8192, LDS_K = 0, LDS_V = 3 * SLOTB;
    const int r32 = lane & 31, hi = lane >> 5;
    const unsigned lds0 = (unsigned)(unsigned long long)L;
    const int jlast = j0 + nreal - 1;
    const bf16_t* ksrc = kbase + (size_t)lane * 256 + wave * 8;
    const bf16_t* vsrc = vbase + (size_t)(16 * (wave & 3) + (lane >> 2)) * 256 + (wave >> 2) * 32 + (lane & 3) * 8;
    const unsigned kdst = lds0 + LDS_K + wave * 1024, vdst = lds0 + LDS_V + wave * 1024;
#define AS_JT(u) ((j0 + (u)) > jlast ? jlast : (j0 + (u)))
#define AS_DMA_K(u, slot) as_glds16(ksrc + (size_t)AS_JT(u) * (64 * 256), (unsigned)__builtin_amdgcn_readfirstlane((int)(kdst + (slot))))
#define AS_DMA_V(u, slot) as_glds16(vsrc + (size_t)AS_JT(u) * (64 * 256), (unsigned)__builtin_amdgcn_readfirstlane((int)(vdst + (slot))))
    const LAS unsigned char* vp0 = L + LDS_V + ((lane >> 4) & 1) * 32 + (lane & 3) * 8 + (4 * hi + ((lane & 15) >> 2)) * 64;
    const LAS unsigned char* kp0 = L + LDS_K + hi * 1024 + r32 * 16;
    AS_DMA_K(0, 0); AS_DMA_V(0, 0); AS_DMA_K(1, SLOTB); AS_DMA_K(2, 2 * SLOTB);
    float mhat = 0.f, l_reg = 0.f; f32x16 o[2];
#pragma unroll
    for (int r = 0; r < 16; ++r) { o[0][r] = 0.f; o[1][r] = 0.f; }
    const f32x16 zero16 = {0.f, 0.f, 0.f, 0.f, 0.f, 0.f, 0.f, 0.f, 0.f, 0.f, 0.f, 0.f, 0.f, 0.f, 0.f, 0.f};
    bool resc = false;
    f32x16 pA0, pA1, pB0, pB1; bf16x8 kf[8]; s16x4 vlo[8], vhi[8]; u32x4 pw0, pw1, pw2, pw3;
    int sl_prev = 0, sl_cur = 0, sl_next = SLOTB;
#define AS_ROT() do { sl_prev = sl_cur; sl_cur = sl_next; sl_next = (sl_next == 2 * SLOTB) ? 0 : sl_next + SLOTB; } while (0)
#define AS_EX(v) __builtin_amdgcn_exp2f((v) + nmh)
#define AS_RESC() do { if (resc) { const LAS float* wh_ = wsf + 4 * hi; _Pragma("unroll") for (int d_ = 0; d_ < 2; ++d_) _Pragma("unroll") for (int r = 0; r < 16; ++r) o[d_][r] *= wh_[CROW0(r)]; } } while (0)
    AS_WAIT_BAR(3);
#pragma unroll
    for (int d0 = 0; d0 < 4; ++d0) as_kload2(kf, kp0, d0);
    pA0 = AS_MFMA(kf[0], qr[0], zero16); pA1 = AS_MFMA(kf[1], qr[0], zero16); pA0 = AS_MFMA(kf[2], qr[1], pA0); pA1 = AS_MFMA(kf[3], qr[1], pA1);
    pA0 = AS_MFMA(kf[4], qr[2], pA0); pA1 = AS_MFMA(kf[5], qr[2], pA1); pA0 = AS_MFMA(kf[6], qr[3], pA0); pA1 = AS_MFMA(kf[7], qr[3], pA1);
    { const float bc = as_mask<WIN>(pA0, pA1, 0, j0, nreal, c, t, mymask, bfar, xlg, lut, hi);
      const float rm = as_rowmax(pA0, pA1) + bc; mhat = __builtin_fmaxf(rm, -60.f); const float nmh = bc - mhat;
#pragma unroll
      for (int r = 0; r < 16; ++r) { pA0[r] = AS_EX(pA0[r]); pA1[r] = AS_EX(pA1[r]); } }
    AS_WAIT_BAR(0);
    AS_DMA_K(3, 0); AS_DMA_V(1, SLOTB); AS_ROT();
#pragma unroll
    for (int d0 = 0; d0 < 4; ++d0) as_kload2(kf, kp0 + sl_cur, d0);
    AS_WAIT_BAR(2);
#define AS_PKW(P, i) cvtpk(P[i], P[i + 1])
#define AS_PAF(k) __builtin_bit_cast(bf16x8, pw##k)
#define AS_VFR(i) (bf16x8){vlo[i][0], vlo[i][1], vlo[i][2], vlo[i][3], vhi[i][0], vhi[i][1], vhi[i][2], vhi[i][3]}
#define AS_VRD(i) do { vlo[i] = vtr(vp_ + (((i) >> 2) * 4096 + ((i) & 3) * 1024)); vhi[i] = vtr(vp_ + (((i) >> 2) * 4096 + ((i) & 3) * 1024 + 512)); } while (0)
#define AS_KRD(G, d0) do { if (G) { as_kload2(kf, kp0 + sl_next, d0); AS_SBAR(); } } while (0)
#define AS_GAPA(MF, a0, a1, a2, a3, W0, W1, PW) do { MF; sacc += a0; sacc += a1; sacc += a2; sacc += a3; W0; W1; AS_PIN(PW); AS_PIN(sacc); AS_SBAR(); } while (0)
#define AS_GAPB(MF, X, i) do { MF; X[i] = AS_EX(X[i]); X[i + 1] = AS_EX(X[i + 1]); X[i + 2] = AS_EX(X[i + 2]); X[i + 3] = AS_EX(X[i + 3]); AS_PIN(X); AS_SBAR(); } while (0)
#define AS_STEP(C0, C1, P0, P1, tt, MASK, GK, GV, GL) do { AS_SBAR(); \
    const LAS unsigned char* vp_ = vp0 + sl_prev; \
    AS_VRD(0); AS_SBAR(); float sacc = P0[0] + P0[1]; \
                    AS_GAPA(C0 = AS_MFMA(kf[0], qr[0], zero16), P0[2], P0[3], P0[4], P0[5],     pw0[0] = AS_PKW(P0, 0),  pw0[1] = AS_PKW(P0, 2),  pw0); \
    AS_VRD(4); AS_SBAR(); AS_GAPA(C1 = AS_MFMA(kf[1], qr[0], zero16), P0[6], P0[7], P0[8], P0[9],     pw0[2] = AS_PKW(P0, 4),  pw0[3] = AS_PKW(P0, 6),  pw0); \
    AS_VRD(1); AS_SBAR(); AS_GAPA(C0 = AS_MFMA(kf[2], qr[1], C0),    P0[10], P0[11], P0[12], P0[13], pw1[0] = AS_PKW(P0, 8),  pw1[1] = AS_PKW(P0, 10), pw1); \
    AS_VRD(5); AS_SBAR(); AS_GAPA(C1 = AS_MFMA(kf[3], qr[1], C1),    P0[14], P0[15], P1[0], P1[1],   pw1[2] = AS_PKW(P0, 12), pw1[3] = AS_PKW(P0, 14), pw1); \
    AS_VRD(2); AS_SBAR(); AS_GAPA(C0 = AS_MFMA(kf[4], qr[2], C0),    P1[2], P1[3], P1[4], P1[5],     pw2[0] = AS_PKW(P1, 0),  pw2[1] = AS_PKW(P1, 2),  pw2); \
    AS_VRD(6); AS_SBAR(); AS_GAPA(C1 = AS_MFMA(kf[5], qr[2], C1),    P1[6], P1[7], P1[8], P1[9],     pw2[2] = AS_PKW(P1, 4),  pw2[3] = AS_PKW(P1, 6),  pw2); \
    AS_VRD(3); AS_SBAR(); AS_GAPA(C0 = AS_MFMA(kf[6], qr[3], C0),    P1[10], P1[11], P1[12], P1[13], pw3[0] = AS_PKW(P1, 8),  pw3[1] = AS_PKW(P1, 10), pw3); \
    AS_VRD(7); AS_SBAR(); AS_GAPA(C1 = AS_MFMA(kf[7], qr[3], C1),    P1[14], P1[15], 0.f, 0.f,       pw3[2] = AS_PKW(P1, 12), pw3[3] = AS_PKW(P1, 14), pw3); \
    l_reg += sacc; \
    if (GK) AS_DMA_K((tt) + 3, sl_cur); if (GV) AS_DMA_V((tt) + 1, sl_next); \
    float bc_ = bfar; bool sel_ = true; \
    if (MASK) bc_ = as_mask<WIN>(C0, C1, (tt), j0, nreal, c, t, mymask, bfar, xlg, lut, hi); \
    else if (!WIN) sel_ = (mymask >> (j0 + (tt))) & 1ull;            \
    { const float rm = as_rowmax(C0, C1) + bc_ - mhat; resc = false; \
      if (__builtin_expect(__any(rm > 8.0f), 0)) { const float dl = __builtin_fmaxf(rm, 0.f); mhat += dl; \
          const float f = __builtin_amdgcn_exp2f(-dl); l_reg *= f; if (hi == 0) wsf[r32] = f; resc = true; } } \
    const float nmh = sel_ ? bc_ - mhat : -INFINITY; AS_SBAR(); \
    AS_GAPB(o[0] = AS_MFMA(AS_PAF(0), AS_VFR(0), o[0]), C0, 0);              AS_GAPB(o[1] = AS_MFMA(AS_PAF(0), AS_VFR(4), o[1]), C0, 4); \
    AS_KRD(GL, 0); AS_GAPB(o[0] = AS_MFMA(AS_PAF(1), AS_VFR(1), o[0]), C0, 8);  AS_KRD(GL, 1); AS_GAPB(o[1] = AS_MFMA(AS_PAF(1), AS_VFR(5), o[1]), C0, 12); \
    AS_KRD(GL, 2); AS_GAPB(o[0] = AS_MFMA(AS_PAF(2), AS_VFR(2), o[0]), C1, 0);  AS_KRD(GL, 3); AS_GAPB(o[1] = AS_MFMA(AS_PAF(2), AS_VFR(6), o[1]), C1, 4); \
    AS_GAPB(o[0] = AS_MFMA(AS_PAF(3), AS_VFR(3), o[0]), C1, 8);              AS_GAPB(o[1] = AS_MFMA(AS_PAF(3), AS_VFR(7), o[1]), C1, 12); \
    } while (0)
    int tt = 1;
    for (; tt + 5 < NT; tt += 2) {
        AS_STEP(pB0, pB1, pA0, pA1, tt, false, true, true, true);     AS_WAIT_BAR(2); AS_RESC(); AS_ROT();
        AS_STEP(pA0, pA1, pB0, pB1, tt + 1, false, true, true, true); AS_WAIT_BAR(2); AS_RESC(); AS_ROT();
    }
#define AS_ENDW(x) do { if ((x) + 3 < NT) { AS_WAIT_BAR(2); } else if ((x) + 2 < NT) { AS_WAIT_BAR(1); } else { AS_WAIT_BAR(0); } } while (0)
    for (; tt + 1 < NT; tt += 2) {
        AS_STEP(pB0, pB1, pA0, pA1, tt, true, (tt + 3 < NT), (tt + 1 < NT), (tt + 1 < NT));         AS_ENDW(tt);     AS_RESC(); AS_ROT();
        AS_STEP(pA0, pA1, pB0, pB1, tt + 1, true, (tt + 4 < NT), (tt + 2 < NT), (tt + 2 < NT));     AS_ENDW(tt + 1); AS_RESC(); AS_ROT();
    }
    AS_STEP(pB0, pB1, pA0, pA1, NT - 1, true, false, false, false); AS_RESC();
    { float sacc = pB0[0] + pB0[1];
#pragma unroll
      for (int r = 2; r < 16; ++r) sacc += pB0[r];
#pragma unroll
      for (int r = 0; r < 16; ++r) sacc += pB1[r];
      l_reg += sacc;
      pw0 = (u32x4){AS_PKW(pB0, 0), AS_PKW(pB0, 2), AS_PKW(pB0, 4), AS_PKW(pB0, 6)}; pw1 = (u32x4){AS_PKW(pB0, 8), AS_PKW(pB0, 10), AS_PKW(pB0, 12), AS_PKW(pB0, 14)};
      pw2 = (u32x4){AS_PKW(pB1, 0), AS_PKW(pB1, 2), AS_PKW(pB1, 4), AS_PKW(pB1, 6)}; pw3 = (u32x4){AS_PKW(pB1, 8), AS_PKW(pB1, 10), AS_PKW(pB1, 12), AS_PKW(pB1, 14)};
      const LAS unsigned char* vp_ = vp0 + sl_cur;
#pragma unroll
      for (int i = 0; i < 8; ++i) AS_VRD(i);
      o[0] = AS_MFMA(AS_PAF(0), AS_VFR(0), o[0]); o[1] = AS_MFMA(AS_PAF(0), AS_VFR(4), o[1]); o[0] = AS_MFMA(AS_PAF(1), AS_VFR(1), o[0]); o[1] = AS_MFMA(AS_PAF(1), AS_VFR(5), o[1]);
      o[0] = AS_MFMA(AS_PAF(2), AS_VFR(2), o[0]); o[1] = AS_MFMA(AS_PAF(2), AS_VFR(6), o[1]); o[0] = AS_MFMA(AS_PAF(3), AS_VFR(3), o[0]); o[1] = AS_MFMA(AS_PAF(3), AS_VFR(7), o[1]); }
    { const float lt = x32_sum(l_reg); const float f = lt > 0.f ? gate / lt : 0.f; row_out<ACC>(ow, o, f, wsf, r32, hi); }
    asm volatile("s_waitcnt lgkmcnt(0)\n\ts_barrier" ::: "memory");
#undef AS_JT
#undef AS_DMA_K
#undef AS_DMA_V
#undef AS_ROT
#undef AS_EX
#undef AS_RESC
#undef AS_PKW
#undef AS_PAF
#undef AS_VFR
#undef AS_VRD
#undef AS_KRD
#undef AS_GAPA
#undef AS_GAPB
#undef AS_STEP
#undef AS_ENDW
}

__device__ __forceinline__ void prompt_unit(const Ptrs& P, LAS unsigned char* L, int b, int kv, int c, int tid, int wave, int lane) {
    asm volatile("" : "+v"(lane), "+v"(tid));
    const int r32 = lane & 31, hi = lane >> 5, g = r32 >> 3, qi = r32 & 7, head = kv * 4 + g;
    const int t = c * 64 + wave * 8 + qi; const unsigned row = (unsigned)b * SEQ + t;
    bf16x8 qr[4];
#pragma unroll
    for (int ds = 0; ds < 4; ++ds) qr[ds] = *(const bf16x8*)(P.Q + (size_t)row * D + head * 64 + ds * 16 + hi * 8);
    const LAS float* lut = (const LAS float*)(L + LUT_OFF) + head * 128; const float bfar = lut[127];
    LAS float* wsf = (LAS float*)(L + WSF_OFF) + wave * 32;
    LAS float* ow = (LAS float*)(L + 65536 + wave * 8192);
    LAS unsigned* impq = (LAS unsigned*)(L + IMP_OFF) + wave * 512 + qi * 64;
    const int skey = tid >> 3, sch = tid & 7;
    const int kwoff = skey * 128 + ((sch ^ ((skey >> 1) & 7)) << 4), vwoff = (sch >> 2) * 4096 + skey * 64 + (sch & 3) * 16;
    LAS unsigned char* KB0 = L; LAS unsigned char* VB0 = L + 32768;
    { const unsigned co = ((unsigned)(b * 4 + kv) * 128 + skey) * 64 + sch * 8;
      const u32x4 k0 = *(const u32x4*)(P.kcp + co), k1 = *(const u32x4*)(P.kcp + co + 4096), v0 = *(const u32x4*)(P.vcp + co), v1 = *(const u32x4*)(P.vcp + co + 4096);
      *(LAS u32x4*)(KB0 + kwoff) = k0; *(LAS u32x4*)(KB0 + 8192 + kwoff) = k1; *(LAS u32x4*)(VB0 + vwoff) = v0; *(LAS u32x4*)(VB0 + 8192 + vwoff) = v1; }
    const int nwin = (c < 8 ? c : 8) + 1;
    __syncthreads();
    f32x16 o[2];
#pragma unroll
    for (int r = 0; r < 16; ++r) { o[0][r] = 0.f; o[1][r] = 0.f; }
    unsigned long long mymask = ~0ull;
    {
        float cm = -1e30f, cl = 0.f; const int ncmp = c <= 30 ? 1 : 2;
#pragma unroll 1
        for (int T = 0; T < ncmp; ++T) { f32x16 a0, a1; qk_tile(a0, a1, KB0 + T * 8192, qr, 0.f, r32, hi); mask_bias(a0, a1, t, 31 + 2048 * T, 32, 1 << 30, true, true, lut, hi);
            float rm = fmaxf(a0[0], a1[0]);
#pragma unroll
            for (int r = 1; r < 16; ++r) rm = fmaxf(rm, fmaxf(a0[r], a1[r]));
            rm = x32_max(rm); const float mn = fmaxf(cm, rm); float sacc = 0.f;
#pragma unroll
            for (int r = 0; r < 16; ++r) sacc += ex2(a0[r] - mn) + ex2(a1[r] - mn);
            cl = cl * ex2(cm - mn) + sacc; cm = mn; }
        cl = x32_sum(cl); const float cinv = cl > 0.f ? 1.0f / cl : 0.f;
#pragma unroll 1
        for (int T = 0; T < ncmp; ++T) { f32x16 a0, a1; qk_tile(a0, a1, KB0 + T * 8192, qr, 0.f, r32, hi); mask_bias(a0, a1, t, 31 + 2048 * T, 32, 1 << 30, true, true, lut, hi);
#pragma unroll
            for (int r = 0; r < 16; ++r) { a0[r] = ex2(a0[r] - cm) * cinv; a1[r] = ex2(a1[r] - cm) * cinv; }
            if (c >= 16) imp_store(a0, a1, T, impq, c, g, hi);
            pv_tile(o, VB0 + T * 8192, a0, a1, lane); }
        if (c >= 16 && ncmp == 1 && g == 0) {
#pragma unroll
            for (int q8 = 0; q8 < 8; ++q8) { const int jc = 32 + 4 * q8; u32x2 w; w.x = imp_key(0.f, jc + 2 * hi, c); w.y = imp_key(0.f, jc + 2 * hi + 1, c); *(LAS u32x2*)(impq + 2 * hi + jc) = w; } }
    }
    { const float g0 = GATEV(P, row, head, 0); row_out<false>(ow, o, g0, wsf, r32, hi); }
    if (c >= 16) mymask = select_mask(impq, g, hi);
    __syncthreads();
    { LAS float* xl = (LAS float*)(L + IMP_OFF);
      for (int u = tid; u < 4 * 272; u += 512) { const int gg = u / 272, ii = u % 272, dd = ii - 67; xl[u] = ((const LAS float*)(L + LUT_OFF))[(kv * 4 + gg) * 128 + (dd < 0 ? 0 : (dd > 127 ? 127 : dd))]; } }
    const LAS float* xlg = (const LAS float*)(L + IMP_OFF) + g * 272;
    { const size_t kvb = ((size_t)b * SEQ) * 256 + kv * 64;
      { const int nreal = c + 1; int NT = (nreal + 1) & ~1; if (NT < 4) NT = 4;
        attn_stream<false, true>(P.KS + kvb, P.VS + kvb, 0, nreal, NT, c, t, mymask, qr, bfar, xlg, lut, GATEV(P, row, head, 1), L, wsf, ow, wave, lane); }
      { int NT = (nwin + 1) & ~1; if (NT < 4) NT = 4;
        attn_stream<true, true>(P.KW + kvb, P.VW + kvb, c - nwin + 1, nwin, NT, c, t, mymask, qr, bfar, xlg, lut, GATEV(P, row, head, 2), L, wsf, ow, wave, lane); } }
    { const int rr = lane >> 1, hf = lane & 1, gg = rr >> 3, qq = rr & 7; const LAS float* src = ow + rr * 64 + hf * 32;
      bf16_t* op = P.O + ((size_t)b * SEQ + c * 64 + wave * 8 + qq) * D + (kv * 4 + gg) * 64 + hf * 32;
#pragma unroll
      for (int q4 = 0; q4 < 4; ++q4) { const f32x4 x0 = *(const LAS f32x4*)(src + q4 * 8), x1 = *(const LAS f32x4*)(src + q4 * 8 + 4); u32x4 w;
          w.x = cvtpk(x0[0], x0[1]); w.y = cvtpk(x0[2], x0[3]); w.z = cvtpk(x1[0], x1[1]); w.w = cvtpk(x1[2], x1[3]); *(u32x4*)(op + q4 * 8) = w; } }
    __syncthreads();
}

template <bool COPY>
__device__ __forceinline__ void stage_f32_pair(const float* ksrc_, const float* vsrc_, LAS unsigned char* Kb, LAS unsigned char* Vb, int lane, float* kdst_ = nullptr, float* vdst_ = nullptr, int first_row = 0) {
    const int c4 = lane & 15; const char* ks = uniform_ptr(ksrc_); const char* vs = uniform_ptr(vsrc_); const unsigned lo = (unsigned)((lane >> 4) * 1024 + c4 * 16);
#pragma unroll 1
    for (int hf = 0; hf < 2; ++hf) {
        f32x4 x[8], y[8];
#pragma unroll
        for (int it = 0; it < 8; ++it) x[it] = *(const f32x4*)(ks + (lo + (unsigned)(hf * 8 + it) * 4096u));
#pragma unroll
        for (int it = 0; it < 8; ++it) y[it] = *(const f32x4*)(vs + (lo + (unsigned)(hf * 8 + it) * 4096u));
        if constexpr (COPY) {
            char* kd = (char*)uniform_ptr(kdst_); char* vd = (char*)uniform_ptr(vdst_);
#pragma unroll
            for (int it = 0; it < 8; ++it) { const int key = (hf * 8 + it) * 4 + (lane >> 4);
                if (key >= first_row) { __builtin_nontemporal_store(x[it], (f32x4*)(kd + (lo + (unsigned)(hf * 8 + it) * 4096u))); __builtin_nontemporal_store(y[it], (f32x4*)(vd + (lo + (unsigned)(hf * 8 + it) * 4096u))); } }
        }
#pragma unroll
        for (int it = 0; it < 8; ++it) { const int key = (hf * 8 + it) * 4 + (lane >> 4);
            u32x2 w; w.x = cvtpk(x[it][0], x[it][1]); w.y = cvtpk(x[it][2], x[it][3]);
            *(LAS u32x2*)(Kb + key * 128 + (((c4 >> 1) ^ ((key >> 1) & 7)) << 4) + (c4 & 1) * 8) = w; }
#pragma unroll
        for (int it = 0; it < 8; ++it) { const int key = (hf * 8 + it) * 4 + (lane >> 4);
            u32x2 w; w.x = cvtpk(y[it][0], y[it][1]); w.y = cvtpk(y[it][2], y[it][3]);
            *(LAS u32x2*)(Vb + (c4 >> 3) * 4096 + key * 64 + (c4 & 7) * 8) = w; }
        __builtin_amdgcn_sched_barrier(0);
    }
}
__device__ __forceinline__ void stage_bf16_tile(const bf16_t* src_  , LAS unsigned char* Kb, bool isV, int lane) {
    const char* src = uniform_ptr(src_);
#pragma unroll
    for (int it = 0; it < 8; ++it) { const int idx = it * 64 + lane, key = idx >> 3, ch = idx & 7; const u32x4 x = *(const u32x4*)(src + (unsigned)idx * 16u);
        const int off = isV ? ((ch >> 2) * 4096 + key * 64 + (ch & 3) * 16) : (key * 128 + ((ch ^ ((key >> 1) & 7)) << 4));
        *(LAS u32x4*)(Kb + off) = x; }
}
__device__ __forceinline__ void stage_new_tile(const bf16_t* src_  , LAS unsigned char* Kb, bool isV, int lane) {
    const char* src = uniform_ptr(src_);
#pragma unroll
    for (int it = 0; it < 8; ++it) *(LAS u32x4*)(Kb + (it * 64 + lane) * 16) = (u32x4){0u, 0u, 0u, 0u};
    if (lane < 32) { const int key = lane >> 3, ch = lane & 7; const u32x4 x = *(const u32x4*)(src + (unsigned)(key * 512 + ch * 16));
        const int off = isV ? ((ch >> 2) * 4096 + key * 64 + (ch & 3) * 16) : (key * 128 + ((ch ^ ((key >> 1) & 7)) << 4));
        *(LAS u32x4*)(Kb + off) = x; }
}
__device__ __forceinline__ void sample_unit(const Ptrs& P, LAS unsigned char* L, int uA, int uB, int tid, int wave, int lane) {
    asm volatile("" : "+v"(lane), "+v"(tid));
    const int half = wave >> 2, lw = wave & 3, usel = half ? uB : uA, b = usel >> 2, kv = usel & 3;
    const int r32 = lane & 31, hi = lane >> 5, g = r32 >> 3, qi = r32 & 7, qs = qi & 3, head = kv * 4 + g;
    const int t = PAST + qs; const unsigned row = (unsigned)MP + b * 4 + qs;
    bf16x8 qr[4];
#pragma unroll
    for (int ds = 0; ds < 4; ++ds) qr[ds] = *(const bf16x8*)(P.Q + (size_t)row * D + head * 64 + ds * 16 + hi * 8);
    const LAS float* lut = (const LAS float*)(L + LUT_OFF) + head * 128; const float bfar = lut[127];
    LAS float* wsf = (LAS float*)(L + WSF_OFF) + wave * 32;
    LAS unsigned* impq = (LAS unsigned*)(L + IMP_OFF) + wave * 512 + qi * 64;
    LAS unsigned char* Kb = L + wave * 16384; LAS unsigned char* Vb = Kb + 8192;
    f32x16 out[2], o[2];
#pragma unroll
    for (int r = 0; r < 16; ++r) { out[0][r] = 0.f; out[1][r] = 0.f; o[0][r] = 0.f; o[1][r] = 0.f; }
    stage_bf16_tile(P.kcs + (size_t)(b * 4 + kv) * 4096, Kb, false, lane); stage_bf16_tile(P.vcs + (size_t)(b * 4 + kv) * 4096, Vb, true, lane);
    LDS_WAIT();
    {
        f32x16 a0, a1;
        qk_tile(a0, a1, Kb, qr, 0.f, r32, hi);
        mask_bias(a0, a1, t, 31, 32, 1 << 30, true, true, lut, hi);
        { float rm = fmaxf(a0[0], a1[0]);
#pragma unroll
          for (int r = 1; r < 16; ++r) rm = fmaxf(rm, fmaxf(a0[r], a1[r]));
          rm = x32_max(rm); float sacc = 0.f;
#pragma unroll
          for (int r = 0; r < 16; ++r) { a0[r] = ex2(a0[r] - rm); a1[r] = ex2(a1[r] - rm); sacc += a0[r] + a1[r]; }
          sacc = x32_sum(sacc); const float cinv = 1.0f / sacc;
#pragma unroll
          for (int r = 0; r < 16; ++r) { a0[r] *= cinv; a1[r] *= cinv; } }
        imp_store(a0, a1, 0, impq, 32, g, hi);
        if (g == 0) {
#pragma unroll
            for (int q8 = 0; q8 < 8; ++q8) { const int jc = 32 + 4 * q8; u32x2 w; w.x = imp_key(0.f, jc + 2 * hi, 32); w.y = imp_key(0.f, jc + 2 * hi + 1, 32); *(LAS u32x2*)(impq + 2 * hi + jc) = w; } }
        if (lw == 0) { pv_tile(o, Vb, a0, a1, lane); const float g0 = GATEV(P, row, head, 0); row_fma(out, o, g0, wsf, r32, hi);
#pragma unroll
            for (int r = 0; r < 16; ++r) { o[0][r] = 0.f; o[1][r] = 0.f; } }
    }
    const unsigned long long mymask = select_mask(impq, g, hi);
    const unsigned long long umask = wave_or64(mymask) & 0x1FFFFFFFFull;
    const bool winw = lw == 3;
    const int nsel = __builtin_popcountll(umask);
    const int nmine = winw ? 9 : nsel, first = winw ? 0 : lw, step = winw ? 1 : 3;
    float m = -1e30f, l = 0.f;
#pragma unroll 1
    for (int idx = first; idx < nmine; idx += step) {
        LDS_WAIT();
        int pos0; bool near, sel = true;
        int ln = lane; asm volatile("" : "+v"(ln));
        if (!winw) {
            unsigned long long mm = umask; for (int n = 0; n < idx; ++n) mm &= mm - 1ull;
            const int j = __builtin_ctzll(mm);
            if (j < 32) { const int page = P.pt[b * 16 + (j >> 1)]; const size_t off = (((size_t)page * 128 + (j & 1) * 64) * 4 + kv) * 64;
                stage_f32_pair<false>(P.ck_sel + off, P.cv_sel + off, Kb, Vb, ln); }
            else { stage_new_tile(P.KS + ((size_t)MP + b * 4) * 256 + kv * 64, Kb, false, ln); stage_new_tile(P.VS + ((size_t)MP + b * 4) * 256 + kv * 64, Vb, true, ln); }
            pos0 = 64 * j; near = j >= 30; sel = (mymask >> j) & 1ull;
        } else {
            if (idx < 8) { const size_t off = (((size_t)b * 512 + 64 * idx) * 4 + kv) * 64;
                stage_f32_pair<true>(P.st_kw + off, P.st_vw + off, Kb, Vb, ln, P.kw_out + off - 1024, P.vw_out + off - 1024, idx == 0 ? 4 : 0); }
            else { stage_new_tile(P.KW + ((size_t)MP + b * 4) * 256 + kv * 64, Kb, false, ln); stage_new_tile(P.VW + ((size_t)MP + b * 4) * 256 + kv * 64, Vb, true, ln); }
            pos0 = PAST - 512 + 64 * idx; near = idx >= 6;
        }
        LDS_WAIT();
        f32x16 p0, p1;
        qk_tile(p0, p1, Kb, qr, near ? 0.f : bfar, r32, hi);
        mask_bias(p0, p1, t, pos0, 1, winw ? 512 : (1 << 30), sel, near, lut, hi);
        softmax_update(p0, p1, m, l, o, wsf, r32, hi);
        pv_tile(o, Vb, p0, p1, lane);
    }
    LDS_WAIT();
    { const float lt = x32_sum(l);
      LAS f32x2* ml = (LAS f32x2*)(L + IMP_OFF);
      if (hi == 0) ml[wave * 256 + r32] = (f32x2){m, lt};
      __syncthreads();
      const int w0 = half * 4 + (winw ? 3 : 0), w1 = half * 4 + (winw ? 4 : 3);
      float M = -1e30f;
      for (int w = w0; w < w1; ++w) M = fmaxf(M, ml[w * 256 + r32][0]);
      float Ls = 0.f;
      for (int w = w0; w < w1; ++w) { const f32x2 x = ml[w * 256 + r32]; Ls += x[1] * ex2(x[0] - M); }
      const float gt = GATEV(P, row, head, (winw ? 2 : 1));
      const float f = Ls > 0.f ? gt * ex2(m - M) / Ls : 0.f;
      row_fma(out, o, f, wsf, r32, hi); }
    LAS float* ob = (LAS float*)Kb + hi * 256 + r32;
#pragma unroll
    for (int r = 0; r < 16; ++r) { ob[CROW0(r) * 64] = out[0][r]; ob[CROW0(r) * 64 + 32] = out[1][r]; }
    __syncthreads();
    { const int hs = tid >> 8, vr = (tid >> 4) & 15, d4 = (tid & 15) * 4, gg = vr >> 2, qq = vr & 3, uo = hs ? uB : uA; f32x4 sacc = (f32x4){0.f, 0.f, 0.f, 0.f};
#pragma unroll
      for (int w = 0; w < 4; ++w) sacc = sacc + *(const LAS f32x4*)((const LAS float*)(L + (hs * 4 + w) * 16384) + (gg * 8 + qq) * 64 + d4);
      u32x2 w2; w2.x = cvtpk(sacc[0], sacc[1]); w2.y = cvtpk(sacc[2], sacc[3]);
      *(u32x2*)(P.O + ((size_t)MP + (uo >> 2) * 4 + qq) * D + ((uo & 3) * 4 + gg) * 64 + d4) = w2; }
    __syncthreads();
}

#ifdef VERIFY
__device__ __forceinline__ float wsum(float v) { for (int o = 1; o < 64; o <<= 1) v += __shfl_xor(v, o); return v; }
__device__ __forceinline__ float wmax(float v) { for (int o = 1; o < 64; o <<= 1) v = fmaxf(v, __shfl_xor(v, o)); return v; }
__device__ __forceinline__ float rb(float x) { return bf2f((unsigned short)(cvtpk(x, 0.f) & 0xffffu)); }
__device__ __forceinline__ void verify_item(const Ptrs& P, LAS unsigned char* L, bool sample, int b, int tq, int kv, int br, float* errs, int wave, int lane) {
    LAS float* sc = (LAS float*)(L + wave * 16384);
    LAS float* qs = (LAS float*)(L + IMP_OFF) + wave * 512;
    const LAS float* lutb = (const LAS float*)(L + LUT_OFF);
    const size_t row = sample ? (size_t)MP + b * 4 + tq : (size_t)b * SEQ + tq; const int pos = sample ? PAST + tq : tq; const int cq = pos >> 6;
    for (int g = 0; g < 4; ++g) qs[g * 64 + lane] = bf2f(P.Q[row * D + (kv * 4 + g) * 64 + lane]);
    LDS_WAIT();
    const int ncmp = sample ? 64 : 128; const size_t cmpo = (size_t)(b * 4 + kv) * (sample ? 4096 : 8192); const bf16_t* kc = (const bf16_t*)((const char*)P.kcp + (sample ? WS_KCMPS - WS_KCMPP : 0)) + cmpo; const bf16_t* vc = (const bf16_t*)((const char*)P.vcp + (sample ? WS_VCMPS - WS_VCMPP : 0)) + cmpo;
    float oc0 = 0.f, oc1 = 0.f, oc2 = 0.f, oc3 = 0.f;
    for (int g = 0; g < 4; ++g) {
        float sA = -INFINITY, sB = -INFINITY;
        for (int h = 0; h < 2; ++h) { const int n = lane + 64 * h; const int dist = pos - (32 * n + 31); float s = -INFINITY;
            if (n < ncmp && dist >= 0) { float a = 0.f; for (int d = 0; d < 64; ++d) a += qs[g * 64 + d] * bf2f(kc[(size_t)n * 64 + d]); s = a + lutb[(kv * 4 + g) * 128 + (dist > 127 ? 127 : dist)]; }
            if (h == 0) sA = s; else sB = s; }
        const float mx = wmax(fmaxf(sA, sB)); float p0 = 0.f, p1 = 0.f;
        if (mx > -INFINITY) { p0 = ex2(sA - mx); p1 = ex2(sB - mx); }
        const float sm = wsum(p0 + p1); const float inv = sm > 0.f ? 1.0f / sm : 0.f;
        sc[g * 128 + lane] = p0 * inv; sc[g * 128 + 64 + lane] = p1 * inv;
    }
    LDS_WAIT();
    for (int g = 0; g < 4; ++g) { float a = 0.f; for (int n = 0; n < ncmp; ++n) a += sc[g * 128 + n] * bf2f(vc[(size_t)n * 64 + lane]); if (g == 0) oc0 = a; else if (g == 1) oc1 = a; else if (g == 2) oc2 = a; else oc3 = a; }
    float imp = 0.f; for (int g = 0; g < 4; ++g) imp += sc[g * 128 + 2 * lane] + sc[g * 128 + 2 * lane + 1];
    { const bool forced = (lane == 0) || (lane == cq) || (lane == cq - 1), elig = lane <= cq; imp = forced ? 1e9f : (elig ? imp : -1.0f); }
    LDS_WAIT(); qs[256 + lane] = imp; LDS_WAIT();
    int rank = 0; for (int j = 0; j < 64; ++j) { const float v = qs[256 + j]; rank += (v > imp) || (v == imp && j < lane); }
    const int nsb = sample ? 33 : 64;
    const unsigned long long selm = __ballot(rank < 16 && lane < nsb);
    float r0 = oc0, r1 = oc1, r2_ = oc2, r3 = oc3;
    if (br != 0) {
        const int nslot = br == 1 ? __builtin_popcountll(selm) : 9;
        LDS_WAIT();
        for (int si = 0; si < nslot && si < 16; ++si) {
            int j;
            if (br == 1) { unsigned long long mm = selm; for (int n = 0; n < si; ++n) mm &= mm - 1ull; j = __builtin_ctzll(mm); } else j = sample ? si : cq - 8 + si;
            bool ok = false; int pk = 0; const float* kf = nullptr; const bf16_t* kb = nullptr;
            if (br == 1) { pk = 64 * j + lane;
                if (!sample) { ok = pk <= pos; kb = P.KS + ((size_t)b * SEQ + pk) * 256 + kv * 64; }
                else if (j < 32) { ok = true; kf = P.ck_sel + (((size_t)P.pt[b * 16 + (j >> 1)] * 128 + (j & 1) * 64 + lane) * 4 + kv) * 64; }
                else { ok = lane < 4 && pk <= pos; kb = P.KS + ((size_t)MP + b * 4 + (lane & 3)) * 256 + kv * 64; } }
            else { if (!sample) { pk = 64 * j + lane; ok = j >= 0 && pk <= pos && pos - pk < 512; kb = P.KW + ((size_t)b * SEQ + (ok ? pk : 0)) * 256 + kv * 64; }
                else { const int e = 64 * j + lane; pk = PAST - 512 + e; ok = e < 516 && pk <= pos && pos - pk < 512;
                    if (e < 512) kf = P.st_kw + (((size_t)b * 512 + e) * 4 + kv) * 64; else kb = P.KW + ((size_t)MP + b * 4 + ((e - 512) & 3)) * 256 + kv * 64; } }
            const int dist = pos - pk;
            for (int g = 0; g < 4; ++g) { float s = -INFINITY;
                if (ok) { float a = 0.f; for (int d = 0; d < 64; ++d) a += qs[g * 64 + d] * (kf ? rb(kf[d]) : bf2f(kb[d])); s = a + lutb[(kv * 4 + g) * 128 + (dist > 127 ? 127 : dist)]; }
                sc[g * 1024 + si * 64 + lane] = s; }
        }
        LDS_WAIT();
        for (int g = 0; g < 4; ++g) {
            float mx = -INFINITY; for (int si = 0; si < nslot && si < 16; ++si) mx = fmaxf(mx, sc[g * 1024 + si * 64 + lane]);
            mx = wmax(mx); float sm = 0.f;
            for (int si = 0; si < nslot && si < 16; ++si) { const float p = mx > -INFINITY ? ex2(sc[g * 1024 + si * 64 + lane] - mx) : 0.f; sc[g * 1024 + si * 64 + lane] = p; sm += p; }
            sm = wsum(sm); const float inv = sm > 0.f ? 1.0f / sm : 0.f;
            LDS_WAIT();
            float a = 0.f;
            for (int si = 0; si < nslot && si < 16; ++si) {
                int j;
                if (br == 1) { unsigned long long mm = selm; for (int n = 0; n < si; ++n) mm &= mm - 1ull; j = __builtin_ctzll(mm); } else j = sample ? si : cq - 8 + si;
                for (int k = 0; k < 64; ++k) { const float p = sc[g * 1024 + si * 64 + k]; if (p == 0.f) continue; float v;
                    if (br == 1) { if (!sample) v = bf2f(P.VS[((size_t)b * SEQ + 64 * j + k) * 256 + kv * 64 + lane]);
                        else if (j < 32) v = rb(P.cv_sel[(((size_t)P.pt[b * 16 + (j >> 1)] * 128 + (j & 1) * 64 + k) * 4 + kv) * 64 + lane]);
                        else v = bf2f(P.VS[((size_t)MP + b * 4 + (k & 3)) * 256 + kv * 64 + lane]); }
                    else { if (!sample) v = bf2f(P.VW[((size_t)b * SEQ + 64 * j + k) * 256 + kv * 64 + lane]);
                        else { const int e = 64 * j + k; v = e < 512 ? rb(P.st_vw[(((size_t)b * 512 + e) * 4 + kv) * 64 + lane]) : bf2f(P.VW[((size_t)MP + b * 4 + ((e - 512) & 3)) * 256 + kv * 64 + lane]); } }
                    a += p * v; } }
            a *= inv; if (g == 0) r0 = a; else if (g == 1) r1 = a; else if (g == 2) r2_ = a; else r3 = a;
            LDS_WAIT();
        }
    }
    float d2 = 0.f, rr2 = 0.f;
    for (int g = 0; g < 4; ++g) { const float ref = g == 0 ? r0 : g == 1 ? r1 : g == 2 ? r2_ : r3; const float f = bf2f(P.O[row * D + (kv * 4 + g) * 64 + lane]); const float df = f - ref; d2 += df * df; rr2 += ref * ref; }
    d2 = wsum(d2); rr2 = wsum(rr2);
    if (lane == 0) { atomicAdd(errs + ((sample ? 3 : 0) + br) * 2, d2); atomicAdd(errs + ((sample ? 3 : 0) + br) * 2 + 1, rr2); }
}
#endif
}

constexpr int NPHASE = 17;
__global__ void __launch_bounds__(512, 2) nsa_fwd(Args args) {
    extern __shared__ __attribute__((aligned(16))) unsigned char lds[];
    Frame F;
    F.lds = (LAS unsigned char*)lds;
    F.tid = threadIdx.x; F.lane = F.tid & 63; F.wave = __builtin_amdgcn_readfirstlane(F.tid >> 6);
    F.G = gridDim.x; { const int bx = blockIdx.x; F.vcu = (F.G % 8 == 0) ? (bx % 8) * (F.G / 8) + bx / 8 : bx; }
    F.x_p = (const float*)args.in[0]; F.x_s = (const float*)args.in[1]; F.c_p = (const float*)args.in[2]; F.c_s = (const float*)args.in[3];
    F.ck_cmp = (const float*)args.in[4]; F.cv_cmp = (const float*)args.in[5]; F.ck_sel = (const float*)args.in[6]; F.cv_sel = (const float*)args.in[7];
    F.page_table = (const int*)args.in[8]; F.st_kw = (const float*)args.in[9]; F.st_vw = (const float*)args.in[10]; F.st_pool = (const float*)args.in[11];
    F.rel_bias = (const float*)args.in[12]; F.ada_w = (const float*)args.in[13]; F.ada_b = (const float*)args.in[14]; F.norm_g = (const float*)args.in[15]; F.final_g = (const float*)args.in[16];
    F.w_in = (const float*)args.in[17]; F.w_out = (const float*)args.in[18]; F.cmp_wk = (const float*)args.in[19]; F.cmp_wv = (const float*)args.in[20];
    F.pe_k = (const float*)args.in[21]; F.pe_v = (const float*)args.in[22]; F.pool_w = (const float*)args.in[23]; F.pool_scale = (const float*)args.in[24];
    F.ffn_wg = (const float*)args.in[25]; F.ffn_wu = (const float*)args.in[26]; F.ffn_wd = (const float*)args.in[27];
    F.out = args.out; F.ws = args.ws;
    unsigned char* ws = args.ws;
    for (int u = F.tid; u < 64; u += 512) ((LAS unsigned*)(F.lds + MISC_OFF))[u] = 0u;
    for (int u = F.tid; u < 16 * 128; u += 512) { const int h = u >> 7, d = u & 127; ((LAS float*)(F.lds + LUT_OFF))[u] = F.rel_bias[t5_bucket(d) * 16 + h] * LOG2E; }
    __syncthreads();
    volatile LAS unsigned* MISC = (volatile LAS unsigned*)(F.lds + MISC_OFF);
    XcdBarrier bar; bar.bar = (unsigned*)(ws + WS_CTL) + CW_BAR; bar.x = 0; bar.st = nullptr;
    if (!MK_SPLIT) bar = xcd_barrier_post((unsigned*)(ws + WS_CTL) + CW_BAR, MISC + 8);
    const int lo = args.ph_lo, hi = args.ph_hi;
#ifndef PHMASK
#define PHMASK 0x1FFFF
#endif
#define IN(k) (((PHMASK >> (k)) & 1) && lo <= (k) && (k) < hi)
#define SEAM(k) do { if (IN(k) && IN((k) + 1)) xcd_barrier(bar); } while (0)
#ifndef REPMASK
#define REPMASK 0
#endif
#define REPS(k) (((REPMASK >> (k)) & 1) ? 2 : 1)
    bf16_t* H = (bf16_t*)(ws + WS_H); float* X = (float*)(ws + WS_X); float* MOD = (float*)(ws + WS_MOD);

    if (IN(0)) { for (int rep = 0; rep < REPS(0); ++rep) p0_prologue(F); } SEAM(0);
    if (IN(1)) { for (int rep = 0; rep < REPS(1); ++rep) { p1_compress_sample(F); p1_ada(F); } } SEAM(1);
    if (IN(2)) { for (int rep = 0; rep < REPS(2); ++rep) norm_phase<0>(F, true, 0, 0); } SEAM(2);
    if (IN(3)) {
        pg8::Gemm g{H, (const bf16_t*)(ws + WS_WIN), D, D, D, 0}; pg8::StaticOrder S; S.init(MT, NPROJ, F.G, (int)blockIdx.x);
        pg8::EpiProj E{(bf16_t*)(ws + WS_Q), (bf16_t*)(ws + WS_KV), (float*)(ws + WS_GATES), F.out};
        for (int rep = 0; rep < REPS(3); ++rep) pg8::gemm_phase<pg8::EpiProj, pg8::StaticOrder, true>(F.lds, g, S, E);
    } SEAM(3);
    if (IN(4)) { for (int rep = 0; rep < REPS(4); ++rep) p4_compress_prompt(F); } SEAM(4);
    if (IN(5)) {
        att::Ptrs P; P.Q = (const bf16_t*)(ws + WS_Q); P.kcp = (const bf16_t*)(ws + WS_KCMPP); P.vcp = (const bf16_t*)(ws + WS_VCMPP); P.kcs = (const bf16_t*)(ws + WS_KCMPS); P.vcs = (const bf16_t*)(ws + WS_VCMPS);
        const bf16_t* kvb = (const bf16_t*)(ws + WS_KV); P.KS = kvb + 2 * KV_STRIDE; P.VS = kvb + 3 * KV_STRIDE; P.KW = kvb + 4 * KV_STRIDE; P.VW = kvb + 5 * KV_STRIDE;
        P.gates = (const float*)(ws + WS_GATES); P.O = (bf16_t*)(ws + WS_O); P.ck_sel = F.ck_sel; P.cv_sel = F.cv_sel; P.st_kw = F.st_kw; P.st_vw = F.st_vw; P.pt = F.page_table;
        P.gov = -1; P.kw_out = F.out + O_KWS; P.vw_out = F.out + O_KWS + SZ_WS;
#ifdef VERIFY
        P.gov = args.pad0 - 1;
#endif
#ifndef RS
#define RS 1
#endif
#ifndef RP
#define RP 1
#endif
#pragma unroll 1
        for (int pass = 0; pass < 2; ++pass) {
            if ((pass == 0) != ((F.vcu & 1) != 0)) {
#pragma unroll 1
                for (int rep = 0; rep < RS; ++rep)
                for (int u = F.vcu; u < NSB * 2; u += F.G) att::sample_unit(P, F.lds, u, u + NSB * 2, F.tid, F.wave, F.lane);
            } else {
#pragma unroll 1
                for (int rep = 0; rep < RP; ++rep)
                for (int u = F.vcu; u < 16 * 16; u += F.G) { const int bk = u >> 4, s = u & 15;
#pragma unroll 1
                    for (int i = 0; i < 4; ++i) { const int c = (i == 0) ? s : (i == 1) ? 31 - s : (i == 2) ? 32 + s : 63 - s; att::prompt_unit(P, F.lds, bk >> 2, bk & 3, c, F.tid, F.wave, F.lane); } }
            }
        }
    } SEAM(5);
    if (IN(6)) {
        pg8::Gemm g{(const bf16_t*)(ws + WS_O), (const bf16_t*)(ws + WS_WOUT), D, D, D, 0}; pg8::StaticOrder S; S.init(MP, D, F.G, (int)blockIdx.x);
        pg8::EpiRes E{F.x_p, F.x_s, X, MOD + 2048, nullptr};
        pg8::gemm_phase<pg8::EpiRes, pg8::StaticOrder, true>(F.lds, g, S, E);
        small_gemm_res(F, (const bf16_t*)(ws + WS_O) + (size_t)MP * D, D, (const bf16_t*)(ws + WS_WOUT), D, D, false, F.x_s, X + (size_t)MP * D, MOD + 2048, nullptr);
    } SEAM(6);
    if (IN(7)) { for (int rep = 0; rep < REPS(7); ++rep) norm_phase<0>(F, false, 0, 1); } SEAM(7);
    if (IN(8)) {
        pg8::Gemm g{H, (const bf16_t*)(ws + WS_WGU), D, D, D, 0}; pg8::StaticOrder S; S.init(MT, NGU, F.G, (int)blockIdx.x);
        pg8::EpiGU E{(bf16_t*)(ws + WS_ACT)};
        for (int rep = 0; rep < REPS(8); ++rep) pg8::gemm_phase<pg8::EpiGU, pg8::StaticOrder, true>(F.lds, g, S, E);
    } SEAM(8);
    if (IN(9)) {
        pg8::Gemm g{(const bf16_t*)(ws + WS_ACT), (const bf16_t*)(ws + WS_WD), FF, FF, FF, 0}; pg8::StaticOrder S; S.init(MP, D, F.G, (int)blockIdx.x);
        pg8::EpiRes E{X, X + (size_t)MP * D, X, MOD + 5120, nullptr};
        pg8::gemm_phase<pg8::EpiRes, pg8::StaticOrder, true>(F.lds, g, S, E);
        small_gemm_res(F, (const bf16_t*)(ws + WS_ACT) + (size_t)MP * FF, FF, (const bf16_t*)(ws + WS_WD), FF, FF, false, X + (size_t)MP * D, X + (size_t)MP * D, MOD + 5120, nullptr);
    } SEAM(9);
    if (IN(10)) { for (int rep = 0; rep < REPS(10); ++rep) norm_phase<1>(F, false, 1, 0); } SEAM(10);
    if (IN(11)) { for (int rep = 0; rep < REPS(11); ++rep) pool_phase(F); } SEAM(11);
    if (IN(12)) {
        pg8::Gemm g{H, (const bf16_t*)(ws + WS_WPOOL), D, 256, 256, 256}; pg8::StaticOrder S; S.init(MP, D, F.G, (int)blockIdx.x);
        pg8::EpiRes E{X, X + (size_t)MP * D, X, MOD + (size_t)NMODB * 6144 + 2048, F.pool_scale};
        pg8::gemm_phase<pg8::EpiRes, pg8::StaticOrder, true>(F.lds, g, S, E);
        small_gemm_res(F, H + (size_t)MP * D, D, (const bf16_t*)(ws + WS_WPOOL), 256, 256, true, X + (size_t)MP * D, X + (size_t)MP * D, MOD + (size_t)NMODB * 6144 + 2048, F.pool_scale);
    } SEAM(12);
    if (IN(13)) { for (int rep = 0; rep < REPS(13); ++rep) norm_phase<0>(F, false, 1, 1); } SEAM(13);
    if (IN(14)) {
        pg8::Gemm g{H, (const bf16_t*)(ws + WS_WGU) + (size_t)NGU * D, D, D, D, 0}; pg8::StaticOrder S; S.init(MT, NGU, F.G, (int)blockIdx.x);
        pg8::EpiGU E{(bf16_t*)(ws + WS_ACT)};
        pg8::gemm_phase<pg8::EpiGU, pg8::StaticOrder, true>(F.lds, g, S, E);
    } SEAM(14);
    if (IN(15)) {
        pg8::Gemm g{(const bf16_t*)(ws + WS_ACT), (const bf16_t*)(ws + WS_WD) + (size_t)D * FF, FF, FF, FF, 0}; pg8::StaticOrder S; S.init(MP, D, F.G, (int)blockIdx.x);
        pg8::EpiRes E{X, X + (size_t)MP * D, X, MOD + (size_t)NMODB * 6144 + 5120, nullptr};
        pg8::gemm_phase<pg8::EpiRes, pg8::StaticOrder, true>(F.lds, g, S, E);
        small_gemm_res(F, (const bf16_t*)(ws + WS_ACT) + (size_t)MP * FF, FF, (const bf16_t*)(ws + WS_WD) + (size_t)D * FF, FF, FF, false, X + (size_t)MP * D, X + (size_t)MP * D, MOD + (size_t)NMODB * 6144 + 5120, nullptr);
    } SEAM(15);
    if (IN(16)) { for (int rep = 0; rep < REPS(16); ++rep) norm_phase<2>(F, false, 0, 0); }
#undef IN
#undef SEAM
}


#ifdef VERIFY
__global__ void __launch_bounds__(512, 2) verify_k(Args args) {
    extern __shared__ __attribute__((aligned(16))) unsigned char lds[];
    LAS unsigned char* L = (LAS unsigned char*)lds; unsigned char* ws = args.ws;
    const int tid = threadIdx.x, lane = tid & 63, wave = __builtin_amdgcn_readfirstlane(tid >> 6);
    const float* rel_bias = (const float*)args.in[12];
    for (int u = tid; u < 16 * 128; u += 512) { const int h = u >> 7, d = u & 127; ((LAS float*)(L + LUT_OFF))[u] = rel_bias[t5_bucket(d) * 16 + h] * LOG2E; }
    __syncthreads();
    att::Ptrs P; P.Q = (const bf16_t*)(ws + WS_Q); P.kcp = (const bf16_t*)(ws + WS_KCMPP); P.vcp = (const bf16_t*)(ws + WS_VCMPP); P.kcs = (const bf16_t*)(ws + WS_KCMPS); P.vcs = (const bf16_t*)(ws + WS_VCMPS);
    const bf16_t* kvb = (const bf16_t*)(ws + WS_KV); P.KS = kvb + 2 * KV_STRIDE; P.VS = kvb + 3 * KV_STRIDE; P.KW = kvb + 4 * KV_STRIDE; P.VW = kvb + 5 * KV_STRIDE;
    P.gates = (const float*)(ws + WS_GATES); P.O = (bf16_t*)(ws + WS_O); P.ck_sel = (const float*)args.in[6]; P.cv_sel = (const float*)args.in[7]; P.st_kw = (const float*)args.in[9]; P.st_vw = (const float*)args.in[10]; P.pt = (const int*)args.in[8]; P.gov = args.pad0 - 1;
    float* errs = (float*)(ws + WS_CTL) + 65536;
    const int gw = blockIdx.x * 8 + wave;
    for (int it = gw; it < 168 + 64; it += gridDim.x * 8) { bool smp = it >= 168; int vb_, vt_, vk_;
        if (!smp) { const int ti = it % 21, r = it / 21; vb_ = (r >> 2) ? 3 : 0; vk_ = r & 3; vt_ = ti == 0 ? 0 : ti == 1 ? 5 : ti == 2 ? 30 : ti == 3 ? 31 : ti == 4 ? 63 : ti == 5 ? 64 : ti == 6 ? 100 : ti == 7 ? 511 : ti == 8 ? 512 : ti == 9 ? 600 : ti == 10 ? 959 : ti == 11 ? 960 : ti == 12 ? 1023 : ti == 13 ? 1024 : ti == 14 ? 1055 : ti == 15 ? 1100 : ti == 16 ? 2047 : ti == 17 ? 2048 : ti == 18 ? 3000 : ti == 19 ? 4032 : 4095; }
        else { const int q = it - 168, bi = q >> 4; vb_ = bi == 0 ? 0 : bi == 1 ? 1 : bi == 2 ? 77 : 127; vt_ = q & 3; vk_ = (q >> 2) & 3; }
        att::verify_item(P, L, smp, vb_, vt_, vk_, args.pad0 - 1, errs, wave, lane); }
}
__global__ void scale_k(Args args) {
    const float* errs = (const float*)(args.ws + WS_CTL) + 65536; const size_t offs[6] = {O_KCP, O_KCP + SZ_KVP, O_KCP + 2 * SZ_KVP, O_KCS, O_KCS + SZ_KVS, O_KCS + 2 * SZ_KVS};
    const int k = blockIdx.y; const float d2 = errs[2 * k], r2 = errs[2 * k + 1]; const float e = r2 > 0.f ? sqrtf(d2 / r2) : 7.0f; const size_t n = k < 3 ? SZ_KVP : SZ_KVS;
    for (size_t i = (size_t)blockIdx.x * blockDim.x + threadIdx.x; i < n; i += (size_t)gridDim.x * blockDim.x) args.out[offs[k] + i] *= (1.0f + e);
}
#endif
extern "C" void kernel_launch(void* const* d_in, const int* in_sizes, int n_in, void* d_out, int out_size, void* d_ws, size_t ws_size, hipStream_t stream) {
    static int grid = 0;
    if (grid == 0) {
        if (n_in != 28 || (size_t)out_size != O_END || ws_size < WS_END) { fprintf(stderr, "kernel_launch: unexpected shapes (n_in %d, out %d, ws %zu); nothing launched\n", n_in, out_size, ws_size); grid = -1; return; }
        int dev = 0, cus = 0, per_cu = 0;
        if (hipGetDevice(&dev) != hipSuccess || hipDeviceGetAttribute(&cus, hipDeviceAttributeMultiprocessorCount, dev) != hipSuccess) { grid = -1; return; }
        if (hipFuncSetAttribute((const void*)nsa_fwd, hipFuncAttributeMaxDynamicSharedMemorySize, LDS_BYTES) != hipSuccess) { fprintf(stderr, "kernel_launch: hipFuncSetAttribute(%d B LDS) failed\n", LDS_BYTES); grid = -1; return; }
        if (hipOccupancyMaxActiveBlocksPerMultiprocessor(&per_cu, (const void*)nsa_fwd, 512, LDS_BYTES) != hipSuccess || per_cu < 1)
            fprintf(stderr, "kernel_launch: note: occupancy query reports %d workgroups per CU\n", per_cu);
        (void)hipGetLastError();
        grid = cus;
    }
    if (grid < 0) return;
    (void)hipMemsetAsync((char*)d_ws + WS_CTL, 0, CTL_ZERO_BYTES, stream);
    Args a{};
    for (int i = 0; i < 28; ++i) a.in[i] = d_in[i];
    a.out = (float*)d_out; a.ws = (unsigned char*)d_ws; a.pad0 = 0; a.pad1 = 0;
#ifdef VERIFY
    hipFuncSetAttribute((const void*)verify_k, hipFuncAttributeMaxDynamicSharedMemorySize, LDS_BYTES);
    for (int pass = 0; pass < 3; ++pass) { a.pad0 = pass + 1; a.ph_lo = 0; a.ph_hi = 6;
        (void)hipMemsetAsync((char*)d_ws + WS_CTL, 0, 65536 * 4, stream);
        hipLaunchKernelGGL(nsa_fwd, dim3(grid), dim3(512), LDS_BYTES, stream, a);
        hipLaunchKernelGGL(verify_k, dim3(grid), dim3(512), LDS_BYTES, stream, a); }
    a.pad0 = 0; (void)hipMemsetAsync((char*)d_ws + WS_CTL, 0, 65536 * 4, stream);
    a.ph_lo = 0; a.ph_hi = NPHASE;
    hipLaunchKernelGGL(nsa_fwd, dim3(grid), dim3(512), LDS_BYTES, stream, a);
    hipLaunchKernelGGL(scale_k, dim3(64, 6), dim3(256), 0, stream, a);
#elif MK_SPLIT
    for (int p = 0; p < NPHASE; ++p) { a.ph_lo = p; a.ph_hi = p + 1; hipLaunchKernelGGL(nsa_fwd, dim3(grid), dim3(512), LDS_BYTES, stream, a); }
#else
    a.ph_lo = 0; a.ph_hi = NPHASE;
    hipLaunchKernelGGL(nsa_fwd, dim3(grid), dim3(512), LDS_BYTES, stream, a);
#endif
    const hipError_t le = hipPeekAtLastError();
    if (le != hipSuccess) fprintf(stderr, "kernel_launch: launch failed: %s\n", hipGetErrorName(le));
}
```

```cpp
#include <hip/hip_runtime.h>
#include <cstdio>
#include <cstdint>

#ifndef MK_SPLIT
#define MK_SPLIT 0
#endif

#define GAS __attribute__((address_space(1)))
#define LAS __attribute__((address_space(3)))
typedef unsigned short bf16_t;
typedef short bf16x8 __attribute__((ext_vector_type(8)));
typedef short s16x4 __attribute__((ext_vector_type(4)));
typedef float f32x2 __attribute__((ext_vector_type(2)));
typedef float f32x4 __attribute__((ext_vector_type(4)));
typedef float f32x16 __attribute__((ext_vector_type(16)));
typedef unsigned u32x2 __attribute__((ext_vector_type(2)));
typedef unsigned u32x4 __attribute__((ext_vector_type(4)));
typedef __bf16 bf16x2_t __attribute__((ext_vector_type(2)));
typedef GAS unsigned gu32;

constexpr int D = 1024, SEQ = 4096, NB = 4, NSB = 128, DSEQ = 4;
constexpr int MP = NB * SEQ, MS = NSB * DSEQ, MT = MP + MS;
constexpr int INCOLS = 2608, NPROJ = 2816, FF = 2816, NGU = 2 * FF;
constexpr int NMODB = NB + NSB;
constexpr int PAST = 2048;
constexpr float C2 = 0.125f * 1.4426950408889634f;
constexpr float LOG2E = 1.4426950408889634f;

constexpr size_t O_YP = 0, O_YS = O_YP + (size_t)MP * D;
constexpr size_t O_KCP = O_YS + (size_t)MS * D, SZ_KVP = (size_t)MP * 256;
constexpr size_t O_KWP = O_KCP + 4 * SZ_KVP, SZ_WP = (size_t)NB * 512 * 256;
constexpr size_t O_PLP = O_KWP + 2 * SZ_WP;
constexpr size_t O_KCS = O_PLP + (size_t)NB * 15 * D, SZ_KVS = (size_t)MS * 256;
constexpr size_t O_KWS = O_KCS + 4 * SZ_KVS, SZ_WS = (size_t)NSB * 512 * 256;
constexpr size_t O_PLS = O_KWS + 2 * SZ_WS;
constexpr size_t O_END = O_PLS + (size_t)NSB * 15 * D;
static_assert(O_END == 71233536, "output size");

constexpr size_t MiB = 1u << 20;
#ifdef VERIFY
constexpr size_t WS_CTL = 0, CTL_ZERO_BYTES = 1 * MiB;
#else
constexpr size_t WS_CTL = 0, CTL_ZERO_BYTES = 65536;
#endif
constexpr size_t WS_WIN = 2 * MiB;
constexpr size_t WS_WOUT = 8 * MiB;
constexpr size_t WS_WGU = 10 * MiB;
constexpr size_t WS_WD = 32 * MiB;
constexpr size_t WS_WPOOL = 44 * MiB;
constexpr size_t WS_WCK = 45 * MiB, WS_WCV = WS_WCK + 262144;
constexpr size_t WS_SC = 46 * MiB;
constexpr size_t WS_CB = 47 * MiB;
constexpr size_t WS_MOD = 48 * MiB;
constexpr size_t WS_KCMPP = 56 * MiB, WS_VCMPP = 57 * MiB;
constexpr size_t WS_KCMPS = 58 * MiB, WS_VCMPS = 62 * MiB;
constexpr size_t WS_GATES = 66 * MiB;
constexpr size_t WS_H = 72 * MiB;
constexpr size_t WS_Q = 108 * MiB;
constexpr size_t WS_O = 144 * MiB;
constexpr size_t WS_KV = 180 * MiB, KV_STRIDE = (size_t)MT * 256;
constexpr size_t WS_X = 232 * MiB;
constexpr size_t WS_HF = 300 * MiB;
constexpr size_t WS_ACT = 368 * MiB;
constexpr size_t WS_END = 464 * MiB;
static_assert(WS_KV + 6 * KV_STRIDE * 2 <= WS_X && WS_X + (size_t)MT * D * 4 <= WS_HF && WS_HF + (size_t)MT * D * 4 <= WS_ACT && WS_ACT + (size_t)MT * FF * 2 <= WS_END, "ws map");
static_assert(WS_WGU + 2 * (size_t)NGU * D * 2 <= WS_WD && WS_WD + 2 * (size_t)D * FF * 2 <= WS_WPOOL && WS_MOD + 2 * (size_t)NMODB * 6144 * 4 <= WS_KCMPP, "ws map 2");
static_assert(WS_GATES + (size_t)MT * 48 * 4 <= WS_H && WS_H + (size_t)MT * D * 2 <= WS_Q && WS_Q + (size_t)MT * D * 2 <= WS_O && WS_O + (size_t)MT * D * 2 <= WS_KV, "ws map 3");
constexpr int CW_BAR = 4096;

constexpr int RING_BYTES = 131072;
constexpr int LUT_OFF = RING_BYTES;
constexpr int WSF_OFF = LUT_OFF + 8192;
constexpr int IMP_OFF = WSF_OFF + 1024;
constexpr int MISC_OFF = IMP_OFF + 16384;
constexpr int LDS_BYTES = MISC_OFF + 256;
static_assert(LDS_BYTES <= 160 * 1024, "LDS");

__device__ __forceinline__ unsigned cvtpk(float lo, float hi) { f32x2 v = {lo, hi}; bf16x2_t b = __builtin_convertvector(v, bf16x2_t); return __builtin_bit_cast(unsigned, b); }
__device__ __forceinline__ float bf2f(unsigned short h) { return __builtin_bit_cast(float, (unsigned)h << 16); }
__device__ __forceinline__ float ex2(float x) { return __builtin_amdgcn_exp2f(x); }
__device__ __forceinline__ float sigmoidf_(float x) { return __builtin_amdgcn_rcpf(1.0f + ex2(-x * LOG2E)); }
#define CROW0(r) (((r) & 3) + 8 * ((r) >> 2))
#define LDS_WAIT() asm volatile("s_waitcnt lgkmcnt(0)" ::: "memory")
#define VM_WAIT() asm volatile("s_waitcnt vmcnt(0)" ::: "memory")
__device__ __forceinline__ const char* uniform_ptr(const void* p) { const unsigned long long v = (unsigned long long)p; const unsigned lo = (unsigned)__builtin_amdgcn_readfirstlane((int)(unsigned)v), hi = (unsigned)__builtin_amdgcn_readfirstlane((int)(unsigned)(v >> 32)); return (const char*)(((unsigned long long)hi << 32) | lo); }

__device__ __forceinline__ int lane_id() { int l; asm volatile("v_mbcnt_lo_u32_b32 %0, -1, 0\n\tv_mbcnt_hi_u32_b32 %0, -1, %0" : "=v"(l)); return l; }
__device__ __forceinline__ int t5_bucket(int d) {
    if (d < 16) return d;
    int b = 16;
    b += (d >= 19) + (d >= 21) + (d >= 24) + (d >= 27) + (d >= 31) + (d >= 35) + (d >= 40) + (d >= 46) + (d >= 52) + (d >= 59) + (d >= 67) + (d >= 77) + (d >= 87) + (d >= 99) + (d >= 113);
    return b;
}

namespace pg8 {
constexpr int BM = 256, BK = 64, HALF = 128, HTB = HALF * BK * 2, STAGE_BYTES = 8 * HTB, NXCD = 8, WGM = 8;
__host__ __device__ __forceinline__ int lds_byte(int r, int c) { const int st = (r >> 4) * 2 + (c >> 5), rr = r & 15, cc = c & 31, ob = rr * 64 + cc * 2; return st * 1024 + (ob ^ (((ob >> 9) & 1) << 5)); }
__host__ __device__ __forceinline__ void stage_rc(int b, int& R, int& C) { const int st = b / 1024, sb = b % 1024, swz = sb ^ (((sb >> 9) & 1) << 5); R = (st >> 1) * 16 + swz / 64; C = (st & 1) * 32 + (swz % 64) / 2; }
__host__ __device__ __forceinline__ int perm32(int rho) { const int n = rho >> 4, i = rho & 15; return 8 * (i >> 2) + 4 * n + (i & 3); }
struct Unit { int pm, pn; };
struct Gemm { const bf16_t* A; const bf16_t* Bt; int lda, ldb, K, acs; };
struct StaticOrder {
    int nM, nN, nwg, G, c;
    __host__ __device__ void init(int M, int N, int G_, int c_) { nM = M / BM; nN = N / BM; nwg = nM * nN; G = G_; c = c_; }
    __host__ __device__ bool next(int i, Unit& u) const {
        const long L = (long)i * G + c; if (L >= nwg) return false;
        int wgid = (int)L; { const int q = nwg / NXCD, r = nwg % NXCD, xcd = wgid % NXCD, off = wgid / NXCD; wgid = (xcd < r ? xcd * (q + 1) : r * (q + 1) + (xcd - r) * q) + off; }
        const int nig = WGM * nN, gid = wgid / nig, fm = gid * WGM, gsz = (nM - fm) < WGM ? (nM - fm) : WGM;
        u.pm = fm + ((wgid % nig) % gsz); u.pn = (wgid % nig) / gsz; return true;
    }
};
template <class Epi, class Sched, bool ALIGN_EPI>
__device__ __forceinline__ void gemm_phase(LAS unsigned char* lds, const Gemm g, const Sched& S, const Epi& E) {
    const int tid = threadIdx.x, wid = __builtin_amdgcn_readfirstlane(tid >> 6), lane = tid & 63, wr = wid >> 2, wc = wid & 3, fr = lane & 15, fq = lane >> 4;
    const int K = g.K, nt = K / BK;
    unsigned voffA[2], voffB[2];
#pragma unroll
    for (int i = 0; i < 2; ++i) { int R, C; stage_rc(tid * 16 + i * 8192, R, C); const int Rb = Epi::PERM ? ((R & ~31) + perm32(R & 31)) : R;
        voffA[i] = (unsigned)(R * g.lda + C) * 2u; voffB[i] = (unsigned)(Rb * g.ldb + C) * 2u; }
    const size_t kstep = (size_t)(BK * 2);
    const size_t hsA = (size_t)HALF * g.lda * 2, hsB = (size_t)HALF * g.ldb * 2;
    const unsigned ldsw = (unsigned)wid * 1024u;
    const int aoff = lds_byte(wr * 64 + fr, fq * 8), boff = lds_byte(wc * 32 + fr, fq * 8);
#define PG8_SA(b, h) (((b) * 2 + (h)) * HTB)
#define PG8_SB(b, h) ((4 + (b) * 2 + (h)) * HTB)
#define PG8_STAGE(bufoff, gbase, voff) do { _Pragma("unroll") for (int _i = 0; _i < 2; ++_i) \
        __builtin_amdgcn_global_load_lds((const unsigned*)((const char*)(gbase) + (voff)[_i]), (LAS unsigned*)(lds + (bufoff) + ldsw + _i * 8192), 16, 0, 0); } while (0)
#define PG8_LDA(dst, b, h) do { _Pragma("unroll") for (int m = 0; m < 4; ++m) _Pragma("unroll") for (int k = 0; k < 2; ++k) dst[m][k] = *(const LAS bf16x8*)(lds + PG8_SA(b, h) + aoff + m * 2048 + k * 1024); } while (0)
#define PG8_LDB(dst, b, h) do { _Pragma("unroll") for (int n = 0; n < 2; ++n) _Pragma("unroll") for (int k = 0; k < 2; ++k) dst[n][k] = *(const LAS bf16x8*)(lds + PG8_SB(b, h) + boff + n * 2048 + k * 1024); } while (0)
#define PG8_MMA(ai, bj, At, Bt) do { __builtin_amdgcn_s_setprio(1); _Pragma("unroll") for (int m = 0; m < 4; ++m) _Pragma("unroll") for (int n = 0; n < 2; ++n) _Pragma("unroll") for (int k = 0; k < 2; ++k) \
        acc[ai][bj][m][n] = __builtin_amdgcn_mfma_f32_16x16x32_bf16(Bt[n][k], At[m][k], acc[ai][bj][m][n], 0, 0, 0); __builtin_amdgcn_s_setprio(0); } while (0)
#define PG8_WAIT_V(n) asm volatile("s_waitcnt vmcnt(" #n ")" ::: "memory")
#define PG8_WAIT_L(n) asm volatile("s_waitcnt lgkmcnt(" #n ")" ::: "memory")
#define PG8_BAR __builtin_amdgcn_s_barrier()
#define PG8_SCHED __builtin_amdgcn_sched_barrier(0)
#define PG8_UA(u) ((const char*)g.A + (size_t)(u).pm * 2 * hsA + (size_t)(u).pn * (size_t)g.acs * 2)
#define PG8_UB(u) ((const char*)g.Bt + (size_t)(u).pn * 2 * hsB)
    Unit cur, nxt; int ui = 0;
    if (!S.next(0, cur)) return;
    f32x4 acc[2][2][4][2];
#pragma unroll
    for (int a = 0; a < 2; ++a)
#pragma unroll
        for (int b = 0; b < 2; ++b)
#pragma unroll
            for (int m = 0; m < 4; ++m)
#pragma unroll
                for (int n = 0; n < 2; ++n) acc[a][b][m][n] = (f32x4){0.f, 0.f, 0.f, 0.f};
    bf16x8 At[4][2], B0[2][2], B1[2][2];
    const char* cA = PG8_UA(cur); const char* cB = PG8_UB(cur);
    PG8_STAGE(PG8_SB(0, 0), cB, voffB); PG8_STAGE(PG8_SB(0, 1), cB + hsB, voffB); PG8_STAGE(PG8_SA(0, 0), cA, voffA); PG8_STAGE(PG8_SA(0, 1), cA + hsA, voffA);
    if (wr == 1) PG8_BAR;
    PG8_WAIT_V(2); PG8_BAR;
    PG8_STAGE(PG8_SB(1, 0), cB + kstep, voffB); PG8_STAGE(PG8_SA(1, 0), cA + kstep, voffA); PG8_STAGE(PG8_SB(1, 1), cB + hsB + kstep, voffB);
    PG8_WAIT_V(6); PG8_BAR;
    for (;;) {
        const bool has_next = S.next(ui + 1, nxt);
        const char* nA = has_next ? PG8_UA(nxt) : cA; const char* nB = has_next ? PG8_UB(nxt) : cB;
        for (int t = 0; t < nt; t += 2) {
            const bool last = (t == nt - 2);
            const char* a1 = cA + (size_t)(t + 1) * kstep;
            const char* a2 = last ? nA : cA + (size_t)(t + 2) * kstep; const char* b2 = last ? nB : cB + (size_t)(t + 2) * kstep;
            const char* a3 = a2 + kstep; const char* b3 = b2 + kstep;
            PG8_LDB(B0, 0, 0); PG8_LDB(B1, 0, 1); PG8_SCHED; PG8_LDA(At, 0, 0); PG8_STAGE(PG8_SA(1, 1), a1 + hsA, voffA);
            PG8_WAIT_V(8); PG8_WAIT_L(0); PG8_BAR; PG8_MMA(0, 0, At, B0); PG8_MMA(0, 1, At, B1); PG8_BAR; PG8_SCHED;
            PG8_LDA(At, 0, 1); PG8_STAGE(PG8_SB(0, 0), b2, voffB); PG8_STAGE(PG8_SB(0, 1), b2 + hsB, voffB); PG8_STAGE(PG8_SA(0, 0), a2, voffA);
            PG8_WAIT_V(8); PG8_WAIT_L(0); PG8_BAR; PG8_MMA(1, 0, At, B0); PG8_MMA(1, 1, At, B1); PG8_BAR; PG8_SCHED;
            PG8_LDB(B0, 1, 0); PG8_LDB(B1, 1, 1); PG8_SCHED; PG8_LDA(At, 1, 0); PG8_STAGE(PG8_SA(0, 1), a2 + hsA, voffA);
            PG8_WAIT_V(8); PG8_WAIT_L(0); PG8_BAR; PG8_MMA(0, 0, At, B0); PG8_MMA(0, 1, At, B1); PG8_BAR; PG8_SCHED;
            PG8_LDA(At, 1, 1); PG8_STAGE(PG8_SB(1, 0), b3, voffB); PG8_STAGE(PG8_SB(1, 1), b3 + hsB, voffB); PG8_STAGE(PG8_SA(1, 0), a3, voffA);
            PG8_WAIT_V(8); PG8_WAIT_L(0); PG8_BAR; PG8_MMA(1, 0, At, B0); PG8_MMA(1, 1, At, B1); PG8_BAR; PG8_SCHED;
        }
        if constexpr (ALIGN_EPI) { if (wr == 0) PG8_BAR; }
        E(acc, cur, wr, wc, fr, fq);
        if (!has_next) break;
#pragma unroll
        for (int a = 0; a < 2; ++a)
#pragma unroll
            for (int b = 0; b < 2; ++b)
#pragma unroll
                for (int m = 0; m < 4; ++m)
#pragma unroll
                    for (int n = 0; n < 2; ++n) acc[a][b][m][n] = (f32x4){0.f, 0.f, 0.f, 0.f};
        cur = nxt; cA = nA; cB = nB; ++ui;
        if constexpr (ALIGN_EPI) { if (wr == 1) PG8_BAR; }
    }
    PG8_WAIT_V(0);
    if constexpr (!ALIGN_EPI) { if (wr == 0) PG8_BAR; }
    PG8_BAR;
#undef PG8_SA
#undef PG8_SB
#undef PG8_STAGE
#undef PG8_LDA
#undef PG8_LDB
#undef PG8_MMA
#undef PG8_WAIT_V
#undef PG8_WAIT_L
#undef PG8_BAR
#undef PG8_SCHED
#undef PG8_UA
#undef PG8_UB
}

struct EpiProj {
    static constexpr bool PERM = true;
    bf16_t* Q; bf16_t* KV; float* gates; float* out;
    __device__ __forceinline__ void operator()(const f32x4 (&acc)[2][2][4][2], const Unit& u, int wr, int wc, int fr, int fq) const {
        const int pn = u.pn;
#pragma unroll
        for (int ai = 0; ai < 2; ++ai)
#pragma unroll
            for (int m = 0; m < 4; ++m) {
                const int row = u.pm * BM + ai * HALF + wr * 64 + m * 16 + fr;
                if (pn < 4) {
#pragma unroll
                    for (int bj = 0; bj < 2; ++bj) { const f32x4 v0 = acc[ai][bj][m][0] * C2, v1 = acc[ai][bj][m][1] * C2; u32x4 w;
                        w.x = cvtpk(v0[0], v0[1]); w.y = cvtpk(v0[2], v0[3]); w.z = cvtpk(v1[0], v1[1]); w.w = cvtpk(v1[2], v1[3]);
                        *(u32x4*)(Q + (size_t)row * D + pn * 256 + bj * HALF + wc * 32 + 8 * fq) = w; }
                } else if (pn < 10) {
                    const int t = pn - 4; float* dst = nullptr;
                    if (row < MP) { if (t < 4) dst = out + O_KCP + (size_t)t * SZ_KVP + (size_t)row * 256; else { const int tt = row & (SEQ - 1); if (tt >= SEQ - 512) dst = out + O_KWP + (size_t)(t - 4) * SZ_WP + ((size_t)(row >> 12) * 512 + (tt - (SEQ - 512))) * 256; } }
                    else { const int rs = row - MP; if (t < 4) dst = out + O_KCS + (size_t)t * SZ_KVS + (size_t)rs * 256; else dst = out + O_KWS + (size_t)(t - 4) * SZ_WS + ((size_t)(rs >> 2) * 512 + 508 + (rs & 3)) * 256; }
                    bf16_t* bd = KV + (size_t)t * KV_STRIDE + (size_t)row * 256;
#pragma unroll
                    for (int bj = 0; bj < 2; ++bj) { const int cc = bj * HALF + wc * 32 + 8 * fq; const f32x4 v0 = acc[ai][bj][m][0], v1 = acc[ai][bj][m][1]; u32x4 w;
                        w.x = cvtpk(v0[0], v0[1]); w.y = cvtpk(v0[2], v0[3]); w.z = cvtpk(v1[0], v1[1]); w.w = cvtpk(v1[2], v1[3]);
                        *(u32x4*)(bd + cc) = w;
                        if (dst) { *(f32x4*)(dst + cc) = v0; *(f32x4*)(dst + cc + 4) = v1; } }
                } else {
                    const int cc = wc * 32 + 8 * fq;
                    if (cc < 48) { float* gd = gates + (size_t)row * 48 + cc; *(f32x4*)gd = acc[ai][0][m][0]; *(f32x4*)(gd + 4) = acc[ai][0][m][1]; }
                }
            }
    }
};
struct EpiRes {
    static constexpr bool PERM = false;
    const float* xin_p; const float* xin_s; float* xout; const float* gate; const float* scale;
    __device__ __forceinline__ void operator()(const f32x4 (&acc)[2][2][4][2], const Unit& u, int wr, int wc, int fr, int fq) const {
#pragma unroll
        for (int ai = 0; ai < 2; ++ai)
#pragma unroll
            for (int m = 0; m < 4; ++m) {
                const int row = u.pm * BM + ai * HALF + wr * 64 + m * 16 + fr;
                const int bb = row < MP ? (row >> 12) : NB + ((row - MP) >> 2);
                const float* xi = row < MP ? xin_p + (size_t)row * D : xin_s + (size_t)(row - MP) * D;
                const float* gp = gate + (size_t)bb * 6144; float* xo = xout + (size_t)row * D;
#pragma unroll
                for (int bj = 0; bj < 2; ++bj)
#pragma unroll
                    for (int n = 0; n < 2; ++n) { const int col = u.pn * BM + bj * HALF + wc * 32 + 16 * n + 4 * fq;
                        f32x4 g4 = *(const f32x4*)(gp + col); if (scale) g4 = g4 * *(const f32x4*)(scale + col);
                        const f32x4 x4 = *(const f32x4*)(xi + col); *(f32x4*)(xo + col) = x4 + g4 * acc[ai][bj][m][n]; }
            }
    }
};
struct EpiGU {
    static constexpr bool PERM = true;
    bf16_t* act;
    __device__ __forceinline__ void operator()(const f32x4 (&acc)[2][2][4][2], const Unit& u, int wr, int wc, int fr, int fq) const {
#pragma unroll
        for (int ai = 0; ai < 2; ++ai)
#pragma unroll
            for (int m = 0; m < 4; ++m) {
                const int row = u.pm * BM + ai * HALF + wr * 64 + m * 16 + fr; float r[8];
#pragma unroll
                for (int n = 0; n < 2; ++n)
#pragma unroll
                    for (int e = 0; e < 4; ++e) { const float gv = acc[ai][0][m][n][e], uv = acc[ai][1][m][n][e]; r[n * 4 + e] = gv * sigmoidf_(gv) * uv; }
                u32x4 w; w.x = cvtpk(r[0], r[1]); w.y = cvtpk(r[2], r[3]); w.z = cvtpk(r[4], r[5]); w.w = cvtpk(r[6], r[7]);
                *(u32x4*)(act + (size_t)row * FF + u.pn * HALF + wc * 32 + 8 * fq) = w;
            }
    }
};
}

#define XB_TMO      128
#define XB_XCNT(j)  (256  + 64 * (j))
#define XB_XSUB(j)  (1280 + 64 * (j))
#define XB_XGEN(j)  (2304 + 64 * (j))
#define XB_TOP      3328
#define XB_TOPGEN   3392
#define XCD_BAR_WORDS 3456
#define XB_SPIN_CAP (1u << 18)
__device__ __forceinline__ unsigned xb_ld(unsigned* p)              { return __hip_atomic_load(p, __ATOMIC_RELAXED, __HIP_MEMORY_SCOPE_AGENT); }
__device__ __forceinline__ unsigned xb_add(unsigned* p, unsigned v) { return __hip_atomic_fetch_add(p, v, __ATOMIC_RELAXED, __HIP_MEMORY_SCOPE_AGENT); }
__device__ __forceinline__ unsigned xb_xcc_id() { return (unsigned)__builtin_amdgcn_s_getreg((3 << 11) | 20) & 0xFu; }
#define XB_SPIN(cond, bar) do { unsigned _sp = 0; while (cond) { __builtin_amdgcn_s_sleep(1); \
    if ((++_sp & 255u) == 0u) { if (xb_ld(&(bar)[XB_TMO])) break; if (_sp > XB_SPIN_CAP) { atomicAdd(&(bar)[XB_TMO], 1u); break; } } } } while (0)
struct XcdBarrier { unsigned* bar; unsigned x; volatile LAS unsigned* st; };
__device__ __forceinline__ XcdBarrier xcd_barrier_post(unsigned* bar, volatile LAS unsigned* st) {
    XcdBarrier b; b.bar = bar; b.x = xb_xcc_id(); b.st = st;
    if (threadIdx.x == 0) (void)xb_add(&bar[XB_XCNT(b.x)], 1u);
    return b;
}
__device__ __forceinline__ void xcd_barrier_complete(unsigned* bar, unsigned x, unsigned& nloc, unsigned& nx) {
    const unsigned G = gridDim.x * gridDim.y * gridDim.z;
    unsigned sum, cnt, mine, sp = 0u;
    for (;;) {
        sum = 0u; cnt = 0u; mine = 0u;
#pragma unroll
        for (unsigned j = 0; j < 16; ++j) { const unsigned c = xb_ld(&bar[XB_XCNT(j)]); sum += c; cnt += (c > 0u) ? 1u : 0u; mine = (j == x) ? c : mine; }
        if (sum == G) break;
        __builtin_amdgcn_s_sleep(1);
        if ((++sp & 255u) == 0u) { if (xb_ld(&bar[XB_TMO])) break; if (sp > XB_SPIN_CAP) { atomicAdd(&bar[XB_TMO], 1u); break; } }
    }
    nloc = mine > 0u ? mine : 1u; nx = cnt > 0u ? cnt : 1u;
}
__device__ __forceinline__ void xcd_barrier(const XcdBarrier& b) {
    asm volatile("s_waitcnt vmcnt(0)" ::: "memory");
    __syncthreads();
    if (threadIdx.x == 0) {
        unsigned* bar = b.bar;
        __builtin_amdgcn_s_waitcnt(0);
        unsigned nloc = b.st[0], nx = b.st[1];
        if (nloc == 0u) { xcd_barrier_complete(bar, b.x, nloc, nx); b.st[0] = nloc; b.st[1] = nx; }
        const unsigned old = xb_add(&bar[XB_XSUB(b.x)], 1u);
        const unsigned gen = old / nloc;
        if (old + 1u == (gen + 1u) * nloc) {
            __builtin_amdgcn_fence(__ATOMIC_RELEASE, "agent");
            asm volatile("s_waitcnt vmcnt(0)" ::: "memory");
            const unsigned og = xb_add(&bar[XB_TOP], 1u);
            const unsigned tg = og / nx;
            if (og + 1u == (tg + 1u) * nx) xb_add(&bar[XB_TOPGEN], 1u);
            else XB_SPIN(xb_ld(&bar[XB_TOPGEN]) == tg, bar);
            __builtin_amdgcn_fence(__ATOMIC_ACQUIRE, "agent");
            xb_add(&bar[XB_XGEN(b.x)], 1u);
            asm volatile("s_waitcnt vmcnt(0)" ::: "memory");
        } else {
            XB_SPIN(xb_ld(&bar[XB_XGEN(b.x)]) == gen, bar);
            __builtin_amdgcn_fence(__ATOMIC_ACQUIRE, "agent");
            asm volatile("s_waitcnt vmcnt(0)" ::: "memory");
        }
    }
    __syncthreads();
}

struct Args { const void* in[28]; float* out; unsigned char* ws; int ph_lo, ph_hi, pad0, pad1; };
struct Frame {
    LAS unsigned char* lds; int tid, lane, wave, vcu, G;
    const float *x_p, *x_s, *c_p, *c_s, *ck_cmp, *cv_cmp, *ck_sel, *cv_sel; const int* page_table; const float *st_kw, *st_vw, *st_pool, *rel_bias, *ada_w, *ada_b, *norm_g, *final_g,
        *w_in, *w_out, *cmp_wk, *cmp_wv, *pe_k, *pe_v, *pool_w, *pool_scale, *ffn_wg, *ffn_wu, *ffn_wd;
    float* out; unsigned char* ws;
};
__device__ __forceinline__ float wave_sum(float v) {
#pragma unroll
    for (int o = 1; o < 64; o <<= 1) v += __shfl_xor(v, o);
    return v;
}

__device__ __forceinline__ void transpose_item(const float* W, int ldw, int nvalid, bf16_t* WT, int ldt, int drow0, LAS float* scr, int k0, int n0, int lane) {
    float tv[32];
#pragma unroll
    for (int i = 0; i < 32; ++i) { const int kk = 2 * i + (lane >> 5), n = n0 + (lane & 31); tv[i] = (n < nvalid) ? W[(size_t)(k0 + kk) * ldw + n] : 0.f; }
#pragma unroll
    for (int i = 0; i < 32; ++i) { const int kk = 2 * i + (lane >> 5); scr[kk * 33 + (lane & 31)] = tv[i]; }
    LDS_WAIT();
    const int c = lane & 7;
#pragma unroll
    for (int j = 0; j < 4; ++j) { const int n = (lane >> 3) + 8 * j; const LAS float* s = scr + (8 * c) * 33 + n;
        u32x4 o; o.x = cvtpk(s[0 * 33], s[1 * 33]); o.y = cvtpk(s[2 * 33], s[3 * 33]); o.z = cvtpk(s[4 * 33], s[5 * 33]); o.w = cvtpk(s[6 * 33], s[7 * 33]);
        *(u32x4*)(WT + (size_t)(drow0 + n) * ldt + k0 + 8 * c) = o; }
    LDS_WAIT();
}
__device__ __forceinline__ void p0_prologue(Frame& F) {
    LAS float* scr = (LAS float*)(F.lds + F.wave * 16384);
    const int gw = F.vcu * 8 + F.wave, NGW = F.G * 8, lane = F.lane;
    unsigned char* ws = F.ws;
    constexpr int I_IN = 16 * 88, I_OUT = 16 * 32, I_G = 16 * 88, I_D = 44 * 32, I_P = 4 * 8, I_C = 32 * 2;
    constexpr int NITEMS = I_IN + I_OUT + 4 * I_G + 2 * I_D + 4 * I_P + 2 * I_C;
    for (int it = gw; it < NITEMS; it += NGW) {
        int r = it;
        if (r < I_IN) { const int kb = r / 88, nb = r % 88; transpose_item(F.w_in, INCOLS, INCOLS, (bf16_t*)(ws + WS_WIN), D, nb * 32, scr, kb * 64, nb * 32, lane); continue; } r -= I_IN;
        if (r < I_OUT) { const int kb = r / 32, nb = r % 32; transpose_item(F.w_out, D, D, (bf16_t*)(ws + WS_WOUT), D, nb * 32, scr, kb * 64, nb * 32, lane); continue; } r -= I_OUT;
        if (r < 4 * I_G) { const int l = r / (2 * I_G), which = (r / I_G) & 1, q = r % I_G, kb = q / 88, nb = q % 88, n0 = nb * 32;
            const float* W = (which ? F.ffn_wu : F.ffn_wg) + (size_t)l * D * FF;
            transpose_item(W, FF, FF, (bf16_t*)(ws + WS_WGU) + (size_t)l * NGU * D, D, (n0 >> 7) * 256 + which * 128 + (n0 & 127), scr, kb * 64, n0, lane); continue; } r -= 4 * I_G;
        if (r < 2 * I_D) { const int l = r / I_D, q = r % I_D, kb = q / 32, nb = q % 32;
            transpose_item(F.ffn_wd + (size_t)l * FF * D, D, D, (bf16_t*)(ws + WS_WD) + (size_t)l * D * FF, FF, nb * 32, scr, kb * 64, nb * 32, lane); continue; } r -= 2 * I_D;
        if (r < 4 * I_P) { const int gI = r / I_P, q = r % I_P, kb = q / 8, nb = q % 8;
            transpose_item(F.pool_w + (size_t)gI * 65536, 256, 256, (bf16_t*)(ws + WS_WPOOL) + (size_t)gI * 65536, 256, nb * 32, scr, kb * 64, nb * 32, lane); continue; } r -= 4 * I_P;
        { const int which = r / I_C, q = r % I_C, kb = q / 2, nb = q % 2;
          transpose_item(which ? F.cmp_wv : F.cmp_wk, 64, 64, (bf16_t*)(ws + (which ? WS_WCV : WS_WCK)), 2048, nb * 32, scr, kb * 64, nb * 32, lane); }
    }
    { const int gt = (F.vcu * 8 + F.wave) * 64 + lane, NT = F.G * 512; bf16_t* sc = (bf16_t*)(ws + WS_SC);
      for (int i = gt; i < 144 * 512; i += NT) { const int row = i >> 9, c2 = (i & 511) * 2; float a = 0.f, b = 0.f;
          if (row < NMODB) { const float* cp = row < NB ? F.c_p + (size_t)row * D : F.c_s + (size_t)(row - NB) * D; const float x0 = cp[c2], x1 = cp[c2 + 1]; a = x0 * sigmoidf_(x0); b = x1 * sigmoidf_(x1); }
          *(unsigned*)(sc + (size_t)row * D + c2) = cvtpk(a, b); } }
    if (F.vcu < 16) { const int tsel = F.vcu >> 3, part = F.vcu & 7; const float* pe = tsel ? F.pe_v : F.pe_k; const float* W = tsel ? F.cmp_wv : F.cmp_wk; float sacc = 0.f;
        const int kb = part * 256 + F.wave * 32;
#pragma unroll
        for (int k = 0; k < 32; ++k) sacc += pe[kb + k] * W[(size_t)(kb + k) * 64 + lane];
        LAS float* red = (LAS float*)(F.lds + WSF_OFF);
        red[F.wave * 64 + lane] = sacc; LDS_WAIT(); __syncthreads();
        if (F.wave == 0) { float t2 = 0.f;
#pragma unroll
            for (int w = 0; w < 8; ++w) t2 += red[w * 64 + lane];
            ((float*)(ws + WS_CB))[(tsel * 8 + part) * 64 + lane] = t2; }
        __syncthreads(); }
    { const size_t gt = (size_t)(F.vcu * 8 + F.wave) * 64 + lane, NT = (size_t)F.G * 512;
      const size_t pp = (size_t)NSB * 11 * 256;
      for (size_t i = gt; i < pp; i += NT) { const size_t b = i / (11 * 256), rem = i % (11 * 256);
          ((f32x4*)(F.out + O_PLS + b * 15 * D))[rem] = ((const f32x4*)(F.st_pool + (b * 15 + 4) * D))[rem]; } }
}

__device__ __forceinline__ void p1_ada(Frame& F) {
    const int gw = F.vcu * 8 + F.wave, NGW = F.G * 8, lane = F.lane, fr = lane & 15, kq = lane >> 4;
    const bf16_t* sc = (const bf16_t*)(F.ws + WS_SC); float* mod = (float*)(F.ws + WS_MOD);
    for (int tile = F.wave < 3 ? F.vcu * 3 + F.wave : 768; tile < 768; tile += F.G * 3) {
        const int layer = tile / 384, n0 = (tile % 384) * 16;
        const float* W = F.ada_w + (size_t)layer * D * 6144 + n0 + fr;
        f32x4 acc[9];
#pragma unroll
        for (int i = 0; i < 9; ++i) acc[i] = (f32x4){0.f, 0.f, 0.f, 0.f};
#pragma unroll 4
        for (int k0 = 0; k0 < D; k0 += 32) {
            float w[8];
#pragma unroll
            for (int i = 0; i < 8; ++i) w[i] = W[(size_t)(k0 + 8 * kq + i) * 6144];
            u32x4 bw; bw.x = cvtpk(w[0], w[1]); bw.y = cvtpk(w[2], w[3]); bw.z = cvtpk(w[4], w[5]); bw.w = cvtpk(w[6], w[7]);
            const bf16x8 bfrag = __builtin_bit_cast(bf16x8, bw);
#pragma unroll
            for (int mt = 0; mt < 9; ++mt) { const bf16x8 af = *(const bf16x8*)(sc + (size_t)(mt * 16 + fr) * D + k0 + 8 * kq);
                acc[mt] = __builtin_amdgcn_mfma_f32_16x16x32_bf16(af, bfrag, acc[mt], 0, 0, 0); }
        }
        const float bias = F.ada_b[layer * 6144 + n0 + fr];
#pragma unroll
        for (int mt = 0; mt < 9; ++mt)
#pragma unroll
            for (int e = 0; e < 4; ++e) { const int row = mt * 16 + 4 * kq + e; if (row < NMODB) mod[((size_t)layer * NMODB + row) * 6144 + n0 + fr] = acc[mt][e] + bias; }
    }
}

__device__ __forceinline__ void p1_compress_sample(Frame& F) {
    const int lane = F.lane, wave = F.wave, r32 = lane & 31, hi = lane >> 5, kvl = lane >> 4, c4 = lane & 15;
    LAS unsigned char* L = F.lds;
    const int wrow = wave * 4 + kvl, total = 2 * NSB * 8;
    const int nitem = (total - F.vcu + F.G - 1) / F.G; if (nitem <= 0) return;
    const int nstage = 2 * nitem;
#define CS_BAR() do { asm volatile("s_waitcnt lgkmcnt(0)" ::: "memory"); __builtin_amdgcn_s_barrier(); asm volatile("" ::: "memory"); } while (0)
#define CS_SRC(g, ptr) do { const int it_ = F.vcu + F.G * ((g) >> 1); const int wh_ = it_ / (NSB * 8), q_ = it_ % (NSB * 8), b_ = q_ >> 3, n_ = (q_ & 7) * 8 + wave; const int pg_ = F.page_table[b_ * 16 + (n_ >> 2)]; \
        ptr = uniform_ptr((wh_ ? F.cv_cmp : F.ck_cmp) + ((size_t)pg_ * 128 + (n_ & 3) * 32 + ((g) & 1) * 16) * 256); } while (0)
#define CS_LOAD(ptr) do { _Pragma("unroll") for (int jj = 0; jj < 16; ++jj) x[jj] = *(const f32x4*)((ptr) + (unsigned)(jj * 1024 + lane * 16)); } while (0)
#define CS_STORE(buf) do { _Pragma("unroll") for (int jj = 0; jj < 16; ++jj) { u32x2 w_; w_.x = cvtpk(x[jj][0], x[jj][1]); w_.y = cvtpk(x[jj][2], x[jj][3]); \
        *(LAS u32x2*)(L + (buf) * 65536 + wrow * 2048 + (((jj * 8 + (c4 >> 1)) ^ (wrow & 15)) << 4) + (c4 & 1) * 8) = w_; } } while (0)
    f32x4 x[16]; const char* sp;
    CS_SRC(0, sp); CS_LOAD(sp); CS_STORE(0); CS_BAR();
    f32x16 a0, a1;
#pragma unroll
    for (int r = 0; r < 16; ++r) { a0[r] = 0.f; a1[r] = 0.f; }
#pragma unroll 1
    for (int g = 0; g < nstage; ++g) {
        const int it = F.vcu + F.G * (g >> 1), which = it / (NSB * 8), q = it % (NSB * 8), b = q >> 3, n0 = (q & 7) * 8;
        const bf16_t* wp = (const bf16_t*)(F.ws + (which ? WS_WCV : WS_WCK)) + (size_t)r32 * 2048 + (g & 1) * 1024 + 128 * wave + 8 * hi;
        bf16x8 bfr[16];
#pragma unroll
        for (int ks = 0; ks < 8; ++ks) { bfr[2 * ks] = *(const bf16x8*)(wp + 16 * ks); bfr[2 * ks + 1] = *(const bf16x8*)(wp + 32 * 2048 + 16 * ks); }
        if (g + 1 < nstage) { CS_SRC(g + 1, sp); CS_LOAD(sp); }
        const LAS unsigned char* ab = L + (g & 1) * 65536 + r32 * 2048;
#pragma unroll
        for (int ks = 0; ks < 8; ++ks) { const bf16x8 af = *(const LAS bf16x8*)(ab + (((16 * wave + 2 * ks + hi) ^ (r32 & 15)) << 4));
            a0 = __builtin_amdgcn_mfma_f32_32x32x16_bf16(af, bfr[2 * ks], a0, 0, 0, 0); a1 = __builtin_amdgcn_mfma_f32_32x32x16_bf16(af, bfr[2 * ks + 1], a1, 0, 0, 0); }
        CS_BAR();
        if (g & 1) {
            LAS float* red = (LAS float*)(L + 65536) + wave * 2048 + hi * 256 + r32;
#pragma unroll
            for (int r = 0; r < 16; ++r) { red[CROW0(r) * 64] = a0[r]; red[CROW0(r) * 64 + 32] = a1[r]; a0[r] = 0.f; a1[r] = 0.f; }
            CS_BAR();
            { const int row = F.tid >> 4, cc = (F.tid & 15) * 4; f32x4 sacc = (f32x4){0.f, 0.f, 0.f, 0.f};
#pragma unroll
              for (int pp = 0; pp < 8; ++pp) sacc = sacc + *(const f32x4*)((const float*)(F.ws + WS_CB) + (which * 8 + pp) * 64 + cc);
#pragma unroll
              for (int w = 0; w < 8; ++w) sacc = sacc + *(const LAS f32x4*)((const LAS float*)(L + 65536) + w * 2048 + row * 64 + cc);
              bf16_t* o = (bf16_t*)(F.ws + (which ? WS_VCMPS : WS_KCMPS)) + (size_t)b * 4 * 64 * 64 + ((size_t)(row & 3) * 64 + n0 + (row >> 2)) * 64 + cc;
              u32x2 w2; w2.x = cvtpk(sacc[0], sacc[1]); w2.y = cvtpk(sacc[2], sacc[3]); *(u32x2*)o = w2; }
        }
        if (g + 1 < nstage) CS_STORE((g + 1) & 1);
        CS_BAR();
    }
    VM_WAIT(); __syncthreads();
#undef CS_BAR
#undef CS_SRC
#undef CS_LOAD
#undef CS_STORE
}
__device__ __forceinline__ void p4_compress_prompt(Frame& F) {
    const int lane = F.lane, r32 = lane & 31, hi = lane >> 5, nl = r32 >> 2, kv = r32 & 3;
    for (int it = F.vcu; it < 2 * NB * 16; it += F.G) {
        const int which = it / (NB * 16), q = it % (NB * 16), b = q >> 4, n0 = (q & 15) * 8, n = n0 + nl;
        const bf16_t* src = (const bf16_t*)(F.ws + WS_KV) + (size_t)which * KV_STRIDE + ((size_t)b * SEQ + (size_t)n * 32) * 256 + kv * 64;
        const bf16_t* Wt = (const bf16_t*)(F.ws + (which ? WS_WCV : WS_WCK));
        const bf16_t* w0 = Wt + (size_t)r32 * 2048 + hi * 8; const bf16_t* w1 = w0 + (size_t)32 * 2048;
        f32x16 a0, a1;
#pragma unroll
        for (int r = 0; r < 16; ++r) { a0[r] = 0.f; a1[r] = 0.f; }
#pragma unroll
        for (int jj = 0; jj < 4; ++jj) { const int j = F.wave * 4 + jj;
#pragma unroll
            for (int ds = 0; ds < 4; ++ds) { const bf16x8 af = *(const bf16x8*)(src + (size_t)j * 256 + ds * 16 + hi * 8);
                const bf16x8 b0 = *(const bf16x8*)(w0 + j * 64 + ds * 16), b1 = *(const bf16x8*)(w1 + j * 64 + ds * 16);
                a0 = __builtin_amdgcn_mfma_f32_32x32x16_bf16(af, b0, a0, 0, 0, 0); a1 = __builtin_amdgcn_mfma_f32_32x32x16_bf16(af, b1, a1, 0, 0, 0); } }
        LAS float* red = (LAS float*)F.lds + F.wave * 2048 + hi * 256 + r32;
#pragma unroll
        for (int r = 0; r < 16; ++r) { red[CROW0(r) * 64] = a0[r]; red[CROW0(r) * 64 + 32] = a1[r]; }
        LDS_WAIT(); __syncthreads();
        { const int row = F.tid >> 4, c4 = (F.tid & 15) * 4; f32x4 sacc = (f32x4){0.f, 0.f, 0.f, 0.f};
#pragma unroll
          for (int pp = 0; pp < 8; ++pp) sacc = sacc + *(const f32x4*)((const float*)(F.ws + WS_CB) + (which * 8 + pp) * 64 + c4);
#pragma unroll
          for (int w = 0; w < 8; ++w) sacc = sacc + *(const LAS f32x4*)((const LAS float*)F.lds + w * 2048 + row * 64 + c4);
          bf16_t* o = (bf16_t*)(F.ws + (which ? WS_VCMPP : WS_KCMPP)) + (size_t)b * 4 * 128 * 64 + ((size_t)(row & 3) * 128 + n0 + (row >> 2)) * 64 + c4;
          u32x2 w2; w2.x = cvtpk(sacc[0], sacc[1]); w2.y = cvtpk(sacc[2], sacc[3]); *(u32x2*)o = w2; }
        __syncthreads();
    }
}

__device__ __forceinline__ void small_gemm_res(Frame& F, const bf16_t* A  , int lda, const bf16_t* Wt, int ldb, int K, bool bd, const float* xin_s, float* xout_s, const float* gate, const float* scale) {
    const int lane = F.lane, r32 = lane & 31, hi = lane >> 5, kw = K >> 3, kbeg = F.wave * kw;
    for (int tile = F.vcu; tile < 256; tile += F.G) {
        const int row0 = (tile >> 4) * 32, col0 = (tile & 15) * 64, acol = bd ? (col0 >> 8) * 256 : 0;
        const bf16_t* ap = A + (size_t)(row0 + r32) * lda + acol + kbeg + 8 * hi;
        const bf16_t* b0p = Wt + (size_t)(col0 + r32) * ldb + kbeg + 8 * hi; const bf16_t* b1p = b0p + (size_t)32 * ldb;
        f32x16 c0, c1;
#pragma unroll
        for (int r = 0; r < 16; ++r) { c0[r] = 0.f; c1[r] = 0.f; }
#pragma unroll 8
        for (int ks = 0; ks < kw; ks += 16) { const bf16x8 a = *(const bf16x8*)(ap + ks), b0 = *(const bf16x8*)(b0p + ks), b1 = *(const bf16x8*)(b1p + ks);
            c0 = __builtin_amdgcn_mfma_f32_32x32x16_bf16(a, b0, c0, 0, 0, 0); c1 = __builtin_amdgcn_mfma_f32_32x32x16_bf16(a, b1, c1, 0, 0, 0); }
        LAS float* red = (LAS float*)F.lds + F.wave * 2048 + hi * 256 + r32;
#pragma unroll
        for (int r = 0; r < 16; ++r) { red[CROW0(r) * 64] = c0[r]; red[CROW0(r) * 64 + 32] = c1[r]; }
        LDS_WAIT(); __syncthreads();
        { const int row = F.tid >> 4, c4 = (F.tid & 15) * 4; f32x4 sacc = (f32x4){0.f, 0.f, 0.f, 0.f};
#pragma unroll
          for (int w = 0; w < 8; ++w) sacc = sacc + *(const LAS f32x4*)((const LAS float*)F.lds + w * 2048 + row * 64 + c4);
          const int rs = row0 + row, col = col0 + c4, bb = NB + (rs >> 2);
          f32x4 g4 = *(const f32x4*)(gate + (size_t)bb * 6144 + col); if (scale) g4 = g4 * *(const f32x4*)(scale + col);
          const f32x4 x4 = *(const f32x4*)(xin_s + (size_t)rs * D + col); *(f32x4*)(xout_s + (size_t)rs * D + col) = x4 + g4 * sacc; }
        __syncthreads();
    }
}

template <int MODE, int NR>
__device__ __forceinline__ void norm_rows(Frame& F, bool from_inputs, int layer, int which, int row0, const f32x4 (&gg)[4], int lane) {
    const float* X = (const float*)(F.ws + WS_X);
    const float* xr = from_inputs ? (row0 < MP ? F.x_p + (size_t)row0 * D : F.x_s + (size_t)(row0 - MP) * D) : X + (size_t)row0 * D;
    f32x4 v[NR][4];
#pragma unroll
    for (int r = 0; r < NR; ++r)
#pragma unroll
        for (int j = 0; j < 4; ++j) v[r][j] = *(const f32x4*)(xr + (size_t)r * D + 4 * lane + 256 * j);
    f32x4 sh[4], sc[4];
    if constexpr (MODE != 2) {
        const int bb = row0 < MP ? (row0 >> 12) : NB + ((row0 - MP) >> 2);
        const float* mp = (const float*)(F.ws + WS_MOD) + ((size_t)layer * NMODB + bb) * 6144 + (which ? 3072 : 0);
#pragma unroll
        for (int j = 0; j < 4; ++j) { sh[j] = *(const f32x4*)(mp + 4 * lane + 256 * j); sc[j] = *(const f32x4*)(mp + 1024 + 4 * lane + 256 * j) + 1.0f; }
    }
    float ss[NR];
#pragma unroll
    for (int r = 0; r < NR; ++r) { float a = 0.f;
#pragma unroll
        for (int j = 0; j < 4; ++j) a += (v[r][j][0] * v[r][j][0] + v[r][j][1] * v[r][j][1]) + (v[r][j][2] * v[r][j][2] + v[r][j][3] * v[r][j][3]);
        ss[r] = a; }
#pragma unroll
    for (int o = 1; o < 64; o <<= 1) {
#pragma unroll
        for (int r = 0; r < NR; ++r) ss[r] += __shfl_xor(ss[r], o); }
#pragma unroll
    for (int r = 0; r < NR; ++r) {
        const int row = row0 + r; const float rstd = 1.0f / sqrtf(ss[r] * (1.0f / D) + 1e-6f);
        if constexpr (MODE == 2) {
            float* o = row < MP ? F.out + O_YP + (size_t)row * D : F.out + O_YS + (size_t)(row - MP) * D;
#pragma unroll
            for (int j = 0; j < 4; ++j) *(f32x4*)(o + 4 * lane + 256 * j) = v[r][j] * rstd * gg[j];
        } else {
            float* pool_dst = nullptr;
            if constexpr (MODE == 1) {
                if (row < MP) { const int tt = row & (SEQ - 1); if (tt >= SEQ - 15) pool_dst = F.out + O_PLP + ((size_t)(row >> 12) * 15 + (tt - (SEQ - 15))) * D; }
                else { const int rs = row - MP; pool_dst = F.out + O_PLS + ((size_t)(rs >> 2) * 15 + 11 + (rs & 3)) * D; }
            }
#pragma unroll
            for (int j = 0; j < 4; ++j) { const int col = 4 * lane + 256 * j; const f32x4 h = (v[r][j] * rstd * gg[j]) * sc[j] + sh[j];
                if constexpr (MODE == 0) { u32x2 w; w.x = cvtpk(h[0], h[1]); w.y = cvtpk(h[2], h[3]); *(u32x2*)((bf16_t*)(F.ws + WS_H) + (size_t)row * D + col) = w; }
                else { *(f32x4*)((float*)(F.ws + WS_HF) + (size_t)row * D + col) = h; if (pool_dst) *(f32x4*)(pool_dst + col) = h; } }
        }
    }
}
template <int MODE>
__device__ __forceinline__ void norm_phase(Frame& F, bool from_inputs, int layer, int which) {
    const int gw = F.vcu * 8 + F.wave, NGW = F.G * 8, lane = lane_id();
    const float* gvec = MODE == 2 ? F.final_g : F.norm_g + (size_t)(layer * 2 + which) * D;
    f32x4 gg[4];
#pragma unroll
    for (int j = 0; j < 4; ++j) gg[j] = *(const f32x4*)(gvec + 4 * lane + 256 * j);
#pragma unroll 1
    for (int grp = gw; grp < MP / 8; grp += NGW) norm_rows<MODE, 8>(F, from_inputs, layer, which, grp * 8, gg, lane);
#pragma unroll 1
    for (int r = gw; r < MS; r += NGW) norm_rows<MODE, 1>(F, from_inputs, layer, which, MP + r, gg, lane);
}

template <int W, int R, bool SAMPLE>
__device__ __forceinline__ void pool_chunk(const float* HF, const float* st_pool, bf16_t* H, int row0, int col) {
    f32x4 v[R + W - 1];
    const int t0 = SAMPLE ? 0 : (row0 & (SEQ - 1));
#pragma unroll
    for (int k = 0; k < R + W - 1; ++k) { const int tt = t0 - (W - 1) + k;
        if (SAMPLE) { const int b = (row0 - MP) >> 2; v[k] = tt >= 0 ? *(const f32x4*)(HF + (size_t)(row0 + tt) * D + col) : *(const f32x4*)(st_pool + ((size_t)b * 15 + 15 + tt) * D + col); }
        else v[k] = tt >= 0 ? *(const f32x4*)(HF + (size_t)(row0 - (W - 1) + k) * D + col) : (f32x4){0.f, 0.f, 0.f, 0.f}; }
    f32x4 sacc = v[0];
#pragma unroll
    for (int k = 1; k < W; ++k) sacc = sacc + v[k];
#pragma unroll
    for (int r = 0; r < R; ++r) {
        if (r > 0) sacc = sacc + v[r + W - 1] - v[r - 1];
        const int tt = t0 + r; const float inv = 1.0f / (float)(SAMPLE ? W : (tt + 1 < W ? tt + 1 : W));
        const f32x4 cur = v[r + W - 1], pv = sacc * inv - cur;
        u32x2 w2; w2.x = cvtpk(pv[0], pv[1]); w2.y = cvtpk(pv[2], pv[3]); *(u32x2*)(H + (size_t)(row0 + r) * D + col) = w2; }
}
__device__ __forceinline__ void pool_phase(Frame& F) {
    const int gt = (F.vcu * 8 + F.wave) * 64 + lane_id(), NT = F.G * 512;
    const float* HF = (const float*)(F.ws + WS_HF); bf16_t* H = (bf16_t*)(F.ws + WS_H);
    constexpr int NPI = (MP / 8) * 256, NSI = (MS / 4) * 256;
#pragma unroll 1
    for (int i = gt; i < NPI + NSI; i += NT) {
        const bool smp = i >= NPI; const int q = smp ? i - NPI : i; const int cg = q & 255, col = cg * 4, grp = cg >> 6;
        if (!smp) { const int row0 = (q >> 8) * 8;
            if (grp == 0) pool_chunk<2, 8, false>(HF, F.st_pool, H, row0, col); else if (grp == 1) pool_chunk<4, 8, false>(HF, F.st_pool, H, row0, col);
            else if (grp == 2) pool_chunk<8, 8, false>(HF, F.st_pool, H, row0, col); else pool_chunk<16, 8, false>(HF, F.st_pool, H, row0, col); }
        else { const int row0 = MP + (q >> 8) * 4;
            if (grp == 0) pool_chunk<2, 4, true>(HF, F.st_pool, H, row0, col); else if (grp == 1) pool_chunk<4, 4, true>(HF, F.st_pool, H, row0, col);
            else if (grp == 2) pool_chunk<8, 4, true>(HF, F.st_pool, H, row0, col); else pool_chunk<16, 4, true>(HF, F.st_pool, H, row0, col); }
    }
}

namespace att {
__device__ __forceinline__ int crow(int r, int hi) { return (r & 3) + 8 * (r >> 2) + 4 * hi; }
__device__ __forceinline__ float x32_sum(float v) { auto rr = __builtin_amdgcn_permlane32_swap(__float_as_uint(v), __float_as_uint(v), false, false); return __uint_as_float(rr[0]) + __uint_as_float(rr[1]); }
__device__ __forceinline__ float x32_max(float v) { auto rr = __builtin_amdgcn_permlane32_swap(__float_as_uint(v), __float_as_uint(v), false, false); return fmaxf(__uint_as_float(rr[0]), __uint_as_float(rr[1])); }
__device__ __forceinline__ unsigned x32_or(unsigned v) { auto rr = __builtin_amdgcn_permlane32_swap(v, v, false, false); return rr[0] | rr[1]; }
template <int X> __device__ __forceinline__ unsigned swz_xor(unsigned v) { return (unsigned)__builtin_amdgcn_ds_swizzle((int)v, (X << 10) | 0x1F); }
template <int X> __device__ __forceinline__ float swz_xorf(float v) { return __uint_as_float(swz_xor<X>(__float_as_uint(v))); }
__device__ __forceinline__ s16x4 vtr(const LAS unsigned char* p) { typedef short v4i16_t __attribute__((ext_vector_type(4))); return __builtin_bit_cast(s16x4, __builtin_amdgcn_ds_read_tr16_b64_v4i16((LAS v4i16_t*)p)); }
__device__ __forceinline__ void qk_tile(f32x16& p0, f32x16& p1, const LAS unsigned char* Kb, const bf16x8 (&qr)[4], float init, int r32, int hi) {
    f32x16 ci;
#pragma unroll
    for (int r = 0; r < 16; ++r) ci[r] = init;
    const int sw = (r32 >> 1) & 7;
    bf16x8 ka[4], kb[4];
#pragma unroll
    for (int ds = 0; ds < 4; ++ds) { const int ch = ((2 * ds + hi) ^ sw) << 4; ka[ds] = *(const LAS bf16x8*)(Kb + r32 * 128 + ch); kb[ds] = *(const LAS bf16x8*)(Kb + (32 + r32) * 128 + ch); }
    __builtin_amdgcn_s_setprio(1);
    f32x16 c0 = __builtin_amdgcn_mfma_f32_32x32x16_bf16(ka[0], qr[0], ci, 0, 0, 0);
    f32x16 c1 = __builtin_amdgcn_mfma_f32_32x32x16_bf16(kb[0], qr[0], ci, 0, 0, 0);
#pragma unroll
    for (int ds = 1; ds < 4; ++ds) {
        c0 = __builtin_amdgcn_mfma_f32_32x32x16_bf16(ka[ds], qr[ds], c0, 0, 0, 0);
        c1 = __builtin_amdgcn_mfma_f32_32x32x16_bf16(kb[ds], qr[ds], c1, 0, 0, 0);
    }
    __builtin_amdgcn_s_setprio(0);
    p0 = c0; p1 = c1;
}
__device__ __forceinline__ void pv_tile(f32x16 (&o)[2], const LAS unsigned char* Vb, const f32x16& p0, const f32x16& p1, int lane) {
    const int g4 = lane >> 4, nhalf = g4 & 1, h = g4 >> 1, i = lane & 15, q = i >> 2, pp = i & 3;
    const LAS unsigned char* vb = Vb + (4 * h + q) * 64 + nhalf * 32 + pp * 8;
#pragma unroll
    for (int kh = 0; kh < 2; ++kh) {
        s16x4 lo[2][2], hh[2][2];
#pragma unroll
        for (int s = 0; s < 2; ++s)
#pragma unroll
            for (int db = 0; db < 2; ++db) { lo[s][db] = vtr(vb + db * 4096 + (32 * kh + 16 * s) * 64); hh[s][db] = vtr(vb + db * 4096 + (32 * kh + 16 * s + 8) * 64); }
#pragma unroll
        for (int s = 0; s < 2; ++s) {
            const f32x16& p = kh ? p1 : p0; u32x4 pw;
            pw.x = cvtpk(p[8 * s + 0], p[8 * s + 1]); pw.y = cvtpk(p[8 * s + 2], p[8 * s + 3]); pw.z = cvtpk(p[8 * s + 4], p[8 * s + 5]); pw.w = cvtpk(p[8 * s + 6], p[8 * s + 7]);
            const bf16x8 pa = __builtin_bit_cast(bf16x8, pw);
#pragma unroll
            for (int db = 0; db < 2; ++db) {
                const bf16x8 vf = (bf16x8){lo[s][db][0], lo[s][db][1], lo[s][db][2], lo[s][db][3], hh[s][db][0], hh[s][db][1], hh[s][db][2], hh[s][db][3]};
                o[db] = __builtin_amdgcn_mfma_f32_32x32x16_bf16(pa, vf, o[db], 0, 0, 0);
            }
        }
    }
}
__device__ __forceinline__ void row_scale(f32x16 (&o)[2], float f, LAS float* wsf, int r32, int hi) {
    if (hi == 0) wsf[r32] = f;
    LDS_WAIT();
    const LAS float* wh = wsf + 4 * hi;
#pragma unroll
    for (int r = 0; r < 16; ++r) { const float fr = wh[CROW0(r)]; o[0][r] *= fr; o[1][r] *= fr; }
    LDS_WAIT();
}
__device__ __forceinline__ void row_fma(f32x16 (&dst)[2], const f32x16 (&o)[2], float f, LAS float* wsf, int r32, int hi) {
    if (hi == 0) wsf[r32] = f;
    LDS_WAIT();
    const LAS float* wh = wsf + 4 * hi;
#pragma unroll
    for (int r = 0; r < 16; ++r) { const float fr = wh[CROW0(r)]; dst[0][r] += fr * o[0][r]; dst[1][r] += fr * o[1][r]; }
    LDS_WAIT();
}
__device__ __forceinline__ void softmax_update(f32x16& p0, f32x16& p1, float& m, float& l, f32x16 (&o)[2], LAS float* wsf, int r32, int hi) {
    float rm = fmaxf(p0[0], p1[0]);
#pragma unroll
    for (int r = 1; r < 16; ++r) rm = fmaxf(rm, fmaxf(p0[r], p1[r]));
    rm = x32_max(rm);
    const float mn = fmaxf(m, rm), f = ex2(m - mn);
    m = mn; float s = 0.f;
#pragma unroll
    for (int r = 0; r < 16; ++r) { p0[r] = ex2(p0[r] - mn); p1[r] = ex2(p1[r] - mn); s += p0[r] + p1[r]; }
    l = l * f + s;
    if (__any(f != 1.0f)) row_scale(o, f, wsf, r32, hi);
}
__device__ __forceinline__ void softmax_full(f32x16& a0, f32x16& a1, f32x16& b0, f32x16& b1) {
    float rm = -1e30f;
#pragma unroll
    for (int r = 0; r < 16; ++r) rm = fmaxf(rm, fmaxf(fmaxf(a0[r], a1[r]), fmaxf(b0[r], b1[r])));
    rm = x32_max(rm); float s = 0.f;
#pragma unroll
    for (int r = 0; r < 16; ++r) { a0[r] = ex2(a0[r] - rm); a1[r] = ex2(a1[r] - rm); b0[r] = ex2(b0[r] - rm); b1[r] = ex2(b1[r] - rm); s += (a0[r] + a1[r]) + (b0[r] + b1[r]); }
    s = x32_sum(s);
    const float inv = s > 0.f ? 1.0f / s : 0.f;
#pragma unroll
    for (int r = 0; r < 16; ++r) { a0[r] *= inv; a1[r] *= inv; b0[r] *= inv; b1[r] *= inv; }
}
__device__ __forceinline__ unsigned imp_key(float v, int j, int c) {
    const bool forced = (j == 0) | (j == c) | (j == c - 1);
    const unsigned base = forced ? 0x7F000000u : (j <= c ? (__float_as_uint(v) & 0xFFFFFFC0u) : 0u);
    return base | (unsigned)(63 - j);
}
__device__ __forceinline__ void imp_store(const f32x16& p0, const f32x16& p1, int T, LAS unsigned* impq  , int c, int g, int hi) {
#pragma unroll
    for (int kh = 0; kh < 2; ++kh)
#pragma unroll
        for (int a = 0; a < 4; ++a) {
            const f32x16& p = kh ? p1 : p0; float e0 = p[4 * a] + p[4 * a + 1], e1 = p[4 * a + 2] + p[4 * a + 3];
            e0 += swz_xorf<8>(e0); e0 += swz_xorf<16>(e0); e1 += swz_xorf<8>(e1); e1 += swz_xorf<16>(e1);
            const int jc = 32 * T + 16 * kh + 4 * a, j0 = jc + 2 * hi;
            if (g == 0) { u32x2 w; w.x = imp_key(e0, j0, c); w.y = imp_key(e1, j0 + 1, c); *(LAS u32x2*)(impq + 2 * hi + jc) = w; }
        }
}
__device__ __forceinline__ unsigned long long select_mask(const LAS unsigned* impq, int g, int hi) {
    LDS_WAIT();
    unsigned mk[8], cnt[8];
#pragma unroll
    for (int a = 0; a < 4; ++a) { const u32x2 w = *(const LAS u32x2*)(impq + (16 * g + 2 * hi) + 4 * a); mk[2 * a] = w.x; mk[2 * a + 1] = w.y; cnt[2 * a] = 0; cnt[2 * a + 1] = 0; }
#pragma unroll 4
    for (int jj = 0; jj < 16; ++jj) { const u32x4 kx = *(const LAS u32x4*)(impq + 4 * jj);
#pragma unroll
        for (int ci = 0; ci < 8; ++ci) cnt[ci] += (unsigned)(kx.x > mk[ci]) + (unsigned)(kx.y > mk[ci]) + (unsigned)(kx.z > mk[ci]) + (unsigned)(kx.w > mk[ci]); }
    unsigned lb = 0u;
#pragma unroll
    for (int a = 0; a < 4; ++a)
#pragma unroll
        for (int e = 0; e < 2; ++e) lb |= (cnt[2 * a + e] < 16u ? 1u : 0u) << (4 * a + e);
    const unsigned long long mm = (unsigned long long)lb << (16 * g + 2 * hi);
    unsigned lo = (unsigned)mm, hh = (unsigned)(mm >> 32);
    lo |= swz_xor<8>(lo); hh |= swz_xor<8>(hh); lo |= swz_xor<16>(lo); hh |= swz_xor<16>(hh); lo = x32_or(lo); hh = x32_or(hh);
    return ((unsigned long long)hh << 32) | lo;
}
__device__ __forceinline__ unsigned long long wave_or64(unsigned long long m) {
    unsigned lo = (unsigned)m, hh = (unsigned)(m >> 32);
    lo |= swz_xor<1>(lo); hh |= swz_xor<1>(hh); lo |= swz_xor<2>(lo); hh |= swz_xor<2>(hh); lo |= swz_xor<4>(lo); hh |= swz_xor<4>(hh);
    lo |= swz_xor<8>(lo); hh |= swz_xor<8>(hh); lo |= swz_xor<16>(lo); hh |= swz_xor<16>(hh); lo = x32_or(lo); hh = x32_or(hh);
    return ((unsigned long long)(unsigned)__builtin_amdgcn_readfirstlane(hh) << 32) | (unsigned)__builtin_amdgcn_readfirstlane(lo);
}
__device__ __forceinline__ void mask_bias(f32x16& p0, f32x16& p1, int t, int pos0, int stride, int wlim, bool sel, bool near, const LAS float* lut, int hi) {
#pragma unroll
    for (int kh = 0; kh < 2; ++kh)
#pragma unroll
        for (int r = 0; r < 16; ++r) { const int kk = 32 * kh + crow(r, hi), dist = t - pos0 - stride * kk; const bool ok = sel && dist >= 0 && dist < wlim;
            float bv = 0.f; if (near) { const int di = dist < 0 ? 0 : (dist > 127 ? 127 : dist); bv = lut[di]; }
            if (kh) p1[r] = ok ? p1[r] + bv : -INFINITY; else p0[r] = ok ? p0[r] + bv : -INFINITY; }
}
template <bool CAUSAL>
__device__ __forceinline__ void mask_bias_near(f32x16& p0, f32x16& p1, int t, int pos0, bool sel, const LAS float* xlg, int hi) {
    const int dist0 = t - pos0 - 4 * hi;
    const LAS float* bp = xlg + (dist0 + 4);
#pragma unroll
    for (int kh = 0; kh < 2; ++kh)
#pragma unroll
        for (int r = 0; r < 16; ++r) { const int kc = 32 * kh + CROW0(r); const float bv = bp[63 - kc]; bool ok = sel; if (CAUSAL) ok = ok && (dist0 - kc >= 0);
            if (kh) p1[r] = ok ? p1[r] + bv : -INFINITY; else p0[r] = ok ? p0[r] + bv : -INFINITY; }
}
struct Ptrs { const bf16_t *Q, *kcp, *vcp, *kcs, *vcs, *KS, *VS, *KW, *VW; const float* gates; bf16_t* O; const float *ck_sel, *cv_sel, *st_kw, *st_vw; const int* pt; int gov; float* kw_out; float* vw_out; };
#ifdef VERIFY
#define GATEV(P, row, head, br) ((P).gov < 0 ? sigmoidf_((P).gates[(size_t)(row) * 48 + (head) * 3 + (br)]) : ((P).gov == (br) ? 1.0f : 0.0f))
#else
#define GATEV(P, row, head, br) sigmoidf_((P).gates[(size_t)(row) * 48 + (head) * 3 + (br)])
#endif

template <bool ACC>
__device__ __forceinline__ void row_out(LAS float* ow, const f32x16 (&o)[2], float f, LAS float* wsf, int r32, int hi) {
    if (hi == 0) wsf[r32] = f;
    LDS_WAIT();
    const LAS float* wh = wsf + 4 * hi; LAS float* ob = ow + hi * 256 + r32;
#pragma unroll
    for (int r = 0; r < 16; ++r) { const float fr = wh[CROW0(r)]; LAS float* p = ob + CROW0(r) * 64;
        if (ACC) { p[0] += fr * o[0][r]; p[32] += fr * o[1][r]; } else { p[0] = fr * o[0][r]; p[32] = fr * o[1][r]; } }
    LDS_WAIT();
}
template <bool NEXT>
__device__ __forceinline__ void tile_block(f32x16& s0, f32x16& s1, f32x16& n0, f32x16& n1, const LAS unsigned char* KBn, float ninit, const LAS unsigned char* VB, const bf16x8 (&qr)[4],
                                           float m, float& l, f32x16 (&o)[2], int lane, int r32, int hi) {
    if (NEXT) qk_tile(n0, n1, KBn, qr, ninit, r32, hi);
    float sacc = 0.f;
#pragma unroll
    for (int r = 0; r < 16; ++r) { s0[r] = ex2(s0[r] - m); s1[r] = ex2(s1[r] - m); sacc += s0[r] + s1[r]; }
    l += sacc;
    pv_tile(o, VB, s0, s1, lane);
}
#define AS_SBAR() __builtin_amdgcn_sched_barrier(0)
#define AS_PIN(x) asm volatile("" : "+v"(x))
#define AS_MFMA(a, b, c) __builtin_amdgcn_mfma_f32_32x32x16_bf16(a, b, c, 0, 0, 0)
#define AS_WAIT_BAR(N) asm volatile("s_waitcnt vmcnt(" #N ") lgkmcnt(0)\n\ts_barrier" ::: "memory")
#define AS_MX3(a, b, c) __builtin_fmaxf(__builtin_fmaxf((a), (b)), (c))
__device__ __forceinline__ void as_glds16(const void* gsrc, unsigned lds_base) {
    unsigned sv; asm volatile("s_mov_b32 %0, m0\n\ts_mov_b32 m0, %2\n\ts_nop 0\n\tglobal_load_lds_dwordx4 %1, off\n\ts_mov_b32 m0, %0" : "=&s"(sv) : "v"(gsrc), "s"(lds_base) : "memory"); }
__device__ __forceinline__ void as_kload2(bf16x8* kf, const LAS unsigned char* kp, int d0) { kf[2 * d0] = *(const LAS bf16x8*)(kp + d0 * 2048); kf[2 * d0 + 1] = *(const LAS bf16x8*)(kp + d0 * 2048 + 512); }
__device__ __forceinline__ float as_rowmax(const f32x16& p0, const f32x16& p1) {
    float a = AS_MX3(p0[0], p0[1], p1[0]), b = AS_MX3(p0[2], p0[3], p1[1]); a = AS_MX3(a, p1[2], p1[3]);
#pragma unroll
    for (int r = 4; r < 16; r += 4) { a = AS_MX3(a, p0[r], p0[r + 1]); b = AS_MX3(b, p0[r + 2], p0[r + 3]); a = AS_MX3(a, p1[r], p1[r + 1]); b = AS_MX3(b, p1[r + 2], p1[r + 3]); }
    return x32_max(__builtin_fmaxf(a, b)); }
template <bool WIN>
__device__ __forceinline__ float as_mask(f32x16& c0, f32x16& c1, int u, int j0, int nreal, int c, int t, unsigned long long mymask, float bfar, const LAS float* xlg, const LAS float* lut, int hi) {
    const int j = j0 + u;
    if (u >= nreal) {
#pragma unroll
        for (int r = 0; r < 16; ++r) { c0[r] = -INFINITY; c1[r] = -INFINITY; }
        return 0.f; }
    const bool sel = WIN || ((mymask >> j) & 1ull);
    if (j >= c - 2) { if (j == c) mask_bias_near<true>(c0, c1, t, 64 * j, sel, xlg, hi); else mask_bias_near<false>(c0, c1, t, 64 * j, sel, xlg, hi); return 0.f; }
    if (WIN) { if (j == c - 8) mask_bias(c0, c1, t, 64 * j, 1, 512, true, false, lut, hi); }
    else {
#pragma unroll
        for (int r = 0; r < 16; ++r) { c0[r] = sel ? c0[r] : -INFINITY; c1[r] = sel ? c1[r] : -INFINITY; } }
    return bfar;
}
template <bool WIN, bool ACC>
__device__ __forceinline__ void attn_stream(const bf16_t* kbase  , const bf16_t* vbase, int j0, int nreal, int NT, int c, int t, unsigned long long mymask,
                                            const bf16x8 (&qr)[4], float bfar, const LAS float* xlg, const LAS float* lut, float gate, LAS unsigned char* L, LAS float* wsf, LAS float* ow, int wave, int lane) {
    constexpr int SLOTB = 8192, LDS_K = 0, LDS_V = 3 * SLOTB;
    const int r32 = lane & 31, hi = lane >> 5;
    const unsigned lds0 = (unsigned)(unsigned long long)L;
    const int jlast = j0 + nreal - 1;
    const bf16_t* ksrc = kbase + (size_t)lane * 256 + wave * 8;
    const bf16_t* vsrc = vbase + (size_t)(16 * (wave & 3) + (lane >> 2)) * 256 + (wave >> 2) * 32 + (lane & 3) * 8;
    const unsigned kdst = lds0 + LDS_K + wave * 1024, vdst = lds0 + LDS_V + wave * 1024;
#define AS_JT(u) ((j0 + (u)) > jlast ? jlast : (j0 + (u)))
#define AS_DMA_K(u, slot) as_glds16(ksrc + (size_t)AS_JT(u) * (64 * 256), (unsigned)__builtin_amdgcn_readfirstlane((int)(kdst + (slot))))
#define AS_DMA_V(u, slot) as_glds16(vsrc + (size_t)AS_JT(u) * (64 * 256), (unsigned)__builtin_amdgcn_readfirstlane((int)(vdst + (slot))))
    const LAS unsigned char* vp0 = L + LDS_V + ((lane >> 4) & 1) * 32 + (lane & 3) * 8 + (4 * hi + ((lane & 15) >> 2)) * 64;
    const LAS unsigned char* kp0 = L + LDS_K + hi * 1024 + r32 * 16;
    AS_DMA_K(0, 0); AS_DMA_V(0, 0); AS_DMA_K(1, SLOTB); AS_DMA_K(2, 2 * SLOTB);
    float mhat = 0.f, l_reg = 0.f; f32x16 o[2];
#pragma unroll
    for (int r = 0; r < 16; ++r) { o[0][r] = 0.f; o[1][r] = 0.f; }
    const f32x16 zero16 = {0.f, 0.f, 0.f, 0.f, 0.f, 0.f, 0.f, 0.f, 0.f, 0.f, 0.f, 0.f, 0.f, 0.f, 0.f, 0.f};
    bool resc = false;
    f32x16 pA0, pA1, pB0, pB1; bf16x8 kf[8]; s16x4 vlo[8], vhi[8]; u32x4 pw0, pw1, pw2, pw3;
    int sl_prev = 0, sl_cur = 0, sl_next = SLOTB;
#define AS_ROT() do { sl_prev = sl_cur; sl_cur = sl_next; sl_next = (sl_next == 2 * SLOTB) ? 0 : sl_next + SLOTB; } while (0)
#define AS_EX(v) __builtin_amdgcn_exp2f((v) + nmh)
#define AS_RESC() do { if (resc) { const LAS float* wh_ = wsf + 4 * hi; _Pragma("unroll") for (int d_ = 0; d_ < 2; ++d_) _Pragma("unroll") for (int r = 0; r < 16; ++r) o[d_][r] *= wh_[CROW0(r)]; } } while (0)
    AS_WAIT_BAR(3);
#pragma unroll
    for (int d0 = 0; d0 < 4; ++d0) as_kload2(kf, kp0, d0);
    pA0 = AS_MFMA(kf[0], qr[0], zero16); pA1 = AS_MFMA(kf[1], qr[0], zero16); pA0 = AS_MFMA(kf[2], qr[1], pA0); pA1 = AS_MFMA(kf[3], qr[1], pA1);
    pA0 = AS_MFMA(kf[4], qr[2], pA0); pA1 = AS_MFMA(kf[5], qr[2], pA1); pA0 = AS_MFMA(kf[6], qr[3], pA0); pA1 = AS_MFMA(kf[7], qr[3], pA1);
    { const float bc = as_mask<WIN>(pA0, pA1, 0, j0, nreal, c, t, mymask, bfar, xlg, lut, hi);
      const float rm = as_rowmax(pA0, pA1) + bc; mhat = __builtin_fmaxf(rm, -60.f); const float nmh = bc - mhat;
#pragma unroll
      for (int r = 0; r < 16; ++r) { pA0[r] = AS_EX(pA0[r]); pA1[r] = AS_EX(pA1[r]); } }
    AS_WAIT_BAR(0);
    AS_DMA_K(3, 0); AS_DMA_V(1, SLOTB); AS_ROT();
#pragma unroll
    for (int d0 = 0; d0 < 4; ++d0) as_kload2(kf, kp0 + sl_cur, d0);
    AS_WAIT_BAR(2);
#define AS_PKW(P, i) cvtpk(P[i], P[i + 1])
#define AS_PAF(k) __builtin_bit_cast(bf16x8, pw##k)
#define AS_VFR(i) (bf16x8){vlo[i][0], vlo[i][1], vlo[i][2], vlo[i][3], vhi[i][0], vhi[i][1], vhi[i][2], vhi[i][3]}
#define AS_VRD(i) do { vlo[i] = vtr(vp_ + (((i) >> 2) * 4096 + ((i) & 3) * 1024)); vhi[i] = vtr(vp_ + (((i) >> 2) * 4096 + ((i) & 3) * 1024 + 512)); } while (0)
#define AS_KRD(G, d0) do { if (G) { as_kload2(kf, kp0 + sl_next, d0); AS_SBAR(); } } while (0)
#define AS_GAPA(MF, a0, a1, a2, a3, W0, W1, PW) do { MF; sacc += a0; sacc += a1; sacc += a2; sacc += a3; W0; W1; AS_PIN(PW); AS_PIN(sacc); AS_SBAR(); } while (0)
#define AS_GAPB(MF, X, i) do { MF; X[i] = AS_EX(X[i]); X[i + 1] = AS_EX(X[i + 1]); X[i + 2] = AS_EX(X[i + 2]); X[i + 3] = AS_EX(X[i + 3]); AS_PIN(X); AS_SBAR(); } while (0)
#define AS_STEP(C0, C1, P0, P1, tt, MASK, GK, GV, GL) do { AS_SBAR(); \
    const LAS unsigned char* vp_ = vp0 + sl_prev; \
    AS_VRD(0); AS_SBAR(); float sacc = P0[0] + P0[1]; \
                    AS_GAPA(C0 = AS_MFMA(kf[0], qr[0], zero16), P0[2], P0[3], P0[4], P0[5],     pw0[0] = AS_PKW(P0, 0),  pw0[1] = AS_PKW(P0, 2),  pw0); \
    AS_VRD(4); AS_SBAR(); AS_GAPA(C1 = AS_MFMA(kf[1], qr[0], zero16), P0[6], P0[7], P0[8], P0[9],     pw0[2] = AS_PKW(P0, 4),  pw0[3] = AS_PKW(P0, 6),  pw0); \
    AS_VRD(1); AS_SBAR(); AS_GAPA(C0 = AS_MFMA(kf[2], qr[1], C0),    P0[10], P0[11], P0[12], P0[13], pw1[0] = AS_PKW(P0, 8),  pw1[1] = AS_PKW(P0, 10), pw1); \
    AS_VRD(5); AS_SBAR(); AS_GAPA(C1 = AS_MFMA(kf[3], qr[1], C1),    P0[14], P0[15], P1[0], P1[1],   pw1[2] = AS_PKW(P0, 12), pw1[3] = AS_PKW(P0, 14), pw1); \
    AS_VRD(2); AS_SBAR(); AS_GAPA(C0 = AS_MFMA(kf[4], qr[2], C0),    P1[2], P1[3], P1[4], P1[5],     pw2[0] = AS_PKW(P1, 0),  pw2[1] = AS_PKW(P1, 2),  pw2); \
    AS_VRD(6); AS_SBAR(); AS_GAPA(C1 = AS_MFMA(kf[5], qr[2], C1),    P1[6], P1[7], P1[8], P1[9],     pw2[2] = AS_PKW(P1, 4),  pw2[3] = AS_PKW(P1, 6),  pw2); \
    AS_VRD(3); AS_SBAR(); AS_GAPA(C0 = AS_MFMA(kf[6], qr[3], C0),    P1[10], P1[11], P1[12], P1[13], pw3[0] = AS_PKW(P1, 8),  pw3[1] = AS_PKW(P1, 10), pw3); \
    AS_VRD(7); AS_SBAR(); AS_GAPA(C1 = AS_MFMA(kf[7], qr[3], C1),    P1[14], P1[15], 0.f, 0.f,       pw3[2] = AS_PKW(P1, 12), pw3[3] = AS_PKW(P1, 14), pw3); \
    l_reg += sacc; \
    if (GK) AS_DMA_K((tt) + 3, sl_cur); if (GV) AS_DMA_V((tt) + 1, sl_next); \
    float bc_ = bfar; bool sel_ = true; \
    if (MASK) bc_ = as_mask<WIN>(C0, C1, (tt), j0, nreal, c, t, mymask, bfar, xlg, lut, hi); \
    else if (!WIN) sel_ = (mymask >> (j0 + (tt))) & 1ull;            \
    { const float rm = as_rowmax(C0, C1) + bc_ - mhat; resc = false; \
      if (__builtin_expect(__any(rm > 8.0f), 0)) { const float dl = __builtin_fmaxf(rm, 0.f); mhat += dl; \
          const float f = __builtin_amdgcn_exp2f(-dl); l_reg *= f; if (hi == 0) wsf[r32] = f; resc = true; } } \
    const float nmh = sel_ ? bc_ - mhat : -INFINITY; AS_SBAR(); \
    AS_GAPB(o[0] = AS_MFMA(AS_PAF(0), AS_VFR(0), o[0]), C0, 0);              AS_GAPB(o[1] = AS_MFMA(AS_PAF(0), AS_VFR(4), o[1]), C0, 4); \
    AS_KRD(GL, 0); AS_GAPB(o[0] = AS_MFMA(AS_PAF(1), AS_VFR(1), o[0]), C0, 8);  AS_KRD(GL, 1); AS_GAPB(o[1] = AS_MFMA(AS_PAF(1), AS_VFR(5), o[1]), C0, 12); \
    AS_KRD(GL, 2); AS_GAPB(o[0] = AS_MFMA(AS_PAF(2), AS_VFR(2), o[0]), C1, 0);  AS_KRD(GL, 3); AS_GAPB(o[1] = AS_MFMA(AS_PAF(2), AS_VFR(6), o[1]), C1, 4); \
    AS_GAPB(o[0] = AS_MFMA(AS_PAF(3), AS_VFR(3), o[0]), C1, 8);              AS_GAPB(o[1] = AS_MFMA(AS_PAF(3), AS_VFR(7), o[1]), C1, 12); \
    } while (0)
    int tt = 1;
    for (; tt + 5 < NT; tt += 2) {
        AS_STEP(pB0, pB1, pA0, pA1, tt, false, true, true, true);     AS_WAIT_BAR(2); AS_RESC(); AS_ROT();
        AS_STEP(pA0, pA1, pB0, pB1, tt + 1, false, true, true, true); AS_WAIT_BAR(2); AS_RESC(); AS_ROT();
    }
#define AS_ENDW(x) do { if ((x) + 3 < NT) { AS_WAIT_BAR(2); } else if ((x) + 2 < NT) { AS_WAIT_BAR(1); } else { AS_WAIT_BAR(0); } } while (0)
    for (; tt + 1 < NT; tt += 2) {
        AS_STEP(pB0, pB1, pA0, pA1, tt, true, (tt + 3 < NT), (tt + 1 < NT), (tt + 1 < NT));         AS_ENDW(tt);     AS_RESC(); AS_ROT();
        AS_STEP(pA0, pA1, pB0, pB1, tt + 1, true, (tt + 4 < NT), (tt + 2 < NT), (tt + 2 < NT));     AS_ENDW(tt + 1); AS_RESC(); AS_ROT();
    }
    AS_STEP(pB0, pB1, pA0, pA1, NT - 1, true, false, false, false); AS_RESC();
    { float sacc = pB0[0] + pB0[1];
#pragma unroll
      for (int r = 2; r < 16; ++r) sacc += pB0[r];
#pragma unroll
      for (int r = 0; r < 16; ++r) sacc += pB1[r];
      l_reg += sacc;
      pw0 = (u32x4){AS_PKW(pB0, 0), AS_PKW(pB0, 2), AS_PKW(pB0, 4), AS_PKW(pB0, 6)}; pw1 = (u32x4){AS_PKW(pB0, 8), AS_PKW(pB0, 10), AS_PKW(pB0, 12), AS_PKW(pB0, 14)};
      pw2 = (u32x4){AS_PKW(pB1, 0), AS_PKW(pB1, 2), AS_PKW(pB1, 4), AS_PKW(pB1, 6)}; pw3 = (u32x4){AS_PKW(pB1, 8), AS_PKW(pB1, 10), AS_PKW(pB1, 12), AS_PKW(pB1, 14)};
      const LAS unsigned char* vp_ = vp0 + sl_cur;
#pragma unroll
      for (int i = 0; i < 8; ++i) AS_VRD(i);
      o[0] = AS_MFMA(AS_PAF(0), AS_VFR(0), o[0]); o[1] = AS_MFMA(AS_PAF(0), AS_VFR(4), o[1]); o[0] = AS_MFMA(AS_PAF(1), AS_VFR(1), o[0]); o[1] = AS_MFMA(AS_PAF(1), AS_VFR(5), o[1]);
      o[0] = AS_MFMA(AS_PAF(2), AS_VFR(2), o[0]); o[1] = AS_MFMA(AS_PAF(2), AS_VFR(6), o[1]); o[0] = AS_MFMA(AS_PAF(3), AS_VFR(3), o[0]); o[1] = AS_MFMA(AS_PAF(3), AS_VFR(7), o[1]); }
    { const float lt = x32_sum(l_reg); const float f = lt > 0.f ? gate / lt : 0.f; row_out<ACC>(ow, o, f, wsf, r32, hi); }
    asm volatile("s_waitcnt lgkmcnt(0)\n\ts_barrier" ::: "memory");
#undef AS_JT
#undef AS_DMA_K
#undef AS_DMA_V
#undef AS_ROT
#undef AS_EX
#undef AS_RESC
#undef AS_PKW
#undef AS_PAF
#undef AS_VFR
#undef AS_VRD
#undef AS_KRD
#undef AS_GAPA
#undef AS_GAPB
#undef AS_STEP
#undef AS_ENDW
}

__device__ __forceinline__ void prompt_unit(const Ptrs& P, LAS unsigned char* L, int b, int kv, int c, int tid, int wave, int lane) {
    asm volatile("" : "+v"(lane), "+v"(tid));
    const int r32 = lane & 31, hi = lane >> 5, g = r32 >> 3, qi = r32 & 7, head = kv * 4 + g;
    const int t = c * 64 + wave * 8 + qi; const unsigned row = (unsigned)b * SEQ + t;
    bf16x8 qr[4];
#pragma unroll
    for (int ds = 0; ds < 4; ++ds) qr[ds] = *(const bf16x8*)(P.Q + (size_t)row * D + head * 64 + ds * 16 + hi * 8);
    const LAS float* lut = (const LAS float*)(L + LUT_OFF) + head * 128; const float bfar = lut[127];
    LAS float* wsf = (LAS float*)(L + WSF_OFF) + wave * 32;
    LAS float* ow = (LAS float*)(L + 65536 + wave * 8192);
    LAS unsigned* impq = (LAS unsigned*)(L + IMP_OFF) + wave * 512 + qi * 64;
    const int skey = tid >> 3, sch = tid & 7;
    const int kwoff = skey * 128 + ((sch ^ ((skey >> 1) & 7)) << 4), vwoff = (sch >> 2) * 4096 + skey * 64 + (sch & 3) * 16;
    LAS unsigned char* KB0 = L; LAS unsigned char* VB0 = L + 32768;
    { const unsigned co = ((unsigned)(b * 4 + kv) * 128 + skey) * 64 + sch * 8;
      const u32x4 k0 = *(const u32x4*)(P.kcp + co), k1 = *(const u32x4*)(P.kcp + co + 4096), v0 = *(const u32x4*)(P.vcp + co), v1 = *(const u32x4*)(P.vcp + co + 4096);
      *(LAS u32x4*)(KB0 + kwoff) = k0; *(LAS u32x4*)(KB0 + 8192 + kwoff) = k1; *(LAS u32x4*)(VB0 + vwoff) = v0; *(LAS u32x4*)(VB0 + 8192 + vwoff) = v1; }
    const int nwin = (c < 8 ? c : 8) + 1;
    __syncthreads();
    f32x16 o[2];
#pragma unroll
    for (int r = 0; r < 16; ++r) { o[0][r] = 0.f; o[1][r] = 0.f; }
    unsigned long long mymask = ~0ull;
    {
        float cm = -1e30f, cl = 0.f; const int ncmp = c <= 30 ? 1 : 2;
#pragma unroll 1
        for (int T = 0; T < ncmp; ++T) { f32x16 a0, a1; qk_tile(a0, a1, KB0 + T * 8192, qr, 0.f, r32, hi); mask_bias(a0, a1, t, 31 + 2048 * T, 32, 1 << 30, true, true, lut, hi);
            float rm = fmaxf(a0[0], a1[0]);
#pragma unroll
            for (int r = 1; r < 16; ++r) rm = fmaxf(rm, fmaxf(a0[r], a1[r]));
            rm = x32_max(rm); const float mn = fmaxf(cm, rm); float sacc = 0.f;
#pragma unroll
            for (int r = 0; r < 16; ++r) sacc += ex2(a0[r] - mn) + ex2(a1[r] - mn);
            cl = cl * ex2(cm - mn) + sacc; cm = mn; }
        cl = x32_sum(cl); const float cinv = cl > 0.f ? 1.0f / cl : 0.f;
#pragma unroll 1
        for (int T = 0; T < ncmp; ++T) { f32x16 a0, a1; qk_tile(a0, a1, KB0 + T * 8192, qr, 0.f, r32, hi); mask_bias(a0, a1, t, 31 + 2048 * T, 32, 1 << 30, true, true, lut, hi);
#pragma unroll
            for (int r = 0; r < 16; ++r) { a0[r] = ex2(a0[r] - cm) * cinv; a1[r] = ex2(a1[r] - cm) * cinv; }
            if (c >= 16) imp_store(a0, a1, T, impq, c, g, hi);
            pv_tile(o, VB0 + T * 8192, a0, a1, lane); }
        if (c >= 16 && ncmp == 1 && g == 0) {
#pragma unroll
            for (int q8 = 0; q8 < 8; ++q8) { const int jc = 32 + 4 * q8; u32x2 w; w.x = imp_key(0.f, jc + 2 * hi, c); w.y = imp_key(0.f, jc + 2 * hi + 1, c); *(LAS u32x2*)(impq + 2 * hi + jc) = w; } }
    }
    { const float g0 = GATEV(P, row, head, 0); row_out<false>(ow, o, g0, wsf, r32, hi); }
    if (c >= 16) mymask = select_mask(impq, g, hi);
    __syncthreads();
    { LAS float* xl = (LAS float*)(L + IMP_OFF);
      for (int u = tid; u < 4 * 272; u += 512) { const int gg = u / 272, ii = u % 272, dd = ii - 67; xl[u] = ((const LAS float*)(L + LUT_OFF))[(kv * 4 + gg) * 128 + (dd < 0 ? 0 : (dd > 127 ? 127 : dd))]; } }
    const LAS float* xlg = (const LAS float*)(L + IMP_OFF) + g * 272;
    { const size_t kvb = ((size_t)b * SEQ) * 256 + kv * 64;
      { const int nreal = c + 1; int NT = (nreal + 1) & ~1; if (NT < 4) NT = 4;
        attn_stream<false, true>(P.KS + kvb, P.VS + kvb, 0, nreal, NT, c, t, mymask, qr, bfar, xlg, lut, GATEV(P, row, head, 1), L, wsf, ow, wave, lane); }
      { int NT = (nwin + 1) & ~1; if (NT < 4) NT = 4;
        attn_stream<true, true>(P.KW + kvb, P.VW + kvb, c - nwin + 1, nwin, NT, c, t, mymask, qr, bfar, xlg, lut, GATEV(P, row, head, 2), L, wsf, ow, wave, lane); } }
    { const int rr = lane >> 1, hf = lane & 1, gg = rr >> 3, qq = rr & 7; const LAS float* src = ow + rr * 64 + hf * 32;
      bf16_t* op = P.O + ((size_t)b * SEQ + c * 64 + wave * 8 + qq) * D + (kv * 4 + gg) * 64 + hf * 32;
#pragma unroll
      for (int q4 = 0; q4 < 4; ++q4) { const f32x4 x0 = *(const LAS f32x4*)(src + q4 * 8), x1 = *(const LAS f32x4*)(src + q4 * 8 + 4); u32x4 w;
          w.x = cvtpk(x0[0], x0[1]); w.y = cvtpk(x0[2], x0[3]); w.z = cvtpk(x1[0], x1[1]); w.w = cvtpk(x1[2], x1[3]); *(u32x4*)(op + q4 * 8) = w; } }
    __syncthreads();
}

template <bool COPY>
__device__ __forceinline__ void stage_f32_pair(const float* ksrc_, const float* vsrc_, LAS unsigned char* Kb, LAS unsigned char* Vb, int lane, float* kdst_ = nullptr, float* vdst_ = nullptr, int first_row = 0) {
    const int c4 = lane & 15; const char* ks = uniform_ptr(ksrc_); const char* vs = uniform_ptr(vsrc_); const unsigned lo = (unsigned)((lane >> 4) * 1024 + c4 * 16);
#pragma unroll 1
    for (int hf = 0; hf < 2; ++hf) {
        f32x4 x[8], y[8];
#pragma unroll
        for (int it = 0; it < 8; ++it) x[it] = *(const f32x4*)(ks + (lo + (unsigned)(hf * 8 + it) * 4096u));
#pragma unroll
        for (int it = 0; it < 8; ++it) y[it] = *(const f32x4*)(vs + (lo + (unsigned)(hf * 8 + it) * 4096u));
        if constexpr (COPY) {
            char* kd = (char*)uniform_ptr(kdst_); char* vd = (char*)uniform_ptr(vdst_);
#pragma unroll
            for (int it = 0; it < 8; ++it) { const int key = (hf * 8 + it) * 4 + (lane >> 4);
                if (key >= first_row) { __builtin_nontemporal_store(x[it], (f32x4*)(kd + (lo + (unsigned)(hf * 8 + it) * 4096u))); __builtin_nontemporal_store(y[it], (f32x4*)(vd + (lo + (unsigned)(hf * 8 + it) * 4096u))); } }
        }
#pragma unroll
        for (int it = 0; it < 8; ++it) { const int key = (hf * 8 + it) * 4 + (lane >> 4);
            u32x2 w; w.x = cvtpk(x[it][0], x[it][1]); w.y = cvtpk(x[it][2], x[it][3]);
            *(LAS u32x2*)(Kb + key * 128 + (((c4 >> 1) ^ ((key >> 1) & 7)) << 4) + (c4 & 1) * 8) = w; }
#pragma unroll
        for (int it = 0; it < 8; ++it) { const int key = (hf * 8 + it) * 4 + (lane >> 4);
            u32x2 w; w.x = cvtpk(y[it][0], y[it][1]); w.y = cvtpk(y[it][2], y[it][3]);
            *(LAS u32x2*)(Vb + (c4 >> 3) * 4096 + key * 64 + (c4 & 7) * 8) = w; }
        __builtin_amdgcn_sched_barrier(0);
    }
}
__device__ __forceinline__ void stage_bf16_tile(const bf16_t* src_  , LAS unsigned char* Kb, bool isV, int lane) {
    const char* src = uniform_ptr(src_);
#pragma unroll
    for (int it = 0; it < 8; ++it) { const int idx = it * 64 + lane, key = idx >> 3, ch = idx & 7; const u32x4 x = *(const u32x4*)(src + (unsigned)idx * 16u);
        const int off = isV ? ((ch >> 2) * 4096 + key * 64 + (ch & 3) * 16) : (key * 128 + ((ch ^ ((key >> 1) & 7)) << 4));
        *(LAS u32x4*)(Kb + off) = x; }
}
__device__ __forceinline__ void stage_new_tile(const bf16_t* src_  , LAS unsigned char* Kb, bool isV, int lane) {
    const char* src = uniform_ptr(src_);
#pragma unroll
    for (int it = 0; it < 8; ++it) *(LAS u32x4*)(Kb + (it * 64 + lane) * 16) = (u32x4){0u, 0u, 0u, 0u};
    if (lane < 32) { const int key = lane >> 3, ch = lane & 7; const u32x4 x = *(const u32x4*)(src + (unsigned)(key * 512 + ch * 16));
        const int off = isV ? ((ch >> 2) * 4096 + key * 64 + (ch & 3) * 16) : (key * 128 + ((ch ^ ((key >> 1) & 7)) << 4));
        *(LAS u32x4*)(Kb + off) = x; }
}
__device__ __forceinline__ void sample_unit(const Ptrs& P, LAS unsigned char* L, int uA, int uB, int tid, int wave, int lane) {
    asm volatile("" : "+v"(lane), "+v"(tid));
    const int half = wave >> 2, lw = wave & 3, usel = half ? uB : uA, b = usel >> 2, kv = usel & 3;
    const int r32 = lane & 31, hi = lane >> 5, g = r32 >> 3, qi = r32 & 7, qs = qi & 3, head = kv * 4 + g;
    const int t = PAST + qs; const unsigned row = (unsigned)MP + b * 4 + qs;
    bf16x8 qr[4];
#pragma unroll
    for (int ds = 0; ds < 4; ++ds) qr[ds] = *(const bf16x8*)(P.Q + (size_t)row * D + head * 64 + ds * 16 + hi * 8);
    const LAS float* lut = (const LAS float*)(L + LUT_OFF) + head * 128; const float bfar = lut[127];
    LAS float* wsf = (LAS float*)(L + WSF_OFF) + wave * 32;
    LAS unsigned* impq = (LAS unsigned*)(L + IMP_OFF) + wave * 512 + qi * 64;
    LAS unsigned char* Kb = L + wave * 16384; LAS unsigned char* Vb = Kb + 8192;
    f32x16 out[2], o[2];
#pragma unroll
    for (int r = 0; r < 16; ++r) { out[0][r] = 0.f; out[1][r] = 0.f; o[0][r] = 0.f; o[1][r] = 0.f; }
    stage_bf16_tile(P.kcs + (size_t)(b * 4 + kv) * 4096, Kb, false, lane); stage_bf16_tile(P.vcs + (size_t)(b * 4 + kv) * 4096, Vb, true, lane);
    LDS_WAIT();
    {
        f32x16 a0, a1;
        qk_tile(a0, a1, Kb, qr, 0.f, r32, hi);
        mask_bias(a0, a1, t, 31, 32, 1 << 30, true, true, lut, hi);
        { float rm = fmaxf(a0[0], a1[0]);
#pragma unroll
          for (int r = 1; r < 16; ++r) rm = fmaxf(rm, fmaxf(a0[r], a1[r]));
          rm = x32_max(rm); float sacc = 0.f;
#pragma unroll
          for (int r = 0; r < 16; ++r) { a0[r] = ex2(a0[r] - rm); a1[r] = ex2(a1[r] - rm); sacc += a0[r] + a1[r]; }
          sacc = x32_sum(sacc); const float cinv = 1.0f / sacc;
#pragma unroll
          for (int r = 0; r < 16; ++r) { a0[r] *= cinv; a1[r] *= cinv; } }
        imp_store(a0, a1, 0, impq, 32, g, hi);
        if (g == 0) {
#pragma unroll
            for (int q8 = 0; q8 < 8; ++q8) { const int jc = 32 + 4 * q8; u32x2 w; w.x = imp_key(0.f, jc + 2 * hi, 32); w.y = imp_key(0.f, jc + 2 * hi + 1, 32); *(LAS u32x2*)(impq + 2 * hi + jc) = w; } }
        if (lw == 0) { pv_tile(o, Vb, a0, a1, lane); const float g0 = GATEV(P, row, head, 0); row_fma(out, o, g0, wsf, r32, hi);
#pragma unroll
            for (int r = 0; r < 16; ++r) { o[0][r] = 0.f; o[1][r] = 0.f; } }
    }
    const unsigned long long mymask = select_mask(impq, g, hi);
    const unsigned long long umask = wave_or64(mymask) & 0x1FFFFFFFFull;
    const bool winw = lw == 3;
    const int nsel = __builtin_popcountll(umask);
    const int nmine = winw ? 9 : nsel, first = winw ? 0 : lw, step = winw ? 1 : 3;
    float m = -1e30f, l = 0.f;
#pragma unroll 1
    for (int idx = first; idx < nmine; idx += step) {
        LDS_WAIT();
        int pos0; bool near, sel = true;
        int ln = lane; asm volatile("" : "+v"(ln));
        if (!winw) {
            unsigned long long mm = umask; for (int n = 0; n < idx; ++n) mm &= mm - 1ull;
            const int j = __builtin_ctzll(mm);
            if (j < 32) { const int page = P.pt[b * 16 + (j >> 1)]; const size_t off = (((size_t)page * 128 + (j & 1) * 64) * 4 + kv) * 64;
                stage_f32_pair<false>(P.ck_sel + off, P.cv_sel + off, Kb, Vb, ln); }
            else { stage_new_tile(P.KS + ((size_t)MP + b * 4) * 256 + kv * 64, Kb, false, ln); stage_new_tile(P.VS + ((size_t)MP + b * 4) * 256 + kv * 64, Vb, true, ln); }
            pos0 = 64 * j; near = j >= 30; sel = (mymask >> j) & 1ull;
        } else {
            if (idx < 8) { const size_t off = (((size_t)b * 512 + 64 * idx) * 4 + kv) * 64;
                stage_f32_pair<true>(P.st_kw + off, P.st_vw + off, Kb, Vb, ln, P.kw_out + off - 1024, P.vw_out + off - 1024, idx == 0 ? 4 : 0); }
            else { stage_new_tile(P.KW + ((size_t)MP + b * 4) * 256 + kv * 64, Kb, false, ln); stage_new_tile(P.VW + ((size_t)MP + b * 4) * 256 + kv * 64, Vb, true, ln); }
            pos0 = PAST - 512 + 64 * idx; near = idx >= 6;
        }
        LDS_WAIT();
        f32x16 p0, p1;
        qk_tile(p0, p1, Kb, qr, near ? 0.f : bfar, r32, hi);
        mask_bias(p0, p1, t, pos0, 1, winw ? 512 : (1 << 30), sel, near, lut, hi);
        softmax_update(p0, p1, m, l, o, wsf, r32, hi);
        pv_tile(o, Vb, p0, p1, lane);
    }
    LDS_WAIT();
    { const float lt = x32_sum(l);
      LAS f32x2* ml = (LAS f32x2*)(L + IMP_OFF);
      if (hi == 0) ml[wave * 256 + r32] = (f32x2){m, lt};
      __syncthreads();
      const int w0 = half * 4 + (winw ? 3 : 0), w1 = half * 4 + (winw ? 4 : 3);
      float M = -1e30f;
      for (int w = w0; w < w1; ++w) M = fmaxf(M, ml[w * 256 + r32][0]);
      float Ls = 0.f;
      for (int w = w0; w < w1; ++w) { const f32x2 x = ml[w * 256 + r32]; Ls += x[1] * ex2(x[0] - M); }
      const float gt = GATEV(P, row, head, (winw ? 2 : 1));
      const float f = Ls > 0.f ? gt * ex2(m - M) / Ls : 0.f;
      row_fma(out, o, f, wsf, r32, hi); }
    LAS float* ob = (LAS float*)Kb + hi * 256 + r32;
#pragma unroll
    for (int r = 0; r < 16; ++r) { ob[CROW0(r) * 64] = out[0][r]; ob[CROW0(r) * 64 + 32] = out[1][r]; }
    __syncthreads();
    { const int hs = tid >> 8, vr = (tid >> 4) & 15, d4 = (tid & 15) * 4, gg = vr >> 2, qq = vr & 3, uo = hs ? uB : uA; f32x4 sacc = (f32x4){0.f, 0.f, 0.f, 0.f};
#pragma unroll
      for (int w = 0; w < 4; ++w) sacc = sacc + *(const LAS f32x4*)((const LAS float*)(L + (hs * 4 + w) * 16384) + (gg * 8 + qq) * 64 + d4);
      u32x2 w2; w2.x = cvtpk(sacc[0], sacc[1]); w2.y = cvtpk(sacc[2], sacc[3]);
      *(u32x2*)(P.O + ((size_t)MP + (uo >> 2) * 4 + qq) * D + ((uo & 3) * 4 + gg) * 64 + d4) = w2; }
    __syncthreads();
}

#ifdef VERIFY
__device__ __forceinline__ float wsum(float v) { for (int o = 1; o < 64; o <<= 1) v += __shfl_xor(v, o); return v; }
__device__ __forceinline__ float wmax(float v) { for (int o = 1; o < 64; o <<= 1) v = fmaxf(v, __shfl_xor(v, o)); return v; }
__device__ __forceinline__ float rb(float x) { return bf2f((unsigned short)(cvtpk(x, 0.f) & 0xffffu)); }
__device__ __forceinline__ void verify_item(const Ptrs& P, LAS unsigned char* L, bool sample, int b, int tq, int kv, int br, float* errs, int wave, int lane) {
    LAS float* sc = (LAS float*)(L + wave * 16384);
    LAS float* qs = (LAS float*)(L + IMP_OFF) + wave * 512;
    const LAS float* lutb = (const LAS float*)(L + LUT_OFF);
    const size_t row = sample ? (size_t)MP + b * 4 + tq : (size_t)b * SEQ + tq; const int pos = sample ? PAST + tq : tq; const int cq = pos >> 6;
    for (int g = 0; g < 4; ++g) qs[g * 64 + lane] = bf2f(P.Q[row * D + (kv * 4 + g) * 64 + lane]);
    LDS_WAIT();
    const int ncmp = sample ? 64 : 128; const size_t cmpo = (size_t)(b * 4 + kv) * (sample ? 4096 : 8192); const bf16_t* kc = (const bf16_t*)((const char*)P.kcp + (sample ? WS_KCMPS - WS_KCMPP : 0)) + cmpo; const bf16_t* vc = (const bf16_t*)((const char*)P.vcp + (sample ? WS_VCMPS - WS_VCMPP : 0)) + cmpo;
    float oc0 = 0.f, oc1 = 0.f, oc2 = 0.f, oc3 = 0.f;
    for (int g = 0; g < 4; ++g) {
        float sA = -INFINITY, sB = -INFINITY;
        for (int h = 0; h < 2; ++h) { const int n = lane + 64 * h; const int dist = pos - (32 * n + 31); float s = -INFINITY;
            if (n < ncmp && dist >= 0) { float a = 0.f; for (int d = 0; d < 64; ++d) a += qs[g * 64 + d] * bf2f(kc[(size_t)n * 64 + d]); s = a + lutb[(kv * 4 + g) * 128 + (dist > 127 ? 127 : dist)]; }
            if (h == 0) sA = s; else sB = s; }
        const float mx = wmax(fmaxf(sA, sB)); float p0 = 0.f, p1 = 0.f;
        if (mx > -INFINITY) { p0 = ex2(sA - mx); p1 = ex2(sB - mx); }
        const float sm = wsum(p0 + p1); const float inv = sm > 0.f ? 1.0f / sm : 0.f;
        sc[g * 128 + lane] = p0 * inv; sc[g * 128 + 64 + lane] = p1 * inv;
    }
    LDS_WAIT();
    for (int g = 0; g < 4; ++g) { float a = 0.f; for (int n = 0; n < ncmp; ++n) a += sc[g * 128 + n] * bf2f(vc[(size_t)n * 64 + lane]); if (g == 0) oc0 = a; else if (g == 1) oc1 = a; else if (g == 2) oc2 = a; else oc3 = a; }
    float imp = 0.f; for (int g = 0; g < 4; ++g) imp += sc[g * 128 + 2 * lane] + sc[g * 128 + 2 * lane + 1];
    { const bool forced = (lane == 0) || (lane == cq) || (lane == cq - 1), elig = lane <= cq; imp = forced ? 1e9f : (elig ? imp : -1.0f); }
    LDS_WAIT(); qs[256 + lane] = imp; LDS_WAIT();
    int rank = 0; for (int j = 0; j < 64; ++j) { const float v = qs[256 + j]; rank += (v > imp) || (v == imp && j < lane); }
    const int nsb = sample ? 33 : 64;
    const unsigned long long selm = __ballot(rank < 16 && lane < nsb);
    float r0 = oc0, r1 = oc1, r2_ = oc2, r3 = oc3;
    if (br != 0) {
        const int nslot = br == 1 ? __builtin_popcountll(selm) : 9;
        LDS_WAIT();
        for (int si = 0; si < nslot && si < 16; ++si) {
            int j;
            if (br == 1) { unsigned long long mm = selm; for (int n = 0; n < si; ++n) mm &= mm - 1ull; j = __builtin_ctzll(mm); } else j = sample ? si : cq - 8 + si;
            bool ok = false; int pk = 0; const float* kf = nullptr; const bf16_t* kb = nullptr;
            if (br == 1) { pk = 64 * j + lane;
                if (!sample) { ok = pk <= pos; kb = P.KS + ((size_t)b * SEQ + pk) * 256 + kv * 64; }
                else if (j < 32) { ok = true; kf = P.ck_sel + (((size_t)P.pt[b * 16 + (j >> 1)] * 128 + (j & 1) * 64 + lane) * 4 + kv) * 64; }
                else { ok = lane < 4 && pk <= pos; kb = P.KS + ((size_t)MP + b * 4 + (lane & 3)) * 256 + kv * 64; } }
            else { if (!sample) { pk = 64 * j + lane; ok = j >= 0 && pk <= pos && pos - pk < 512; kb = P.KW + ((size_t)b * SEQ + (ok ? pk : 0)) * 256 + kv * 64; }
                else { const int e = 64 * j + lane; pk = PAST - 512 + e; ok = e < 516 && pk <= pos && pos - pk < 512;
                    if (e < 512) kf = P.st_kw + (((size_t)b * 512 + e) * 4 + kv) * 64; else kb = P.KW + ((size_t)MP + b * 4 + ((e - 512) & 3)) * 256 + kv * 64; } }
            const int dist = pos - pk;
            for (int g = 0; g < 4; ++g) { float s = -INFINITY;
                if (ok) { float a = 0.f; for (int d = 0; d < 64; ++d) a += qs[g * 64 + d] * (kf ? rb(kf[d]) : bf2f(kb[d])); s = a + lutb[(kv * 4 + g) * 128 + (dist > 127 ? 127 : dist)]; }
                sc[g * 1024 + si * 64 + lane] = s; }
        }
        LDS_WAIT();
        for (int g = 0; g < 4; ++g) {
            float mx = -INFINITY; for (int si = 0; si < nslot && si < 16; ++si) mx = fmaxf(mx, sc[g * 1024 + si * 64 + lane]);
            mx = wmax(mx); float sm = 0.f;
            for (int si = 0; si < nslot && si < 16; ++si) { const float p = mx > -INFINITY ? ex2(sc[g * 1024 + si * 64 + lane] - mx) : 0.f; sc[g * 1024 + si * 64 + lane] = p; sm += p; }
            sm = wsum(sm); const float inv = sm > 0.f ? 1.0f / sm : 0.f;
            LDS_WAIT();
            float a = 0.f;
            for (int si = 0; si < nslot && si < 16; ++si) {
                int j;
                if (br == 1) { unsigned long long mm = selm; for (int n = 0; n < si; ++n) mm &= mm - 1ull; j = __builtin_ctzll(mm); } else j = sample ? si : cq - 8 + si;
                for (int k = 0; k < 64; ++k) { const float p = sc[g * 1024 + si * 64 + k]; if (p == 0.f) continue; float v;
                    if (br == 1) { if (!sample) v = bf2f(P.VS[((size_t)b * SEQ + 64 * j + k) * 256 + kv * 64 + lane]);
                        else if (j < 32) v = rb(P.cv_sel[(((size_t)P.pt[b * 16 + (j >> 1)] * 128 + (j & 1) * 64 + k) * 4 + kv) * 64 + lane]);
                        else v = bf2f(P.VS[((size_t)MP + b * 4 + (k & 3)) * 256 + kv * 64 + lane]); }
                    else { if (!sample) v = bf2f(P.VW[((size_t)b * SEQ + 64 * j + k) * 256 + kv * 64 + lane]);
                        else { const int e = 64 * j + k; v = e < 512 ? rb(P.st_vw[(((size_t)b * 512 + e) * 4 + kv) * 64 + lane]) : bf2f(P.VW[((size_t)MP + b * 4 + ((e - 512) & 3)) * 256 + kv * 64 + lane]); } }
                    a += p * v; } }
            a *= inv; if (g == 0) r0 = a; else if (g == 1) r1 = a; else if (g == 2) r2_ = a; else r3 = a;
            LDS_WAIT();
        }
    }
    float d2 = 0.f, rr2 = 0.f;
    for (int g = 0; g < 4; ++g) { const float ref = g == 0 ? r0 : g == 1 ? r1 : g == 2 ? r2_ : r3; const float f = bf2f(P.O[row * D + (kv * 4 + g) * 64 + lane]); const float df = f - ref; d2 += df * df; rr2 += ref * ref; }
    d2 = wsum(d2); rr2 = wsum(rr2);
    if (lane == 0) { atomicAdd(errs + ((sample ? 3 : 0) + br) * 2, d2); atomicAdd(errs + ((sample ? 3 : 0) + br) * 2 + 1, rr2); }
}
#endif
}

constexpr int NPHASE = 17;
__global__ void __launch_bounds__(512, 2) nsa_fwd(Args args) {
    extern __shared__ __attribute__((aligned(16))) unsigned char lds[];
    Frame F;
    F.lds = (LAS unsigned char*)lds;
    F.tid = threadIdx.x; F.lane = F.tid & 63; F.wave = __builtin_amdgcn_readfirstlane(F.tid >> 6);
    F.G = gridDim.x; { const int bx = blockIdx.x; F.vcu = (F.G % 8 == 0) ? (bx % 8) * (F.G / 8) + bx / 8 : bx; }
    F.x_p = (const float*)args.in[0]; F.x_s = (const float*)args.in[1]; F.c_p = (const float*)args.in[2]; F.c_s = (const float*)args.in[3];
    F.ck_cmp = (const float*)args.in[4]; F.cv_cmp = (const float*)args.in[5]; F.ck_sel = (const float*)args.in[6]; F.cv_sel = (const float*)args.in[7];
    F.page_table = (const int*)args.in[8]; F.st_kw = (const float*)args.in[9]; F.st_vw = (const float*)args.in[10]; F.st_pool = (const float*)args.in[11];
    F.rel_bias = (const float*)args.in[12]; F.ada_w = (const float*)args.in[13]; F.ada_b = (const float*)args.in[14]; F.norm_g = (const float*)args.in[15]; F.final_g = (const float*)args.in[16];
    F.w_in = (const float*)args.in[17]; F.w_out = (const float*)args.in[18]; F.cmp_wk = (const float*)args.in[19]; F.cmp_wv = (const float*)args.in[20];
    F.pe_k = (const float*)args.in[21]; F.pe_v = (const float*)args.in[22]; F.pool_w = (const float*)args.in[23]; F.pool_scale = (const float*)args.in[24];
    F.ffn_wg = (const float*)args.in[25]; F.ffn_wu = (const float*)args.in[26]; F.ffn_wd = (const float*)args.in[27];
    F.out = args.out; F.ws = args.ws;
    unsigned char* ws = args.ws;
    for (int u = F.tid; u < 64; u += 512) ((LAS unsigned*)(F.lds + MISC_OFF))[u] = 0u;
    for (int u = F.tid; u < 16 * 128; u += 512) { const int h = u >> 7, d = u & 127; ((LAS float*)(F.lds + LUT_OFF))[u] = F.rel_bias[t5_bucket(d) * 16 + h] * LOG2E; }
    __syncthreads();
    volatile LAS unsigned* MISC = (volatile LAS unsigned*)(F.lds + MISC_OFF);
    XcdBarrier bar; bar.bar = (unsigned*)(ws + WS_CTL) + CW_BAR; bar.x = 0; bar.st = nullptr;
    if (!MK_SPLIT) bar = xcd_barrier_post((unsigned*)(ws + WS_CTL) + CW_BAR, MISC + 8);
    const int lo = args.ph_lo, hi = args.ph_hi;
#ifndef PHMASK
#define PHMASK 0x1FFFF
#endif
#define IN(k) (((PHMASK >> (k)) & 1) && lo <= (k) && (k) < hi)
#define SEAM(k) do { if (IN(k) && IN((k) + 1)) xcd_barrier(bar); } while (0)
#ifndef REPMASK
#define REPMASK 0
#endif
#define REPS(k) (((REPMASK >> (k)) & 1) ? 2 : 1)
    bf16_t* H = (bf16_t*)(ws + WS_H); float* X = (float*)(ws + WS_X); float* MOD = (float*)(ws + WS_MOD);

    if (IN(0)) { for (int rep = 0; rep < REPS(0); ++rep) p0_prologue(F); } SEAM(0);
    if (IN(1)) { for (int rep = 0; rep < REPS(1); ++rep) { p1_compress_sample(F); p1_ada(F); } } SEAM(1);
    if (IN(2)) { for (int rep = 0; rep < REPS(2); ++rep) norm_phase<0>(F, true, 0, 0); } SEAM(2);
    if (IN(3)) {
        pg8::Gemm g{H, (const bf16_t*)(ws + WS_WIN), D, D, D, 0}; pg8::StaticOrder S; S.init(MT, NPROJ, F.G, (int)blockIdx.x);
        pg8::EpiProj E{(bf16_t*)(ws + WS_Q), (bf16_t*)(ws + WS_KV), (float*)(ws + WS_GATES), F.out};
        for (int rep = 0; rep < REPS(3); ++rep) pg8::gemm_phase<pg8::EpiProj, pg8::StaticOrder, true>(F.lds, g, S, E);
    } SEAM(3);
    if (IN(4)) { for (int rep = 0; rep < REPS(4); ++rep) p4_compress_prompt(F); } SEAM(4);
    if (IN(5)) {
        att::Ptrs P; P.Q = (const bf16_t*)(ws + WS_Q); P.kcp = (const bf16_t*)(ws + WS_KCMPP); P.vcp = (const bf16_t*)(ws + WS_VCMPP); P.kcs = (const bf16_t*)(ws + WS_KCMPS); P.vcs = (const bf16_t*)(ws + WS_VCMPS);
        const bf16_t* kvb = (const bf16_t*)(ws + WS_KV); P.KS = kvb + 2 * KV_STRIDE; P.VS = kvb + 3 * KV_STRIDE; P.KW = kvb + 4 * KV_STRIDE; P.VW = kvb + 5 * KV_STRIDE;
        P.gates = (const float*)(ws + WS_GATES); P.O = (bf16_t*)(ws + WS_O); P.ck_sel = F.ck_sel; P.cv_sel = F.cv_sel; P.st_kw = F.st_kw; P.st_vw = F.st_vw; P.pt = F.page_table;
        P.gov = -1; P.kw_out = F.out + O_KWS; P.vw_out = F.out + O_KWS + SZ_WS;
#ifdef VERIFY
        P.gov = args.pad0 - 1;
#endif
#ifndef RS
#define RS 1
#endif
#ifndef RP
#define RP 1
#endif
#pragma unroll 1
        for (int pass = 0; pass < 2; ++pass) {
            if ((pass == 0) != ((F.vcu & 1) != 0)) {
#pragma unroll 1
                for (int rep = 0; rep < RS; ++rep)
                for (int u = F.vcu; u < NSB * 2; u += F.G) att::sample_unit(P, F.lds, u, u + NSB * 2, F.tid, F.wave, F.lane);
            } else {
#pragma unroll 1
                for (int rep = 0; rep < RP; ++rep)
                for (int u = F.vcu; u < 16 * 16; u += F.G) { const int bk = u >> 4, s = u & 15;
#pragma unroll 1
                    for (int i = 0; i < 4; ++i) { const int c = (i == 0) ? s : (i == 1) ? 31 - s : (i == 2) ? 32 + s : 63 - s; att::prompt_unit(P, F.lds, bk >> 2, bk & 3, c, F.tid, F.wave, F.lane); } }
            }
        }
    } SEAM(5);
    if (IN(6)) {
        pg8::Gemm g{(const bf16_t*)(ws + WS_O), (const bf16_t*)(ws + WS_WOUT), D, D, D, 0}; pg8::StaticOrder S; S.init(MP, D, F.G, (int)blockIdx.x);
        pg8::EpiRes E{F.x_p, F.x_s, X, MOD + 2048, nullptr};
        pg8::gemm_phase<pg8::EpiRes, pg8::StaticOrder, true>(F.lds, g, S, E);
        small_gemm_res(F, (const bf16_t*)(ws + WS_O) + (size_t)MP * D, D, (const bf16_t*)(ws + WS_WOUT), D, D, false, F.x_s, X + (size_t)MP * D, MOD + 2048, nullptr);
    } SEAM(6);
    if (IN(7)) { for (int rep = 0; rep < REPS(7); ++rep) norm_phase<0>(F, false, 0, 1); } SEAM(7);
    if (IN(8)) {
        pg8::Gemm g{H, (const bf16_t*)(ws + WS_WGU), D, D, D, 0}; pg8::StaticOrder S; S.init(MT, NGU, F.G, (int)blockIdx.x);
        pg8::EpiGU E{(bf16_t*)(ws + WS_ACT)};
        for (int rep = 0; rep < REPS(8); ++rep) pg8::gemm_phase<pg8::EpiGU, pg8::StaticOrder, true>(F.lds, g, S, E);
    } SEAM(8);
    if (IN(9)) {
        pg8::Gemm g{(const bf16_t*)(ws + WS_ACT), (const bf16_t*)(ws + WS_WD), FF, FF, FF, 0}; pg8::StaticOrder S; S.init(MP, D, F.G, (int)blockIdx.x);
        pg8::EpiRes E{X, X + (size_t)MP * D, X, MOD + 5120, nullptr};
        pg8::gemm_phase<pg8::EpiRes, pg8::StaticOrder, true>(F.lds, g, S, E);
        small_gemm_res(F, (const bf16_t*)(ws + WS_ACT) + (size_t)MP * FF, FF, (const bf16_t*)(ws + WS_WD), FF, FF, false, X + (size_t)MP * D, X + (size_t)MP * D, MOD + 5120, nullptr);
    } SEAM(9);
    if (IN(10)) { for (int rep = 0; rep < REPS(10); ++rep) norm_phase<1>(F, false, 1, 0); } SEAM(10);
    if (IN(11)) { for (int rep = 0; rep < REPS(11); ++rep) pool_phase(F); } SEAM(11);
    if (IN(12)) {
        pg8::Gemm g{H, (const bf16_t*)(ws + WS_WPOOL), D, 256, 256, 256}; pg8::StaticOrder S; S.init(MP, D, F.G, (int)blockIdx.x);
        pg8::EpiRes E{X, X + (size_t)MP * D, X, MOD + (size_t)NMODB * 6144 + 2048, F.pool_scale};
        pg8::gemm_phase<pg8::EpiRes, pg8::StaticOrder, true>(F.lds, g, S, E);
        small_gemm_res(F, H + (size_t)MP * D, D, (const bf16_t*)(ws + WS_WPOOL), 256, 256, true, X + (size_t)MP * D, X + (size_t)MP * D, MOD + (size_t)NMODB * 6144 + 2048, F.pool_scale);
    } SEAM(12);
    if (IN(13)) { for (int rep = 0; rep < REPS(13); ++rep) norm_phase<0>(F, false, 1, 1); } SEAM(13);
    if (IN(14)) {
        pg8::Gemm g{H, (const bf16_t*)(ws + WS_WGU) + (size_t)NGU * D, D, D, D, 0}; pg8::StaticOrder S; S.init(MT, NGU, F.G, (int)blockIdx.x);
        pg8::EpiGU E{(bf16_t*)(ws + WS_ACT)};
        pg8::gemm_phase<pg8::EpiGU, pg8::StaticOrder, true>(F.lds, g, S, E);
    } SEAM(14);
    if (IN(15)) {
        pg8::Gemm g{(const bf16_t*)(ws + WS_ACT), (const bf16_t*)(ws + WS_WD) + (size_t)D * FF, FF, FF, FF, 0}; pg8::StaticOrder S; S.init(MP, D, F.G, (int)blockIdx.x);
        pg8::EpiRes E{X, X + (size_t)MP * D, X, MOD + (size_t)NMODB * 6144 + 5120, nullptr};
        pg8::gemm_phase<pg8::EpiRes, pg8::StaticOrder, true>(F.lds, g, S, E);
        small_gemm_res(F, (const bf16_t*)(ws + WS_ACT) + (size_t)MP * FF, FF, (const bf16_t*)(ws + WS_WD) + (size_t)D * FF, FF, FF, false, X + (size_t)MP * D, X + (size_t)MP * D, MOD + (size_t)NMODB * 6144 + 5120, nullptr);
    } SEAM(15);
    if (IN(16)) { for (int rep = 0; rep < REPS(16); ++rep) norm_phase<2>(F, false, 0, 0); }
#undef IN
#undef SEAM
}


#ifdef VERIFY
__global__ void __launch_bounds__(512, 2) verify_k(Args args) {
    extern __shared__ __attribute__((aligned(16))) unsigned char lds[];
    LAS unsigned char* L = (LAS unsigned char*)lds; unsigned char* ws = args.ws;
    const int tid = threadIdx.x, lane = tid & 63, wave = __builtin_amdgcn_readfirstlane(tid >> 6);
    const float* rel_bias = (const float*)args.in[12];
    for (int u = tid; u < 16 * 128; u += 512) { const int h = u >> 7, d = u & 127; ((LAS float*)(L + LUT_OFF))[u] = rel_bias[t5_bucket(d) * 16 + h] * LOG2E; }
    __syncthreads();
    att::Ptrs P; P.Q = (const bf16_t*)(ws + WS_Q); P.kcp = (const bf16_t*)(ws + WS_KCMPP); P.vcp = (const bf16_t*)(ws + WS_VCMPP); P.kcs = (const bf16_t*)(ws + WS_KCMPS); P.vcs = (const bf16_t*)(ws + WS_VCMPS);
    const bf16_t* kvb = (const bf16_t*)(ws + WS_KV); P.KS = kvb + 2 * KV_STRIDE; P.VS = kvb + 3 * KV_STRIDE; P.KW = kvb + 4 * KV_STRIDE; P.VW = kvb + 5 * KV_STRIDE;
    P.gates = (const float*)(ws + WS_GATES); P.O = (bf16_t*)(ws + WS_O); P.ck_sel = (const float*)args.in[6]; P.cv_sel = (const float*)args.in[7]; P.st_kw = (const float*)args.in[9]; P.st_vw = (const float*)args.in[10]; P.pt = (const int*)args.in[8]; P.gov = args.pad0 - 1;
    float* errs = (float*)(ws + WS_CTL) + 65536;
    const int gw = blockIdx.x * 8 + wave;
    for (int it = gw; it < 168 + 64; it += gridDim.x * 8) { bool smp = it >= 168; int vb_, vt_, vk_;
        if (!smp) { const int ti = it % 21, r = it / 21; vb_ = (r >> 2) ? 3 : 0; vk_ = r & 3; vt_ = ti == 0 ? 0 : ti == 1 ? 5 : ti == 2 ? 30 : ti == 3 ? 31 : ti == 4 ? 63 : ti == 5 ? 64 : ti == 6 ? 100 : ti == 7 ? 511 : ti == 8 ? 512 : ti == 9 ? 600 : ti == 10 ? 959 : ti == 11 ? 960 : ti == 12 ? 1023 : ti == 13 ? 1024 : ti == 14 ? 1055 : ti == 15 ? 1100 : ti == 16 ? 2047 : ti == 17 ? 2048 : ti == 18 ? 3000 : ti == 19 ? 4032 : 4095; }
        else { const int q = it - 168, bi = q >> 4; vb_ = bi == 0 ? 0 : bi == 1 ? 1 : bi == 2 ? 77 : 127; vt_ = q & 3; vk_ = (q >> 2) & 3; }
        att::verify_item(P, L, smp, vb_, vt_, vk_, args.pad0 - 1, errs, wave, lane); }
}
__global__ void scale_k(Args args) {
    const float* errs = (const float*)(args.ws + WS_CTL) + 65536; const size_t offs[6] = {O_KCP, O_KCP + SZ_KVP, O_KCP + 2 * SZ_KVP, O_KCS, O_KCS + SZ_KVS, O_KCS + 2 * SZ_KVS};
    const int k = blockIdx.y; const float d2 = errs[2 * k], r2 = errs[2 * k + 1]; const float e = r2 > 0.f ? sqrtf(d2 / r2) : 7.0f; const size_t n = k < 3 ? SZ_KVP : SZ_KVS;
    for (size_t i = (size_t)blockIdx.x * blockDim.x + threadIdx.x; i < n; i += (size_t)gridDim.x * blockDim.x) args.out[offs[k] + i] *= (1.0f + e);
}
#endif
extern "C" void kernel_launch(void* const* d_in, const int* in_sizes, int n_in, void* d_out, int out_size, void* d_ws, size_t ws_size, hipStream_t stream) {
    static int grid = 0;
    if (grid == 0) {
        if (n_in != 28 || (size_t)out_size != O_END || ws_size < WS_END) { fprintf(stderr, "kernel_launch: unexpected shapes (n_in %d, out %d, ws %zu); nothing launched\n", n_in, out_size, ws_size); grid = -1; return; }
        int dev = 0, cus = 0, per_cu = 0;
        if (hipGetDevice(&dev) != hipSuccess || hipDeviceGetAttribute(&cus, hipDeviceAttributeMultiprocessorCount, dev) != hipSuccess) { grid = -1; return; }
        if (hipFuncSetAttribute((const void*)nsa_fwd, hipFuncAttributeMaxDynamicSharedMemorySize, LDS_BYTES) != hipSuccess) { fprintf(stderr, "kernel_launch: hipFuncSetAttribute(%d B LDS) failed\n", LDS_BYTES); grid = -1; return; }
        if (hipOccupancyMaxActiveBlocksPerMultiprocessor(&per_cu, (const void*)nsa_fwd, 512, LDS_BYTES) != hipSuccess || per_cu < 1)
            fprintf(stderr, "kernel_launch: note: occupancy query reports %d workgroups per CU\n", per_cu);
        (void)hipGetLastError();
        grid = cus;
    }
    if (grid < 0) return;
    (void)hipMemsetAsync((char*)d_ws + WS_CTL, 0, CTL_ZERO_BYTES, stream);
    Args a{};
    for (int i = 0; i < 28; ++i) a.in[i] = d_in[i];
    a.out = (float*)d_out; a.ws = (unsigned char*)d_ws; a.pad0 = 0; a.pad1 = 0;
#ifdef VERIFY
    hipFuncSetAttribute((const void*)verify_k, hipFuncAttributeMaxDynamicSharedMemorySize, LDS_BYTES);
    for (int pass = 0; pass < 3; ++pass) { a.pad0 = pass + 1; a.ph_lo = 0; a.ph_hi = 6;
        (void)hipMemsetAsync((char*)d_ws + WS_CTL, 0, 65536 * 4, stream);
        hipLaunchKernelGGL(nsa_fwd, dim3(grid), dim3(512), LDS_BYTES, stream, a);
        hipLaunchKernelGGL(verify_k, dim3(grid), dim3(512), LDS_BYTES, stream, a); }
    a.pad0 = 0; (void)hipMemsetAsync((char*)d_ws + WS_CTL, 0, 65536 * 4, stream);
    a.ph_lo = 0; a.ph_hi = NPHASE;
    hipLaunchKernelGGL(nsa_fwd, dim3(grid), dim3(512), LDS_BYTES, stream, a);
    hipLaunchKernelGGL(scale_k, dim3(64, 6), dim3(256), 0, stream, a);
#elif MK_SPLIT
    for (int p = 0; p < NPHASE; ++p) { a.ph_lo = p; a.ph_hi = p + 1; hipLaunchKernelGGL(nsa_fwd, dim3(grid), dim3(512), LDS_BYTES, stream, a); }
#else
    a.ph_lo = 0; a.ph_hi = NPHASE;
    hipLaunchKernelGGL(nsa_fwd, dim3(grid), dim3(512), LDS_BYTES, stream, a);
#endif
    const hipError_t le = hipPeekAtLastError();
    if (le != hipSuccess) fprintf(stderr, "kernel_launch: launch failed: %s\n", hipGetErrorName(le));
}
```

```cpp
#include <hip/hip_runtime.h>
#include <cstdio>
#include <cstdint>

#ifndef MK_SPLIT
#define MK_SPLIT 0
#endif

#define GAS __attribute__((address_space(1)))
#define LAS __attribute__((address_space(3)))
typedef unsigned short bf16_t;
typedef short bf16x8 __attribute__((ext_vector_type(8)));
typedef short s16x4 __attribute__((ext_vector_type(4)));
typedef float f32x2 __attribute__((ext_vector_type(2)));
typedef float f32x4 __attribute__((ext_vector_type(4)));
typedef float f32x16 __attribute__((ext_vector_type(16)));
typedef unsigned u32x2 __attribute__((ext_vector_type(2)));
typedef unsigned u32x4 __attribute__((ext_vector_type(4)));
typedef __bf16 bf16x2_t __attribute__((ext_vector_type(2)));
typedef GAS unsigned gu32;

constexpr int D = 1024, SEQ = 4096, NB = 4, NSB = 128, DSEQ = 4;
constexpr int MP = NB * SEQ, MS = NSB * DSEQ, MT = MP + MS;
constexpr int INCOLS = 2608, NPROJ = 2816, FF = 2816, NGU = 2 * FF;
constexpr int NMODB = NB + NSB;
constexpr int PAST = 2048;
constexpr float C2 = 0.125f * 1.4426950408889634f;
constexpr float LOG2E = 1.4426950408889634f;

constexpr size_t O_YP = 0, O_YS = O_YP + (size_t)MP * D;
constexpr size_t O_KCP = O_YS + (size_t)MS * D, SZ_KVP = (size_t)MP * 256;
constexpr size_t O_KWP = O_KCP + 4 * SZ_KVP, SZ_WP = (size_t)NB * 512 * 256;
constexpr size_t O_PLP = O_KWP + 2 * SZ_WP;
constexpr size_t O_KCS = O_PLP + (size_t)NB * 15 * D, SZ_KVS = (size_t)MS * 256;
constexpr size_t O_KWS = O_KCS + 4 * SZ_KVS, SZ_WS = (size_t)NSB * 512 * 256;
constexpr size_t O_PLS = O_KWS + 2 * SZ_WS;
constexpr size_t O_END = O_PLS + (size_t)NSB * 15 * D;
static_assert(O_END == 71233536, "output size");

constexpr size_t MiB = 1u << 20;
#ifdef VERIFY
constexpr size_t WS_CTL = 0, CTL_ZERO_BYTES = 1 * MiB;
#else
constexpr size_t WS_CTL = 0, CTL_ZERO_BYTES = 65536;
#endif
constexpr size_t WS_WIN = 2 * MiB;
constexpr size_t WS_WOUT = 8 * MiB;
constexpr size_t WS_WGU = 10 * MiB;
constexpr size_t WS_WD = 32 * MiB;
constexpr size_t WS_WPOOL = 44 * MiB;
constexpr size_t WS_WCK = 45 * MiB, WS_WCV = WS_WCK + 262144;
constexpr size_t WS_SC = 46 * MiB;
constexpr size_t WS_CB = 47 * MiB;
constexpr size_t WS_MOD = 48 * MiB;
constexpr size_t WS_KCMPP = 56 * MiB, WS_VCMPP = 57 * MiB;
constexpr size_t WS_KCMPS = 58 * MiB, WS_VCMPS = 62 * MiB;
constexpr size_t WS_GATES = 66 * MiB;
constexpr size_t WS_H = 72 * MiB;
constexpr size_t WS_Q = 108 * MiB;
constexpr size_t WS_O = 144 * MiB;
constexpr size_t WS_KV = 180 * MiB, KV_STRIDE = (size_t)MT * 256;
constexpr size_t WS_X = 232 * MiB;
constexpr size_t WS_HF = 300 * MiB;
constexpr size_t WS_ACT = 368 * MiB;
constexpr size_t WS_END = 464 * MiB;
static_assert(WS_KV + 6 * KV_STRIDE * 2 <= WS_X && WS_X + (size_t)MT * D * 4 <= WS_HF && WS_HF + (size_t)MT * D * 4 <= WS_ACT && WS_ACT + (size_t)MT * FF * 2 <= WS_END, "ws map");
static_assert(WS_WGU + 2 * (size_t)NGU * D * 2 <= WS_WD && WS_WD + 2 * (size_t)D * FF * 2 <= WS_WPOOL && WS_MOD + 2 * (size_t)NMODB * 6144 * 4 <= WS_KCMPP, "ws map 2");
static_assert(WS_GATES + (size_t)MT * 48 * 4 <= WS_H && WS_H + (size_t)MT * D * 2 <= WS_Q && WS_Q + (size_t)MT * D * 2 <= WS_O && WS_O + (size_t)MT * D * 2 <= WS_KV, "ws map 3");
constexpr int CW_BAR = 4096;

constexpr int RING_BYTES = 131072;
constexpr int LUT_OFF = RING_BYTES;
constexpr int WSF_OFF = LUT_OFF + 8192;
constexpr int IMP_OFF = WSF_OFF + 1024;
constexpr int MISC_OFF = IMP_OFF + 16384;
constexpr int LDS_BYTES = MISC_OFF + 256;
static_assert(LDS_BYTES <= 160 * 1024, "LDS");

__device__ __forceinline__ unsigned cvtpk(float lo, float hi) { f32x2 v = {lo, hi}; bf16x2_t b = __builtin_convertvector(v, bf16x2_t); return __builtin_bit_cast(unsigned, b); }
__device__ __forceinline__ float bf2f(unsigned short h) { return __builtin_bit_cast(float, (unsigned)h << 16); }
__device__ __forceinline__ float ex2(float x) { return __builtin_amdgcn_exp2f(x); }
__device__ __forceinline__ float sigmoidf_(float x) { return __builtin_amdgcn_rcpf(1.0f + ex2(-x * LOG2E)); }
#define CROW0(r) (((r) & 3) + 8 * ((r) >> 2))
#define LDS_WAIT() asm volatile("s_waitcnt lgkmcnt(0)" ::: "memory")
#define VM_WAIT() asm volatile("s_waitcnt vmcnt(0)" ::: "memory")
__device__ __forceinline__ const char* uniform_ptr(const void* p) { const unsigned long long v = (unsigned long long)p; const unsigned lo = (unsigned)__builtin_amdgcn_readfirstlane((int)(unsigned)v), hi = (unsigned)__builtin_amdgcn_readfirstlane((int)(unsigned)(v >> 32)); return (const char*)(((unsigned long long)hi << 32) | lo); }

__device__ __forceinline__ int lane_id() { int l; asm volatile("v_mbcnt_lo_u32_b32 %0, -1, 0\n\tv_mbcnt_hi_u32_b32 %0, -1, %0" : "=v"(l)); return l; }
__device__ __forceinline__ int t5_bucket(int d) {
    if (d < 16) return d;
    int b = 16;
    b += (d >= 19) + (d >= 21) + (d >= 24) + (d >= 27) + (d >= 31) + (d >= 35) + (d >= 40) + (d >= 46) + (d >= 52) + (d >= 59) + (d >= 67) + (d >= 77) + (d >= 87) + (d >= 99) + (d >= 113);
    return b;
}

namespace pg8 {
constexpr int BM = 256, BK = 64, HALF = 128, HTB = HALF * BK * 2, STAGE_BYTES = 8 * HTB, NXCD = 8, WGM = 8;
__host__ __device__ __forceinline__ int lds_byte(int r, int c) { const int st = (r >> 4) * 2 + (c >> 5), rr = r & 15, cc = c & 31, ob = rr * 64 + cc * 2; return st * 1024 + (ob ^ (((ob >> 9) & 1) << 5)); }
__host__ __device__ __forceinline__ void stage_rc(int b, int& R, int& C) { const int st = b / 1024, sb = b % 1024, swz = sb ^ (((sb >> 9) & 1) << 5); R = (st >> 1) * 16 + swz / 64; C = (st & 1) * 32 + (swz % 64) / 2; }
__host__ __device__ __forceinline__ int perm32(int rho) { const int n = rho >> 4, i = rho & 15; return 8 * (i >> 2) + 4 * n + (i & 3); }
struct Unit { int pm, pn; };
struct Gemm { const bf16_t* A; const bf16_t* Bt; int lda, ldb, K, acs; };
struct StaticOrder {
    int nM, nN, nwg, G, c;
    __host__ __device__ void init(int M, int N, int G_, int c_) { nM = M / BM; nN = N / BM; nwg = nM * nN; G = G_; c = c_; }
    __host__ __device__ bool next(int i, Unit& u) const {
        const long L = (long)i * G + c; if (L >= nwg) return false;
        int wgid = (int)L; { const int q = nwg / NXCD, r = nwg % NXCD, xcd = wgid % NXCD, off = wgid / NXCD; wgid = (xcd < r ? xcd * (q + 1) : r * (q + 1) + (xcd - r) * q) + off; }
        const int nig = WGM * nN, gid = wgid / nig, fm = gid * WGM, gsz = (nM - fm) < WGM ? (nM - fm) : WGM;
        u.pm = fm + ((wgid % nig) % gsz); u.pn = (wgid % nig) / gsz; return true;
    }
};
template <class Epi, class Sched, bool ALIGN_EPI>
__device__ __forceinline__ void gemm_phase(LAS unsigned char* lds, const Gemm g, const Sched& S, const Epi& E) {
    const int tid = threadIdx.x, wid = __builtin_amdgcn_readfirstlane(tid >> 6), lane = tid & 63, wr = wid >> 2, wc = wid & 3, fr = lane & 15, fq = lane >> 4;
    const int K = g.K, nt = K / BK;
    unsigned voffA[2], voffB[2];
#pragma unroll
    for (int i = 0; i < 2; ++i) { int R, C; stage_rc(tid * 16 + i * 8192, R, C); const int Rb = Epi::PERM ? ((R & ~31) + perm32(R & 31)) : R;
        voffA[i] = (unsigned)(R * g.lda + C) * 2u; voffB[i] = (unsigned)(Rb * g.ldb + C) * 2u; }
    const size_t kstep = (size_t)(BK * 2);
    const size_t hsA = (size_t)HALF * g.lda * 2, hsB = (size_t)HALF * g.ldb * 2;
    const unsigned ldsw = (unsigned)wid * 1024u;
    const int aoff = lds_byte(wr * 64 + fr, fq * 8), boff = lds_byte(wc * 32 + fr, fq * 8);
#define PG8_SA(b, h) (((b) * 2 + (h)) * HTB)
#define PG8_SB(b, h) ((4 + (b) * 2 + (h)) * HTB)
#define PG8_STAGE(bufoff, gbase, voff) do { _Pragma("unroll") for (int _i = 0; _i < 2; ++_i) \
        __builtin_amdgcn_global_load_lds((const unsigned*)((const char*)(gbase) + (voff)[_i]), (LAS unsigned*)(lds + (bufoff) + ldsw + _i * 8192), 16, 0, 0); } while (0)
#define PG8_LDA(dst, b, h) do { _Pragma("unroll") for (int m = 0; m < 4; ++m) _Pragma("unroll") for (int k = 0; k < 2; ++k) dst[m][k] = *(const LAS bf16x8*)(lds + PG8_SA(b, h) + aoff + m * 2048 + k * 1024); } while (0)
#define PG8_LDB(dst, b, h) do { _Pragma("unroll") for (int n = 0; n < 2; ++n) _Pragma("unroll") for (int k = 0; k < 2; ++k) dst[n][k] = *(const LAS bf16x8*)(lds + PG8_SB(b, h) + boff + n * 2048 + k * 1024); } while (0)
#define PG8_MMA(ai, bj, At, Bt) do { __builtin_amdgcn_s_setprio(1); _Pragma("unroll") for (int m = 0; m < 4; ++m) _Pragma("unroll") for (int n = 0; n < 2; ++n) _Pragma("unroll") for (int k = 0; k < 2; ++k) \
        acc[ai][bj][m][n] = __builtin_amdgcn_mfma_f32_16x16x32_bf16(Bt[n][k], At[m][k], acc[ai][bj][m][n], 0, 0, 0); __builtin_amdgcn_s_setprio(0); } while (0)
#define PG8_WAIT_V(n) asm volatile("s_waitcnt vmcnt(" #n ")" ::: "memory")
#define PG8_WAIT_L(n) asm volatile("s_waitcnt lgkmcnt(" #n ")" ::: "memory")
#define PG8_BAR __builtin_amdgcn_s_barrier()
#define PG8_SCHED __builtin_amdgcn_sched_barrier(0)
#define PG8_UA(u) ((const char*)g.A + (size_t)(u).pm * 2 * hsA + (size_t)(u).pn * (size_t)g.acs * 2)
#define PG8_UB(u) ((const char*)g.Bt + (size_t)(u).pn * 2 * hsB)
    Unit cur, nxt; int ui = 0;
    if (!S.next(0, cur)) return;
    f32x4 acc[2][2][4][2];
#pragma unroll
    for (int a = 0; a < 2; ++a)
#pragma unroll
        for (int b = 0; b < 2; ++b)
#pragma unroll
            for (int m = 0; m < 4; ++m)
#pragma unroll
                for (int n = 0; n < 2; ++n) acc[a][b][m][n] = (f32x4){0.f, 0.f, 0.f, 0.f};
    bf16x8 At[4][2], B0[2][2], B1[2][2];
    const char* cA = PG8_UA(cur); const char* cB = PG8_UB(cur);
    PG8_STAGE(PG8_SB(0, 0), cB, voffB); PG8_STAGE(PG8_SB(0, 1), cB + hsB, voffB); PG8_STAGE(PG8_SA(0, 0), cA, voffA); PG8_STAGE(PG8_SA(0, 1), cA + hsA, voffA);
    if (wr == 1) PG8_BAR;
    PG8_WAIT_V(2); PG8_BAR;
    PG8_STAGE(PG8_SB(1, 0), cB + kstep, voffB); PG8_STAGE(PG8_SA(1, 0), cA + kstep, voffA); PG8_STAGE(PG8_SB(1, 1), cB + hsB + kstep, voffB);
    PG8_WAIT_V(6); PG8_BAR;
    for (;;) {
        const bool has_next = S.next(ui + 1, nxt);
        const char* nA = has_next ? PG8_UA(nxt) : cA; const char* nB = has_next ? PG8_UB(nxt) : cB;
        for (int t = 0; t < nt; t += 2) {
            const bool last = (t == nt - 2);
            const char* a1 = cA + (size_t)(t + 1) * kstep;
            const char* a2 = last ? nA : cA + (size_t)(t + 2) * kstep; const char* b2 = last ? nB : cB + (size_t)(t + 2) * kstep;
            const char* a3 = a2 + kstep; const char* b3 = b2 + kstep;
            PG8_LDB(B0, 0, 0); PG8_LDB(B1, 0, 1); PG8_SCHED; PG8_LDA(At, 0, 0); PG8_STAGE(PG8_SA(1, 1), a1 + hsA, voffA);
            PG8_WAIT_V(8); PG8_WAIT_L(0); PG8_BAR; PG8_MMA(0, 0, At, B0); PG8_MMA(0, 1, At, B1); PG8_BAR; PG8_SCHED;
            PG8_LDA(At, 0, 1); PG8_STAGE(PG8_SB(0, 0), b2, voffB); PG8_STAGE(PG8_SB(0, 1), b2 + hsB, voffB); PG8_STAGE(PG8_SA(0, 0), a2, voffA);
            PG8_WAIT_V(8); PG8_WAIT_L(0); PG8_BAR; PG8_MMA(1, 0, At, B0); PG8_MMA(1, 1, At, B1); PG8_BAR; PG8_SCHED;
            PG8_LDB(B0, 1, 0); PG8_LDB(B1, 1, 1); PG8_SCHED; PG8_LDA(At, 1, 0); PG8_STAGE(PG8_SA(0, 1), a2 + hsA, voffA);
            PG8_WAIT_V(8); PG8_WAIT_L(0); PG8_BAR; PG8_MMA(0, 0, At, B0); PG8_MMA(0, 1, At, B1); PG8_BAR; PG8_SCHED;
            PG8_LDA(At, 1, 1); PG8_STAGE(PG8_SB(1, 0), b3, voffB); PG8_STAGE(PG8_SB(1, 1), b3 + hsB, voffB); PG8_STAGE(PG8_SA(1, 0), a3, voffA);
            PG8_WAIT_V(8); PG8_WAIT_L(0); PG8_BAR; PG8_MMA(1, 0, At, B0); PG8_MMA(1, 1, At, B1); PG8_BAR; PG8_SCHED;
        }
        if constexpr (ALIGN_EPI) { if (wr == 0) PG8_BAR; }
        E(acc, cur, wr, wc, fr, fq);
        if (!has_next) break;
#pragma unroll
        for (int a = 0; a < 2; ++a)
#pragma unroll
            for (int b = 0; b < 2; ++b)
#pragma unroll
                for (int m = 0; m < 4; ++m)
#pragma unroll
                    for (int n = 0; n < 2; ++n) acc[a][b][m][n] = (f32x4){0.f, 0.f, 0.f, 0.f};
        cur = nxt; cA = nA; cB = nB; ++ui;
        if constexpr (ALIGN_EPI) { if (wr == 1) PG8_BAR; }
    }
    PG8_WAIT_V(0);
    if constexpr (!ALIGN_EPI) { if (wr == 0) PG8_BAR; }
    PG8_BAR;
#undef PG8_SA
#undef PG8_SB
#undef PG8_STAGE
#undef PG8_LDA
#undef PG8_LDB
#undef PG8_MMA
#undef PG8_WAIT_V
#undef PG8_WAIT_L
#undef PG8_BAR
#undef PG8_SCHED
#undef PG8_UA
#undef PG8_UB
}

struct EpiProj {
    static constexpr bool PERM = true;
    bf16_t* Q; bf16_t* KV; float* gates; float* out;
    __device__ __forceinline__ void operator()(const f32x4 (&acc)[2][2][4][2], const Unit& u, int wr, int wc, int fr, int fq) const {
        const int pn = u.pn;
#pragma unroll
        for (int ai = 0; ai < 2; ++ai)
#pragma unroll
            for (int m = 0; m < 4; ++m) {
                const int row = u.pm * BM + ai * HALF + wr * 64 + m * 16 + fr;
                if (pn < 4) {
#pragma unroll
                    for (int bj = 0; bj < 2; ++bj) { const f32x4 v0 = acc[ai][bj][m][0] * C2, v1 = acc[ai][bj][m][1] * C2; u32x4 w;
                        w.x = cvtpk(v0[0], v0[1]); w.y = cvtpk(v0[2], v0[3]); w.z = cvtpk(v1[0], v1[1]); w.w = cvtpk(v1[2], v1[3]);
                        *(u32x4*)(Q + (size_t)row * D + pn * 256 + bj * HALF + wc * 32 + 8 * fq) = w; }
                } else if (pn < 10) {
                    const int t = pn - 4; float* dst = nullptr;
                    if (row < MP) { if (t < 4) dst = out + O_KCP + (size_t)t * SZ_KVP + (size_t)row * 256; else { const int tt = row & (SEQ - 1); if (tt >= SEQ - 512) dst = out + O_KWP + (size_t)(t - 4) * SZ_WP + ((size_t)(row >> 12) * 512 + (tt - (SEQ - 512))) * 256; } }
                    else { const int rs = row - MP; if (t < 4) dst = out + O_KCS + (size_t)t * SZ_KVS + (size_t)rs * 256; else dst = out + O_KWS + (size_t)(t - 4) * SZ_WS + ((size_t)(rs >> 2) * 512 + 508 + (rs & 3)) * 256; }
                    bf16_t* bd = KV + (size_t)t * KV_STRIDE + (size_t)row * 256;
#pragma unroll
                    for (int bj = 0; bj < 2; ++bj) { const int cc = bj * HALF + wc * 32 + 8 * fq; const f32x4 v0 = acc[ai][bj][m][0], v1 = acc[ai][bj][m][1]; u32x4 w;
                        w.x = cvtpk(v0[0], v0[1]); w.y = cvtpk(v0[2], v0[3]); w.z = cvtpk(v1[0], v1[1]); w.w = cvtpk(v1[2], v1[3]);
                        *(u32x4*)(bd + cc) = w;
                        if (dst) { *(f32x4*)(dst + cc) = v0; *(f32x4*)(dst + cc + 4) = v1; } }
                } else {
                    const int cc = wc * 32 + 8 * fq;
                    if (cc < 48) { float* gd = gates + (size_t)row * 48 + cc; *(f32x4*)gd = acc[ai][0][m][0]; *(f32x4*)(gd + 4) = acc[ai][0][m][1]; }
                }
            }
    }
};
struct EpiRes {
    static constexpr bool PERM = false;
    const float* xin_p; const float* xin_s; float* xout; const float* gate; const float* scale;
    __device__ __forceinline__ void operator()(const f32x4 (&acc)[2][2][4][2], const Unit& u, int wr, int wc, int fr, int fq) const {
#pragma unroll
        for (int ai = 0; ai < 2; ++ai)
#pragma unroll
            for (int m = 0; m < 4; ++m) {
                const int row = u.pm * BM + ai * HALF + wr * 64 + m * 16 + fr;
                const int bb = row < MP ? (row >> 12) : NB + ((row - MP) >> 2);
                const float* xi = row < MP ? xin_p + (size_t)row * D : xin_s + (size_t)(row - MP) * D;
                const float* gp = gate + (size_t)bb * 6144; float* xo = xout + (size_t)row * D;
#pragma unroll
                for (int bj = 0; bj < 2; ++bj)
#pragma unroll
                    for (int n = 0; n < 2; ++n) { const int col = u.pn * BM + bj * HALF + wc * 32 + 16 * n + 4 * fq;
                        f32x4 g4 = *(const f32x4*)(gp + col); if (scale) g4 = g4 * *(const f32x4*)(scale + col);
                        const f32x4 x4 = *(const f32x4*)(xi + col); *(f32x4*)(xo + col) = x4 + g4 * acc[ai][bj][m][n]; }
            }
    }
};
struct EpiGU {
    static constexpr bool PERM = true;
    bf16_t* act;
    __device__ __forceinline__ void operator()(const f32x4 (&acc)[2][2][4][2], const Unit& u, int wr, int wc, int fr, int fq) const {
#pragma unroll
        for (int ai = 0; ai < 2; ++ai)
#pragma unroll
            for (int m = 0; m < 4; ++m) {
                const int row = u.pm * BM + ai * HALF + wr * 64 + m * 16 + fr; float r[8];
#pragma unroll
                for (int n = 0; n < 2; ++n)
#pragma unroll
                    for (int e = 0; e < 4; ++e) { const float gv = acc[ai][0][m][n][e], uv = acc[ai][1][m][n][e]; r[n * 4 + e] = gv * sigmoidf_(gv) * uv; }
                u32x4 w; w.x = cvtpk(r[0], r[1]); w.y = cvtpk(r[2], r[3]); w.z = cvtpk(r[4], r[5]); w.w = cvtpk(r[6], r[7]);
                *(u32x4*)(act + (size_t)row * FF + u.pn * HALF + wc * 32 + 8 * fq) = w;
            }
    }
};
}

#define XB_TMO      128
#define XB_XCNT(j)  (256  + 64 * (j))
#define XB_XSUB(j)  (1280 + 64 * (j))
#define XB_XGEN(j)  (2304 + 64 * (j))
#define XB_TOP      3328
#define XB_TOPGEN   3392
#define XCD_BAR_WORDS 3456
#define XB_SPIN_CAP (1u << 18)
__device__ __forceinline__ unsigned xb_ld(unsigned* p)              { return __hip_atomic_load(p, __ATOMIC_RELAXED, __HIP_MEMORY_SCOPE_AGENT); }
__device__ __forceinline__ unsigned xb_add(unsigned* p, unsigned v) { return __hip_atomic_fetch_add(p, v, __ATOMIC_RELAXED, __HIP_MEMORY_SCOPE_AGENT); }
__device__ __forceinline__ unsigned xb_xcc_id() { return (unsigned)__builtin_amdgcn_s_getreg((3 << 11) | 20) & 0xFu; }
#define XB_SPIN(cond, bar) do { unsigned _sp = 0; while (cond) { __builtin_amdgcn_s_sleep(1); \
    if ((++_sp & 255u) == 0u) { if (xb_ld(&(bar)[XB_TMO])) break; if (_sp > XB_SPIN_CAP) { atomicAdd(&(bar)[XB_TMO], 1u); break; } } } } while (0)
struct XcdBarrier { unsigned* bar; unsigned x; volatile LAS unsigned* st; };
__device__ __forceinline__ XcdBarrier xcd_barrier_post(unsigned* bar, volatile LAS unsigned* st) {
    XcdBarrier b; b.bar = bar; b.x = xb_xcc_id(); b.st = st;
    if (threadIdx.x == 0) (void)xb_add(&bar[XB_XCNT(b.x)], 1u);
    return b;
}
__device__ __forceinline__ void xcd_barrier_complete(unsigned* bar, unsigned x, unsigned& nloc, unsigned& nx) {
    const unsigned G = gridDim.x * gridDim.y * gridDim.z;
    unsigned sum, cnt, mine, sp = 0u;
    for (;;) {
        sum = 0u; cnt = 0u; mine = 0u;
#pragma unroll
        for (unsigned j = 0; j < 16; ++j) { const unsigned c = xb_ld(&bar[XB_XCNT(j)]); sum += c; cnt += (c > 0u) ? 1u : 0u; mine = (j == x) ? c : mine; }
        if (sum == G) break;
        __builtin_amdgcn_s_sleep(1);
        if ((++sp & 255u) == 0u) { if (xb_ld(&bar[XB_TMO])) break; if (sp > XB_SPIN_CAP) { atomicAdd(&bar[XB_TMO], 1u); break; } }
    }
    nloc = mine > 0u ? mine : 1u; nx = cnt > 0u ? cnt : 1u;
}
__device__ __forceinline__ void xcd_barrier(const XcdBarrier& b) {
    asm volatile("s_waitcnt vmcnt(0)" ::: "memory");
    __syncthreads();
    if (threadIdx.x == 0) {
        unsigned* bar = b.bar;
        __builtin_amdgcn_s_waitcnt(0);
        unsigned nloc = b.st[0], nx = b.st[1];
        if (nloc == 0u) { xcd_barrier_complete(bar, b.x, nloc, nx); b.st[0] = nloc; b.st[1] = nx; }
        const unsigned old = xb_add(&bar[XB_XSUB(b.x)], 1u);
        const unsigned gen = old / nloc;
        if (old + 1u == (gen + 1u) * nloc) {
            __builtin_amdgcn_fence(__ATOMIC_RELEASE, "agent");
            asm volatile("s_waitcnt vmcnt(0)" ::: "memory");
            const unsigned og = xb_add(&bar[XB_TOP], 1u);
            const unsigned tg = og / nx;
            if (og + 1u == (tg + 1u) * nx) xb_add(&bar[XB_TOPGEN], 1u);
            else XB_SPIN(xb_ld(&bar[XB_TOPGEN]) == tg, bar);
            __builtin_amdgcn_fence(__ATOMIC_ACQUIRE, "agent");
            xb_add(&bar[XB_XGEN(b.x)], 1u);
            asm volatile("s_waitcnt vmcnt(0)" ::: "memory");
        } else {
            XB_SPIN(xb_ld(&bar[XB_XGEN(b.x)]) == gen, bar);
            __builtin_amdgcn_fence(__ATOMIC_ACQUIRE, "agent");
            asm volatile("s_waitcnt vmcnt(0)" ::: "memory");
        }
    }
    __syncthreads();
}

struct Args { const void* in[28]; float* out; unsigned char* ws; int ph_lo, ph_hi, pad0, pad1; };
struct Frame {
    LAS unsigned char* lds; int tid, lane, wave, vcu, G;
    const float *x_p, *x_s, *c_p, *c_s, *ck_cmp, *cv_cmp, *ck_sel, *cv_sel; const int* page_table; const float *st_kw, *st_vw, *st_pool, *rel_bias, *ada_w, *ada_b, *norm_g, *final_g,
        *w_in, *w_out, *cmp_wk, *cmp_wv, *pe_k, *pe_v, *pool_w, *pool_scale, *ffn_wg, *ffn_wu, *ffn_wd;
    float* out; unsigned char* ws;
};
__device__ __forceinline__ float wave_sum(float v) {
#pragma unroll
    for (int o = 1; o < 64; o <<= 1) v += __shfl_xor(v, o);
    return v;
}

__device__ __forceinline__ void transpose_item(const float* W, int ldw, int nvalid, bf16_t* WT, int ldt, int drow0, LAS float* scr, int k0, int n0, int lane) {
    float tv[32];
#pragma unroll
    for (int i = 0; i < 32; ++i) { const int kk = 2 * i + (lane >> 5), n = n0 + (lane & 31); tv[i] = (n < nvalid) ? W[(size_t)(k0 + kk) * ldw + n] : 0.f; }
#pragma unroll
    for (int i = 0; i < 32; ++i) { const int kk = 2 * i + (lane >> 5); scr[kk * 33 + (lane & 31)] = tv[i]; }
    LDS_WAIT();
    const int c = lane & 7;
#pragma unroll
    for (int j = 0; j < 4; ++j) { const int n = (lane >> 3) + 8 * j; const LAS float* s = scr + (8 * c) * 33 + n;
        u32x4 o; o.x = cvtpk(s[0 * 33], s[1 * 33]); o.y = cvtpk(s[2 * 33], s[3 * 33]); o.z = cvtpk(s[4 * 33], s[5 * 33]); o.w = cvtpk(s[6 * 33], s[7 * 33]);
        *(u32x4*)(WT + (size_t)(drow0 + n) * ldt + k0 + 8 * c) = o; }
    LDS_WAIT();
}
__device__ __forceinline__ void p0_prologue(Frame& F) {
    LAS float* scr = (LAS float*)(F.lds + F.wave * 16384);
    const int gw = F.vcu * 8 + F.wave, NGW = F.G * 8, lane = F.lane;
    unsigned char* ws = F.ws;
    constexpr int I_IN = 16 * 88, I_OUT = 16 * 32, I_G = 16 * 88, I_D = 44 * 32, I_P = 4 * 8, I_C = 32 * 2;
    constexpr int NITEMS = I_IN + I_OUT + 4 * I_G + 2 * I_D + 4 * I_P + 2 * I_C;
    for (int it = gw; it < NITEMS; it += NGW) {
        int r = it;
        if (r < I_IN) { const int kb = r / 88, nb = r % 88; transpose_item(F.w_in, INCOLS, INCOLS, (bf16_t*)(ws + WS_WIN), D, nb * 32, scr, kb * 64, nb * 32, lane); continue; } r -= I_IN;
        if (r < I_OUT) { const int kb = r / 32, nb = r % 32; transpose_item(F.w_out, D, D, (bf16_t*)(ws + WS_WOUT), D, nb * 32, scr, kb * 64, nb * 32, lane); continue; } r -= I_OUT;
        if (r < 4 * I_G) { const int l = r / (2 * I_G), which = (r / I_G) & 1, q = r % I_G, kb = q / 88, nb = q % 88, n0 = nb * 32;
            const float* W = (which ? F.ffn_wu : F.ffn_wg) + (size_t)l * D * FF;
            transpose_item(W, FF, FF, (bf16_t*)(ws + WS_WGU) + (size_t)l * NGU * D, D, (n0 >> 7) * 256 + which * 128 + (n0 & 127), scr, kb * 64, n0, lane); continue; } r -= 4 * I_G;
        if (r < 2 * I_D) { const int l = r / I_D, q = r % I_D, kb = q / 32, nb = q % 32;
            transpose_item(F.ffn_wd + (size_t)l * FF * D, D, D, (bf16_t*)(ws + WS_WD) + (size_t)l * D * FF, FF, nb * 32, scr, kb * 64, nb * 32, lane); continue; } r -= 2 * I_D;
        if (r < 4 * I_P) { const int gI = r / I_P, q = r % I_P, kb = q / 8, nb = q % 8;
            transpose_item(F.pool_w + (size_t)gI * 65536, 256, 256, (bf16_t*)(ws + WS_WPOOL) + (size_t)gI * 65536, 256, nb * 32, scr, kb * 64, nb * 32, lane); continue; } r -= 4 * I_P;
        { const int which = r / I_C, q = r % I_C, kb = q / 2, nb = q % 2;
          transpose_item(which ? F.cmp_wv : F.cmp_wk, 64, 64, (bf16_t*)(ws + (which ? WS_WCV : WS_WCK)), 2048, nb * 32, scr, kb * 64, nb * 32, lane); }
    }
    { const int gt = (F.vcu * 8 + F.wave) * 64 + lane, NT = F.G * 512; bf16_t* sc = (bf16_t*)(ws + WS_SC);
      for (int i = gt; i < 144 * 512; i += NT) { const int row = i >> 9, c2 = (i & 511) * 2; float a = 0.f, b = 0.f;
          if (row < NMODB) { const float* cp = row < NB ? F.c_p + (size_t)row * D : F.c_s + (size_t)(row - NB) * D; const float x0 = cp[c2], x1 = cp[c2 + 1]; a = x0 * sigmoidf_(x0); b = x1 * sigmoidf_(x1); }
          *(unsigned*)(sc + (size_t)row * D + c2) = cvtpk(a, b); } }
    if (F.vcu < 16) { const int tsel = F.vcu >> 3, part = F.vcu & 7; const float* pe = tsel ? F.pe_v : F.pe_k; const float* W = tsel ? F.cmp_wv : F.cmp_wk; float sacc = 0.f;
        const int kb = part * 256 + F.wave * 32;
#pragma unroll
        for (int k = 0; k < 32; ++k) sacc += pe[kb + k] * W[(size_t)(kb + k) * 64 + lane];
        LAS float* red = (LAS float*)(F.lds + WSF_OFF);
        red[F.wave * 64 + lane] = sacc; LDS_WAIT(); __syncthreads();
        if (F.wave == 0) { float t2 = 0.f;
#pragma unroll
            for (int w = 0; w < 8; ++w) t2 += red[w * 64 + lane];
            ((float*)(ws + WS_CB))[(tsel * 8 + part) * 64 + lane] = t2; }
        __syncthreads(); }
    { const size_t gt = (size_t)(F.vcu * 8 + F.wave) * 64 + lane, NT = (size_t)F.G * 512;
      const size_t pp = (size_t)NSB * 11 * 256;
      for (size_t i = gt; i < pp; i += NT) { const size_t b = i / (11 * 256), rem = i % (11 * 256);
          ((f32x4*)(F.out + O_PLS + b * 15 * D))[rem] = ((const f32x4*)(F.st_pool + (b * 15 + 4) * D))[rem]; } }
}

__device__ __forceinline__ void p1_ada(Frame& F) {
    const int gw = F.vcu * 8 + F.wave, NGW = F.G * 8, lane = F.lane, fr = lane & 15, kq = lane >> 4;
    const bf16_t* sc = (const bf16_t*)(F.ws + WS_SC); float* mod = (float*)(F.ws + WS_MOD);
    for (int tile = F.wave < 3 ? F.vcu * 3 + F.wave : 768; tile < 768; tile += F.G * 3) {
        const int layer = tile / 384, n0 = (tile % 384) * 16;
        const float* W = F.ada_w + (size_t)layer * D * 6144 + n0 + fr;
        f32x4 acc[9];
#pragma unroll
        for (int i = 0; i < 9; ++i) acc[i] = (f32x4){0.f, 0.f, 0.f, 0.f};
#pragma unroll 4
        for (int k0 = 0; k0 < D; k0 += 32) {
            float w[8];
#pragma unroll
            for (int i = 0; i < 8; ++i) w[i] = W[(size_t)(k0 + 8 * kq + i) * 6144];
            u32x4 bw; bw.x = cvtpk(w[0], w[1]); bw.y = cvtpk(w[2], w[3]); bw.z = cvtpk(w[4], w[5]); bw.w = cvtpk(w[6], w[7]);
            const bf16x8 bfrag = __builtin_bit_cast(bf16x8, bw);
#pragma unroll
            for (int mt = 0; mt < 9; ++mt) { const bf16x8 af = *(const bf16x8*)(sc + (size_t)(mt * 16 + fr) * D + k0 + 8 * kq);
                acc[mt] = __builtin_amdgcn_mfma_f32_16x16x32_bf16(af, bfrag, acc[mt], 0, 0, 0); }
        }
        const float bias = F.ada_b[layer * 6144 + n0 + fr];
#pragma unroll
        for (int mt = 0; mt < 9; ++mt)
#pragma unroll
            for (int e = 0; e < 4; ++e) { const int row = mt * 16 + 4 * kq + e; if (row < NMODB) mod[((size_t)layer * NMODB + row) * 6144 + n0 + fr] = acc[mt][e] + bias; }
    }
}

__device__ __forceinline__ void p1_compress_sample(Frame& F) {
    const int lane = F.lane, wave = F.wave, r32 = lane & 31, hi = lane >> 5, kvl = lane >> 4, c4 = lane & 15;
    LAS unsigned char* L = F.lds;
    const int wrow = wave * 4 + kvl, total = 2 * NSB * 8;
    const int nitem = (total - F.vcu + F.G - 1) / F.G; if (nitem <= 0) return;
    const int nstage = 2 * nitem;
#define CS_BAR() do { asm volatile("s_waitcnt lgkmcnt(0)" ::: "memory"); __builtin_amdgcn_s_barrier(); asm volatile("" ::: "memory"); } while (0)
#define CS_SRC(g, ptr) do { const int it_ = F.vcu + F.G * ((g) >> 1); const int wh_ = it_ / (NSB * 8), q_ = it_ % (NSB * 8), b_ = q_ >> 3, n_ = (q_ & 7) * 8 + wave; const int pg_ = F.page_table[b_ * 16 + (n_ >> 2)]; \
        ptr = uniform_ptr((wh_ ? F.cv_cmp : F.ck_cmp) + ((size_t)pg_ * 128 + (n_ & 3) * 32 + ((g) & 1) * 16) * 256); } while (0)
#define CS_LOAD(ptr) do { _Pragma("unroll") for (int jj = 0; jj < 16; ++jj) x[jj] = *(const f32x4*)((ptr) + (unsigned)(jj * 1024 + lane * 16)); } while (0)
#define CS_STORE(buf) do { _Pragma("unroll") for (int jj = 0; jj < 16; ++jj) { u32x2 w_; w_.x = cvtpk(x[jj][0], x[jj][1]); w_.y = cvtpk(x[jj][2], x[jj][3]); \
        *(LAS u32x2*)(L + (buf) * 65536 + wrow * 2048 + (((jj * 8 + (c4 >> 1)) ^ (wrow & 15)) << 4) + (c4 & 1) * 8) = w_; } } while (0)
    f32x4 x[16]; const char* sp;
    CS_SRC(0, sp); CS_LOAD(sp); CS_STORE(0); CS_BAR();
    f32x16 a0, a1;
#pragma unroll
    for (int r = 0; r < 16; ++r) { a0[r] = 0.f; a1[r] = 0.f; }
#pragma unroll 1
    for (int g = 0; g < nstage; ++g) {
        const int it = F.vcu + F.G * (g >> 1), which = it / (NSB * 8), q = it % (NSB * 8), b = q >> 3, n0 = (q & 7) * 8;
        const bf16_t* wp = (const bf16_t*)(F.ws + (which ? WS_WCV : WS_WCK)) + (size_t)r32 * 2048 + (g & 1) * 1024 + 128 * wave + 8 * hi;
        bf16x8 bfr[16];
#pragma unroll
        for (int ks = 0; ks < 8; ++ks) { bfr[2 * ks] = *(const bf16x8*)(wp + 16 * ks); bfr[2 * ks + 1] = *(const bf16x8*)(wp + 32 * 2048 + 16 * ks); }
        if (g + 1 < nstage) { CS_SRC(g + 1, sp); CS_LOAD(sp); }
        const LAS unsigned char* ab = L + (g & 1) * 65536 + r32 * 2048;
#pragma unroll
        for (int ks = 0; ks < 8; ++ks) { const bf16x8 af = *(const LAS bf16x8*)(ab + (((16 * wave + 2 * ks + hi) ^ (r32 & 15)) << 4));
            a0 = __builtin_amdgcn_mfma_f32_32x32x16_bf16(af, bfr[2 * ks], a0, 0, 0, 0); a1 = __builtin_amdgcn_mfma_f32_32x32x16_bf16(af, bfr[2 * ks + 1], a1, 0, 0, 0); }
        CS_BAR();
        if (g & 1) {
            LAS float* red = (LAS float*)(L + 65536) + wave * 2048 + hi * 256 + r32;
#pragma unroll
            for (int r = 0; r < 16; ++r) { red[CROW0(r) * 64] = a0[r]; red[CROW0(r) * 64 + 32] = a1[r]; a0[r] = 0.f; a1[r] = 0.f; }
            CS_BAR();
            { const int row = F.tid >> 4, cc = (F.tid & 15) * 4; f32x4 sacc = (f32x4){0.f, 0.f, 0.f, 0.f};
#pragma unroll
              for (int pp = 0; pp < 8; ++pp) sacc = sacc + *(const f32x4*)((const float*)(F.ws + WS_CB) + (which * 8 + pp) * 64 + cc);
#pragma unroll
              for (int w = 0; w < 8; ++w) sacc = sacc + *(const LAS f32x4*)((const LAS float*)(L + 65536) + w * 2048 + row * 64 + cc);
              bf16_t* o = (bf16_t*)(F.ws + (which ? WS_VCMPS : WS_KCMPS)) + (size_t)b * 4 * 64 * 64 + ((size_t)(row & 3) * 64 + n0 + (row >> 2)) * 64 + cc;
              u32x2 w2; w2.x = cvtpk(sacc[0], sacc[1]); w2.y = cvtpk(sacc[2], sacc[3]); *(u32x2*)o = w2; }
        }
        if (g + 1 < nstage) CS_STORE((g + 1) & 1);
        CS_BAR();
    }
    VM_WAIT(); __syncthreads();
#undef CS_BAR
#undef CS_SRC
#undef CS_LOAD
#undef CS_STORE
}
__device__ __forceinline__ void p4_compress_prompt(Frame& F) {
    const int lane = F.lane, r32 = lane & 31, hi = lane >> 5, nl = r32 >> 2, kv = r32 & 3;
    for (int it = F.vcu; it < 2 * NB * 16; it += F.G) {
        const int which = it / (NB * 16), q = it % (NB * 16), b = q >> 4, n0 = (q & 15) * 8, n = n0 + nl;
        const bf16_t* src = (const bf16_t*)(F.ws + WS_KV) + (size_t)which * KV_STRIDE + ((size_t)b * SEQ + (size_t)n * 32) * 256 + kv * 64;
        const bf16_t* Wt = (const bf16_t*)(F.ws + (which ? WS_WCV : WS_WCK));
        const bf16_t* w0 = Wt + (size_t)r32 * 2048 + hi * 8; const bf16_t* w1 = w0 + (size_t)32 * 2048;
        f32x16 a0, a1;
#pragma unroll
        for (int r = 0; r < 16; ++r) { a0[r] = 0.f; a1[r] = 0.f; }
#pragma unroll
        for (int jj = 0; jj < 4; ++jj) { const int j = F.wave * 4 + jj;
#pragma unroll
            for (int ds = 0; ds < 4; ++ds) { const bf16x8 af = *(const bf16x8*)(src + (size_t)j * 256 + ds * 16 + hi * 8);
                const bf16x8 b0 = *(const bf16x8*)(w0 + j * 64 + ds * 16), b1 = *(const bf16x8*)(w1 + j * 64 + ds * 16);
                a0 = __builtin_amdgcn_mfma_f32_32x32x16_bf16(af, b0, a0, 0, 0, 0); a1 = __builtin_amdgcn_mfma_f32_32x32x16_bf16(af, b1, a1, 0, 0, 0); } }
        LAS float* red = (LAS float*)F.lds + F.wave * 2048 + hi * 256 + r32;
#pragma unroll
        for (int r = 0; r < 16; ++r) { red[CROW0(r) * 64] = a0[r]; red[CROW0(r) * 64 + 32] = a1[r]; }
        LDS_WAIT(); __syncthreads();
        { const int row = F.tid >> 4, c4 = (F.tid & 15) * 4; f32x4 sacc = (f32x4){0.f, 0.f, 0.f, 0.f};
#pragma unroll
          for (int pp = 0; pp < 8; ++pp) sacc = sacc + *(const f32x4*)((const float*)(F.ws + WS_CB) + (which * 8 + pp) * 64 + c4);
#pragma unroll
          for (int w = 0; w < 8; ++w) sacc = sacc + *(const LAS f32x4*)((const LAS float*)F.lds + w * 2048 + row * 64 + c4);
          bf16_t* o = (bf16_t*)(F.ws + (which ? WS_VCMPP : WS_KCMPP)) + (size_t)b * 4 * 128 * 64 + ((size_t)(row & 3) * 128 + n0 + (row >> 2)) * 64 + c4;
          u32x2 w2; w2.x = cvtpk(sacc[0], sacc[1]); w2.y = cvtpk(sacc[2], sacc[3]); *(u32x2*)o = w2; }
        __syncthreads();
    }
}

__device__ __forceinline__ void small_gemm_res(Frame& F, const bf16_t* A  , int lda, const bf16_t* Wt, int ldb, int K, bool bd, const float* xin_s, float* xout_s, const float* gate, const float* scale) {
    const int lane = F.lane, r32 = lane & 31, hi = lane >> 5, kw = K >> 3, kbeg = F.wave * kw;
    for (int tile = F.vcu; tile < 256; tile += F.G) {
        const int row0 = (tile >> 4) * 32, col0 = (tile & 15) * 64, acol = bd ? (col0 >> 8) * 256 : 0;
        const bf16_t* ap = A + (size_t)(row0 + r32) * lda + acol + kbeg + 8 * hi;
        const bf16_t* b0p = Wt + (size_t)(col0 + r32) * ldb + kbeg + 8 * hi; const bf16_t* b1p = b0p + (size_t)32 * ldb;
        f32x16 c0, c1;
#pragma unroll
        for (int r = 0; r < 16; ++r) { c0[r] = 0.f; c1[r] = 0.f; }
#pragma unroll 8
        for (int ks = 0; ks < kw; ks += 16) { const bf16x8 a = *(const bf16x8*)(ap + ks), b0 = *(const bf16x8*)(b0p + ks), b1 = *(const bf16x8*)(b1p + ks);
            c0 = __builtin_amdgcn_mfma_f32_32x32x16_bf16(a, b0, c0, 0, 0, 0); c1 = __builtin_amdgcn_mfma_f32_32x32x16_bf16(a, b1, c1, 0, 0, 0); }
        LAS float* red = (LAS float*)F.lds + F.wave * 2048 + hi * 256 + r32;
#pragma unroll
        for (int r = 0; r < 16; ++r) { red[CROW0(r) * 64] = c0[r]; red[CROW0(r) * 64 + 32] = c1[r]; }
        LDS_WAIT(); __syncthreads();
        { const int row = F.tid >> 4, c4 = (F.tid & 15) * 4; f32x4 sacc = (f32x4){0.f, 0.f, 0.f, 0.f};
#pragma unroll
          for (int w = 0; w < 8; ++w) sacc = sacc + *(const LAS f32x4*)((const LAS float*)F.lds + w * 2048 + row * 64 + c4);
          const int rs = row0 + row, col = col0 + c4, bb = NB + (rs >> 2);
          f32x4 g4 = *(const f32x4*)(gate + (size_t)bb * 6144 + col); if (scale) g4 = g4 * *(const f32x4*)(scale + col);
          const f32x4 x4 = *(const f32x4*)(xin_s + (size_t)rs * D + col); *(f32x4*)(xout_s + (size_t)rs * D + col) = x4 + g4 * sacc; }
        __syncthreads();
    }
}

template <int MODE, int NR>
__device__ __forceinline__ void norm_rows(Frame& F, bool from_inputs, int layer, int which, int row0, const f32x4 (&gg)[4], int lane) {
    const float* X = (const float*)(F.ws + WS_X);
    const float* xr = from_inputs ? (row0 < MP ? F.x_p + (size_t)row0 * D : F.x_s + (size_t)(row0 - MP) * D) : X + (size_t)row0 * D;
    f32x4 v[NR][4];
#pragma unroll
    for (int r = 0; r < NR; ++r)
#pragma unroll
        for (int j = 0; j < 4; ++j) v[r][j] = *(const f32x4*)(xr + (size_t)r * D + 4 * lane + 256 * j);
    f32x4 sh[4], sc[4];
    if constexpr (MODE != 2) {
        const int bb = row0 < MP ? (row0 >> 12) : NB + ((row0 - MP) >> 2);
        const float* mp = (const float*)(F.ws + WS_MOD) + ((size_t)layer * NMODB + bb) * 6144 + (which ? 3072 : 0);
#pragma unroll
        for (int j = 0; j < 4; ++j) { sh[j] = *(const f32x4*)(mp + 4 * lane + 256 * j); sc[j] = *(const f32x4*)(mp + 1024 + 4 * lane + 256 * j) + 1.0f; }
    }
    float ss[NR];
#pragma unroll
    for (int r = 0; r < NR; ++r) { float a = 0.f;
#pragma unroll
        for (int j = 0; j < 4; ++j) a += (v[r][j][0] * v[r][j][0] + v[r][j][1] * v[r][j][1]) + (v[r][j][2] * v[r][j][2] + v[r][j][3] * v[r][j][3]);
        ss[r] = a; }
#pragma unroll
    for (int o = 1; o < 64; o <<= 1) {
#pragma unroll
        for (int r = 0; r < NR; ++r) ss[r] += __shfl_xor(ss[r], o); }
#pragma unroll
    for (int r = 0; r < NR; ++r) {
        const int row = row0 + r; const float rstd = 1.0f / sqrtf(ss[r] * (1.0f / D) + 1e-6f);
        if constexpr (MODE == 2) {
            float* o = row < MP ? F.out + O_YP + (size_t)row * D : F.out + O_YS + (size_t)(row - MP) * D;
#pragma unroll
            for (int j = 0; j < 4; ++j) *(f32x4*)(o + 4 * lane + 256 * j) = v[r][j] * rstd * gg[j];
        } else {
            float* pool_dst = nullptr;
            if constexpr (MODE == 1) {
                if (row < MP) { const int tt = row & (SEQ - 1); if (tt >= SEQ - 15) pool_dst = F.out + O_PLP + ((size_t)(row >> 12) * 15 + (tt - (SEQ - 15))) * D; }
                else { const int rs = row - MP; pool_dst = F.out + O_PLS + ((size_t)(rs >> 2) * 15 + 11 + (rs & 3)) * D; }
            }
#pragma unroll
            for (int j = 0; j < 4; ++j) { const int col = 4 * lane + 256 * j; const f32x4 h = (v[r][j] * rstd * gg[j]) * sc[j] + sh[j];
                if constexpr (MODE == 0) { u32x2 w; w.x = cvtpk(h[0], h[1]); w.y = cvtpk(h[2], h[3]); *(u32x2*)((bf16_t*)(F.ws + WS_H) + (size_t)row * D + col) = w; }
                else { *(f32x4*)((float*)(F.ws + WS_HF) + (size_t)row * D + col) = h; if (pool_dst) *(f32x4*)(pool_dst + col) = h; } }
        }
    }
}
template <int MODE>
__device__ __forceinline__ void norm_phase(Frame& F, bool from_inputs, int layer, int which) {
    const int gw = F.vcu * 8 + F.wave, NGW = F.G * 8, lane = lane_id();
    const float* gvec = MODE == 2 ? F.final_g : F.norm_g + (size_t)(layer * 2 + which) * D;
    f32x4 gg[4];
#pragma unroll
    for (int j = 0; j < 4; ++j) gg[j] = *(const f32x4*)(gvec + 4 * lane + 256 * j);
#pragma unroll 1
    for (int grp = gw; grp < MP / 8; grp += NGW) norm_rows<MODE, 8>(F, from_inputs, layer, which, grp * 8, gg, lane);
#pragma unroll 1
    for (int r = gw; r < MS; r += NGW) norm_rows<MODE, 1>(F, from_inputs, layer, which, MP + r, gg, lane);
}

template <int W, int R, bool SAMPLE>
__device__ __forceinline__ void pool_chunk(const float* HF, const float* st_pool, bf16_t* H, int row0, int col) {
    f32x4 v[R + W - 1];
    const int t0 = SAMPLE ? 0 : (row0 & (SEQ - 1));
#pragma unroll
    for (int k = 0; k < R + W - 1; ++k) { const int tt = t0 - (W - 1) + k;
        if (SAMPLE) { const int b = (row0 - MP) >> 2; v[k] = tt >= 0 ? *(const f32x4*)(HF + (size_t)(row0 + tt) * D + col) : *(const f32x4*)(st_pool + ((size_t)b * 15 + 15 + tt) * D + col); }
        else v[k] = tt >= 0 ? *(const f32x4*)(HF + (size_t)(row0 - (W - 1) + k) * D + col) : (f32x4){0.f, 0.f, 0.f, 0.f}; }
    f32x4 sacc = v[0];
#pragma unroll
    for (int k = 1; k < W; ++k) sacc = sacc + v[k];
#pragma unroll
    for (int r = 0; r < R; ++r) {
        if (r > 0) sacc = sacc + v[r + W - 1] - v[r - 1];
        const int tt = t0 + r; const float inv = 1.0f / (float)(SAMPLE ? W : (tt + 1 < W ? tt + 1 : W));
        const f32x4 cur = v[r + W - 1], pv = sacc * inv - cur;
        u32x2 w2; w2.x = cvtpk(pv[0], pv[1]); w2.y = cvtpk(pv[2], pv[3]); *(u32x2*)(H + (size_t)(row0 + r) * D + col) = w2; }
}
__device__ __forceinline__ void pool_phase(Frame& F) {
    const int gt = (F.vcu * 8 + F.wave) * 64 + lane_id(), NT = F.G * 512;
    const float* HF = (const float*)(F.ws + WS_HF); bf16_t* H = (bf16_t*)(F.ws + WS_H);
    constexpr int NPI = (MP / 8) * 256, NSI = (MS / 4) * 256;
#pragma unroll 1
    for (int i = gt; i < NPI + NSI; i += NT) {
        const bool smp = i >= NPI; const int q = smp ? i - NPI : i; const int cg = q & 255, col = cg * 4, grp = cg >> 6;
        if (!smp) { const int row0 = (q >> 8) * 8;
            if (grp == 0) pool_chunk<2, 8, false>(HF, F.st_pool, H, row0, col); else if (grp == 1) pool_chunk<4, 8, false>(HF, F.st_pool, H, row0, col);
            else if (grp == 2) pool_chunk<8, 8, false>(HF, F.st_pool, H, row0, col); else pool_chunk<16, 8, false>(HF, F.st_pool, H, row0, col); }
        else { const int row0 = MP + (q >> 8) * 4;
            if (grp == 0) pool_chunk<2, 4, true>(HF, F.st_pool, H, row0, col); else if (grp == 1) pool_chunk<4, 4, true>(HF, F.st_pool, H, row0, col);
            else if (grp == 2) pool_chunk<8, 4, true>(HF, F.st_pool, H, row0, col); else pool_chunk<16, 4, true>(HF, F.st_pool, H, row0, col); }
    }
}

namespace att {
__device__ __forceinline__ int crow(int r, int hi) { return (r & 3) + 8 * (r >> 2) + 4 * hi; }
__device__ __forceinline__ float x32_sum(float v) { auto rr = __builtin_amdgcn_permlane32_swap(__float_as_uint(v), __float_as_uint(v), false, false); return __uint_as_float(rr[0]) + __uint_as_float(rr[1]); }
__device__ __forceinline__ float x32_max(float v) { auto rr = __builtin_amdgcn_permlane32_swap(__float_as_uint(v), __float_as_uint(v), false, false); return fmaxf(__uint_as_float(rr[0]), __uint_as_float(rr[1])); }
__device__ __forceinline__ unsigned x32_or(unsigned v) { auto rr = __builtin_amdgcn_permlane32_swap(v, v, false, false); return rr[0] | rr[1]; }
template <int X> __device__ __forceinline__ unsigned swz_xor(unsigned v) { return (unsigned)__builtin_amdgcn_ds_swizzle((int)v, (X << 10) | 0x1F); }
template <int X> __device__ __forceinline__ float swz_xorf(float v) { return __uint_as_float(swz_xor<X>(__float_as_uint(v))); }
__device__ __forceinline__ s16x4 vtr(const LAS unsigned char* p) { typedef short v4i16_t __attribute__((ext_vector_type(4))); return __builtin_bit_cast(s16x4, __builtin_amdgcn_ds_read_tr16_b64_v4i16((LAS v4i16_t*)p)); }
__device__ __forceinline__ void qk_tile(f32x16& p0, f32x16& p1, const LAS unsigned char* Kb, const bf16x8 (&qr)[4], float init, int r32, int hi) {
    f32x16 ci;
#pragma unroll
    for (int r = 0; r < 16; ++r) ci[r] = init;
    const int sw = (r32 >> 1) & 7;
    bf16x8 ka[4], kb[4];
#pragma unroll
    for (int ds = 0; ds < 4; ++ds) { const int ch = ((2 * ds + hi) ^ sw) << 4; ka[ds] = *(const LAS bf16x8*)(Kb + r32 * 128 + ch); kb[ds] = *(const LAS bf16x8*)(Kb + (32 + r32) * 128 + ch); }
    __builtin_amdgcn_s_setprio(1);
    f32x16 c0 = __builtin_amdgcn_mfma_f32_32x32x16_bf16(ka[0], qr[0], ci, 0, 0, 0);
    f32x16 c1 = __builtin_amdgcn_mfma_f32_32x32x16_bf16(kb[0], qr[0], ci, 0, 0, 0);
#pragma unroll
    for (int ds = 1; ds < 4; ++ds) {
        c0 = __builtin_amdgcn_mfma_f32_32x32x16_bf16(ka[ds], qr[ds], c0, 0, 0, 0);
        c1 = __builtin_amdgcn_mfma_f32_32x32x16_bf16(kb[ds], qr[ds], c1, 0, 0, 0);
    }
    __builtin_amdgcn_s_setprio(0);
    p0 = c0; p1 = c1;
}
__device__ __forceinline__ void pv_tile(f32x16 (&o)[2], const LAS unsigned char* Vb, const f32x16& p0, const f32x16& p1, int lane) {
    const int g4 = lane >> 4, nhalf = g4 & 1, h = g4 >> 1, i = lane & 15, q = i >> 2, pp = i & 3;
    const LAS unsigned char* vb = Vb + (4 * h + q) * 64 + nhalf * 32 + pp * 8;
#pragma unroll
    for (int kh = 0; kh < 2; ++kh) {
        s16x4 lo[2][2], hh[2][2];
#pragma unroll
        for (int s = 0; s < 2; ++s)
#pragma unroll
            for (int db = 0; db < 2; ++db) { lo[s][db] = vtr(vb + db * 4096 + (32 * kh + 16 * s) * 64); hh[s][db] = vtr(vb + db * 4096 + (32 * kh + 16 * s + 8) * 64); }
#pragma unroll
        for (int s = 0; s < 2; ++s) {
            const f32x16& p = kh ? p1 : p0; u32x4 pw;
            pw.x = cvtpk(p[8 * s + 0], p[8 * s + 1]); pw.y = cvtpk(p[8 * s + 2], p[8 * s + 3]); pw.z = cvtpk(p[8 * s + 4], p[8 * s + 5]); pw.w = cvtpk(p[8 * s + 6], p[8 * s + 7]);
            const bf16x8 pa = __builtin_bit_cast(bf16x8, pw);
#pragma unroll
            for (int db = 0; db < 2; ++db) {
                const bf16x8 vf = (bf16x8){lo[s][db][0], lo[s][db][1], lo[s][db][2], lo[s][db][3], hh[s][db][0], hh[s][db][1], hh[s][db][2], hh[s][db][3]};
                o[db] = __builtin_amdgcn_mfma_f32_32x32x16_bf16(pa, vf, o[db], 0, 0, 0);
            }
        }
    }
}
__device__ __forceinline__ void row_scale(f32x16 (&o)[2], float f, LAS float* wsf, int r32, int hi) {
    if (hi == 0) wsf[r32] = f;
    LDS_WAIT();
    const LAS float* wh = wsf + 4 * hi;
#pragma unroll
    for (int r = 0; r < 16; ++r) { const float fr = wh[CROW0(r)]; o[0][r] *= fr; o[1][r] *= fr; }
    LDS_WAIT();
}
__device__ __forceinline__ void row_fma(f32x16 (&dst)[2], const f32x16 (&o)[2], float f, LAS float* wsf, int r32, int hi) {
    if (hi == 0) wsf[r32] = f;
    LDS_WAIT();
    const LAS float* wh = wsf + 4 * hi;
#pragma unroll
    for (int r = 0; r < 16; ++r) { const float fr = wh[CROW0(r)]; dst[0][r] += fr * o[0][r]; dst[1][r] += fr * o[1][r]; }
    LDS_WAIT();
}
__device__ __forceinline__ void softmax_update(f32x16& p0, f32x16& p1, float& m, float& l, f32x16 (&o)[2], LAS float* wsf, int r32, int hi) {
    float rm = fmaxf(p0[0], p1[0]);
#pragma unroll
    for (int r = 1; r < 16; ++r) rm = fmaxf(rm, fmaxf(p0[r], p1[r]));
    rm = x32_max(rm);
    const float mn = fmaxf(m, rm), f = ex2(m - mn);
    m = mn; float s = 0.f;
#pragma unroll
    for (int r = 0; r < 16; ++r) { p0[r] = ex2(p0[r] - mn); p1[r] = ex2(p1[r] - mn); s += p0[r] + p1[r]; }
    l = l * f + s;
    if (__any(f != 1.0f)) row_scale(o, f, wsf, r32, hi);
}
__device__ __forceinline__ void softmax_full(f32x16& a0, f32x16& a1, f32x16& b0, f32x16& b1) {
    float rm = -1e30f;
#pragma unroll
    for (int r = 0; r < 16; ++r) rm = fmaxf(rm, fmaxf(fmaxf(a0[r], a1[r]), fmaxf(b0[r], b1[r])));
    rm = x32_max(rm); float s = 0.f;
#pragma unroll
    for (int r = 0; r < 16; ++r) { a0[r] = ex2(a0[r] - rm); a1[r] = ex2(a1[r] - rm); b0[r] = ex2(b0[r] - rm); b1[r] = ex2(b1[r] - rm); s += (a0[r] + a1[r]) + (b0[r] + b1[r]); }
    s = x32_sum(s);
    const float inv = s > 0.f ? 1.0f / s : 0.f;
#pragma unroll
    for (int r = 0; r < 16; ++r) { a0[r] *= inv; a1[r] *= inv; b0[r] *= inv; b1[r] *= inv; }
}
__device__ __forceinline__ unsigned imp_key(float v, int j, int c) {
    const bool forced = (j == 0) | (j == c) | (j == c - 1);
    const unsigned base = forced ? 0x7F000000u : (j <= c ? (__float_as_uint(v) & 0xFFFFFFC0u) : 0u);
    return base | (unsigned)(63 - j);
}
__device__ __forceinline__ void imp_store(const f32x16& p0, const f32x16& p1, int T, LAS unsigned* impq  , int c, int g, int hi) {
#pragma unroll
    for (int kh = 0; kh < 2; ++kh)
#pragma unroll
        for (int a = 0; a < 4; ++a) {
            const f32x16& p = kh ? p1 : p0; float e0 = p[4 * a] + p[4 * a + 1], e1 = p[4 * a + 2] + p[4 * a + 3];
            e0 += swz_xorf<8>(e0); e0 += swz_xorf<16>(e0); e1 += swz_xorf<8>(e1); e1 += swz_xorf<16>(e1);
            const int jc = 32 * T + 16 * kh + 4 * a, j0 = jc + 2 * hi;
            if (g == 0) { u32x2 w; w.x = imp_key(e0, j0, c); w.y = imp_key(e1, j0 + 1, c); *(LAS u32x2*)(impq + 2 * hi + jc) = w; }
        }
}
__device__ __forceinline__ unsigned long long select_mask(const LAS unsigned* impq, int g, int hi, int nq4 = 16) {
    LDS_WAIT();
    unsigned mk[8], cnt[8];
#pragma unroll
    for (int a = 0; a < 4; ++a) { const u32x2 w = *(const LAS u32x2*)(impq + (16 * g + 2 * hi) + 4 * a); mk[2 * a] = w.x; mk[2 * a + 1] = w.y; cnt[2 * a] = 0; cnt[2 * a + 1] = 0; }
#pragma unroll 4
    for (int jj = 0; jj < nq4; ++jj) { const u32x4 kx = *(const LAS u32x4*)(impq + 4 * jj);
#pragma unroll
        for (int ci = 0; ci < 8; ++ci) cnt[ci] += (unsigned)(kx.x > mk[ci]) + (unsigned)(kx.y > mk[ci]) + (unsigned)(kx.z > mk[ci]) + (unsigned)(kx.w > mk[ci]); }
    unsigned lb = 0u;
#pragma unroll
    for (int a = 0; a < 4; ++a)
#pragma unroll
        for (int e = 0; e < 2; ++e) lb |= (cnt[2 * a + e] < 16u ? 1u : 0u) << (4 * a + e);
    const unsigned long long mm = (unsigned long long)lb << (16 * g + 2 * hi);
    unsigned lo = (unsigned)mm, hh = (unsigned)(mm >> 32);
    lo |= swz_xor<8>(lo); hh |= swz_xor<8>(hh); lo |= swz_xor<16>(lo); hh |= swz_xor<16>(hh); lo = x32_or(lo); hh = x32_or(hh);
    return ((unsigned long long)hh << 32) | lo;
}
__device__ __forceinline__ unsigned long long wave_or64(unsigned long long m) {
    unsigned lo = (unsigned)m, hh = (unsigned)(m >> 32);
    lo |= swz_xor<1>(lo); hh |= swz_xor<1>(hh); lo |= swz_xor<2>(lo); hh |= swz_xor<2>(hh); lo |= swz_xor<4>(lo); hh |= swz_xor<4>(hh);
    lo |= swz_xor<8>(lo); hh |= swz_xor<8>(hh); lo |= swz_xor<16>(lo); hh |= swz_xor<16>(hh); lo = x32_or(lo); hh = x32_or(hh);
    return ((unsigned long long)(unsigned)__builtin_amdgcn_readfirstlane(hh) << 32) | (unsigned)__builtin_amdgcn_readfirstlane(lo);
}
__device__ __forceinline__ void mask_bias(f32x16& p0, f32x16& p1, int t, int pos0, int stride, int wlim, bool sel, bool near, const LAS float* lut, int hi) {
#pragma unroll
    for (int kh = 0; kh < 2; ++kh)
#pragma unroll
        for (int r = 0; r < 16; ++r) { const int kk = 32 * kh + crow(r, hi), dist = t - pos0 - stride * kk; const bool ok = sel && dist >= 0 && dist < wlim;
            float bv = 0.f; if (near) { const int di = dist < 0 ? 0 : (dist > 127 ? 127 : dist); bv = lut[di]; }
            if (kh) p1[r] = ok ? p1[r] + bv : -INFINITY; else p0[r] = ok ? p0[r] + bv : -INFINITY; }
}
template <bool CAUSAL>
__device__ __forceinline__ void mask_bias_near(f32x16& p0, f32x16& p1, int t, int pos0, bool sel, const LAS float* xlg, int hi) {
    const int dist0 = t - pos0 - 4 * hi;
    const LAS float* bp = xlg + (dist0 + 4);
#pragma unroll
    for (int kh = 0; kh < 2; ++kh)
#pragma unroll
        for (int r = 0; r < 16; ++r) { const int kc = 32 * kh + CROW0(r); const float bv = bp[63 - kc]; bool ok = sel; if (CAUSAL) ok = ok && (dist0 - kc >= 0);
            if (kh) p1[r] = ok ? p1[r] + bv : -INFINITY; else p0[r] = ok ? p0[r] + bv : -INFINITY; }
}
struct Ptrs { const bf16_t *Q, *kcp, *vcp, *kcs, *vcs, *KS, *VS, *KW, *VW; const float* gates; bf16_t* O; const float *ck_sel, *cv_sel, *st_kw, *st_vw; const int* pt; int gov; float* kw_out; float* vw_out; };
#ifdef VERIFY
#define GATEV(P, row, head, br) ((P).gov < 0 ? sigmoidf_((P).gates[(size_t)(row) * 48 + (head) * 3 + (br)]) : ((P).gov == (br) ? 1.0f : 0.0f))
#else
#define GATEV(P, row, head, br) sigmoidf_((P).gates[(size_t)(row) * 48 + (head) * 3 + (br)])
#endif

template <bool ACC>
__device__ __forceinline__ void row_out(LAS float* ow, const f32x16 (&o)[2], float f, LAS float* wsf, int r32, int hi) {
    if (hi == 0) wsf[r32] = f;
    LDS_WAIT();
    const LAS float* wh = wsf + 4 * hi; LAS float* ob = ow + hi * 256 + r32;
#pragma unroll
    for (int r = 0; r < 16; ++r) { const float fr = wh[CROW0(r)]; LAS float* p = ob + CROW0(r) * 64;
        if (ACC) { p[0] += fr * o[0][r]; p[32] += fr * o[1][r]; } else { p[0] = fr * o[0][r]; p[32] = fr * o[1][r]; } }
    LDS_WAIT();
}
template <bool NEXT>
__device__ __forceinline__ void tile_block(f32x16& s0, f32x16& s1, f32x16& n0, f32x16& n1, const LAS unsigned char* KBn, float ninit, const LAS unsigned char* VB, const bf16x8 (&qr)[4],
                                           float m, float& l, f32x16 (&o)[2], int lane, int r32, int hi) {
    if (NEXT) qk_tile(n0, n1, KBn, qr, ninit, r32, hi);
    float sacc = 0.f;
#pragma unroll
    for (int r = 0; r < 16; ++r) { s0[r] = ex2(s0[r] - m); s1[r] = ex2(s1[r] - m); sacc += s0[r] + s1[r]; }
    l += sacc;
    pv_tile(o, VB, s0, s1, lane);
}
#define AS_SBAR() __builtin_amdgcn_sched_barrier(0)
#define AS_PIN(x) asm volatile("" : "+v"(x))
#define AS_MFMA(a, b, c) __builtin_amdgcn_mfma_f32_32x32x16_bf16(a, b, c, 0, 0, 0)
#define AS_WAIT_BAR(N) asm volatile("s_waitcnt vmcnt(" #N ") lgkmcnt(0)\n\ts_barrier" ::: "memory")
#define AS_MX3(a, b, c) __builtin_fmaxf(__builtin_fmaxf((a), (b)), (c))
__device__ __forceinline__ void as_glds16(const void* gsrc, unsigned lds_base) {
    unsigned sv; asm volatile("s_mov_b32 %0, m0\n\ts_mov_b32 m0, %2\n\ts_nop 0\n\tglobal_load_lds_dwordx4 %1, off\n\ts_mov_b32 m0, %0" : "=&s"(sv) : "v"(gsrc), "s"(lds_base) : "memory"); }
__device__ __forceinline__ void as_kload2(bf16x8* kf, const LAS unsigned char* kp, int d0) { kf[2 * d0] = *(const LAS bf16x8*)(kp + d0 * 2048); kf[2 * d0 + 1] = *(const LAS bf16x8*)(kp + d0 * 2048 + 512); }
__device__ __forceinline__ float as_rowmax(const f32x16& p0, const f32x16& p1) {
    float a = AS_MX3(p0[0], p0[1], p1[0]), b = AS_MX3(p0[2], p0[3], p1[1]); a = AS_MX3(a, p1[2], p1[3]);
#pragma unroll
    for (int r = 4; r < 16; r += 4) { a = AS_MX3(a, p0[r], p0[r + 1]); b = AS_MX3(b, p0[r + 2], p0[r + 3]); a = AS_MX3(a, p1[r], p1[r + 1]); b = AS_MX3(b, p1[r + 2], p1[r + 3]); }
    return x32_max(__builtin_fmaxf(a, b)); }
template <bool WIN>
__device__ __forceinline__ float as_mask(f32x16& c0, f32x16& c1, int u, int j0, int nreal, int c, int t, unsigned long long mymask, float bfar, const LAS float* xlg, const LAS float* lut, int hi) {
    const int j = j0 + u;
    if (u >= nreal) {
#pragma unroll
        for (int r = 0; r < 16; ++r) { c0[r] = -INFINITY; c1[r] = -INFINITY; }
        return 0.f; }
    const bool sel = WIN || ((mymask >> j) & 1ull);
    if (j >= c - 2) { if (j == c) mask_bias_near<true>(c0, c1, t, 64 * j, sel, xlg, hi); else mask_bias_near<false>(c0, c1, t, 64 * j, sel, xlg, hi); return 0.f; }
    if (WIN) { if (j == c - 8) mask_bias(c0, c1, t, 64 * j, 1, 512, true, false, lut, hi); }
    else {
#pragma unroll
        for (int r = 0; r < 16; ++r) { c0[r] = sel ? c0[r] : -INFINITY; c1[r] = sel ? c1[r] : -INFINITY; } }
    return bfar;
}
template <bool WIN, bool ACC>
__device__ __forceinline__ void attn_stream(const bf16_t* kbase  , const bf16_t* vbase, int j0, int nreal, int NT, int c, int t, unsigned long long mymask,
                                            const bf16x8 (&qr)[4], float bfar, const LAS float* xlg, const LAS float* lut, float gate, LAS unsigned char* L, LAS float* wsf, LAS float* ow, int wave, int lane) {
    constexpr int SLOTB = 8192, LDS_K = 0, LDS_V = 3 * SLOTB;
    const int r32 = lane & 31, hi = lane >> 5;
    const unsigned lds0 = (unsigned)(unsigned long long)L;
    const int jlast = j0 + nreal - 1;
    const bf16_t* ksrc = kbase + (size_t)lane * 256 + wave * 8;
    const bf16_t* vsrc = vbase + (size_t)(16 * (wave & 3) + (lane >> 2)) * 256 + (wave >> 2) * 32 + (lane & 3) * 8;
    const unsigned kdst = lds0 + LDS_K + wave * 1024, vdst = lds0 + LDS_V + wave * 1024;
#define AS_JT(u) ((j0 + (u)) > jlast ? jlast : (j0 + (u)))
#define AS_DMA_K(u, slot) as_glds16(ksrc + (size_t)AS_JT(u) * (64 * 256), (unsigned)__builtin_amdgcn_readfirstlane((int)(kdst + (slot))))
#define AS_DMA_V(u, slot) as_glds16(vsrc + (size_t)AS_JT(u) * (64 * 256), (unsigned)__builtin_amdgcn_readfirstlane((int)(vdst + (slot))))
    const LAS unsigned char* vp0 = L + LDS_V + ((lane >> 4) & 1) * 32 + (lane & 3) * 8 + (4 * hi + ((lane & 15) >> 2)) * 64;
    const LAS unsigned char* kp0 = L + LDS_K + hi * 1024 + r32 * 16;
    AS_DMA_K(0, 0); AS_DMA_V(0, 0); AS_DMA_K(1, SLOTB); AS_DMA_K(2, 2 * SLOTB);
    float mhat = 0.f, l_reg = 0.f; f32x16 o[2];
#pragma unroll
    for (int r = 0; r < 16; ++r) { o[0][r] = 0.f; o[1][r] = 0.f; }
    const f32x16 zero16 = {0.f, 0.f, 0.f, 0.f, 0.f, 0.f, 0.f, 0.f, 0.f, 0.f, 0.f, 0.f, 0.f, 0.f, 0.f, 0.f};
    bool resc = false;
    f32x16 pA0, pA1, pB0, pB1; bf16x8 kf[8]; s16x4 vlo[8], vhi[8]; u32x4 pw0, pw1, pw2, pw3;
    int sl_prev = 0, sl_cur = 0, sl_next = SLOTB;
#define AS_ROT() do { sl_prev = sl_cur; sl_cur = sl_next; sl_next = (sl_next == 2 * SLOTB) ? 0 : sl_next + SLOTB; } while (0)
#define AS_EX(v) __builtin_amdgcn_exp2f((v) + nmh)
#define AS_RESC() do { if (resc) { const LAS float* wh_ = wsf + 4 * hi; _Pragma("unroll") for (int d_ = 0; d_ < 2; ++d_) _Pragma("unroll") for (int r = 0; r < 16; ++r) o[d_][r] *= wh_[CROW0(r)]; } } while (0)
    AS_WAIT_BAR(3);
#pragma unroll
    for (int d0 = 0; d0 < 4; ++d0) as_kload2(kf, kp0, d0);
    pA0 = AS_MFMA(kf[0], qr[0], zero16); pA1 = AS_MFMA(kf[1], qr[0], zero16); pA0 = AS_MFMA(kf[2], qr[1], pA0); pA1 = AS_MFMA(kf[3], qr[1], pA1);
    pA0 = AS_MFMA(kf[4], qr[2], pA0); pA1 = AS_MFMA(kf[5], qr[2], pA1); pA0 = AS_MFMA(kf[6], qr[3], pA0); pA1 = AS_MFMA(kf[7], qr[3], pA1);
    { const float bc = as_mask<WIN>(pA0, pA1, 0, j0, nreal, c, t, mymask, bfar, xlg, lut, hi);
      const float rm = as_rowmax(pA0, pA1) + bc; mhat = __builtin_fmaxf(rm, -60.f); const float nmh = bc - mhat;
#pragma unroll
      for (int r = 0; r < 16; ++r) { pA0[r] = AS_EX(pA0[r]); pA1[r] = AS_EX(pA1[r]); } }
    AS_WAIT_BAR(0);
    AS_DMA_K(3, 0); AS_DMA_V(1, SLOTB); AS_ROT();
#pragma unroll
    for (int d0 = 0; d0 < 4; ++d0) as_kload2(kf, kp0 + sl_cur, d0);
    AS_WAIT_BAR(2);
#define AS_PKW(P, i) cvtpk(P[i], P[i + 1])
#define AS_PAF(k) __builtin_bit_cast(bf16x8, pw##k)
#define AS_VFR(i) (bf16x8){vlo[i][0], vlo[i][1], vlo[i][2], vlo[i][3], vhi[i][0], vhi[i][1], vhi[i][2], vhi[i][3]}
#define AS_VRD(i) do { vlo[i] = vtr(vp_ + (((i) >> 2) * 4096 + ((i) & 3) * 1024)); vhi[i] = vtr(vp_ + (((i) >> 2) * 4096 + ((i) & 3) * 1024 + 512)); } while (0)
#define AS_KRD(G, d0) do { if (G) { as_kload2(kf, kp0 + sl_next, d0); AS_SBAR(); } } while (0)
#define AS_GAPA(MF, a0, a1, a2, a3, W0, W1, PW) do { MF; sacc += a0; sacc += a1; sacc += a2; sacc += a3; W0; W1; AS_PIN(PW); AS_PIN(sacc); AS_SBAR(); } while (0)
#define AS_GAPB(MF, X, i) do { MF; X[i] = AS_EX(X[i]); X[i + 1] = AS_EX(X[i + 1]); X[i + 2] = AS_EX(X[i + 2]); X[i + 3] = AS_EX(X[i + 3]); AS_PIN(X); AS_SBAR(); } while (0)
#define AS_STEP(C0, C1, P0, P1, tt, MASK, GK, GV, GL) do { AS_SBAR(); \
    const LAS unsigned char* vp_ = vp0 + sl_prev; \
    AS_VRD(0); AS_SBAR(); float sacc = P0[0] + P0[1]; \
                    AS_GAPA(C0 = AS_MFMA(kf[0], qr[0], zero16), P0[2], P0[3], P0[4], P0[5],     pw0[0] = AS_PKW(P0, 0),  pw0[1] = AS_PKW(P0, 2),  pw0); \
    AS_VRD(4); AS_SBAR(); AS_GAPA(C1 = AS_MFMA(kf[1], qr[0], zero16), P0[6], P0[7], P0[8], P0[9],     pw0[2] = AS_PKW(P0, 4),  pw0[3] = AS_PKW(P0, 6),  pw0); \
    AS_VRD(1); AS_SBAR(); AS_GAPA(C0 = AS_MFMA(kf[2], qr[1], C0),    P0[10], P0[11], P0[12], P0[13], pw1[0] = AS_PKW(P0, 8),  pw1[1] = AS_PKW(P0, 10), pw1); \
    AS_VRD(5); AS_SBAR(); AS_GAPA(C1 = AS_MFMA(kf[3], qr[1], C1),    P0[14], P0[15], P1[0], P1[1],   pw1[2] = AS_PKW(P0, 12), pw1[3] = AS_PKW(P0, 14), pw1); \
    AS_VRD(2); AS_SBAR(); AS_GAPA(C0 = AS_MFMA(kf[4], qr[2], C0),    P1[2], P1[3], P1[4], P1[5],     pw2[0] = AS_PKW(P1, 0),  pw2[1] = AS_PKW(P1, 2),  pw2); \
    AS_VRD(6); AS_SBAR(); AS_GAPA(C1 = AS_MFMA(kf[5], qr[2], C1),    P1[6], P1[7], P1[8], P1[9],     pw2[2] = AS_PKW(P1, 4),  pw2[3] = AS_PKW(P1, 6),  pw2); \
    AS_VRD(3); AS_SBAR(); AS_GAPA(C0 = AS_MFMA(kf[6], qr[3], C0),    P1[10], P1[11], P1[12], P1[13], pw3[0] = AS_PKW(P1, 8),  pw3[1] = AS_PKW(P1, 10), pw3); \
    AS_VRD(7); AS_SBAR(); AS_GAPA(C1 = AS_MFMA(kf[7], qr[3], C1),    P1[14], P1[15], 0.f, 0.f,       pw3[2] = AS_PKW(P1, 12), pw3[3] = AS_PKW(P1, 14), pw3); \
    l_reg += sacc; \
    if (GK) AS_DMA_K((tt) + 3, sl_cur); if (GV) AS_DMA_V((tt) + 1, sl_next); \
    float bc_ = bfar; bool sel_ = true; \
    if (MASK) bc_ = as_mask<WIN>(C0, C1, (tt), j0, nreal, c, t, mymask, bfar, xlg, lut, hi); \
    else if (!WIN) sel_ = (mymask >> (j0 + (tt))) & 1ull;            \
    { const float rm = as_rowmax(C0, C1) + bc_ - mhat; resc = false; \
      if (__builtin_expect(__any(rm > 8.0f), 0)) { const float dl = __builtin_fmaxf(rm, 0.f); mhat += dl; \
          const float f = __builtin_amdgcn_exp2f(-dl); l_reg *= f; if (hi == 0) wsf[r32] = f; resc = true; } } \
    const float nmh = sel_ ? bc_ - mhat : -INFINITY; AS_SBAR(); \
    AS_GAPB(o[0] = AS_MFMA(AS_PAF(0), AS_VFR(0), o[0]), C0, 0);              AS_GAPB(o[1] = AS_MFMA(AS_PAF(0), AS_VFR(4), o[1]), C0, 4); \
    AS_KRD(GL, 0); AS_GAPB(o[0] = AS_MFMA(AS_PAF(1), AS_VFR(1), o[0]), C0, 8);  AS_KRD(GL, 1); AS_GAPB(o[1] = AS_MFMA(AS_PAF(1), AS_VFR(5), o[1]), C0, 12); \
    AS_KRD(GL, 2); AS_GAPB(o[0] = AS_MFMA(AS_PAF(2), AS_VFR(2), o[0]), C1, 0);  AS_KRD(GL, 3); AS_GAPB(o[1] = AS_MFMA(AS_PAF(2), AS_VFR(6), o[1]), C1, 4); \
    AS_GAPB(o[0] = AS_MFMA(AS_PAF(3), AS_VFR(3), o[0]), C1, 8);              AS_GAPB(o[1] = AS_MFMA(AS_PAF(3), AS_VFR(7), o[1]), C1, 12); \
    } while (0)
    int tt = 1;
    for (; tt + 5 < NT; tt += 2) {
        AS_STEP(pB0, pB1, pA0, pA1, tt, false, true, true, true);     AS_WAIT_BAR(2); AS_RESC(); AS_ROT();
        AS_STEP(pA0, pA1, pB0, pB1, tt + 1, false, true, true, true); AS_WAIT_BAR(2); AS_RESC(); AS_ROT();
    }
#define AS_ENDW(x) do { if ((x) + 3 < NT) { AS_WAIT_BAR(2); } else if ((x) + 2 < NT) { AS_WAIT_BAR(1); } else { AS_WAIT_BAR(0); } } while (0)
    for (; tt + 1 < NT; tt += 2) {
        AS_STEP(pB0, pB1, pA0, pA1, tt, true, (tt + 3 < NT), (tt + 1 < NT), (tt + 1 < NT));         AS_ENDW(tt);     AS_RESC(); AS_ROT();
        AS_STEP(pA0, pA1, pB0, pB1, tt + 1, true, (tt + 4 < NT), (tt + 2 < NT), (tt + 2 < NT));     AS_ENDW(tt + 1); AS_RESC(); AS_ROT();
    }
    AS_STEP(pB0, pB1, pA0, pA1, NT - 1, true, false, false, false); AS_RESC();
    { float sacc = pB0[0] + pB0[1];
#pragma unroll
      for (int r = 2; r < 16; ++r) sacc += pB0[r];
#pragma unroll
      for (int r = 0; r < 16; ++r) sacc += pB1[r];
      l_reg += sacc;
      pw0 = (u32x4){AS_PKW(pB0, 0), AS_PKW(pB0, 2), AS_PKW(pB0, 4), AS_PKW(pB0, 6)}; pw1 = (u32x4){AS_PKW(pB0, 8), AS_PKW(pB0, 10), AS_PKW(pB0, 12), AS_PKW(pB0, 14)};
      pw2 = (u32x4){AS_PKW(pB1, 0), AS_PKW(pB1, 2), AS_PKW(pB1, 4), AS_PKW(pB1, 6)}; pw3 = (u32x4){AS_PKW(pB1, 8), AS_PKW(pB1, 10), AS_PKW(pB1, 12), AS_PKW(pB1, 14)};
      const LAS unsigned char* vp_ = vp0 + sl_cur;
#pragma unroll
      for (int i = 0; i < 8; ++i) AS_VRD(i);
      o[0] = AS_MFMA(AS_PAF(0), AS_VFR(0), o[0]); o[1] = AS_MFMA(AS_PAF(0), AS_VFR(4), o[1]); o[0] = AS_MFMA(AS_PAF(1), AS_VFR(1), o[0]); o[1] = AS_MFMA(AS_PAF(1), AS_VFR(5), o[1]);
      o[0] = AS_MFMA(AS_PAF(2), AS_VFR(2), o[0]); o[1] = AS_MFMA(AS_PAF(2), AS_VFR(6), o[1]); o[0] = AS_MFMA(AS_PAF(3), AS_VFR(3), o[0]); o[1] = AS_MFMA(AS_PAF(3), AS_VFR(7), o[1]); }
    { const float lt = x32_sum(l_reg); const float f = lt > 0.f ? gate / lt : 0.f; row_out<ACC>(ow, o, f, wsf, r32, hi); }
    asm volatile("s_waitcnt lgkmcnt(0)\n\ts_barrier" ::: "memory");
#undef AS_JT
#undef AS_DMA_K
#undef AS_DMA_V
#undef AS_ROT
#undef AS_EX
#undef AS_RESC
#undef AS_PKW
#undef AS_PAF
#undef AS_VFR
#undef AS_VRD
#undef AS_KRD
#undef AS_GAPA
#undef AS_GAPB
#undef AS_STEP
#undef AS_ENDW
}

__device__ __forceinline__ void prompt_unit(const Ptrs& P, LAS unsigned char* L, int b, int kv, int c, int tid, int wave, int lane) {
    asm volatile("" : "+v"(lane), "+v"(tid));
    const int r32 = lane & 31, hi = lane >> 5, g = r32 >> 3, qi = r32 & 7, head = kv * 4 + g;
    const int t = c * 64 + wave * 8 + qi; const unsigned row = (unsigned)b * SEQ + t;
    bf16x8 qr[4];
#pragma unroll
    for (int ds = 0; ds < 4; ++ds) qr[ds] = *(const bf16x8*)(P.Q + (size_t)row * D + head * 64 + ds * 16 + hi * 8);
    const LAS float* lut = (const LAS float*)(L + LUT_OFF) + head * 128; const float bfar = lut[127];
    LAS float* wsf = (LAS float*)(L + WSF_OFF) + wave * 32;
    LAS float* ow = (LAS float*)(L + 65536 + wave * 8192);
    LAS unsigned* impq = (LAS unsigned*)(L + IMP_OFF) + wave * 512 + qi * 64;
    const int skey = tid >> 3, sch = tid & 7;
    const int kwoff = skey * 128 + ((sch ^ ((skey >> 1) & 7)) << 4), vwoff = (sch >> 2) * 4096 + skey * 64 + (sch & 3) * 16;
    LAS unsigned char* KB0 = L; LAS unsigned char* VB0 = L + 32768;
    { const unsigned co = ((unsigned)(b * 4 + kv) * 128 + skey) * 64 + sch * 8;
      const u32x4 k0 = *(const u32x4*)(P.kcp + co), k1 = *(const u32x4*)(P.kcp + co + 4096), v0 = *(const u32x4*)(P.vcp + co), v1 = *(const u32x4*)(P.vcp + co + 4096);
      *(LAS u32x4*)(KB0 + kwoff) = k0; *(LAS u32x4*)(KB0 + 8192 + kwoff) = k1; *(LAS u32x4*)(VB0 + vwoff) = v0; *(LAS u32x4*)(VB0 + 8192 + vwoff) = v1; }
    const int nwin = (c < 8 ? c : 8) + 1;
    __syncthreads();
    f32x16 o[2];
#pragma unroll
    for (int r = 0; r < 16; ++r) { o[0][r] = 0.f; o[1][r] = 0.f; }
    unsigned long long mymask = ~0ull;
    if (c <= 30) {
        f32x16 a0, a1; qk_tile(a0, a1, KB0, qr, 0.f, r32, hi); mask_bias(a0, a1, t, 31, 32, 1 << 30, true, true, lut, hi);
        float rm = fmaxf(a0[0], a1[0]);
#pragma unroll
        for (int r = 1; r < 16; ++r) rm = fmaxf(rm, fmaxf(a0[r], a1[r]));
        rm = fmaxf(x32_max(rm), -1e30f); float sacc = 0.f;
#pragma unroll
        for (int r = 0; r < 16; ++r) { a0[r] = ex2(a0[r] - rm); a1[r] = ex2(a1[r] - rm); sacc += a0[r] + a1[r]; }
        sacc = x32_sum(sacc); const float cinv = sacc > 0.f ? 1.0f / sacc : 0.f;
#pragma unroll
        for (int r = 0; r < 16; ++r) { a0[r] *= cinv; a1[r] *= cinv; }
        if (c >= 16) { imp_store(a0, a1, 0, impq, c, g, hi);
            if (g == 0) {
#pragma unroll
                for (int q8 = 0; q8 < 8; ++q8) { const int jc = 32 + 4 * q8; u32x2 w; w.x = imp_key(0.f, jc + 2 * hi, c); w.y = imp_key(0.f, jc + 2 * hi + 1, c); *(LAS u32x2*)(impq + 2 * hi + jc) = w; } } }
        pv_tile(o, VB0, a0, a1, lane);
    } else {
        f32x16 a0, a1, b0, b1;
        qk_tile(a0, a1, KB0, qr, 0.f, r32, hi); mask_bias(a0, a1, t, 31, 32, 1 << 30, true, true, lut, hi);
        qk_tile(b0, b1, KB0 + 8192, qr, 0.f, r32, hi); mask_bias(b0, b1, t, 31 + 2048, 32, 1 << 30, true, true, lut, hi);
        float rm = fmaxf(fmaxf(a0[0], a1[0]), fmaxf(b0[0], b1[0]));
#pragma unroll
        for (int r = 1; r < 16; ++r) rm = fmaxf(rm, fmaxf(fmaxf(a0[r], a1[r]), fmaxf(b0[r], b1[r])));
        rm = fmaxf(x32_max(rm), -1e30f); float sacc = 0.f;
#pragma unroll
        for (int r = 0; r < 16; ++r) { a0[r] = ex2(a0[r] - rm); a1[r] = ex2(a1[r] - rm); b0[r] = ex2(b0[r] - rm); b1[r] = ex2(b1[r] - rm); sacc += (a0[r] + a1[r]) + (b0[r] + b1[r]); }
        sacc = x32_sum(sacc); const float cinv = sacc > 0.f ? 1.0f / sacc : 0.f;
#pragma unroll
        for (int r = 0; r < 16; ++r) { a0[r] *= cinv; a1[r] *= cinv; b0[r] *= cinv; b1[r] *= cinv; }
        imp_store(a0, a1, 0, impq, c, g, hi); imp_store(b0, b1, 1, impq, c, g, hi);
        pv_tile(o, VB0, a0, a1, lane); pv_tile(o, VB0 + 8192, b0, b1, lane);
    }
    { const float g0 = GATEV(P, row, head, 0); row_out<false>(ow, o, g0, wsf, r32, hi); }
    if (c >= 16) mymask = select_mask(impq, g, hi, (c + 4) >> 2);
    __syncthreads();
    { LAS float* xl = (LAS float*)(L + IMP_OFF);
      for (int u = tid; u < 4 * 272; u += 512) { const int gg = u / 272, ii = u % 272, dd = ii - 67; xl[u] = ((const LAS float*)(L + LUT_OFF))[(kv * 4 + gg) * 128 + (dd < 0 ? 0 : (dd > 127 ? 127 : dd))]; } }
    const LAS float* xlg = (const LAS float*)(L + IMP_OFF) + g * 272;
    { const size_t kvb = ((size_t)b * SEQ) * 256 + kv * 64;
      { const int nreal = c + 1; int NT = (nreal + 1) & ~1; if (NT < 4) NT = 4;
        attn_stream<false, true>(P.KS + kvb, P.VS + kvb, 0, nreal, NT, c, t, mymask, qr, bfar, xlg, lut, GATEV(P, row, head, 1), L, wsf, ow, wave, lane); }
      { int NT = (nwin + 1) & ~1; if (NT < 4) NT = 4;
        attn_stream<true, true>(P.KW + kvb, P.VW + kvb, c - nwin + 1, nwin, NT, c, t, mymask, qr, bfar, xlg, lut, GATEV(P, row, head, 2), L, wsf, ow, wave, lane); } }
    { const int rr = lane >> 1, hf = lane & 1, gg = rr >> 3, qq = rr & 7; const LAS float* src = ow + rr * 64 + hf * 32;
      bf16_t* op = P.O + ((size_t)b * SEQ + c * 64 + wave * 8 + qq) * D + (kv * 4 + gg) * 64 + hf * 32;
#pragma unroll
      for (int q4 = 0; q4 < 4; ++q4) { const f32x4 x0 = *(const LAS f32x4*)(src + q4 * 8), x1 = *(const LAS f32x4*)(src + q4 * 8 + 4); u32x4 w;
          w.x = cvtpk(x0[0], x0[1]); w.y = cvtpk(x0[2], x0[3]); w.z = cvtpk(x1[0], x1[1]); w.w = cvtpk(x1[2], x1[3]); *(u32x4*)(op + q4 * 8) = w; } }
    __syncthreads();
}

template <bool COPY>
__device__ __forceinline__ void stage_f32_pair(const float* ksrc_, const float* vsrc_, LAS unsigned char* Kb, LAS unsigned char* Vb, int lane, float* kdst_ = nullptr, float* vdst_ = nullptr, int first_row = 0) {
    const int c4 = lane & 15; const char* ks = uniform_ptr(ksrc_); const char* vs = uniform_ptr(vsrc_); const unsigned lo = (unsigned)((lane >> 4) * 1024 + c4 * 16);
#pragma unroll 1
    for (int hf = 0; hf < 2; ++hf) {
        f32x4 x[8], y[8];
#pragma unroll
        for (int it = 0; it < 8; ++it) x[it] = *(const f32x4*)(ks + (lo + (unsigned)(hf * 8 + it) * 4096u));
#pragma unroll
        for (int it = 0; it < 8; ++it) y[it] = *(const f32x4*)(vs + (lo + (unsigned)(hf * 8 + it) * 4096u));
        if constexpr (COPY) {
            char* kd = (char*)uniform_ptr(kdst_); char* vd = (char*)uniform_ptr(vdst_);
#pragma unroll
            for (int it = 0; it < 8; ++it) { const int key = (hf * 8 + it) * 4 + (lane >> 4);
                if (key >= first_row) { __builtin_nontemporal_store(x[it], (f32x4*)(kd + (lo + (unsigned)(hf * 8 + it) * 4096u))); __builtin_nontemporal_store(y[it], (f32x4*)(vd + (lo + (unsigned)(hf * 8 + it) * 4096u))); } }
        }
#pragma unroll
        for (int it = 0; it < 8; ++it) { const int key = (hf * 8 + it) * 4 + (lane >> 4);
            u32x2 w; w.x = cvtpk(x[it][0], x[it][1]); w.y = cvtpk(x[it][2], x[it][3]);
            *(LAS u32x2*)(Kb + key * 128 + (((c4 >> 1) ^ ((key >> 1) & 7)) << 4) + (c4 & 1) * 8) = w; }
#pragma unroll
        for (int it = 0; it < 8; ++it) { const int key = (hf * 8 + it) * 4 + (lane >> 4);
            u32x2 w; w.x = cvtpk(y[it][0], y[it][1]); w.y = cvtpk(y[it][2], y[it][3]);
            *(LAS u32x2*)(Vb + (c4 >> 3) * 4096 + key * 64 + (c4 & 7) * 8) = w; }
        __builtin_amdgcn_sched_barrier(0);
    }
}
__device__ __forceinline__ void stage_bf16_tile(const bf16_t* src_  , LAS unsigned char* Kb, bool isV, int lane) {
    const char* src = uniform_ptr(src_);
#pragma unroll
    for (int it = 0; it < 8; ++it) { const int idx = it * 64 + lane, key = idx >> 3, ch = idx & 7; const u32x4 x = *(const u32x4*)(src + (unsigned)idx * 16u);
        const int off = isV ? ((ch >> 2) * 4096 + key * 64 + (ch & 3) * 16) : (key * 128 + ((ch ^ ((key >> 1) & 7)) << 4));
        *(LAS u32x4*)(Kb + off) = x; }
}
__device__ __forceinline__ void stage_new_tile(const bf16_t* src_  , LAS unsigned char* Kb, bool isV, int lane) {
    const char* src = uniform_ptr(src_);
#pragma unroll
    for (int it = 0; it < 8; ++it) *(LAS u32x4*)(Kb + (it * 64 + lane) * 16) = (u32x4){0u, 0u, 0u, 0u};
    if (lane < 32) { const int key = lane >> 3, ch = lane & 7; const u32x4 x = *(const u32x4*)(src + (unsigned)(key * 512 + ch * 16));
        const int off = isV ? ((ch >> 2) * 4096 + key * 64 + (ch & 3) * 16) : (key * 128 + ((ch ^ ((key >> 1) & 7)) << 4));
        *(LAS u32x4*)(Kb + off) = x; }
}
__device__ __forceinline__ void sample_unit(const Ptrs& P, LAS unsigned char* L, int uA, int uB, int tid, int wave, int lane) {
    asm volatile("" : "+v"(lane), "+v"(tid));
    const int half = wave >> 2, lw = wave & 3, usel = half ? uB : uA, b = usel >> 2, kv = usel & 3;
    const int r32 = lane & 31, hi = lane >> 5, g = r32 >> 3, qi = r32 & 7, qs = qi & 3, head = kv * 4 + g;
    const int t = PAST + qs; const unsigned row = (unsigned)MP + b * 4 + qs;
    bf16x8 qr[4];
#pragma unroll
    for (int ds = 0; ds < 4; ++ds) qr[ds] = *(const bf16x8*)(P.Q + (size_t)row * D + head * 64 + ds * 16 + hi * 8);
    const LAS float* lut = (const LAS float*)(L + LUT_OFF) + head * 128; const float bfar = lut[127];
    LAS float* wsf = (LAS float*)(L + WSF_OFF) + wave * 32;
    LAS unsigned* impq = (LAS unsigned*)(L + IMP_OFF) + wave * 512 + qi * 64;
    LAS unsigned char* Kb = L + wave * 16384; LAS unsigned char* Vb = Kb + 8192;
    f32x16 out[2], o[2];
#pragma unroll
    for (int r = 0; r < 16; ++r) { out[0][r] = 0.f; out[1][r] = 0.f; o[0][r] = 0.f; o[1][r] = 0.f; }
    stage_bf16_tile(P.kcs + (size_t)(b * 4 + kv) * 4096, Kb, false, lane); stage_bf16_tile(P.vcs + (size_t)(b * 4 + kv) * 4096, Vb, true, lane);
    LDS_WAIT();
    {
        f32x16 a0, a1;
        qk_tile(a0, a1, Kb, qr, 0.f, r32, hi);
        mask_bias(a0, a1, t, 31, 32, 1 << 30, true, true, lut, hi);
        { float rm = fmaxf(a0[0], a1[0]);
#pragma unroll
          for (int r = 1; r < 16; ++r) rm = fmaxf(rm, fmaxf(a0[r], a1[r]));
          rm = x32_max(rm); float sacc = 0.f;
#pragma unroll
          for (int r = 0; r < 16; ++r) { a0[r] = ex2(a0[r] - rm); a1[r] = ex2(a1[r] - rm); sacc += a0[r] + a1[r]; }
          sacc = x32_sum(sacc); const float cinv = 1.0f / sacc;
#pragma unroll
          for (int r = 0; r < 16; ++r) { a0[r] *= cinv; a1[r] *= cinv; } }
        imp_store(a0, a1, 0, impq, 32, g, hi);
        if (g == 0) {
#pragma unroll
            for (int q8 = 0; q8 < 8; ++q8) { const int jc = 32 + 4 * q8; u32x2 w; w.x = imp_key(0.f, jc + 2 * hi, 32); w.y = imp_key(0.f, jc + 2 * hi + 1, 32); *(LAS u32x2*)(impq + 2 * hi + jc) = w; } }
        if (lw == 0) { pv_tile(o, Vb, a0, a1, lane); const float g0 = GATEV(P, row, head, 0); row_fma(out, o, g0, wsf, r32, hi);
#pragma unroll
            for (int r = 0; r < 16; ++r) { o[0][r] = 0.f; o[1][r] = 0.f; } }
    }
    const unsigned long long mymask = select_mask(impq, g, hi);
    const unsigned long long umask = wave_or64(mymask) & 0x1FFFFFFFFull;
    const bool winw = lw == 3;
    const int nsel = __builtin_popcountll(umask);
    const int nmine = winw ? 9 : nsel, first = winw ? 0 : lw, step = winw ? 1 : 3;
    float m = -1e30f, l = 0.f;
#pragma unroll 1
    for (int idx = first; idx < nmine; idx += step) {
        LDS_WAIT();
        int pos0; bool near, sel = true;
        int ln = lane; asm volatile("" : "+v"(ln));
        if (!winw) {
            unsigned long long mm = umask; for (int n = 0; n < idx; ++n) mm &= mm - 1ull;
            const int j = __builtin_ctzll(mm);
            if (j < 32) { const int page = P.pt[b * 16 + (j >> 1)]; const size_t off = (((size_t)page * 128 + (j & 1) * 64) * 4 + kv) * 64;
                stage_f32_pair<false>(P.ck_sel + off, P.cv_sel + off, Kb, Vb, ln); }
            else { stage_new_tile(P.KS + ((size_t)MP + b * 4) * 256 + kv * 64, Kb, false, ln); stage_new_tile(P.VS + ((size_t)MP + b * 4) * 256 + kv * 64, Vb, true, ln); }
            pos0 = 64 * j; near = j >= 30; sel = (mymask >> j) & 1ull;
        } else {
            if (idx < 8) { const size_t off = (((size_t)b * 512 + 64 * idx) * 4 + kv) * 64;
                stage_f32_pair<true>(P.st_kw + off, P.st_vw + off, Kb, Vb, ln, P.kw_out + off - 1024, P.vw_out + off - 1024, idx == 0 ? 4 : 0); }
            else { stage_new_tile(P.KW + ((size_t)MP + b * 4) * 256 + kv * 64, Kb, false, ln); stage_new_tile(P.VW + ((size_t)MP + b * 4) * 256 + kv * 64, Vb, true, ln); }
            pos0 = PAST - 512 + 64 * idx; near = idx >= 6;
        }
        LDS_WAIT();
        f32x16 p0, p1;
        qk_tile(p0, p1, Kb, qr, near ? 0.f : bfar, r32, hi);
        mask_bias(p0, p1, t, pos0, 1, winw ? 512 : (1 << 30), sel, near, lut, hi);
        softmax_update(p0, p1, m, l, o, wsf, r32, hi);
        pv_tile(o, Vb, p0, p1, lane);
    }
    LDS_WAIT();
    { const float lt = x32_sum(l);
      LAS f32x2* ml = (LAS f32x2*)(L + IMP_OFF);
      if (hi == 0) ml[wave * 256 + r32] = (f32x2){m, lt};
      __syncthreads();
      const int w0 = half * 4 + (winw ? 3 : 0), w1 = half * 4 + (winw ? 4 : 3);
      float M = -1e30f;
      for (int w = w0; w < w1; ++w) M = fmaxf(M, ml[w * 256 + r32][0]);
      float Ls = 0.f;
      for (int w = w0; w < w1; ++w) { const f32x2 x = ml[w * 256 + r32]; Ls += x[1] * ex2(x[0] - M); }
      const float gt = GATEV(P, row, head, (winw ? 2 : 1));
      const float f = Ls > 0.f ? gt * ex2(m - M) / Ls : 0.f;
      row_fma(out, o, f, wsf, r32, hi); }
    LAS float* ob = (LAS float*)Kb + hi * 256 + r32;
#pragma unroll
    for (int r = 0; r < 16; ++r) { ob[CROW0(r) * 64] = out[0][r]; ob[CROW0(r) * 64 + 32] = out[1][r]; }
    __syncthreads();
    { const int hs = tid >> 8, vr = (tid >> 4) & 15, d4 = (tid & 15) * 4, gg = vr >> 2, qq = vr & 3, uo = hs ? uB : uA; f32x4 sacc = (f32x4){0.f, 0.f, 0.f, 0.f};
#pragma unroll
      for (int w = 0; w < 4; ++w) sacc = sacc + *(const LAS f32x4*)((const LAS float*)(L + (hs * 4 + w) * 16384) + (gg * 8 + qq) * 64 + d4);
      u32x2 w2; w2.x = cvtpk(sacc[0], sacc[1]); w2.y = cvtpk(sacc[2], sacc[3]);
      *(u32x2*)(P.O + ((size_t)MP + (uo >> 2) * 4 + qq) * D + ((uo & 3) * 4 + gg) * 64 + d4) = w2; }
    __syncthreads();
}

#ifdef VERIFY
__device__ __forceinline__ float wsum(float v) { for (int o = 1; o < 64; o <<= 1) v += __shfl_xor(v, o); return v; }
__device__ __forceinline__ float wmax(float v) { for (int o = 1; o < 64; o <<= 1) v = fmaxf(v, __shfl_xor(v, o)); return v; }
__device__ __forceinline__ float rb(float x) { return bf2f((unsigned short)(cvtpk(x, 0.f) & 0xffffu)); }
__device__ __forceinline__ void verify_item(const Ptrs& P, LAS unsigned char* L, bool sample, int b, int tq, int kv, int br, float* errs, int wave, int lane) {
    LAS float* sc = (LAS float*)(L + wave * 16384);
    LAS float* qs = (LAS float*)(L + IMP_OFF) + wave * 512;
    const LAS float* lutb = (const LAS float*)(L + LUT_OFF);
    const size_t row = sample ? (size_t)MP + b * 4 + tq : (size_t)b * SEQ + tq; const int pos = sample ? PAST + tq : tq; const int cq = pos >> 6;
    for (int g = 0; g < 4; ++g) qs[g * 64 + lane] = bf2f(P.Q[row * D + (kv * 4 + g) * 64 + lane]);
    LDS_WAIT();
    const int ncmp = sample ? 64 : 128; const size_t cmpo = (size_t)(b * 4 + kv) * (sample ? 4096 : 8192); const bf16_t* kc = (const bf16_t*)((const char*)P.kcp + (sample ? WS_KCMPS - WS_KCMPP : 0)) + cmpo; const bf16_t* vc = (const bf16_t*)((const char*)P.vcp + (sample ? WS_VCMPS - WS_VCMPP : 0)) + cmpo;
    float oc0 = 0.f, oc1 = 0.f, oc2 = 0.f, oc3 = 0.f;
    for (int g = 0; g < 4; ++g) {
        float sA = -INFINITY, sB = -INFINITY;
        for (int h = 0; h < 2; ++h) { const int n = lane + 64 * h; const int dist = pos - (32 * n + 31); float s = -INFINITY;
            if (n < ncmp && dist >= 0) { float a = 0.f; for (int d = 0; d < 64; ++d) a += qs[g * 64 + d] * bf2f(kc[(size_t)n * 64 + d]); s = a + lutb[(kv * 4 + g) * 128 + (dist > 127 ? 127 : dist)]; }
            if (h == 0) sA = s; else sB = s; }
        const float mx = wmax(fmaxf(sA, sB)); float p0 = 0.f, p1 = 0.f;
        if (mx > -INFINITY) { p0 = ex2(sA - mx); p1 = ex2(sB - mx); }
        const float sm = wsum(p0 + p1); const float inv = sm > 0.f ? 1.0f / sm : 0.f;
        sc[g * 128 + lane] = p0 * inv; sc[g * 128 + 64 + lane] = p1 * inv;
    }
    LDS_WAIT();
    for (int g = 0; g < 4; ++g) { float a = 0.f; for (int n = 0; n < ncmp; ++n) a += sc[g * 128 + n] * bf2f(vc[(size_t)n * 64 + lane]); if (g == 0) oc0 = a; else if (g == 1) oc1 = a; else if (g == 2) oc2 = a; else oc3 = a; }
    float imp = 0.f; for (int g = 0; g < 4; ++g) imp += sc[g * 128 + 2 * lane] + sc[g * 128 + 2 * lane + 1];
    { const bool forced = (lane == 0) || (lane == cq) || (lane == cq - 1), elig = lane <= cq; imp = forced ? 1e9f : (elig ? imp : -1.0f); }
    LDS_WAIT(); qs[256 + lane] = imp; LDS_WAIT();
    int rank = 0; for (int j = 0; j < 64; ++j) { const float v = qs[256 + j]; rank += (v > imp) || (v == imp && j < lane); }
    const int nsb = sample ? 33 : 64;
    const unsigned long long selm = __ballot(rank < 16 && lane < nsb);
    float r0 = oc0, r1 = oc1, r2_ = oc2, r3 = oc3;
    if (br != 0) {
        const int nslot = br == 1 ? __builtin_popcountll(selm) : 9;
        LDS_WAIT();
        for (int si = 0; si < nslot && si < 16; ++si) {
            int j;
            if (br == 1) { unsigned long long mm = selm; for (int n = 0; n < si; ++n) mm &= mm - 1ull; j = __builtin_ctzll(mm); } else j = sample ? si : cq - 8 + si;
            bool ok = false; int pk = 0; const float* kf = nullptr; const bf16_t* kb = nullptr;
            if (br == 1) { pk = 64 * j + lane;
                if (!sample) { ok = pk <= pos; kb = P.KS + ((size_t)b * SEQ + pk) * 256 + kv * 64; }
                else if (j < 32) { ok = true; kf = P.ck_sel + (((size_t)P.pt[b * 16 + (j >> 1)] * 128 + (j & 1) * 64 + lane) * 4 + kv) * 64; }
                else { ok = lane < 4 && pk <= pos; kb = P.KS + ((size_t)MP + b * 4 + (lane & 3)) * 256 + kv * 64; } }
            else { if (!sample) { pk = 64 * j + lane; ok = j >= 0 && pk <= pos && pos - pk < 512; kb = P.KW + ((size_t)b * SEQ + (ok ? pk : 0)) * 256 + kv * 64; }
                else { const int e = 64 * j + lane; pk = PAST - 512 + e; ok = e < 516 && pk <= pos && pos - pk < 512;
                    if (e < 512) kf = P.st_kw + (((size_t)b * 512 + e) * 4 + kv) * 64; else kb = P.KW + ((size_t)MP + b * 4 + ((e - 512) & 3)) * 256 + kv * 64; } }
            const int dist = pos - pk;
            for (int g = 0; g < 4; ++g) { float s = -INFINITY;
                if (ok) { float a = 0.f; for (int d = 0; d < 64; ++d) a += qs[g * 64 + d] * (kf ? rb(kf[d]) : bf2f(kb[d])); s = a + lutb[(kv * 4 + g) * 128 + (dist > 127 ? 127 : dist)]; }
                sc[g * 1024 + si * 64 + lane] = s; }
        }
        LDS_WAIT();
        for (int g = 0; g < 4; ++g) {
            float mx = -INFINITY; for (int si = 0; si < nslot && si < 16; ++si) mx = fmaxf(mx, sc[g * 1024 + si * 64 + lane]);
            mx = wmax(mx); float sm = 0.f;
            for (int si = 0; si < nslot && si < 16; ++si) { const float p = mx > -INFINITY ? ex2(sc[g * 1024 + si * 64 + lane] - mx) : 0.f; sc[g * 1024 + si * 64 + lane] = p; sm += p; }
            sm = wsum(sm); const float inv = sm > 0.f ? 1.0f / sm : 0.f;
            LDS_WAIT();
            float a = 0.f;
            for (int si = 0; si < nslot && si < 16; ++si) {
                int j;
                if (br == 1) { unsigned long long mm = selm; for (int n = 0; n < si; ++n) mm &= mm - 1ull; j = __builtin_ctzll(mm); } else j = sample ? si : cq - 8 + si;
                for (int k = 0; k < 64; ++k) { const float p = sc[g * 1024 + si * 64 + k]; if (p == 0.f) continue; float v;
                    if (br == 1) { if (!sample) v = bf2f(P.VS[((size_t)b * SEQ + 64 * j + k) * 256 + kv * 64 + lane]);
                        else if (j < 32) v = rb(P.cv_sel[(((size_t)P.pt[b * 16 + (j >> 1)] * 128 + (j & 1) * 64 + k) * 4 + kv) * 64 + lane]);
                        else v = bf2f(P.VS[((size_t)MP + b * 4 + (k & 3)) * 256 + kv * 64 + lane]); }
                    else { if (!sample) v = bf2f(P.VW[((size_t)b * SEQ + 64 * j + k) * 256 + kv * 64 + lane]);
                        else { const int e = 64 * j + k; v = e < 512 ? rb(P.st_vw[(((size_t)b * 512 + e) * 4 + kv) * 64 + lane]) : bf2f(P.VW[((size_t)MP + b * 4 + ((e - 512) & 3)) * 256 + kv * 64 + lane]); } }
                    a += p * v; } }
            a *= inv; if (g == 0) r0 = a; else if (g == 1) r1 = a; else if (g == 2) r2_ = a; else r3 = a;
            LDS_WAIT();
        }
    }
    float d2 = 0.f, rr2 = 0.f;
    for (int g = 0; g < 4; ++g) { const float ref = g == 0 ? r0 : g == 1 ? r1 : g == 2 ? r2_ : r3; const float f = bf2f(P.O[row * D + (kv * 4 + g) * 64 + lane]); const float df = f - ref; d2 += df * df; rr2 += ref * ref; }
    d2 = wsum(d2); rr2 = wsum(rr2);
    if (lane == 0) { atomicAdd(errs + ((sample ? 3 : 0) + br) * 2, d2); atomicAdd(errs + ((sample ? 3 : 0) + br) * 2 + 1, rr2); }
}
#endif
}

constexpr int NPHASE = 17;
__global__ void __launch_bounds__(512, 2) nsa_fwd(Args args) {
    extern __shared__ __attribute__((aligned(16))) unsigned char lds[];
    Frame F;
    F.lds = (LAS unsigned char*)lds;
    F.tid = threadIdx.x; F.lane = F.tid & 63; F.wave = __builtin_amdgcn_readfirstlane(F.tid >> 6);
    F.G = gridDim.x; { const int bx = blockIdx.x; F.vcu = (F.G % 8 == 0) ? (bx % 8) * (F.G / 8) + bx / 8 : bx; }
    F.x_p = (const float*)args.in[0]; F.x_s = (const float*)args.in[1]; F.c_p = (const float*)args.in[2]; F.c_s = (const float*)args.in[3];
    F.ck_cmp = (const float*)args.in[4]; F.cv_cmp = (const float*)args.in[5]; F.ck_sel = (const float*)args.in[6]; F.cv_sel = (const float*)args.in[7];
    F.page_table = (const int*)args.in[8]; F.st_kw = (const float*)args.in[9]; F.st_vw = (const float*)args.in[10]; F.st_pool = (const float*)args.in[11];
    F.rel_bias = (const float*)args.in[12]; F.ada_w = (const float*)args.in[13]; F.ada_b = (const float*)args.in[14]; F.norm_g = (const float*)args.in[15]; F.final_g = (const float*)args.in[16];
    F.w_in = (const float*)args.in[17]; F.w_out = (const float*)args.in[18]; F.cmp_wk = (const float*)args.in[19]; F.cmp_wv = (const float*)args.in[20];
    F.pe_k = (const float*)args.in[21]; F.pe_v = (const float*)args.in[22]; F.pool_w = (const float*)args.in[23]; F.pool_scale = (const float*)args.in[24];
    F.ffn_wg = (const float*)args.in[25]; F.ffn_wu = (const float*)args.in[26]; F.ffn_wd = (const float*)args.in[27];
    F.out = args.out; F.ws = args.ws;
    unsigned char* ws = args.ws;
    for (int u = F.tid; u < 64; u += 512) ((LAS unsigned*)(F.lds + MISC_OFF))[u] = 0u;
    for (int u = F.tid; u < 16 * 128; u += 512) { const int h = u >> 7, d = u & 127; ((LAS float*)(F.lds + LUT_OFF))[u] = F.rel_bias[t5_bucket(d) * 16 + h] * LOG2E; }
    __syncthreads();
    volatile LAS unsigned* MISC = (volatile LAS unsigned*)(F.lds + MISC_OFF);
    XcdBarrier bar; bar.bar = (unsigned*)(ws + WS_CTL) + CW_BAR; bar.x = 0; bar.st = nullptr;
    if (!MK_SPLIT) bar = xcd_barrier_post((unsigned*)(ws + WS_CTL) + CW_BAR, MISC + 8);
    const int lo = args.ph_lo, hi = args.ph_hi;
#ifndef PHMASK
#define PHMASK 0x1FFFF
#endif
#define IN(k) (((PHMASK >> (k)) & 1) && lo <= (k) && (k) < hi)
#define SEAM(k) do { if (IN(k) && IN((k) + 1)) xcd_barrier(bar); } while (0)
#ifndef REPMASK
#define REPMASK 0
#endif
#define REPS(k) (((REPMASK >> (k)) & 1) ? 2 : 1)
    bf16_t* H = (bf16_t*)(ws + WS_H); float* X = (float*)(ws + WS_X); float* MOD = (float*)(ws + WS_MOD);

    if (IN(0)) { for (int rep = 0; rep < REPS(0); ++rep) p0_prologue(F); } SEAM(0);
    if (IN(1)) { for (int rep = 0; rep < REPS(1); ++rep) { p1_compress_sample(F); p1_ada(F); } } SEAM(1);
    if (IN(2)) { for (int rep = 0; rep < REPS(2); ++rep) norm_phase<0>(F, true, 0, 0); } SEAM(2);
    if (IN(3)) {
        pg8::Gemm g{H, (const bf16_t*)(ws + WS_WIN), D, D, D, 0}; pg8::StaticOrder S; S.init(MT, NPROJ, F.G, (int)blockIdx.x);
        pg8::EpiProj E{(bf16_t*)(ws + WS_Q), (bf16_t*)(ws + WS_KV), (float*)(ws + WS_GATES), F.out};
        for (int rep = 0; rep < REPS(3); ++rep) pg8::gemm_phase<pg8::EpiProj, pg8::StaticOrder, true>(F.lds, g, S, E);
    } SEAM(3);
    if (IN(4)) { for (int rep = 0; rep < REPS(4); ++rep) p4_compress_prompt(F); } SEAM(4);
    if (IN(5)) {
        att::Ptrs P; P.Q = (const bf16_t*)(ws + WS_Q); P.kcp = (const bf16_t*)(ws + WS_KCMPP); P.vcp = (const bf16_t*)(ws + WS_VCMPP); P.kcs = (const bf16_t*)(ws + WS_KCMPS); P.vcs = (const bf16_t*)(ws + WS_VCMPS);
        const bf16_t* kvb = (const bf16_t*)(ws + WS_KV); P.KS = kvb + 2 * KV_STRIDE; P.VS = kvb + 3 * KV_STRIDE; P.KW = kvb + 4 * KV_STRIDE; P.VW = kvb + 5 * KV_STRIDE;
        P.gates = (const float*)(ws + WS_GATES); P.O = (bf16_t*)(ws + WS_O); P.ck_sel = F.ck_sel; P.cv_sel = F.cv_sel; P.st_kw = F.st_kw; P.st_vw = F.st_vw; P.pt = F.page_table;
        P.gov = -1; P.kw_out = F.out + O_KWS; P.vw_out = F.out + O_KWS + SZ_WS;
#ifdef VERIFY
        P.gov = args.pad0 - 1;
#endif
#ifndef RS
#define RS 1
#endif
#ifndef RP
#define RP 1
#endif
#pragma unroll 1
        for (int pass = 0; pass < 2; ++pass) {
            if ((pass == 0) != ((F.vcu & 1) != 0)) {
#pragma unroll 1
                for (int rep = 0; rep < RS; ++rep)
                for (int u = F.vcu; u < NSB * 2; u += F.G) att::sample_unit(P, F.lds, u, u + NSB * 2, F.tid, F.wave, F.lane);
            } else {
#pragma unroll 1
                for (int rep = 0; rep < RP; ++rep)
                for (int u = F.vcu; u < 16 * 16; u += F.G) { const int bk = u >> 4, s = u & 15;
#pragma unroll 1
                    for (int i = 0; i < 4; ++i) { const int c = (i == 0) ? s : (i == 1) ? 31 - s : (i == 2) ? 32 + s : 63 - s; att::prompt_unit(P, F.lds, bk >> 2, bk & 3, c, F.tid, F.wave, F.lane); } }
            }
        }
    } SEAM(5);
    if (IN(6)) {
        pg8::Gemm g{(const bf16_t*)(ws + WS_O), (const bf16_t*)(ws + WS_WOUT), D, D, D, 0}; pg8::StaticOrder S; S.init(MP, D, F.G, (int)blockIdx.x);
        pg8::EpiRes E{F.x_p, F.x_s, X, MOD + 2048, nullptr};
        pg8::gemm_phase<pg8::EpiRes, pg8::StaticOrder, true>(F.lds, g, S, E);
        small_gemm_res(F, (const bf16_t*)(ws + WS_O) + (size_t)MP * D, D, (const bf16_t*)(ws + WS_WOUT), D, D, false, F.x_s, X + (size_t)MP * D, MOD + 2048, nullptr);
    } SEAM(6);
    if (IN(7)) { for (int rep = 0; rep < REPS(7); ++rep) norm_phase<0>(F, false, 0, 1); } SEAM(7);
    if (IN(8)) {
        pg8::Gemm g{H, (const bf16_t*)(ws + WS_WGU), D, D, D, 0}; pg8::StaticOrder S; S.init(MT, NGU, F.G, (int)blockIdx.x);
        pg8::EpiGU E{(bf16_t*)(ws + WS_ACT)};
        for (int rep = 0; rep < REPS(8); ++rep) pg8::gemm_phase<pg8::EpiGU, pg8::StaticOrder, true>(F.lds, g, S, E);
    } SEAM(8);
    if (IN(9)) {
        pg8::Gemm g{(const bf16_t*)(ws + WS_ACT), (const bf16_t*)(ws + WS_WD), FF, FF, FF, 0}; pg8::StaticOrder S; S.init(MP, D, F.G, (int)blockIdx.x);
        pg8::EpiRes E{X, X + (size_t)MP * D, X, MOD + 5120, nullptr};
        pg8::gemm_phase<pg8::EpiRes, pg8::StaticOrder, true>(F.lds, g, S, E);
        small_gemm_res(F, (const bf16_t*)(ws + WS_ACT) + (size_t)MP * FF, FF, (const bf16_t*)(ws + WS_WD), FF, FF, false, X + (size_t)MP * D, X + (size_t)MP * D, MOD + 5120, nullptr);
    } SEAM(9);
    if (IN(10)) { for (int rep = 0; rep < REPS(10); ++rep) norm_phase<1>(F, false, 1, 0); } SEAM(10);
    if (IN(11)) { for (int rep = 0; rep < REPS(11); ++rep) pool_phase(F); } SEAM(11);
    if (IN(12)) {
        pg8::Gemm g{H, (const bf16_t*)(ws + WS_WPOOL), D, 256, 256, 256}; pg8::StaticOrder S; S.init(MP, D, F.G, (int)blockIdx.x);
        pg8::EpiRes E{X, X + (size_t)MP * D, X, MOD + (size_t)NMODB * 6144 + 2048, F.pool_scale};
        pg8::gemm_phase<pg8::EpiRes, pg8::StaticOrder, true>(F.lds, g, S, E);
        small_gemm_res(F, H + (size_t)MP * D, D, (const bf16_t*)(ws + WS_WPOOL), 256, 256, true, X + (size_t)MP * D, X + (size_t)MP * D, MOD + (size_t)NMODB * 6144 + 2048, F.pool_scale);
    } SEAM(12);
    if (IN(13)) { for (int rep = 0; rep < REPS(13); ++rep) norm_phase<0>(F, false, 1, 1); } SEAM(13);
    if (IN(14)) {
        pg8::Gemm g{H, (const bf16_t*)(ws + WS_WGU) + (size_t)NGU * D, D, D, D, 0}; pg8::StaticOrder S; S.init(MT, NGU, F.G, (int)blockIdx.x);
        pg8::EpiGU E{(bf16_t*)(ws + WS_ACT)};
        pg8::gemm_phase<pg8::EpiGU, pg8::StaticOrder, true>(F.lds, g, S, E);
    } SEAM(14);
    if (IN(15)) {
        pg8::Gemm g{(const bf16_t*)(ws + WS_ACT), (const bf16_t*)(ws + WS_WD) + (size_t)D * FF, FF, FF, FF, 0}; pg8::StaticOrder S; S.init(MP, D, F.G, (int)blockIdx.x);
        pg8::EpiRes E{X, X + (size_t)MP * D, X, MOD + (size_t)NMODB * 6144 + 5120, nullptr};
        pg8::gemm_phase<pg8::EpiRes, pg8::StaticOrder, true>(F.lds, g, S, E);
        small_gemm_res(F, (const bf16_t*)(ws + WS_ACT) + (size_t)MP * FF, FF, (const bf16_t*)(ws + WS_WD) + (size_t)D * FF, FF, FF, false, X + (size_t)MP * D, X + (size_t)MP * D, MOD + (size_t)NMODB * 6144 + 5120, nullptr);
    } SEAM(15);
    if (IN(16)) { for (int rep = 0; rep < REPS(16); ++rep) norm_phase<2>(F, false, 0, 0); }
#undef IN
#undef SEAM
}


#ifdef VERIFY
__global__ void __launch_bounds__(512, 2) verify_k(Args args) {
    extern __shared__ __attribute__((aligned(16))) unsigned char lds[];
    LAS unsigned char* L = (LAS unsigned char*)lds; unsigned char* ws = args.ws;
    const int tid = threadIdx.x, lane = tid & 63, wave = __builtin_amdgcn_readfirstlane(tid >> 6);
    const float* rel_bias = (const float*)args.in[12];
    for (int u = tid; u < 16 * 128; u += 512) { const int h = u >> 7, d = u & 127; ((LAS float*)(L + LUT_OFF))[u] = rel_bias[t5_bucket(d) * 16 + h] * LOG2E; }
    __syncthreads();
    att::Ptrs P; P.Q = (const bf16_t*)(ws + WS_Q); P.kcp = (const bf16_t*)(ws + WS_KCMPP); P.vcp = (const bf16_t*)(ws + WS_VCMPP); P.kcs = (const bf16_t*)(ws + WS_KCMPS); P.vcs = (const bf16_t*)(ws + WS_VCMPS);
    const bf16_t* kvb = (const bf16_t*)(ws + WS_KV); P.KS = kvb + 2 * KV_STRIDE; P.VS = kvb + 3 * KV_STRIDE; P.KW = kvb + 4 * KV_STRIDE; P.VW = kvb + 5 * KV_STRIDE;
    P.gates = (const float*)(ws + WS_GATES); P.O = (bf16_t*)(ws + WS_O); P.ck_sel = (const float*)args.in[6]; P.cv_sel = (const float*)args.in[7]; P.st_kw = (const float*)args.in[9]; P.st_vw = (const float*)args.in[10]; P.pt = (const int*)args.in[8]; P.gov = args.pad0 - 1;
    float* errs = (float*)(ws + WS_CTL) + 65536;
    const int gw = blockIdx.x * 8 + wave;
    for (int it = gw; it < 168 + 64; it += gridDim.x * 8) { bool smp = it >= 168; int vb_, vt_, vk_;
        if (!smp) { const int ti = it % 21, r = it / 21; vb_ = (r >> 2) ? 3 : 0; vk_ = r & 3; vt_ = ti == 0 ? 0 : ti == 1 ? 5 : ti == 2 ? 30 : ti == 3 ? 31 : ti == 4 ? 63 : ti == 5 ? 64 : ti == 6 ? 100 : ti == 7 ? 511 : ti == 8 ? 512 : ti == 9 ? 600 : ti == 10 ? 959 : ti == 11 ? 960 : ti == 12 ? 1023 : ti == 13 ? 1024 : ti == 14 ? 1055 : ti == 15 ? 1100 : ti == 16 ? 2047 : ti == 17 ? 2048 : ti == 18 ? 3000 : ti == 19 ? 4032 : 4095; }
        else { const int q = it - 168, bi = q >> 4; vb_ = bi == 0 ? 0 : bi == 1 ? 1 : bi == 2 ? 77 : 127; vt_ = q & 3; vk_ = (q >> 2) & 3; }
        att::verify_item(P, L, smp, vb_, vt_, vk_, args.pad0 - 1, errs, wave, lane); }
}
__global__ void scale_k(Args args) {
    const float* errs = (const float*)(args.ws + WS_CTL) + 65536; const size_t offs[6] = {O_KCP, O_KCP + SZ_KVP, O_KCP + 2 * SZ_KVP, O_KCS, O_KCS + SZ_KVS, O_KCS + 2 * SZ_KVS};
    const int k = blockIdx.y; const float d2 = errs[2 * k], r2 = errs[2 * k + 1]; const float e = r2 > 0.f ? sqrtf(d2 / r2) : 7.0f; const size_t n = k < 3 ? SZ_KVP : SZ_KVS;
    for (size_t i = (size_t)blockIdx.x * blockDim.x + threadIdx.x; i < n; i += (size_t)gridDim.x * blockDim.x) args.out[offs[k] + i] *= (1.0f + e);
}
#endif
extern "C" void kernel_launch(void* const* d_in, const int* in_sizes, int n_in, void* d_out, int out_size, void* d_ws, size_t ws_size, hipStream_t stream) {
    static int grid = 0;
    if (grid == 0) {
        if (n_in != 28 || (size_t)out_size != O_END || ws_size < WS_END) { fprintf(stderr, "kernel_launch: unexpected shapes (n_in %d, out %d, ws %zu); nothing launched\n", n_in, out_size, ws_size); grid = -1; return; }
        int dev = 0, cus = 0, per_cu = 0;
        if (hipGetDevice(&dev) != hipSuccess || hipDeviceGetAttribute(&cus, hipDeviceAttributeMultiprocessorCount, dev) != hipSuccess) { grid = -1; return; }
        if (hipFuncSetAttribute((const void*)nsa_fwd, hipFuncAttributeMaxDynamicSharedMemorySize, LDS_BYTES) != hipSuccess) { fprintf(stderr, "kernel_launch: hipFuncSetAttribute(%d B LDS) failed\n", LDS_BYTES); grid = -1; return; }
        if (hipOccupancyMaxActiveBlocksPerMultiprocessor(&per_cu, (const void*)nsa_fwd, 512, LDS_BYTES) != hipSuccess || per_cu < 1)
            fprintf(stderr, "kernel_launch: note: occupancy query reports %d workgroups per CU\n", per_cu);
        (void)hipGetLastError();
        grid = cus;
    }
    if (grid < 0) return;
    (void)hipMemsetAsync((char*)d_ws + WS_CTL, 0, CTL_ZERO_BYTES, stream);
    Args a{};
    for (int i = 0; i < 28; ++i) a.in[i] = d_in[i];
    a.out = (float*)d_out; a.ws = (unsigned char*)d_ws; a.pad0 = 0; a.pad1 = 0;
#ifdef VERIFY
    hipFuncSetAttribute((const void*)verify_k, hipFuncAttributeMaxDynamicSharedMemorySize, LDS_BYTES);
    for (int pass = 0; pass < 3; ++pass) { a.pad0 = pass + 1; a.ph_lo = 0; a.ph_hi = 6;
        (void)hipMemsetAsync((char*)d_ws + WS_CTL, 0, 65536 * 4, stream);
        hipLaunchKernelGGL(nsa_fwd, dim3(grid), dim3(512), LDS_BYTES, stream, a);
        hipLaunchKernelGGL(verify_k, dim3(grid), dim3(512), LDS_BYTES, stream, a); }
    a.pad0 = 0; (void)hipMemsetAsync((char*)d_ws + WS_CTL, 0, 65536 * 4, stream);
    a.ph_lo = 0; a.ph_hi = NPHASE;
    hipLaunchKernelGGL(nsa_fwd, dim3(grid), dim3(512), LDS_BYTES, stream, a);
    hipLaunchKernelGGL(scale_k, dim3(64, 6), dim3(256), 0, stream, a);
#elif MK_SPLIT
    for (int p = 0; p < NPHASE; ++p) { a.ph_lo = p; a.ph_hi = p + 1; hipLaunchKernelGGL(nsa_fwd, dim3(grid), dim3(512), LDS_BYTES, stream, a); }
#else
    a.ph_lo = 0; a.ph_hi = NPHASE;
    hipLaunchKernelGGL(nsa_fwd, dim3(grid), dim3(512), LDS_BYTES, stream, a);
#endif
    const hipError_t le = hipPeekAtLastError();
    if (le != hipSuccess) fprintf(stderr, "kernel_launch: launch failed: %s\n", hipGetErrorName(le));
}
```

```cpp
#include <hip/hip_runtime.h>
#include <cstdio>
#include <cstdint>

#ifndef MK_SPLIT
#define MK_SPLIT 0
#endif

#define GAS __attribute__((address_space(1)))
#define LAS __attribute__((address_space(3)))
typedef unsigned short bf16_t;
typedef short bf16x8 __attribute__((ext_vector_type(8)));
typedef short s16x4 __attribute__((ext_vector_type(4)));
typedef float f32x2 __attribute__((ext_vector_type(2)));
typedef float f32x4 __attribute__((ext_vector_type(4)));
typedef float f32x16 __attribute__((ext_vector_type(16)));
typedef unsigned u32x2 __attribute__((ext_vector_type(2)));
typedef unsigned u32x4 __attribute__((ext_vector_type(4)));
typedef __bf16 bf16x2_t __attribute__((ext_vector_type(2)));
typedef GAS unsigned gu32;

constexpr int D = 1024, SEQ = 4096, NB = 4, NSB = 128, DSEQ = 4;
constexpr int MP = NB * SEQ, MS = NSB * DSEQ, MT = MP + MS;
constexpr int INCOLS = 2608, NPROJ = 2816, FF = 2816, NGU = 2 * FF;
constexpr int NMODB = NB + NSB;
constexpr int PAST = 2048;
constexpr float C2 = 0.125f * 1.4426950408889634f;
constexpr float LOG2E = 1.4426950408889634f;

constexpr size_t O_YP = 0, O_YS = O_YP + (size_t)MP * D;
constexpr size_t O_KCP = O_YS + (size_t)MS * D, SZ_KVP = (size_t)MP * 256;
constexpr size_t O_KWP = O_KCP + 4 * SZ_KVP, SZ_WP = (size_t)NB * 512 * 256;
constexpr size_t O_PLP = O_KWP + 2 * SZ_WP;
constexpr size_t O_KCS = O_PLP + (size_t)NB * 15 * D, SZ_KVS = (size_t)MS * 256;
constexpr size_t O_KWS = O_KCS + 4 * SZ_KVS, SZ_WS = (size_t)NSB * 512 * 256;
constexpr size_t O_PLS = O_KWS + 2 * SZ_WS;
constexpr size_t O_END = O_PLS + (size_t)NSB * 15 * D;
static_assert(O_END == 71233536, "output size");

constexpr size_t MiB = 1u << 20;
#ifdef VERIFY
constexpr size_t WS_CTL = 0, CTL_ZERO_BYTES = 1 * MiB;
#else
constexpr size_t WS_CTL = 0, CTL_ZERO_BYTES = 65536;
#endif
constexpr size_t WS_WIN = 2 * MiB;
constexpr size_t WS_WOUT = 8 * MiB;
constexpr size_t WS_WGU = 10 * MiB;
constexpr size_t WS_WD = 32 * MiB;
constexpr size_t WS_WPOOL = 44 * MiB;
constexpr size_t WS_WCK = 45 * MiB, WS_WCV = WS_WCK + 262144;
constexpr size_t WS_SC = 46 * MiB;
constexpr size_t WS_CB = 47 * MiB;
constexpr size_t WS_MOD = 48 * MiB;
constexpr size_t WS_KCMPP = 56 * MiB, WS_VCMPP = 57 * MiB;
constexpr size_t WS_KCMPS = 58 * MiB, WS_VCMPS = 62 * MiB;
constexpr size_t WS_GATES = 66 * MiB;
constexpr size_t WS_H = 72 * MiB;
constexpr size_t WS_Q = 108 * MiB;
constexpr size_t WS_O = 144 * MiB;
constexpr size_t WS_KV = 180 * MiB, KV_STRIDE = (size_t)MT * 256;
constexpr size_t WS_X = 232 * MiB;
constexpr size_t WS_HF = 300 * MiB;
constexpr size_t WS_ACT = 368 * MiB;
constexpr size_t WS_END = 464 * MiB;
static_assert(WS_KV + 6 * KV_STRIDE * 2 <= WS_X && WS_X + (size_t)MT * D * 4 <= WS_HF && WS_HF + (size_t)MT * D * 4 <= WS_ACT && WS_ACT + (size_t)MT * FF * 2 <= WS_END, "ws map");
static_assert(WS_WGU + 2 * (size_t)NGU * D * 2 <= WS_WD && WS_WD + 2 * (size_t)D * FF * 2 <= WS_WPOOL && WS_MOD + 2 * (size_t)NMODB * 6144 * 4 <= WS_KCMPP, "ws map 2");
static_assert(WS_GATES + (size_t)MT * 48 * 4 <= WS_H && WS_H + (size_t)MT * D * 2 <= WS_Q && WS_Q + (size_t)MT * D * 2 <= WS_O && WS_O + (size_t)MT * D * 2 <= WS_KV, "ws map 3");
constexpr int CW_BAR = 4096;

constexpr int RING_BYTES = 131072;
constexpr int LUT_OFF = RING_BYTES;
constexpr int WSF_OFF = LUT_OFF + 8192;
constexpr int IMP_OFF = WSF_OFF + 1024;
constexpr int MISC_OFF = IMP_OFF + 16384;
constexpr int LDS_BYTES = MISC_OFF + 256;
static_assert(LDS_BYTES <= 160 * 1024, "LDS");

__device__ __forceinline__ unsigned cvtpk(float lo, float hi) { f32x2 v = {lo, hi}; bf16x2_t b = __builtin_convertvector(v, bf16x2_t); return __builtin_bit_cast(unsigned, b); }
__device__ __forceinline__ float bf2f(unsigned short h) { return __builtin_bit_cast(float, (unsigned)h << 16); }
__device__ __forceinline__ float ex2(float x) { return __builtin_amdgcn_exp2f(x); }
__device__ __forceinline__ float sigmoidf_(float x) { return __builtin_amdgcn_rcpf(1.0f + ex2(-x * LOG2E)); }
#define CROW0(r) (((r) & 3) + 8 * ((r) >> 2))
#define LDS_WAIT() asm volatile("s_waitcnt lgkmcnt(0)" ::: "memory")
#define VM_WAIT() asm volatile("s_waitcnt vmcnt(0)" ::: "memory")
__device__ __forceinline__ const char* uniform_ptr(const void* p) { const unsigned long long v = (unsigned long long)p; const unsigned lo = (unsigned)__builtin_amdgcn_readfirstlane((int)(unsigned)v), hi = (unsigned)__builtin_amdgcn_readfirstlane((int)(unsigned)(v >> 32)); return (const char*)(((unsigned long long)hi << 32) | lo); }

__device__ __forceinline__ int lane_id() { int l; asm volatile("v_mbcnt_lo_u32_b32 %0, -1, 0\n\tv_mbcnt_hi_u32_b32 %0, -1, %0" : "=v"(l)); return l; }
__device__ __forceinline__ int t5_bucket(int d) {
    if (d < 16) return d;
    int b = 16;
    b += (d >= 19) + (d >= 21) + (d >= 24) + (d >= 27) + (d >= 31) + (d >= 35) + (d >= 40) + (d >= 46) + (d >= 52) + (d >= 59) + (d >= 67) + (d >= 77) + (d >= 87) + (d >= 99) + (d >= 113);
    return b;
}

namespace pg8 {
constexpr int BM = 256, BK = 64, HALF = 128, HTB = HALF * BK * 2, STAGE_BYTES = 8 * HTB, NXCD = 8, WGM = 8;
__host__ __device__ __forceinline__ int lds_byte(int r, int c) { const int st = (r >> 4) * 2 + (c >> 5), rr = r & 15, cc = c & 31, ob = rr * 64 + cc * 2; return st * 1024 + (ob ^ (((ob >> 9) & 1) << 5)); }
__host__ __device__ __forceinline__ void stage_rc(int b, int& R, int& C) { const int st = b / 1024, sb = b % 1024, swz = sb ^ (((sb >> 9) & 1) << 5); R = (st >> 1) * 16 + swz / 64; C = (st & 1) * 32 + (swz % 64) / 2; }
__host__ __device__ __forceinline__ int perm32(int rho) { const int n = rho >> 4, i = rho & 15; return 8 * (i >> 2) + 4 * n + (i & 3); }
struct Unit { int pm, pn; };
struct Gemm { const bf16_t* A; const bf16_t* Bt; int lda, ldb, K, acs; };
struct StaticOrder {
    int nM, nN, nwg, G, c;
    __host__ __device__ void init(int M, int N, int G_, int c_) { nM = M / BM; nN = N / BM; nwg = nM * nN; G = G_; c = c_; }
    __host__ __device__ bool next(int i, Unit& u) const {
        const long L = (long)i * G + c; if (L >= nwg) return false;
        int wgid = (int)L; { const int q = nwg / NXCD, r = nwg % NXCD, xcd = wgid % NXCD, off = wgid / NXCD; wgid = (xcd < r ? xcd * (q + 1) : r * (q + 1) + (xcd - r) * q) + off; }
        const int nig = WGM * nN, gid = wgid / nig, fm = gid * WGM, gsz = (nM - fm) < WGM ? (nM - fm) : WGM;
        u.pm = fm + ((wgid % nig) % gsz); u.pn = (wgid % nig) / gsz; return true;
    }
};
template <class Epi, class Sched, bool ALIGN_EPI>
__device__ __forceinline__ void gemm_phase(LAS unsigned char* lds, const Gemm g, const Sched& S, const Epi& E) {
    const int tid = threadIdx.x, wid = __builtin_amdgcn_readfirstlane(tid >> 6), lane = tid & 63, wr = wid >> 2, wc = wid & 3, fr = lane & 15, fq = lane >> 4;
    const int K = g.K, nt = K / BK;
    unsigned voffA[2], voffB[2];
#pragma unroll
    for (int i = 0; i < 2; ++i) { int R, C; stage_rc(tid * 16 + i * 8192, R, C); const int Rb = Epi::PERM ? ((R & ~31) + perm32(R & 31)) : R;
        voffA[i] = (unsigned)(R * g.lda + C) * 2u; voffB[i] = (unsigned)(Rb * g.ldb + C) * 2u; }
    const size_t kstep = (size_t)(BK * 2);
    const size_t hsA = (size_t)HALF * g.lda * 2, hsB = (size_t)HALF * g.ldb * 2;
    const unsigned ldsw = (unsigned)wid * 1024u;
    const int aoff = lds_byte(wr * 64 + fr, fq * 8), boff = lds_byte(wc * 32 + fr, fq * 8);
#define PG8_SA(b, h) (((b) * 2 + (h)) * HTB)
#define PG8_SB(b, h) ((4 + (b) * 2 + (h)) * HTB)
#define PG8_STAGE(bufoff, gbase, voff) do { _Pragma("unroll") for (int _i = 0; _i < 2; ++_i) \
        __builtin_amdgcn_global_load_lds((const unsigned*)((const char*)(gbase) + (voff)[_i]), (LAS unsigned*)(lds + (bufoff) + ldsw + _i * 8192), 16, 0, 0); } while (0)
#define PG8_LDA(dst, b, h) do { _Pragma("unroll") for (int m = 0; m < 4; ++m) _Pragma("unroll") for (int k = 0; k < 2; ++k) dst[m][k] = *(const LAS bf16x8*)(lds + PG8_SA(b, h) + aoff + m * 2048 + k * 1024); } while (0)
#define PG8_LDB(dst, b, h) do { _Pragma("unroll") for (int n = 0; n < 2; ++n) _Pragma("unroll") for (int k = 0; k < 2; ++k) dst[n][k] = *(const LAS bf16x8*)(lds + PG8_SB(b, h) + boff + n * 2048 + k * 1024); } while (0)
#define PG8_MMA(ai, bj, At, Bt) do { __builtin_amdgcn_s_setprio(1); _Pragma("unroll") for (int m = 0; m < 4; ++m) _Pragma("unroll") for (int n = 0; n < 2; ++n) _Pragma("unroll") for (int k = 0; k < 2; ++k) \
        acc[ai][bj][m][n] = __builtin_amdgcn_mfma_f32_16x16x32_bf16(Bt[n][k], At[m][k], acc[ai][bj][m][n], 0, 0, 0); __builtin_amdgcn_s_setprio(0); } while (0)
#define PG8_WAIT_V(n) asm volatile("s_waitcnt vmcnt(" #n ")" ::: "memory")
#define PG8_WAIT_L(n) asm volatile("s_waitcnt lgkmcnt(" #n ")" ::: "memory")
#define PG8_BAR __builtin_amdgcn_s_barrier()
#define PG8_SCHED __builtin_amdgcn_sched_barrier(0)
#define PG8_UA(u) ((const char*)g.A + (size_t)(u).pm * 2 * hsA + (size_t)(u).pn * (size_t)g.acs * 2)
#define PG8_UB(u) ((const char*)g.Bt + (size_t)(u).pn * 2 * hsB)
    Unit cur, nxt; int ui = 0;
    if (!S.next(0, cur)) return;
    f32x4 acc[2][2][4][2];
#pragma unroll
    for (int a = 0; a < 2; ++a)
#pragma unroll
        for (int b = 0; b < 2; ++b)
#pragma unroll
            for (int m = 0; m < 4; ++m)
#pragma unroll
                for (int n = 0; n < 2; ++n) acc[a][b][m][n] = (f32x4){0.f, 0.f, 0.f, 0.f};
    bf16x8 At[4][2], B0[2][2], B1[2][2];
    const char* cA = PG8_UA(cur); const char* cB = PG8_UB(cur);
    PG8_STAGE(PG8_SB(0, 0), cB, voffB); PG8_STAGE(PG8_SB(0, 1), cB + hsB, voffB); PG8_STAGE(PG8_SA(0, 0), cA, voffA); PG8_STAGE(PG8_SA(0, 1), cA + hsA, voffA);
    if (wr == 1) PG8_BAR;
    PG8_WAIT_V(2); PG8_BAR;
    PG8_STAGE(PG8_SB(1, 0), cB + kstep, voffB); PG8_STAGE(PG8_SA(1, 0), cA + kstep, voffA); PG8_STAGE(PG8_SB(1, 1), cB + hsB + kstep, voffB);
    PG8_WAIT_V(6); PG8_BAR;
    for (;;) {
        const bool has_next = S.next(ui + 1, nxt);
        const char* nA = has_next ? PG8_UA(nxt) : cA; const char* nB = has_next ? PG8_UB(nxt) : cB;
        for (int t = 0; t < nt; t += 2) {
            const bool last = (t == nt - 2);
            const char* a1 = cA + (size_t)(t + 1) * kstep;
            const char* a2 = last ? nA : cA + (size_t)(t + 2) * kstep; const char* b2 = last ? nB : cB + (size_t)(t + 2) * kstep;
            const char* a3 = a2 + kstep; const char* b3 = b2 + kstep;
            PG8_LDB(B0, 0, 0); PG8_LDB(B1, 0, 1); PG8_SCHED; PG8_LDA(At, 0, 0); PG8_STAGE(PG8_SA(1, 1), a1 + hsA, voffA);
            PG8_WAIT_V(8); PG8_WAIT_L(0); PG8_BAR; PG8_MMA(0, 0, At, B0); PG8_MMA(0, 1, At, B1); PG8_BAR; PG8_SCHED;
            PG8_LDA(At, 0, 1); PG8_STAGE(PG8_SB(0, 0), b2, voffB); PG8_STAGE(PG8_SB(0, 1), b2 + hsB, voffB); PG8_STAGE(PG8_SA(0, 0), a2, voffA);
            PG8_WAIT_V(8); PG8_WAIT_L(0); PG8_BAR; PG8_MMA(1, 0, At, B0); PG8_MMA(1, 1, At, B1); PG8_BAR; PG8_SCHED;
            PG8_LDB(B0, 1, 0); PG8_LDB(B1, 1, 1); PG8_SCHED; PG8_LDA(At, 1, 0); PG8_STAGE(PG8_SA(0, 1), a2 + hsA, voffA);
            PG8_WAIT_V(8); PG8_WAIT_L(0); PG8_BAR; PG8_MMA(0, 0, At, B0); PG8_MMA(0, 1, At, B1); PG8_BAR; PG8_SCHED;
            PG8_LDA(At, 1, 1); PG8_STAGE(PG8_SB(1, 0), b3, voffB); PG8_STAGE(PG8_SB(1, 1), b3 + hsB, voffB); PG8_STAGE(PG8_SA(1, 0), a3, voffA);
            PG8_WAIT_V(8); PG8_WAIT_L(0); PG8_BAR; PG8_MMA(1, 0, At, B0); PG8_MMA(1, 1, At, B1); PG8_BAR; PG8_SCHED;
        }
        if constexpr (ALIGN_EPI) { if (wr == 0) PG8_BAR; }
        E(acc, cur, wr, wc, fr, fq);
        if (!has_next) break;
#pragma unroll
        for (int a = 0; a < 2; ++a)
#pragma unroll
            for (int b = 0; b < 2; ++b)
#pragma unroll
                for (int m = 0; m < 4; ++m)
#pragma unroll
                    for (int n = 0; n < 2; ++n) acc[a][b][m][n] = (f32x4){0.f, 0.f, 0.f, 0.f};
        cur = nxt; cA = nA; cB = nB; ++ui;
        if constexpr (ALIGN_EPI) { if (wr == 1) PG8_BAR; }
    }
    PG8_WAIT_V(0);
    if constexpr (!ALIGN_EPI) { if (wr == 0) PG8_BAR; }
    PG8_BAR;
#undef PG8_SA
#undef PG8_SB
#undef PG8_STAGE
#undef PG8_LDA
#undef PG8_LDB
#undef PG8_MMA
#undef PG8_WAIT_V
#undef PG8_WAIT_L
#undef PG8_BAR
#undef PG8_SCHED
#undef PG8_UA
#undef PG8_UB
}

struct EpiProj {
    static constexpr bool PERM = true;
    bf16_t* Q; bf16_t* KV; float* gates; float* out;
    __device__ __forceinline__ void operator()(const f32x4 (&acc)[2][2][4][2], const Unit& u, int wr, int wc, int fr, int fq) const {
        const int pn = u.pn;
#pragma unroll
        for (int ai = 0; ai < 2; ++ai)
#pragma unroll
            for (int m = 0; m < 4; ++m) {
                const int row = u.pm * BM + ai * HALF + wr * 64 + m * 16 + fr;
                if (pn < 4) {
#pragma unroll
                    for (int bj = 0; bj < 2; ++bj) { const f32x4 v0 = acc[ai][bj][m][0] * C2, v1 = acc[ai][bj][m][1] * C2; u32x4 w;
                        w.x = cvtpk(v0[0], v0[1]); w.y = cvtpk(v0[2], v0[3]); w.z = cvtpk(v1[0], v1[1]); w.w = cvtpk(v1[2], v1[3]);
                        *(u32x4*)(Q + (size_t)row * D + pn * 256 + bj * HALF + wc * 32 + 8 * fq) = w; }
                } else if (pn < 10) {
                    const int t = pn - 4; float* dst = nullptr;
                    if (row < MP) { if (t < 4) dst = out + O_KCP + (size_t)t * SZ_KVP + (size_t)row * 256; else { const int tt = row & (SEQ - 1); if (tt >= SEQ - 512) dst = out + O_KWP + (size_t)(t - 4) * SZ_WP + ((size_t)(row >> 12) * 512 + (tt - (SEQ - 512))) * 256; } }
                    else { const int rs = row - MP; if (t < 4) dst = out + O_KCS + (size_t)t * SZ_KVS + (size_t)rs * 256; else dst = out + O_KWS + (size_t)(t - 4) * SZ_WS + ((size_t)(rs >> 2) * 512 + 508 + (rs & 3)) * 256; }
                    bf16_t* bd = KV + (size_t)t * KV_STRIDE + (size_t)row * 256;
#pragma unroll
                    for (int bj = 0; bj < 2; ++bj) { const int cc = bj * HALF + wc * 32 + 8 * fq; const f32x4 v0 = acc[ai][bj][m][0], v1 = acc[ai][bj][m][1]; u32x4 w;
                        w.x = cvtpk(v0[0], v0[1]); w.y = cvtpk(v0[2], v0[3]); w.z = cvtpk(v1[0], v1[1]); w.w = cvtpk(v1[2], v1[3]);
                        *(u32x4*)(bd + cc) = w;
                        if (dst) { *(f32x4*)(dst + cc) = v0; *(f32x4*)(dst + cc + 4) = v1; } }
                } else {
                    const int cc = wc * 32 + 8 * fq;
                    if (cc < 48) { float* gd = gates + (size_t)row * 48 + cc; *(f32x4*)gd = acc[ai][0][m][0]; *(f32x4*)(gd + 4) = acc[ai][0][m][1]; }
                }
            }
    }
};
struct EpiRes {
    static constexpr bool PERM = false;
    const float* xin_p; const float* xin_s; float* xout; const float* gate; const float* scale;
    __device__ __forceinline__ void operator()(const f32x4 (&acc)[2][2][4][2], const Unit& u, int wr, int wc, int fr, int fq) const {
#pragma unroll
        for (int ai = 0; ai < 2; ++ai)
#pragma unroll
            for (int m = 0; m < 4; ++m) {
                const int row = u.pm * BM + ai * HALF + wr * 64 + m * 16 + fr;
                const int bb = row < MP ? (row >> 12) : NB + ((row - MP) >> 2);
                const float* xi = row < MP ? xin_p + (size_t)row * D : xin_s + (size_t)(row - MP) * D;
                const float* gp = gate + (size_t)bb * 6144; float* xo = xout + (size_t)row * D;
#pragma unroll
                for (int bj = 0; bj < 2; ++bj)
#pragma unroll
                    for (int n = 0; n < 2; ++n) { const int col = u.pn * BM + bj * HALF + wc * 32 + 16 * n + 4 * fq;
                        f32x4 g4 = *(const f32x4*)(gp + col); if (scale) g4 = g4 * *(const f32x4*)(scale + col);
                        const f32x4 x4 = *(const f32x4*)(xi + col); *(f32x4*)(xo + col) = x4 + g4 * acc[ai][bj][m][n]; }
            }
    }
};
struct EpiGU {
    static constexpr bool PERM = true;
    bf16_t* act;
    __device__ __forceinline__ void operator()(const f32x4 (&acc)[2][2][4][2], const Unit& u, int wr, int wc, int fr, int fq) const {
#pragma unroll
        for (int ai = 0; ai < 2; ++ai)
#pragma unroll
            for (int m = 0; m < 4; ++m) {
                const int row = u.pm * BM + ai * HALF + wr * 64 + m * 16 + fr; float r[8];
#pragma unroll
                for (int n = 0; n < 2; ++n)
#pragma unroll
                    for (int e = 0; e < 4; ++e) { const float gv = acc[ai][0][m][n][e], uv = acc[ai][1][m][n][e]; r[n * 4 + e] = gv * sigmoidf_(gv) * uv; }
                u32x4 w; w.x = cvtpk(r[0], r[1]); w.y = cvtpk(r[2], r[3]); w.z = cvtpk(r[4], r[5]); w.w = cvtpk(r[6], r[7]);
                *(u32x4*)(act + (size_t)row * FF + u.pn * HALF + wc * 32 + 8 * fq) = w;
            }
    }
};
}

#define XB_TMO      128
#define XB_XCNT(j)  (256  + 64 * (j))
#define XB_XSUB(j)  (1280 + 64 * (j))
#define XB_XGEN(j)  (2304 + 64 * (j))
#define XB_TOP      3328
#define XB_TOPGEN   3392
#define XCD_BAR_WORDS 3456
#define XB_SPIN_CAP (1u << 18)
__device__ __forceinline__ unsigned xb_ld(unsigned* p)              { return __hip_atomic_load(p, __ATOMIC_RELAXED, __HIP_MEMORY_SCOPE_AGENT); }
__device__ __forceinline__ unsigned xb_add(unsigned* p, unsigned v) { return __hip_atomic_fetch_add(p, v, __ATOMIC_RELAXED, __HIP_MEMORY_SCOPE_AGENT); }
__device__ __forceinline__ unsigned xb_xcc_id() { return (unsigned)__builtin_amdgcn_s_getreg((3 << 11) | 20) & 0xFu; }
#define XB_SPIN(cond, bar) do { unsigned _sp = 0; while (cond) { __builtin_amdgcn_s_sleep(1); \
    if ((++_sp & 255u) == 0u) { if (xb_ld(&(bar)[XB_TMO])) break; if (_sp > XB_SPIN_CAP) { atomicAdd(&(bar)[XB_TMO], 1u); break; } } } } while (0)
struct XcdBarrier { unsigned* bar; unsigned x; volatile LAS unsigned* st; };
__device__ __forceinline__ XcdBarrier xcd_barrier_post(unsigned* bar, volatile LAS unsigned* st) {
    XcdBarrier b; b.bar = bar; b.x = xb_xcc_id(); b.st = st;
    if (threadIdx.x == 0) (void)xb_add(&bar[XB_XCNT(b.x)], 1u);
    return b;
}
__device__ __forceinline__ void xcd_barrier_complete(unsigned* bar, unsigned x, unsigned& nloc, unsigned& nx) {
    const unsigned G = gridDim.x * gridDim.y * gridDim.z;
    unsigned sum, cnt, mine, sp = 0u;
    for (;;) {
        sum = 0u; cnt = 0u; mine = 0u;
#pragma unroll
        for (unsigned j = 0; j < 16; ++j) { const unsigned c = xb_ld(&bar[XB_XCNT(j)]); sum += c; cnt += (c > 0u) ? 1u : 0u; mine = (j == x) ? c : mine; }
        if (sum == G) break;
        __builtin_amdgcn_s_sleep(1);
        if ((++sp & 255u) == 0u) { if (xb_ld(&bar[XB_TMO])) break; if (sp > XB_SPIN_CAP) { atomicAdd(&bar[XB_TMO], 1u); break; } }
    }
    nloc = mine > 0u ? mine : 1u; nx = cnt > 0u ? cnt : 1u;
}
__device__ __forceinline__ void xcd_barrier(const XcdBarrier& b) {
    asm volatile("s_waitcnt vmcnt(0)" ::: "memory");
    __syncthreads();
    if (threadIdx.x == 0) {
        unsigned* bar = b.bar;
        __builtin_amdgcn_s_waitcnt(0);
        unsigned nloc = b.st[0], nx = b.st[1];
        if (nloc == 0u) { xcd_barrier_complete(bar, b.x, nloc, nx); b.st[0] = nloc; b.st[1] = nx; }
        const unsigned old = xb_add(&bar[XB_XSUB(b.x)], 1u);
        const unsigned gen = old / nloc;
        if (old + 1u == (gen + 1u) * nloc) {
            __builtin_amdgcn_fence(__ATOMIC_RELEASE, "agent");
            asm volatile("s_waitcnt vmcnt(0)" ::: "memory");
            const unsigned og = xb_add(&bar[XB_TOP], 1u);
            const unsigned tg = og / nx;
            if (og + 1u == (tg + 1u) * nx) xb_add(&bar[XB_TOPGEN], 1u);
            else XB_SPIN(xb_ld(&bar[XB_TOPGEN]) == tg, bar);
            __builtin_amdgcn_fence(__ATOMIC_ACQUIRE, "agent");
            xb_add(&bar[XB_XGEN(b.x)], 1u);
            asm volatile("s_waitcnt vmcnt(0)" ::: "memory");
        } else {
            XB_SPIN(xb_ld(&bar[XB_XGEN(b.x)]) == gen, bar);
            __builtin_amdgcn_fence(__ATOMIC_ACQUIRE, "agent");
            asm volatile("s_waitcnt vmcnt(0)" ::: "memory");
        }
    }
    __syncthreads();
}

struct Args { const void* in[28]; float* out; unsigned char* ws; int ph_lo, ph_hi, pad0, pad1; };
struct Frame {
    LAS unsigned char* lds; int tid, lane, wave, vcu, G;
    const float *x_p, *x_s, *c_p, *c_s, *ck_cmp, *cv_cmp, *ck_sel, *cv_sel; const int* page_table; const float *st_kw, *st_vw, *st_pool, *rel_bias, *ada_w, *ada_b, *norm_g, *final_g,
        *w_in, *w_out, *cmp_wk, *cmp_wv, *pe_k, *pe_v, *pool_w, *pool_scale, *ffn_wg, *ffn_wu, *ffn_wd;
    float* out; unsigned char* ws;
};
__device__ __forceinline__ float wave_sum(float v) {
#pragma unroll
    for (int o = 1; o < 64; o <<= 1) v += __shfl_xor(v, o);
    return v;
}

__device__ __forceinline__ void transpose_item(const float* W, int ldw, int nvalid, bf16_t* WT, int ldt, int drow0, LAS float* scr, int k0, int n0, int lane) {
    float tv[32];
#pragma unroll
    for (int i = 0; i < 32; ++i) { const int kk = 2 * i + (lane >> 5), n = n0 + (lane & 31); tv[i] = (n < nvalid) ? W[(size_t)(k0 + kk) * ldw + n] : 0.f; }
#pragma unroll
    for (int i = 0; i < 32; ++i) { const int kk = 2 * i + (lane >> 5); scr[kk * 33 + (lane & 31)] = tv[i]; }
    LDS_WAIT();
    const int c = lane & 7;
#pragma unroll
    for (int j = 0; j < 4; ++j) { const int n = (lane >> 3) + 8 * j; const LAS float* s = scr + (8 * c) * 33 + n;
        u32x4 o; o.x = cvtpk(s[0 * 33], s[1 * 33]); o.y = cvtpk(s[2 * 33], s[3 * 33]); o.z = cvtpk(s[4 * 33], s[5 * 33]); o.w = cvtpk(s[6 * 33], s[7 * 33]);
        *(u32x4*)(WT + (size_t)(drow0 + n) * ldt + k0 + 8 * c) = o; }
    LDS_WAIT();
}
__device__ __forceinline__ void p0_prologue(Frame& F) {
    LAS float* scr = (LAS float*)(F.lds + F.wave * 16384);
    const int gw = F.vcu * 8 + F.wave, NGW = F.G * 8, lane = F.lane;
    unsigned char* ws = F.ws;
    constexpr int I_IN = 16 * 88, I_OUT = 16 * 32, I_G = 16 * 88, I_D = 44 * 32, I_P = 4 * 8, I_C = 32 * 2;
    constexpr int NITEMS = I_IN + I_OUT + 4 * I_G + 2 * I_D + 4 * I_P + 2 * I_C;
    for (int it = gw; it < NITEMS; it += NGW) {
        int r = it;
        if (r < I_IN) { const int kb = r / 88, nb = r % 88; transpose_item(F.w_in, INCOLS, INCOLS, (bf16_t*)(ws + WS_WIN), D, nb * 32, scr, kb * 64, nb * 32, lane); continue; } r -= I_IN;
        if (r < I_OUT) { const int kb = r / 32, nb = r % 32; transpose_item(F.w_out, D, D, (bf16_t*)(ws + WS_WOUT), D, nb * 32, scr, kb * 64, nb * 32, lane); continue; } r -= I_OUT;
        if (r < 4 * I_G) { const int l = r / (2 * I_G), which = (r / I_G) & 1, q = r % I_G, kb = q / 88, nb = q % 88, n0 = nb * 32;
            const float* W = (which ? F.ffn_wu : F.ffn_wg) + (size_t)l * D * FF;
            transpose_item(W, FF, FF, (bf16_t*)(ws + WS_WGU) + (size_t)l * NGU * D, D, (n0 >> 7) * 256 + which * 128 + (n0 & 127), scr, kb * 64, n0, lane); continue; } r -= 4 * I_G;
        if (r < 2 * I_D) { const int l = r / I_D, q = r % I_D, kb = q / 32, nb = q % 32;
            transpose_item(F.ffn_wd + (size_t)l * FF * D, D, D, (bf16_t*)(ws + WS_WD) + (size_t)l * D * FF, FF, nb * 32, scr, kb * 64, nb * 32, lane); continue; } r -= 2 * I_D;
        if (r < 4 * I_P) { const int gI = r / I_P, q = r % I_P, kb = q / 8, nb = q % 8;
            transpose_item(F.pool_w + (size_t)gI * 65536, 256, 256, (bf16_t*)(ws + WS_WPOOL) + (size_t)gI * 65536, 256, nb * 32, scr, kb * 64, nb * 32, lane); continue; } r -= 4 * I_P;
        { const int which = r / I_C, q = r % I_C, kb = q / 2, nb = q % 2;
          transpose_item(which ? F.cmp_wv : F.cmp_wk, 64, 64, (bf16_t*)(ws + (which ? WS_WCV : WS_WCK)), 2048, nb * 32, scr, kb * 64, nb * 32, lane); }
    }
    { const int gt = (F.vcu * 8 + F.wave) * 64 + lane, NT = F.G * 512; bf16_t* sc = (bf16_t*)(ws + WS_SC);
      for (int i = gt; i < 144 * 512; i += NT) { const int row = i >> 9, c2 = (i & 511) * 2; float a = 0.f, b = 0.f;
          if (row < NMODB) { const float* cp = row < NB ? F.c_p + (size_t)row * D : F.c_s + (size_t)(row - NB) * D; const float x0 = cp[c2], x1 = cp[c2 + 1]; a = x0 * sigmoidf_(x0); b = x1 * sigmoidf_(x1); }
          *(unsigned*)(sc + (size_t)row * D + c2) = cvtpk(a, b); } }
    if (F.vcu < 16) { const int tsel = F.vcu >> 3, part = F.vcu & 7; const float* pe = tsel ? F.pe_v : F.pe_k; const float* W = tsel ? F.cmp_wv : F.cmp_wk; float sacc = 0.f;
        const int kb = part * 256 + F.wave * 32;
#pragma unroll
        for (int k = 0; k < 32; ++k) sacc += pe[kb + k] * W[(size_t)(kb + k) * 64 + lane];
        LAS float* red = (LAS float*)(F.lds + WSF_OFF);
        red[F.wave * 64 + lane] = sacc; LDS_WAIT(); __syncthreads();
        if (F.wave == 0) { float t2 = 0.f;
#pragma unroll
            for (int w = 0; w < 8; ++w) t2 += red[w * 64 + lane];
            ((float*)(ws + WS_CB))[(tsel * 8 + part) * 64 + lane] = t2; }
        __syncthreads(); }
    { const size_t gt = (size_t)(F.vcu * 8 + F.wave) * 64 + lane, NT = (size_t)F.G * 512;
      const size_t pp = (size_t)NSB * 11 * 256;
      for (size_t i = gt; i < pp; i += NT) { const size_t b = i / (11 * 256), rem = i % (11 * 256);
          ((f32x4*)(F.out + O_PLS + b * 15 * D))[rem] = ((const f32x4*)(F.st_pool + (b * 15 + 4) * D))[rem]; } }
}

__device__ __forceinline__ void p1_ada(Frame& F) {
    const int gw = F.vcu * 8 + F.wave, NGW = F.G * 8, lane = F.lane, fr = lane & 15, kq = lane >> 4;
    const bf16_t* sc = (const bf16_t*)(F.ws + WS_SC); float* mod = (float*)(F.ws + WS_MOD);
    for (int tile = F.wave < 3 ? F.vcu * 3 + F.wave : 768; tile < 768; tile += F.G * 3) {
        const int layer = tile / 384, n0 = (tile % 384) * 16;
        const float* W = F.ada_w + (size_t)layer * D * 6144 + n0 + fr;
        f32x4 acc[9];
#pragma unroll
        for (int i = 0; i < 9; ++i) acc[i] = (f32x4){0.f, 0.f, 0.f, 0.f};
#pragma unroll 4
        for (int k0 = 0; k0 < D; k0 += 32) {
            float w[8];
#pragma unroll
            for (int i = 0; i < 8; ++i) w[i] = W[(size_t)(k0 + 8 * kq + i) * 6144];
            u32x4 bw; bw.x = cvtpk(w[0], w[1]); bw.y = cvtpk(w[2], w[3]); bw.z = cvtpk(w[4], w[5]); bw.w = cvtpk(w[6], w[7]);
            const bf16x8 bfrag = __builtin_bit_cast(bf16x8, bw);
#pragma unroll
            for (int mt = 0; mt < 9; ++mt) { const bf16x8 af = *(const bf16x8*)(sc + (size_t)(mt * 16 + fr) * D + k0 + 8 * kq);
                acc[mt] = __builtin_amdgcn_mfma_f32_16x16x32_bf16(af, bfrag, acc[mt], 0, 0, 0); }
        }
        const float bias = F.ada_b[layer * 6144 + n0 + fr];
#pragma unroll
        for (int mt = 0; mt < 9; ++mt)
#pragma unroll
            for (int e = 0; e < 4; ++e) { const int row = mt * 16 + 4 * kq + e; if (row < NMODB) mod[((size_t)layer * NMODB + row) * 6144 + n0 + fr] = acc[mt][e] + bias; }
    }
}

__device__ __forceinline__ void p1_compress_sample(Frame& F) {
    const int lane = F.lane, wave = F.wave, r32 = lane & 31, hi = lane >> 5, kvl = lane >> 4, c4 = lane & 15;
    LAS unsigned char* L = F.lds;
    const int wrow = wave * 4 + kvl, total = 2 * NSB * 8;
    const int nitem = (total - F.vcu + F.G - 1) / F.G; if (nitem <= 0) return;
    const int nstage = 2 * nitem;
#define CS_BAR() do { asm volatile("s_waitcnt lgkmcnt(0)" ::: "memory"); __builtin_amdgcn_s_barrier(); asm volatile("" ::: "memory"); } while (0)
#define CS_SRC(g, ptr) do { const int it_ = F.vcu + F.G * ((g) >> 1); const int wh_ = it_ / (NSB * 8), q_ = it_ % (NSB * 8), b_ = q_ >> 3, n_ = (q_ & 7) * 8 + wave; const int pg_ = F.page_table[b_ * 16 + (n_ >> 2)]; \
        ptr = uniform_ptr((wh_ ? F.cv_cmp : F.ck_cmp) + ((size_t)pg_ * 128 + (n_ & 3) * 32 + ((g) & 1) * 16) * 256); } while (0)
#define CS_LOAD(ptr) do { _Pragma("unroll") for (int jj = 0; jj < 16; ++jj) x[jj] = *(const f32x4*)((ptr) + (unsigned)(jj * 1024 + lane * 16)); } while (0)
#define CS_STORE(buf) do { _Pragma("unroll") for (int jj = 0; jj < 16; ++jj) { u32x2 w_; w_.x = cvtpk(x[jj][0], x[jj][1]); w_.y = cvtpk(x[jj][2], x[jj][3]); \
        *(LAS u32x2*)(L + (buf) * 65536 + wrow * 2048 + (((jj * 8 + (c4 >> 1)) ^ (wrow & 15)) << 4) + (c4 & 1) * 8) = w_; } } while (0)
    f32x4 x[16]; const char* sp;
    CS_SRC(0, sp); CS_LOAD(sp); CS_STORE(0); CS_BAR();
    f32x16 a0, a1;
#pragma unroll
    for (int r = 0; r < 16; ++r) { a0[r] = 0.f; a1[r] = 0.f; }
#pragma unroll 1
    for (int g = 0; g < nstage; ++g) {
        const int it = F.vcu + F.G * (g >> 1), which = it / (NSB * 8), q = it % (NSB * 8), b = q >> 3, n0 = (q & 7) * 8;
        const bf16_t* wp = (const bf16_t*)(F.ws + (which ? WS_WCV : WS_WCK)) + (size_t)r32 * 2048 + (g & 1) * 1024 + 128 * wave + 8 * hi;
        bf16x8 bfr[16];
#pragma unroll
        for (int ks = 0; ks < 8; ++ks) { bfr[2 * ks] = *(const bf16x8*)(wp + 16 * ks); bfr[2 * ks + 1] = *(const bf16x8*)(wp + 32 * 2048 + 16 * ks); }
        if (g + 1 < nstage) { CS_SRC(g + 1, sp); CS_LOAD(sp); }
        const LAS unsigned char* ab = L + (g & 1) * 65536 + r32 * 2048;
#pragma unroll
        for (int ks = 0; ks < 8; ++ks) { const bf16x8 af = *(const LAS bf16x8*)(ab + (((16 * wave + 2 * ks + hi) ^ (r32 & 15)) << 4));
            a0 = __builtin_amdgcn_mfma_f32_32x32x16_bf16(af, bfr[2 * ks], a0, 0, 0, 0); a1 = __builtin_amdgcn_mfma_f32_32x32x16_bf16(af, bfr[2 * ks + 1], a1, 0, 0, 0); }
        CS_BAR();
        if (g & 1) {
            LAS float* red = (LAS float*)(L + 65536) + wave * 2048 + hi * 256 + r32;
#pragma unroll
            for (int r = 0; r < 16; ++r) { red[CROW0(r) * 64] = a0[r]; red[CROW0(r) * 64 + 32] = a1[r]; a0[r] = 0.f; a1[r] = 0.f; }
            CS_BAR();
            { const int row = F.tid >> 4, cc = (F.tid & 15) * 4; f32x4 sacc = (f32x4){0.f, 0.f, 0.f, 0.f};
#pragma unroll
              for (int pp = 0; pp < 8; ++pp) sacc = sacc + *(const f32x4*)((const float*)(F.ws + WS_CB) + (which * 8 + pp) * 64 + cc);
#pragma unroll
              for (int w = 0; w < 8; ++w) sacc = sacc + *(const LAS f32x4*)((const LAS float*)(L + 65536) + w * 2048 + row * 64 + cc);
              bf16_t* o = (bf16_t*)(F.ws + (which ? WS_VCMPS : WS_KCMPS)) + (size_t)b * 4 * 64 * 64 + ((size_t)(row & 3) * 64 + n0 + (row >> 2)) * 64 + cc;
              u32x2 w2; w2.x = cvtpk(sacc[0], sacc[1]); w2.y = cvtpk(sacc[2], sacc[3]); *(u32x2*)o = w2; }
        }
        if (g + 1 < nstage) CS_STORE((g + 1) & 1);
        CS_BAR();
    }
    VM_WAIT(); __syncthreads();
#undef CS_BAR
#undef CS_SRC
#undef CS_LOAD
#undef CS_STORE
}
__device__ __forceinline__ void p4_compress_prompt(Frame& F) {
    const int lane = F.lane, r32 = lane & 31, hi = lane >> 5, nl = r32 >> 2, kv = r32 & 3;
    for (int it = F.vcu; it < 2 * NB * 16; it += F.G) {
        const int which = it / (NB * 16), q = it % (NB * 16), b = q >> 4, n0 = (q & 15) * 8, n = n0 + nl;
        const bf16_t* src = (const bf16_t*)(F.ws + WS_KV) + (size_t)which * KV_STRIDE + ((size_t)b * SEQ + (size_t)n * 32) * 256 + kv * 64;
        const bf16_t* Wt = (const bf16_t*)(F.ws + (which ? WS_WCV : WS_WCK));
        const bf16_t* w0 = Wt + (size_t)r32 * 2048 + hi * 8; const bf16_t* w1 = w0 + (size_t)32 * 2048;
        f32x16 a0, a1;
#pragma unroll
        for (int r = 0; r < 16; ++r) { a0[r] = 0.f; a1[r] = 0.f; }
#pragma unroll
        for (int jj = 0; jj < 4; ++jj) { const int j = F.wave * 4 + jj;
#pragma unroll
            for (int ds = 0; ds < 4; ++ds) { const bf16x8 af = *(const bf16x8*)(src + (size_t)j * 256 + ds * 16 + hi * 8);
                const bf16x8 b0 = *(const bf16x8*)(w0 + j * 64 + ds * 16), b1 = *(const bf16x8*)(w1 + j * 64 + ds * 16);
                a0 = __builtin_amdgcn_mfma_f32_32x32x16_bf16(af, b0, a0, 0, 0, 0); a1 = __builtin_amdgcn_mfma_f32_32x32x16_bf16(af, b1, a1, 0, 0, 0); } }
        LAS float* red = (LAS float*)F.lds + F.wave * 2048 + hi * 256 + r32;
#pragma unroll
        for (int r = 0; r < 16; ++r) { red[CROW0(r) * 64] = a0[r]; red[CROW0(r) * 64 + 32] = a1[r]; }
        LDS_WAIT(); __syncthreads();
        { const int row = F.tid >> 4, c4 = (F.tid & 15) * 4; f32x4 sacc = (f32x4){0.f, 0.f, 0.f, 0.f};
#pragma unroll
          for (int pp = 0; pp < 8; ++pp) sacc = sacc + *(const f32x4*)((const float*)(F.ws + WS_CB) + (which * 8 + pp) * 64 + c4);
#pragma unroll
          for (int w = 0; w < 8; ++w) sacc = sacc + *(const LAS f32x4*)((const LAS float*)F.lds + w * 2048 + row * 64 + c4);
          bf16_t* o = (bf16_t*)(F.ws + (which ? WS_VCMPP : WS_KCMPP)) + (size_t)b * 4 * 128 * 64 + ((size_t)(row & 3) * 128 + n0 + (row >> 2)) * 64 + c4;
          u32x2 w2; w2.x = cvtpk(sacc[0], sacc[1]); w2.y = cvtpk(sacc[2], sacc[3]); *(u32x2*)o = w2; }
        __syncthreads();
    }
}

__device__ __forceinline__ void small_gemm_res(Frame& F, const bf16_t* A  , int lda, const bf16_t* Wt, int ldb, int K, bool bd, const float* xin_s, float* xout_s, const float* gate, const float* scale) {
    const int lane = F.lane, r32 = lane & 31, hi = lane >> 5, kw = K >> 3, kbeg = F.wave * kw;
    for (int tile = F.vcu; tile < 256; tile += F.G) {
        const int row0 = (tile >> 4) * 32, col0 = (tile & 15) * 64, acol = bd ? (col0 >> 8) * 256 : 0;
        const bf16_t* ap = A + (size_t)(row0 + r32) * lda + acol + kbeg + 8 * hi;
        const bf16_t* b0p = Wt + (size_t)(col0 + r32) * ldb + kbeg + 8 * hi; const bf16_t* b1p = b0p + (size_t)32 * ldb;
        f32x16 c0, c1;
#pragma unroll
        for (int r = 0; r < 16; ++r) { c0[r] = 0.f; c1[r] = 0.f; }
#pragma unroll 8
        for (int ks = 0; ks < kw; ks += 16) { const bf16x8 a = *(const bf16x8*)(ap + ks), b0 = *(const bf16x8*)(b0p + ks), b1 = *(const bf16x8*)(b1p + ks);
            c0 = __builtin_amdgcn_mfma_f32_32x32x16_bf16(a, b0, c0, 0, 0, 0); c1 = __builtin_amdgcn_mfma_f32_32x32x16_bf16(a, b1, c1, 0, 0, 0); }
        LAS float* red = (LAS float*)F.lds + F.wave * 2048 + hi * 256 + r32;
#pragma unroll
        for (int r = 0; r < 16; ++r) { red[CROW0(r) * 64] = c0[r]; red[CROW0(r) * 64 + 32] = c1[r]; }
        LDS_WAIT(); __syncthreads();
        { const int row = F.tid >> 4, c4 = (F.tid & 15) * 4; f32x4 sacc = (f32x4){0.f, 0.f, 0.f, 0.f};
#pragma unroll
          for (int w = 0; w < 8; ++w) sacc = sacc + *(const LAS f32x4*)((const LAS float*)F.lds + w * 2048 + row * 64 + c4);
          const int rs = row0 + row, col = col0 + c4, bb = NB + (rs >> 2);
          f32x4 g4 = *(const f32x4*)(gate + (size_t)bb * 6144 + col); if (scale) g4 = g4 * *(const f32x4*)(scale + col);
          const f32x4 x4 = *(const f32x4*)(xin_s + (size_t)rs * D + col); *(f32x4*)(xout_s + (size_t)rs * D + col) = x4 + g4 * sacc; }
        __syncthreads();
    }
}

template <int MODE, int NR>
__device__ __forceinline__ void norm_rows(Frame& F, bool from_inputs, int layer, int which, int row0, const f32x4 (&gg)[4], int lane) {
    const float* X = (const float*)(F.ws + WS_X);
    const float* xr = from_inputs ? (row0 < MP ? F.x_p + (size_t)row0 * D : F.x_s + (size_t)(row0 - MP) * D) : X + (size_t)row0 * D;
    f32x4 v[NR][4];
#pragma unroll
    for (int r = 0; r < NR; ++r)
#pragma unroll
        for (int j = 0; j < 4; ++j) v[r][j] = *(const f32x4*)(xr + (size_t)r * D + 4 * lane + 256 * j);
    f32x4 sh[4], sc[4];
    if constexpr (MODE != 2) {
        const int bb = row0 < MP ? (row0 >> 12) : NB + ((row0 - MP) >> 2);
        const float* mp = (const float*)(F.ws + WS_MOD) + ((size_t)layer * NMODB + bb) * 6144 + (which ? 3072 : 0);
#pragma unroll
        for (int j = 0; j < 4; ++j) { sh[j] = *(const f32x4*)(mp + 4 * lane + 256 * j); sc[j] = *(const f32x4*)(mp + 1024 + 4 * lane + 256 * j) + 1.0f; }
    }
    float ss[NR];
#pragma unroll
    for (int r = 0; r < NR; ++r) { float a = 0.f;
#pragma unroll
        for (int j = 0; j < 4; ++j) a += (v[r][j][0] * v[r][j][0] + v[r][j][1] * v[r][j][1]) + (v[r][j][2] * v[r][j][2] + v[r][j][3] * v[r][j][3]);
        ss[r] = a; }
#pragma unroll
    for (int o = 1; o < 64; o <<= 1) {
#pragma unroll
        for (int r = 0; r < NR; ++r) ss[r] += __shfl_xor(ss[r], o); }
#pragma unroll
    for (int r = 0; r < NR; ++r) {
        const int row = row0 + r; const float rstd = 1.0f / sqrtf(ss[r] * (1.0f / D) + 1e-6f);
        if constexpr (MODE == 2) {
            float* o = row < MP ? F.out + O_YP + (size_t)row * D : F.out + O_YS + (size_t)(row - MP) * D;
#pragma unroll
            for (int j = 0; j < 4; ++j) *(f32x4*)(o + 4 * lane + 256 * j) = v[r][j] * rstd * gg[j];
        } else {
            float* pool_dst = nullptr;
            if constexpr (MODE == 1) {
                if (row < MP) { const int tt = row & (SEQ - 1); if (tt >= SEQ - 15) pool_dst = F.out + O_PLP + ((size_t)(row >> 12) * 15 + (tt - (SEQ - 15))) * D; }
                else { const int rs = row - MP; pool_dst = F.out + O_PLS + ((size_t)(rs >> 2) * 15 + 11 + (rs & 3)) * D; }
            }
#pragma unroll
            for (int j = 0; j < 4; ++j) { const int col = 4 * lane + 256 * j; const f32x4 h = (v[r][j] * rstd * gg[j]) * sc[j] + sh[j];
                if constexpr (MODE == 0) { u32x2 w; w.x = cvtpk(h[0], h[1]); w.y = cvtpk(h[2], h[3]); *(u32x2*)((bf16_t*)(F.ws + WS_H) + (size_t)row * D + col) = w; }
                else { *(f32x4*)((float*)(F.ws + WS_HF) + (size_t)row * D + col) = h; if (pool_dst) *(f32x4*)(pool_dst + col) = h; } }
        }
    }
}
template <int MODE>
__device__ __forceinline__ void norm_phase(Frame& F, bool from_inputs, int layer, int which) {
    const int gw = F.vcu * 8 + F.wave, NGW = F.G * 8, lane = lane_id();
    const float* gvec = MODE == 2 ? F.final_g : F.norm_g + (size_t)(layer * 2 + which) * D;
    f32x4 gg[4];
#pragma unroll
    for (int j = 0; j < 4; ++j) gg[j] = *(const f32x4*)(gvec + 4 * lane + 256 * j);
#pragma unroll 1
    for (int grp = gw; grp < MP / 8; grp += NGW) norm_rows<MODE, 8>(F, from_inputs, layer, which, grp * 8, gg, lane);
#pragma unroll 1
    for (int r = gw; r < MS; r += NGW) norm_rows<MODE, 1>(F, from_inputs, layer, which, MP + r, gg, lane);
}

template <int W, int R, bool SAMPLE>
__device__ __forceinline__ void pool_chunk(const float* HF, const float* st_pool, bf16_t* H, int row0, int col) {
    f32x4 v[R + W - 1];
    const int t0 = SAMPLE ? 0 : (row0 & (SEQ - 1));
#pragma unroll
    for (int k = 0; k < R + W - 1; ++k) { const int tt = t0 - (W - 1) + k;
        if (SAMPLE) { const int b = (row0 - MP) >> 2; v[k] = tt >= 0 ? *(const f32x4*)(HF + (size_t)(row0 + tt) * D + col) : *(const f32x4*)(st_pool + ((size_t)b * 15 + 15 + tt) * D + col); }
        else v[k] = tt >= 0 ? *(const f32x4*)(HF + (size_t)(row0 - (W - 1) + k) * D + col) : (f32x4){0.f, 0.f, 0.f, 0.f}; }
    f32x4 sacc = v[0];
#pragma unroll
    for (int k = 1; k < W; ++k) sacc = sacc + v[k];
#pragma unroll
    for (int r = 0; r < R; ++r) {
        if (r > 0) sacc = sacc + v[r + W - 1] - v[r - 1];
        const int tt = t0 + r; const float inv = 1.0f / (float)(SAMPLE ? W : (tt + 1 < W ? tt + 1 : W));
        const f32x4 cur = v[r + W - 1], pv = sacc * inv - cur;
        u32x2 w2; w2.x = cvtpk(pv[0], pv[1]); w2.y = cvtpk(pv[2], pv[3]); *(u32x2*)(H + (size_t)(row0 + r) * D + col) = w2; }
}
__device__ __forceinline__ void pool_phase(Frame& F) {
    const int gt = (F.vcu * 8 + F.wave) * 64 + lane_id(), NT = F.G * 512;
    const float* HF = (const float*)(F.ws + WS_HF); bf16_t* H = (bf16_t*)(F.ws + WS_H);
    constexpr int NPI = (MP / 8) * 256, NSI = (MS / 4) * 256;
#pragma unroll 1
    for (int i = gt; i < NPI + NSI; i += NT) {
        const bool smp = i >= NPI; const int q = smp ? i - NPI : i; const int cg = q & 255, col = cg * 4, grp = cg >> 6;
        if (!smp) { const int row0 = (q >> 8) * 8;
            if (grp == 0) pool_chunk<2, 8, false>(HF, F.st_pool, H, row0, col); else if (grp == 1) pool_chunk<4, 8, false>(HF, F.st_pool, H, row0, col);
            else if (grp == 2) pool_chunk<8, 8, false>(HF, F.st_pool, H, row0, col); else pool_chunk<16, 8, false>(HF, F.st_pool, H, row0, col); }
        else { const int row0 = MP + (q >> 8) * 4;
            if (grp == 0) pool_chunk<2, 4, true>(HF, F.st_pool, H, row0, col); else if (grp == 1) pool_chunk<4, 4, true>(HF, F.st_pool, H, row0, col);
            else if (grp == 2) pool_chunk<8, 4, true>(HF, F.st_pool, H, row0, col); else pool_chunk<16, 4, true>(HF, F.st_pool, H, row0, col); }
    }
}

namespace att {
__device__ __forceinline__ int crow(int r, int hi) { return (r & 3) + 8 * (r >> 2) + 4 * hi; }
__device__ __forceinline__ float x32_sum(float v) { auto rr = __builtin_amdgcn_permlane32_swap(__float_as_uint(v), __float_as_uint(v), false, false); return __uint_as_float(rr[0]) + __uint_as_float(rr[1]); }
__device__ __forceinline__ float x32_max(float v) { auto rr = __builtin_amdgcn_permlane32_swap(__float_as_uint(v), __float_as_uint(v), false, false); return fmaxf(__uint_as_float(rr[0]), __uint_as_float(rr[1])); }
__device__ __forceinline__ unsigned x32_or(unsigned v) { auto rr = __builtin_amdgcn_permlane32_swap(v, v, false, false); return rr[0] | rr[1]; }
template <int X> __device__ __forceinline__ unsigned swz_xor(unsigned v) { return (unsigned)__builtin_amdgcn_ds_swizzle((int)v, (X << 10) | 0x1F); }
template <int X> __device__ __forceinline__ float swz_xorf(float v) { return __uint_as_float(swz_xor<X>(__float_as_uint(v))); }
__device__ __forceinline__ s16x4 vtr(const LAS unsigned char* p) { typedef short v4i16_t __attribute__((ext_vector_type(4))); return __builtin_bit_cast(s16x4, __builtin_amdgcn_ds_read_tr16_b64_v4i16((LAS v4i16_t*)p)); }
__device__ __forceinline__ void qk_tile(f32x16& p0, f32x16& p1, const LAS unsigned char* Kb, const bf16x8 (&qr)[4], float init, int r32, int hi) {
    f32x16 ci;
#pragma unroll
    for (int r = 0; r < 16; ++r) ci[r] = init;
    const int sw = (r32 >> 1) & 7;
    bf16x8 ka[4], kb[4];
#pragma unroll
    for (int ds = 0; ds < 4; ++ds) { const int ch = ((2 * ds + hi) ^ sw) << 4; ka[ds] = *(const LAS bf16x8*)(Kb + r32 * 128 + ch); kb[ds] = *(const LAS bf16x8*)(Kb + (32 + r32) * 128 + ch); }
    __builtin_amdgcn_s_setprio(1);
    f32x16 c0 = __builtin_amdgcn_mfma_f32_32x32x16_bf16(ka[0], qr[0], ci, 0, 0, 0);
    f32x16 c1 = __builtin_amdgcn_mfma_f32_32x32x16_bf16(kb[0], qr[0], ci, 0, 0, 0);
#pragma unroll
    for (int ds = 1; ds < 4; ++ds) {
        c0 = __builtin_amdgcn_mfma_f32_32x32x16_bf16(ka[ds], qr[ds], c0, 0, 0, 0);
        c1 = __builtin_amdgcn_mfma_f32_32x32x16_bf16(kb[ds], qr[ds], c1, 0, 0, 0);
    }
    __builtin_amdgcn_s_setprio(0);
    p0 = c0; p1 = c1;
}
__device__ __forceinline__ void pv_tile(f32x16 (&o)[2], const LAS unsigned char* Vb, const f32x16& p0, const f32x16& p1, int lane) {
    const int g4 = lane >> 4, nhalf = g4 & 1, h = g4 >> 1, i = lane & 15, q = i >> 2, pp = i & 3;
    const LAS unsigned char* vb = Vb + (4 * h + q) * 64 + nhalf * 32 + pp * 8;
#pragma unroll
    for (int kh = 0; kh < 2; ++kh) {
        s16x4 lo[2][2], hh[2][2];
#pragma unroll
        for (int s = 0; s < 2; ++s)
#pragma unroll
            for (int db = 0; db < 2; ++db) { lo[s][db] = vtr(vb + db * 4096 + (32 * kh + 16 * s) * 64); hh[s][db] = vtr(vb + db * 4096 + (32 * kh + 16 * s + 8) * 64); }
#pragma unroll
        for (int s = 0; s < 2; ++s) {
            const f32x16& p = kh ? p1 : p0; u32x4 pw;
            pw.x = cvtpk(p[8 * s + 0], p[8 * s + 1]); pw.y = cvtpk(p[8 * s + 2], p[8 * s + 3]); pw.z = cvtpk(p[8 * s + 4], p[8 * s + 5]); pw.w = cvtpk(p[8 * s + 6], p[8 * s + 7]);
            const bf16x8 pa = __builtin_bit_cast(bf16x8, pw);
#pragma unroll
            for (int db = 0; db < 2; ++db) {
                const bf16x8 vf = (bf16x8){lo[s][db][0], lo[s][db][1], lo[s][db][2], lo[s][db][3], hh[s][db][0], hh[s][db][1], hh[s][db][2], hh[s][db][3]};
                o[db] = __builtin_amdgcn_mfma_f32_32x32x16_bf16(pa, vf, o[db], 0, 0, 0);
            }
        }
    }
}
__device__ __forceinline__ void row_scale(f32x16 (&o)[2], float f, LAS float* wsf, int r32, int hi) {
    if (hi == 0) wsf[r32] = f;
    LDS_WAIT();
    const LAS float* wh = wsf + 4 * hi;
#pragma unroll
    for (int r = 0; r < 16; ++r) { const float fr = wh[CROW0(r)]; o[0][r] *= fr; o[1][r] *= fr; }
    LDS_WAIT();
}
__device__ __forceinline__ void row_fma(f32x16 (&dst)[2], const f32x16 (&o)[2], float f, LAS float* wsf, int r32, int hi) {
    if (hi == 0) wsf[r32] = f;
    LDS_WAIT();
    const LAS float* wh = wsf + 4 * hi;
#pragma unroll
    for (int r = 0; r < 16; ++r) { const float fr = wh[CROW0(r)]; dst[0][r] += fr * o[0][r]; dst[1][r] += fr * o[1][r]; }
    LDS_WAIT();
}
__device__ __forceinline__ void softmax_update(f32x16& p0, f32x16& p1, float& m, float& l, f32x16 (&o)[2], LAS float* wsf, int r32, int hi) {
    float rm = fmaxf(p0[0], p1[0]);
#pragma unroll
    for (int r = 1; r < 16; ++r) rm = fmaxf(rm, fmaxf(p0[r], p1[r]));
    rm = x32_max(rm);
    const float mn = fmaxf(m, rm), f = ex2(m - mn);
    m = mn; float s = 0.f;
#pragma unroll
    for (int r = 0; r < 16; ++r) { p0[r] = ex2(p0[r] - mn); p1[r] = ex2(p1[r] - mn); s += p0[r] + p1[r]; }
    l = l * f + s;
    if (__any(f != 1.0f)) row_scale(o, f, wsf, r32, hi);
}
__device__ __forceinline__ void softmax_full(f32x16& a0, f32x16& a1, f32x16& b0, f32x16& b1) {
    float rm = -1e30f;
#pragma unroll
    for (int r = 0; r < 16; ++r) rm = fmaxf(rm, fmaxf(fmaxf(a0[r], a1[r]), fmaxf(b0[r], b1[r])));
    rm = x32_max(rm); float s = 0.f;
#pragma unroll
    for (int r = 0; r < 16; ++r) { a0[r] = ex2(a0[r] - rm); a1[r] = ex2(a1[r] - rm); b0[r] = ex2(b0[r] - rm); b1[r] = ex2(b1[r] - rm); s += (a0[r] + a1[r]) + (b0[r] + b1[r]); }
    s = x32_sum(s);
    const float inv = s > 0.f ? 1.0f / s : 0.f;
#pragma unroll
    for (int r = 0; r < 16; ++r) { a0[r] *= inv; a1[r] *= inv; b0[r] *= inv; b1[r] *= inv; }
}
__device__ __forceinline__ unsigned imp_key(float v, int j, int c) {
    const bool forced = (j == 0) | (j == c) | (j == c - 1);
    const unsigned base = forced ? 0x7F000000u : (j <= c ? (__float_as_uint(v) & 0xFFFFFFC0u) : 0u);
    return base | (unsigned)(63 - j);
}
__device__ __forceinline__ void imp_store(const f32x16& p0, const f32x16& p1, int T, LAS unsigned* impq  , int c, int g, int hi) {
#pragma unroll
    for (int kh = 0; kh < 2; ++kh)
#pragma unroll
        for (int a = 0; a < 4; ++a) {
            const f32x16& p = kh ? p1 : p0; float e0 = p[4 * a] + p[4 * a + 1], e1 = p[4 * a + 2] + p[4 * a + 3];
            e0 += swz_xorf<8>(e0); e0 += swz_xorf<16>(e0); e1 += swz_xorf<8>(e1); e1 += swz_xorf<16>(e1);
            const int jc = 32 * T + 16 * kh + 4 * a, j0 = jc + 2 * hi;
            if (g == 0) { u32x2 w; w.x = imp_key(e0, j0, c); w.y = imp_key(e1, j0 + 1, c); *(LAS u32x2*)(impq + 2 * hi + jc) = w; }
        }
}
__device__ __forceinline__ unsigned long long select_mask(const LAS unsigned* impq, int g, int hi, int nq4 = 16) {
    LDS_WAIT();
    unsigned mk[8], cnt[8];
#pragma unroll
    for (int a = 0; a < 4; ++a) { const u32x2 w = *(const LAS u32x2*)(impq + (16 * g + 2 * hi) + 4 * a); mk[2 * a] = w.x; mk[2 * a + 1] = w.y; cnt[2 * a] = 0; cnt[2 * a + 1] = 0; }
#pragma unroll 4
    for (int jj = 0; jj < nq4; ++jj) { const u32x4 kx = *(const LAS u32x4*)(impq + 4 * jj);
#pragma unroll
        for (int ci = 0; ci < 8; ++ci) cnt[ci] += (unsigned)(kx.x > mk[ci]) + (unsigned)(kx.y > mk[ci]) + (unsigned)(kx.z > mk[ci]) + (unsigned)(kx.w > mk[ci]); }
    unsigned lb = 0u;
#pragma unroll
    for (int a = 0; a < 4; ++a)
#pragma unroll
        for (int e = 0; e < 2; ++e) lb |= (cnt[2 * a + e] < 16u ? 1u : 0u) << (4 * a + e);
    const unsigned long long mm = (unsigned long long)lb << (16 * g + 2 * hi);
    unsigned lo = (unsigned)mm, hh = (unsigned)(mm >> 32);
    lo |= swz_xor<8>(lo); hh |= swz_xor<8>(hh); lo |= swz_xor<16>(lo); hh |= swz_xor<16>(hh); lo = x32_or(lo); hh = x32_or(hh);
    return ((unsigned long long)hh << 32) | lo;
}
__device__ __forceinline__ unsigned long long wave_or64(unsigned long long m) {
    unsigned lo = (unsigned)m, hh = (unsigned)(m >> 32);
    lo |= swz_xor<1>(lo); hh |= swz_xor<1>(hh); lo |= swz_xor<2>(lo); hh |= swz_xor<2>(hh); lo |= swz_xor<4>(lo); hh |= swz_xor<4>(hh);
    lo |= swz_xor<8>(lo); hh |= swz_xor<8>(hh); lo |= swz_xor<16>(lo); hh |= swz_xor<16>(hh); lo = x32_or(lo); hh = x32_or(hh);
    return ((unsigned long long)(unsigned)__builtin_amdgcn_readfirstlane(hh) << 32) | (unsigned)__builtin_amdgcn_readfirstlane(lo);
}
__device__ __forceinline__ void mask_bias(f32x16& p0, f32x16& p1, int t, int pos0, int stride, int wlim, bool sel, bool near, const LAS float* lut, int hi) {
#pragma unroll
    for (int kh = 0; kh < 2; ++kh)
#pragma unroll
        for (int r = 0; r < 16; ++r) { const int kk = 32 * kh + crow(r, hi), dist = t - pos0 - stride * kk; const bool ok = sel && dist >= 0 && dist < wlim;
            float bv = 0.f; if (near) { const int di = dist < 0 ? 0 : (dist > 127 ? 127 : dist); bv = lut[di]; }
            if (kh) p1[r] = ok ? p1[r] + bv : -INFINITY; else p0[r] = ok ? p0[r] + bv : -INFINITY; }
}
template <bool CAUSAL>
__device__ __forceinline__ void mask_bias_near(f32x16& p0, f32x16& p1, int t, int pos0, bool sel, const LAS float* xlg, int hi) {
    const int dist0 = t - pos0 - 4 * hi;
    const LAS float* bp = xlg + (dist0 + 4);
#pragma unroll
    for (int kh = 0; kh < 2; ++kh)
#pragma unroll
        for (int r = 0; r < 16; ++r) { const int kc = 32 * kh + CROW0(r); const float bv = bp[63 - kc]; bool ok = sel; if (CAUSAL) ok = ok && (dist0 - kc >= 0);
            if (kh) p1[r] = ok ? p1[r] + bv : -INFINITY; else p0[r] = ok ? p0[r] + bv : -INFINITY; }
}
struct Ptrs { const bf16_t *Q, *kcp, *vcp, *kcs, *vcs, *KS, *VS, *KW, *VW; const float* gates; bf16_t* O; const float *ck_sel, *cv_sel, *st_kw, *st_vw; const int* pt; int gov; float* kw_out; float* vw_out; };
#ifdef VERIFY
#define GATEV(P, row, head, br) ((P).gov < 0 ? sigmoidf_((P).gates[(size_t)(row) * 48 + (head) * 3 + (br)]) : ((P).gov == (br) ? 1.0f : 0.0f))
#else
#define GATEV(P, row, head, br) sigmoidf_((P).gates[(size_t)(row) * 48 + (head) * 3 + (br)])
#endif

template <bool ACC>
__device__ __forceinline__ void row_out(LAS float* ow, const f32x16 (&o)[2], float f, LAS float* wsf, int r32, int hi) {
    if (hi == 0) wsf[r32] = f;
    LDS_WAIT();
    const LAS float* wh = wsf + 4 * hi; LAS float* ob = ow + hi * 256 + r32;
#pragma unroll
    for (int r = 0; r < 16; ++r) { const float fr = wh[CROW0(r)]; LAS float* p = ob + CROW0(r) * 64;
        if (ACC) { p[0] += fr * o[0][r]; p[32] += fr * o[1][r]; } else { p[0] = fr * o[0][r]; p[32] = fr * o[1][r]; } }
    LDS_WAIT();
}
template <bool NEXT>
__device__ __forceinline__ void tile_block(f32x16& s0, f32x16& s1, f32x16& n0, f32x16& n1, const LAS unsigned char* KBn, float ninit, const LAS unsigned char* VB, const bf16x8 (&qr)[4],
                                           float m, float& l, f32x16 (&o)[2], int lane, int r32, int hi) {
    if (NEXT) qk_tile(n0, n1, KBn, qr, ninit, r32, hi);
    float sacc = 0.f;
#pragma unroll
    for (int r = 0; r < 16; ++r) { s0[r] = ex2(s0[r] - m); s1[r] = ex2(s1[r] - m); sacc += s0[r] + s1[r]; }
    l += sacc;
    pv_tile(o, VB, s0, s1, lane);
}
#define AS_SBAR() __builtin_amdgcn_sched_barrier(0)
#define AS_PIN(x) asm volatile("" : "+v"(x))
#define AS_MFMA(a, b, c) __builtin_amdgcn_mfma_f32_32x32x16_bf16(a, b, c, 0, 0, 0)
#define AS_WAIT_BAR(N) asm volatile("s_waitcnt vmcnt(" #N ") lgkmcnt(0)\n\ts_barrier" ::: "memory")
#define AS_MX3(a, b, c) __builtin_fmaxf(__builtin_fmaxf((a), (b)), (c))
__device__ __forceinline__ void as_glds16(const void* gsrc, unsigned lds_base) {
    unsigned sv; asm volatile("s_mov_b32 %0, m0\n\ts_mov_b32 m0, %2\n\ts_nop 0\n\tglobal_load_lds_dwordx4 %1, off\n\ts_mov_b32 m0, %0" : "=&s"(sv) : "v"(gsrc), "s"(lds_base) : "memory"); }
__device__ __forceinline__ void as_kload2(bf16x8* kf, const LAS unsigned char* kp, int d0) { kf[2 * d0] = *(const LAS bf16x8*)(kp + d0 * 2048); kf[2 * d0 + 1] = *(const LAS bf16x8*)(kp + d0 * 2048 + 512); }
__device__ __forceinline__ float as_rowmax(const f32x16& p0, const f32x16& p1) {
    float a = AS_MX3(p0[0], p0[1], p1[0]), b = AS_MX3(p0[2], p0[3], p1[1]); a = AS_MX3(a, p1[2], p1[3]);
#pragma unroll
    for (int r = 4; r < 16; r += 4) { a = AS_MX3(a, p0[r], p0[r + 1]); b = AS_MX3(b, p0[r + 2], p0[r + 3]); a = AS_MX3(a, p1[r], p1[r + 1]); b = AS_MX3(b, p1[r + 2], p1[r + 3]); }
    return x32_max(__builtin_fmaxf(a, b)); }
__device__ __forceinline__ float as_mask(f32x16& c0, f32x16& c1, int u, int nsel, int nwin, int c, int t, unsigned long long mymask, float bfar, const LAS float* xlg, const LAS float* lut, int hi) {
    if (u >= nsel + nwin) {
#pragma unroll
        for (int r = 0; r < 16; ++r) { c0[r] = -INFINITY; c1[r] = -INFINITY; }
        return 0.f; }
    const bool win = u >= nsel; const int j = win ? c - nwin + 1 + (u - nsel) : u;
    const bool sel = win || ((mymask >> j) & 1ull);
    if (j >= c - 2) { if (j == c) mask_bias_near<true>(c0, c1, t, 64 * j, sel, xlg, hi); else mask_bias_near<false>(c0, c1, t, 64 * j, sel, xlg, hi); return 0.f; }
    if (win) { if (j == c - 8) mask_bias(c0, c1, t, 64 * j, 1, 512, true, false, lut, hi); }
    else {
#pragma unroll
        for (int r = 0; r < 16; ++r) { c0[r] = sel ? c0[r] : -INFINITY; c1[r] = sel ? c1[r] : -INFINITY; } }
    return bfar;
}
__device__ __forceinline__ void attn_stream(const bf16_t* ksb, const bf16_t* vsb, const bf16_t* kwb, const bf16_t* vwb  , int nsel, int nwin, int NT, int c, int t,
                                            unsigned long long mymask, const bf16x8 (&qr)[4], float bfar, const LAS float* xlg, const LAS float* lut, float gate1, float gate2,
                                            LAS unsigned char* L, LAS float* wsf, LAS float* ow, int wave, int lane) {
    constexpr int SLOTB = 8192, LDS_K = 0, LDS_V = 3 * SLOTB;
    const int r32 = lane & 31, hi = lane >> 5;
    const unsigned lds0 = (unsigned)(unsigned long long)L;
    const int nreal = nsel + nwin;
    const unsigned klo = (unsigned)lane * 256 + wave * 8, vlo_ = (unsigned)(16 * (wave & 3) + (lane >> 2)) * 256 + (wave >> 2) * 32 + (lane & 3) * 8;
    const unsigned kdst = lds0 + LDS_K + wave * 1024, vdst = lds0 + LDS_V + wave * 1024;
#define AS_UT(u) ((u) < nreal ? (u) : nreal - 1)
#define AS_JB(u) (AS_UT(u) < nsel ? AS_UT(u) : c - nwin + 1 + (AS_UT(u) - nsel))
#define AS_DMA_K(u, slot) as_glds16((AS_UT(u) < nsel ? ksb : kwb) + klo + (size_t)AS_JB(u) * (64 * 256), (unsigned)__builtin_amdgcn_readfirstlane((int)(kdst + (slot))))
#define AS_DMA_V(u, slot) as_glds16((AS_UT(u) < nsel ? vsb : vwb) + vlo_ + (size_t)AS_JB(u) * (64 * 256), (unsigned)__builtin_amdgcn_readfirstlane((int)(vdst + (slot))))
    const LAS unsigned char* vp0 = L + LDS_V + ((lane >> 4) & 1) * 32 + (lane & 3) * 8 + (4 * hi + ((lane & 15) >> 2)) * 64;
    const LAS unsigned char* kp0 = L + LDS_K + hi * 1024 + r32 * 16;
    AS_DMA_K(0, 0); AS_DMA_V(0, 0); AS_DMA_K(1, SLOTB); AS_DMA_K(2, 2 * SLOTB);
    float mhat = 0.f, l_reg = 0.f, l_sel = 0.f; f32x16 o[2];
#pragma unroll
    for (int r = 0; r < 16; ++r) { o[0][r] = 0.f; o[1][r] = 0.f; }
    const f32x16 zero16 = {0.f, 0.f, 0.f, 0.f, 0.f, 0.f, 0.f, 0.f, 0.f, 0.f, 0.f, 0.f, 0.f, 0.f, 0.f, 0.f};
    bool resc = false, bnd = false;
    f32x16 pA0, pA1, pB0, pB1; bf16x8 kf[8]; s16x4 vlo[8], vhi[8]; u32x4 pw0, pw1, pw2, pw3;
    int sl_prev = 0, sl_cur = 0, sl_next = SLOTB;
#define AS_ROT() do { sl_prev = sl_cur; sl_cur = sl_next; sl_next = (sl_next == 2 * SLOTB) ? 0 : sl_next + SLOTB; } while (0)
#define AS_EX(v) __builtin_amdgcn_exp2f((v) + nmh)
#define AS_RESC() do { if (resc) { const LAS float* wh_ = wsf + 4 * hi; _Pragma("unroll") for (int d_ = 0; d_ < 2; ++d_) _Pragma("unroll") for (int r = 0; r < 16; ++r) o[d_][r] *= wh_[CROW0(r)]; } } while (0)
#define AS_BND() do { if (bnd) { const float lt_ = x32_sum(l_sel); row_out<true>(ow, o, lt_ > 0.f ? gate1 / lt_ : 0.f, wsf, r32, hi); _Pragma("unroll") for (int r = 0; r < 16; ++r) { o[0][r] = 0.f; o[1][r] = 0.f; } bnd = false; } } while (0)
    AS_WAIT_BAR(3);
#pragma unroll
    for (int d0 = 0; d0 < 4; ++d0) as_kload2(kf, kp0, d0);
    pA0 = AS_MFMA(kf[0], qr[0], zero16); pA1 = AS_MFMA(kf[1], qr[0], zero16); pA0 = AS_MFMA(kf[2], qr[1], pA0); pA1 = AS_MFMA(kf[3], qr[1], pA1);
    pA0 = AS_MFMA(kf[4], qr[2], pA0); pA1 = AS_MFMA(kf[5], qr[2], pA1); pA0 = AS_MFMA(kf[6], qr[3], pA0); pA1 = AS_MFMA(kf[7], qr[3], pA1);
    { const float bc = as_mask(pA0, pA1, 0, nsel, nwin, c, t, mymask, bfar, xlg, lut, hi);
      const float rm = as_rowmax(pA0, pA1) + bc; mhat = __builtin_fmaxf(rm, -60.f); const float nmh = bc - mhat;
#pragma unroll
      for (int r = 0; r < 16; ++r) { pA0[r] = AS_EX(pA0[r]); pA1[r] = AS_EX(pA1[r]); } }
    AS_WAIT_BAR(0);
    AS_DMA_K(3, 0); AS_DMA_V(1, SLOTB); AS_ROT();
#pragma unroll
    for (int d0 = 0; d0 < 4; ++d0) as_kload2(kf, kp0 + sl_cur, d0);
    AS_WAIT_BAR(2);
#define AS_PKW(P, i) cvtpk(P[i], P[i + 1])
#define AS_PAF(k) __builtin_bit_cast(bf16x8, pw##k)
#define AS_VFR(i) (bf16x8){vlo[i][0], vlo[i][1], vlo[i][2], vlo[i][3], vhi[i][0], vhi[i][1], vhi[i][2], vhi[i][3]}
#define AS_VRD(i) do { vlo[i] = vtr(vp_ + (((i) >> 2) * 4096 + ((i) & 3) * 1024)); vhi[i] = vtr(vp_ + (((i) >> 2) * 4096 + ((i) & 3) * 1024 + 512)); } while (0)
#define AS_KRD(G, d0) do { if (G) { as_kload2(kf, kp0 + sl_next, d0); AS_SBAR(); } } while (0)
#define AS_GAPA(MF, a0, a1, a2, a3, W0, W1, PW) do { MF; sacc += a0; sacc += a1; sacc += a2; sacc += a3; W0; W1; AS_PIN(PW); AS_PIN(sacc); AS_SBAR(); } while (0)
#define AS_GAPB(MF, X, i) do { MF; X[i] = AS_EX(X[i]); X[i + 1] = AS_EX(X[i + 1]); X[i + 2] = AS_EX(X[i + 2]); X[i + 3] = AS_EX(X[i + 3]); AS_PIN(X); AS_SBAR(); } while (0)
#define AS_STEP(C0, C1, P0, P1, tt, MASK, GK, GV, GL) do { AS_SBAR(); \
    const LAS unsigned char* vp_ = vp0 + sl_prev; \
    AS_VRD(0); AS_SBAR(); float sacc = P0[0] + P0[1]; \
                    AS_GAPA(C0 = AS_MFMA(kf[0], qr[0], zero16), P0[2], P0[3], P0[4], P0[5],     pw0[0] = AS_PKW(P0, 0),  pw0[1] = AS_PKW(P0, 2),  pw0); \
    AS_VRD(4); AS_SBAR(); AS_GAPA(C1 = AS_MFMA(kf[1], qr[0], zero16), P0[6], P0[7], P0[8], P0[9],     pw0[2] = AS_PKW(P0, 4),  pw0[3] = AS_PKW(P0, 6),  pw0); \
    AS_VRD(1); AS_SBAR(); AS_GAPA(C0 = AS_MFMA(kf[2], qr[1], C0),    P0[10], P0[11], P0[12], P0[13], pw1[0] = AS_PKW(P0, 8),  pw1[1] = AS_PKW(P0, 10), pw1); \
    AS_VRD(5); AS_SBAR(); AS_GAPA(C1 = AS_MFMA(kf[3], qr[1], C1),    P0[14], P0[15], P1[0], P1[1],   pw1[2] = AS_PKW(P0, 12), pw1[3] = AS_PKW(P0, 14), pw1); \
    AS_VRD(2); AS_SBAR(); AS_GAPA(C0 = AS_MFMA(kf[4], qr[2], C0),    P1[2], P1[3], P1[4], P1[5],     pw2[0] = AS_PKW(P1, 0),  pw2[1] = AS_PKW(P1, 2),  pw2); \
    AS_VRD(6); AS_SBAR(); AS_GAPA(C1 = AS_MFMA(kf[5], qr[2], C1),    P1[6], P1[7], P1[8], P1[9],     pw2[2] = AS_PKW(P1, 4),  pw2[3] = AS_PKW(P1, 6),  pw2); \
    AS_VRD(3); AS_SBAR(); AS_GAPA(C0 = AS_MFMA(kf[6], qr[3], C0),    P1[10], P1[11], P1[12], P1[13], pw3[0] = AS_PKW(P1, 8),  pw3[1] = AS_PKW(P1, 10), pw3); \
    AS_VRD(7); AS_SBAR(); AS_GAPA(C1 = AS_MFMA(kf[7], qr[3], C1),    P1[14], P1[15], 0.f, 0.f,       pw3[2] = AS_PKW(P1, 12), pw3[3] = AS_PKW(P1, 14), pw3); \
    l_reg += sacc; \
    if (GK) AS_DMA_K((tt) + 3, sl_cur); if (GV) AS_DMA_V((tt) + 1, sl_next); \
    float bc_ = bfar; bool sel_ = true; \
    if (MASK) bc_ = as_mask(C0, C1, (tt), nsel, nwin, c, t, mymask, bfar, xlg, lut, hi); \
    else sel_ = (mymask >> (tt)) & 1ull;                             \
    if (MASK && (tt) == nsel) { l_sel = l_reg; l_reg = 0.f; mhat = __builtin_fmaxf(as_rowmax(C0, C1) + bc_, -60.f); resc = false; bnd = true; }     \
    else { const float rm = as_rowmax(C0, C1) + bc_ - mhat; resc = false; \
      if (__builtin_expect(__any(rm > 8.0f), 0)) { const float dl = __builtin_fmaxf(rm, 0.f); mhat += dl; \
          const float f = __builtin_amdgcn_exp2f(-dl); l_reg *= f; if (hi == 0) wsf[r32] = f; resc = true; } } \
    const float nmh = sel_ ? bc_ - mhat : -INFINITY; AS_SBAR(); \
    AS_GAPB(o[0] = AS_MFMA(AS_PAF(0), AS_VFR(0), o[0]), C0, 0);              AS_GAPB(o[1] = AS_MFMA(AS_PAF(0), AS_VFR(4), o[1]), C0, 4); \
    AS_KRD(GL, 0); AS_GAPB(o[0] = AS_MFMA(AS_PAF(1), AS_VFR(1), o[0]), C0, 8);  AS_KRD(GL, 1); AS_GAPB(o[1] = AS_MFMA(AS_PAF(1), AS_VFR(5), o[1]), C0, 12); \
    AS_KRD(GL, 2); AS_GAPB(o[0] = AS_MFMA(AS_PAF(2), AS_VFR(2), o[0]), C1, 0);  AS_KRD(GL, 3); AS_GAPB(o[1] = AS_MFMA(AS_PAF(2), AS_VFR(6), o[1]), C1, 4); \
    AS_GAPB(o[0] = AS_MFMA(AS_PAF(3), AS_VFR(3), o[0]), C1, 8);              AS_GAPB(o[1] = AS_MFMA(AS_PAF(3), AS_VFR(7), o[1]), C1, 12); \
    } while (0)
    int tt = 1;
    for (; tt + 1 < nsel - 3; tt += 2) {
        AS_STEP(pB0, pB1, pA0, pA1, tt, false, true, true, true);     AS_WAIT_BAR(2); AS_RESC(); AS_ROT();
        AS_STEP(pA0, pA1, pB0, pB1, tt + 1, false, true, true, true); AS_WAIT_BAR(2); AS_RESC(); AS_ROT();
    }
#define AS_ENDW(x) do { if ((x) + 3 < NT) { AS_WAIT_BAR(2); } else if ((x) + 2 < NT) { AS_WAIT_BAR(1); } else { AS_WAIT_BAR(0); } } while (0)
    for (; tt + 1 < NT; tt += 2) {
        AS_STEP(pB0, pB1, pA0, pA1, tt, true, (tt + 3 < NT), (tt + 1 < NT), (tt + 1 < NT));         AS_ENDW(tt);     AS_RESC(); AS_BND(); AS_ROT();
        AS_STEP(pA0, pA1, pB0, pB1, tt + 1, true, (tt + 4 < NT), (tt + 2 < NT), (tt + 2 < NT));     AS_ENDW(tt + 1); AS_RESC(); AS_BND(); AS_ROT();
    }
    AS_STEP(pB0, pB1, pA0, pA1, NT - 1, true, false, false, false); AS_RESC(); AS_BND();
    { float sacc = pB0[0] + pB0[1];
#pragma unroll
      for (int r = 2; r < 16; ++r) sacc += pB0[r];
#pragma unroll
      for (int r = 0; r < 16; ++r) sacc += pB1[r];
      l_reg += sacc;
      pw0 = (u32x4){AS_PKW(pB0, 0), AS_PKW(pB0, 2), AS_PKW(pB0, 4), AS_PKW(pB0, 6)}; pw1 = (u32x4){AS_PKW(pB0, 8), AS_PKW(pB0, 10), AS_PKW(pB0, 12), AS_PKW(pB0, 14)};
      pw2 = (u32x4){AS_PKW(pB1, 0), AS_PKW(pB1, 2), AS_PKW(pB1, 4), AS_PKW(pB1, 6)}; pw3 = (u32x4){AS_PKW(pB1, 8), AS_PKW(pB1, 10), AS_PKW(pB1, 12), AS_PKW(pB1, 14)};
      const LAS unsigned char* vp_ = vp0 + sl_cur;
#pragma unroll
      for (int i = 0; i < 8; ++i) AS_VRD(i);
      o[0] = AS_MFMA(AS_PAF(0), AS_VFR(0), o[0]); o[1] = AS_MFMA(AS_PAF(0), AS_VFR(4), o[1]); o[0] = AS_MFMA(AS_PAF(1), AS_VFR(1), o[0]); o[1] = AS_MFMA(AS_PAF(1), AS_VFR(5), o[1]);
      o[0] = AS_MFMA(AS_PAF(2), AS_VFR(2), o[0]); o[1] = AS_MFMA(AS_PAF(2), AS_VFR(6), o[1]); o[0] = AS_MFMA(AS_PAF(3), AS_VFR(3), o[0]); o[1] = AS_MFMA(AS_PAF(3), AS_VFR(7), o[1]); }
    { const float lt = x32_sum(l_reg); const float f = lt > 0.f ? gate2 / lt : 0.f; row_out<true>(ow, o, f, wsf, r32, hi); }
    asm volatile("s_waitcnt lgkmcnt(0)\n\ts_barrier" ::: "memory");
#undef AS_UT
#undef AS_JB
#undef AS_DMA_K
#undef AS_DMA_V
#undef AS_ROT
#undef AS_EX
#undef AS_RESC
#undef AS_BND
#undef AS_PKW
#undef AS_PAF
#undef AS_VFR
#undef AS_VRD
#undef AS_KRD
#undef AS_GAPA
#undef AS_GAPB
#undef AS_STEP
#undef AS_ENDW
}

__device__ __forceinline__ void prompt_unit(const Ptrs& P, LAS unsigned char* L, int b, int kv, int c, int tid, int wave, int lane) {
    asm volatile("" : "+v"(lane), "+v"(tid));
    const int r32 = lane & 31, hi = lane >> 5, g = r32 >> 3, qi = r32 & 7, head = kv * 4 + g;
    const int t = c * 64 + wave * 8 + qi; const unsigned row = (unsigned)b * SEQ + t;
    bf16x8 qr[4];
#pragma unroll
    for (int ds = 0; ds < 4; ++ds) qr[ds] = *(const bf16x8*)(P.Q + (size_t)row * D + head * 64 + ds * 16 + hi * 8);
    const LAS float* lut = (const LAS float*)(L + LUT_OFF) + head * 128; const float bfar = lut[127];
    LAS float* wsf = (LAS float*)(L + WSF_OFF) + wave * 32;
    LAS float* ow = (LAS float*)(L + 65536 + wave * 8192);
    LAS unsigned* impq = (LAS unsigned*)(L + IMP_OFF) + wave * 512 + qi * 64;
    const int skey = tid >> 3, sch = tid & 7;
    const int kwoff = skey * 128 + ((sch ^ ((skey >> 1) & 7)) << 4), vwoff = (sch >> 2) * 4096 + skey * 64 + (sch & 3) * 16;
    LAS unsigned char* KB0 = L; LAS unsigned char* VB0 = L + 32768;
    { const unsigned co = ((unsigned)(b * 4 + kv) * 128 + skey) * 64 + sch * 8;
      const u32x4 k0 = *(const u32x4*)(P.kcp + co), k1 = *(const u32x4*)(P.kcp + co + 4096), v0 = *(const u32x4*)(P.vcp + co), v1 = *(const u32x4*)(P.vcp + co + 4096);
      *(LAS u32x4*)(KB0 + kwoff) = k0; *(LAS u32x4*)(KB0 + 8192 + kwoff) = k1; *(LAS u32x4*)(VB0 + vwoff) = v0; *(LAS u32x4*)(VB0 + 8192 + vwoff) = v1; }
    const int nwin = (c < 8 ? c : 8) + 1;
    __syncthreads();
    f32x16 o[2];
#pragma unroll
    for (int r = 0; r < 16; ++r) { o[0][r] = 0.f; o[1][r] = 0.f; }
    unsigned long long mymask = ~0ull;
    if (c <= 30) {
        f32x16 a0, a1; qk_tile(a0, a1, KB0, qr, 0.f, r32, hi); mask_bias(a0, a1, t, 31, 32, 1 << 30, true, true, lut, hi);
        float rm = fmaxf(a0[0], a1[0]);
#pragma unroll
        for (int r = 1; r < 16; ++r) rm = fmaxf(rm, fmaxf(a0[r], a1[r]));
        rm = fmaxf(x32_max(rm), -1e30f); float sacc = 0.f;
#pragma unroll
        for (int r = 0; r < 16; ++r) { a0[r] = ex2(a0[r] - rm); a1[r] = ex2(a1[r] - rm); sacc += a0[r] + a1[r]; }
        sacc = x32_sum(sacc); const float cinv = sacc > 0.f ? 1.0f / sacc : 0.f;
#pragma unroll
        for (int r = 0; r < 16; ++r) { a0[r] *= cinv; a1[r] *= cinv; }
        if (c >= 16) { imp_store(a0, a1, 0, impq, c, g, hi);
            if (g == 0) {
#pragma unroll
                for (int q8 = 0; q8 < 8; ++q8) { const int jc = 32 + 4 * q8; u32x2 w; w.x = imp_key(0.f, jc + 2 * hi, c); w.y = imp_key(0.f, jc + 2 * hi + 1, c); *(LAS u32x2*)(impq + 2 * hi + jc) = w; } } }
        pv_tile(o, VB0, a0, a1, lane);
    } else {
        f32x16 a0, a1, b0, b1;
        qk_tile(a0, a1, KB0, qr, 0.f, r32, hi); mask_bias(a0, a1, t, 31, 32, 1 << 30, true, true, lut, hi);
        qk_tile(b0, b1, KB0 + 8192, qr, 0.f, r32, hi); mask_bias(b0, b1, t, 31 + 2048, 32, 1 << 30, true, true, lut, hi);
        float rm = fmaxf(fmaxf(a0[0], a1[0]), fmaxf(b0[0], b1[0]));
#pragma unroll
        for (int r = 1; r < 16; ++r) rm = fmaxf(rm, fmaxf(fmaxf(a0[r], a1[r]), fmaxf(b0[r], b1[r])));
        rm = fmaxf(x32_max(rm), -1e30f); float sacc = 0.f;
#pragma unroll
        for (int r = 0; r < 16; ++r) { a0[r] = ex2(a0[r] - rm); a1[r] = ex2(a1[r] - rm); b0[r] = ex2(b0[r] - rm); b1[r] = ex2(b1[r] - rm); sacc += (a0[r] + a1[r]) + (b0[r] + b1[r]); }
        sacc = x32_sum(sacc); const float cinv = sacc > 0.f ? 1.0f / sacc : 0.f;
#pragma unroll
        for (int r = 0; r < 16; ++r) { a0[r] *= cinv; a1[r] *= cinv; b0[r] *= cinv; b1[r] *= cinv; }
        imp_store(a0, a1, 0, impq, c, g, hi); imp_store(b0, b1, 1, impq, c, g, hi);
        pv_tile(o, VB0, a0, a1, lane); pv_tile(o, VB0 + 8192, b0, b1, lane);
    }
    { const float g0 = GATEV(P, row, head, 0); row_out<false>(ow, o, g0, wsf, r32, hi); }
    if (c >= 16) mymask = select_mask(impq, g, hi, (c + 4) >> 2);
    __syncthreads();
    { LAS float* xl = (LAS float*)(L + IMP_OFF);
      for (int u = tid; u < 4 * 272; u += 512) { const int gg = u / 272, ii = u % 272, dd = ii - 67; xl[u] = ((const LAS float*)(L + LUT_OFF))[(kv * 4 + gg) * 128 + (dd < 0 ? 0 : (dd > 127 ? 127 : dd))]; } }
    const LAS float* xlg = (const LAS float*)(L + IMP_OFF) + g * 272;
    { const size_t kvb = ((size_t)b * SEQ) * 256 + kv * 64; const int nsel = c + 1; int NT = (nsel + nwin + 1) & ~1; if (NT < 4) NT = 4;
      attn_stream(P.KS + kvb, P.VS + kvb, P.KW + kvb, P.VW + kvb, nsel, nwin, NT, c, t, mymask, qr, bfar, xlg, lut, GATEV(P, row, head, 1), GATEV(P, row, head, 2), L, wsf, ow, wave, lane); }
    { const int rr = lane >> 1, hf = lane & 1, gg = rr >> 3, qq = rr & 7; const LAS float* src = ow + rr * 64 + hf * 32;
      bf16_t* op = P.O + ((size_t)b * SEQ + c * 64 + wave * 8 + qq) * D + (kv * 4 + gg) * 64 + hf * 32;
#pragma unroll
      for (int q4 = 0; q4 < 4; ++q4) { const f32x4 x0 = *(const LAS f32x4*)(src + q4 * 8), x1 = *(const LAS f32x4*)(src + q4 * 8 + 4); u32x4 w;
          w.x = cvtpk(x0[0], x0[1]); w.y = cvtpk(x0[2], x0[3]); w.z = cvtpk(x1[0], x1[1]); w.w = cvtpk(x1[2], x1[3]); *(u32x4*)(op + q4 * 8) = w; } }
    __syncthreads();
}

template <bool COPY>
__device__ __forceinline__ void stage_f32_pair(const float* ksrc_, const float* vsrc_, LAS unsigned char* Kb, LAS unsigned char* Vb, int lane, float* kdst_ = nullptr, float* vdst_ = nullptr, int first_row = 0) {
    const int c4 = lane & 15; const char* ks = uniform_ptr(ksrc_); const char* vs = uniform_ptr(vsrc_); const unsigned lo = (unsigned)((lane >> 4) * 1024 + c4 * 16);
#pragma unroll 1
    for (int hf = 0; hf < 2; ++hf) {
        f32x4 x[8], y[8];
#pragma unroll
        for (int it = 0; it < 8; ++it) x[it] = *(const f32x4*)(ks + (lo + (unsigned)(hf * 8 + it) * 4096u));
#pragma unroll
        for (int it = 0; it < 8; ++it) y[it] = *(const f32x4*)(vs + (lo + (unsigned)(hf * 8 + it) * 4096u));
        if constexpr (COPY) {
            char* kd = (char*)uniform_ptr(kdst_); char* vd = (char*)uniform_ptr(vdst_);
#pragma unroll
            for (int it = 0; it < 8; ++it) { const int key = (hf * 8 + it) * 4 + (lane >> 4);
                if (key >= first_row) { __builtin_nontemporal_store(x[it], (f32x4*)(kd + (lo + (unsigned)(hf * 8 + it) * 4096u))); __builtin_nontemporal_store(y[it], (f32x4*)(vd + (lo + (unsigned)(hf * 8 + it) * 4096u))); } }
        }
#pragma unroll
        for (int it = 0; it < 8; ++it) { const int key = (hf * 8 + it) * 4 + (lane >> 4);
            u32x2 w; w.x = cvtpk(x[it][0], x[it][1]); w.y = cvtpk(x[it][2], x[it][3]);
            *(LAS u32x2*)(Kb + key * 128 + (((c4 >> 1) ^ ((key >> 1) & 7)) << 4) + (c4 & 1) * 8) = w; }
#pragma unroll
        for (int it = 0; it < 8; ++it) { const int key = (hf * 8 + it) * 4 + (lane >> 4);
            u32x2 w; w.x = cvtpk(y[it][0], y[it][1]); w.y = cvtpk(y[it][2], y[it][3]);
            *(LAS u32x2*)(Vb + (c4 >> 3) * 4096 + key * 64 + (c4 & 7) * 8) = w; }
        __builtin_amdgcn_sched_barrier(0);
    }
}
__device__ __forceinline__ void stage_bf16_tile(const bf16_t* src_  , LAS unsigned char* Kb, bool isV, int lane) {
    const char* src = uniform_ptr(src_);
#pragma unroll
    for (int it = 0; it < 8; ++it) { const int idx = it * 64 + lane, key = idx >> 3, ch = idx & 7; const u32x4 x = *(const u32x4*)(src + (unsigned)idx * 16u);
        const int off = isV ? ((ch >> 2) * 4096 + key * 64 + (ch & 3) * 16) : (key * 128 + ((ch ^ ((key >> 1) & 7)) << 4));
        *(LAS u32x4*)(Kb + off) = x; }
}
__device__ __forceinline__ void stage_new_tile(const bf16_t* src_  , LAS unsigned char* Kb, bool isV, int lane) {
    const char* src = uniform_ptr(src_);
#pragma unroll
    for (int it = 0; it < 8; ++it) *(LAS u32x4*)(Kb + (it * 64 + lane) * 16) = (u32x4){0u, 0u, 0u, 0u};
    if (lane < 32) { const int key = lane >> 3, ch = lane & 7; const u32x4 x = *(const u32x4*)(src + (unsigned)(key * 512 + ch * 16));
        const int off = isV ? ((ch >> 2) * 4096 + key * 64 + (ch & 3) * 16) : (key * 128 + ((ch ^ ((key >> 1) & 7)) << 4));
        *(LAS u32x4*)(Kb + off) = x; }
}
__device__ __forceinline__ void sample_unit(const Ptrs& P, LAS unsigned char* L, int uA, int uB, int tid, int wave, int lane) {
    asm volatile("" : "+v"(lane), "+v"(tid));
    const int half = wave >> 2, lw = wave & 3, usel = half ? uB : uA, b = usel >> 2, kv = usel & 3;
    const int r32 = lane & 31, hi = lane >> 5, g = r32 >> 3, qi = r32 & 7, qs = qi & 3, head = kv * 4 + g;
    const int t = PAST + qs; const unsigned row = (unsigned)MP + b * 4 + qs;
    bf16x8 qr[4];
#pragma unroll
    for (int ds = 0; ds < 4; ++ds) qr[ds] = *(const bf16x8*)(P.Q + (size_t)row * D + head * 64 + ds * 16 + hi * 8);
    const LAS float* lut = (const LAS float*)(L + LUT_OFF) + head * 128; const float bfar = lut[127];
    LAS float* wsf = (LAS float*)(L + WSF_OFF) + wave * 32;
    LAS unsigned* impq = (LAS unsigned*)(L + IMP_OFF) + wave * 512 + qi * 64;
    LAS unsigned char* Kb = L + wave * 16384; LAS unsigned char* Vb = Kb + 8192;
    f32x16 out[2], o[2];
#pragma unroll
    for (int r = 0; r < 16; ++r) { out[0][r] = 0.f; out[1][r] = 0.f; o[0][r] = 0.f; o[1][r] = 0.f; }
    stage_bf16_tile(P.kcs + (size_t)(b * 4 + kv) * 4096, Kb, false, lane); stage_bf16_tile(P.vcs + (size_t)(b * 4 + kv) * 4096, Vb, true, lane);
    LDS_WAIT();
    {
        f32x16 a0, a1;
        qk_tile(a0, a1, Kb, qr, 0.f, r32, hi);
        mask_bias(a0, a1, t, 31, 32, 1 << 30, true, true, lut, hi);
        { float rm = fmaxf(a0[0], a1[0]);
#pragma unroll
          for (int r = 1; r < 16; ++r) rm = fmaxf(rm, fmaxf(a0[r], a1[r]));
          rm = x32_max(rm); float sacc = 0.f;
#pragma unroll
          for (int r = 0; r < 16; ++r) { a0[r] = ex2(a0[r] - rm); a1[r] = ex2(a1[r] - rm); sacc += a0[r] + a1[r]; }
          sacc = x32_sum(sacc); const float cinv = 1.0f / sacc;
#pragma unroll
          for (int r = 0; r < 16; ++r) { a0[r] *= cinv; a1[r] *= cinv; } }
        imp_store(a0, a1, 0, impq, 32, g, hi);
        if (g == 0) {
#pragma unroll
            for (int q8 = 0; q8 < 8; ++q8) { const int jc = 32 + 4 * q8; u32x2 w; w.x = imp_key(0.f, jc + 2 * hi, 32); w.y = imp_key(0.f, jc + 2 * hi + 1, 32); *(LAS u32x2*)(impq + 2 * hi + jc) = w; } }
        if (lw == 0) { pv_tile(o, Vb, a0, a1, lane); const float g0 = GATEV(P, row, head, 0); row_fma(out, o, g0, wsf, r32, hi);
#pragma unroll
            for (int r = 0; r < 16; ++r) { o[0][r] = 0.f; o[1][r] = 0.f; } }
    }
    const unsigned long long mymask = select_mask(impq, g, hi);
    const unsigned long long umask = wave_or64(mymask) & 0x1FFFFFFFFull;
    const bool winw = lw == 3;
    const int nsel = __builtin_popcountll(umask);
    const int nmine = winw ? 9 : nsel, first = winw ? 0 : lw, step = winw ? 1 : 3;
    float m = -1e30f, l = 0.f;
#pragma unroll 1
    for (int idx = first; idx < nmine; idx += step) {
        LDS_WAIT();
        int pos0; bool near, sel = true;
        int ln = lane; asm volatile("" : "+v"(ln));
        if (!winw) {
            unsigned long long mm = umask; for (int n = 0; n < idx; ++n) mm &= mm - 1ull;
            const int j = __builtin_ctzll(mm);
            if (j < 32) { const int page = P.pt[b * 16 + (j >> 1)]; const size_t off = (((size_t)page * 128 + (j & 1) * 64) * 4 + kv) * 64;
                stage_f32_pair<false>(P.ck_sel + off, P.cv_sel + off, Kb, Vb, ln); }
            else { stage_new_tile(P.KS + ((size_t)MP + b * 4) * 256 + kv * 64, Kb, false, ln); stage_new_tile(P.VS + ((size_t)MP + b * 4) * 256 + kv * 64, Vb, true, ln); }
            pos0 = 64 * j; near = j >= 30; sel = (mymask >> j) & 1ull;
        } else {
            if (idx < 8) { const size_t off = (((size_t)b * 512 + 64 * idx) * 4 + kv) * 64;
                stage_f32_pair<true>(P.st_kw + off, P.st_vw + off, Kb, Vb, ln, P.kw_out + off - 1024, P.vw_out + off - 1024, idx == 0 ? 4 : 0); }
            else { stage_new_tile(P.KW + ((size_t)MP + b * 4) * 256 + kv * 64, Kb, false, ln); stage_new_tile(P.VW + ((size_t)MP + b * 4) * 256 + kv * 64, Vb, true, ln); }
            pos0 = PAST - 512 + 64 * idx; near = idx >= 6;
        }
        LDS_WAIT();
        f32x16 p0, p1;
        qk_tile(p0, p1, Kb, qr, near ? 0.f : bfar, r32, hi);
        mask_bias(p0, p1, t, pos0, 1, winw ? 512 : (1 << 30), sel, near, lut, hi);
        softmax_update(p0, p1, m, l, o, wsf, r32, hi);
        pv_tile(o, Vb, p0, p1, lane);
    }
    LDS_WAIT();
    { const float lt = x32_sum(l);
      LAS f32x2* ml = (LAS f32x2*)(L + IMP_OFF);
      if (hi == 0) ml[wave * 256 + r32] = (f32x2){m, lt};
      __syncthreads();
      const int w0 = half * 4 + (winw ? 3 : 0), w1 = half * 4 + (winw ? 4 : 3);
      float M = -1e30f;
      for (int w = w0; w < w1; ++w) M = fmaxf(M, ml[w * 256 + r32][0]);
      float Ls = 0.f;
      for (int w = w0; w < w1; ++w) { const f32x2 x = ml[w * 256 + r32]; Ls += x[1] * ex2(x[0] - M); }
      const float gt = GATEV(P, row, head, (winw ? 2 : 1));
      const float f = Ls > 0.f ? gt * ex2(m - M) / Ls : 0.f;
      row_fma(out, o, f, wsf, r32, hi); }
    LAS float* ob = (LAS float*)Kb + hi * 256 + r32;
#pragma unroll
    for (int r = 0; r < 16; ++r) { ob[CROW0(r) * 64] = out[0][r]; ob[CROW0(r) * 64 + 32] = out[1][r]; }
    __syncthreads();
    { const int hs = tid >> 8, vr = (tid >> 4) & 15, d4 = (tid & 15) * 4, gg = vr >> 2, qq = vr & 3, uo = hs ? uB : uA; f32x4 sacc = (f32x4){0.f, 0.f, 0.f, 0.f};
#pragma unroll
      for (int w = 0; w < 4; ++w) sacc = sacc + *(const LAS f32x4*)((const LAS float*)(L + (hs * 4 + w) * 16384) + (gg * 8 + qq) * 64 + d4);
      u32x2 w2; w2.x = cvtpk(sacc[0], sacc[1]); w2.y = cvtpk(sacc[2], sacc[3]);
      *(u32x2*)(P.O + ((size_t)MP + (uo >> 2) * 4 + qq) * D + ((uo & 3) * 4 + gg) * 64 + d4) = w2; }
    __syncthreads();
}

#ifdef VERIFY
__device__ __forceinline__ float wsum(float v) { for (int o = 1; o < 64; o <<= 1) v += __shfl_xor(v, o); return v; }
__device__ __forceinline__ float wmax(float v) { for (int o = 1; o < 64; o <<= 1) v = fmaxf(v, __shfl_xor(v, o)); return v; }
__device__ __forceinline__ float rb(float x) { return bf2f((unsigned short)(cvtpk(x, 0.f) & 0xffffu)); }
__device__ __forceinline__ void verify_item(const Ptrs& P, LAS unsigned char* L, bool sample, int b, int tq, int kv, int br, float* errs, int wave, int lane) {
    LAS float* sc = (LAS float*)(L + wave * 16384);
    LAS float* qs = (LAS float*)(L + IMP_OFF) + wave * 512;
    const LAS float* lutb = (const LAS float*)(L + LUT_OFF);
    const size_t row = sample ? (size_t)MP + b * 4 + tq : (size_t)b * SEQ + tq; const int pos = sample ? PAST + tq : tq; const int cq = pos >> 6;
    for (int g = 0; g < 4; ++g) qs[g * 64 + lane] = bf2f(P.Q[row * D + (kv * 4 + g) * 64 + lane]);
    LDS_WAIT();
    const int ncmp = sample ? 64 : 128; const size_t cmpo = (size_t)(b * 4 + kv) * (sample ? 4096 : 8192); const bf16_t* kc = (const bf16_t*)((const char*)P.kcp + (sample ? WS_KCMPS - WS_KCMPP : 0)) + cmpo; const bf16_t* vc = (const bf16_t*)((const char*)P.vcp + (sample ? WS_VCMPS - WS_VCMPP : 0)) + cmpo;
    float oc0 = 0.f, oc1 = 0.f, oc2 = 0.f, oc3 = 0.f;
    for (int g = 0; g < 4; ++g) {
        float sA = -INFINITY, sB = -INFINITY;
        for (int h = 0; h < 2; ++h) { const int n = lane + 64 * h; const int dist = pos - (32 * n + 31); float s = -INFINITY;
            if (n < ncmp && dist >= 0) { float a = 0.f; for (int d = 0; d < 64; ++d) a += qs[g * 64 + d] * bf2f(kc[(size_t)n * 64 + d]); s = a + lutb[(kv * 4 + g) * 128 + (dist > 127 ? 127 : dist)]; }
            if (h == 0) sA = s; else sB = s; }
        const float mx = wmax(fmaxf(sA, sB)); float p0 = 0.f, p1 = 0.f;
        if (mx > -INFINITY) { p0 = ex2(sA - mx); p1 = ex2(sB - mx); }
        const float sm = wsum(p0 + p1); const float inv = sm > 0.f ? 1.0f / sm : 0.f;
        sc[g * 128 + lane] = p0 * inv; sc[g * 128 + 64 + lane] = p1 * inv;
    }
    LDS_WAIT();
    for (int g = 0; g < 4; ++g) { float a = 0.f; for (int n = 0; n < ncmp; ++n) a += sc[g * 128 + n] * bf2f(vc[(size_t)n * 64 + lane]); if (g == 0) oc0 = a; else if (g == 1) oc1 = a; else if (g == 2) oc2 = a; else oc3 = a; }
    float imp = 0.f; for (int g = 0; g < 4; ++g) imp += sc[g * 128 + 2 * lane] + sc[g * 128 + 2 * lane + 1];
    { const bool forced = (lane == 0) || (lane == cq) || (lane == cq - 1), elig = lane <= cq; imp = forced ? 1e9f : (elig ? imp : -1.0f); }
    LDS_WAIT(); qs[256 + lane] = imp; LDS_WAIT();
    int rank = 0; for (int j = 0; j < 64; ++j) { const float v = qs[256 + j]; rank += (v > imp) || (v == imp && j < lane); }
    const int nsb = sample ? 33 : 64;
    const unsigned long long selm = __ballot(rank < 16 && lane < nsb);
    float r0 = oc0, r1 = oc1, r2_ = oc2, r3 = oc3;
    if (br != 0) {
        const int nslot = br == 1 ? __builtin_popcountll(selm) : 9;
        LDS_WAIT();
        for (int si = 0; si < nslot && si < 16; ++si) {
            int j;
            if (br == 1) { unsigned long long mm = selm; for (int n = 0; n < si; ++n) mm &= mm - 1ull; j = __builtin_ctzll(mm); } else j = sample ? si : cq - 8 + si;
            bool ok = false; int pk = 0; const float* kf = nullptr; const bf16_t* kb = nullptr;
            if (br == 1) { pk = 64 * j + lane;
                if (!sample) { ok = pk <= pos; kb = P.KS + ((size_t)b * SEQ + pk) * 256 + kv * 64; }
                else if (j < 32) { ok = true; kf = P.ck_sel + (((size_t)P.pt[b * 16 + (j >> 1)] * 128 + (j & 1) * 64 + lane) * 4 + kv) * 64; }
                else { ok = lane < 4 && pk <= pos; kb = P.KS + ((size_t)MP + b * 4 + (lane & 3)) * 256 + kv * 64; } }
            else { if (!sample) { pk = 64 * j + lane; ok = j >= 0 && pk <= pos && pos - pk < 512; kb = P.KW + ((size_t)b * SEQ + (ok ? pk : 0)) * 256 + kv * 64; }
                else { const int e = 64 * j + lane; pk = PAST - 512 + e; ok = e < 516 && pk <= pos && pos - pk < 512;
                    if (e < 512) kf = P.st_kw + (((size_t)b * 512 + e) * 4 + kv) * 64; else kb = P.KW + ((size_t)MP + b * 4 + ((e - 512) & 3)) * 256 + kv * 64; } }
            const int dist = pos - pk;
            for (int g = 0; g < 4; ++g) { float s = -INFINITY;
                if (ok) { float a = 0.f; for (int d = 0; d < 64; ++d) a += qs[g * 64 + d] * (kf ? rb(kf[d]) : bf2f(kb[d])); s = a + lutb[(kv * 4 + g) * 128 + (dist > 127 ? 127 : dist)]; }
                sc[g * 1024 + si * 64 + lane] = s; }
        }
        LDS_WAIT();
        for (int g = 0; g < 4; ++g) {
            float mx = -INFINITY; for (int si = 0; si < nslot && si < 16; ++si) mx = fmaxf(mx, sc[g * 1024 + si * 64 + lane]);
            mx = wmax(mx); float sm = 0.f;
            for (int si = 0; si < nslot && si < 16; ++si) { const float p = mx > -INFINITY ? ex2(sc[g * 1024 + si * 64 + lane] - mx) : 0.f; sc[g * 1024 + si * 64 + lane] = p; sm += p; }
            sm = wsum(sm); const float inv = sm > 0.f ? 1.0f / sm : 0.f;
            LDS_WAIT();
            float a = 0.f;
            for (int si = 0; si < nslot && si < 16; ++si) {
                int j;
                if (br == 1) { unsigned long long mm = selm; for (int n = 0; n < si; ++n) mm &= mm - 1ull; j = __builtin_ctzll(mm); } else j = sample ? si : cq - 8 + si;
                for (int k = 0; k < 64; ++k) { const float p = sc[g * 1024 + si * 64 + k]; if (p == 0.f) continue; float v;
                    if (br == 1) { if (!sample) v = bf2f(P.VS[((size_t)b * SEQ + 64 * j + k) * 256 + kv * 64 + lane]);
                        else if (j < 32) v = rb(P.cv_sel[(((size_t)P.pt[b * 16 + (j >> 1)] * 128 + (j & 1) * 64 + k) * 4 + kv) * 64 + lane]);
                        else v = bf2f(P.VS[((size_t)MP + b * 4 + (k & 3)) * 256 + kv * 64 + lane]); }
                    else { if (!sample) v = bf2f(P.VW[((size_t)b * SEQ + 64 * j + k) * 256 + kv * 64 + lane]);
                        else { const int e = 64 * j + k; v = e < 512 ? rb(P.st_vw[(((size_t)b * 512 + e) * 4 + kv) * 64 + lane]) : bf2f(P.VW[((size_t)MP + b * 4 + ((e - 512) & 3)) * 256 + kv * 64 + lane]); } }
                    a += p * v; } }
            a *= inv; if (g == 0) r0 = a; else if (g == 1) r1 = a; else if (g == 2) r2_ = a; else r3 = a;
            LDS_WAIT();
        }
    }
    float d2 = 0.f, rr2 = 0.f;
    for (int g = 0; g < 4; ++g) { const float ref = g == 0 ? r0 : g == 1 ? r1 : g == 2 ? r2_ : r3; const float f = bf2f(P.O[row * D + (kv * 4 + g) * 64 + lane]); const float df = f - ref; d2 += df * df; rr2 += ref * ref; }
    d2 = wsum(d2); rr2 = wsum(rr2);
    if (lane == 0) { atomicAdd(errs + ((sample ? 3 : 0) + br) * 2, d2); atomicAdd(errs + ((sample ? 3 : 0) + br) * 2 + 1, rr2); }
}
#endif
}

constexpr int NPHASE = 17;
__global__ void __launch_bounds__(512, 2) nsa_fwd(Args args) {
    extern __shared__ __attribute__((aligned(16))) unsigned char lds[];
    Frame F;
    F.lds = (LAS unsigned char*)lds;
    F.tid = threadIdx.x; F.lane = F.tid & 63; F.wave = __builtin_amdgcn_readfirstlane(F.tid >> 6);
    F.G = gridDim.x; { const int bx = blockIdx.x; F.vcu = (F.G % 8 == 0) ? (bx % 8) * (F.G / 8) + bx / 8 : bx; }
    F.x_p = (const float*)args.in[0]; F.x_s = (const float*)args.in[1]; F.c_p = (const float*)args.in[2]; F.c_s = (const float*)args.in[3];
    F.ck_cmp = (const float*)args.in[4]; F.cv_cmp = (const float*)args.in[5]; F.ck_sel = (const float*)args.in[6]; F.cv_sel = (const float*)args.in[7];
    F.page_table = (const int*)args.in[8]; F.st_kw = (const float*)args.in[9]; F.st_vw = (const float*)args.in[10]; F.st_pool = (const float*)args.in[11];
    F.rel_bias = (const float*)args.in[12]; F.ada_w = (const float*)args.in[13]; F.ada_b = (const float*)args.in[14]; F.norm_g = (const float*)args.in[15]; F.final_g = (const float*)args.in[16];
    F.w_in = (const float*)args.in[17]; F.w_out = (const float*)args.in[18]; F.cmp_wk = (const float*)args.in[19]; F.cmp_wv = (const float*)args.in[20];
    F.pe_k = (const float*)args.in[21]; F.pe_v = (const float*)args.in[22]; F.pool_w = (const float*)args.in[23]; F.pool_scale = (const float*)args.in[24];
    F.ffn_wg = (const float*)args.in[25]; F.ffn_wu = (const float*)args.in[26]; F.ffn_wd = (const float*)args.in[27];
    F.out = args.out; F.ws = args.ws;
    unsigned char* ws = args.ws;
    for (int u = F.tid; u < 64; u += 512) ((LAS unsigned*)(F.lds + MISC_OFF))[u] = 0u;
    for (int u = F.tid; u < 16 * 128; u += 512) { const int h = u >> 7, d = u & 127; ((LAS float*)(F.lds + LUT_OFF))[u] = F.rel_bias[t5_bucket(d) * 16 + h] * LOG2E; }
    __syncthreads();
    volatile LAS unsigned* MISC = (volatile LAS unsigned*)(F.lds + MISC_OFF);
    XcdBarrier bar; bar.bar = (unsigned*)(ws + WS_CTL) + CW_BAR; bar.x = 0; bar.st = nullptr;
    if (!MK_SPLIT) bar = xcd_barrier_post((unsigned*)(ws + WS_CTL) + CW_BAR, MISC + 8);
    const int lo = args.ph_lo, hi = args.ph_hi;
#ifndef PHMASK
#define PHMASK 0x1FFFF
#endif
#define IN(k) (((PHMASK >> (k)) & 1) && lo <= (k) && (k) < hi)
#define SEAM(k) do { if (IN(k) && IN((k) + 1)) xcd_barrier(bar); } while (0)
#ifndef REPMASK
#define REPMASK 0
#endif
#define REPS(k) (((REPMASK >> (k)) & 1) ? 2 : 1)
    bf16_t* H = (bf16_t*)(ws + WS_H); float* X = (float*)(ws + WS_X); float* MOD = (float*)(ws + WS_MOD);

    if (IN(0)) { for (int rep = 0; rep < REPS(0); ++rep) p0_prologue(F); } SEAM(0);
    if (IN(1)) { for (int rep = 0; rep < REPS(1); ++rep) { p1_compress_sample(F); p1_ada(F); } } SEAM(1);
    if (IN(2)) { for (int rep = 0; rep < REPS(2); ++rep) norm_phase<0>(F, true, 0, 0); } SEAM(2);
    if (IN(3)) {
        pg8::Gemm g{H, (const bf16_t*)(ws + WS_WIN), D, D, D, 0}; pg8::StaticOrder S; S.init(MT, NPROJ, F.G, (int)blockIdx.x);
        pg8::EpiProj E{(bf16_t*)(ws + WS_Q), (bf16_t*)(ws + WS_KV), (float*)(ws + WS_GATES), F.out};
        for (int rep = 0; rep < REPS(3); ++rep) pg8::gemm_phase<pg8::EpiProj, pg8::StaticOrder, true>(F.lds, g, S, E);
    } SEAM(3);
    if (IN(4)) { for (int rep = 0; rep < REPS(4); ++rep) p4_compress_prompt(F); } SEAM(4);
    if (IN(5)) {
        att::Ptrs P; P.Q = (const bf16_t*)(ws + WS_Q); P.kcp = (const bf16_t*)(ws + WS_KCMPP); P.vcp = (const bf16_t*)(ws + WS_VCMPP); P.kcs = (const bf16_t*)(ws + WS_KCMPS); P.vcs = (const bf16_t*)(ws + WS_VCMPS);
        const bf16_t* kvb = (const bf16_t*)(ws + WS_KV); P.KS = kvb + 2 * KV_STRIDE; P.VS = kvb + 3 * KV_STRIDE; P.KW = kvb + 4 * KV_STRIDE; P.VW = kvb + 5 * KV_STRIDE;
        P.gates = (const float*)(ws + WS_GATES); P.O = (bf16_t*)(ws + WS_O); P.ck_sel = F.ck_sel; P.cv_sel = F.cv_sel; P.st_kw = F.st_kw; P.st_vw = F.st_vw; P.pt = F.page_table;
        P.gov = -1; P.kw_out = F.out + O_KWS; P.vw_out = F.out + O_KWS + SZ_WS;
#ifdef VERIFY
        P.gov = args.pad0 - 1;
#endif
#ifndef RS
#define RS 1
#endif
#ifndef RP
#define RP 1
#endif
#pragma unroll 1
        for (int pass = 0; pass < 2; ++pass) {
            if ((pass == 0) != ((F.vcu & 1) != 0)) {
#pragma unroll 1
                for (int rep = 0; rep < RS; ++rep)
                for (int u = F.vcu; u < NSB * 2; u += F.G) att::sample_unit(P, F.lds, u, u + NSB * 2, F.tid, F.wave, F.lane);
            } else {
#pragma unroll 1
                for (int rep = 0; rep < RP; ++rep)
                for (int u = F.vcu; u < 16 * 16; u += F.G) { const int bk = u >> 4, s = u & 15;
#pragma unroll 1
                    for (int i = 0; i < 4; ++i) { const int c = (i == 0) ? s : (i == 1) ? 31 - s : (i == 2) ? 32 + s : 63 - s; att::prompt_unit(P, F.lds, bk >> 2, bk & 3, c, F.tid, F.wave, F.lane); } }
            }
        }
    } SEAM(5);
    if (IN(6)) {
        pg8::Gemm g{(const bf16_t*)(ws + WS_O), (const bf16_t*)(ws + WS_WOUT), D, D, D, 0}; pg8::StaticOrder S; S.init(MP, D, F.G, (int)blockIdx.x);
        pg8::EpiRes E{F.x_p, F.x_s, X, MOD + 2048, nullptr};
        pg8::gemm_phase<pg8::EpiRes, pg8::StaticOrder, true>(F.lds, g, S, E);
        small_gemm_res(F, (const bf16_t*)(ws + WS_O) + (size_t)MP * D, D, (const bf16_t*)(ws + WS_WOUT), D, D, false, F.x_s, X + (size_t)MP * D, MOD + 2048, nullptr);
    } SEAM(6);
    if (IN(7)) { for (int rep = 0; rep < REPS(7); ++rep) norm_phase<0>(F, false, 0, 1); } SEAM(7);
    if (IN(8)) {
        pg8::Gemm g{H, (const bf16_t*)(ws + WS_WGU), D, D, D, 0}; pg8::StaticOrder S; S.init(MT, NGU, F.G, (int)blockIdx.x);
        pg8::EpiGU E{(bf16_t*)(ws + WS_ACT)};
        for (int rep = 0; rep < REPS(8); ++rep) pg8::gemm_phase<pg8::EpiGU, pg8::StaticOrder, true>(F.lds, g, S, E);
    } SEAM(8);
    if (IN(9)) {
        pg8::Gemm g{(const bf16_t*)(ws + WS_ACT), (const bf16_t*)(ws + WS_WD), FF, FF, FF, 0}; pg8::StaticOrder S; S.init(MP, D, F.G, (int)blockIdx.x);
        pg8::EpiRes E{X, X + (size_t)MP * D, X, MOD + 5120, nullptr};
        pg8::gemm_phase<pg8::EpiRes, pg8::StaticOrder, true>(F.lds, g, S, E);
        small_gemm_res(F, (const bf16_t*)(ws + WS_ACT) + (size_t)MP * FF, FF, (const bf16_t*)(ws + WS_WD), FF, FF, false, X + (size_t)MP * D, X + (size_t)MP * D, MOD + 5120, nullptr);
    } SEAM(9);
    if (IN(10)) { for (int rep = 0; rep < REPS(10); ++rep) norm_phase<1>(F, false, 1, 0); } SEAM(10);
    if (IN(11)) { for (int rep = 0; rep < REPS(11); ++rep) pool_phase(F); } SEAM(11);
    if (IN(12)) {
        pg8::Gemm g{H, (const bf16_t*)(ws + WS_WPOOL), D, 256, 256, 256}; pg8::StaticOrder S; S.init(MP, D, F.G, (int)blockIdx.x);
        pg8::EpiRes E{X, X + (size_t)MP * D, X, MOD + (size_t)NMODB * 6144 + 2048, F.pool_scale};
        pg8::gemm_phase<pg8::EpiRes, pg8::StaticOrder, true>(F.lds, g, S, E);
        small_gemm_res(F, H + (size_t)MP * D, D, (const bf16_t*)(ws + WS_WPOOL), 256, 256, true, X + (size_t)MP * D, X + (size_t)MP * D, MOD + (size_t)NMODB * 6144 + 2048, F.pool_scale);
    } SEAM(12);
    if (IN(13)) { for (int rep = 0; rep < REPS(13); ++rep) norm_phase<0>(F, false, 1, 1); } SEAM(13);
    if (IN(14)) {
        pg8::Gemm g{H, (const bf16_t*)(ws + WS_WGU) + (size_t)NGU * D, D, D, D, 0}; pg8::StaticOrder S; S.init(MT, NGU, F.G, (int)blockIdx.x);
        pg8::EpiGU E{(bf16_t*)(ws + WS_ACT)};
        pg8::gemm_phase<pg8::EpiGU, pg8::StaticOrder, true>(F.lds, g, S, E);
    } SEAM(14);
    if (IN(15)) {
        pg8::Gemm g{(const bf16_t*)(ws + WS_ACT), (const bf16_t*)(ws + WS_WD) + (size_t)D * FF, FF, FF, FF, 0}; pg8::StaticOrder S; S.init(MP, D, F.G, (int)blockIdx.x);
        pg8::EpiRes E{X, X + (size_t)MP * D, X, MOD + (size_t)NMODB * 6144 + 5120, nullptr};
        pg8::gemm_phase<pg8::EpiRes, pg8::StaticOrder, true>(F.lds, g, S, E);
        small_gemm_res(F, (const bf16_t*)(ws + WS_ACT) + (size_t)MP * FF, FF, (const bf16_t*)(ws + WS_WD) + (size_t)D * FF, FF, FF, false, X + (size_t)MP * D, X + (size_t)MP * D, MOD + (size_t)NMODB * 6144 + 5120, nullptr);
    } SEAM(15);
    if (IN(16)) { for (int rep = 0; rep < REPS(16); ++rep) norm_phase<2>(F, false, 0, 0); }
#undef IN
#undef SEAM
}


#ifdef VERIFY
__global__ void __launch_bounds__(512, 2) verify_k(Args args) {
    extern __shared__ __attribute__((aligned(16))) unsigned char lds[];
    LAS unsigned char* L = (LAS unsigned char*)lds; unsigned char* ws = args.ws;
    const int tid = threadIdx.x, lane = tid & 63, wave = __builtin_amdgcn_readfirstlane(tid >> 6);
    const float* rel_bias = (const float*)args.in[12];
    for (int u = tid; u < 16 * 128; u += 512) { const int h = u >> 7, d = u & 127; ((LAS float*)(L + LUT_OFF))[u] = rel_bias[t5_bucket(d) * 16 + h] * LOG2E; }
    __syncthreads();
    att::Ptrs P; P.Q = (const bf16_t*)(ws + WS_Q); P.kcp = (const bf16_t*)(ws + WS_KCMPP); P.vcp = (const bf16_t*)(ws + WS_VCMPP); P.kcs = (const bf16_t*)(ws + WS_KCMPS); P.vcs = (const bf16_t*)(ws + WS_VCMPS);
    const bf16_t* kvb = (const bf16_t*)(ws + WS_KV); P.KS = kvb + 2 * KV_STRIDE; P.VS = kvb + 3 * KV_STRIDE; P.KW = kvb + 4 * KV_STRIDE; P.VW = kvb + 5 * KV_STRIDE;
    P.gates = (const float*)(ws + WS_GATES); P.O = (bf16_t*)(ws + WS_O); P.ck_sel = (const float*)args.in[6]; P.cv_sel = (const float*)args.in[7]; P.st_kw = (const float*)args.in[9]; P.st_vw = (const float*)args.in[10]; P.pt = (const int*)args.in[8]; P.gov = args.pad0 - 1;
    float* errs = (float*)(ws + WS_CTL) + 65536;
    const int gw = blockIdx.x * 8 + wave;
    for (int it = gw; it < 168 + 64; it += gridDim.x * 8) { bool smp = it >= 168; int vb_, vt_, vk_;
        if (!smp) { const int ti = it % 21, r = it / 21; vb_ = (r >> 2) ? 3 : 0; vk_ = r & 3; vt_ = ti == 0 ? 0 : ti == 1 ? 5 : ti == 2 ? 30 : ti == 3 ? 31 : ti == 4 ? 63 : ti == 5 ? 64 : ti == 6 ? 100 : ti == 7 ? 511 : ti == 8 ? 512 : ti == 9 ? 600 : ti == 10 ? 959 : ti == 11 ? 960 : ti == 12 ? 1023 : ti == 13 ? 1024 : ti == 14 ? 1055 : ti == 15 ? 1100 : ti == 16 ? 2047 : ti == 17 ? 2048 : ti == 18 ? 3000 : ti == 19 ? 4032 : 4095; }
        else { const int q = it - 168, bi = q >> 4; vb_ = bi == 0 ? 0 : bi == 1 ? 1 : bi == 2 ? 77 : 127; vt_ = q & 3; vk_ = (q >> 2) & 3; }
        att::verify_item(P, L, smp, vb_, vt_, vk_, args.pad0 - 1, errs, wave, lane); }
}
__global__ void scale_k(Args args) {
    const float* errs = (const float*)(args.ws + WS_CTL) + 65536; const size_t offs[6] = {O_KCP, O_KCP + SZ_KVP, O_KCP + 2 * SZ_KVP, O_KCS, O_KCS + SZ_KVS, O_KCS + 2 * SZ_KVS};
    const int k = blockIdx.y; const float d2 = errs[2 * k], r2 = errs[2 * k + 1]; const float e = r2 > 0.f ? sqrtf(d2 / r2) : 7.0f; const size_t n = k < 3 ? SZ_KVP : SZ_KVS;
    for (size_t i = (size_t)blockIdx.x * blockDim.x + threadIdx.x; i < n; i += (size_t)gridDim.x * blockDim.x) args.out[offs[k] + i] *= (1.0f + e);
}
#endif
extern "C" void kernel_launch(void* const* d_in, const int* in_sizes, int n_in, void* d_out, int out_size, void* d_ws, size_t ws_size, hipStream_t stream) {
    static int grid = 0;
    if (grid == 0) {
        if (n_in != 28 || (size_t)out_size != O_END || ws_size < WS_END) { fprintf(stderr, "kernel_launch: unexpected shapes (n_in %d, out %d, ws %zu); nothing launched\n", n_in, out_size, ws_size); grid = -1; return; }
        int dev = 0, cus = 0, per_cu = 0;
        if (hipGetDevice(&dev) != hipSuccess || hipDeviceGetAttribute(&cus, hipDeviceAttributeMultiprocessorCount, dev) != hipSuccess) { grid = -1; return; }
        if (hipFuncSetAttribute((const void*)nsa_fwd, hipFuncAttributeMaxDynamicSharedMemorySize, LDS_BYTES) != hipSuccess) { fprintf(stderr, "kernel_launch: hipFuncSetAttribute(%d B LDS) failed\n", LDS_BYTES); grid = -1; return; }
        if (hipOccupancyMaxActiveBlocksPerMultiprocessor(&per_cu, (const void*)nsa_fwd, 512, LDS_BYTES) != hipSuccess || per_cu < 1)
            fprintf(stderr, "kernel_launch: note: occupancy query reports %d workgroups per CU\n", per_cu);
        (void)hipGetLastError();
        grid = cus;
    }
    if (grid < 0) return;
    (void)hipMemsetAsync((char*)d_ws + WS_CTL, 0, CTL_ZERO_BYTES, stream);
    Args a{};
    for (int i = 0; i < 28; ++i) a.in[i] = d_in[i];
    a.out = (float*)d_out; a.ws = (unsigned char*)d_ws; a.pad0 = 0; a.pad1 = 0;
#ifdef VERIFY
    hipFuncSetAttribute((const void*)verify_k, hipFuncAttributeMaxDynamicSharedMemorySize, LDS_BYTES);
    for (int pass = 0; pass < 3; ++pass) { a.pad0 = pass + 1; a.ph_lo = 0; a.ph_hi = 6;
        (void)hipMemsetAsync((char*)d_ws + WS_CTL, 0, 65536 * 4, stream);
        hipLaunchKernelGGL(nsa_fwd, dim3(grid), dim3(512), LDS_BYTES, stream, a);
        hipLaunchKernelGGL(verify_k, dim3(grid), dim3(512), LDS_BYTES, stream, a); }
    a.pad0 = 0; (void)hipMemsetAsync((char*)d_ws + WS_CTL, 0, 65536 * 4, stream);
    a.ph_lo = 0; a.ph_hi = NPHASE;
    hipLaunchKernelGGL(nsa_fwd, dim3(grid), dim3(512), LDS_BYTES, stream, a);
    hipLaunchKernelGGL(scale_k, dim3(64, 6), dim3(256), 0, stream, a);
#elif MK_SPLIT
    for (int p = 0; p < NPHASE; ++p) { a.ph_lo = p; a.ph_hi = p + 1; hipLaunchKernelGGL(nsa_fwd, dim3(grid), dim3(512), LDS_BYTES, stream, a); }
#else
    a.ph_lo = 0; a.ph_hi = NPHASE;
    hipLaunchKernelGGL(nsa_fwd, dim3(grid), dim3(512), LDS_BYTES, stream, a);
#endif
    const hipError_t le = hipPeekAtLastError();
    if (le != hipSuccess) fprintf(stderr, "kernel_launch: launch failed: %s\n", hipGetErrorName(le));
}
```

```cpp
#include <hip/hip_runtime.h>
#include <cstdio>
#include <cstdint>

#ifndef MK_SPLIT
#define MK_SPLIT 0
#endif

#define GAS __attribute__((address_space(1)))
#define LAS __attribute__((address_space(3)))
typedef unsigned short bf16_t;
typedef short bf16x8 __attribute__((ext_vector_type(8)));
typedef short s16x4 __attribute__((ext_vector_type(4)));
typedef float f32x2 __attribute__((ext_vector_type(2)));
typedef float f32x4 __attribute__((ext_vector_type(4)));
typedef float f32x16 __attribute__((ext_vector_type(16)));
typedef unsigned u32x2 __attribute__((ext_vector_type(2)));
typedef unsigned u32x4 __attribute__((ext_vector_type(4)));
typedef __bf16 bf16x2_t __attribute__((ext_vector_type(2)));
typedef GAS unsigned gu32;

constexpr int D = 1024, SEQ = 4096, NB = 4, NSB = 128, DSEQ = 4;
constexpr int MP = NB * SEQ, MS = NSB * DSEQ, MT = MP + MS;
constexpr int INCOLS = 2608, NPROJ = 2816, FF = 2816, NGU = 2 * FF;
constexpr int NMODB = NB + NSB;
constexpr int PAST = 2048;
constexpr float C2 = 0.125f * 1.4426950408889634f;
constexpr float LOG2E = 1.4426950408889634f;

constexpr size_t O_YP = 0, O_YS = O_YP + (size_t)MP * D;
constexpr size_t O_KCP = O_YS + (size_t)MS * D, SZ_KVP = (size_t)MP * 256;
constexpr size_t O_KWP = O_KCP + 4 * SZ_KVP, SZ_WP = (size_t)NB * 512 * 256;
constexpr size_t O_PLP = O_KWP + 2 * SZ_WP;
constexpr size_t O_KCS = O_PLP + (size_t)NB * 15 * D, SZ_KVS = (size_t)MS * 256;
constexpr size_t O_KWS = O_KCS + 4 * SZ_KVS, SZ_WS = (size_t)NSB * 512 * 256;
constexpr size_t O_PLS = O_KWS + 2 * SZ_WS;
constexpr size_t O_END = O_PLS + (size_t)NSB * 15 * D;
static_assert(O_END == 71233536, "output size");

constexpr size_t MiB = 1u << 20;
#ifdef VERIFY
constexpr size_t WS_CTL = 0, CTL_ZERO_BYTES = 1 * MiB;
#else
constexpr size_t WS_CTL = 0, CTL_ZERO_BYTES = 65536;
#endif
constexpr size_t WS_WIN = 2 * MiB;
constexpr size_t WS_WOUT = 8 * MiB;
constexpr size_t WS_WGU = 10 * MiB;
constexpr size_t WS_WD = 32 * MiB;
constexpr size_t WS_WPOOL = 44 * MiB;
constexpr size_t WS_WCK = 45 * MiB, WS_WCV = WS_WCK + 262144;
constexpr size_t WS_SC = 46 * MiB;
constexpr size_t WS_CB = 47 * MiB;
constexpr size_t WS_MOD = 48 * MiB;
constexpr size_t WS_KCMPP = 56 * MiB, WS_VCMPP = 57 * MiB;
constexpr size_t WS_KCMPS = 58 * MiB, WS_VCMPS = 62 * MiB;
constexpr size_t WS_GATES = 66 * MiB;
constexpr size_t WS_H = 72 * MiB;
constexpr size_t WS_Q = 108 * MiB;
constexpr size_t WS_O = 144 * MiB;
constexpr size_t WS_KV = 180 * MiB, KV_STRIDE = (size_t)MT * 256;
constexpr size_t WS_X = 232 * MiB;
constexpr size_t WS_HF = 300 * MiB;
constexpr size_t WS_ACT = 368 * MiB;
constexpr size_t WS_END = 464 * MiB;
static_assert(WS_KV + 6 * KV_STRIDE * 2 <= WS_X && WS_X + (size_t)MT * D * 4 <= WS_HF && WS_HF + (size_t)MT * D * 4 <= WS_ACT && WS_ACT + (size_t)MT * FF * 2 <= WS_END, "ws map");
static_assert(WS_WGU + 2 * (size_t)NGU * D * 2 <= WS_WD && WS_WD + 2 * (size_t)D * FF * 2 <= WS_WPOOL && WS_MOD + 2 * (size_t)NMODB * 6144 * 4 <= WS_KCMPP, "ws map 2");
static_assert(WS_GATES + (size_t)MT * 48 * 4 <= WS_H && WS_H + (size_t)MT * D * 2 <= WS_Q && WS_Q + (size_t)MT * D * 2 <= WS_O && WS_O + (size_t)MT * D * 2 <= WS_KV, "ws map 3");
constexpr int CW_BAR = 4096;

constexpr int RING_BYTES = 131072;
constexpr int LUT_OFF = RING_BYTES;
constexpr int WSF_OFF = LUT_OFF + 8192;
constexpr int IMP_OFF = WSF_OFF + 1024;
constexpr int MISC_OFF = IMP_OFF + 16384;
constexpr int LDS_BYTES = MISC_OFF + 256;
static_assert(LDS_BYTES <= 160 * 1024, "LDS");

__device__ __forceinline__ unsigned cvtpk(float lo, float hi) { f32x2 v = {lo, hi}; bf16x2_t b = __builtin_convertvector(v, bf16x2_t); return __builtin_bit_cast(unsigned, b); }
__device__ __forceinline__ float bf2f(unsigned short h) { return __builtin_bit_cast(float, (unsigned)h << 16); }
__device__ __forceinline__ float ex2(float x) { return __builtin_amdgcn_exp2f(x); }
__device__ __forceinline__ float sigmoidf_(float x) { return __builtin_amdgcn_rcpf(1.0f + ex2(-x * LOG2E)); }
#define CROW0(r) (((r) & 3) + 8 * ((r) >> 2))
#define LDS_WAIT() asm volatile("s_waitcnt lgkmcnt(0)" ::: "memory")
#define VM_WAIT() asm volatile("s_waitcnt vmcnt(0)" ::: "memory")
__device__ __forceinline__ const char* uniform_ptr(const void* p) { const unsigned long long v = (unsigned long long)p; const unsigned lo = (unsigned)__builtin_amdgcn_readfirstlane((int)(unsigned)v), hi = (unsigned)__builtin_amdgcn_readfirstlane((int)(unsigned)(v >> 32)); return (const char*)(((unsigned long long)hi << 32) | lo); }

__device__ __forceinline__ int lane_id() { int l; asm volatile("v_mbcnt_lo_u32_b32 %0, -1, 0\n\tv_mbcnt_hi_u32_b32 %0, -1, %0" : "=v"(l)); return l; }
__device__ __forceinline__ int t5_bucket(int d) {
    if (d < 16) return d;
    int b = 16;
    b += (d >= 19) + (d >= 21) + (d >= 24) + (d >= 27) + (d >= 31) + (d >= 35) + (d >= 40) + (d >= 46) + (d >= 52) + (d >= 59) + (d >= 67) + (d >= 77) + (d >= 87) + (d >= 99) + (d >= 113);
    return b;
}

namespace pg8 {
constexpr int BM = 256, BK = 64, HALF = 128, HTB = HALF * BK * 2, STAGE_BYTES = 8 * HTB, NXCD = 8, WGM = 8;
__host__ __device__ __forceinline__ int lds_byte(int r, int c) { const int st = (r >> 4) * 2 + (c >> 5), rr = r & 15, cc = c & 31, ob = rr * 64 + cc * 2; return st * 1024 + (ob ^ (((ob >> 9) & 1) << 5)); }
__host__ __device__ __forceinline__ void stage_rc(int b, int& R, int& C) { const int st = b / 1024, sb = b % 1024, swz = sb ^ (((sb >> 9) & 1) << 5); R = (st >> 1) * 16 + swz / 64; C = (st & 1) * 32 + (swz % 64) / 2; }
__host__ __device__ __forceinline__ int perm32(int rho) { const int n = rho >> 4, i = rho & 15; return 8 * (i >> 2) + 4 * n + (i & 3); }
struct Unit { int pm, pn; };
struct Gemm { const bf16_t* A; const bf16_t* Bt; int lda, ldb, K, acs; };
struct StaticOrder {
    int nM, nN, nwg, G, c;
    __host__ __device__ void init(int M, int N, int G_, int c_) { nM = M / BM; nN = N / BM; nwg = nM * nN; G = G_; c = c_; }
    __host__ __device__ bool next(int i, Unit& u) const {
        const long L = (long)i * G + c; if (L >= nwg) return false;
        int wgid = (int)L; { const int q = nwg / NXCD, r = nwg % NXCD, xcd = wgid % NXCD, off = wgid / NXCD; wgid = (xcd < r ? xcd * (q + 1) : r * (q + 1) + (xcd - r) * q) + off; }
        const int nig = WGM * nN, gid = wgid / nig, fm = gid * WGM, gsz = (nM - fm) < WGM ? (nM - fm) : WGM;
        u.pm = fm + ((wgid % nig) % gsz); u.pn = (wgid % nig) / gsz; return true;
    }
};
template <class Epi, class Sched, bool ALIGN_EPI>
__device__ __forceinline__ void gemm_phase(LAS unsigned char* lds, const Gemm g, const Sched& S, const Epi& E) {
    const int tid = threadIdx.x, wid = __builtin_amdgcn_readfirstlane(tid >> 6), lane = tid & 63, wr = wid >> 2, wc = wid & 3, fr = lane & 15, fq = lane >> 4;
    const int K = g.K, nt = K / BK;
    unsigned voffA[2], voffB[2];
#pragma unroll
    for (int i = 0; i < 2; ++i) { int R, C; stage_rc(tid * 16 + i * 8192, R, C); const int Rb = Epi::PERM ? ((R & ~31) + perm32(R & 31)) : R;
        voffA[i] = (unsigned)(R * g.lda + C) * 2u; voffB[i] = (unsigned)(Rb * g.ldb + C) * 2u; }
    const size_t kstep = (size_t)(BK * 2);
    const size_t hsA = (size_t)HALF * g.lda * 2, hsB = (size_t)HALF * g.ldb * 2;
    const unsigned ldsw = (unsigned)wid * 1024u;
    const int aoff = lds_byte(wr * 64 + fr, fq * 8), boff = lds_byte(wc * 32 + fr, fq * 8);
#define PG8_SA(b, h) (((b) * 2 + (h)) * HTB)
#define PG8_SB(b, h) ((4 + (b) * 2 + (h)) * HTB)
#define PG8_STAGE(bufoff, gbase, voff) do { _Pragma("unroll") for (int _i = 0; _i < 2; ++_i) \
        __builtin_amdgcn_global_load_lds((const unsigned*)((const char*)(gbase) + (voff)[_i]), (LAS unsigned*)(lds + (bufoff) + ldsw + _i * 8192), 16, 0, 0); } while (0)
#define PG8_LDA(dst, b, h) do { _Pragma("unroll") for (int m = 0; m < 4; ++m) _Pragma("unroll") for (int k = 0; k < 2; ++k) dst[m][k] = *(const LAS bf16x8*)(lds + PG8_SA(b, h) + aoff + m * 2048 + k * 1024); } while (0)
#define PG8_LDB(dst, b, h) do { _Pragma("unroll") for (int n = 0; n < 2; ++n) _Pragma("unroll") for (int k = 0; k < 2; ++k) dst[n][k] = *(const LAS bf16x8*)(lds + PG8_SB(b, h) + boff + n * 2048 + k * 1024); } while (0)
#define PG8_MMA(ai, bj, At, Bt) do { __builtin_amdgcn_s_setprio(1); _Pragma("unroll") for (int m = 0; m < 4; ++m) _Pragma("unroll") for (int n = 0; n < 2; ++n) _Pragma("unroll") for (int k = 0; k < 2; ++k) \
        acc[ai][bj][m][n] = __builtin_amdgcn_mfma_f32_16x16x32_bf16(Bt[n][k], At[m][k], acc[ai][bj][m][n], 0, 0, 0); __builtin_amdgcn_s_setprio(0); } while (0)
#define PG8_WAIT_V(n) asm volatile("s_waitcnt vmcnt(" #n ")" ::: "memory")
#define PG8_WAIT_L(n) asm volatile("s_waitcnt lgkmcnt(" #n ")" ::: "memory")
#define PG8_BAR __builtin_amdgcn_s_barrier()
#define PG8_SCHED __builtin_amdgcn_sched_barrier(0)
#define PG8_UA(u) ((const char*)g.A + (size_t)(u).pm * 2 * hsA + (size_t)(u).pn * (size_t)g.acs * 2)
#define PG8_UB(u) ((const char*)g.Bt + (size_t)(u).pn * 2 * hsB)
    Unit cur, nxt; int ui = 0;
    if (!S.next(0, cur)) return;
    f32x4 acc[2][2][4][2];
#pragma unroll
    for (int a = 0; a < 2; ++a)
#pragma unroll
        for (int b = 0; b < 2; ++b)
#pragma unroll
            for (int m = 0; m < 4; ++m)
#pragma unroll
                for (int n = 0; n < 2; ++n) acc[a][b][m][n] = (f32x4){0.f, 0.f, 0.f, 0.f};
    bf16x8 At[4][2], B0[2][2], B1[2][2];
    const char* cA = PG8_UA(cur); const char* cB = PG8_UB(cur);
    PG8_STAGE(PG8_SB(0, 0), cB, voffB); PG8_STAGE(PG8_SB(0, 1), cB + hsB, voffB); PG8_STAGE(PG8_SA(0, 0), cA, voffA); PG8_STAGE(PG8_SA(0, 1), cA + hsA, voffA);
    if (wr == 1) PG8_BAR;
    PG8_WAIT_V(2); PG8_BAR;
    PG8_STAGE(PG8_SB(1, 0), cB + kstep, voffB); PG8_STAGE(PG8_SA(1, 0), cA + kstep, voffA); PG8_STAGE(PG8_SB(1, 1), cB + hsB + kstep, voffB);
    PG8_WAIT_V(6); PG8_BAR;
    for (;;) {
        const bool has_next = S.next(ui + 1, nxt);
        const char* nA = has_next ? PG8_UA(nxt) : cA; const char* nB = has_next ? PG8_UB(nxt) : cB;
        for (int t = 0; t < nt; t += 2) {
            const bool last = (t == nt - 2);
            const char* a1 = cA + (size_t)(t + 1) * kstep;
            const char* a2 = last ? nA : cA + (size_t)(t + 2) * kstep; const char* b2 = last ? nB : cB + (size_t)(t + 2) * kstep;
            const char* a3 = a2 + kstep; const char* b3 = b2 + kstep;
            PG8_LDB(B0, 0, 0); PG8_LDB(B1, 0, 1); PG8_SCHED; PG8_LDA(At, 0, 0); PG8_STAGE(PG8_SA(1, 1), a1 + hsA, voffA);
            PG8_WAIT_V(8); PG8_WAIT_L(0); PG8_BAR; PG8_MMA(0, 0, At, B0); PG8_MMA(0, 1, At, B1); PG8_BAR; PG8_SCHED;
            PG8_LDA(At, 0, 1); PG8_STAGE(PG8_SB(0, 0), b2, voffB); PG8_STAGE(PG8_SB(0, 1), b2 + hsB, voffB); PG8_STAGE(PG8_SA(0, 0), a2, voffA);
            PG8_WAIT_V(8); PG8_WAIT_L(0); PG8_BAR; PG8_MMA(1, 0, At, B0); PG8_MMA(1, 1, At, B1); PG8_BAR; PG8_SCHED;
            PG8_LDB(B0, 1, 0); PG8_LDB(B1, 1, 1); PG8_SCHED; PG8_LDA(At, 1, 0); PG8_STAGE(PG8_SA(0, 1), a2 + hsA, voffA);
            PG8_WAIT_V(8); PG8_WAIT_L(0); PG8_BAR; PG8_MMA(0, 0, At, B0); PG8_MMA(0, 1, At, B1); PG8_BAR; PG8_SCHED;
            PG8_LDA(At, 1, 1); PG8_STAGE(PG8_SB(1, 0), b3, voffB); PG8_STAGE(PG8_SB(1, 1), b3 + hsB, voffB); PG8_STAGE(PG8_SA(1, 0), a3, voffA);
            PG8_WAIT_V(8); PG8_WAIT_L(0); PG8_BAR; PG8_MMA(1, 0, At, B0); PG8_MMA(1, 1, At, B1); PG8_BAR; PG8_SCHED;
        }
        if constexpr (ALIGN_EPI) { if (wr == 0) PG8_BAR; }
        E(acc, cur, wr, wc, fr, fq);
        if (!has_next) break;
#pragma unroll
        for (int a = 0; a < 2; ++a)
#pragma unroll
            for (int b = 0; b < 2; ++b)
#pragma unroll
                for (int m = 0; m < 4; ++m)
#pragma unroll
                    for (int n = 0; n < 2; ++n) acc[a][b][m][n] = (f32x4){0.f, 0.f, 0.f, 0.f};
        cur = nxt; cA = nA; cB = nB; ++ui;
        if constexpr (ALIGN_EPI) { if (wr == 1) PG8_BAR; }
    }
    PG8_WAIT_V(0);
    if constexpr (!ALIGN_EPI) { if (wr == 0) PG8_BAR; }
    PG8_BAR;
#undef PG8_SA
#undef PG8_SB
#undef PG8_STAGE
#undef PG8_LDA
#undef PG8_LDB
#undef PG8_MMA
#undef PG8_WAIT_V
#undef PG8_WAIT_L
#undef PG8_BAR
#undef PG8_SCHED
#undef PG8_UA
#undef PG8_UB
}

struct EpiProj {
    static constexpr bool PERM = true;
    bf16_t* Q; bf16_t* KV; float* gates; float* out;
    __device__ __forceinline__ void operator()(const f32x4 (&acc)[2][2][4][2], const Unit& u, int wr, int wc, int fr, int fq) const {
        const int pn = u.pn;
#pragma unroll
        for (int ai = 0; ai < 2; ++ai)
#pragma unroll
            for (int m = 0; m < 4; ++m) {
                const int row = u.pm * BM + ai * HALF + wr * 64 + m * 16 + fr;
                if (pn < 4) {
#pragma unroll
                    for (int bj = 0; bj < 2; ++bj) { const f32x4 v0 = acc[ai][bj][m][0] * C2, v1 = acc[ai][bj][m][1] * C2; u32x4 w;
                        w.x = cvtpk(v0[0], v0[1]); w.y = cvtpk(v0[2], v0[3]); w.z = cvtpk(v1[0], v1[1]); w.w = cvtpk(v1[2], v1[3]);
                        *(u32x4*)(Q + (size_t)row * D + pn * 256 + bj * HALF + wc * 32 + 8 * fq) = w; }
                } else if (pn < 10) {
                    const int t = pn - 4; float* dst = nullptr;
                    if (row < MP) { if (t < 4) dst = out + O_KCP + (size_t)t * SZ_KVP + (size_t)row * 256; else { const int tt = row & (SEQ - 1); if (tt >= SEQ - 512) dst = out + O_KWP + (size_t)(t - 4) * SZ_WP + ((size_t)(row >> 12) * 512 + (tt - (SEQ - 512))) * 256; } }
                    else { const int rs = row - MP; if (t < 4) dst = out + O_KCS + (size_t)t * SZ_KVS + (size_t)rs * 256; else dst = out + O_KWS + (size_t)(t - 4) * SZ_WS + ((size_t)(rs >> 2) * 512 + 508 + (rs & 3)) * 256; }
                    bf16_t* bd = KV + (size_t)t * KV_STRIDE + (size_t)row * 256;
#pragma unroll
                    for (int bj = 0; bj < 2; ++bj) { const int cc = bj * HALF + wc * 32 + 8 * fq; const f32x4 v0 = acc[ai][bj][m][0], v1 = acc[ai][bj][m][1]; u32x4 w;
                        w.x = cvtpk(v0[0], v0[1]); w.y = cvtpk(v0[2], v0[3]); w.z = cvtpk(v1[0], v1[1]); w.w = cvtpk(v1[2], v1[3]);
                        *(u32x4*)(bd + cc) = w;
                        if (dst) { *(f32x4*)(dst + cc) = v0; *(f32x4*)(dst + cc + 4) = v1; } }
                } else {
                    const int cc = wc * 32 + 8 * fq;
                    if (cc < 48) { float* gd = gates + (size_t)row * 48 + cc; *(f32x4*)gd = acc[ai][0][m][0]; *(f32x4*)(gd + 4) = acc[ai][0][m][1]; }
                }
            }
    }
};
template <bool XF32>
struct EpiRes {
    static constexpr bool PERM = false;
    const float* xin_p; const float* xin_s; bf16_t* xout; const float* gate;
    __device__ __forceinline__ void operator()(const f32x4 (&acc)[2][2][4][2], const Unit& u, int wr, int wc, int fr, int fq) const {
#pragma unroll
        for (int ai = 0; ai < 2; ++ai)
#pragma unroll
            for (int m = 0; m < 4; ++m) {
                const int row = u.pm * BM + ai * HALF + wr * 64 + m * 16 + fr;
                const int bb = row < MP ? (row >> 12) : NB + ((row - MP) >> 2);
                const float* xi = row < MP ? xin_p + (size_t)row * D : xin_s + (size_t)(row - MP) * D;
                const float* gp = gate + (size_t)bb * 6144; bf16_t* xo = xout + (size_t)row * D;
#pragma unroll
                for (int bj = 0; bj < 2; ++bj)
#pragma unroll
                    for (int n = 0; n < 2; ++n) { const int col = u.pn * BM + bj * HALF + wc * 32 + 16 * n + 4 * fq;
                        const f32x4 g4 = *(const f32x4*)(gp + col);
                        f32x4 x4;
                        if constexpr (XF32) x4 = *(const f32x4*)(xi + col);
                        else { const u32x2 xw = *(const u32x2*)(xo + col); x4 = (f32x4){__builtin_bit_cast(float, xw.x << 16), __builtin_bit_cast(float, xw.x & 0xffff0000u), __builtin_bit_cast(float, xw.y << 16), __builtin_bit_cast(float, xw.y & 0xffff0000u)}; }
                        const f32x4 rr = x4 + g4 * acc[ai][bj][m][n];
                        u32x2 w; w.x = cvtpk(rr[0], rr[1]); w.y = cvtpk(rr[2], rr[3]); *(u32x2*)(xo + col) = w; }
            }
    }
};
struct EpiGU {
    static constexpr bool PERM = true;
    bf16_t* act;
    __device__ __forceinline__ void operator()(const f32x4 (&acc)[2][2][4][2], const Unit& u, int wr, int wc, int fr, int fq) const {
#pragma unroll
        for (int ai = 0; ai < 2; ++ai)
#pragma unroll
            for (int m = 0; m < 4; ++m) {
                const int row = u.pm * BM + ai * HALF + wr * 64 + m * 16 + fr; float r[8];
#pragma unroll
                for (int n = 0; n < 2; ++n)
#pragma unroll
                    for (int e = 0; e < 4; ++e) { const float gv = acc[ai][0][m][n][e], uv = acc[ai][1][m][n][e]; r[n * 4 + e] = gv * sigmoidf_(gv) * uv; }
                u32x4 w; w.x = cvtpk(r[0], r[1]); w.y = cvtpk(r[2], r[3]); w.z = cvtpk(r[4], r[5]); w.w = cvtpk(r[6], r[7]);
                *(u32x4*)(act + (size_t)row * FF + u.pn * HALF + wc * 32 + 8 * fq) = w;
            }
    }
};
}

#define XB_TMO      128
#define XB_XCNT(j)  (256  + 64 * (j))
#define XB_XSUB(j)  (1280 + 64 * (j))
#define XB_XGEN(j)  (2304 + 64 * (j))
#define XB_TOP      3328
#define XB_TOPGEN   3392
#define XCD_BAR_WORDS 3456
#define XB_SPIN_CAP (1u << 18)
__device__ __forceinline__ unsigned xb_ld(unsigned* p)              { return __hip_atomic_load(p, __ATOMIC_RELAXED, __HIP_MEMORY_SCOPE_AGENT); }
__device__ __forceinline__ unsigned xb_add(unsigned* p, unsigned v) { return __hip_atomic_fetch_add(p, v, __ATOMIC_RELAXED, __HIP_MEMORY_SCOPE_AGENT); }
__device__ __forceinline__ unsigned xb_xcc_id() { return (unsigned)__builtin_amdgcn_s_getreg((3 << 11) | 20) & 0xFu; }
#define XB_SPIN(cond, bar) do { unsigned _sp = 0; while (cond) { __builtin_amdgcn_s_sleep(1); \
    if ((++_sp & 255u) == 0u) { if (xb_ld(&(bar)[XB_TMO])) break; if (_sp > XB_SPIN_CAP) { atomicAdd(&(bar)[XB_TMO], 1u); break; } } } } while (0)
struct XcdBarrier { unsigned* bar; unsigned x; volatile LAS unsigned* st; };
__device__ __forceinline__ XcdBarrier xcd_barrier_post(unsigned* bar, volatile LAS unsigned* st) {
    XcdBarrier b; b.bar = bar; b.x = xb_xcc_id(); b.st = st;
    if (threadIdx.x == 0) (void)xb_add(&bar[XB_XCNT(b.x)], 1u);
    return b;
}
__device__ __forceinline__ void xcd_barrier_complete(unsigned* bar, unsigned x, unsigned& nloc, unsigned& nx) {
    const unsigned G = gridDim.x * gridDim.y * gridDim.z;
    unsigned sum, cnt, mine, sp = 0u;
    for (;;) {
        sum = 0u; cnt = 0u; mine = 0u;
#pragma unroll
        for (unsigned j = 0; j < 16; ++j) { const unsigned c = xb_ld(&bar[XB_XCNT(j)]); sum += c; cnt += (c > 0u) ? 1u : 0u; mine = (j == x) ? c : mine; }
        if (sum == G) break;
        __builtin_amdgcn_s_sleep(1);
        if ((++sp & 255u) == 0u) { if (xb_ld(&bar[XB_TMO])) break; if (sp > XB_SPIN_CAP) { atomicAdd(&bar[XB_TMO], 1u); break; } }
    }
    nloc = mine > 0u ? mine : 1u; nx = cnt > 0u ? cnt : 1u;
}
__device__ __forceinline__ void xcd_barrier(const XcdBarrier& b) {
    asm volatile("s_waitcnt vmcnt(0)" ::: "memory");
    __syncthreads();
    if (threadIdx.x == 0) {
        unsigned* bar = b.bar;
        __builtin_amdgcn_s_waitcnt(0);
        unsigned nloc = b.st[0], nx = b.st[1];
        if (nloc == 0u) { xcd_barrier_complete(bar, b.x, nloc, nx); b.st[0] = nloc; b.st[1] = nx; }
        const unsigned old = xb_add(&bar[XB_XSUB(b.x)], 1u);
        const unsigned gen = old / nloc;
        if (old + 1u == (gen + 1u) * nloc) {
            __builtin_amdgcn_fence(__ATOMIC_RELEASE, "agent");
            asm volatile("s_waitcnt vmcnt(0)" ::: "memory");
            const unsigned og = xb_add(&bar[XB_TOP], 1u);
            const unsigned tg = og / nx;
            if (og + 1u == (tg + 1u) * nx) xb_add(&bar[XB_TOPGEN], 1u);
            else XB_SPIN(xb_ld(&bar[XB_TOPGEN]) == tg, bar);
            __builtin_amdgcn_fence(__ATOMIC_ACQUIRE, "agent");
            xb_add(&bar[XB_XGEN(b.x)], 1u);
            asm volatile("s_waitcnt vmcnt(0)" ::: "memory");
        } else {
            XB_SPIN(xb_ld(&bar[XB_XGEN(b.x)]) == gen, bar);
            __builtin_amdgcn_fence(__ATOMIC_ACQUIRE, "agent");
            asm volatile("s_waitcnt vmcnt(0)" ::: "memory");
        }
    }
    __syncthreads();
}

struct Args { const void* in[28]; float* out; unsigned char* ws; int ph_lo, ph_hi, pad0, pad1; };
struct Frame {
    LAS unsigned char* lds; int tid, lane, wave, vcu, G;
    const float *x_p, *x_s, *c_p, *c_s, *ck_cmp, *cv_cmp, *ck_sel, *cv_sel; const int* page_table; const float *st_kw, *st_vw, *st_pool, *rel_bias, *ada_w, *ada_b, *norm_g, *final_g,
        *w_in, *w_out, *cmp_wk, *cmp_wv, *pe_k, *pe_v, *pool_w, *pool_scale, *ffn_wg, *ffn_wu, *ffn_wd;
    float* out; unsigned char* ws;
};
__device__ __forceinline__ float wave_sum(float v) {
#pragma unroll
    for (int o = 1; o < 64; o <<= 1) v += __shfl_xor(v, o);
    return v;
}

__device__ __forceinline__ void transpose_item(const float* W, int ldw, int nvalid, bf16_t* WT, int ldt, int drow0, LAS float* scr, int k0, int n0, int lane, const float* rs = nullptr  ) {
    float tv[32];
#pragma unroll
    for (int i = 0; i < 32; ++i) { const int kk = 2 * i + (lane >> 5), n = n0 + (lane & 31); tv[i] = (n < nvalid) ? W[(size_t)(k0 + kk) * ldw + n] : 0.f; }
    if (rs) { const float rsv = rs[n0 + (lane & 31)];
#pragma unroll
        for (int i = 0; i < 32; ++i) tv[i] *= rsv; }
#pragma unroll
    for (int i = 0; i < 32; ++i) { const int kk = 2 * i + (lane >> 5); scr[kk * 33 + (lane & 31)] = tv[i]; }
    LDS_WAIT();
    const int c = lane & 7;
#pragma unroll
    for (int j = 0; j < 4; ++j) { const int n = (lane >> 3) + 8 * j; const LAS float* s = scr + (8 * c) * 33 + n;
        u32x4 o; o.x = cvtpk(s[0 * 33], s[1 * 33]); o.y = cvtpk(s[2 * 33], s[3 * 33]); o.z = cvtpk(s[4 * 33], s[5 * 33]); o.w = cvtpk(s[6 * 33], s[7 * 33]);
        *(u32x4*)(WT + (size_t)(drow0 + n) * ldt + k0 + 8 * c) = o; }
    LDS_WAIT();
}
__device__ __forceinline__ void p0_prologue(Frame& F) {
    LAS float* scr = (LAS float*)(F.lds + F.wave * 16384);
    const int gw = F.vcu * 8 + F.wave, NGW = F.G * 8, lane = F.lane;
    unsigned char* ws = F.ws;
    constexpr int I_IN = 16 * 88, I_OUT = 16 * 32, I_G = 16 * 88, I_D = 44 * 32, I_P = 4 * 8, I_C = 32 * 2;
    constexpr int NITEMS = I_IN + I_OUT + 4 * I_G + 2 * I_D + 4 * I_P + 2 * I_C;
    for (int it = gw; it < NITEMS; it += NGW) {
        int r = it;
        if (r < I_IN) { const int kb = r / 88, nb = r % 88; transpose_item(F.w_in, INCOLS, INCOLS, (bf16_t*)(ws + WS_WIN), D, nb * 32, scr, kb * 64, nb * 32, lane); continue; } r -= I_IN;
        if (r < I_OUT) { const int kb = r / 32, nb = r % 32; transpose_item(F.w_out, D, D, (bf16_t*)(ws + WS_WOUT), D, nb * 32, scr, kb * 64, nb * 32, lane); continue; } r -= I_OUT;
        if (r < 4 * I_G) { const int l = r / (2 * I_G), which = (r / I_G) & 1, q = r % I_G, kb = q / 88, nb = q % 88, n0 = nb * 32;
            const float* W = (which ? F.ffn_wu : F.ffn_wg) + (size_t)l * D * FF;
            transpose_item(W, FF, FF, (bf16_t*)(ws + WS_WGU) + (size_t)l * NGU * D, D, (n0 >> 7) * 256 + which * 128 + (n0 & 127), scr, kb * 64, n0, lane); continue; } r -= 4 * I_G;
        if (r < 2 * I_D) { const int l = r / I_D, q = r % I_D, kb = q / 32, nb = q % 32;
            transpose_item(F.ffn_wd + (size_t)l * FF * D, D, D, (bf16_t*)(ws + WS_WD) + (size_t)l * D * FF, FF, nb * 32, scr, kb * 64, nb * 32, lane); continue; } r -= 2 * I_D;
        if (r < 4 * I_P) { const int gI = r / I_P, q = r % I_P, kb = q / 8, nb = q % 8;
            transpose_item(F.pool_w + (size_t)gI * 65536, 256, 256, (bf16_t*)(ws + WS_WPOOL) + (size_t)gI * 65536, 256, nb * 32, scr, kb * 64, nb * 32, lane, F.pool_scale + gI * 256); continue; } r -= 4 * I_P;
        { const int which = r / I_C, q = r % I_C, kb = q / 2, nb = q % 2;
          transpose_item(which ? F.cmp_wv : F.cmp_wk, 64, 64, (bf16_t*)(ws + (which ? WS_WCV : WS_WCK)), 2048, nb * 32, scr, kb * 64, nb * 32, lane); }
    }
    { const int gt = (F.vcu * 8 + F.wave) * 64 + lane, NT = F.G * 512; bf16_t* sc = (bf16_t*)(ws + WS_SC);
      for (int i = gt; i < 144 * 512; i += NT) { const int row = i >> 9, c2 = (i & 511) * 2; float a = 0.f, b = 0.f;
          if (row < NMODB) { const float* cp = row < NB ? F.c_p + (size_t)row * D : F.c_s + (size_t)(row - NB) * D; const float x0 = cp[c2], x1 = cp[c2 + 1]; a = x0 * sigmoidf_(x0); b = x1 * sigmoidf_(x1); }
          *(unsigned*)(sc + (size_t)row * D + c2) = cvtpk(a, b); } }
    if (F.vcu < 16) { const int tsel = F.vcu >> 3, part = F.vcu & 7; const float* pe = tsel ? F.pe_v : F.pe_k; const float* W = tsel ? F.cmp_wv : F.cmp_wk; float sacc = 0.f;
        const int kb = part * 256 + F.wave * 32;
#pragma unroll
        for (int k = 0; k < 32; ++k) sacc += pe[kb + k] * W[(size_t)(kb + k) * 64 + lane];
        LAS float* red = (LAS float*)(F.lds + WSF_OFF);
        red[F.wave * 64 + lane] = sacc; LDS_WAIT(); __syncthreads();
        if (F.wave == 0) { float t2 = 0.f;
#pragma unroll
            for (int w = 0; w < 8; ++w) t2 += red[w * 64 + lane];
            ((float*)(ws + WS_CB))[(tsel * 8 + part) * 64 + lane] = t2; }
        __syncthreads(); }
    { const size_t gt = (size_t)(F.vcu * 8 + F.wave) * 64 + lane, NT = (size_t)F.G * 512;
      const size_t pp = (size_t)NSB * 11 * 256;
      for (size_t i = gt; i < pp; i += NT) { const size_t b = i / (11 * 256), rem = i % (11 * 256);
          ((f32x4*)(F.out + O_PLS + b * 15 * D))[rem] = ((const f32x4*)(F.st_pool + (b * 15 + 4) * D))[rem]; } }
}

__device__ __forceinline__ void p1_ada(Frame& F) {
    const int gw = F.vcu * 8 + F.wave, NGW = F.G * 8, lane = F.lane, fr = lane & 15, kq = lane >> 4;
    const bf16_t* sc = (const bf16_t*)(F.ws + WS_SC); float* mod = (float*)(F.ws + WS_MOD);
    for (int tile = F.wave < 3 ? F.vcu * 3 + F.wave : 768; tile < 768; tile += F.G * 3) {
        const int layer = tile / 384, n0 = (tile % 384) * 16;
        const float* W = F.ada_w + (size_t)layer * D * 6144 + n0 + fr;
        f32x4 acc[9];
#pragma unroll
        for (int i = 0; i < 9; ++i) acc[i] = (f32x4){0.f, 0.f, 0.f, 0.f};
#pragma unroll 4
        for (int k0 = 0; k0 < D; k0 += 32) {
            float w[8];
#pragma unroll
            for (int i = 0; i < 8; ++i) w[i] = W[(size_t)(k0 + 8 * kq + i) * 6144];
            u32x4 bw; bw.x = cvtpk(w[0], w[1]); bw.y = cvtpk(w[2], w[3]); bw.z = cvtpk(w[4], w[5]); bw.w = cvtpk(w[6], w[7]);
            const bf16x8 bfrag = __builtin_bit_cast(bf16x8, bw);
#pragma unroll
            for (int mt = 0; mt < 9; ++mt) { const bf16x8 af = *(const bf16x8*)(sc + (size_t)(mt * 16 + fr) * D + k0 + 8 * kq);
                acc[mt] = __builtin_amdgcn_mfma_f32_16x16x32_bf16(af, bfrag, acc[mt], 0, 0, 0); }
        }
        const float bias = F.ada_b[layer * 6144 + n0 + fr];
#pragma unroll
        for (int mt = 0; mt < 9; ++mt)
#pragma unroll
            for (int e = 0; e < 4; ++e) { const int row = mt * 16 + 4 * kq + e; if (row < NMODB) mod[((size_t)layer * NMODB + row) * 6144 + n0 + fr] = acc[mt][e] + bias; }
    }
}

__device__ __forceinline__ void p1_compress_sample(Frame& F) {
    const int lane = F.lane, wave = F.wave, r32 = lane & 31, hi = lane >> 5, kvl = lane >> 4, c4 = lane & 15;
    LAS unsigned char* L = F.lds;
    const int wrow = wave * 4 + kvl, total = 2 * NSB * 8;
    const int nitem = (total - F.vcu + F.G - 1) / F.G; if (nitem <= 0) return;
    const int nstage = 2 * nitem;
#define CS_BAR() do { asm volatile("s_waitcnt lgkmcnt(0)" ::: "memory"); __builtin_amdgcn_s_barrier(); asm volatile("" ::: "memory"); } while (0)
#define CS_SRC(g, ptr) do { const int it_ = F.vcu + F.G * ((g) >> 1); const int wh_ = it_ / (NSB * 8), q_ = it_ % (NSB * 8), b_ = q_ >> 3, n_ = (q_ & 7) * 8 + wave; const int pg_ = F.page_table[b_ * 16 + (n_ >> 2)]; \
        ptr = uniform_ptr((wh_ ? F.cv_cmp : F.ck_cmp) + ((size_t)pg_ * 128 + (n_ & 3) * 32 + ((g) & 1) * 16) * 256); } while (0)
#define CS_LOAD(ptr) do { _Pragma("unroll") for (int jj = 0; jj < 16; ++jj) x[jj] = *(const f32x4*)((ptr) + (unsigned)(jj * 1024 + lane * 16)); } while (0)
#define CS_STORE(buf) do { _Pragma("unroll") for (int jj = 0; jj < 16; ++jj) { u32x2 w_; w_.x = cvtpk(x[jj][0], x[jj][1]); w_.y = cvtpk(x[jj][2], x[jj][3]); \
        *(LAS u32x2*)(L + (buf) * 65536 + wrow * 2048 + (((jj * 8 + (c4 >> 1)) ^ (wrow & 15)) << 4) + (c4 & 1) * 8) = w_; } } while (0)
    f32x4 x[16]; const char* sp;
    CS_SRC(0, sp); CS_LOAD(sp); CS_STORE(0); CS_BAR();
    f32x16 a0, a1;
#pragma unroll
    for (int r = 0; r < 16; ++r) { a0[r] = 0.f; a1[r] = 0.f; }
#pragma unroll 1
    for (int g = 0; g < nstage; ++g) {
        const int it = F.vcu + F.G * (g >> 1), which = it / (NSB * 8), q = it % (NSB * 8), b = q >> 3, n0 = (q & 7) * 8;
        const bf16_t* wp = (const bf16_t*)(F.ws + (which ? WS_WCV : WS_WCK)) + (size_t)r32 * 2048 + (g & 1) * 1024 + 128 * wave + 8 * hi;
        bf16x8 bfr[16];
#pragma unroll
        for (int ks = 0; ks < 8; ++ks) { bfr[2 * ks] = *(const bf16x8*)(wp + 16 * ks); bfr[2 * ks + 1] = *(const bf16x8*)(wp + 32 * 2048 + 16 * ks); }
        if (g + 1 < nstage) { CS_SRC(g + 1, sp); CS_LOAD(sp); }
        const LAS unsigned char* ab = L + (g & 1) * 65536 + r32 * 2048;
#pragma unroll
        for (int ks = 0; ks < 8; ++ks) { const bf16x8 af = *(const LAS bf16x8*)(ab + (((16 * wave + 2 * ks + hi) ^ (r32 & 15)) << 4));
            a0 = __builtin_amdgcn_mfma_f32_32x32x16_bf16(af, bfr[2 * ks], a0, 0, 0, 0); a1 = __builtin_amdgcn_mfma_f32_32x32x16_bf16(af, bfr[2 * ks + 1], a1, 0, 0, 0); }
        CS_BAR();
        if (g & 1) {
            LAS float* red = (LAS float*)(L + 65536) + wave * 2048 + hi * 256 + r32;
#pragma unroll
            for (int r = 0; r < 16; ++r) { red[CROW0(r) * 64] = a0[r]; red[CROW0(r) * 64 + 32] = a1[r]; a0[r] = 0.f; a1[r] = 0.f; }
            CS_BAR();
            { const int row = F.tid >> 4, cc = (F.tid & 15) * 4; f32x4 sacc = (f32x4){0.f, 0.f, 0.f, 0.f};
#pragma unroll
              for (int pp = 0; pp < 8; ++pp) sacc = sacc + *(const f32x4*)((const float*)(F.ws + WS_CB) + (which * 8 + pp) * 64 + cc);
#pragma unroll
              for (int w = 0; w < 8; ++w) sacc = sacc + *(const LAS f32x4*)((const LAS float*)(L + 65536) + w * 2048 + row * 64 + cc);
              bf16_t* o = (bf16_t*)(F.ws + (which ? WS_VCMPS : WS_KCMPS)) + (size_t)b * 4 * 64 * 64 + ((size_t)(row & 3) * 64 + n0 + (row >> 2)) * 64 + cc;
              u32x2 w2; w2.x = cvtpk(sacc[0], sacc[1]); w2.y = cvtpk(sacc[2], sacc[3]); *(u32x2*)o = w2; }
        }
        if (g + 1 < nstage) CS_STORE((g + 1) & 1);
        CS_BAR();
    }
    VM_WAIT(); __syncthreads();
#undef CS_BAR
#undef CS_SRC
#undef CS_LOAD
#undef CS_STORE
}
__device__ __forceinline__ void p4_compress_prompt(Frame& F) {
    const int lane = F.lane, r32 = lane & 31, hi = lane >> 5, nl = r32 >> 2, kv = r32 & 3;
    for (int it = F.vcu; it < 2 * NB * 16; it += F.G) {
        const int which = it / (NB * 16), q = it % (NB * 16), b = q >> 4, n0 = (q & 15) * 8, n = n0 + nl;
        const bf16_t* src = (const bf16_t*)(F.ws + WS_KV) + (size_t)which * KV_STRIDE + ((size_t)b * SEQ + (size_t)n * 32) * 256 + kv * 64;
        const bf16_t* Wt = (const bf16_t*)(F.ws + (which ? WS_WCV : WS_WCK));
        const bf16_t* w0 = Wt + (size_t)r32 * 2048 + hi * 8; const bf16_t* w1 = w0 + (size_t)32 * 2048;
        f32x16 a0, a1;
#pragma unroll
        for (int r = 0; r < 16; ++r) { a0[r] = 0.f; a1[r] = 0.f; }
#pragma unroll
        for (int jj = 0; jj < 4; ++jj) { const int j = F.wave * 4 + jj;
#pragma unroll
            for (int ds = 0; ds < 4; ++ds) { const bf16x8 af = *(const bf16x8*)(src + (size_t)j * 256 + ds * 16 + hi * 8);
                const bf16x8 b0 = *(const bf16x8*)(w0 + j * 64 + ds * 16), b1 = *(const bf16x8*)(w1 + j * 64 + ds * 16);
                a0 = __builtin_amdgcn_mfma_f32_32x32x16_bf16(af, b0, a0, 0, 0, 0); a1 = __builtin_amdgcn_mfma_f32_32x32x16_bf16(af, b1, a1, 0, 0, 0); } }
        LAS float* red = (LAS float*)F.lds + F.wave * 2048 + hi * 256 + r32;
#pragma unroll
        for (int r = 0; r < 16; ++r) { red[CROW0(r) * 64] = a0[r]; red[CROW0(r) * 64 + 32] = a1[r]; }
        LDS_WAIT(); __syncthreads();
        { const int row = F.tid >> 4, c4 = (F.tid & 15) * 4; f32x4 sacc = (f32x4){0.f, 0.f, 0.f, 0.f};
#pragma unroll
          for (int pp = 0; pp < 8; ++pp) sacc = sacc + *(const f32x4*)((const float*)(F.ws + WS_CB) + (which * 8 + pp) * 64 + c4);
#pragma unroll
          for (int w = 0; w < 8; ++w) sacc = sacc + *(const LAS f32x4*)((const LAS float*)F.lds + w * 2048 + row * 64 + c4);
          bf16_t* o = (bf16_t*)(F.ws + (which ? WS_VCMPP : WS_KCMPP)) + (size_t)b * 4 * 128 * 64 + ((size_t)(row & 3) * 128 + n0 + (row >> 2)) * 64 + c4;
          u32x2 w2; w2.x = cvtpk(sacc[0], sacc[1]); w2.y = cvtpk(sacc[2], sacc[3]); *(u32x2*)o = w2; }
        __syncthreads();
    }
}

template <bool XF32>
__device__ __forceinline__ void small_gemm_res(Frame& F, const bf16_t* A  , int lda, const bf16_t* Wt, int ldb, int K, bool bd, const float* xin_s  , bf16_t* xout_s, const float* gate) {
    const int lane = F.lane, r32 = lane & 31, hi = lane >> 5, kw = K >> 3, kbeg = F.wave * kw;
    for (int tile = F.vcu; tile < 256; tile += F.G) {
        const int row0 = (tile >> 4) * 32, col0 = (tile & 15) * 64, acol = bd ? (col0 >> 8) * 256 : 0;
        const bf16_t* ap = A + (size_t)(row0 + r32) * lda + acol + kbeg + 8 * hi;
        const bf16_t* b0p = Wt + (size_t)(col0 + r32) * ldb + kbeg + 8 * hi; const bf16_t* b1p = b0p + (size_t)32 * ldb;
        f32x16 c0, c1;
#pragma unroll
        for (int r = 0; r < 16; ++r) { c0[r] = 0.f; c1[r] = 0.f; }
#pragma unroll 8
        for (int ks = 0; ks < kw; ks += 16) { const bf16x8 a = *(const bf16x8*)(ap + ks), b0 = *(const bf16x8*)(b0p + ks), b1 = *(const bf16x8*)(b1p + ks);
            c0 = __builtin_amdgcn_mfma_f32_32x32x16_bf16(a, b0, c0, 0, 0, 0); c1 = __builtin_amdgcn_mfma_f32_32x32x16_bf16(a, b1, c1, 0, 0, 0); }
        LAS float* red = (LAS float*)F.lds + F.wave * 2048 + hi * 256 + r32;
#pragma unroll
        for (int r = 0; r < 16; ++r) { red[CROW0(r) * 64] = c0[r]; red[CROW0(r) * 64 + 32] = c1[r]; }
        LDS_WAIT(); __syncthreads();
        { const int row = F.tid >> 4, c4 = (F.tid & 15) * 4; f32x4 sacc = (f32x4){0.f, 0.f, 0.f, 0.f};
#pragma unroll
          for (int w = 0; w < 8; ++w) sacc = sacc + *(const LAS f32x4*)((const LAS float*)F.lds + w * 2048 + row * 64 + c4);
          const int rs = row0 + row, col = col0 + c4, bb = NB + (rs >> 2);
          const f32x4 g4 = *(const f32x4*)(gate + (size_t)bb * 6144 + col);
          f32x4 x4;
          if constexpr (XF32) x4 = *(const f32x4*)(xin_s + (size_t)rs * D + col);
          else { const u32x2 xw = *(const u32x2*)(xout_s + (size_t)rs * D + col); x4 = (f32x4){__builtin_bit_cast(float, xw.x << 16), __builtin_bit_cast(float, xw.x & 0xffff0000u), __builtin_bit_cast(float, xw.y << 16), __builtin_bit_cast(float, xw.y & 0xffff0000u)}; }
          const f32x4 rr = x4 + g4 * sacc; u32x2 w; w.x = cvtpk(rr[0], rr[1]); w.y = cvtpk(rr[2], rr[3]); *(u32x2*)(xout_s + (size_t)rs * D + col) = w; }
        __syncthreads();
    }
}

template <int CTRL> __device__ __forceinline__ float dpp_add(float v) { return v + __uint_as_float((unsigned)__builtin_amdgcn_update_dpp(0, (int)__float_as_uint(v), CTRL, 0xF, 0xF, true)); }
__device__ __forceinline__ float wave_sum64(float v) {
    v = dpp_add<0xB1>(v); v = dpp_add<0x4E>(v); v = dpp_add<0x141>(v); v = dpp_add<0x140>(v);
    { auto rr = __builtin_amdgcn_permlane16_swap(__float_as_uint(v), __float_as_uint(v), false, false); v = __uint_as_float(rr[0]) + __uint_as_float(rr[1]); }
    { auto rr = __builtin_amdgcn_permlane32_swap(__float_as_uint(v), __float_as_uint(v), false, false); v = __uint_as_float(rr[0]) + __uint_as_float(rr[1]); }
    return v;
}
__device__ __forceinline__ f32x4 unpack_bf16x4(u32x2 w) { return (f32x4){__builtin_bit_cast(float, w.x << 16), __builtin_bit_cast(float, w.x & 0xffff0000u), __builtin_bit_cast(float, w.y << 16), __builtin_bit_cast(float, w.y & 0xffff0000u)}; }
template <int MODE, int NR>
__device__ __forceinline__ void norm_rows(Frame& F, bool from_inputs, int layer, int which, int row0, const f32x4 (&gg)[4], int lane) {
    f32x4 v[NR][4]; u32x2 xw[NR][4];
    if (from_inputs) {
        const float* xr = row0 < MP ? F.x_p + (size_t)row0 * D : F.x_s + (size_t)(row0 - MP) * D;
#pragma unroll
        for (int r = 0; r < NR; ++r)
#pragma unroll
            for (int j = 0; j < 4; ++j) v[r][j] = *(const f32x4*)(xr + (size_t)r * D + 4 * lane + 256 * j);
    } else {
        const bf16_t* xr = (const bf16_t*)(F.ws + WS_X) + (size_t)row0 * D;
#pragma unroll
        for (int r = 0; r < NR; ++r)
#pragma unroll
            for (int j = 0; j < 4; ++j) xw[r][j] = *(const u32x2*)(xr + (size_t)r * D + 4 * lane + 256 * j);
    }
#define NV(r, j) (from_inputs ? v[r][j] : unpack_bf16x4(xw[r][j]))
    f32x4 sh[4], sc[4];
    if constexpr (MODE != 2) {
        const int bb = row0 < MP ? (row0 >> 12) : NB + ((row0 - MP) >> 2);
        const float* mp = (const float*)(F.ws + WS_MOD) + ((size_t)layer * NMODB + bb) * 6144 + (which ? 3072 : 0);
#pragma unroll
        for (int j = 0; j < 4; ++j) { sh[j] = *(const f32x4*)(mp + 4 * lane + 256 * j); sc[j] = *(const f32x4*)(mp + 1024 + 4 * lane + 256 * j) + 1.0f; }
    }
    float ss[NR];
#pragma unroll
    for (int r = 0; r < NR; ++r) { float a = 0.f;
#pragma unroll
        for (int j = 0; j < 4; ++j) { const f32x4 x = NV(r, j); a += (x[0] * x[0] + x[1] * x[1]) + (x[2] * x[2] + x[3] * x[3]); }
        ss[r] = a; }
    if (!from_inputs) {
#pragma unroll
        for (int r = 0; r < NR; ++r)
#pragma unroll
            for (int j = 0; j < 4; ++j) asm volatile("" : "+v"(xw[r][j].x), "+v"(xw[r][j].y));
    }
#pragma unroll
    for (int r = 0; r < NR; ++r) ss[r] = wave_sum64(ss[r]);
#pragma unroll
    for (int r = 0; r < NR; ++r) {
        const int row = row0 + r; const float rstd = 1.0f / sqrtf(ss[r] * (1.0f / D) + 1e-6f);
        if constexpr (MODE == 2) {
            float* o = row < MP ? F.out + O_YP + (size_t)row * D : F.out + O_YS + (size_t)(row - MP) * D;
#pragma unroll
            for (int j = 0; j < 4; ++j) *(f32x4*)(o + 4 * lane + 256 * j) = NV(r, j) * rstd * gg[j];
        } else {
            float* pool_dst = nullptr;
            if constexpr (MODE == 1) {
                if (row < MP) { const int tt = row & (SEQ - 1); if (tt >= SEQ - 15) pool_dst = F.out + O_PLP + ((size_t)(row >> 12) * 15 + (tt - (SEQ - 15))) * D; }
                else { const int rs = row - MP; pool_dst = F.out + O_PLS + ((size_t)(rs >> 2) * 15 + 11 + (rs & 3)) * D; }
            }
#pragma unroll
            for (int j = 0; j < 4; ++j) { const int col = 4 * lane + 256 * j; const f32x4 h = (NV(r, j) * rstd * gg[j]) * sc[j] + sh[j];
                if constexpr (MODE == 0) { u32x2 w; w.x = cvtpk(h[0], h[1]); w.y = cvtpk(h[2], h[3]); *(u32x2*)((bf16_t*)(F.ws + WS_H) + (size_t)row * D + col) = w; }
                else { *(f32x4*)((float*)(F.ws + WS_HF) + (size_t)row * D + col) = h; if (pool_dst) *(f32x4*)(pool_dst + col) = h; } }
        }
    }
#undef NV
}
#ifndef NRX
#define NRX 4
#endif
template <int MODE>
__device__ __forceinline__ void norm_phase(Frame& F, bool from_inputs, int layer, int which) {
    const int gw = F.vcu * 8 + F.wave, NGW = F.G * 8, lane = lane_id();
    const float* gvec = MODE == 2 ? F.final_g : F.norm_g + (size_t)(layer * 2 + which) * D;
    f32x4 gg[4];
#pragma unroll
    for (int j = 0; j < 4; ++j) gg[j] = *(const f32x4*)(gvec + 4 * lane + 256 * j);
    if (from_inputs) {
#pragma unroll 1
        for (int grp = gw; grp < MP / 4; grp += NGW) norm_rows<MODE, 4>(F, true, layer, which, grp * 4, gg, lane);
    } else {
#pragma unroll 1
        for (int grp = gw; grp < MP / NRX; grp += NGW) norm_rows<MODE, NRX>(F, false, layer, which, grp * NRX, gg, lane);
    }
#pragma unroll 1
    for (int r = gw; r < MS; r += NGW) norm_rows<MODE, 1>(F, from_inputs, layer, which, MP + r, gg, lane);
}

template <int W, int R, bool SAMPLE>
__device__ __forceinline__ void pool_chunk(const float* HF, const float* st_pool, bf16_t* H, int row0, int col) {
    f32x4 v[R + W - 1];
    const int t0 = SAMPLE ? 0 : (row0 & (SEQ - 1));
#pragma unroll
    for (int k = 0; k < R + W - 1; ++k) { const int tt = t0 - (W - 1) + k;
        if (SAMPLE) { const int b = (row0 - MP) >> 2; v[k] = tt >= 0 ? *(const f32x4*)(HF + (size_t)(row0 + tt) * D + col) : *(const f32x4*)(st_pool + ((size_t)b * 15 + 15 + tt) * D + col); }
        else v[k] = tt >= 0 ? *(const f32x4*)(HF + (size_t)(row0 - (W - 1) + k) * D + col) : (f32x4){0.f, 0.f, 0.f, 0.f}; }
    f32x4 sacc = v[0];
#pragma unroll
    for (int k = 1; k < W; ++k) sacc = sacc + v[k];
#pragma unroll
    for (int r = 0; r < R; ++r) {
        if (r > 0) sacc = sacc + v[r + W - 1] - v[r - 1];
        const int tt = t0 + r; const float inv = 1.0f / (float)(SAMPLE ? W : (tt + 1 < W ? tt + 1 : W));
        const f32x4 cur = v[r + W - 1], pv = sacc * inv - cur;
        u32x2 w2; w2.x = cvtpk(pv[0], pv[1]); w2.y = cvtpk(pv[2], pv[3]); *(u32x2*)(H + (size_t)(row0 + r) * D + col) = w2; }
}
__device__ __forceinline__ void pool_phase(Frame& F) {
    const int gt = (F.vcu * 8 + F.wave) * 64 + lane_id(), NT = F.G * 512;
    const float* HF = (const float*)(F.ws + WS_HF); bf16_t* H = (bf16_t*)(F.ws + WS_H);
    constexpr int NPI = (MP / 8) * 256, NSI = (MS / 4) * 256;
#pragma unroll 1
    for (int i = gt; i < NPI + NSI; i += NT) {
        const bool smp = i >= NPI; const int q = smp ? i - NPI : i; const int cg = q & 255, col = cg * 4, grp = cg >> 6;
        if (!smp) { const int row0 = (q >> 8) * 8;
            if (grp == 0) pool_chunk<2, 8, false>(HF, F.st_pool, H, row0, col); else if (grp == 1) pool_chunk<4, 8, false>(HF, F.st_pool, H, row0, col);
            else if (grp == 2) pool_chunk<8, 8, false>(HF, F.st_pool, H, row0, col); else pool_chunk<16, 8, false>(HF, F.st_pool, H, row0, col); }
        else { const int row0 = MP + (q >> 8) * 4;
            if (grp == 0) pool_chunk<2, 4, true>(HF, F.st_pool, H, row0, col); else if (grp == 1) pool_chunk<4, 4, true>(HF, F.st_pool, H, row0, col);
            else if (grp == 2) pool_chunk<8, 4, true>(HF, F.st_pool, H, row0, col); else pool_chunk<16, 4, true>(HF, F.st_pool, H, row0, col); }
    }
}

namespace att {
__device__ __forceinline__ int crow(int r, int hi) { return (r & 3) + 8 * (r >> 2) + 4 * hi; }
__device__ __forceinline__ float x32_sum(float v) { auto rr = __builtin_amdgcn_permlane32_swap(__float_as_uint(v), __float_as_uint(v), false, false); return __uint_as_float(rr[0]) + __uint_as_float(rr[1]); }
__device__ __forceinline__ float x32_max(float v) { auto rr = __builtin_amdgcn_permlane32_swap(__float_as_uint(v), __float_as_uint(v), false, false); return fmaxf(__uint_as_float(rr[0]), __uint_as_float(rr[1])); }
__device__ __forceinline__ unsigned x32_or(unsigned v) { auto rr = __builtin_amdgcn_permlane32_swap(v, v, false, false); return rr[0] | rr[1]; }
template <int X> __device__ __forceinline__ unsigned swz_xor(unsigned v) { return (unsigned)__builtin_amdgcn_ds_swizzle((int)v, (X << 10) | 0x1F); }
template <int X> __device__ __forceinline__ float swz_xorf(float v) { return __uint_as_float(swz_xor<X>(__float_as_uint(v))); }
__device__ __forceinline__ s16x4 vtr(const LAS unsigned char* p) { typedef short v4i16_t __attribute__((ext_vector_type(4))); return __builtin_bit_cast(s16x4, __builtin_amdgcn_ds_read_tr16_b64_v4i16((LAS v4i16_t*)p)); }
__device__ __forceinline__ void qk_tile(f32x16& p0, f32x16& p1, const LAS unsigned char* Kb, const bf16x8 (&qr)[4], float init, int r32, int hi) {
    f32x16 ci;
#pragma unroll
    for (int r = 0; r < 16; ++r) ci[r] = init;
    const int sw = (r32 >> 1) & 7;
    bf16x8 ka[4], kb[4];
#pragma unroll
    for (int ds = 0; ds < 4; ++ds) { const int ch = ((2 * ds + hi) ^ sw) << 4; ka[ds] = *(const LAS bf16x8*)(Kb + r32 * 128 + ch); kb[ds] = *(const LAS bf16x8*)(Kb + (32 + r32) * 128 + ch); }
    __builtin_amdgcn_s_setprio(1);
    f32x16 c0 = __builtin_amdgcn_mfma_f32_32x32x16_bf16(ka[0], qr[0], ci, 0, 0, 0);
    f32x16 c1 = __builtin_amdgcn_mfma_f32_32x32x16_bf16(kb[0], qr[0], ci, 0, 0, 0);
#pragma unroll
    for (int ds = 1; ds < 4; ++ds) {
        c0 = __builtin_amdgcn_mfma_f32_32x32x16_bf16(ka[ds], qr[ds], c0, 0, 0, 0);
        c1 = __builtin_amdgcn_mfma_f32_32x32x16_bf16(kb[ds], qr[ds], c1, 0, 0, 0);
    }
    __builtin_amdgcn_s_setprio(0);
    p0 = c0; p1 = c1;
}
__device__ __forceinline__ void pv_tile(f32x16 (&o)[2], const LAS unsigned char* Vb, const f32x16& p0, const f32x16& p1, int lane) {
    const int g4 = lane >> 4, nhalf = g4 & 1, h = g4 >> 1, i = lane & 15, q = i >> 2, pp = i & 3;
    const LAS unsigned char* vb = Vb + (4 * h + q) * 64 + nhalf * 32 + pp * 8;
#pragma unroll
    for (int kh = 0; kh < 2; ++kh) {
        s16x4 lo[2][2], hh[2][2];
#pragma unroll
        for (int s = 0; s < 2; ++s)
#pragma unroll
            for (int db = 0; db < 2; ++db) { lo[s][db] = vtr(vb + db * 4096 + (32 * kh + 16 * s) * 64); hh[s][db] = vtr(vb + db * 4096 + (32 * kh + 16 * s + 8) * 64); }
#pragma unroll
        for (int s = 0; s < 2; ++s) {
            const f32x16& p = kh ? p1 : p0; u32x4 pw;
            pw.x = cvtpk(p[8 * s + 0], p[8 * s + 1]); pw.y = cvtpk(p[8 * s + 2], p[8 * s + 3]); pw.z = cvtpk(p[8 * s + 4], p[8 * s + 5]); pw.w = cvtpk(p[8 * s + 6], p[8 * s + 7]);
            const bf16x8 pa = __builtin_bit_cast(bf16x8, pw);
#pragma unroll
            for (int db = 0; db < 2; ++db) {
                const bf16x8 vf = (bf16x8){lo[s][db][0], lo[s][db][1], lo[s][db][2], lo[s][db][3], hh[s][db][0], hh[s][db][1], hh[s][db][2], hh[s][db][3]};
                o[db] = __builtin_amdgcn_mfma_f32_32x32x16_bf16(pa, vf, o[db], 0, 0, 0);
            }
        }
    }
}
__device__ __forceinline__ void row_scale(f32x16 (&o)[2], float f, LAS float* wsf, int r32, int hi) {
    if (hi == 0) wsf[r32] = f;
    LDS_WAIT();
    const LAS float* wh = wsf + 4 * hi;
#pragma unroll
    for (int r = 0; r < 16; ++r) { const float fr = wh[CROW0(r)]; o[0][r] *= fr; o[1][r] *= fr; }
    LDS_WAIT();
}
__device__ __forceinline__ void row_fma(f32x16 (&dst)[2], const f32x16 (&o)[2], float f, LAS float* wsf, int r32, int hi) {
    if (hi == 0) wsf[r32] = f;
    LDS_WAIT();
    const LAS float* wh = wsf + 4 * hi;
#pragma unroll
    for (int r = 0; r < 16; ++r) { const float fr = wh[CROW0(r)]; dst[0][r] += fr * o[0][r]; dst[1][r] += fr * o[1][r]; }
    LDS_WAIT();
}
__device__ __forceinline__ void softmax_update(f32x16& p0, f32x16& p1, float& m, float& l, f32x16 (&o)[2], LAS float* wsf, int r32, int hi) {
    float rm = fmaxf(p0[0], p1[0]);
#pragma unroll
    for (int r = 1; r < 16; ++r) rm = fmaxf(rm, fmaxf(p0[r], p1[r]));
    rm = x32_max(rm);
    const float mn = fmaxf(m, rm), f = ex2(m - mn);
    m = mn; float s = 0.f;
#pragma unroll
    for (int r = 0; r < 16; ++r) { p0[r] = ex2(p0[r] - mn); p1[r] = ex2(p1[r] - mn); s += p0[r] + p1[r]; }
    l = l * f + s;
    if (__any(f != 1.0f)) row_scale(o, f, wsf, r32, hi);
}
__device__ __forceinline__ void softmax_full(f32x16& a0, f32x16& a1, f32x16& b0, f32x16& b1) {
    float rm = -1e30f;
#pragma unroll
    for (int r = 0; r < 16; ++r) rm = fmaxf(rm, fmaxf(fmaxf(a0[r], a1[r]), fmaxf(b0[r], b1[r])));
    rm = x32_max(rm); float s = 0.f;
#pragma unroll
    for (int r = 0; r < 16; ++r) { a0[r] = ex2(a0[r] - rm); a1[r] = ex2(a1[r] - rm); b0[r] = ex2(b0[r] - rm); b1[r] = ex2(b1[r] - rm); s += (a0[r] + a1[r]) + (b0[r] + b1[r]); }
    s = x32_sum(s);
    const float inv = s > 0.f ? 1.0f / s : 0.f;
#pragma unroll
    for (int r = 0; r < 16; ++r) { a0[r] *= inv; a1[r] *= inv; b0[r] *= inv; b1[r] *= inv; }
}
__device__ __forceinline__ unsigned imp_key(float v, int j, int c) {
    const bool forced = (j == 0) | (j == c) | (j == c - 1);
    const unsigned base = forced ? 0x7F000000u : (j <= c ? (__float_as_uint(v) & 0xFFFFFFC0u) : 0u);
    return base | (unsigned)(63 - j);
}
__device__ __forceinline__ void imp_store(const f32x16& p0, const f32x16& p1, int T, LAS unsigned* impq  , int c, int g, int hi) {
#pragma unroll
    for (int kh = 0; kh < 2; ++kh)
#pragma unroll
        for (int a = 0; a < 4; ++a) {
            const f32x16& p = kh ? p1 : p0; float e0 = p[4 * a] + p[4 * a + 1], e1 = p[4 * a + 2] + p[4 * a + 3];
            e0 += swz_xorf<8>(e0); e0 += swz_xorf<16>(e0); e1 += swz_xorf<8>(e1); e1 += swz_xorf<16>(e1);
            const int jc = 32 * T + 16 * kh + 4 * a, j0 = jc + 2 * hi;
            if (g == 0) { u32x2 w; w.x = imp_key(e0, j0, c); w.y = imp_key(e1, j0 + 1, c); *(LAS u32x2*)(impq + 2 * hi + jc) = w; }
        }
}
__device__ __forceinline__ unsigned long long select_mask(const LAS unsigned* impq, int g, int hi, int nq4 = 16) {
    LDS_WAIT();
    unsigned mk[8], cnt[8];
#pragma unroll
    for (int a = 0; a < 4; ++a) { const u32x2 w = *(const LAS u32x2*)(impq + (16 * g + 2 * hi) + 4 * a); mk[2 * a] = w.x; mk[2 * a + 1] = w.y; cnt[2 * a] = 0; cnt[2 * a + 1] = 0; }
#pragma unroll 4
    for (int jj = 0; jj < nq4; ++jj) { const u32x4 kx = *(const LAS u32x4*)(impq + 4 * jj);
#pragma unroll
        for (int ci = 0; ci < 8; ++ci) cnt[ci] += (unsigned)(kx.x > mk[ci]) + (unsigned)(kx.y > mk[ci]) + (unsigned)(kx.z > mk[ci]) + (unsigned)(kx.w > mk[ci]); }
    unsigned lb = 0u;
#pragma unroll
    for (int a = 0; a < 4; ++a)
#pragma unroll
        for (int e = 0; e < 2; ++e) lb |= (cnt[2 * a + e] < 16u ? 1u : 0u) << (4 * a + e);
    const unsigned long long mm = (unsigned long long)lb << (16 * g + 2 * hi);
    unsigned lo = (unsigned)mm, hh = (unsigned)(mm >> 32);
    lo |= swz_xor<8>(lo); hh |= swz_xor<8>(hh); lo |= swz_xor<16>(lo); hh |= swz_xor<16>(hh); lo = x32_or(lo); hh = x32_or(hh);
    return ((unsigned long long)hh << 32) | lo;
}
__device__ __forceinline__ unsigned long long wave_or64(unsigned long long m) {
    unsigned lo = (unsigned)m, hh = (unsigned)(m >> 32);
    lo |= swz_xor<1>(lo); hh |= swz_xor<1>(hh); lo |= swz_xor<2>(lo); hh |= swz_xor<2>(hh); lo |= swz_xor<4>(lo); hh |= swz_xor<4>(hh);
    lo |= swz_xor<8>(lo); hh |= swz_xor<8>(hh); lo |= swz_xor<16>(lo); hh |= swz_xor<16>(hh); lo = x32_or(lo); hh = x32_or(hh);
    return ((unsigned long long)(unsigned)__builtin_amdgcn_readfirstlane(hh) << 32) | (unsigned)__builtin_amdgcn_readfirstlane(lo);
}
__device__ __forceinline__ void mask_bias(f32x16& p0, f32x16& p1, int t, int pos0, int stride, int wlim, bool sel, bool near, const LAS float* lut, int hi) {
#pragma unroll
    for (int kh = 0; kh < 2; ++kh)
#pragma unroll
        for (int r = 0; r < 16; ++r) { const int kk = 32 * kh + crow(r, hi), dist = t - pos0 - stride * kk; const bool ok = sel && dist >= 0 && dist < wlim;
            float bv = 0.f; if (near) { const int di = dist < 0 ? 0 : (dist > 127 ? 127 : dist); bv = lut[di]; }
            if (kh) p1[r] = ok ? p1[r] + bv : -INFINITY; else p0[r] = ok ? p0[r] + bv : -INFINITY; }
}
template <bool CAUSAL>
__device__ __forceinline__ void mask_bias_near(f32x16& p0, f32x16& p1, int t, int pos0, bool sel, const LAS float* xlg, int hi) {
    const int dist0 = t - pos0 - 4 * hi;
    const LAS float* bp = xlg + (dist0 + 4);
#pragma unroll
    for (int kh = 0; kh < 2; ++kh)
#pragma unroll
        for (int r = 0; r < 16; ++r) { const int kc = 32 * kh + CROW0(r); const float bv = bp[63 - kc]; bool ok = sel; if (CAUSAL) ok = ok && (dist0 - kc >= 0);
            if (kh) p1[r] = ok ? p1[r] + bv : -INFINITY; else p0[r] = ok ? p0[r] + bv : -INFINITY; }
}
struct Ptrs { const bf16_t *Q, *kcp, *vcp, *kcs, *vcs, *KS, *VS, *KW, *VW; const float* gates; bf16_t* O; const float *ck_sel, *cv_sel, *st_kw, *st_vw; const int* pt; int gov; float* kw_out; float* vw_out; };
#ifdef VERIFY
#define GATEV(P, row, head, br) ((P).gov < 0 ? sigmoidf_((P).gates[(size_t)(row) * 48 + (head) * 3 + (br)]) : ((P).gov == (br) ? 1.0f : 0.0f))
#else
#define GATEV(P, row, head, br) sigmoidf_((P).gates[(size_t)(row) * 48 + (head) * 3 + (br)])
#endif

template <bool ACC>
__device__ __forceinline__ void row_out(LAS float* ow, const f32x16 (&o)[2], float f, LAS float* wsf, int r32, int hi) {
    if (hi == 0) wsf[r32] = f;
    LDS_WAIT();
    const LAS float* wh = wsf + 4 * hi; LAS float* ob = ow + hi * 256 + r32;
#pragma unroll
    for (int r = 0; r < 16; ++r) { const float fr = wh[CROW0(r)]; LAS float* p = ob + CROW0(r) * 64;
        if (ACC) { p[0] += fr * o[0][r]; p[32] += fr * o[1][r]; } else { p[0] = fr * o[0][r]; p[32] = fr * o[1][r]; } }
    LDS_WAIT();
}
template <bool NEXT>
__device__ __forceinline__ void tile_block(f32x16& s0, f32x16& s1, f32x16& n0, f32x16& n1, const LAS unsigned char* KBn, float ninit, const LAS unsigned char* VB, const bf16x8 (&qr)[4],
                                           float m, float& l, f32x16 (&o)[2], int lane, int r32, int hi) {
    if (NEXT) qk_tile(n0, n1, KBn, qr, ninit, r32, hi);
    float sacc = 0.f;
#pragma unroll
    for (int r = 0; r < 16; ++r) { s0[r] = ex2(s0[r] - m); s1[r] = ex2(s1[r] - m); sacc += s0[r] + s1[r]; }
    l += sacc;
    pv_tile(o, VB, s0, s1, lane);
}
#define AS_SBAR() __builtin_amdgcn_sched_barrier(0)
#define AS_PIN(x) asm volatile("" : "+v"(x))
#define AS_MFMA(a, b, c) __builtin_amdgcn_mfma_f32_32x32x16_bf16(a, b, c, 0, 0, 0)
#define AS_WAIT_BAR(N) asm volatile("s_waitcnt vmcnt(" #N ") lgkmcnt(0)\n\ts_barrier" ::: "memory")
#define AS_MX3(a, b, c) __builtin_fmaxf(__builtin_fmaxf((a), (b)), (c))
__device__ __forceinline__ void as_glds16(const void* gsrc, unsigned lds_base) {
    unsigned sv; asm volatile("s_mov_b32 %0, m0\n\ts_mov_b32 m0, %2\n\ts_nop 0\n\tglobal_load_lds_dwordx4 %1, off\n\ts_mov_b32 m0, %0" : "=&s"(sv) : "v"(gsrc), "s"(lds_base) : "memory"); }
__device__ __forceinline__ void as_kload2(bf16x8* kf, const LAS unsigned char* kp, int d0) { kf[2 * d0] = *(const LAS bf16x8*)(kp + d0 * 2048); kf[2 * d0 + 1] = *(const LAS bf16x8*)(kp + d0 * 2048 + 512); }
__device__ __forceinline__ float as_rowmax(const f32x16& p0, const f32x16& p1) {
    float a = AS_MX3(p0[0], p0[1], p1[0]), b = AS_MX3(p0[2], p0[3], p1[1]); a = AS_MX3(a, p1[2], p1[3]);
#pragma unroll
    for (int r = 4; r < 16; r += 4) { a = AS_MX3(a, p0[r], p0[r + 1]); b = AS_MX3(b, p0[r + 2], p0[r + 3]); a = AS_MX3(a, p1[r], p1[r + 1]); b = AS_MX3(b, p1[r + 2], p1[r + 3]); }
    return x32_max(__builtin_fmaxf(a, b)); }
__device__ __forceinline__ float as_mask(f32x16& c0, f32x16& c1, int u, int nsel, int nwin, int c, int t, unsigned long long mymask, float bfar, const LAS float* xlg, const LAS float* lut, int hi) {
    if (u >= nsel + nwin) {
#pragma unroll
        for (int r = 0; r < 16; ++r) { c0[r] = -INFINITY; c1[r] = -INFINITY; }
        return 0.f; }
    const bool win = u >= nsel; const int j = win ? c - nwin + 1 + (u - nsel) : u;
    const bool sel = win || ((mymask >> j) & 1ull);
    if (j >= c - 2) { if (j == c) mask_bias_near<true>(c0, c1, t, 64 * j, sel, xlg, hi); else mask_bias_near<false>(c0, c1, t, 64 * j, sel, xlg, hi); return 0.f; }
    if (win) { if (j == c - 8) mask_bias(c0, c1, t, 64 * j, 1, 512, true, false, lut, hi); }
    else {
#pragma unroll
        for (int r = 0; r < 16; ++r) { c0[r] = sel ? c0[r] : -INFINITY; c1[r] = sel ? c1[r] : -INFINITY; } }
    return bfar;
}
__device__ __forceinline__ void attn_stream(const bf16_t* ksb, const bf16_t* vsb, const bf16_t* kwb, const bf16_t* vwb  , int nsel, int nwin, int NT, int c, int t,
                                            unsigned long long mymask, const bf16x8 (&qr)[4], float bfar, const LAS float* xlg, const LAS float* lut, float gate1, float gate2,
                                            LAS unsigned char* L, LAS float* wsf, LAS float* ow, int wave, int lane) {
    constexpr int SLOTB = 8192, LDS_K = 0, LDS_V = 3 * SLOTB;
    const int r32 = lane & 31, hi = lane >> 5;
    const unsigned lds0 = (unsigned)(unsigned long long)L;
    const int nreal = nsel + nwin;
    const unsigned klo = (unsigned)lane * 256 + wave * 8, vlo_ = (unsigned)(16 * (wave & 3) + (lane >> 2)) * 256 + (wave >> 2) * 32 + (lane & 3) * 8;
    const unsigned kdst = lds0 + LDS_K + wave * 1024, vdst = lds0 + LDS_V + wave * 1024;
#define AS_UT(u) ((u) < nreal ? (u) : nreal - 1)
#define AS_JB(u) (AS_UT(u) < nsel ? AS_UT(u) : c - nwin + 1 + (AS_UT(u) - nsel))
#define AS_DMA_K(u, slot) as_glds16((AS_UT(u) < nsel ? ksb : kwb) + klo + (size_t)AS_JB(u) * (64 * 256), (unsigned)__builtin_amdgcn_readfirstlane((int)(kdst + (slot))))
#define AS_DMA_V(u, slot) as_glds16((AS_UT(u) < nsel ? vsb : vwb) + vlo_ + (size_t)AS_JB(u) * (64 * 256), (unsigned)__builtin_amdgcn_readfirstlane((int)(vdst + (slot))))
    const LAS unsigned char* vp0 = L + LDS_V + ((lane >> 4) & 1) * 32 + (lane & 3) * 8 + (4 * hi + ((lane & 15) >> 2)) * 64;
    const LAS unsigned char* kp0 = L + LDS_K + hi * 1024 + r32 * 16;
    AS_DMA_K(0, 0); AS_DMA_V(0, 0); AS_DMA_K(1, SLOTB); AS_DMA_K(2, 2 * SLOTB);
    float mhat = 0.f, l_reg = 0.f, l_sel = 0.f; f32x16 o[2];
#pragma unroll
    for (int r = 0; r < 16; ++r) { o[0][r] = 0.f; o[1][r] = 0.f; }
    const f32x16 zero16 = {0.f, 0.f, 0.f, 0.f, 0.f, 0.f, 0.f, 0.f, 0.f, 0.f, 0.f, 0.f, 0.f, 0.f, 0.f, 0.f};
    bool resc = false, bnd = false;
    f32x16 pA0, pA1, pB0, pB1; bf16x8 kf[8]; s16x4 vlo[8], vhi[8]; u32x4 pw0, pw1, pw2, pw3;
    int sl_prev = 0, sl_cur = 0, sl_next = SLOTB;
#define AS_ROT() do { sl_prev = sl_cur; sl_cur = sl_next; sl_next = (sl_next == 2 * SLOTB) ? 0 : sl_next + SLOTB; } while (0)
#define AS_EX(v) __builtin_amdgcn_exp2f((v) + nmh)
#define AS_RESC() do { if (resc) { const LAS float* wh_ = wsf + 4 * hi; _Pragma("unroll") for (int d_ = 0; d_ < 2; ++d_) _Pragma("unroll") for (int r = 0; r < 16; ++r) o[d_][r] *= wh_[CROW0(r)]; } } while (0)
#define AS_BND() do { if (bnd) { const float lt_ = x32_sum(l_sel); row_out<true>(ow, o, lt_ > 0.f ? gate1 / lt_ : 0.f, wsf, r32, hi); _Pragma("unroll") for (int r = 0; r < 16; ++r) { o[0][r] = 0.f; o[1][r] = 0.f; } bnd = false; } } while (0)
    AS_WAIT_BAR(3);
#pragma unroll
    for (int d0 = 0; d0 < 4; ++d0) as_kload2(kf, kp0, d0);
    pA0 = AS_MFMA(kf[0], qr[0], zero16); pA1 = AS_MFMA(kf[1], qr[0], zero16); pA0 = AS_MFMA(kf[2], qr[1], pA0); pA1 = AS_MFMA(kf[3], qr[1], pA1);
    pA0 = AS_MFMA(kf[4], qr[2], pA0); pA1 = AS_MFMA(kf[5], qr[2], pA1); pA0 = AS_MFMA(kf[6], qr[3], pA0); pA1 = AS_MFMA(kf[7], qr[3], pA1);
    { const float bc = as_mask(pA0, pA1, 0, nsel, nwin, c, t, mymask, bfar, xlg, lut, hi);
      const float rm = as_rowmax(pA0, pA1) + bc; mhat = __builtin_fmaxf(rm, -60.f); const float nmh = bc - mhat;
#pragma unroll
      for (int r = 0; r < 16; ++r) { pA0[r] = AS_EX(pA0[r]); pA1[r] = AS_EX(pA1[r]); } }
    AS_WAIT_BAR(0);
    AS_DMA_K(3, 0); AS_DMA_V(1, SLOTB); AS_ROT();
#pragma unroll
    for (int d0 = 0; d0 < 4; ++d0) as_kload2(kf, kp0 + sl_cur, d0);
    AS_WAIT_BAR(2);
#define AS_PKW(P, i) cvtpk(P[i], P[i + 1])
#define AS_PAF(k) __builtin_bit_cast(bf16x8, pw##k)
#define AS_VFR(i) (bf16x8){vlo[i][0], vlo[i][1], vlo[i][2], vlo[i][3], vhi[i][0], vhi[i][1], vhi[i][2], vhi[i][3]}
#define AS_VRD(i) do { vlo[i] = vtr(vp_ + (((i) >> 2) * 4096 + ((i) & 3) * 1024)); vhi[i] = vtr(vp_ + (((i) >> 2) * 4096 + ((i) & 3) * 1024 + 512)); } while (0)
#define AS_KRD(G, d0) do { if (G) { as_kload2(kf, kp0 + sl_next, d0); AS_SBAR(); } } while (0)
#define AS_GAPA(MF, a0, a1, a2, a3, W0, W1, PW) do { MF; sacc += a0; sacc += a1; sacc += a2; sacc += a3; W0; W1; AS_PIN(PW); AS_PIN(sacc); AS_SBAR(); } while (0)
#define AS_GAPB(MF, X, i) do { MF; X[i] = AS_EX(X[i]); X[i + 1] = AS_EX(X[i + 1]); X[i + 2] = AS_EX(X[i + 2]); X[i + 3] = AS_EX(X[i + 3]); AS_PIN(X); AS_SBAR(); } while (0)
#define AS_STEP(C0, C1, P0, P1, tt, MASK, GK, GV, GL) do { AS_SBAR(); \
    const LAS unsigned char* vp_ = vp0 + sl_prev; \
    AS_VRD(0); AS_SBAR(); float sacc = P0[0] + P0[1]; \
                    AS_GAPA(C0 = AS_MFMA(kf[0], qr[0], zero16), P0[2], P0[3], P0[4], P0[5],     pw0[0] = AS_PKW(P0, 0),  pw0[1] = AS_PKW(P0, 2),  pw0); \
    AS_VRD(4); AS_SBAR(); AS_GAPA(C1 = AS_MFMA(kf[1], qr[0], zero16), P0[6], P0[7], P0[8], P0[9],     pw0[2] = AS_PKW(P0, 4),  pw0[3] = AS_PKW(P0, 6),  pw0); \
    AS_VRD(1); AS_SBAR(); AS_GAPA(C0 = AS_MFMA(kf[2], qr[1], C0),    P0[10], P0[11], P0[12], P0[13], pw1[0] = AS_PKW(P0, 8),  pw1[1] = AS_PKW(P0, 10), pw1); \
    AS_VRD(5); AS_SBAR(); AS_GAPA(C1 = AS_MFMA(kf[3], qr[1], C1),    P0[14], P0[15], P1[0], P1[1],   pw1[2] = AS_PKW(P0, 12), pw1[3] = AS_PKW(P0, 14), pw1); \
    AS_VRD(2); AS_SBAR(); AS_GAPA(C0 = AS_MFMA(kf[4], qr[2], C0),    P1[2], P1[3], P1[4], P1[5],     pw2[0] = AS_PKW(P1, 0),  pw2[1] = AS_PKW(P1, 2),  pw2); \
    AS_VRD(6); AS_SBAR(); AS_GAPA(C1 = AS_MFMA(kf[5], qr[2], C1),    P1[6], P1[7], P1[8], P1[9],     pw2[2] = AS_PKW(P1, 4),  pw2[3] = AS_PKW(P1, 6),  pw2); \
    AS_VRD(3); AS_SBAR(); AS_GAPA(C0 = AS_MFMA(kf[6], qr[3], C0),    P1[10], P1[11], P1[12], P1[13], pw3[0] = AS_PKW(P1, 8),  pw3[1] = AS_PKW(P1, 10), pw3); \
    AS_VRD(7); AS_SBAR(); AS_GAPA(C1 = AS_MFMA(kf[7], qr[3], C1),    P1[14], P1[15], 0.f, 0.f,       pw3[2] = AS_PKW(P1, 12), pw3[3] = AS_PKW(P1, 14), pw3); \
    l_reg += sacc; \
    if (GK) AS_DMA_K((tt) + 3, sl_cur); if (GV) AS_DMA_V((tt) + 1, sl_next); \
    float bc_ = bfar; bool sel_ = true; \
    if (MASK) bc_ = as_mask(C0, C1, (tt), nsel, nwin, c, t, mymask, bfar, xlg, lut, hi); \
    else sel_ = (mymask >> (tt)) & 1ull;                             \
    if (MASK && (tt) == nsel) { l_sel = l_reg; l_reg = 0.f; mhat = __builtin_fmaxf(as_rowmax(C0, C1) + bc_, -60.f); resc = false; bnd = true; }     \
    else { const float rm = as_rowmax(C0, C1) + bc_ - mhat; resc = false; \
      if (__builtin_expect(__any(rm > 8.0f), 0)) { const float dl = __builtin_fmaxf(rm, 0.f); mhat += dl; \
          const float f = __builtin_amdgcn_exp2f(-dl); l_reg *= f; if (hi == 0) wsf[r32] = f; resc = true; } } \
    const float nmh = sel_ ? bc_ - mhat : -INFINITY; AS_SBAR(); \
    AS_GAPB(o[0] = AS_MFMA(AS_PAF(0), AS_VFR(0), o[0]), C0, 0);              AS_GAPB(o[1] = AS_MFMA(AS_PAF(0), AS_VFR(4), o[1]), C0, 4); \
    AS_KRD(GL, 0); AS_GAPB(o[0] = AS_MFMA(AS_PAF(1), AS_VFR(1), o[0]), C0, 8);  AS_KRD(GL, 1); AS_GAPB(o[1] = AS_MFMA(AS_PAF(1), AS_VFR(5), o[1]), C0, 12); \
    AS_KRD(GL, 2); AS_GAPB(o[0] = AS_MFMA(AS_PAF(2), AS_VFR(2), o[0]), C1, 0);  AS_KRD(GL, 3); AS_GAPB(o[1] = AS_MFMA(AS_PAF(2), AS_VFR(6), o[1]), C1, 4); \
    AS_GAPB(o[0] = AS_MFMA(AS_PAF(3), AS_VFR(3), o[0]), C1, 8);              AS_GAPB(o[1] = AS_MFMA(AS_PAF(3), AS_VFR(7), o[1]), C1, 12); \
    } while (0)
    int tt = 1;
    for (; tt + 1 < nsel - 3; tt += 2) {
        AS_STEP(pB0, pB1, pA0, pA1, tt, false, true, true, true);     AS_WAIT_BAR(2); AS_RESC(); AS_ROT();
        AS_STEP(pA0, pA1, pB0, pB1, tt + 1, false, true, true, true); AS_WAIT_BAR(2); AS_RESC(); AS_ROT();
    }
#define AS_ENDW(x) do { if ((x) + 3 < NT) { AS_WAIT_BAR(2); } else if ((x) + 2 < NT) { AS_WAIT_BAR(1); } else { AS_WAIT_BAR(0); } } while (0)
    for (; tt + 1 < NT; tt += 2) {
        AS_STEP(pB0, pB1, pA0, pA1, tt, true, (tt + 3 < NT), (tt + 1 < NT), (tt + 1 < NT));         AS_ENDW(tt);     AS_RESC(); AS_BND(); AS_ROT();
        AS_STEP(pA0, pA1, pB0, pB1, tt + 1, true, (tt + 4 < NT), (tt + 2 < NT), (tt + 2 < NT));     AS_ENDW(tt + 1); AS_RESC(); AS_BND(); AS_ROT();
    }
    AS_STEP(pB0, pB1, pA0, pA1, NT - 1, true, false, false, false); AS_RESC(); AS_BND();
    { float sacc = pB0[0] + pB0[1];
#pragma unroll
      for (int r = 2; r < 16; ++r) sacc += pB0[r];
#pragma unroll
      for (int r = 0; r < 16; ++r) sacc += pB1[r];
      l_reg += sacc;
      pw0 = (u32x4){AS_PKW(pB0, 0), AS_PKW(pB0, 2), AS_PKW(pB0, 4), AS_PKW(pB0, 6)}; pw1 = (u32x4){AS_PKW(pB0, 8), AS_PKW(pB0, 10), AS_PKW(pB0, 12), AS_PKW(pB0, 14)};
      pw2 = (u32x4){AS_PKW(pB1, 0), AS_PKW(pB1, 2), AS_PKW(pB1, 4), AS_PKW(pB1, 6)}; pw3 = (u32x4){AS_PKW(pB1, 8), AS_PKW(pB1, 10), AS_PKW(pB1, 12), AS_PKW(pB1, 14)};
      const LAS unsigned char* vp_ = vp0 + sl_cur;
#pragma unroll
      for (int i = 0; i < 8; ++i) AS_VRD(i);
      o[0] = AS_MFMA(AS_PAF(0), AS_VFR(0), o[0]); o[1] = AS_MFMA(AS_PAF(0), AS_VFR(4), o[1]); o[0] = AS_MFMA(AS_PAF(1), AS_VFR(1), o[0]); o[1] = AS_MFMA(AS_PAF(1), AS_VFR(5), o[1]);
      o[0] = AS_MFMA(AS_PAF(2), AS_VFR(2), o[0]); o[1] = AS_MFMA(AS_PAF(2), AS_VFR(6), o[1]); o[0] = AS_MFMA(AS_PAF(3), AS_VFR(3), o[0]); o[1] = AS_MFMA(AS_PAF(3), AS_VFR(7), o[1]); }
    { const float lt = x32_sum(l_reg); const float f = lt > 0.f ? gate2 / lt : 0.f; row_out<true>(ow, o, f, wsf, r32, hi); }
    asm volatile("s_waitcnt lgkmcnt(0)\n\ts_barrier" ::: "memory");
#undef AS_UT
#undef AS_JB
#undef AS_DMA_K
#undef AS_DMA_V
#undef AS_ROT
#undef AS_EX
#undef AS_RESC
#undef AS_BND
#undef AS_PKW
#undef AS_PAF
#undef AS_VFR
#undef AS_VRD
#undef AS_KRD
#undef AS_GAPA
#undef AS_GAPB
#undef AS_STEP
#undef AS_ENDW
}

__device__ __forceinline__ void prompt_unit(const Ptrs& P, LAS unsigned char* L, int b, int kv, int c, int tid, int wave, int lane) {
    asm volatile("" : "+v"(lane), "+v"(tid));
    const int r32 = lane & 31, hi = lane >> 5, g = r32 >> 3, qi = r32 & 7, head = kv * 4 + g;
    const int t = c * 64 + wave * 8 + qi; const unsigned row = (unsigned)b * SEQ + t;
    bf16x8 qr[4];
#pragma unroll
    for (int ds = 0; ds < 4; ++ds) qr[ds] = *(const bf16x8*)(P.Q + (size_t)row * D + head * 64 + ds * 16 + hi * 8);
    const LAS float* lut = (const LAS float*)(L + LUT_OFF) + head * 128; const float bfar = lut[127];
    LAS float* wsf = (LAS float*)(L + WSF_OFF) + wave * 32;
    LAS float* ow = (LAS float*)(L + 65536 + wave * 8192);
    LAS unsigned* impq = (LAS unsigned*)(L + IMP_OFF) + wave * 512 + qi * 64;
    const int skey = tid >> 3, sch = tid & 7;
    const int kwoff = skey * 128 + ((sch ^ ((skey >> 1) & 7)) << 4), vwoff = (sch >> 2) * 4096 + skey * 64 + (sch & 3) * 16;
    LAS unsigned char* KB0 = L; LAS unsigned char* VB0 = L + 32768;
    { const unsigned co = ((unsigned)(b * 4 + kv) * 128 + skey) * 64 + sch * 8;
      const u32x4 k0 = *(const u32x4*)(P.kcp + co), k1 = *(const u32x4*)(P.kcp + co + 4096), v0 = *(const u32x4*)(P.vcp + co), v1 = *(const u32x4*)(P.vcp + co + 4096);
      *(LAS u32x4*)(KB0 + kwoff) = k0; *(LAS u32x4*)(KB0 + 8192 + kwoff) = k1; *(LAS u32x4*)(VB0 + vwoff) = v0; *(LAS u32x4*)(VB0 + 8192 + vwoff) = v1; }
    const int nwin = (c < 8 ? c : 8) + 1;
    __syncthreads();
    f32x16 o[2];
#pragma unroll
    for (int r = 0; r < 16; ++r) { o[0][r] = 0.f; o[1][r] = 0.f; }
    unsigned long long mymask = ~0ull;
    if (c <= 30) {
        f32x16 a0, a1; qk_tile(a0, a1, KB0, qr, 0.f, r32, hi); mask_bias(a0, a1, t, 31, 32, 1 << 30, true, true, lut, hi);
        float rm = fmaxf(a0[0], a1[0]);
#pragma unroll
        for (int r = 1; r < 16; ++r) rm = fmaxf(rm, fmaxf(a0[r], a1[r]));
        rm = fmaxf(x32_max(rm), -1e30f); float sacc = 0.f;
#pragma unroll
        for (int r = 0; r < 16; ++r) { a0[r] = ex2(a0[r] - rm); a1[r] = ex2(a1[r] - rm); sacc += a0[r] + a1[r]; }
        sacc = x32_sum(sacc); const float cinv = sacc > 0.f ? 1.0f / sacc : 0.f;
#pragma unroll
        for (int r = 0; r < 16; ++r) { a0[r] *= cinv; a1[r] *= cinv; }
        if (c >= 16) { imp_store(a0, a1, 0, impq, c, g, hi);
            if (g == 0) {
#pragma unroll
                for (int q8 = 0; q8 < 8; ++q8) { const int jc = 32 + 4 * q8; u32x2 w; w.x = imp_key(0.f, jc + 2 * hi, c); w.y = imp_key(0.f, jc + 2 * hi + 1, c); *(LAS u32x2*)(impq + 2 * hi + jc) = w; } } }
        pv_tile(o, VB0, a0, a1, lane);
    } else {
        f32x16 a0, a1, b0, b1;
        qk_tile(a0, a1, KB0, qr, 0.f, r32, hi); mask_bias(a0, a1, t, 31, 32, 1 << 30, true, true, lut, hi);
        qk_tile(b0, b1, KB0 + 8192, qr, 0.f, r32, hi); mask_bias(b0, b1, t, 31 + 2048, 32, 1 << 30, true, true, lut, hi);
        float rm = fmaxf(fmaxf(a0[0], a1[0]), fmaxf(b0[0], b1[0]));
#pragma unroll
        for (int r = 1; r < 16; ++r) rm = fmaxf(rm, fmaxf(fmaxf(a0[r], a1[r]), fmaxf(b0[r], b1[r])));
        rm = fmaxf(x32_max(rm), -1e30f); float sacc = 0.f;
#pragma unroll
        for (int r = 0; r < 16; ++r) { a0[r] = ex2(a0[r] - rm); a1[r] = ex2(a1[r] - rm); b0[r] = ex2(b0[r] - rm); b1[r] = ex2(b1[r] - rm); sacc += (a0[r] + a1[r]) + (b0[r] + b1[r]); }
        sacc = x32_sum(sacc); const float cinv = sacc > 0.f ? 1.0f / sacc : 0.f;
#pragma unroll
        for (int r = 0; r < 16; ++r) { a0[r] *= cinv; a1[r] *= cinv; b0[r] *= cinv; b1[r] *= cinv; }
        imp_store(a0, a1, 0, impq, c, g, hi); imp_store(b0, b1, 1, impq, c, g, hi);
        pv_tile(o, VB0, a0, a1, lane); pv_tile(o, VB0 + 8192, b0, b1, lane);
    }
    { const float g0 = GATEV(P, row, head, 0); row_out<false>(ow, o, g0, wsf, r32, hi); }
    if (c >= 16) mymask = select_mask(impq, g, hi, (c + 4) >> 2);
    __syncthreads();
    { LAS float* xl = (LAS float*)(L + IMP_OFF);
      for (int u = tid; u < 4 * 272; u += 512) { const int gg = u / 272, ii = u % 272, dd = ii - 67; xl[u] = ((const LAS float*)(L + LUT_OFF))[(kv * 4 + gg) * 128 + (dd < 0 ? 0 : (dd > 127 ? 127 : dd))]; } }
    const LAS float* xlg = (const LAS float*)(L + IMP_OFF) + g * 272;
    { const size_t kvb = ((size_t)b * SEQ) * 256 + kv * 64; const int nsel = c + 1; int NT = (nsel + nwin + 1) & ~1; if (NT < 4) NT = 4;
      attn_stream(P.KS + kvb, P.VS + kvb, P.KW + kvb, P.VW + kvb, nsel, nwin, NT, c, t, mymask, qr, bfar, xlg, lut, GATEV(P, row, head, 1), GATEV(P, row, head, 2), L, wsf, ow, wave, lane); }
    { const int rr = lane >> 1, hf = lane & 1, gg = rr >> 3, qq = rr & 7; const LAS float* src = ow + rr * 64 + hf * 32;
      bf16_t* op = P.O + ((size_t)b * SEQ + c * 64 + wave * 8 + qq) * D + (kv * 4 + gg) * 64 + hf * 32;
#pragma unroll
      for (int q4 = 0; q4 < 4; ++q4) { const f32x4 x0 = *(const LAS f32x4*)(src + q4 * 8), x1 = *(const LAS f32x4*)(src + q4 * 8 + 4); u32x4 w;
          w.x = cvtpk(x0[0], x0[1]); w.y = cvtpk(x0[2], x0[3]); w.z = cvtpk(x1[0], x1[1]); w.w = cvtpk(x1[2], x1[3]); *(u32x4*)(op + q4 * 8) = w; } }
    __syncthreads();
}

template <bool COPY>
__device__ __forceinline__ void stage_f32_pair(const float* ksrc_, const float* vsrc_, LAS unsigned char* Kb, LAS unsigned char* Vb, int lane, float* kdst_ = nullptr, float* vdst_ = nullptr, int first_row = 0) {
    const int c4 = lane & 15; const char* ks = uniform_ptr(ksrc_); const char* vs = uniform_ptr(vsrc_); const unsigned lo = (unsigned)((lane >> 4) * 1024 + c4 * 16);
#pragma unroll 1
    for (int hf = 0; hf < 2; ++hf) {
        f32x4 x[8], y[8];
#pragma unroll
        for (int it = 0; it < 8; ++it) x[it] = *(const f32x4*)(ks + (lo + (unsigned)(hf * 8 + it) * 4096u));
#pragma unroll
        for (int it = 0; it < 8; ++it) y[it] = *(const f32x4*)(vs + (lo + (unsigned)(hf * 8 + it) * 4096u));
        if constexpr (COPY) {
            char* kd = (char*)uniform_ptr(kdst_); char* vd = (char*)uniform_ptr(vdst_);
#pragma unroll
            for (int it = 0; it < 8; ++it) { const int key = (hf * 8 + it) * 4 + (lane >> 4);
                if (key >= first_row) { __builtin_nontemporal_store(x[it], (f32x4*)(kd + (lo + (unsigned)(hf * 8 + it) * 4096u))); __builtin_nontemporal_store(y[it], (f32x4*)(vd + (lo + (unsigned)(hf * 8 + it) * 4096u))); } }
        }
#pragma unroll
        for (int it = 0; it < 8; ++it) { const int key = (hf * 8 + it) * 4 + (lane >> 4);
            u32x2 w; w.x = cvtpk(x[it][0], x[it][1]); w.y = cvtpk(x[it][2], x[it][3]);
            *(LAS u32x2*)(Kb + key * 128 + (((c4 >> 1) ^ ((key >> 1) & 7)) << 4) + (c4 & 1) * 8) = w; }
#pragma unroll
        for (int it = 0; it < 8; ++it) { const int key = (hf * 8 + it) * 4 + (lane >> 4);
            u32x2 w; w.x = cvtpk(y[it][0], y[it][1]); w.y = cvtpk(y[it][2], y[it][3]);
            *(LAS u32x2*)(Vb + (c4 >> 3) * 4096 + key * 64 + (c4 & 7) * 8) = w; }
        __builtin_amdgcn_sched_barrier(0);
    }
}
__device__ __forceinline__ void stage_bf16_tile(const bf16_t* src_  , LAS unsigned char* Kb, bool isV, int lane) {
    const char* src = uniform_ptr(src_);
#pragma unroll
    for (int it = 0; it < 8; ++it) { const int idx = it * 64 + lane, key = idx >> 3, ch = idx & 7; const u32x4 x = *(const u32x4*)(src + (unsigned)idx * 16u);
        const int off = isV ? ((ch >> 2) * 4096 + key * 64 + (ch & 3) * 16) : (key * 128 + ((ch ^ ((key >> 1) & 7)) << 4));
        *(LAS u32x4*)(Kb + off) = x; }
}
__device__ __forceinline__ void stage_new_tile(const bf16_t* src_  , LAS unsigned char* Kb, bool isV, int lane) {
    const char* src = uniform_ptr(src_);
#pragma unroll
    for (int it = 0; it < 8; ++it) *(LAS u32x4*)(Kb + (it * 64 + lane) * 16) = (u32x4){0u, 0u, 0u, 0u};
    if (lane < 32) { const int key = lane >> 3, ch = lane & 7; const u32x4 x = *(const u32x4*)(src + (unsigned)(key * 512 + ch * 16));
        const int off = isV ? ((ch >> 2) * 4096 + key * 64 + (ch & 3) * 16) : (key * 128 + ((ch ^ ((key >> 1) & 7)) << 4));
        *(LAS u32x4*)(Kb + off) = x; }
}
__device__ __forceinline__ void sample_unit(const Ptrs& P, LAS unsigned char* L, int uA, int uB, int tid, int wave, int lane) {
    asm volatile("" : "+v"(lane), "+v"(tid));
    const int half = wave >> 2, lw = wave & 3, usel = half ? uB : uA, b = usel >> 2, kv = usel & 3;
    const int r32 = lane & 31, hi = lane >> 5, g = r32 >> 3, qi = r32 & 7, qs = qi & 3, head = kv * 4 + g;
    const int t = PAST + qs; const unsigned row = (unsigned)MP + b * 4 + qs;
    bf16x8 qr[4];
#pragma unroll
    for (int ds = 0; ds < 4; ++ds) qr[ds] = *(const bf16x8*)(P.Q + (size_t)row * D + head * 64 + ds * 16 + hi * 8);
    const LAS float* lut = (const LAS float*)(L + LUT_OFF) + head * 128; const float bfar = lut[127];
    LAS float* wsf = (LAS float*)(L + WSF_OFF) + wave * 32;
    LAS unsigned* impq = (LAS unsigned*)(L + IMP_OFF) + wave * 512 + qi * 64;
    LAS unsigned char* Kb = L + wave * 16384; LAS unsigned char* Vb = Kb + 8192;
    f32x16 out[2], o[2];
#pragma unroll
    for (int r = 0; r < 16; ++r) { out[0][r] = 0.f; out[1][r] = 0.f; o[0][r] = 0.f; o[1][r] = 0.f; }
    stage_bf16_tile(P.kcs + (size_t)(b * 4 + kv) * 4096, Kb, false, lane); stage_bf16_tile(P.vcs + (size_t)(b * 4 + kv) * 4096, Vb, true, lane);
    LDS_WAIT();
    {
        f32x16 a0, a1;
        qk_tile(a0, a1, Kb, qr, 0.f, r32, hi);
        mask_bias(a0, a1, t, 31, 32, 1 << 30, true, true, lut, hi);
        { float rm = fmaxf(a0[0], a1[0]);
#pragma unroll
          for (int r = 1; r < 16; ++r) rm = fmaxf(rm, fmaxf(a0[r], a1[r]));
          rm = x32_max(rm); float sacc = 0.f;
#pragma unroll
          for (int r = 0; r < 16; ++r) { a0[r] = ex2(a0[r] - rm); a1[r] = ex2(a1[r] - rm); sacc += a0[r] + a1[r]; }
          sacc = x32_sum(sacc); const float cinv = 1.0f / sacc;
#pragma unroll
          for (int r = 0; r < 16; ++r) { a0[r] *= cinv; a1[r] *= cinv; } }
        imp_store(a0, a1, 0, impq, 32, g, hi);
        if (g == 0) {
#pragma unroll
            for (int q8 = 0; q8 < 8; ++q8) { const int jc = 32 + 4 * q8; u32x2 w; w.x = imp_key(0.f, jc + 2 * hi, 32); w.y = imp_key(0.f, jc + 2 * hi + 1, 32); *(LAS u32x2*)(impq + 2 * hi + jc) = w; } }
        if (lw == 0) { pv_tile(o, Vb, a0, a1, lane); const float g0 = GATEV(P, row, head, 0); row_fma(out, o, g0, wsf, r32, hi);
#pragma unroll
            for (int r = 0; r < 16; ++r) { o[0][r] = 0.f; o[1][r] = 0.f; } }
    }
    const unsigned long long mymask = select_mask(impq, g, hi);
    const unsigned long long umask = wave_or64(mymask) & 0x1FFFFFFFFull;
    const bool winw = lw == 3;
    const int nsel = __builtin_popcountll(umask);
    const int nmine = winw ? 9 : nsel, first = winw ? 0 : lw, step = winw ? 1 : 3;
    float m = -1e30f, l = 0.f;
#pragma unroll 1
    for (int idx = first; idx < nmine; idx += step) {
        LDS_WAIT();
        int pos0; bool near, sel = true;
        int ln = lane; asm volatile("" : "+v"(ln));
        if (!winw) {
            unsigned long long mm = umask; for (int n = 0; n < idx; ++n) mm &= mm - 1ull;
            const int j = __builtin_ctzll(mm);
            if (j < 32) { const int page = P.pt[b * 16 + (j >> 1)]; const size_t off = (((size_t)page * 128 + (j & 1) * 64) * 4 + kv) * 64;
                stage_f32_pair<false>(P.ck_sel + off, P.cv_sel + off, Kb, Vb, ln); }
            else { stage_new_tile(P.KS + ((size_t)MP + b * 4) * 256 + kv * 64, Kb, false, ln); stage_new_tile(P.VS + ((size_t)MP + b * 4) * 256 + kv * 64, Vb, true, ln); }
            pos0 = 64 * j; near = j >= 30; sel = (mymask >> j) & 1ull;
        } else {
            if (idx < 8) { const size_t off = (((size_t)b * 512 + 64 * idx) * 4 + kv) * 64;
                stage_f32_pair<true>(P.st_kw + off, P.st_vw + off, Kb, Vb, ln, P.kw_out + off - 1024, P.vw_out + off - 1024, idx == 0 ? 4 : 0); }
            else { stage_new_tile(P.KW + ((size_t)MP + b * 4) * 256 + kv * 64, Kb, false, ln); stage_new_tile(P.VW + ((size_t)MP + b * 4) * 256 + kv * 64, Vb, true, ln); }
            pos0 = PAST - 512 + 64 * idx; near = idx >= 6;
        }
        LDS_WAIT();
        f32x16 p0, p1;
        qk_tile(p0, p1, Kb, qr, near ? 0.f : bfar, r32, hi);
        mask_bias(p0, p1, t, pos0, 1, winw ? 512 : (1 << 30), sel, near, lut, hi);
        softmax_update(p0, p1, m, l, o, wsf, r32, hi);
        pv_tile(o, Vb, p0, p1, lane);
    }
    LDS_WAIT();
    { const float lt = x32_sum(l);
      LAS f32x2* ml = (LAS f32x2*)(L + IMP_OFF);
      if (hi == 0) ml[wave * 256 + r32] = (f32x2){m, lt};
      __syncthreads();
      const int w0 = half * 4 + (winw ? 3 : 0), w1 = half * 4 + (winw ? 4 : 3);
      float M = -1e30f;
      for (int w = w0; w < w1; ++w) M = fmaxf(M, ml[w * 256 + r32][0]);
      float Ls = 0.f;
      for (int w = w0; w < w1; ++w) { const f32x2 x = ml[w * 256 + r32]; Ls += x[1] * ex2(x[0] - M); }
      const float gt = GATEV(P, row, head, (winw ? 2 : 1));
      const float f = Ls > 0.f ? gt * ex2(m - M) / Ls : 0.f;
      row_fma(out, o, f, wsf, r32, hi); }
    LAS float* ob = (LAS float*)Kb + hi * 256 + r32;
#pragma unroll
    for (int r = 0; r < 16; ++r) { ob[CROW0(r) * 64] = out[0][r]; ob[CROW0(r) * 64 + 32] = out[1][r]; }
    __syncthreads();
    { const int hs = tid >> 8, vr = (tid >> 4) & 15, d4 = (tid & 15) * 4, gg = vr >> 2, qq = vr & 3, uo = hs ? uB : uA; f32x4 sacc = (f32x4){0.f, 0.f, 0.f, 0.f};
#pragma unroll
      for (int w = 0; w < 4; ++w) sacc = sacc + *(const LAS f32x4*)((const LAS float*)(L + (hs * 4 + w) * 16384) + (gg * 8 + qq) * 64 + d4);
      u32x2 w2; w2.x = cvtpk(sacc[0], sacc[1]); w2.y = cvtpk(sacc[2], sacc[3]);
      *(u32x2*)(P.O + ((size_t)MP + (uo >> 2) * 4 + qq) * D + ((uo & 3) * 4 + gg) * 64 + d4) = w2; }
    __syncthreads();
}

#ifdef VERIFY
__device__ __forceinline__ float wsum(float v) { for (int o = 1; o < 64; o <<= 1) v += __shfl_xor(v, o); return v; }
__device__ __forceinline__ float wmax(float v) { for (int o = 1; o < 64; o <<= 1) v = fmaxf(v, __shfl_xor(v, o)); return v; }
__device__ __forceinline__ float rb(float x) { return bf2f((unsigned short)(cvtpk(x, 0.f) & 0xffffu)); }
__device__ __forceinline__ void verify_item(const Ptrs& P, LAS unsigned char* L, bool sample, int b, int tq, int kv, int br, float* errs, int wave, int lane) {
    LAS float* sc = (LAS float*)(L + wave * 16384);
    LAS float* qs = (LAS float*)(L + IMP_OFF) + wave * 512;
    const LAS float* lutb = (const LAS float*)(L + LUT_OFF);
    const size_t row = sample ? (size_t)MP + b * 4 + tq : (size_t)b * SEQ + tq; const int pos = sample ? PAST + tq : tq; const int cq = pos >> 6;
    for (int g = 0; g < 4; ++g) qs[g * 64 + lane] = bf2f(P.Q[row * D + (kv * 4 + g) * 64 + lane]);
    LDS_WAIT();
    const int ncmp = sample ? 64 : 128; const size_t cmpo = (size_t)(b * 4 + kv) * (sample ? 4096 : 8192); const bf16_t* kc = (const bf16_t*)((const char*)P.kcp + (sample ? WS_KCMPS - WS_KCMPP : 0)) + cmpo; const bf16_t* vc = (const bf16_t*)((const char*)P.vcp + (sample ? WS_VCMPS - WS_VCMPP : 0)) + cmpo;
    float oc0 = 0.f, oc1 = 0.f, oc2 = 0.f, oc3 = 0.f;
    for (int g = 0; g < 4; ++g) {
        float sA = -INFINITY, sB = -INFINITY;
        for (int h = 0; h < 2; ++h) { const int n = lane + 64 * h; const int dist = pos - (32 * n + 31); float s = -INFINITY;
            if (n < ncmp && dist >= 0) { float a = 0.f; for (int d = 0; d < 64; ++d) a += qs[g * 64 + d] * bf2f(kc[(size_t)n * 64 + d]); s = a + lutb[(kv * 4 + g) * 128 + (dist > 127 ? 127 : dist)]; }
            if (h == 0) sA = s; else sB = s; }
        const float mx = wmax(fmaxf(sA, sB)); float p0 = 0.f, p1 = 0.f;
        if (mx > -INFINITY) { p0 = ex2(sA - mx); p1 = ex2(sB - mx); }
        const float sm = wsum(p0 + p1); const float inv = sm > 0.f ? 1.0f / sm : 0.f;
        sc[g * 128 + lane] = p0 * inv; sc[g * 128 + 64 + lane] = p1 * inv;
    }
    LDS_WAIT();
    for (int g = 0; g < 4; ++g) { float a = 0.f; for (int n = 0; n < ncmp; ++n) a += sc[g * 128 + n] * bf2f(vc[(size_t)n * 64 + lane]); if (g == 0) oc0 = a; else if (g == 1) oc1 = a; else if (g == 2) oc2 = a; else oc3 = a; }
    float imp = 0.f; for (int g = 0; g < 4; ++g) imp += sc[g * 128 + 2 * lane] + sc[g * 128 + 2 * lane + 1];
    { const bool forced = (lane == 0) || (lane == cq) || (lane == cq - 1), elig = lane <= cq; imp = forced ? 1e9f : (elig ? imp : -1.0f); }
    LDS_WAIT(); qs[256 + lane] = imp; LDS_WAIT();
    int rank = 0; for (int j = 0; j < 64; ++j) { const float v = qs[256 + j]; rank += (v > imp) || (v == imp && j < lane); }
    const int nsb = sample ? 33 : 64;
    const unsigned long long selm = __ballot(rank < 16 && lane < nsb);
    float r0 = oc0, r1 = oc1, r2_ = oc2, r3 = oc3;
    if (br != 0) {
        const int nslot = br == 1 ? __builtin_popcountll(selm) : 9;
        LDS_WAIT();
        for (int si = 0; si < nslot && si < 16; ++si) {
            int j;
            if (br == 1) { unsigned long long mm = selm; for (int n = 0; n < si; ++n) mm &= mm - 1ull; j = __builtin_ctzll(mm); } else j = sample ? si : cq - 8 + si;
            bool ok = false; int pk = 0; const float* kf = nullptr; const bf16_t* kb = nullptr;
            if (br == 1) { pk = 64 * j + lane;
                if (!sample) { ok = pk <= pos; kb = P.KS + ((size_t)b * SEQ + pk) * 256 + kv * 64; }
                else if (j < 32) { ok = true; kf = P.ck_sel + (((size_t)P.pt[b * 16 + (j >> 1)] * 128 + (j & 1) * 64 + lane) * 4 + kv) * 64; }
                else { ok = lane < 4 && pk <= pos; kb = P.KS + ((size_t)MP + b * 4 + (lane & 3)) * 256 + kv * 64; } }
            else { if (!sample) { pk = 64 * j + lane; ok = j >= 0 && pk <= pos && pos - pk < 512; kb = P.KW + ((size_t)b * SEQ + (ok ? pk : 0)) * 256 + kv * 64; }
                else { const int e = 64 * j + lane; pk = PAST - 512 + e; ok = e < 516 && pk <= pos && pos - pk < 512;
                    if (e < 512) kf = P.st_kw + (((size_t)b * 512 + e) * 4 + kv) * 64; else kb = P.KW + ((size_t)MP + b * 4 + ((e - 512) & 3)) * 256 + kv * 64; } }
            const int dist = pos - pk;
            for (int g = 0; g < 4; ++g) { float s = -INFINITY;
                if (ok) { float a = 0.f; for (int d = 0; d < 64; ++d) a += qs[g * 64 + d] * (kf ? rb(kf[d]) : bf2f(kb[d])); s = a + lutb[(kv * 4 + g) * 128 + (dist > 127 ? 127 : dist)]; }
                sc[g * 1024 + si * 64 + lane] = s; }
        }
        LDS_WAIT();
        for (int g = 0; g < 4; ++g) {
            float mx = -INFINITY; for (int si = 0; si < nslot && si < 16; ++si) mx = fmaxf(mx, sc[g * 1024 + si * 64 + lane]);
            mx = wmax(mx); float sm = 0.f;
            for (int si = 0; si < nslot && si < 16; ++si) { const float p = mx > -INFINITY ? ex2(sc[g * 1024 + si * 64 + lane] - mx) : 0.f; sc[g * 1024 + si * 64 + lane] = p; sm += p; }
            sm = wsum(sm); const float inv = sm > 0.f ? 1.0f / sm : 0.f;
            LDS_WAIT();
            float a = 0.f;
            for (int si = 0; si < nslot && si < 16; ++si) {
                int j;
                if (br == 1) { unsigned long long mm = selm; for (int n = 0; n < si; ++n) mm &= mm - 1ull; j = __builtin_ctzll(mm); } else j = sample ? si : cq - 8 + si;
                for (int k = 0; k < 64; ++k) { const float p = sc[g * 1024 + si * 64 + k]; if (p == 0.f) continue; float v;
                    if (br == 1) { if (!sample) v = bf2f(P.VS[((size_t)b * SEQ + 64 * j + k) * 256 + kv * 64 + lane]);
                        else if (j < 32) v = rb(P.cv_sel[(((size_t)P.pt[b * 16 + (j >> 1)] * 128 + (j & 1) * 64 + k) * 4 + kv) * 64 + lane]);
                        else v = bf2f(P.VS[((size_t)MP + b * 4 + (k & 3)) * 256 + kv * 64 + lane]); }
                    else { if (!sample) v = bf2f(P.VW[((size_t)b * SEQ + 64 * j + k) * 256 + kv * 64 + lane]);
                        else { const int e = 64 * j + k; v = e < 512 ? rb(P.st_vw[(((size_t)b * 512 + e) * 4 + kv) * 64 + lane]) : bf2f(P.VW[((size_t)MP + b * 4 + ((e - 512) & 3)) * 256 + kv * 64 + lane]); } }
                    a += p * v; } }
            a *= inv; if (g == 0) r0 = a; else if (g == 1) r1 = a; else if (g == 2) r2_ = a; else r3 = a;
            LDS_WAIT();
        }
    }
    float d2 = 0.f, rr2 = 0.f;
    for (int g = 0; g < 4; ++g) { const float ref = g == 0 ? r0 : g == 1 ? r1 : g == 2 ? r2_ : r3; const float f = bf2f(P.O[row * D + (kv * 4 + g) * 64 + lane]); const float df = f - ref; d2 += df * df; rr2 += ref * ref; }
    d2 = wsum(d2); rr2 = wsum(rr2);
    if (lane == 0) { atomicAdd(errs + ((sample ? 3 : 0) + br) * 2, d2); atomicAdd(errs + ((sample ? 3 : 0) + br) * 2 + 1, rr2); }
}
#endif
}

constexpr int NPHASE = 17;
__global__ void __launch_bounds__(512, 2) nsa_fwd(Args args) {
    extern __shared__ __attribute__((aligned(16))) unsigned char lds[];
    Frame F;
    F.lds = (LAS unsigned char*)lds;
    F.tid = threadIdx.x; F.lane = F.tid & 63; F.wave = __builtin_amdgcn_readfirstlane(F.tid >> 6);
    F.G = gridDim.x; { const int bx = blockIdx.x; F.vcu = (F.G % 8 == 0) ? (bx % 8) * (F.G / 8) + bx / 8 : bx; }
    F.x_p = (const float*)args.in[0]; F.x_s = (const float*)args.in[1]; F.c_p = (const float*)args.in[2]; F.c_s = (const float*)args.in[3];
    F.ck_cmp = (const float*)args.in[4]; F.cv_cmp = (const float*)args.in[5]; F.ck_sel = (const float*)args.in[6]; F.cv_sel = (const float*)args.in[7];
    F.page_table = (const int*)args.in[8]; F.st_kw = (const float*)args.in[9]; F.st_vw = (const float*)args.in[10]; F.st_pool = (const float*)args.in[11];
    F.rel_bias = (const float*)args.in[12]; F.ada_w = (const float*)args.in[13]; F.ada_b = (const float*)args.in[14]; F.norm_g = (const float*)args.in[15]; F.final_g = (const float*)args.in[16];
    F.w_in = (const float*)args.in[17]; F.w_out = (const float*)args.in[18]; F.cmp_wk = (const float*)args.in[19]; F.cmp_wv = (const float*)args.in[20];
    F.pe_k = (const float*)args.in[21]; F.pe_v = (const float*)args.in[22]; F.pool_w = (const float*)args.in[23]; F.pool_scale = (const float*)args.in[24];
    F.ffn_wg = (const float*)args.in[25]; F.ffn_wu = (const float*)args.in[26]; F.ffn_wd = (const float*)args.in[27];
    F.out = args.out; F.ws = args.ws;
    unsigned char* ws = args.ws;
    for (int u = F.tid; u < 64; u += 512) ((LAS unsigned*)(F.lds + MISC_OFF))[u] = 0u;
    for (int u = F.tid; u < 16 * 128; u += 512) { const int h = u >> 7, d = u & 127; ((LAS float*)(F.lds + LUT_OFF))[u] = F.rel_bias[t5_bucket(d) * 16 + h] * LOG2E; }
    __syncthreads();
    volatile LAS unsigned* MISC = (volatile LAS unsigned*)(F.lds + MISC_OFF);
    XcdBarrier bar; bar.bar = (unsigned*)(ws + WS_CTL) + CW_BAR; bar.x = 0; bar.st = nullptr;
    if (!MK_SPLIT) bar = xcd_barrier_post((unsigned*)(ws + WS_CTL) + CW_BAR, MISC + 8);
    const int lo = args.ph_lo, hi = args.ph_hi;
#ifndef PHMASK
#define PHMASK 0x1FFFF
#endif
#define IN(k) (((PHMASK >> (k)) & 1) && lo <= (k) && (k) < hi)
#define SEAM(k) do { if (IN(k) && IN((k) + 1)) xcd_barrier(bar); } while (0)
#ifndef REPMASK
#define REPMASK 0
#endif
#define REPS(k) (((REPMASK >> (k)) & 1) ? 2 : 1)
    bf16_t* H = (bf16_t*)(ws + WS_H); bf16_t* X = (bf16_t*)(ws + WS_X); float* MOD = (float*)(ws + WS_MOD);

    if (IN(0)) { for (int rep = 0; rep < REPS(0); ++rep) p0_prologue(F); } SEAM(0);
    if (IN(1)) { for (int rep = 0; rep < REPS(1); ++rep) { p1_compress_sample(F); p1_ada(F); } } SEAM(1);
    if (IN(2)) { for (int rep = 0; rep < REPS(2); ++rep) norm_phase<0>(F, true, 0, 0); } SEAM(2);
    if (IN(3)) {
        pg8::Gemm g{H, (const bf16_t*)(ws + WS_WIN), D, D, D, 0}; pg8::StaticOrder S; S.init(MT, NPROJ, F.G, (int)blockIdx.x);
        pg8::EpiProj E{(bf16_t*)(ws + WS_Q), (bf16_t*)(ws + WS_KV), (float*)(ws + WS_GATES), F.out};
        for (int rep = 0; rep < REPS(3); ++rep) pg8::gemm_phase<pg8::EpiProj, pg8::StaticOrder, true>(F.lds, g, S, E);
    } SEAM(3);
    if (IN(4)) { for (int rep = 0; rep < REPS(4); ++rep) p4_compress_prompt(F); } SEAM(4);
    if (IN(5)) {
        att::Ptrs P; P.Q = (const bf16_t*)(ws + WS_Q); P.kcp = (const bf16_t*)(ws + WS_KCMPP); P.vcp = (const bf16_t*)(ws + WS_VCMPP); P.kcs = (const bf16_t*)(ws + WS_KCMPS); P.vcs = (const bf16_t*)(ws + WS_VCMPS);
        const bf16_t* kvb = (const bf16_t*)(ws + WS_KV); P.KS = kvb + 2 * KV_STRIDE; P.VS = kvb + 3 * KV_STRIDE; P.KW = kvb + 4 * KV_STRIDE; P.VW = kvb + 5 * KV_STRIDE;
        P.gates = (const float*)(ws + WS_GATES); P.O = (bf16_t*)(ws + WS_O); P.ck_sel = F.ck_sel; P.cv_sel = F.cv_sel; P.st_kw = F.st_kw; P.st_vw = F.st_vw; P.pt = F.page_table;
        P.gov = -1; P.kw_out = F.out + O_KWS; P.vw_out = F.out + O_KWS + SZ_WS;
#ifdef VERIFY
        P.gov = args.pad0 - 1;
#endif
#ifndef RS
#define RS 1
#endif
#ifndef RP
#define RP 1
#endif
#pragma unroll 1
        for (int pass = 0; pass < 2; ++pass) {
            if ((pass == 0) != ((F.vcu & 1) != 0)) {
#pragma unroll 1
                for (int rep = 0; rep < RS; ++rep)
                for (int u = F.vcu; u < NSB * 2; u += F.G) att::sample_unit(P, F.lds, u, u + NSB * 2, F.tid, F.wave, F.lane);
            } else {
#pragma unroll 1
                for (int rep = 0; rep < RP; ++rep)
                for (int u = F.vcu; u < 16 * 16; u += F.G) { const int bk = u >> 4, s = u & 15;
#pragma unroll 1
                    for (int i = 0; i < 4; ++i) { const int c = (i == 0) ? s : (i == 1) ? 31 - s : (i == 2) ? 32 + s : 63 - s; att::prompt_unit(P, F.lds, bk >> 2, bk & 3, c, F.tid, F.wave, F.lane); } }
            }
        }
    } SEAM(5);
    if (IN(6)) {
        pg8::Gemm g{(const bf16_t*)(ws + WS_O), (const bf16_t*)(ws + WS_WOUT), D, D, D, 0}; pg8::StaticOrder S; S.init(MP, D, F.G, (int)blockIdx.x);
        pg8::EpiRes<true> E{F.x_p, F.x_s, X, MOD + 2048};
        pg8::gemm_phase<decltype(E), pg8::StaticOrder, true>(F.lds, g, S, E);
        small_gemm_res<true>(F, (const bf16_t*)(ws + WS_O) + (size_t)MP * D, D, (const bf16_t*)(ws + WS_WOUT), D, D, false, F.x_s, X + (size_t)MP * D, MOD + 2048);
    } SEAM(6);
    if (IN(7)) { for (int rep = 0; rep < REPS(7); ++rep) norm_phase<0>(F, false, 0, 1); } SEAM(7);
    if (IN(8)) {
        pg8::Gemm g{H, (const bf16_t*)(ws + WS_WGU), D, D, D, 0}; pg8::StaticOrder S; S.init(MT, NGU, F.G, (int)blockIdx.x);
        pg8::EpiGU E{(bf16_t*)(ws + WS_ACT)};
        for (int rep = 0; rep < REPS(8); ++rep) pg8::gemm_phase<pg8::EpiGU, pg8::StaticOrder, true>(F.lds, g, S, E);
    } SEAM(8);
    if (IN(9)) {
        pg8::Gemm g{(const bf16_t*)(ws + WS_ACT), (const bf16_t*)(ws + WS_WD), FF, FF, FF, 0}; pg8::StaticOrder S; S.init(MP, D, F.G, (int)blockIdx.x);
        pg8::EpiRes<false> E{nullptr, nullptr, X, MOD + 5120};
        pg8::gemm_phase<decltype(E), pg8::StaticOrder, true>(F.lds, g, S, E);
        small_gemm_res<false>(F, (const bf16_t*)(ws + WS_ACT) + (size_t)MP * FF, FF, (const bf16_t*)(ws + WS_WD), FF, FF, false, nullptr, X + (size_t)MP * D, MOD + 5120);
    } SEAM(9);
    if (IN(10)) { for (int rep = 0; rep < REPS(10); ++rep) norm_phase<1>(F, false, 1, 0); } SEAM(10);
    if (IN(11)) { for (int rep = 0; rep < REPS(11); ++rep) pool_phase(F); } SEAM(11);
    if (IN(12)) {
        pg8::Gemm g{H, (const bf16_t*)(ws + WS_WPOOL), D, 256, 256, 256}; pg8::StaticOrder S; S.init(MP, D, F.G, (int)blockIdx.x);
        pg8::EpiRes<false> E{nullptr, nullptr, X, MOD + (size_t)NMODB * 6144 + 2048};
        pg8::gemm_phase<decltype(E), pg8::StaticOrder, true>(F.lds, g, S, E);
        small_gemm_res<false>(F, H + (size_t)MP * D, D, (const bf16_t*)(ws + WS_WPOOL), 256, 256, true, nullptr, X + (size_t)MP * D, MOD + (size_t)NMODB * 6144 + 2048);
    } SEAM(12);
    if (IN(13)) { for (int rep = 0; rep < REPS(13); ++rep) norm_phase<0>(F, false, 1, 1); } SEAM(13);
    if (IN(14)) {
        pg8::Gemm g{H, (const bf16_t*)(ws + WS_WGU) + (size_t)NGU * D, D, D, D, 0}; pg8::StaticOrder S; S.init(MT, NGU, F.G, (int)blockIdx.x);
        pg8::EpiGU E{(bf16_t*)(ws + WS_ACT)};
        pg8::gemm_phase<pg8::EpiGU, pg8::StaticOrder, true>(F.lds, g, S, E);
    } SEAM(14);
    if (IN(15)) {
        pg8::Gemm g{(const bf16_t*)(ws + WS_ACT), (const bf16_t*)(ws + WS_WD) + (size_t)D * FF, FF, FF, FF, 0}; pg8::StaticOrder S; S.init(MP, D, F.G, (int)blockIdx.x);
        pg8::EpiRes<false> E{nullptr, nullptr, X, MOD + (size_t)NMODB * 6144 + 5120};
        pg8::gemm_phase<decltype(E), pg8::StaticOrder, true>(F.lds, g, S, E);
        small_gemm_res<false>(F, (const bf16_t*)(ws + WS_ACT) + (size_t)MP * FF, FF, (const bf16_t*)(ws + WS_WD) + (size_t)D * FF, FF, FF, false, nullptr, X + (size_t)MP * D, MOD + (size_t)NMODB * 6144 + 5120);
    } SEAM(15);
    if (IN(16)) { for (int rep = 0; rep < REPS(16); ++rep) norm_phase<2>(F, false, 0, 0); }
#undef IN
#undef SEAM
}


#ifdef VERIFY
__global__ void __launch_bounds__(512, 2) verify_k(Args args) {
    extern __shared__ __attribute__((aligned(16))) unsigned char lds[];
    LAS unsigned char* L = (LAS unsigned char*)lds; unsigned char* ws = args.ws;
    const int tid = threadIdx.x, lane = tid & 63, wave = __builtin_amdgcn_readfirstlane(tid >> 6);
    const float* rel_bias = (const float*)args.in[12];
    for (int u = tid; u < 16 * 128; u += 512) { const int h = u >> 7, d = u & 127; ((LAS float*)(L + LUT_OFF))[u] = rel_bias[t5_bucket(d) * 16 + h] * LOG2E; }
    __syncthreads();
    att::Ptrs P; P.Q = (const bf16_t*)(ws + WS_Q); P.kcp = (const bf16_t*)(ws + WS_KCMPP); P.vcp = (const bf16_t*)(ws + WS_VCMPP); P.kcs = (const bf16_t*)(ws + WS_KCMPS); P.vcs = (const bf16_t*)(ws + WS_VCMPS);
    const bf16_t* kvb = (const bf16_t*)(ws + WS_KV); P.KS = kvb + 2 * KV_STRIDE; P.VS = kvb + 3 * KV_STRIDE; P.KW = kvb + 4 * KV_STRIDE; P.VW = kvb + 5 * KV_STRIDE;
    P.gates = (const float*)(ws + WS_GATES); P.O = (bf16_t*)(ws + WS_O); P.ck_sel = (const float*)args.in[6]; P.cv_sel = (const float*)args.in[7]; P.st_kw = (const float*)args.in[9]; P.st_vw = (const float*)args.in[10]; P.pt = (const int*)args.in[8]; P.gov = args.pad0 - 1;
    float* errs = (float*)(ws + WS_CTL) + 65536;
    const int gw = blockIdx.x * 8 + wave;
    for (int it = gw; it < 168 + 64; it += gridDim.x * 8) { bool smp = it >= 168; int vb_, vt_, vk_;
        if (!smp) { const int ti = it % 21, r = it / 21; vb_ = (r >> 2) ? 3 : 0; vk_ = r & 3; vt_ = ti == 0 ? 0 : ti == 1 ? 5 : ti == 2 ? 30 : ti == 3 ? 31 : ti == 4 ? 63 : ti == 5 ? 64 : ti == 6 ? 100 : ti == 7 ? 511 : ti == 8 ? 512 : ti == 9 ? 600 : ti == 10 ? 959 : ti == 11 ? 960 : ti == 12 ? 1023 : ti == 13 ? 1024 : ti == 14 ? 1055 : ti == 15 ? 1100 : ti == 16 ? 2047 : ti == 17 ? 2048 : ti == 18 ? 3000 : ti == 19 ? 4032 : 4095; }
        else { const int q = it - 168, bi = q >> 4; vb_ = bi == 0 ? 0 : bi == 1 ? 1 : bi == 2 ? 77 : 127; vt_ = q & 3; vk_ = (q >> 2) & 3; }
        att::verify_item(P, L, smp, vb_, vt_, vk_, args.pad0 - 1, errs, wave, lane); }
}
__global__ void scale_k(Args args) {
    const float* errs = (const float*)(args.ws + WS_CTL) + 65536; const size_t offs[6] = {O_KCP, O_KCP + SZ_KVP, O_KCP + 2 * SZ_KVP, O_KCS, O_KCS + SZ_KVS, O_KCS + 2 * SZ_KVS};
    const int k = blockIdx.y; const float d2 = errs[2 * k], r2 = errs[2 * k + 1]; const float e = r2 > 0.f ? sqrtf(d2 / r2) : 7.0f; const size_t n = k < 3 ? SZ_KVP : SZ_KVS;
    for (size_t i = (size_t)blockIdx.x * blockDim.x + threadIdx.x; i < n; i += (size_t)gridDim.x * blockDim.x) args.out[offs[k] + i] *= (1.0f + e);
}
#endif
extern "C" void kernel_launch(void* const* d_in, const int* in_sizes, int n_in, void* d_out, int out_size, void* d_ws, size_t ws_size, hipStream_t stream) {
    static int grid = 0;
    if (grid == 0) {
        if (n_in != 28 || (size_t)out_size != O_END || ws_size < WS_END) { fprintf(stderr, "kernel_launch: unexpected shapes (n_in %d, out %d, ws %zu); nothing launched\n", n_in, out_size, ws_size); grid = -1; return; }
        int dev = 0, cus = 0, per_cu = 0;
        if (hipGetDevice(&dev) != hipSuccess || hipDeviceGetAttribute(&cus, hipDeviceAttributeMultiprocessorCount, dev) != hipSuccess) { grid = -1; return; }
        if (hipFuncSetAttribute((const void*)nsa_fwd, hipFuncAttributeMaxDynamicSharedMemorySize, LDS_BYTES) != hipSuccess) { fprintf(stderr, "kernel_launch: hipFuncSetAttribute(%d B LDS) failed\n", LDS_BYTES); grid = -1; return; }
        if (hipOccupancyMaxActiveBlocksPerMultiprocessor(&per_cu, (const void*)nsa_fwd, 512, LDS_BYTES) != hipSuccess || per_cu < 1)
            fprintf(stderr, "kernel_launch: note: occupancy query reports %d workgroups per CU\n", per_cu);
        (void)hipGetLastError();
        grid = cus;
    }
    if (grid < 0) return;
    (void)hipMemsetAsync((char*)d_ws + WS_CTL, 0, CTL_ZERO_BYTES, stream);
    Args a{};
    for (int i = 0; i < 28; ++i) a.in[i] = d_in[i];
    a.out = (float*)d_out; a.ws = (unsigned char*)d_ws; a.pad0 = 0; a.pad1 = 0;
#ifdef VERIFY
    hipFuncSetAttribute((const void*)verify_k, hipFuncAttributeMaxDynamicSharedMemorySize, LDS_BYTES);
    for (int pass = 0; pass < 3; ++pass) { a.pad0 = pass + 1; a.ph_lo = 0; a.ph_hi = 6;
        (void)hipMemsetAsync((char*)d_ws + WS_CTL, 0, 65536 * 4, stream);
        hipLaunchKernelGGL(nsa_fwd, dim3(grid), dim3(512), LDS_BYTES, stream, a);
        hipLaunchKernelGGL(verify_k, dim3(grid), dim3(512), LDS_BYTES, stream, a); }
    a.pad0 = 0; (void)hipMemsetAsync((char*)d_ws + WS_CTL, 0, 65536 * 4, stream);
    a.ph_lo = 0; a.ph_hi = NPHASE;
    hipLaunchKernelGGL(nsa_fwd, dim3(grid), dim3(512), LDS_BYTES, stream, a);
    hipLaunchKernelGGL(scale_k, dim3(64, 6), dim3(256), 0, stream, a);
#elif MK_SPLIT
    for (int p = 0; p < NPHASE; ++p) { a.ph_lo = p; a.ph_hi = p + 1; hipLaunchKernelGGL(nsa_fwd, dim3(grid), dim3(512), LDS_BYTES, stream, a); }
#else
    a.ph_lo = 0; a.ph_hi = NPHASE;
    hipLaunchKernelGGL(nsa_fwd, dim3(grid), dim3(512), LDS_BYTES, stream, a);
#endif
    const hipError_t le = hipPeekAtLastError();
    if (le != hipSuccess) fprintf(stderr, "kernel_launch: launch failed: %s\n", hipGetErrorName(le));
}
```

```cpp
#include <hip/hip_runtime.h>
#include <cstdio>
#include <cstdint>

#ifndef MK_SPLIT
#define MK_SPLIT 0
#endif

#define GAS __attribute__((address_space(1)))
#define LAS __attribute__((address_space(3)))
typedef unsigned short bf16_t;
typedef short bf16x8 __attribute__((ext_vector_type(8)));
typedef short s16x4 __attribute__((ext_vector_type(4)));
typedef float f32x2 __attribute__((ext_vector_type(2)));
typedef float f32x4 __attribute__((ext_vector_type(4)));
typedef float f32x16 __attribute__((ext_vector_type(16)));
typedef unsigned u32x2 __attribute__((ext_vector_type(2)));
typedef unsigned u32x4 __attribute__((ext_vector_type(4)));
typedef __bf16 bf16x2_t __attribute__((ext_vector_type(2)));
typedef GAS unsigned gu32;

constexpr int D = 1024, SEQ = 4096, NB = 4, NSB = 128, DSEQ = 4;
constexpr int MP = NB * SEQ, MS = NSB * DSEQ, MT = MP + MS;
constexpr int INCOLS = 2608, NPROJ = 2816, FF = 2816, NGU = 2 * FF;
constexpr int NMODB = NB + NSB;
constexpr int PAST = 2048;
constexpr float C2 = 0.125f * 1.4426950408889634f;
constexpr float LOG2E = 1.4426950408889634f;

constexpr size_t O_YP = 0, O_YS = O_YP + (size_t)MP * D;
constexpr size_t O_KCP = O_YS + (size_t)MS * D, SZ_KVP = (size_t)MP * 256;
constexpr size_t O_KWP = O_KCP + 4 * SZ_KVP, SZ_WP = (size_t)NB * 512 * 256;
constexpr size_t O_PLP = O_KWP + 2 * SZ_WP;
constexpr size_t O_KCS = O_PLP + (size_t)NB * 15 * D, SZ_KVS = (size_t)MS * 256;
constexpr size_t O_KWS = O_KCS + 4 * SZ_KVS, SZ_WS = (size_t)NSB * 512 * 256;
constexpr size_t O_PLS = O_KWS + 2 * SZ_WS;
constexpr size_t O_END = O_PLS + (size_t)NSB * 15 * D;
static_assert(O_END == 71233536, "output size");

constexpr size_t MiB = 1u << 20;
#ifdef VERIFY
constexpr size_t WS_CTL = 0, CTL_ZERO_BYTES = 1 * MiB;
#else
constexpr size_t WS_CTL = 0, CTL_ZERO_BYTES = 65536;
#endif
constexpr size_t WS_WIN = 2 * MiB;
constexpr size_t WS_WOUT = 8 * MiB;
constexpr size_t WS_WGU = 10 * MiB;
constexpr size_t WS_WD = 32 * MiB;
constexpr size_t WS_WPOOL = 44 * MiB;
constexpr size_t WS_WCK = 45 * MiB, WS_WCV = WS_WCK + 262144;
constexpr size_t WS_SC = 46 * MiB;
constexpr size_t WS_CB = 47 * MiB;
constexpr size_t WS_MOD = 48 * MiB;
constexpr size_t WS_KCMPP = 56 * MiB, WS_VCMPP = 57 * MiB;
constexpr size_t WS_KCMPS = 58 * MiB, WS_VCMPS = 62 * MiB;
constexpr size_t WS_GATES = 66 * MiB;
constexpr size_t WS_RSTD = 70 * MiB;
constexpr size_t WS_H = 72 * MiB;
constexpr size_t WS_Q = 108 * MiB;
constexpr size_t WS_O = 144 * MiB;
constexpr size_t WS_KV = 180 * MiB, KV_STRIDE = (size_t)MT * 256;
constexpr size_t WS_X = 232 * MiB;
constexpr size_t WS_HF = 300 * MiB;
constexpr size_t WS_ACT = 368 * MiB;
constexpr size_t WS_END = 464 * MiB;
static_assert(WS_KV + 6 * KV_STRIDE * 2 <= WS_X && WS_X + (size_t)MT * D * 4 <= WS_HF && WS_HF + (size_t)MT * D * 4 <= WS_ACT && WS_ACT + (size_t)MT * FF * 2 <= WS_END, "ws map");
static_assert(WS_WGU + 2 * (size_t)NGU * D * 2 <= WS_WD && WS_WD + 2 * (size_t)D * FF * 2 <= WS_WPOOL && WS_MOD + 2 * (size_t)NMODB * 6144 * 4 <= WS_KCMPP, "ws map 2");
static_assert(WS_GATES + (size_t)MT * 48 * 4 <= WS_H && WS_H + (size_t)MT * D * 2 <= WS_Q && WS_Q + (size_t)MT * D * 2 <= WS_O && WS_O + (size_t)MT * D * 2 <= WS_KV, "ws map 3");
constexpr int CW_BAR = 4096;

constexpr int RING_BYTES = 131072;
constexpr int LUT_OFF = RING_BYTES;
constexpr int WSF_OFF = LUT_OFF + 8192;
constexpr int IMP_OFF = WSF_OFF + 1024;
constexpr int MISC_OFF = IMP_OFF + 16384;
constexpr int LDS_BYTES = MISC_OFF + 256;
static_assert(LDS_BYTES <= 160 * 1024, "LDS");

__device__ __forceinline__ unsigned cvtpk(float lo, float hi) { f32x2 v = {lo, hi}; bf16x2_t b = __builtin_convertvector(v, bf16x2_t); return __builtin_bit_cast(unsigned, b); }
__device__ __forceinline__ float bf2f(unsigned short h) { return __builtin_bit_cast(float, (unsigned)h << 16); }
__device__ __forceinline__ float ex2(float x) { return __builtin_amdgcn_exp2f(x); }
__device__ __forceinline__ float sigmoidf_(float x) { return __builtin_amdgcn_rcpf(1.0f + ex2(-x * LOG2E)); }
#define CROW0(r) (((r) & 3) + 8 * ((r) >> 2))
#define LDS_WAIT() asm volatile("s_waitcnt lgkmcnt(0)" ::: "memory")
#define VM_WAIT() asm volatile("s_waitcnt vmcnt(0)" ::: "memory")
__device__ __forceinline__ const char* uniform_ptr(const void* p) { const unsigned long long v = (unsigned long long)p; const unsigned lo = (unsigned)__builtin_amdgcn_readfirstlane((int)(unsigned)v), hi = (unsigned)__builtin_amdgcn_readfirstlane((int)(unsigned)(v >> 32)); return (const char*)(((unsigned long long)hi << 32) | lo); }

__device__ __forceinline__ int lane_id() { int l; asm volatile("v_mbcnt_lo_u32_b32 %0, -1, 0\n\tv_mbcnt_hi_u32_b32 %0, -1, %0" : "=v"(l)); return l; }
__device__ __forceinline__ int t5_bucket(int d) {
    if (d < 16) return d;
    int b = 16;
    b += (d >= 19) + (d >= 21) + (d >= 24) + (d >= 27) + (d >= 31) + (d >= 35) + (d >= 40) + (d >= 46) + (d >= 52) + (d >= 59) + (d >= 67) + (d >= 77) + (d >= 87) + (d >= 99) + (d >= 113);
    return b;
}

namespace pg8 {
constexpr int BM = 256, BK = 64, HALF = 128, HTB = HALF * BK * 2, STAGE_BYTES = 8 * HTB, NXCD = 8, WGM = 8;
__host__ __device__ __forceinline__ int lds_byte(int r, int c) { const int st = (r >> 4) * 2 + (c >> 5), rr = r & 15, cc = c & 31, ob = rr * 64 + cc * 2; return st * 1024 + (ob ^ (((ob >> 9) & 1) << 5)); }
__host__ __device__ __forceinline__ void stage_rc(int b, int& R, int& C) { const int st = b / 1024, sb = b % 1024, swz = sb ^ (((sb >> 9) & 1) << 5); R = (st >> 1) * 16 + swz / 64; C = (st & 1) * 32 + (swz % 64) / 2; }
__host__ __device__ __forceinline__ int perm32(int rho) { const int n = rho >> 4, i = rho & 15; return 8 * (i >> 2) + 4 * n + (i & 3); }
struct Unit { int pm, pn; };
struct Gemm { const bf16_t* A; const bf16_t* Bt; int lda, ldb, K, acs; };
struct StaticOrder {
    int nM, nN, nwg, G, c;
    __host__ __device__ void init(int M, int N, int G_, int c_) { nM = M / BM; nN = N / BM; nwg = nM * nN; G = G_; c = c_; }
    __host__ __device__ bool next(int i, Unit& u) const {
        const long L = (long)i * G + c; if (L >= nwg) return false;
        int wgid = (int)L; { const int q = nwg / NXCD, r = nwg % NXCD, xcd = wgid % NXCD, off = wgid / NXCD; wgid = (xcd < r ? xcd * (q + 1) : r * (q + 1) + (xcd - r) * q) + off; }
        const int nig = WGM * nN, gid = wgid / nig, fm = gid * WGM, gsz = (nM - fm) < WGM ? (nM - fm) : WGM;
        u.pm = fm + ((wgid % nig) % gsz); u.pn = (wgid % nig) / gsz; return true;
    }
};
template <class Epi, class Sched, bool ALIGN_EPI>
__device__ __forceinline__ void gemm_phase(LAS unsigned char* lds, const Gemm g, const Sched& S, const Epi& E) {
    const int tid = threadIdx.x, wid = __builtin_amdgcn_readfirstlane(tid >> 6), lane = tid & 63, wr = wid >> 2, wc = wid & 3, fr = lane & 15, fq = lane >> 4;
    const int K = g.K, nt = K / BK;
    unsigned voffA[2], voffB[2];
#pragma unroll
    for (int i = 0; i < 2; ++i) { int R, C; stage_rc(tid * 16 + i * 8192, R, C); const int Rb = Epi::PERM ? ((R & ~31) + perm32(R & 31)) : R;
        voffA[i] = (unsigned)(R * g.lda + C) * 2u; voffB[i] = (unsigned)(Rb * g.ldb + C) * 2u; }
    const size_t kstep = (size_t)(BK * 2);
    const size_t hsA = (size_t)HALF * g.lda * 2, hsB = (size_t)HALF * g.ldb * 2;
    const unsigned ldsw = (unsigned)wid * 1024u;
    const int aoff = lds_byte(wr * 64 + fr, fq * 8), boff = lds_byte(wc * 32 + fr, fq * 8);
#define PG8_SA(b, h) (((b) * 2 + (h)) * HTB)
#define PG8_SB(b, h) ((4 + (b) * 2 + (h)) * HTB)
#define PG8_STAGE(bufoff, gbase, voff) do { _Pragma("unroll") for (int _i = 0; _i < 2; ++_i) \
        __builtin_amdgcn_global_load_lds((const unsigned*)((const char*)(gbase) + (voff)[_i]), (LAS unsigned*)(lds + (bufoff) + ldsw + _i * 8192), 16, 0, 0); } while (0)
#define PG8_LDA(dst, b, h) do { _Pragma("unroll") for (int m = 0; m < 4; ++m) _Pragma("unroll") for (int k = 0; k < 2; ++k) dst[m][k] = *(const LAS bf16x8*)(lds + PG8_SA(b, h) + aoff + m * 2048 + k * 1024); } while (0)
#define PG8_LDB(dst, b, h) do { _Pragma("unroll") for (int n = 0; n < 2; ++n) _Pragma("unroll") for (int k = 0; k < 2; ++k) dst[n][k] = *(const LAS bf16x8*)(lds + PG8_SB(b, h) + boff + n * 2048 + k * 1024); } while (0)
#define PG8_MMA(ai, bj, At, Bt) do { __builtin_amdgcn_s_setprio(1); _Pragma("unroll") for (int m = 0; m < 4; ++m) _Pragma("unroll") for (int n = 0; n < 2; ++n) _Pragma("unroll") for (int k = 0; k < 2; ++k) \
        acc[ai][bj][m][n] = __builtin_amdgcn_mfma_f32_16x16x32_bf16(Bt[n][k], At[m][k], acc[ai][bj][m][n], 0, 0, 0); __builtin_amdgcn_s_setprio(0); } while (0)
#define PG8_WAIT_V(n) asm volatile("s_waitcnt vmcnt(" #n ")" ::: "memory")
#define PG8_WAIT_L(n) asm volatile("s_waitcnt lgkmcnt(" #n ")" ::: "memory")
#define PG8_BAR __builtin_amdgcn_s_barrier()
#define PG8_SCHED __builtin_amdgcn_sched_barrier(0)
#define PG8_UA(u) ((const char*)g.A + (size_t)(u).pm * 2 * hsA + (size_t)(u).pn * (size_t)g.acs * 2)
#define PG8_UB(u) ((const char*)g.Bt + (size_t)(u).pn * 2 * hsB)
    Unit cur, nxt; int ui = 0;
    if (!S.next(0, cur)) return;
    f32x4 acc[2][2][4][2];
#pragma unroll
    for (int a = 0; a < 2; ++a)
#pragma unroll
        for (int b = 0; b < 2; ++b)
#pragma unroll
            for (int m = 0; m < 4; ++m)
#pragma unroll
                for (int n = 0; n < 2; ++n) acc[a][b][m][n] = (f32x4){0.f, 0.f, 0.f, 0.f};
    bf16x8 At[4][2], B0[2][2], B1[2][2];
    const char* cA = PG8_UA(cur); const char* cB = PG8_UB(cur);
    PG8_STAGE(PG8_SB(0, 0), cB, voffB); PG8_STAGE(PG8_SB(0, 1), cB + hsB, voffB); PG8_STAGE(PG8_SA(0, 0), cA, voffA); PG8_STAGE(PG8_SA(0, 1), cA + hsA, voffA);
    if (wr == 1) PG8_BAR;
    PG8_WAIT_V(2); PG8_BAR;
    PG8_STAGE(PG8_SB(1, 0), cB + kstep, voffB); PG8_STAGE(PG8_SA(1, 0), cA + kstep, voffA); PG8_STAGE(PG8_SB(1, 1), cB + hsB + kstep, voffB);
    PG8_WAIT_V(6); PG8_BAR;
    for (;;) {
        const bool has_next = S.next(ui + 1, nxt);
        const char* nA = has_next ? PG8_UA(nxt) : cA; const char* nB = has_next ? PG8_UB(nxt) : cB;
        for (int t = 0; t < nt; t += 2) {
            const bool last = (t == nt - 2);
            const char* a1 = cA + (size_t)(t + 1) * kstep;
            const char* a2 = last ? nA : cA + (size_t)(t + 2) * kstep; const char* b2 = last ? nB : cB + (size_t)(t + 2) * kstep;
            const char* a3 = a2 + kstep; const char* b3 = b2 + kstep;
            PG8_LDB(B0, 0, 0); PG8_LDB(B1, 0, 1); PG8_SCHED; PG8_LDA(At, 0, 0); PG8_STAGE(PG8_SA(1, 1), a1 + hsA, voffA);
            PG8_WAIT_V(8); PG8_WAIT_L(0); PG8_BAR; PG8_MMA(0, 0, At, B0); PG8_MMA(0, 1, At, B1); PG8_BAR; PG8_SCHED;
            PG8_LDA(At, 0, 1); PG8_STAGE(PG8_SB(0, 0), b2, voffB); PG8_STAGE(PG8_SB(0, 1), b2 + hsB, voffB); PG8_STAGE(PG8_SA(0, 0), a2, voffA);
            PG8_WAIT_V(8); PG8_WAIT_L(0); PG8_BAR; PG8_MMA(1, 0, At, B0); PG8_MMA(1, 1, At, B1); PG8_BAR; PG8_SCHED;
            PG8_LDB(B0, 1, 0); PG8_LDB(B1, 1, 1); PG8_SCHED; PG8_LDA(At, 1, 0); PG8_STAGE(PG8_SA(0, 1), a2 + hsA, voffA);
            PG8_WAIT_V(8); PG8_WAIT_L(0); PG8_BAR; PG8_MMA(0, 0, At, B0); PG8_MMA(0, 1, At, B1); PG8_BAR; PG8_SCHED;
            PG8_LDA(At, 1, 1); PG8_STAGE(PG8_SB(1, 0), b3, voffB); PG8_STAGE(PG8_SB(1, 1), b3 + hsB, voffB); PG8_STAGE(PG8_SA(1, 0), a3, voffA);
            PG8_WAIT_V(8); PG8_WAIT_L(0); PG8_BAR; PG8_MMA(1, 0, At, B0); PG8_MMA(1, 1, At, B1); PG8_BAR; PG8_SCHED;
        }
        if constexpr (ALIGN_EPI) { if (wr == 0) PG8_BAR; }
        E(acc, cur, wr, wc, fr, fq);
        if (!has_next) break;
#pragma unroll
        for (int a = 0; a < 2; ++a)
#pragma unroll
            for (int b = 0; b < 2; ++b)
#pragma unroll
                for (int m = 0; m < 4; ++m)
#pragma unroll
                    for (int n = 0; n < 2; ++n) acc[a][b][m][n] = (f32x4){0.f, 0.f, 0.f, 0.f};
        cur = nxt; cA = nA; cB = nB; ++ui;
        if constexpr (ALIGN_EPI) { if (wr == 1) PG8_BAR; }
    }
    PG8_WAIT_V(0);
    if constexpr (!ALIGN_EPI) { if (wr == 0) PG8_BAR; }
    PG8_BAR;
#undef PG8_SA
#undef PG8_SB
#undef PG8_STAGE
#undef PG8_LDA
#undef PG8_LDB
#undef PG8_MMA
#undef PG8_WAIT_V
#undef PG8_WAIT_L
#undef PG8_BAR
#undef PG8_SCHED
#undef PG8_UA
#undef PG8_UB
}

struct EpiProj {
    static constexpr bool PERM = true;
    bf16_t* Q; bf16_t* KV; float* gates; float* out;
    __device__ __forceinline__ void operator()(const f32x4 (&acc)[2][2][4][2], const Unit& u, int wr, int wc, int fr, int fq) const {
        const int pn = u.pn;
#pragma unroll
        for (int ai = 0; ai < 2; ++ai)
#pragma unroll
            for (int m = 0; m < 4; ++m) {
                const int row = u.pm * BM + ai * HALF + wr * 64 + m * 16 + fr;
                if (pn < 4) {
#pragma unroll
                    for (int bj = 0; bj < 2; ++bj) { const f32x4 v0 = acc[ai][bj][m][0] * C2, v1 = acc[ai][bj][m][1] * C2; u32x4 w;
                        w.x = cvtpk(v0[0], v0[1]); w.y = cvtpk(v0[2], v0[3]); w.z = cvtpk(v1[0], v1[1]); w.w = cvtpk(v1[2], v1[3]);
                        *(u32x4*)(Q + (size_t)row * D + pn * 256 + bj * HALF + wc * 32 + 8 * fq) = w; }
                } else if (pn < 10) {
                    const int t = pn - 4; float* dst = nullptr;
                    if (row < MP) { if (t < 4) dst = out + O_KCP + (size_t)t * SZ_KVP + (size_t)row * 256; else { const int tt = row & (SEQ - 1); if (tt >= SEQ - 512) dst = out + O_KWP + (size_t)(t - 4) * SZ_WP + ((size_t)(row >> 12) * 512 + (tt - (SEQ - 512))) * 256; } }
                    else { const int rs = row - MP; if (t < 4) dst = out + O_KCS + (size_t)t * SZ_KVS + (size_t)rs * 256; else dst = out + O_KWS + (size_t)(t - 4) * SZ_WS + ((size_t)(rs >> 2) * 512 + 508 + (rs & 3)) * 256; }
                    bf16_t* bd = KV + (size_t)t * KV_STRIDE + (size_t)row * 256;
#pragma unroll
                    for (int bj = 0; bj < 2; ++bj) { const int cc = bj * HALF + wc * 32 + 8 * fq; const f32x4 v0 = acc[ai][bj][m][0], v1 = acc[ai][bj][m][1]; u32x4 w;
                        w.x = cvtpk(v0[0], v0[1]); w.y = cvtpk(v0[2], v0[3]); w.z = cvtpk(v1[0], v1[1]); w.w = cvtpk(v1[2], v1[3]);
                        *(u32x4*)(bd + cc) = w;
                        if (dst) { *(f32x4*)(dst + cc) = v0; *(f32x4*)(dst + cc + 4) = v1; } }
                } else {
                    const int cc = wc * 32 + 8 * fq;
                    if (cc < 48) { float* gd = gates + (size_t)row * 48 + cc; *(f32x4*)gd = acc[ai][0][m][0]; *(f32x4*)(gd + 4) = acc[ai][0][m][1]; }
                }
            }
    }
};
template <bool XF32>
struct EpiRes {
    static constexpr bool PERM = false;
    const float* xin_p; const float* xin_s; bf16_t* xout; const float* gate;
    __device__ __forceinline__ void operator()(const f32x4 (&acc)[2][2][4][2], const Unit& u, int wr, int wc, int fr, int fq) const {
#pragma unroll
        for (int ai = 0; ai < 2; ++ai)
#pragma unroll
            for (int m = 0; m < 4; ++m) {
                const int row = u.pm * BM + ai * HALF + wr * 64 + m * 16 + fr;
                const int bb = row < MP ? (row >> 12) : NB + ((row - MP) >> 2);
                const float* xi = row < MP ? xin_p + (size_t)row * D : xin_s + (size_t)(row - MP) * D;
                const float* gp = gate + (size_t)bb * 6144; bf16_t* xo = xout + (size_t)row * D;
#pragma unroll
                for (int bj = 0; bj < 2; ++bj)
#pragma unroll
                    for (int n = 0; n < 2; ++n) { const int col = u.pn * BM + bj * HALF + wc * 32 + 16 * n + 4 * fq;
                        const f32x4 g4 = *(const f32x4*)(gp + col);
                        f32x4 x4;
                        if constexpr (XF32) x4 = *(const f32x4*)(xi + col);
                        else { const u32x2 xw = *(const u32x2*)(xo + col); x4 = (f32x4){__builtin_bit_cast(float, xw.x << 16), __builtin_bit_cast(float, xw.x & 0xffff0000u), __builtin_bit_cast(float, xw.y << 16), __builtin_bit_cast(float, xw.y & 0xffff0000u)}; }
                        const f32x4 rr = x4 + g4 * acc[ai][bj][m][n];
                        u32x2 w; w.x = cvtpk(rr[0], rr[1]); w.y = cvtpk(rr[2], rr[3]); *(u32x2*)(xo + col) = w; }
            }
    }
};
struct EpiGU {
    static constexpr bool PERM = true;
    bf16_t* act;
    __device__ __forceinline__ void operator()(const f32x4 (&acc)[2][2][4][2], const Unit& u, int wr, int wc, int fr, int fq) const {
#pragma unroll
        for (int ai = 0; ai < 2; ++ai)
#pragma unroll
            for (int m = 0; m < 4; ++m) {
                const int row = u.pm * BM + ai * HALF + wr * 64 + m * 16 + fr; float r[8];
#pragma unroll
                for (int n = 0; n < 2; ++n)
#pragma unroll
                    for (int e = 0; e < 4; ++e) { const float gv = acc[ai][0][m][n][e], uv = acc[ai][1][m][n][e]; r[n * 4 + e] = gv * sigmoidf_(gv) * uv; }
                u32x4 w; w.x = cvtpk(r[0], r[1]); w.y = cvtpk(r[2], r[3]); w.z = cvtpk(r[4], r[5]); w.w = cvtpk(r[6], r[7]);
                *(u32x4*)(act + (size_t)row * FF + u.pn * HALF + wc * 32 + 8 * fq) = w;
            }
    }
};
}

#define XB_TMO      128
#define XB_XCNT(j)  (256  + 64 * (j))
#define XB_XSUB(j)  (1280 + 64 * (j))
#define XB_XGEN(j)  (2304 + 64 * (j))
#define XB_TOP      3328
#define XB_TOPGEN   3392
#define XCD_BAR_WORDS 3456
#define XB_SPIN_CAP (1u << 18)
__device__ __forceinline__ unsigned xb_ld(unsigned* p)              { return __hip_atomic_load(p, __ATOMIC_RELAXED, __HIP_MEMORY_SCOPE_AGENT); }
__device__ __forceinline__ unsigned xb_add(unsigned* p, unsigned v) { return __hip_atomic_fetch_add(p, v, __ATOMIC_RELAXED, __HIP_MEMORY_SCOPE_AGENT); }
__device__ __forceinline__ unsigned xb_xcc_id() { return (unsigned)__builtin_amdgcn_s_getreg((3 << 11) | 20) & 0xFu; }
#define XB_SPIN(cond, bar) do { unsigned _sp = 0; while (cond) { __builtin_amdgcn_s_sleep(1); \
    if ((++_sp & 255u) == 0u) { if (xb_ld(&(bar)[XB_TMO])) break; if (_sp > XB_SPIN_CAP) { atomicAdd(&(bar)[XB_TMO], 1u); break; } } } } while (0)
struct XcdBarrier { unsigned* bar; unsigned x; volatile LAS unsigned* st; };
__device__ __forceinline__ XcdBarrier xcd_barrier_post(unsigned* bar, volatile LAS unsigned* st) {
    XcdBarrier b; b.bar = bar; b.x = xb_xcc_id(); b.st = st;
    if (threadIdx.x == 0) (void)xb_add(&bar[XB_XCNT(b.x)], 1u);
    return b;
}
__device__ __forceinline__ void xcd_barrier_complete(unsigned* bar, unsigned x, unsigned& nloc, unsigned& nx) {
    const unsigned G = gridDim.x * gridDim.y * gridDim.z;
    unsigned sum, cnt, mine, sp = 0u;
    for (;;) {
        sum = 0u; cnt = 0u; mine = 0u;
#pragma unroll
        for (unsigned j = 0; j < 16; ++j) { const unsigned c = xb_ld(&bar[XB_XCNT(j)]); sum += c; cnt += (c > 0u) ? 1u : 0u; mine = (j == x) ? c : mine; }
        if (sum == G) break;
        __builtin_amdgcn_s_sleep(1);
        if ((++sp & 255u) == 0u) { if (xb_ld(&bar[XB_TMO])) break; if (sp > XB_SPIN_CAP) { atomicAdd(&bar[XB_TMO], 1u); break; } }
    }
    nloc = mine > 0u ? mine : 1u; nx = cnt > 0u ? cnt : 1u;
}
__device__ __forceinline__ void xcd_barrier(const XcdBarrier& b) {
    asm volatile("s_waitcnt vmcnt(0)" ::: "memory");
    __syncthreads();
    if (threadIdx.x == 0) {
        unsigned* bar = b.bar;
        __builtin_amdgcn_s_waitcnt(0);
        unsigned nloc = b.st[0], nx = b.st[1];
        if (nloc == 0u) { xcd_barrier_complete(bar, b.x, nloc, nx); b.st[0] = nloc; b.st[1] = nx; }
        const unsigned old = xb_add(&bar[XB_XSUB(b.x)], 1u);
        const unsigned gen = old / nloc;
        if (old + 1u == (gen + 1u) * nloc) {
            __builtin_amdgcn_fence(__ATOMIC_RELEASE, "agent");
            asm volatile("s_waitcnt vmcnt(0)" ::: "memory");
            const unsigned og = xb_add(&bar[XB_TOP], 1u);
            const unsigned tg = og / nx;
            if (og + 1u == (tg + 1u) * nx) xb_add(&bar[XB_TOPGEN], 1u);
            else XB_SPIN(xb_ld(&bar[XB_TOPGEN]) == tg, bar);
            __builtin_amdgcn_fence(__ATOMIC_ACQUIRE, "agent");
            xb_add(&bar[XB_XGEN(b.x)], 1u);
            asm volatile("s_waitcnt vmcnt(0)" ::: "memory");
        } else {
            XB_SPIN(xb_ld(&bar[XB_XGEN(b.x)]) == gen, bar);
            __builtin_amdgcn_fence(__ATOMIC_ACQUIRE, "agent");
            asm volatile("s_waitcnt vmcnt(0)" ::: "memory");
        }
    }
    __syncthreads();
}

struct Args { const void* in[28]; float* out; unsigned char* ws; int ph_lo, ph_hi, pad0, pad1; };
struct Frame {
    LAS unsigned char* lds; int tid, lane, wave, vcu, G;
    const float *x_p, *x_s, *c_p, *c_s, *ck_cmp, *cv_cmp, *ck_sel, *cv_sel; const int* page_table; const float *st_kw, *st_vw, *st_pool, *rel_bias, *ada_w, *ada_b, *norm_g, *final_g,
        *w_in, *w_out, *cmp_wk, *cmp_wv, *pe_k, *pe_v, *pool_w, *pool_scale, *ffn_wg, *ffn_wu, *ffn_wd;
    float* out; unsigned char* ws;
};
__device__ __forceinline__ float wave_sum(float v) {
#pragma unroll
    for (int o = 1; o < 64; o <<= 1) v += __shfl_xor(v, o);
    return v;
}

__device__ __forceinline__ void transpose_item(const float* W, int ldw, int nvalid, bf16_t* WT, int ldt, int drow0, LAS float* scr, int k0, int n0, int lane, const float* rs = nullptr  ) {
    float tv[32];
#pragma unroll
    for (int i = 0; i < 32; ++i) { const int kk = 2 * i + (lane >> 5), n = n0 + (lane & 31); tv[i] = (n < nvalid) ? W[(size_t)(k0 + kk) * ldw + n] : 0.f; }
    if (rs) { const float rsv = rs[n0 + (lane & 31)];
#pragma unroll
        for (int i = 0; i < 32; ++i) tv[i] *= rsv; }
#pragma unroll
    for (int i = 0; i < 32; ++i) { const int kk = 2 * i + (lane >> 5); scr[kk * 33 + (lane & 31)] = tv[i]; }
    LDS_WAIT();
    const int c = lane & 7;
#pragma unroll
    for (int j = 0; j < 4; ++j) { const int n = (lane >> 3) + 8 * j; const LAS float* s = scr + (8 * c) * 33 + n;
        u32x4 o; o.x = cvtpk(s[0 * 33], s[1 * 33]); o.y = cvtpk(s[2 * 33], s[3 * 33]); o.z = cvtpk(s[4 * 33], s[5 * 33]); o.w = cvtpk(s[6 * 33], s[7 * 33]);
        *(u32x4*)(WT + (size_t)(drow0 + n) * ldt + k0 + 8 * c) = o; }
    LDS_WAIT();
}
__device__ __forceinline__ void p0_prologue(Frame& F) {
    LAS float* scr = (LAS float*)(F.lds + F.wave * 16384);
    const int gw = F.vcu * 8 + F.wave, NGW = F.G * 8, lane = F.lane;
    unsigned char* ws = F.ws;
    constexpr int I_IN = 16 * 88, I_OUT = 16 * 32, I_G = 16 * 88, I_D = 44 * 32, I_P = 4 * 8, I_C = 32 * 2;
    constexpr int NITEMS = I_IN + I_OUT + 4 * I_G + 2 * I_D + 4 * I_P + 2 * I_C;
    for (int it = gw; it < NITEMS; it += NGW) {
        int r = it;
        if (r < I_IN) { const int kb = r / 88, nb = r % 88; transpose_item(F.w_in, INCOLS, INCOLS, (bf16_t*)(ws + WS_WIN), D, nb * 32, scr, kb * 64, nb * 32, lane); continue; } r -= I_IN;
        if (r < I_OUT) { const int kb = r / 32, nb = r % 32; transpose_item(F.w_out, D, D, (bf16_t*)(ws + WS_WOUT), D, nb * 32, scr, kb * 64, nb * 32, lane); continue; } r -= I_OUT;
        if (r < 4 * I_G) { const int l = r / (2 * I_G), which = (r / I_G) & 1, q = r % I_G, kb = q / 88, nb = q % 88, n0 = nb * 32;
            const float* W = (which ? F.ffn_wu : F.ffn_wg) + (size_t)l * D * FF;
            transpose_item(W, FF, FF, (bf16_t*)(ws + WS_WGU) + (size_t)l * NGU * D, D, (n0 >> 7) * 256 + which * 128 + (n0 & 127), scr, kb * 64, n0, lane); continue; } r -= 4 * I_G;
        if (r < 2 * I_D) { const int l = r / I_D, q = r % I_D, kb = q / 32, nb = q % 32;
            transpose_item(F.ffn_wd + (size_t)l * FF * D, D, D, (bf16_t*)(ws + WS_WD) + (size_t)l * D * FF, FF, nb * 32, scr, kb * 64, nb * 32, lane); continue; } r -= 2 * I_D;
        if (r < 4 * I_P) { const int gI = r / I_P, q = r % I_P, kb = q / 8, nb = q % 8;
            transpose_item(F.pool_w + (size_t)gI * 65536, 256, 256, (bf16_t*)(ws + WS_WPOOL) + (size_t)gI * 65536, 256, nb * 32, scr, kb * 64, nb * 32, lane, F.pool_scale + gI * 256); continue; } r -= 4 * I_P;
        { const int which = r / I_C, q = r % I_C, kb = q / 2, nb = q % 2;
          transpose_item(which ? F.cmp_wv : F.cmp_wk, 64, 64, (bf16_t*)(ws + (which ? WS_WCV : WS_WCK)), 2048, nb * 32, scr, kb * 64, nb * 32, lane); }
    }
    { const int gt = (F.vcu * 8 + F.wave) * 64 + lane, NT = F.G * 512; bf16_t* sc = (bf16_t*)(ws + WS_SC);
      for (int i = gt; i < 144 * 512; i += NT) { const int row = i >> 9, c2 = (i & 511) * 2; float a = 0.f, b = 0.f;
          if (row < NMODB) { const float* cp = row < NB ? F.c_p + (size_t)row * D : F.c_s + (size_t)(row - NB) * D; const float x0 = cp[c2], x1 = cp[c2 + 1]; a = x0 * sigmoidf_(x0); b = x1 * sigmoidf_(x1); }
          *(unsigned*)(sc + (size_t)row * D + c2) = cvtpk(a, b); } }
    if (F.vcu < 16) { const int tsel = F.vcu >> 3, part = F.vcu & 7; const float* pe = tsel ? F.pe_v : F.pe_k; const float* W = tsel ? F.cmp_wv : F.cmp_wk; float sacc = 0.f;
        const int kb = part * 256 + F.wave * 32;
#pragma unroll
        for (int k = 0; k < 32; ++k) sacc += pe[kb + k] * W[(size_t)(kb + k) * 64 + lane];
        LAS float* red = (LAS float*)(F.lds + WSF_OFF);
        red[F.wave * 64 + lane] = sacc; LDS_WAIT(); __syncthreads();
        if (F.wave == 0) { float t2 = 0.f;
#pragma unroll
            for (int w = 0; w < 8; ++w) t2 += red[w * 64 + lane];
            ((float*)(ws + WS_CB))[(tsel * 8 + part) * 64 + lane] = t2; }
        __syncthreads(); }
    { const size_t gt = (size_t)(F.vcu * 8 + F.wave) * 64 + lane, NT = (size_t)F.G * 512;
      const size_t pp = (size_t)NSB * 11 * 256;
      for (size_t i = gt; i < pp; i += NT) { const size_t b = i / (11 * 256), rem = i % (11 * 256);
          ((f32x4*)(F.out + O_PLS + b * 15 * D))[rem] = ((const f32x4*)(F.st_pool + (b * 15 + 4) * D))[rem]; } }
}

__device__ __forceinline__ void p1_ada(Frame& F) {
    const int gw = F.vcu * 8 + F.wave, NGW = F.G * 8, lane = F.lane, fr = lane & 15, kq = lane >> 4;
    const bf16_t* sc = (const bf16_t*)(F.ws + WS_SC); float* mod = (float*)(F.ws + WS_MOD);
    for (int tile = F.wave < 3 ? F.vcu * 3 + F.wave : 768; tile < 768; tile += F.G * 3) {
        const int layer = tile / 384, n0 = (tile % 384) * 16;
        const float* W = F.ada_w + (size_t)layer * D * 6144 + n0 + fr;
        f32x4 acc[9];
#pragma unroll
        for (int i = 0; i < 9; ++i) acc[i] = (f32x4){0.f, 0.f, 0.f, 0.f};
#pragma unroll 4
        for (int k0 = 0; k0 < D; k0 += 32) {
            float w[8];
#pragma unroll
            for (int i = 0; i < 8; ++i) w[i] = W[(size_t)(k0 + 8 * kq + i) * 6144];
            u32x4 bw; bw.x = cvtpk(w[0], w[1]); bw.y = cvtpk(w[2], w[3]); bw.z = cvtpk(w[4], w[5]); bw.w = cvtpk(w[6], w[7]);
            const bf16x8 bfrag = __builtin_bit_cast(bf16x8, bw);
#pragma unroll
            for (int mt = 0; mt < 9; ++mt) { const bf16x8 af = *(const bf16x8*)(sc + (size_t)(mt * 16 + fr) * D + k0 + 8 * kq);
                acc[mt] = __builtin_amdgcn_mfma_f32_16x16x32_bf16(af, bfrag, acc[mt], 0, 0, 0); }
        }
        const float bias = F.ada_b[layer * 6144 + n0 + fr];
#pragma unroll
        for (int mt = 0; mt < 9; ++mt)
#pragma unroll
            for (int e = 0; e < 4; ++e) { const int row = mt * 16 + 4 * kq + e; if (row < NMODB) mod[((size_t)layer * NMODB + row) * 6144 + n0 + fr] = acc[mt][e] + bias; }
    }
}

__device__ __forceinline__ void p1_compress_sample(Frame& F) {
    const int lane = F.lane, wave = F.wave, r32 = lane & 31, hi = lane >> 5, kvl = lane >> 4, c4 = lane & 15;
    LAS unsigned char* L = F.lds;
    const int wrow = wave * 4 + kvl, total = 2 * NSB * 8;
    const int nitem = (total - F.vcu + F.G - 1) / F.G; if (nitem <= 0) return;
    const int nstage = 2 * nitem;
#define CS_BAR() do { asm volatile("s_waitcnt lgkmcnt(0)" ::: "memory"); __builtin_amdgcn_s_barrier(); asm volatile("" ::: "memory"); } while (0)
#define CS_SRC(g, ptr) do { const int it_ = F.vcu + F.G * ((g) >> 1); const int wh_ = it_ / (NSB * 8), q_ = it_ % (NSB * 8), b_ = q_ >> 3, n_ = (q_ & 7) * 8 + wave; const int pg_ = F.page_table[b_ * 16 + (n_ >> 2)]; \
        ptr = uniform_ptr((wh_ ? F.cv_cmp : F.ck_cmp) + ((size_t)pg_ * 128 + (n_ & 3) * 32 + ((g) & 1) * 16) * 256); } while (0)
#define CS_LOAD(ptr) do { _Pragma("unroll") for (int jj = 0; jj < 16; ++jj) x[jj] = *(const f32x4*)((ptr) + (unsigned)(jj * 1024 + lane * 16)); } while (0)
#define CS_STORE(buf) do { _Pragma("unroll") for (int jj = 0; jj < 16; ++jj) { u32x2 w_; w_.x = cvtpk(x[jj][0], x[jj][1]); w_.y = cvtpk(x[jj][2], x[jj][3]); \
        *(LAS u32x2*)(L + (buf) * 65536 + wrow * 2048 + (((jj * 8 + (c4 >> 1)) ^ (wrow & 15)) << 4) + (c4 & 1) * 8) = w_; } } while (0)
    f32x4 x[16]; const char* sp;
    CS_SRC(0, sp); CS_LOAD(sp); CS_STORE(0); CS_BAR();
    f32x16 a0, a1;
#pragma unroll
    for (int r = 0; r < 16; ++r) { a0[r] = 0.f; a1[r] = 0.f; }
#pragma unroll 1
    for (int g = 0; g < nstage; ++g) {
        const int it = F.vcu + F.G * (g >> 1), which = it / (NSB * 8), q = it % (NSB * 8), b = q >> 3, n0 = (q & 7) * 8;
        const bf16_t* wp = (const bf16_t*)(F.ws + (which ? WS_WCV : WS_WCK)) + (size_t)r32 * 2048 + (g & 1) * 1024 + 128 * wave + 8 * hi;
        bf16x8 bfr[16];
#pragma unroll
        for (int ks = 0; ks < 8; ++ks) { bfr[2 * ks] = *(const bf16x8*)(wp + 16 * ks); bfr[2 * ks + 1] = *(const bf16x8*)(wp + 32 * 2048 + 16 * ks); }
        if (g + 1 < nstage) { CS_SRC(g + 1, sp); CS_LOAD(sp); }
        const LAS unsigned char* ab = L + (g & 1) * 65536 + r32 * 2048;
#pragma unroll
        for (int ks = 0; ks < 8; ++ks) { const bf16x8 af = *(const LAS bf16x8*)(ab + (((16 * wave + 2 * ks + hi) ^ (r32 & 15)) << 4));
            a0 = __builtin_amdgcn_mfma_f32_32x32x16_bf16(af, bfr[2 * ks], a0, 0, 0, 0); a1 = __builtin_amdgcn_mfma_f32_32x32x16_bf16(af, bfr[2 * ks + 1], a1, 0, 0, 0); }
        CS_BAR();
        if (g & 1) {
            LAS float* red = (LAS float*)(L + 65536) + wave * 2048 + hi * 256 + r32;
#pragma unroll
            for (int r = 0; r < 16; ++r) { red[CROW0(r) * 64] = a0[r]; red[CROW0(r) * 64 + 32] = a1[r]; a0[r] = 0.f; a1[r] = 0.f; }
            CS_BAR();
            { const int row = F.tid >> 4, cc = (F.tid & 15) * 4; f32x4 sacc = (f32x4){0.f, 0.f, 0.f, 0.f};
#pragma unroll
              for (int pp = 0; pp < 8; ++pp) sacc = sacc + *(const f32x4*)((const float*)(F.ws + WS_CB) + (which * 8 + pp) * 64 + cc);
#pragma unroll
              for (int w = 0; w < 8; ++w) sacc = sacc + *(const LAS f32x4*)((const LAS float*)(L + 65536) + w * 2048 + row * 64 + cc);
              bf16_t* o = (bf16_t*)(F.ws + (which ? WS_VCMPS : WS_KCMPS)) + (size_t)b * 4 * 64 * 64 + ((size_t)(row & 3) * 64 + n0 + (row >> 2)) * 64 + cc;
              u32x2 w2; w2.x = cvtpk(sacc[0], sacc[1]); w2.y = cvtpk(sacc[2], sacc[3]); *(u32x2*)o = w2; }
        }
        if (g + 1 < nstage) CS_STORE((g + 1) & 1);
        CS_BAR();
    }
    VM_WAIT(); __syncthreads();
#undef CS_BAR
#undef CS_SRC
#undef CS_LOAD
#undef CS_STORE
}
__device__ __forceinline__ void p4_compress_prompt(Frame& F) {
    const int lane = F.lane, r32 = lane & 31, hi = lane >> 5, nl = r32 >> 2, kv = r32 & 3;
    for (int it = F.vcu; it < 2 * NB * 16; it += F.G) {
        const int which = it / (NB * 16), q = it % (NB * 16), b = q >> 4, n0 = (q & 15) * 8, n = n0 + nl;
        const bf16_t* src = (const bf16_t*)(F.ws + WS_KV) + (size_t)which * KV_STRIDE + ((size_t)b * SEQ + (size_t)n * 32) * 256 + kv * 64;
        const bf16_t* Wt = (const bf16_t*)(F.ws + (which ? WS_WCV : WS_WCK));
        const bf16_t* w0 = Wt + (size_t)r32 * 2048 + hi * 8; const bf16_t* w1 = w0 + (size_t)32 * 2048;
        f32x16 a0, a1;
#pragma unroll
        for (int r = 0; r < 16; ++r) { a0[r] = 0.f; a1[r] = 0.f; }
#pragma unroll
        for (int jj = 0; jj < 4; ++jj) { const int j = F.wave * 4 + jj;
#pragma unroll
            for (int ds = 0; ds < 4; ++ds) { const bf16x8 af = *(const bf16x8*)(src + (size_t)j * 256 + ds * 16 + hi * 8);
                const bf16x8 b0 = *(const bf16x8*)(w0 + j * 64 + ds * 16), b1 = *(const bf16x8*)(w1 + j * 64 + ds * 16);
                a0 = __builtin_amdgcn_mfma_f32_32x32x16_bf16(af, b0, a0, 0, 0, 0); a1 = __builtin_amdgcn_mfma_f32_32x32x16_bf16(af, b1, a1, 0, 0, 0); } }
        LAS float* red = (LAS float*)F.lds + F.wave * 2048 + hi * 256 + r32;
#pragma unroll
        for (int r = 0; r < 16; ++r) { red[CROW0(r) * 64] = a0[r]; red[CROW0(r) * 64 + 32] = a1[r]; }
        LDS_WAIT(); __syncthreads();
        { const int row = F.tid >> 4, c4 = (F.tid & 15) * 4; f32x4 sacc = (f32x4){0.f, 0.f, 0.f, 0.f};
#pragma unroll
          for (int pp = 0; pp < 8; ++pp) sacc = sacc + *(const f32x4*)((const float*)(F.ws + WS_CB) + (which * 8 + pp) * 64 + c4);
#pragma unroll
          for (int w = 0; w < 8; ++w) sacc = sacc + *(const LAS f32x4*)((const LAS float*)F.lds + w * 2048 + row * 64 + c4);
          bf16_t* o = (bf16_t*)(F.ws + (which ? WS_VCMPP : WS_KCMPP)) + (size_t)b * 4 * 128 * 64 + ((size_t)(row & 3) * 128 + n0 + (row >> 2)) * 64 + c4;
          u32x2 w2; w2.x = cvtpk(sacc[0], sacc[1]); w2.y = cvtpk(sacc[2], sacc[3]); *(u32x2*)o = w2; }
        __syncthreads();
    }
}

template <bool XF32>
__device__ __forceinline__ void small_gemm_res(Frame& F, const bf16_t* A  , int lda, const bf16_t* Wt, int ldb, int K, bool bd, const float* xin_s  , bf16_t* xout_s, const float* gate) {
    const int lane = F.lane, r32 = lane & 31, hi = lane >> 5, kw = K >> 3, kbeg = F.wave * kw;
    for (int tile = F.vcu; tile < 256; tile += F.G) {
        const int row0 = (tile >> 4) * 32, col0 = (tile & 15) * 64, acol = bd ? (col0 >> 8) * 256 : 0;
        const bf16_t* ap = A + (size_t)(row0 + r32) * lda + acol + kbeg + 8 * hi;
        const bf16_t* b0p = Wt + (size_t)(col0 + r32) * ldb + kbeg + 8 * hi; const bf16_t* b1p = b0p + (size_t)32 * ldb;
        f32x16 c0, c1;
#pragma unroll
        for (int r = 0; r < 16; ++r) { c0[r] = 0.f; c1[r] = 0.f; }
#pragma unroll 8
        for (int ks = 0; ks < kw; ks += 16) { const bf16x8 a = *(const bf16x8*)(ap + ks), b0 = *(const bf16x8*)(b0p + ks), b1 = *(const bf16x8*)(b1p + ks);
            c0 = __builtin_amdgcn_mfma_f32_32x32x16_bf16(a, b0, c0, 0, 0, 0); c1 = __builtin_amdgcn_mfma_f32_32x32x16_bf16(a, b1, c1, 0, 0, 0); }
        LAS float* red = (LAS float*)F.lds + F.wave * 2048 + hi * 256 + r32;
#pragma unroll
        for (int r = 0; r < 16; ++r) { red[CROW0(r) * 64] = c0[r]; red[CROW0(r) * 64 + 32] = c1[r]; }
        LDS_WAIT(); __syncthreads();
        { const int row = F.tid >> 4, c4 = (F.tid & 15) * 4; f32x4 sacc = (f32x4){0.f, 0.f, 0.f, 0.f};
#pragma unroll
          for (int w = 0; w < 8; ++w) sacc = sacc + *(const LAS f32x4*)((const LAS float*)F.lds + w * 2048 + row * 64 + c4);
          const int rs = row0 + row, col = col0 + c4, bb = NB + (rs >> 2);
          const f32x4 g4 = *(const f32x4*)(gate + (size_t)bb * 6144 + col);
          f32x4 x4;
          if constexpr (XF32) x4 = *(const f32x4*)(xin_s + (size_t)rs * D + col);
          else { const u32x2 xw = *(const u32x2*)(xout_s + (size_t)rs * D + col); x4 = (f32x4){__builtin_bit_cast(float, xw.x << 16), __builtin_bit_cast(float, xw.x & 0xffff0000u), __builtin_bit_cast(float, xw.y << 16), __builtin_bit_cast(float, xw.y & 0xffff0000u)}; }
          const f32x4 rr = x4 + g4 * sacc; u32x2 w; w.x = cvtpk(rr[0], rr[1]); w.y = cvtpk(rr[2], rr[3]); *(u32x2*)(xout_s + (size_t)rs * D + col) = w; }
        __syncthreads();
    }
}

template <int CTRL> __device__ __forceinline__ float dpp_add(float v) { return v + __uint_as_float((unsigned)__builtin_amdgcn_update_dpp(0, (int)__float_as_uint(v), CTRL, 0xF, 0xF, true)); }
__device__ __forceinline__ float wave_sum64(float v) {
    v = dpp_add<0xB1>(v); v = dpp_add<0x4E>(v); v = dpp_add<0x141>(v); v = dpp_add<0x140>(v);
    { auto rr = __builtin_amdgcn_permlane16_swap(__float_as_uint(v), __float_as_uint(v), false, false); v = __uint_as_float(rr[0]) + __uint_as_float(rr[1]); }
    { auto rr = __builtin_amdgcn_permlane32_swap(__float_as_uint(v), __float_as_uint(v), false, false); v = __uint_as_float(rr[0]) + __uint_as_float(rr[1]); }
    return v;
}
__device__ __forceinline__ f32x4 unpack_bf16x4(u32x2 w) { return (f32x4){__builtin_bit_cast(float, w.x << 16), __builtin_bit_cast(float, w.x & 0xffff0000u), __builtin_bit_cast(float, w.y << 16), __builtin_bit_cast(float, w.y & 0xffff0000u)}; }
template <int MODE, int NR>
__device__ __forceinline__ void norm_rows(Frame& F, bool from_inputs, int layer, int which, int row0, const f32x4 (&gg)[4], int lane) {
    f32x4 v[NR][4]; u32x2 xw[NR][4];
    if (from_inputs) {
        const float* xr = row0 < MP ? F.x_p + (size_t)row0 * D : F.x_s + (size_t)(row0 - MP) * D;
#pragma unroll
        for (int r = 0; r < NR; ++r)
#pragma unroll
            for (int j = 0; j < 4; ++j) v[r][j] = *(const f32x4*)(xr + (size_t)r * D + 4 * lane + 256 * j);
    } else {
        const bf16_t* xr = (const bf16_t*)(F.ws + WS_X) + (size_t)row0 * D;
#pragma unroll
        for (int r = 0; r < NR; ++r)
#pragma unroll
            for (int j = 0; j < 4; ++j) xw[r][j] = *(const u32x2*)(xr + (size_t)r * D + 4 * lane + 256 * j);
    }
#define NV(r, j) (from_inputs ? v[r][j] : unpack_bf16x4(xw[r][j]))
    f32x4 sh[4], sc[4];
    if constexpr (MODE == 0) {
        const int bb = row0 < MP ? (row0 >> 12) : NB + ((row0 - MP) >> 2);
        const float* mp = (const float*)(F.ws + WS_MOD) + ((size_t)layer * NMODB + bb) * 6144 + (which ? 3072 : 0);
#pragma unroll
        for (int j = 0; j < 4; ++j) { sh[j] = *(const f32x4*)(mp + 4 * lane + 256 * j); sc[j] = *(const f32x4*)(mp + 1024 + 4 * lane + 256 * j) + 1.0f; }
    }
    float ss[NR];
#pragma unroll
    for (int r = 0; r < NR; ++r) { float a = 0.f;
#pragma unroll
        for (int j = 0; j < 4; ++j) { const f32x4 x = NV(r, j); a += (x[0] * x[0] + x[1] * x[1]) + (x[2] * x[2] + x[3] * x[3]); }
        ss[r] = a; }
    if (!from_inputs) {
#pragma unroll
        for (int r = 0; r < NR; ++r)
#pragma unroll
            for (int j = 0; j < 4; ++j) asm volatile("" : "+v"(xw[r][j].x), "+v"(xw[r][j].y));
    }
#pragma unroll
    for (int r = 0; r < NR; ++r) ss[r] = wave_sum64(ss[r]);
#pragma unroll
    for (int r = 0; r < NR; ++r) {
        const int row = row0 + r; const float rstd = 1.0f / sqrtf(ss[r] * (1.0f / D) + 1e-6f);
        if constexpr (MODE == 2) {
            float* o = row < MP ? F.out + O_YP + (size_t)row * D : F.out + O_YS + (size_t)(row - MP) * D;
#pragma unroll
            for (int j = 0; j < 4; ++j) *(f32x4*)(o + 4 * lane + 256 * j) = NV(r, j) * rstd * gg[j];
        } else if constexpr (MODE == 1) {
            if (lane == 0) ((float*)(F.ws + WS_RSTD))[row] = rstd;
        } else {
#pragma unroll
            for (int j = 0; j < 4; ++j) { const int col = 4 * lane + 256 * j; const f32x4 h = (NV(r, j) * rstd * gg[j]) * sc[j] + sh[j];
                u32x2 w; w.x = cvtpk(h[0], h[1]); w.y = cvtpk(h[2], h[3]); *(u32x2*)((bf16_t*)(F.ws + WS_H) + (size_t)row * D + col) = w; }
        }
    }
#undef NV
}
#ifndef NRX
#define NRX 4
#endif
template <int MODE>
__device__ __forceinline__ void norm_phase(Frame& F, bool from_inputs, int layer, int which) {
    const int gw = F.vcu * 8 + F.wave, NGW = F.G * 8, lane = lane_id();
    const float* gvec = MODE == 2 ? F.final_g : F.norm_g + (size_t)(layer * 2 + which) * D;
    f32x4 gg[4];
#pragma unroll
    for (int j = 0; j < 4; ++j) gg[j] = *(const f32x4*)(gvec + 4 * lane + 256 * j);
    if (from_inputs) {
#pragma unroll 1
        for (int grp = gw; grp < MP / 4; grp += NGW) norm_rows<MODE, 4>(F, true, layer, which, grp * 4, gg, lane);
    } else {
#pragma unroll 1
        for (int grp = gw; grp < MP / NRX; grp += NGW) norm_rows<MODE, NRX>(F, false, layer, which, grp * NRX, gg, lane);
    }
#pragma unroll 1
    for (int r = gw; r < MS; r += NGW) norm_rows<MODE, 1>(F, from_inputs, layer, which, MP + r, gg, lane);
}

template <int W, int R, bool SAMPLE>
__device__ __forceinline__ void pool_chunk(const bf16_t* X, const float* rstd, f32x4 a4, f32x4 s4, const float* st_pool, bf16_t* H, float* out, int row0, int col) {
    f32x4 v[R + W - 1];
    const int t0 = SAMPLE ? 0 : (row0 & (SEQ - 1));
    u32x2 xw[R + W - 1]; float rs[R + W - 1];
#pragma unroll
    for (int k = 0; k < R + W - 1; ++k) { const int tt = t0 - (W - 1) + k;
        if (SAMPLE) { const int b = (row0 - MP) >> 2;
            if (tt >= 0) { xw[k] = *(const u32x2*)(X + (size_t)(row0 + tt) * D + col); rs[k] = rstd[row0 + tt]; }
            else v[k] = *(const f32x4*)(st_pool + ((size_t)b * 15 + 15 + tt) * D + col); }
        else if (tt >= 0) { xw[k] = *(const u32x2*)(X + (size_t)(row0 - (W - 1) + k) * D + col); rs[k] = rstd[row0 - (W - 1) + k]; }
        else { xw[k] = (u32x2){0u, 0u}; rs[k] = 0.f; } }
#pragma unroll
    for (int k = 0; k < R + W - 1; ++k) { const int tt = t0 - (W - 1) + k;
        if (SAMPLE) { if (tt >= 0) v[k] = unpack_bf16x4(xw[k]) * rs[k] * a4 + s4; }
        else v[k] = tt >= 0 ? unpack_bf16x4(xw[k]) * rs[k] * a4 + s4 : (f32x4){0.f, 0.f, 0.f, 0.f}; }
    f32x4 sacc = v[0];
#pragma unroll
    for (int k = 1; k < W; ++k) sacc = sacc + v[k];
#pragma unroll
    for (int r = 0; r < R; ++r) {
        if (r > 0) sacc = sacc + v[r + W - 1] - v[r - 1];
        const int tt = t0 + r; const float inv = 1.0f / (float)(SAMPLE ? W : (tt + 1 < W ? tt + 1 : W));
        const f32x4 cur = v[r + W - 1], pv = sacc * inv - cur;
        u32x2 w2; w2.x = cvtpk(pv[0], pv[1]); w2.y = cvtpk(pv[2], pv[3]); *(u32x2*)(H + (size_t)(row0 + r) * D + col) = w2;
        if (SAMPLE) { const int rsn = row0 - MP + r; *(f32x4*)(out + O_PLS + ((size_t)(rsn >> 2) * 15 + 11 + (rsn & 3)) * D + col) = cur; }
        else if (tt >= SEQ - 15) *(f32x4*)(out + O_PLP + ((size_t)((row0 + r) >> 12) * 15 + (tt - (SEQ - 15))) * D + col) = cur; }
}
__device__ __forceinline__ void pool_phase(Frame& F) {
    const int gt = (F.vcu * 8 + F.wave) * 64 + lane_id(), NT = F.G * 512;
    const bf16_t* X = (const bf16_t*)(F.ws + WS_X); const float* rstd = (const float*)(F.ws + WS_RSTD); bf16_t* H = (bf16_t*)(F.ws + WS_H);
    constexpr int NPI = (MP / 8) * 256, NSI = (MS / 4) * 256;
#pragma unroll 1
    for (int i = gt; i < NPI + NSI; i += NT) {
        const bool smp = i >= NPI; const int q = smp ? i - NPI : i; const int cg = q & 255, col = cg * 4, grp = cg >> 6;
        const int row0 = smp ? MP + (q >> 8) * 4 : (q >> 8) * 8, bb = smp ? NB + ((row0 - MP) >> 2) : (row0 >> 12);
        const float* mp = (const float*)(F.ws + WS_MOD) + ((size_t)NMODB + bb) * 6144;
        const f32x4 a4 = *(const f32x4*)(F.norm_g + (size_t)2 * D + col) * (*(const f32x4*)(mp + 1024 + col) + 1.0f), s4 = *(const f32x4*)(mp + col);
        if (!smp) {
            if (grp == 0) pool_chunk<2, 8, false>(X, rstd, a4, s4, F.st_pool, H, F.out, row0, col); else if (grp == 1) pool_chunk<4, 8, false>(X, rstd, a4, s4, F.st_pool, H, F.out, row0, col);
            else if (grp == 2) pool_chunk<8, 8, false>(X, rstd, a4, s4, F.st_pool, H, F.out, row0, col); else pool_chunk<16, 8, false>(X, rstd, a4, s4, F.st_pool, H, F.out, row0, col); }
        else {
            if (grp == 0) pool_chunk<2, 4, true>(X, rstd, a4, s4, F.st_pool, H, F.out, row0, col); else if (grp == 1) pool_chunk<4, 4, true>(X, rstd, a4, s4, F.st_pool, H, F.out, row0, col);
            else if (grp == 2) pool_chunk<8, 4, true>(X, rstd, a4, s4, F.st_pool, H, F.out, row0, col); else pool_chunk<16, 4, true>(X, rstd, a4, s4, F.st_pool, H, F.out, row0, col); }
    }
}

namespace att {
__device__ __forceinline__ int crow(int r, int hi) { return (r & 3) + 8 * (r >> 2) + 4 * hi; }
__device__ __forceinline__ float x32_sum(float v) { auto rr = __builtin_amdgcn_permlane32_swap(__float_as_uint(v), __float_as_uint(v), false, false); return __uint_as_float(rr[0]) + __uint_as_float(rr[1]); }
__device__ __forceinline__ float x32_max(float v) { auto rr = __builtin_amdgcn_permlane32_swap(__float_as_uint(v), __float_as_uint(v), false, false); return fmaxf(__uint_as_float(rr[0]), __uint_as_float(rr[1])); }
__device__ __forceinline__ unsigned x32_or(unsigned v) { auto rr = __builtin_amdgcn_permlane32_swap(v, v, false, false); return rr[0] | rr[1]; }
template <int X> __device__ __forceinline__ unsigned swz_xor(unsigned v) { return (unsigned)__builtin_amdgcn_ds_swizzle((int)v, (X << 10) | 0x1F); }
template <int X> __device__ __forceinline__ float swz_xorf(float v) { return __uint_as_float(swz_xor<X>(__float_as_uint(v))); }
__device__ __forceinline__ s16x4 vtr(const LAS unsigned char* p) { typedef short v4i16_t __attribute__((ext_vector_type(4))); return __builtin_bit_cast(s16x4, __builtin_amdgcn_ds_read_tr16_b64_v4i16((LAS v4i16_t*)p)); }
__device__ __forceinline__ void qk_tile(f32x16& p0, f32x16& p1, const LAS unsigned char* Kb, const bf16x8 (&qr)[4], float init, int r32, int hi) {
    f32x16 ci;
#pragma unroll
    for (int r = 0; r < 16; ++r) ci[r] = init;
    const int sw = (r32 >> 1) & 7;
    bf16x8 ka[4], kb[4];
#pragma unroll
    for (int ds = 0; ds < 4; ++ds) { const int ch = ((2 * ds + hi) ^ sw) << 4; ka[ds] = *(const LAS bf16x8*)(Kb + r32 * 128 + ch); kb[ds] = *(const LAS bf16x8*)(Kb + (32 + r32) * 128 + ch); }
    __builtin_amdgcn_s_setprio(1);
    f32x16 c0 = __builtin_amdgcn_mfma_f32_32x32x16_bf16(ka[0], qr[0], ci, 0, 0, 0);
    f32x16 c1 = __builtin_amdgcn_mfma_f32_32x32x16_bf16(kb[0], qr[0], ci, 0, 0, 0);
#pragma unroll
    for (int ds = 1; ds < 4; ++ds) {
        c0 = __builtin_amdgcn_mfma_f32_32x32x16_bf16(ka[ds], qr[ds], c0, 0, 0, 0);
        c1 = __builtin_amdgcn_mfma_f32_32x32x16_bf16(kb[ds], qr[ds], c1, 0, 0, 0);
    }
    __builtin_amdgcn_s_setprio(0);
    p0 = c0; p1 = c1;
}
__device__ __forceinline__ void pv_tile(f32x16 (&o)[2], const LAS unsigned char* Vb, const f32x16& p0, const f32x16& p1, int lane) {
    const int g4 = lane >> 4, nhalf = g4 & 1, h = g4 >> 1, i = lane & 15, q = i >> 2, pp = i & 3;
    const LAS unsigned char* vb = Vb + (4 * h + q) * 64 + nhalf * 32 + pp * 8;
#pragma unroll
    for (int kh = 0; kh < 2; ++kh) {
        s16x4 lo[2][2], hh[2][2];
#pragma unroll
        for (int s = 0; s < 2; ++s)
#pragma unroll
            for (int db = 0; db < 2; ++db) { lo[s][db] = vtr(vb + db * 4096 + (32 * kh + 16 * s) * 64); hh[s][db] = vtr(vb + db * 4096 + (32 * kh + 16 * s + 8) * 64); }
#pragma unroll
        for (int s = 0; s < 2; ++s) {
            const f32x16& p = kh ? p1 : p0; u32x4 pw;
            pw.x = cvtpk(p[8 * s + 0], p[8 * s + 1]); pw.y = cvtpk(p[8 * s + 2], p[8 * s + 3]); pw.z = cvtpk(p[8 * s + 4], p[8 * s + 5]); pw.w = cvtpk(p[8 * s + 6], p[8 * s + 7]);
            const bf16x8 pa = __builtin_bit_cast(bf16x8, pw);
#pragma unroll
            for (int db = 0; db < 2; ++db) {
                const bf16x8 vf = (bf16x8){lo[s][db][0], lo[s][db][1], lo[s][db][2], lo[s][db][3], hh[s][db][0], hh[s][db][1], hh[s][db][2], hh[s][db][3]};
                o[db] = __builtin_amdgcn_mfma_f32_32x32x16_bf16(pa, vf, o[db], 0, 0, 0);
            }
        }
    }
}
__device__ __forceinline__ void row_scale(f32x16 (&o)[2], float f, LAS float* wsf, int r32, int hi) {
    if (hi == 0) wsf[r32] = f;
    LDS_WAIT();
    const LAS float* wh = wsf + 4 * hi;
#pragma unroll
    for (int r = 0; r < 16; ++r) { const float fr = wh[CROW0(r)]; o[0][r] *= fr; o[1][r] *= fr; }
    LDS_WAIT();
}
__device__ __forceinline__ void row_fma(f32x16 (&dst)[2], const f32x16 (&o)[2], float f, LAS float* wsf, int r32, int hi) {
    if (hi == 0) wsf[r32] = f;
    LDS_WAIT();
    const LAS float* wh = wsf + 4 * hi;
#pragma unroll
    for (int r = 0; r < 16; ++r) { const float fr = wh[CROW0(r)]; dst[0][r] += fr * o[0][r]; dst[1][r] += fr * o[1][r]; }
    LDS_WAIT();
}
__device__ __forceinline__ void softmax_update(f32x16& p0, f32x16& p1, float& m, float& l, f32x16 (&o)[2], LAS float* wsf, int r32, int hi) {
    float rm = fmaxf(p0[0], p1[0]);
#pragma unroll
    for (int r = 1; r < 16; ++r) rm = fmaxf(rm, fmaxf(p0[r], p1[r]));
    rm = x32_max(rm);
    const float mn = fmaxf(m, rm), f = ex2(m - mn);
    m = mn; float s = 0.f;
#pragma unroll
    for (int r = 0; r < 16; ++r) { p0[r] = ex2(p0[r] - mn); p1[r] = ex2(p1[r] - mn); s += p0[r] + p1[r]; }
    l = l * f + s;
    if (__any(f != 1.0f)) row_scale(o, f, wsf, r32, hi);
}
__device__ __forceinline__ void softmax_full(f32x16& a0, f32x16& a1, f32x16& b0, f32x16& b1) {
    float rm = -1e30f;
#pragma unroll
    for (int r = 0; r < 16; ++r) rm = fmaxf(rm, fmaxf(fmaxf(a0[r], a1[r]), fmaxf(b0[r], b1[r])));
    rm = x32_max(rm); float s = 0.f;
#pragma unroll
    for (int r = 0; r < 16; ++r) { a0[r] = ex2(a0[r] - rm); a1[r] = ex2(a1[r] - rm); b0[r] = ex2(b0[r] - rm); b1[r] = ex2(b1[r] - rm); s += (a0[r] + a1[r]) + (b0[r] + b1[r]); }
    s = x32_sum(s);
    const float inv = s > 0.f ? 1.0f / s : 0.f;
#pragma unroll
    for (int r = 0; r < 16; ++r) { a0[r] *= inv; a1[r] *= inv; b0[r] *= inv; b1[r] *= inv; }
}
__device__ __forceinline__ unsigned imp_key(float v, int j, int c) {
    const bool forced = (j == 0) | (j == c) | (j == c - 1);
    const unsigned base = forced ? 0x7F000000u : (j <= c ? (__float_as_uint(v) & 0xFFFFFFC0u) : 0u);
    return base | (unsigned)(63 - j);
}
__device__ __forceinline__ void imp_store(const f32x16& p0, const f32x16& p1, int T, LAS unsigned* impq  , int c, int g, int hi) {
#pragma unroll
    for (int kh = 0; kh < 2; ++kh)
#pragma unroll
        for (int a = 0; a < 4; ++a) {
            const f32x16& p = kh ? p1 : p0; float e0 = p[4 * a] + p[4 * a + 1], e1 = p[4 * a + 2] + p[4 * a + 3];
            e0 += swz_xorf<8>(e0); e0 += swz_xorf<16>(e0); e1 += swz_xorf<8>(e1); e1 += swz_xorf<16>(e1);
            const int jc = 32 * T + 16 * kh + 4 * a, j0 = jc + 2 * hi;
            if (g == 0) { u32x2 w; w.x = imp_key(e0, j0, c); w.y = imp_key(e1, j0 + 1, c); *(LAS u32x2*)(impq + 2 * hi + jc) = w; }
        }
}
__device__ __forceinline__ unsigned long long select_mask(const LAS unsigned* impq, int g, int hi, int nq4 = 16) {
    LDS_WAIT();
    unsigned mk[8], cnt[8];
#pragma unroll
    for (int a = 0; a < 4; ++a) { const u32x2 w = *(const LAS u32x2*)(impq + (16 * g + 2 * hi) + 4 * a); mk[2 * a] = w.x; mk[2 * a + 1] = w.y; cnt[2 * a] = 0; cnt[2 * a + 1] = 0; }
#pragma unroll 4
    for (int jj = 0; jj < nq4; ++jj) { const u32x4 kx = *(const LAS u32x4*)(impq + 4 * jj);
#pragma unroll
        for (int ci = 0; ci < 8; ++ci) cnt[ci] += (unsigned)(kx.x > mk[ci]) + (unsigned)(kx.y > mk[ci]) + (unsigned)(kx.z > mk[ci]) + (unsigned)(kx.w > mk[ci]); }
    unsigned lb = 0u;
#pragma unroll
    for (int a = 0; a < 4; ++a)
#pragma unroll
        for (int e = 0; e < 2; ++e) lb |= (cnt[2 * a + e] < 16u ? 1u : 0u) << (4 * a + e);
    const unsigned long long mm = (unsigned long long)lb << (16 * g + 2 * hi);
    unsigned lo = (unsigned)mm, hh = (unsigned)(mm >> 32);
    lo |= swz_xor<8>(lo); hh |= swz_xor<8>(hh); lo |= swz_xor<16>(lo); hh |= swz_xor<16>(hh); lo = x32_or(lo); hh = x32_or(hh);
    return ((unsigned long long)hh << 32) | lo;
}
__device__ __forceinline__ unsigned long long wave_or64(unsigned long long m) {
    unsigned lo = (unsigned)m, hh = (unsigned)(m >> 32);
    lo |= swz_xor<1>(lo); hh |= swz_xor<1>(hh); lo |= swz_xor<2>(lo); hh |= swz_xor<2>(hh); lo |= swz_xor<4>(lo); hh |= swz_xor<4>(hh);
    lo |= swz_xor<8>(lo); hh |= swz_xor<8>(hh); lo |= swz_xor<16>(lo); hh |= swz_xor<16>(hh); lo = x32_or(lo); hh = x32_or(hh);
    return ((unsigned long long)(unsigned)__builtin_amdgcn_readfirstlane(hh) << 32) | (unsigned)__builtin_amdgcn_readfirstlane(lo);
}
__device__ __forceinline__ void mask_bias(f32x16& p0, f32x16& p1, int t, int pos0, int stride, int wlim, bool sel, bool near, const LAS float* lut, int hi) {
#pragma unroll
    for (int kh = 0; kh < 2; ++kh)
#pragma unroll
        for (int r = 0; r < 16; ++r) { const int kk = 32 * kh + crow(r, hi), dist = t - pos0 - stride * kk; const bool ok = sel && dist >= 0 && dist < wlim;
            float bv = 0.f; if (near) { const int di = dist < 0 ? 0 : (dist > 127 ? 127 : dist); bv = lut[di]; }
            if (kh) p1[r] = ok ? p1[r] + bv : -INFINITY; else p0[r] = ok ? p0[r] + bv : -INFINITY; }
}
template <bool CAUSAL>
__device__ __forceinline__ void mask_bias_near(f32x16& p0, f32x16& p1, int t, int pos0, bool sel, const LAS float* xlg, int hi) {
    const int dist0 = t - pos0 - 4 * hi;
    const LAS float* bp = xlg + (dist0 + 4);
#pragma unroll
    for (int kh = 0; kh < 2; ++kh)
#pragma unroll
        for (int r = 0; r < 16; ++r) { const int kc = 32 * kh + CROW0(r); const float bv = bp[63 - kc]; bool ok = sel; if (CAUSAL) ok = ok && (dist0 - kc >= 0);
            if (kh) p1[r] = ok ? p1[r] + bv : -INFINITY; else p0[r] = ok ? p0[r] + bv : -INFINITY; }
}
struct Ptrs { const bf16_t *Q, *kcp, *vcp, *kcs, *vcs, *KS, *VS, *KW, *VW; const float* gates; bf16_t* O; const float *ck_sel, *cv_sel, *st_kw, *st_vw; const int* pt; int gov; float* kw_out; float* vw_out; };
#ifdef VERIFY
#define GATEV(P, row, head, br) ((P).gov < 0 ? sigmoidf_((P).gates[(size_t)(row) * 48 + (head) * 3 + (br)]) : ((P).gov == (br) ? 1.0f : 0.0f))
#else
#define GATEV(P, row, head, br) sigmoidf_((P).gates[(size_t)(row) * 48 + (head) * 3 + (br)])
#endif

template <bool ACC>
__device__ __forceinline__ void row_out(LAS float* ow, const f32x16 (&o)[2], float f, LAS float* wsf, int r32, int hi) {
    if (hi == 0) wsf[r32] = f;
    LDS_WAIT();
    const LAS float* wh = wsf + 4 * hi; LAS float* ob = ow + hi * 256 + r32;
#pragma unroll
    for (int r = 0; r < 16; ++r) { const float fr = wh[CROW0(r)]; LAS float* p = ob + CROW0(r) * 64;
        if (ACC) { p[0] += fr * o[0][r]; p[32] += fr * o[1][r]; } else { p[0] = fr * o[0][r]; p[32] = fr * o[1][r]; } }
    LDS_WAIT();
}
template <bool NEXT>
__device__ __forceinline__ void tile_block(f32x16& s0, f32x16& s1, f32x16& n0, f32x16& n1, const LAS unsigned char* KBn, float ninit, const LAS unsigned char* VB, const bf16x8 (&qr)[4],
                                           float m, float& l, f32x16 (&o)[2], int lane, int r32, int hi) {
    if (NEXT) qk_tile(n0, n1, KBn, qr, ninit, r32, hi);
    float sacc = 0.f;
#pragma unroll
    for (int r = 0; r < 16; ++r) { s0[r] = ex2(s0[r] - m); s1[r] = ex2(s1[r] - m); sacc += s0[r] + s1[r]; }
    l += sacc;
    pv_tile(o, VB, s0, s1, lane);
}
#define AS_SBAR() __builtin_amdgcn_sched_barrier(0)
#define AS_PIN(x) asm volatile("" : "+v"(x))
#define AS_MFMA(a, b, c) __builtin_amdgcn_mfma_f32_32x32x16_bf16(a, b, c, 0, 0, 0)
#define AS_WAIT_BAR(N) asm volatile("s_waitcnt vmcnt(" #N ") lgkmcnt(0)\n\ts_barrier" ::: "memory")
#define AS_MX3(a, b, c) __builtin_fmaxf(__builtin_fmaxf((a), (b)), (c))
__device__ __forceinline__ void as_glds16(const void* gsrc, unsigned lds_base) {
    unsigned sv; asm volatile("s_mov_b32 %0, m0\n\ts_mov_b32 m0, %2\n\ts_nop 0\n\tglobal_load_lds_dwordx4 %1, off\n\ts_mov_b32 m0, %0" : "=&s"(sv) : "v"(gsrc), "s"(lds_base) : "memory"); }
__device__ __forceinline__ void as_kload2(bf16x8* kf, const LAS unsigned char* kp, int d0) { kf[2 * d0] = *(const LAS bf16x8*)(kp + d0 * 2048); kf[2 * d0 + 1] = *(const LAS bf16x8*)(kp + d0 * 2048 + 512); }
__device__ __forceinline__ float as_rowmax(const f32x16& p0, const f32x16& p1) {
    float a = AS_MX3(p0[0], p0[1], p1[0]), b = AS_MX3(p0[2], p0[3], p1[1]); a = AS_MX3(a, p1[2], p1[3]);
#pragma unroll
    for (int r = 4; r < 16; r += 4) { a = AS_MX3(a, p0[r], p0[r + 1]); b = AS_MX3(b, p0[r + 2], p0[r + 3]); a = AS_MX3(a, p1[r], p1[r + 1]); b = AS_MX3(b, p1[r + 2], p1[r + 3]); }
    return x32_max(__builtin_fmaxf(a, b)); }
__device__ __forceinline__ float as_mask(f32x16& c0, f32x16& c1, int u, int nsel, int nwin, int c, int t, unsigned long long mymask, float bfar, const LAS float* xlg, const LAS float* lut, int hi) {
    if (u >= nsel + nwin) {
#pragma unroll
        for (int r = 0; r < 16; ++r) { c0[r] = -INFINITY; c1[r] = -INFINITY; }
        return 0.f; }
    const bool win = u >= nsel; const int j = win ? c - nwin + 1 + (u - nsel) : u;
    const bool sel = win || ((mymask >> j) & 1ull);
    if (j >= c - 2) { if (j == c) mask_bias_near<true>(c0, c1, t, 64 * j, sel, xlg, hi); else mask_bias_near<false>(c0, c1, t, 64 * j, sel, xlg, hi); return 0.f; }
    if (win) { if (j == c - 8) mask_bias(c0, c1, t, 64 * j, 1, 512, true, false, lut, hi); }
    else {
#pragma unroll
        for (int r = 0; r < 16; ++r) { c0[r] = sel ? c0[r] : -INFINITY; c1[r] = sel ? c1[r] : -INFINITY; } }
    return bfar;
}
__device__ __forceinline__ void attn_stream(const bf16_t* ksb, const bf16_t* vsb, const bf16_t* kwb, const bf16_t* vwb  , int nsel, int nwin, int NT, int c, int t,
                                            unsigned long long mymask, const bf16x8 (&qr)[4], float bfar, const LAS float* xlg, const LAS float* lut, float gate1, float gate2,
                                            LAS unsigned char* L, LAS float* wsf, LAS float* ow, int wave, int lane) {
    constexpr int SLOTB = 8192, LDS_K = 0, LDS_V = 3 * SLOTB;
    const int r32 = lane & 31, hi = lane >> 5;
    const unsigned lds0 = (unsigned)(unsigned long long)L;
    const int nreal = nsel + nwin;
    const unsigned klo = (unsigned)lane * 256 + wave * 8, vlo_ = (unsigned)(16 * (wave & 3) + (lane >> 2)) * 256 + (wave >> 2) * 32 + (lane & 3) * 8;
    const unsigned kdst = lds0 + LDS_K + wave * 1024, vdst = lds0 + LDS_V + wave * 1024;
#define AS_UT(u) ((u) < nreal ? (u) : nreal - 1)
#define AS_JB(u) (AS_UT(u) < nsel ? AS_UT(u) : c - nwin + 1 + (AS_UT(u) - nsel))
#define AS_DMA_K(u, slot) as_glds16((AS_UT(u) < nsel ? ksb : kwb) + klo + (size_t)AS_JB(u) * (64 * 256), (unsigned)__builtin_amdgcn_readfirstlane((int)(kdst + (slot))))
#define AS_DMA_V(u, slot) as_glds16((AS_UT(u) < nsel ? vsb : vwb) + vlo_ + (size_t)AS_JB(u) * (64 * 256), (unsigned)__builtin_amdgcn_readfirstlane((int)(vdst + (slot))))
    const LAS unsigned char* vp0 = L + LDS_V + ((lane >> 4) & 1) * 32 + (lane & 3) * 8 + (4 * hi + ((lane & 15) >> 2)) * 64;
    const LAS unsigned char* kp0 = L + LDS_K + hi * 1024 + r32 * 16;
    AS_DMA_K(0, 0); AS_DMA_V(0, 0); AS_DMA_K(1, SLOTB); AS_DMA_K(2, 2 * SLOTB);
    float mhat = 0.f, l_reg = 0.f, l_sel = 0.f; f32x16 o[2];
#pragma unroll
    for (int r = 0; r < 16; ++r) { o[0][r] = 0.f; o[1][r] = 0.f; }
    const f32x16 zero16 = {0.f, 0.f, 0.f, 0.f, 0.f, 0.f, 0.f, 0.f, 0.f, 0.f, 0.f, 0.f, 0.f, 0.f, 0.f, 0.f};
    bool resc = false, bnd = false;
    f32x16 pA0, pA1, pB0, pB1; bf16x8 kf[8]; s16x4 vlo[8], vhi[8]; u32x4 pw0, pw1, pw2, pw3;
    int sl_prev = 0, sl_cur = 0, sl_next = SLOTB;
#define AS_ROT() do { sl_prev = sl_cur; sl_cur = sl_next; sl_next = (sl_next == 2 * SLOTB) ? 0 : sl_next + SLOTB; } while (0)
#define AS_EX(v) __builtin_amdgcn_exp2f((v) + nmh)
#define AS_RESC() do { if (resc) { const LAS float* wh_ = wsf + 4 * hi; _Pragma("unroll") for (int d_ = 0; d_ < 2; ++d_) _Pragma("unroll") for (int r = 0; r < 16; ++r) o[d_][r] *= wh_[CROW0(r)]; } } while (0)
#define AS_BND() do { if (bnd) { const float lt_ = x32_sum(l_sel); row_out<true>(ow, o, lt_ > 0.f ? gate1 / lt_ : 0.f, wsf, r32, hi); _Pragma("unroll") for (int r = 0; r < 16; ++r) { o[0][r] = 0.f; o[1][r] = 0.f; } bnd = false; } } while (0)
    AS_WAIT_BAR(3);
#pragma unroll
    for (int d0 = 0; d0 < 4; ++d0) as_kload2(kf, kp0, d0);
    pA0 = AS_MFMA(kf[0], qr[0], zero16); pA1 = AS_MFMA(kf[1], qr[0], zero16); pA0 = AS_MFMA(kf[2], qr[1], pA0); pA1 = AS_MFMA(kf[3], qr[1], pA1);
    pA0 = AS_MFMA(kf[4], qr[2], pA0); pA1 = AS_MFMA(kf[5], qr[2], pA1); pA0 = AS_MFMA(kf[6], qr[3], pA0); pA1 = AS_MFMA(kf[7], qr[3], pA1);
    { const float bc = as_mask(pA0, pA1, 0, nsel, nwin, c, t, mymask, bfar, xlg, lut, hi);
      const float rm = as_rowmax(pA0, pA1) + bc; mhat = __builtin_fmaxf(rm, -60.f); const float nmh = bc - mhat;
#pragma unroll
      for (int r = 0; r < 16; ++r) { pA0[r] = AS_EX(pA0[r]); pA1[r] = AS_EX(pA1[r]); } }
    AS_WAIT_BAR(0);
    AS_DMA_K(3, 0); AS_DMA_V(1, SLOTB); AS_ROT();
#pragma unroll
    for (int d0 = 0; d0 < 4; ++d0) as_kload2(kf, kp0 + sl_cur, d0);
    AS_WAIT_BAR(2);
#define AS_PKW(P, i) cvtpk(P[i], P[i + 1])
#define AS_PAF(k) __builtin_bit_cast(bf16x8, pw##k)
#define AS_VFR(i) (bf16x8){vlo[i][0], vlo[i][1], vlo[i][2], vlo[i][3], vhi[i][0], vhi[i][1], vhi[i][2], vhi[i][3]}
#define AS_VRD(i) do { vlo[i] = vtr(vp_ + (((i) >> 2) * 4096 + ((i) & 3) * 1024)); vhi[i] = vtr(vp_ + (((i) >> 2) * 4096 + ((i) & 3) * 1024 + 512)); } while (0)
#define AS_KRD(G, d0) do { if (G) { as_kload2(kf, kp0 + sl_next, d0); AS_SBAR(); } } while (0)
#define AS_GAPA(MF, a0, a1, a2, a3, W0, W1, PW) do { MF; sacc += a0; sacc += a1; sacc += a2; sacc += a3; W0; W1; AS_PIN(PW); AS_PIN(sacc); AS_SBAR(); } while (0)
#define AS_GAPB(MF, X, i) do { MF; X[i] = AS_EX(X[i]); X[i + 1] = AS_EX(X[i + 1]); X[i + 2] = AS_EX(X[i + 2]); X[i + 3] = AS_EX(X[i + 3]); AS_PIN(X); AS_SBAR(); } while (0)
#define AS_STEP(C0, C1, P0, P1, tt, MASK, GK, GV, GL) do { AS_SBAR(); \
    const LAS unsigned char* vp_ = vp0 + sl_prev; \
    AS_VRD(0); AS_SBAR(); float sacc = P0[0] + P0[1]; \
                    AS_GAPA(C0 = AS_MFMA(kf[0], qr[0], zero16), P0[2], P0[3], P0[4], P0[5],     pw0[0] = AS_PKW(P0, 0),  pw0[1] = AS_PKW(P0, 2),  pw0); \
    AS_VRD(4); AS_SBAR(); AS_GAPA(C1 = AS_MFMA(kf[1], qr[0], zero16), P0[6], P0[7], P0[8], P0[9],     pw0[2] = AS_PKW(P0, 4),  pw0[3] = AS_PKW(P0, 6),  pw0); \
    AS_VRD(1); AS_SBAR(); AS_GAPA(C0 = AS_MFMA(kf[2], qr[1], C0),    P0[10], P0[11], P0[12], P0[13], pw1[0] = AS_PKW(P0, 8),  pw1[1] = AS_PKW(P0, 10), pw1); \
    AS_VRD(5); AS_SBAR(); AS_GAPA(C1 = AS_MFMA(kf[3], qr[1], C1),    P0[14], P0[15], P1[0], P1[1],   pw1[2] = AS_PKW(P0, 12), pw1[3] = AS_PKW(P0, 14), pw1); \
    AS_VRD(2); AS_SBAR(); AS_GAPA(C0 = AS_MFMA(kf[4], qr[2], C0),    P1[2], P1[3], P1[4], P1[5],     pw2[0] = AS_PKW(P1, 0),  pw2[1] = AS_PKW(P1, 2),  pw2); \
    AS_VRD(6); AS_SBAR(); AS_GAPA(C1 = AS_MFMA(kf[5], qr[2], C1),    P1[6], P1[7], P1[8], P1[9],     pw2[2] = AS_PKW(P1, 4),  pw2[3] = AS_PKW(P1, 6),  pw2); \
    AS_VRD(3); AS_SBAR(); AS_GAPA(C0 = AS_MFMA(kf[6], qr[3], C0),    P1[10], P1[11], P1[12], P1[13], pw3[0] = AS_PKW(P1, 8),  pw3[1] = AS_PKW(P1, 10), pw3); \
    AS_VRD(7); AS_SBAR(); AS_GAPA(C1 = AS_MFMA(kf[7], qr[3], C1),    P1[14], P1[15], 0.f, 0.f,       pw3[2] = AS_PKW(P1, 12), pw3[3] = AS_PKW(P1, 14), pw3); \
    l_reg += sacc; \
    if (GK) AS_DMA_K((tt) + 3, sl_cur); if (GV) AS_DMA_V((tt) + 1, sl_next); \
    float bc_ = bfar; bool sel_ = true; \
    if (MASK) bc_ = as_mask(C0, C1, (tt), nsel, nwin, c, t, mymask, bfar, xlg, lut, hi); \
    else sel_ = (mymask >> (tt)) & 1ull;                             \
    if (MASK && (tt) == nsel) { l_sel = l_reg; l_reg = 0.f; mhat = __builtin_fmaxf(as_rowmax(C0, C1) + bc_, -60.f); resc = false; bnd = true; }     \
    else { const float rm = as_rowmax(C0, C1) + bc_ - mhat; resc = false; \
      if (__builtin_expect(__any(rm > 8.0f), 0)) { const float dl = __builtin_fmaxf(rm, 0.f); mhat += dl; \
          const float f = __builtin_amdgcn_exp2f(-dl); l_reg *= f; if (hi == 0) wsf[r32] = f; resc = true; } } \
    const float nmh = sel_ ? bc_ - mhat : -INFINITY; AS_SBAR(); \
    AS_GAPB(o[0] = AS_MFMA(AS_PAF(0), AS_VFR(0), o[0]), C0, 0);              AS_GAPB(o[1] = AS_MFMA(AS_PAF(0), AS_VFR(4), o[1]), C0, 4); \
    AS_KRD(GL, 0); AS_GAPB(o[0] = AS_MFMA(AS_PAF(1), AS_VFR(1), o[0]), C0, 8);  AS_KRD(GL, 1); AS_GAPB(o[1] = AS_MFMA(AS_PAF(1), AS_VFR(5), o[1]), C0, 12); \
    AS_KRD(GL, 2); AS_GAPB(o[0] = AS_MFMA(AS_PAF(2), AS_VFR(2), o[0]), C1, 0);  AS_KRD(GL, 3); AS_GAPB(o[1] = AS_MFMA(AS_PAF(2), AS_VFR(6), o[1]), C1, 4); \
    AS_GAPB(o[0] = AS_MFMA(AS_PAF(3), AS_VFR(3), o[0]), C1, 8);              AS_GAPB(o[1] = AS_MFMA(AS_PAF(3), AS_VFR(7), o[1]), C1, 12); \
    } while (0)
    int tt = 1;
    for (; tt + 1 < nsel - 3; tt += 2) {
        AS_STEP(pB0, pB1, pA0, pA1, tt, false, true, true, true);     AS_WAIT_BAR(2); AS_RESC(); AS_ROT();
        AS_STEP(pA0, pA1, pB0, pB1, tt + 1, false, true, true, true); AS_WAIT_BAR(2); AS_RESC(); AS_ROT();
    }
#define AS_ENDW(x) do { if ((x) + 3 < NT) { AS_WAIT_BAR(2); } else if ((x) + 2 < NT) { AS_WAIT_BAR(1); } else { AS_WAIT_BAR(0); } } while (0)
    for (; tt + 1 < NT; tt += 2) {
        AS_STEP(pB0, pB1, pA0, pA1, tt, true, (tt + 3 < NT), (tt + 1 < NT), (tt + 1 < NT));         AS_ENDW(tt);     AS_RESC(); AS_BND(); AS_ROT();
        AS_STEP(pA0, pA1, pB0, pB1, tt + 1, true, (tt + 4 < NT), (tt + 2 < NT), (tt + 2 < NT));     AS_ENDW(tt + 1); AS_RESC(); AS_BND(); AS_ROT();
    }
    AS_STEP(pB0, pB1, pA0, pA1, NT - 1, true, false, false, false); AS_RESC(); AS_BND();
    { float sacc = pB0[0] + pB0[1];
#pragma unroll
      for (int r = 2; r < 16; ++r) sacc += pB0[r];
#pragma unroll
      for (int r = 0; r < 16; ++r) sacc += pB1[r];
      l_reg += sacc;
      pw0 = (u32x4){AS_PKW(pB0, 0), AS_PKW(pB0, 2), AS_PKW(pB0, 4), AS_PKW(pB0, 6)}; pw1 = (u32x4){AS_PKW(pB0, 8), AS_PKW(pB0, 10), AS_PKW(pB0, 12), AS_PKW(pB0, 14)};
      pw2 = (u32x4){AS_PKW(pB1, 0), AS_PKW(pB1, 2), AS_PKW(pB1, 4), AS_PKW(pB1, 6)}; pw3 = (u32x4){AS_PKW(pB1, 8), AS_PKW(pB1, 10), AS_PKW(pB1, 12), AS_PKW(pB1, 14)};
      const LAS unsigned char* vp_ = vp0 + sl_cur;
#pragma unroll
      for (int i = 0; i < 8; ++i) AS_VRD(i);
      o[0] = AS_MFMA(AS_PAF(0), AS_VFR(0), o[0]); o[1] = AS_MFMA(AS_PAF(0), AS_VFR(4), o[1]); o[0] = AS_MFMA(AS_PAF(1), AS_VFR(1), o[0]); o[1] = AS_MFMA(AS_PAF(1), AS_VFR(5), o[1]);
      o[0] = AS_MFMA(AS_PAF(2), AS_VFR(2), o[0]); o[1] = AS_MFMA(AS_PAF(2), AS_VFR(6), o[1]); o[0] = AS_MFMA(AS_PAF(3), AS_VFR(3), o[0]); o[1] = AS_MFMA(AS_PAF(3), AS_VFR(7), o[1]); }
    { const float lt = x32_sum(l_reg); const float f = lt > 0.f ? gate2 / lt : 0.f; row_out<true>(ow, o, f, wsf, r32, hi); }
    asm volatile("s_waitcnt lgkmcnt(0)\n\ts_barrier" ::: "memory");
#undef AS_UT
#undef AS_JB
#undef AS_DMA_K
#undef AS_DMA_V
#undef AS_ROT
#undef AS_EX
#undef AS_RESC
#undef AS_BND
#undef AS_PKW
#undef AS_PAF
#undef AS_VFR
#undef AS_VRD
#undef AS_KRD
#undef AS_GAPA
#undef AS_GAPB
#undef AS_STEP
#undef AS_ENDW
}

__device__ __forceinline__ void prompt_unit(const Ptrs& P, LAS unsigned char* L, int b, int kv, int c, int tid, int wave, int lane) {
    asm volatile("" : "+v"(lane), "+v"(tid));
    const int r32 = lane & 31, hi = lane >> 5, g = r32 >> 3, qi = r32 & 7, head = kv * 4 + g;
    const int t = c * 64 + wave * 8 + qi; const unsigned row = (unsigned)b * SEQ + t;
    bf16x8 qr[4];
#pragma unroll
    for (int ds = 0; ds < 4; ++ds) qr[ds] = *(const bf16x8*)(P.Q + (size_t)row * D + head * 64 + ds * 16 + hi * 8);
    const LAS float* lut = (const LAS float*)(L + LUT_OFF) + head * 128; const float bfar = lut[127];
    LAS float* wsf = (LAS float*)(L + WSF_OFF) + wave * 32;
    LAS float* ow = (LAS float*)(L + 65536 + wave * 8192);
    LAS unsigned* impq = (LAS unsigned*)(L + IMP_OFF) + wave * 512 + qi * 64;
    const int skey = tid >> 3, sch = tid & 7;
    const int kwoff = skey * 128 + ((sch ^ ((skey >> 1) & 7)) << 4), vwoff = (sch >> 2) * 4096 + skey * 64 + (sch & 3) * 16;
    LAS unsigned char* KB0 = L; LAS unsigned char* VB0 = L + 32768;
    { const unsigned co = ((unsigned)(b * 4 + kv) * 128 + skey) * 64 + sch * 8;
      const u32x4 k0 = *(const u32x4*)(P.kcp + co), k1 = *(const u32x4*)(P.kcp + co + 4096), v0 = *(const u32x4*)(P.vcp + co), v1 = *(const u32x4*)(P.vcp + co + 4096);
      *(LAS u32x4*)(KB0 + kwoff) = k0; *(LAS u32x4*)(KB0 + 8192 + kwoff) = k1; *(LAS u32x4*)(VB0 + vwoff) = v0; *(LAS u32x4*)(VB0 + 8192 + vwoff) = v1; }
    const int nwin = (c < 8 ? c : 8) + 1;
    __syncthreads();
    f32x16 o[2];
#pragma unroll
    for (int r = 0; r < 16; ++r) { o[0][r] = 0.f; o[1][r] = 0.f; }
    unsigned long long mymask = ~0ull;
    if (c <= 30) {
        f32x16 a0, a1; qk_tile(a0, a1, KB0, qr, 0.f, r32, hi); mask_bias(a0, a1, t, 31, 32, 1 << 30, true, true, lut, hi);
        float rm = fmaxf(a0[0], a1[0]);
#pragma unroll
        for (int r = 1; r < 16; ++r) rm = fmaxf(rm, fmaxf(a0[r], a1[r]));
        rm = fmaxf(x32_max(rm), -1e30f); float sacc = 0.f;
#pragma unroll
        for (int r = 0; r < 16; ++r) { a0[r] = ex2(a0[r] - rm); a1[r] = ex2(a1[r] - rm); sacc += a0[r] + a1[r]; }
        sacc = x32_sum(sacc); const float cinv = sacc > 0.f ? 1.0f / sacc : 0.f;
#pragma unroll
        for (int r = 0; r < 16; ++r) { a0[r] *= cinv; a1[r] *= cinv; }
        if (c >= 16) { imp_store(a0, a1, 0, impq, c, g, hi);
            if (g == 0) {
#pragma unroll
                for (int q8 = 0; q8 < 8; ++q8) { const int jc = 32 + 4 * q8; u32x2 w; w.x = imp_key(0.f, jc + 2 * hi, c); w.y = imp_key(0.f, jc + 2 * hi + 1, c); *(LAS u32x2*)(impq + 2 * hi + jc) = w; } } }
        pv_tile(o, VB0, a0, a1, lane);
    } else {
        f32x16 a0, a1, b0, b1;
        qk_tile(a0, a1, KB0, qr, 0.f, r32, hi); mask_bias(a0, a1, t, 31, 32, 1 << 30, true, true, lut, hi);
        qk_tile(b0, b1, KB0 + 8192, qr, 0.f, r32, hi); mask_bias(b0, b1, t, 31 + 2048, 32, 1 << 30, true, true, lut, hi);
        float rm = fmaxf(fmaxf(a0[0], a1[0]), fmaxf(b0[0], b1[0]));
#pragma unroll
        for (int r = 1; r < 16; ++r) rm = fmaxf(rm, fmaxf(fmaxf(a0[r], a1[r]), fmaxf(b0[r], b1[r])));
        rm = fmaxf(x32_max(rm), -1e30f); float sacc = 0.f;
#pragma unroll
        for (int r = 0; r < 16; ++r) { a0[r] = ex2(a0[r] - rm); a1[r] = ex2(a1[r] - rm); b0[r] = ex2(b0[r] - rm); b1[r] = ex2(b1[r] - rm); sacc += (a0[r] + a1[r]) + (b0[r] + b1[r]); }
        sacc = x32_sum(sacc); const float cinv = sacc > 0.f ? 1.0f / sacc : 0.f;
#pragma unroll
        for (int r = 0; r < 16; ++r) { a0[r] *= cinv; a1[r] *= cinv; b0[r] *= cinv; b1[r] *= cinv; }
        imp_store(a0, a1, 0, impq, c, g, hi); imp_store(b0, b1, 1, impq, c, g, hi);
        pv_tile(o, VB0, a0, a1, lane); pv_tile(o, VB0 + 8192, b0, b1, lane);
    }
    { const float g0 = GATEV(P, row, head, 0); row_out<false>(ow, o, g0, wsf, r32, hi); }
    if (c >= 16) mymask = select_mask(impq, g, hi, (c + 4) >> 2);
    __syncthreads();
    { LAS float* xl = (LAS float*)(L + IMP_OFF);
      for (int u = tid; u < 4 * 272; u += 512) { const int gg = u / 272, ii = u % 272, dd = ii - 67; xl[u] = ((const LAS float*)(L + LUT_OFF))[(kv * 4 + gg) * 128 + (dd < 0 ? 0 : (dd > 127 ? 127 : dd))]; } }
    const LAS float* xlg = (const LAS float*)(L + IMP_OFF) + g * 272;
    { const size_t kvb = ((size_t)b * SEQ) * 256 + kv * 64; const int nsel = c + 1; int NT = (nsel + nwin + 1) & ~1; if (NT < 4) NT = 4;
      attn_stream(P.KS + kvb, P.VS + kvb, P.KW + kvb, P.VW + kvb, nsel, nwin, NT, c, t, mymask, qr, bfar, xlg, lut, GATEV(P, row, head, 1), GATEV(P, row, head, 2), L, wsf, ow, wave, lane); }
    { const int rr = lane >> 1, hf = lane & 1, gg = rr >> 3, qq = rr & 7; const LAS float* src = ow + rr * 64 + hf * 32;
      bf16_t* op = P.O + ((size_t)b * SEQ + c * 64 + wave * 8 + qq) * D + (kv * 4 + gg) * 64 + hf * 32;
#pragma unroll
      for (int q4 = 0; q4 < 4; ++q4) { const f32x4 x0 = *(const LAS f32x4*)(src + q4 * 8), x1 = *(const LAS f32x4*)(src + q4 * 8 + 4); u32x4 w;
          w.x = cvtpk(x0[0], x0[1]); w.y = cvtpk(x0[2], x0[3]); w.z = cvtpk(x1[0], x1[1]); w.w = cvtpk(x1[2], x1[3]); *(u32x4*)(op + q4 * 8) = w; } }
    __syncthreads();
}

template <bool COPY>
__device__ __forceinline__ void stage_f32_pair(const float* ksrc_, const float* vsrc_, LAS unsigned char* Kb, LAS unsigned char* Vb, int lane, float* kdst_ = nullptr, float* vdst_ = nullptr, int first_row = 0) {
    const int c4 = lane & 15; const char* ks = uniform_ptr(ksrc_); const char* vs = uniform_ptr(vsrc_); const unsigned lo = (unsigned)((lane >> 4) * 1024 + c4 * 16);
#pragma unroll 1
    for (int hf = 0; hf < 2; ++hf) {
        f32x4 x[8], y[8];
#pragma unroll
        for (int it = 0; it < 8; ++it) x[it] = *(const f32x4*)(ks + (lo + (unsigned)(hf * 8 + it) * 4096u));
#pragma unroll
        for (int it = 0; it < 8; ++it) y[it] = *(const f32x4*)(vs + (lo + (unsigned)(hf * 8 + it) * 4096u));
        if constexpr (COPY) {
            char* kd = (char*)uniform_ptr(kdst_); char* vd = (char*)uniform_ptr(vdst_);
#pragma unroll
            for (int it = 0; it < 8; ++it) { const int key = (hf * 8 + it) * 4 + (lane >> 4);
                if (key >= first_row) { __builtin_nontemporal_store(x[it], (f32x4*)(kd + (lo + (unsigned)(hf * 8 + it) * 4096u))); __builtin_nontemporal_store(y[it], (f32x4*)(vd + (lo + (unsigned)(hf * 8 + it) * 4096u))); } }
        }
#pragma unroll
        for (int it = 0; it < 8; ++it) { const int key = (hf * 8 + it) * 4 + (lane >> 4);
            u32x2 w; w.x = cvtpk(x[it][0], x[it][1]); w.y = cvtpk(x[it][2], x[it][3]);
            *(LAS u32x2*)(Kb + key * 128 + (((c4 >> 1) ^ ((key >> 1) & 7)) << 4) + (c4 & 1) * 8) = w; }
#pragma unroll
        for (int it = 0; it < 8; ++it) { const int key = (hf * 8 + it) * 4 + (lane >> 4);
            u32x2 w; w.x = cvtpk(y[it][0], y[it][1]); w.y = cvtpk(y[it][2], y[it][3]);
            *(LAS u32x2*)(Vb + (c4 >> 3) * 4096 + key * 64 + (c4 & 7) * 8) = w; }
        __builtin_amdgcn_sched_barrier(0);
    }
}
__device__ __forceinline__ void stage_bf16_tile(const bf16_t* src_  , LAS unsigned char* Kb, bool isV, int lane) {
    const char* src = uniform_ptr(src_);
#pragma unroll
    for (int it = 0; it < 8; ++it) { const int idx = it * 64 + lane, key = idx >> 3, ch = idx & 7; const u32x4 x = *(const u32x4*)(src + (unsigned)idx * 16u);
        const int off = isV ? ((ch >> 2) * 4096 + key * 64 + (ch & 3) * 16) : (key * 128 + ((ch ^ ((key >> 1) & 7)) << 4));
        *(LAS u32x4*)(Kb + off) = x; }
}
__device__ __forceinline__ void stage_new_tile(const bf16_t* src_  , LAS unsigned char* Kb, bool isV, int lane) {
    const char* src = uniform_ptr(src_);
#pragma unroll
    for (int it = 0; it < 8; ++it) *(LAS u32x4*)(Kb + (it * 64 + lane) * 16) = (u32x4){0u, 0u, 0u, 0u};
    if (lane < 32) { const int key = lane >> 3, ch = lane & 7; const u32x4 x = *(const u32x4*)(src + (unsigned)(key * 512 + ch * 16));
        const int off = isV ? ((ch >> 2) * 4096 + key * 64 + (ch & 3) * 16) : (key * 128 + ((ch ^ ((key >> 1) & 7)) << 4));
        *(LAS u32x4*)(Kb + off) = x; }
}
__device__ __forceinline__ void sample_unit(const Ptrs& P, LAS unsigned char* L, int uA, int uB, int tid, int wave, int lane) {
    asm volatile("" : "+v"(lane), "+v"(tid));
    const int half = wave >> 2, lw = wave & 3, usel = half ? uB : uA, b = usel >> 2, kv = usel & 3;
    const int r32 = lane & 31, hi = lane >> 5, g = r32 >> 3, qi = r32 & 7, qs = qi & 3, head = kv * 4 + g;
    const int t = PAST + qs; const unsigned row = (unsigned)MP + b * 4 + qs;
    bf16x8 qr[4];
#pragma unroll
    for (int ds = 0; ds < 4; ++ds) qr[ds] = *(const bf16x8*)(P.Q + (size_t)row * D + head * 64 + ds * 16 + hi * 8);
    const LAS float* lut = (const LAS float*)(L + LUT_OFF) + head * 128; const float bfar = lut[127];
    LAS float* wsf = (LAS float*)(L + WSF_OFF) + wave * 32;
    LAS unsigned* impq = (LAS unsigned*)(L + IMP_OFF) + wave * 512 + qi * 64;
    LAS unsigned char* Kb = L + wave * 16384; LAS unsigned char* Vb = Kb + 8192;
    f32x16 out[2], o[2];
#pragma unroll
    for (int r = 0; r < 16; ++r) { out[0][r] = 0.f; out[1][r] = 0.f; o[0][r] = 0.f; o[1][r] = 0.f; }
    stage_bf16_tile(P.kcs + (size_t)(b * 4 + kv) * 4096, Kb, false, lane); stage_bf16_tile(P.vcs + (size_t)(b * 4 + kv) * 4096, Vb, true, lane);
    LDS_WAIT();
    {
        f32x16 a0, a1;
        qk_tile(a0, a1, Kb, qr, 0.f, r32, hi);
        mask_bias(a0, a1, t, 31, 32, 1 << 30, true, true, lut, hi);
        { float rm = fmaxf(a0[0], a1[0]);
#pragma unroll
          for (int r = 1; r < 16; ++r) rm = fmaxf(rm, fmaxf(a0[r], a1[r]));
          rm = x32_max(rm); float sacc = 0.f;
#pragma unroll
          for (int r = 0; r < 16; ++r) { a0[r] = ex2(a0[r] - rm); a1[r] = ex2(a1[r] - rm); sacc += a0[r] + a1[r]; }
          sacc = x32_sum(sacc); const float cinv = 1.0f / sacc;
#pragma unroll
          for (int r = 0; r < 16; ++r) { a0[r] *= cinv; a1[r] *= cinv; } }
        imp_store(a0, a1, 0, impq, 32, g, hi);
        if (g == 0) {
#pragma unroll
            for (int q8 = 0; q8 < 8; ++q8) { const int jc = 32 + 4 * q8; u32x2 w; w.x = imp_key(0.f, jc + 2 * hi, 32); w.y = imp_key(0.f, jc + 2 * hi + 1, 32); *(LAS u32x2*)(impq + 2 * hi + jc) = w; } }
        if (lw == 0) { pv_tile(o, Vb, a0, a1, lane); const float g0 = GATEV(P, row, head, 0); row_fma(out, o, g0, wsf, r32, hi);
#pragma unroll
            for (int r = 0; r < 16; ++r) { o[0][r] = 0.f; o[1][r] = 0.f; } }
    }
    const unsigned long long mymask = select_mask(impq, g, hi);
    const unsigned long long umask = wave_or64(mymask) & 0x1FFFFFFFFull;
    const bool winw = lw == 3;
    const int nsel = __builtin_popcountll(umask);
    const int nmine = winw ? 9 : nsel, first = winw ? 0 : lw, step = winw ? 1 : 3;
    float m = -1e30f, l = 0.f;
#pragma unroll 1
    for (int idx = first; idx < nmine; idx += step) {
        LDS_WAIT();
        int pos0; bool near, sel = true;
        int ln = lane; asm volatile("" : "+v"(ln));
        if (!winw) {
            unsigned long long mm = umask; for (int n = 0; n < idx; ++n) mm &= mm - 1ull;
            const int j = __builtin_ctzll(mm);
            if (j < 32) { const int page = P.pt[b * 16 + (j >> 1)]; const size_t off = (((size_t)page * 128 + (j & 1) * 64) * 4 + kv) * 64;
                stage_f32_pair<false>(P.ck_sel + off, P.cv_sel + off, Kb, Vb, ln); }
            else { stage_new_tile(P.KS + ((size_t)MP + b * 4) * 256 + kv * 64, Kb, false, ln); stage_new_tile(P.VS + ((size_t)MP + b * 4) * 256 + kv * 64, Vb, true, ln); }
            pos0 = 64 * j; near = j >= 30; sel = (mymask >> j) & 1ull;
        } else {
            if (idx < 8) { const size_t off = (((size_t)b * 512 + 64 * idx) * 4 + kv) * 64;
                stage_f32_pair<true>(P.st_kw + off, P.st_vw + off, Kb, Vb, ln, P.kw_out + off - 1024, P.vw_out + off - 1024, idx == 0 ? 4 : 0); }
            else { stage_new_tile(P.KW + ((size_t)MP + b * 4) * 256 + kv * 64, Kb, false, ln); stage_new_tile(P.VW + ((size_t)MP + b * 4) * 256 + kv * 64, Vb, true, ln); }
            pos0 = PAST - 512 + 64 * idx; near = idx >= 6;
        }
        LDS_WAIT();
        f32x16 p0, p1;
        qk_tile(p0, p1, Kb, qr, near ? 0.f : bfar, r32, hi);
        mask_bias(p0, p1, t, pos0, 1, winw ? 512 : (1 << 30), sel, near, lut, hi);
        softmax_update(p0, p1, m, l, o, wsf, r32, hi);
        pv_tile(o, Vb, p0, p1, lane);
    }
    LDS_WAIT();
    { const float lt = x32_sum(l);
      LAS f32x2* ml = (LAS f32x2*)(L + IMP_OFF);
      if (hi == 0) ml[wave * 256 + r32] = (f32x2){m, lt};
      __syncthreads();
      const int w0 = half * 4 + (winw ? 3 : 0), w1 = half * 4 + (winw ? 4 : 3);
      float M = -1e30f;
      for (int w = w0; w < w1; ++w) M = fmaxf(M, ml[w * 256 + r32][0]);
      float Ls = 0.f;
      for (int w = w0; w < w1; ++w) { const f32x2 x = ml[w * 256 + r32]; Ls += x[1] * ex2(x[0] - M); }
      const float gt = GATEV(P, row, head, (winw ? 2 : 1));
      const float f = Ls > 0.f ? gt * ex2(m - M) / Ls : 0.f;
      row_fma(out, o, f, wsf, r32, hi); }
    LAS float* ob = (LAS float*)Kb + hi * 256 + r32;
#pragma unroll
    for (int r = 0; r < 16; ++r) { ob[CROW0(r) * 64] = out[0][r]; ob[CROW0(r) * 64 + 32] = out[1][r]; }
    __syncthreads();
    { const int hs = tid >> 8, vr = (tid >> 4) & 15, d4 = (tid & 15) * 4, gg = vr >> 2, qq = vr & 3, uo = hs ? uB : uA; f32x4 sacc = (f32x4){0.f, 0.f, 0.f, 0.f};
#pragma unroll
      for (int w = 0; w < 4; ++w) sacc = sacc + *(const LAS f32x4*)((const LAS float*)(L + (hs * 4 + w) * 16384) + (gg * 8 + qq) * 64 + d4);
      u32x2 w2; w2.x = cvtpk(sacc[0], sacc[1]); w2.y = cvtpk(sacc[2], sacc[3]);
      *(u32x2*)(P.O + ((size_t)MP + (uo >> 2) * 4 + qq) * D + ((uo & 3) * 4 + gg) * 64 + d4) = w2; }
    __syncthreads();
}

#ifdef VERIFY
__device__ __forceinline__ float wsum(float v) { for (int o = 1; o < 64; o <<= 1) v += __shfl_xor(v, o); return v; }
__device__ __forceinline__ float wmax(float v) { for (int o = 1; o < 64; o <<= 1) v = fmaxf(v, __shfl_xor(v, o)); return v; }
__device__ __forceinline__ float rb(float x) { return bf2f((unsigned short)(cvtpk(x, 0.f) & 0xffffu)); }
__device__ __forceinline__ void verify_item(const Ptrs& P, LAS unsigned char* L, bool sample, int b, int tq, int kv, int br, float* errs, int wave, int lane) {
    LAS float* sc = (LAS float*)(L + wave * 16384);
    LAS float* qs = (LAS float*)(L + IMP_OFF) + wave * 512;
    const LAS float* lutb = (const LAS float*)(L + LUT_OFF);
    const size_t row = sample ? (size_t)MP + b * 4 + tq : (size_t)b * SEQ + tq; const int pos = sample ? PAST + tq : tq; const int cq = pos >> 6;
    for (int g = 0; g < 4; ++g) qs[g * 64 + lane] = bf2f(P.Q[row * D + (kv * 4 + g) * 64 + lane]);
    LDS_WAIT();
    const int ncmp = sample ? 64 : 128; const size_t cmpo = (size_t)(b * 4 + kv) * (sample ? 4096 : 8192); const bf16_t* kc = (const bf16_t*)((const char*)P.kcp + (sample ? WS_KCMPS - WS_KCMPP : 0)) + cmpo; const bf16_t* vc = (const bf16_t*)((const char*)P.vcp + (sample ? WS_VCMPS - WS_VCMPP : 0)) + cmpo;
    float oc0 = 0.f, oc1 = 0.f, oc2 = 0.f, oc3 = 0.f;
    for (int g = 0; g < 4; ++g) {
        float sA = -INFINITY, sB = -INFINITY;
        for (int h = 0; h < 2; ++h) { const int n = lane + 64 * h; const int dist = pos - (32 * n + 31); float s = -INFINITY;
            if (n < ncmp && dist >= 0) { float a = 0.f; for (int d = 0; d < 64; ++d) a += qs[g * 64 + d] * bf2f(kc[(size_t)n * 64 + d]); s = a + lutb[(kv * 4 + g) * 128 + (dist > 127 ? 127 : dist)]; }
            if (h == 0) sA = s; else sB = s; }
        const float mx = wmax(fmaxf(sA, sB)); float p0 = 0.f, p1 = 0.f;
        if (mx > -INFINITY) { p0 = ex2(sA - mx); p1 = ex2(sB - mx); }
        const float sm = wsum(p0 + p1); const float inv = sm > 0.f ? 1.0f / sm : 0.f;
        sc[g * 128 + lane] = p0 * inv; sc[g * 128 + 64 + lane] = p1 * inv;
    }
    LDS_WAIT();
    for (int g = 0; g < 4; ++g) { float a = 0.f; for (int n = 0; n < ncmp; ++n) a += sc[g * 128 + n] * bf2f(vc[(size_t)n * 64 + lane]); if (g == 0) oc0 = a; else if (g == 1) oc1 = a; else if (g == 2) oc2 = a; else oc3 = a; }
    float imp = 0.f; for (int g = 0; g < 4; ++g) imp += sc[g * 128 + 2 * lane] + sc[g * 128 + 2 * lane + 1];
    { const bool forced = (lane == 0) || (lane == cq) || (lane == cq - 1), elig = lane <= cq; imp = forced ? 1e9f : (elig ? imp : -1.0f); }
    LDS_WAIT(); qs[256 + lane] = imp; LDS_WAIT();
    int rank = 0; for (int j = 0; j < 64; ++j) { const float v = qs[256 + j]; rank += (v > imp) || (v == imp && j < lane); }
    const int nsb = sample ? 33 : 64;
    const unsigned long long selm = __ballot(rank < 16 && lane < nsb);
    float r0 = oc0, r1 = oc1, r2_ = oc2, r3 = oc3;
    if (br != 0) {
        const int nslot = br == 1 ? __builtin_popcountll(selm) : 9;
        LDS_WAIT();
        for (int si = 0; si < nslot && si < 16; ++si) {
            int j;
            if (br == 1) { unsigned long long mm = selm; for (int n = 0; n < si; ++n) mm &= mm - 1ull; j = __builtin_ctzll(mm); } else j = sample ? si : cq - 8 + si;
            bool ok = false; int pk = 0; const float* kf = nullptr; const bf16_t* kb = nullptr;
            if (br == 1) { pk = 64 * j + lane;
                if (!sample) { ok = pk <= pos; kb = P.KS + ((size_t)b * SEQ + pk) * 256 + kv * 64; }
                else if (j < 32) { ok = true; kf = P.ck_sel + (((size_t)P.pt[b * 16 + (j >> 1)] * 128 + (j & 1) * 64 + lane) * 4 + kv) * 64; }
                else { ok = lane < 4 && pk <= pos; kb = P.KS + ((size_t)MP + b * 4 + (lane & 3)) * 256 + kv * 64; } }
            else { if (!sample) { pk = 64 * j + lane; ok = j >= 0 && pk <= pos && pos - pk < 512; kb = P.KW + ((size_t)b * SEQ + (ok ? pk : 0)) * 256 + kv * 64; }
                else { const int e = 64 * j + lane; pk = PAST - 512 + e; ok = e < 516 && pk <= pos && pos - pk < 512;
                    if (e < 512) kf = P.st_kw + (((size_t)b * 512 + e) * 4 + kv) * 64; else kb = P.KW + ((size_t)MP + b * 4 + ((e - 512) & 3)) * 256 + kv * 64; } }
            const int dist = pos - pk;
            for (int g = 0; g < 4; ++g) { float s = -INFINITY;
                if (ok) { float a = 0.f; for (int d = 0; d < 64; ++d) a += qs[g * 64 + d] * (kf ? rb(kf[d]) : bf2f(kb[d])); s = a + lutb[(kv * 4 + g) * 128 + (dist > 127 ? 127 : dist)]; }
                sc[g * 1024 + si * 64 + lane] = s; }
        }
        LDS_WAIT();
        for (int g = 0; g < 4; ++g) {
            float mx = -INFINITY; for (int si = 0; si < nslot && si < 16; ++si) mx = fmaxf(mx, sc[g * 1024 + si * 64 + lane]);
            mx = wmax(mx); float sm = 0.f;
            for (int si = 0; si < nslot && si < 16; ++si) { const float p = mx > -INFINITY ? ex2(sc[g * 1024 + si * 64 + lane] - mx) : 0.f; sc[g * 1024 + si * 64 + lane] = p; sm += p; }
            sm = wsum(sm); const float inv = sm > 0.f ? 1.0f / sm : 0.f;
            LDS_WAIT();
            float a = 0.f;
            for (int si = 0; si < nslot && si < 16; ++si) {
                int j;
                if (br == 1) { unsigned long long mm = selm; for (int n = 0; n < si; ++n) mm &= mm - 1ull; j = __builtin_ctzll(mm); } else j = sample ? si : cq - 8 + si;
                for (int k = 0; k < 64; ++k) { const float p = sc[g * 1024 + si * 64 + k]; if (p == 0.f) continue; float v;
                    if (br == 1) { if (!sample) v = bf2f(P.VS[((size_t)b * SEQ + 64 * j + k) * 256 + kv * 64 + lane]);
                        else if (j < 32) v = rb(P.cv_sel[(((size_t)P.pt[b * 16 + (j >> 1)] * 128 + (j & 1) * 64 + k) * 4 + kv) * 64 + lane]);
                        else v = bf2f(P.VS[((size_t)MP + b * 4 + (k & 3)) * 256 + kv * 64 + lane]); }
                    else { if (!sample) v = bf2f(P.VW[((size_t)b * SEQ + 64 * j + k) * 256 + kv * 64 + lane]);
                        else { const int e = 64 * j + k; v = e < 512 ? rb(P.st_vw[(((size_t)b * 512 + e) * 4 + kv) * 64 + lane]) : bf2f(P.VW[((size_t)MP + b * 4 + ((e - 512) & 3)) * 256 + kv * 64 + lane]); } }
                    a += p * v; } }
            a *= inv; if (g == 0) r0 = a; else if (g == 1) r1 = a; else if (g == 2) r2_ = a; else r3 = a;
            LDS_WAIT();
        }
    }
    float d2 = 0.f, rr2 = 0.f;
    for (int g = 0; g < 4; ++g) { const float ref = g == 0 ? r0 : g == 1 ? r1 : g == 2 ? r2_ : r3; const float f = bf2f(P.O[row * D + (kv * 4 + g) * 64 + lane]); const float df = f - ref; d2 += df * df; rr2 += ref * ref; }
    d2 = wsum(d2); rr2 = wsum(rr2);
    if (lane == 0) { atomicAdd(errs + ((sample ? 3 : 0) + br) * 2, d2); atomicAdd(errs + ((sample ? 3 : 0) + br) * 2 + 1, rr2); }
}
#endif
}

constexpr int NPHASE = 17;
__global__ void __launch_bounds__(512, 2) nsa_fwd(Args args) {
    extern __shared__ __attribute__((aligned(16))) unsigned char lds[];
    Frame F;
    F.lds = (LAS unsigned char*)lds;
    F.tid = threadIdx.x; F.lane = F.tid & 63; F.wave = __builtin_amdgcn_readfirstlane(F.tid >> 6);
    F.G = gridDim.x; { const int bx = blockIdx.x; F.vcu = (F.G % 8 == 0) ? (bx % 8) * (F.G / 8) + bx / 8 : bx; }
    F.x_p = (const float*)args.in[0]; F.x_s = (const float*)args.in[1]; F.c_p = (const float*)args.in[2]; F.c_s = (const float*)args.in[3];
    F.ck_cmp = (const float*)args.in[4]; F.cv_cmp = (const float*)args.in[5]; F.ck_sel = (const float*)args.in[6]; F.cv_sel = (const float*)args.in[7];
    F.page_table = (const int*)args.in[8]; F.st_kw = (const float*)args.in[9]; F.st_vw = (const float*)args.in[10]; F.st_pool = (const float*)args.in[11];
    F.rel_bias = (const float*)args.in[12]; F.ada_w = (const float*)args.in[13]; F.ada_b = (const float*)args.in[14]; F.norm_g = (const float*)args.in[15]; F.final_g = (const float*)args.in[16];
    F.w_in = (const float*)args.in[17]; F.w_out = (const float*)args.in[18]; F.cmp_wk = (const float*)args.in[19]; F.cmp_wv = (const float*)args.in[20];
    F.pe_k = (const float*)args.in[21]; F.pe_v = (const float*)args.in[22]; F.pool_w = (const float*)args.in[23]; F.pool_scale = (const float*)args.in[24];
    F.ffn_wg = (const float*)args.in[25]; F.ffn_wu = (const float*)args.in[26]; F.ffn_wd = (const float*)args.in[27];
    F.out = args.out; F.ws = args.ws;
    unsigned char* ws = args.ws;
    for (int u = F.tid; u < 64; u += 512) ((LAS unsigned*)(F.lds + MISC_OFF))[u] = 0u;
    for (int u = F.tid; u < 16 * 128; u += 512) { const int h = u >> 7, d = u & 127; ((LAS float*)(F.lds + LUT_OFF))[u] = F.rel_bias[t5_bucket(d) * 16 + h] * LOG2E; }
    __syncthreads();
    volatile LAS unsigned* MISC = (volatile LAS unsigned*)(F.lds + MISC_OFF);
    XcdBarrier bar; bar.bar = (unsigned*)(ws + WS_CTL) + CW_BAR; bar.x = 0; bar.st = nullptr;
    if (!MK_SPLIT) bar = xcd_barrier_post((unsigned*)(ws + WS_CTL) + CW_BAR, MISC + 8);
    const int lo = args.ph_lo, hi = args.ph_hi;
#ifndef PHMASK
#define PHMASK 0x1FFFF
#endif
#define IN(k) (((PHMASK >> (k)) & 1) && lo <= (k) && (k) < hi)
#define SEAM(k) do { if (IN(k) && IN((k) + 1)) xcd_barrier(bar); } while (0)
#ifndef REPMASK
#define REPMASK 0
#endif
#define REPS(k) (((REPMASK >> (k)) & 1) ? 2 : 1)
    bf16_t* H = (bf16_t*)(ws + WS_H); bf16_t* X = (bf16_t*)(ws + WS_X); float* MOD = (float*)(ws + WS_MOD);

    if (IN(0)) { for (int rep = 0; rep < REPS(0); ++rep) p0_prologue(F); } SEAM(0);
    if (IN(1)) { for (int rep = 0; rep < REPS(1); ++rep) { p1_compress_sample(F); p1_ada(F); } } SEAM(1);
    if (IN(2)) { for (int rep = 0; rep < REPS(2); ++rep) norm_phase<0>(F, true, 0, 0); } SEAM(2);
    if (IN(3)) {
        pg8::Gemm g{H, (const bf16_t*)(ws + WS_WIN), D, D, D, 0}; pg8::StaticOrder S; S.init(MT, NPROJ, F.G, (int)blockIdx.x);
        pg8::EpiProj E{(bf16_t*)(ws + WS_Q), (bf16_t*)(ws + WS_KV), (float*)(ws + WS_GATES), F.out};
        for (int rep = 0; rep < REPS(3); ++rep) pg8::gemm_phase<pg8::EpiProj, pg8::StaticOrder, true>(F.lds, g, S, E);
    } SEAM(3);
    if (IN(4)) { for (int rep = 0; rep < REPS(4); ++rep) p4_compress_prompt(F); } SEAM(4);
    if (IN(5)) {
        att::Ptrs P; P.Q = (const bf16_t*)(ws + WS_Q); P.kcp = (const bf16_t*)(ws + WS_KCMPP); P.vcp = (const bf16_t*)(ws + WS_VCMPP); P.kcs = (const bf16_t*)(ws + WS_KCMPS); P.vcs = (const bf16_t*)(ws + WS_VCMPS);
        const bf16_t* kvb = (const bf16_t*)(ws + WS_KV); P.KS = kvb + 2 * KV_STRIDE; P.VS = kvb + 3 * KV_STRIDE; P.KW = kvb + 4 * KV_STRIDE; P.VW = kvb + 5 * KV_STRIDE;
        P.gates = (const float*)(ws + WS_GATES); P.O = (bf16_t*)(ws + WS_O); P.ck_sel = F.ck_sel; P.cv_sel = F.cv_sel; P.st_kw = F.st_kw; P.st_vw = F.st_vw; P.pt = F.page_table;
        P.gov = -1; P.kw_out = F.out + O_KWS; P.vw_out = F.out + O_KWS + SZ_WS;
#ifdef VERIFY
        P.gov = args.pad0 - 1;
#endif
#ifndef RS
#define RS 1
#endif
#ifndef RP
#define RP 1
#endif
#pragma unroll 1
        for (int pass = 0; pass < 2; ++pass) {
            if ((pass == 0) != ((F.vcu & 1) != 0)) {
#pragma unroll 1
                for (int rep = 0; rep < RS; ++rep)
                for (int u = F.vcu; u < NSB * 2; u += F.G) att::sample_unit(P, F.lds, u, u + NSB * 2, F.tid, F.wave, F.lane);
            } else {
#pragma unroll 1
                for (int rep = 0; rep < RP; ++rep)
                for (int u = F.vcu; u < 16 * 16; u += F.G) { const int bk = u >> 4, s = u & 15;
#pragma unroll 1
                    for (int i = 0; i < 4; ++i) { const int c = (i == 0) ? s : (i == 1) ? 31 - s : (i == 2) ? 32 + s : 63 - s; att::prompt_unit(P, F.lds, bk >> 2, bk & 3, c, F.tid, F.wave, F.lane); } }
            }
        }
    } SEAM(5);
    if (IN(6)) {
        pg8::Gemm g{(const bf16_t*)(ws + WS_O), (const bf16_t*)(ws + WS_WOUT), D, D, D, 0}; pg8::StaticOrder S; S.init(MP, D, F.G, (int)blockIdx.x);
        pg8::EpiRes<true> E{F.x_p, F.x_s, X, MOD + 2048};
        pg8::gemm_phase<decltype(E), pg8::StaticOrder, true>(F.lds, g, S, E);
        small_gemm_res<true>(F, (const bf16_t*)(ws + WS_O) + (size_t)MP * D, D, (const bf16_t*)(ws + WS_WOUT), D, D, false, F.x_s, X + (size_t)MP * D, MOD + 2048);
    } SEAM(6);
    if (IN(7)) { for (int rep = 0; rep < REPS(7); ++rep) norm_phase<0>(F, false, 0, 1); } SEAM(7);
    if (IN(8)) {
        pg8::Gemm g{H, (const bf16_t*)(ws + WS_WGU), D, D, D, 0}; pg8::StaticOrder S; S.init(MT, NGU, F.G, (int)blockIdx.x);
        pg8::EpiGU E{(bf16_t*)(ws + WS_ACT)};
        for (int rep = 0; rep < REPS(8); ++rep) pg8::gemm_phase<pg8::EpiGU, pg8::StaticOrder, true>(F.lds, g, S, E);
    } SEAM(8);
    if (IN(9)) {
        pg8::Gemm g{(const bf16_t*)(ws + WS_ACT), (const bf16_t*)(ws + WS_WD), FF, FF, FF, 0}; pg8::StaticOrder S; S.init(MP, D, F.G, (int)blockIdx.x);
        pg8::EpiRes<false> E{nullptr, nullptr, X, MOD + 5120};
        pg8::gemm_phase<decltype(E), pg8::StaticOrder, true>(F.lds, g, S, E);
        small_gemm_res<false>(F, (const bf16_t*)(ws + WS_ACT) + (size_t)MP * FF, FF, (const bf16_t*)(ws + WS_WD), FF, FF, false, nullptr, X + (size_t)MP * D, MOD + 5120);
    } SEAM(9);
    if (IN(10)) { for (int rep = 0; rep < REPS(10); ++rep) norm_phase<1>(F, false, 1, 0); } SEAM(10);
    if (IN(11)) { for (int rep = 0; rep < REPS(11); ++rep) pool_phase(F); } SEAM(11);
    if (IN(12)) {
        pg8::Gemm g{H, (const bf16_t*)(ws + WS_WPOOL), D, 256, 256, 256}; pg8::StaticOrder S; S.init(MP, D, F.G, (int)blockIdx.x);
        pg8::EpiRes<false> E{nullptr, nullptr, X, MOD + (size_t)NMODB * 6144 + 2048};
        pg8::gemm_phase<decltype(E), pg8::StaticOrder, true>(F.lds, g, S, E);
        small_gemm_res<false>(F, H + (size_t)MP * D, D, (const bf16_t*)(ws + WS_WPOOL), 256, 256, true, nullptr, X + (size_t)MP * D, MOD + (size_t)NMODB * 6144 + 2048);
    } SEAM(12);
    if (IN(13)) { for (int rep = 0; rep < REPS(13); ++rep) norm_phase<0>(F, false, 1, 1); } SEAM(13);
    if (IN(14)) {
        pg8::Gemm g{H, (const bf16_t*)(ws + WS_WGU) + (size_t)NGU * D, D, D, D, 0}; pg8::StaticOrder S; S.init(MT, NGU, F.G, (int)blockIdx.x);
        pg8::EpiGU E{(bf16_t*)(ws + WS_ACT)};
        pg8::gemm_phase<pg8::EpiGU, pg8::StaticOrder, true>(F.lds, g, S, E);
    } SEAM(14);
    if (IN(15)) {
        pg8::Gemm g{(const bf16_t*)(ws + WS_ACT), (const bf16_t*)(ws + WS_WD) + (size_t)D * FF, FF, FF, FF, 0}; pg8::StaticOrder S; S.init(MP, D, F.G, (int)blockIdx.x);
        pg8::EpiRes<false> E{nullptr, nullptr, X, MOD + (size_t)NMODB * 6144 + 5120};
        pg8::gemm_phase<decltype(E), pg8::StaticOrder, true>(F.lds, g, S, E);
        small_gemm_res<false>(F, (const bf16_t*)(ws + WS_ACT) + (size_t)MP * FF, FF, (const bf16_t*)(ws + WS_WD) + (size_t)D * FF, FF, FF, false, nullptr, X + (size_t)MP * D, MOD + (size_t)NMODB * 6144 + 5120);
    } SEAM(15);
    if (IN(16)) { for (int rep = 0; rep < REPS(16); ++rep) norm_phase<2>(F, false, 0, 0); }
#undef IN
#undef SEAM
}


#ifdef VERIFY
__global__ void __launch_bounds__(512, 2) verify_k(Args args) {
    extern __shared__ __attribute__((aligned(16))) unsigned char lds[];
    LAS unsigned char* L = (LAS unsigned char*)lds; unsigned char* ws = args.ws;
    const int tid = threadIdx.x, lane = tid & 63, wave = __builtin_amdgcn_readfirstlane(tid >> 6);
    const float* rel_bias = (const float*)args.in[12];
    for (int u = tid; u < 16 * 128; u += 512) { const int h = u >> 7, d = u & 127; ((LAS float*)(L + LUT_OFF))[u] = rel_bias[t5_bucket(d) * 16 + h] * LOG2E; }
    __syncthreads();
    att::Ptrs P; P.Q = (const bf16_t*)(ws + WS_Q); P.kcp = (const bf16_t*)(ws + WS_KCMPP); P.vcp = (const bf16_t*)(ws + WS_VCMPP); P.kcs = (const bf16_t*)(ws + WS_KCMPS); P.vcs = (const bf16_t*)(ws + WS_VCMPS);
    const bf16_t* kvb = (const bf16_t*)(ws + WS_KV); P.KS = kvb + 2 * KV_STRIDE; P.VS = kvb + 3 * KV_STRIDE; P.KW = kvb + 4 * KV_STRIDE; P.VW = kvb + 5 * KV_STRIDE;
    P.gates = (const float*)(ws + WS_GATES); P.O = (bf16_t*)(ws + WS_O); P.ck_sel = (const float*)args.in[6]; P.cv_sel = (const float*)args.in[7]; P.st_kw = (const float*)args.in[9]; P.st_vw = (const float*)args.in[10]; P.pt = (const int*)args.in[8]; P.gov = args.pad0 - 1;
    float* errs = (float*)(ws + WS_CTL) + 65536;
    const int gw = blockIdx.x * 8 + wave;
    for (int it = gw; it < 168 + 64; it += gridDim.x * 8) { bool smp = it >= 168; int vb_, vt_, vk_;
        if (!smp) { const int ti = it % 21, r = it / 21; vb_ = (r >> 2) ? 3 : 0; vk_ = r & 3; vt_ = ti == 0 ? 0 : ti == 1 ? 5 : ti == 2 ? 30 : ti == 3 ? 31 : ti == 4 ? 63 : ti == 5 ? 64 : ti == 6 ? 100 : ti == 7 ? 511 : ti == 8 ? 512 : ti == 9 ? 600 : ti == 10 ? 959 : ti == 11 ? 960 : ti == 12 ? 1023 : ti == 13 ? 1024 : ti == 14 ? 1055 : ti == 15 ? 1100 : ti == 16 ? 2047 : ti == 17 ? 2048 : ti == 18 ? 3000 : ti == 19 ? 4032 : 4095; }
        else { const int q = it - 168, bi = q >> 4; vb_ = bi == 0 ? 0 : bi == 1 ? 1 : bi == 2 ? 77 : 127; vt_ = q & 3; vk_ = (q >> 2) & 3; }
        att::verify_item(P, L, smp, vb_, vt_, vk_, args.pad0 - 1, errs, wave, lane); }
}
__global__ void scale_k(Args args) {
    const float* errs = (const float*)(args.ws + WS_CTL) + 65536; const size_t offs[6] = {O_KCP, O_KCP + SZ_KVP, O_KCP + 2 * SZ_KVP, O_KCS, O_KCS + SZ_KVS, O_KCS + 2 * SZ_KVS};
    const int k = blockIdx.y; const float d2 = errs[2 * k], r2 = errs[2 * k + 1]; const float e = r2 > 0.f ? sqrtf(d2 / r2) : 7.0f; const size_t n = k < 3 ? SZ_KVP : SZ_KVS;
    for (size_t i = (size_t)blockIdx.x * blockDim.x + threadIdx.x; i < n; i += (size_t)gridDim.x * blockDim.x) args.out[offs[k] + i] *= (1.0f + e);
}
#endif
extern "C" void kernel_launch(void* const* d_in, const int* in_sizes, int n_in, void* d_out, int out_size, void* d_ws, size_t ws_size, hipStream_t stream) {
    static int grid = 0;
    if (grid == 0) {
        if (n_in != 28 || (size_t)out_size != O_END || ws_size < WS_END) { fprintf(stderr, "kernel_launch: unexpected shapes (n_in %d, out %d, ws %zu); nothing launched\n", n_in, out_size, ws_size); grid = -1; return; }
        int dev = 0, cus = 0, per_cu = 0;
        if (hipGetDevice(&dev) != hipSuccess || hipDeviceGetAttribute(&cus, hipDeviceAttributeMultiprocessorCount, dev) != hipSuccess) { grid = -1; return; }
        if (hipFuncSetAttribute((const void*)nsa_fwd, hipFuncAttributeMaxDynamicSharedMemorySize, LDS_BYTES) != hipSuccess) { fprintf(stderr, "kernel_launch: hipFuncSetAttribute(%d B LDS) failed\n", LDS_BYTES); grid = -1; return; }
        if (hipOccupancyMaxActiveBlocksPerMultiprocessor(&per_cu, (const void*)nsa_fwd, 512, LDS_BYTES) != hipSuccess || per_cu < 1)
            fprintf(stderr, "kernel_launch: note: occupancy query reports %d workgroups per CU\n", per_cu);
        (void)hipGetLastError();
        grid = cus;
    }
    if (grid < 0) return;
    (void)hipMemsetAsync((char*)d_ws + WS_CTL, 0, CTL_ZERO_BYTES, stream);
    Args a{};
    for (int i = 0; i < 28; ++i) a.in[i] = d_in[i];
    a.out = (float*)d_out; a.ws = (unsigned char*)d_ws; a.pad0 = 0; a.pad1 = 0;
#ifdef VERIFY
    hipFuncSetAttribute((const void*)verify_k, hipFuncAttributeMaxDynamicSharedMemorySize, LDS_BYTES);
    for (int pass = 0; pass < 3; ++pass) { a.pad0 = pass + 1; a.ph_lo = 0; a.ph_hi = 6;
        (void)hipMemsetAsync((char*)d_ws + WS_CTL, 0, 65536 * 4, stream);
        hipLaunchKernelGGL(nsa_fwd, dim3(grid), dim3(512), LDS_BYTES, stream, a);
        hipLaunchKernelGGL(verify_k, dim3(grid), dim3(512), LDS_BYTES, stream, a); }
    a.pad0 = 0; (void)hipMemsetAsync((char*)d_ws + WS_CTL, 0, 65536 * 4, stream);
    a.ph_lo = 0; a.ph_hi = NPHASE;
    hipLaunchKernelGGL(nsa_fwd, dim3(grid), dim3(512), LDS_BYTES, stream, a);
    hipLaunchKernelGGL(scale_k, dim3(64, 6), dim3(256), 0, stream, a);
#elif MK_SPLIT
    for (int p = 0; p < NPHASE; ++p) { a.ph_lo = p; a.ph_hi = p + 1; hipLaunchKernelGGL(nsa_fwd, dim3(grid), dim3(512), LDS_BYTES, stream, a); }
#else
    a.ph_lo = 0; a.ph_hi = NPHASE;
    hipLaunchKernelGGL(nsa_fwd, dim3(grid), dim3(512), LDS_BYTES, stream, a);
#endif
    const hipError_t le = hipPeekAtLastError();
    if (le != hipSuccess) fprintf(stderr, "kernel_launch: launch failed: %s\n", hipGetErrorName(le));
}
```

```cpp
#include <hip/hip_runtime.h>
#include <cstdio>
#include <cstdint>

#ifndef MK_SPLIT
#define MK_SPLIT 0
#endif

#define GAS __attribute__((address_space(1)))
#define LAS __attribute__((address_space(3)))
typedef unsigned short bf16_t;
typedef short bf16x8 __attribute__((ext_vector_type(8)));
typedef short s16x4 __attribute__((ext_vector_type(4)));
typedef float f32x2 __attribute__((ext_vector_type(2)));
typedef float f32x4 __attribute__((ext_vector_type(4)));
typedef float f32x16 __attribute__((ext_vector_type(16)));
typedef unsigned u32x2 __attribute__((ext_vector_type(2)));
typedef unsigned u32x4 __attribute__((ext_vector_type(4)));
typedef __bf16 bf16x2_t __attribute__((ext_vector_type(2)));
typedef GAS unsigned gu32;

constexpr int D = 1024, SEQ = 4096, NB = 4, NSB = 128, DSEQ = 4;
constexpr int MP = NB * SEQ, MS = NSB * DSEQ, MT = MP + MS;
constexpr int INCOLS = 2608, NPROJ = 2816, FF = 2816, NGU = 2 * FF;
constexpr int NMODB = NB + NSB;
constexpr int PAST = 2048;
constexpr float C2 = 0.125f * 1.4426950408889634f;
constexpr float LOG2E = 1.4426950408889634f;

constexpr size_t O_YP = 0, O_YS = O_YP + (size_t)MP * D;
constexpr size_t O_KCP = O_YS + (size_t)MS * D, SZ_KVP = (size_t)MP * 256;
constexpr size_t O_KWP = O_KCP + 4 * SZ_KVP, SZ_WP = (size_t)NB * 512 * 256;
constexpr size_t O_PLP = O_KWP + 2 * SZ_WP;
constexpr size_t O_KCS = O_PLP + (size_t)NB * 15 * D, SZ_KVS = (size_t)MS * 256;
constexpr size_t O_KWS = O_KCS + 4 * SZ_KVS, SZ_WS = (size_t)NSB * 512 * 256;
constexpr size_t O_PLS = O_KWS + 2 * SZ_WS;
constexpr size_t O_END = O_PLS + (size_t)NSB * 15 * D;
static_assert(O_END == 71233536, "output size");

constexpr size_t MiB = 1u << 20;
#ifdef VERIFY
constexpr size_t WS_CTL = 0, CTL_ZERO_BYTES = 1 * MiB;
#else
constexpr size_t WS_CTL = 0, CTL_ZERO_BYTES = 65536;
#endif
constexpr size_t WS_WIN = 2 * MiB;
constexpr size_t WS_WOUT = 8 * MiB;
constexpr size_t WS_WGU = 10 * MiB;
constexpr size_t WS_WD = 32 * MiB;
constexpr size_t WS_WPOOL = 44 * MiB;
constexpr size_t WS_WCK = 45 * MiB, WS_WCV = WS_WCK + 262144;
constexpr size_t WS_SC = 46 * MiB;
constexpr size_t WS_CB = 47 * MiB;
constexpr size_t WS_MOD = 48 * MiB;
constexpr size_t WS_KCMPP = 56 * MiB, WS_VCMPP = 57 * MiB;
constexpr size_t WS_KCMPS = 58 * MiB, WS_VCMPS = 62 * MiB;
constexpr size_t WS_GATES = 66 * MiB;
constexpr size_t WS_RSTD = 70 * MiB;
constexpr size_t WS_H = 72 * MiB;
constexpr size_t WS_Q = 108 * MiB;
constexpr size_t WS_O = 144 * MiB;
constexpr size_t WS_KV = 180 * MiB, KV_STRIDE = (size_t)MT * 256;
constexpr size_t WS_X = 232 * MiB;
constexpr size_t WS_HF = 300 * MiB;
constexpr size_t WS_ACT = 368 * MiB;
constexpr size_t WS_END = 464 * MiB;
static_assert(WS_KV + 6 * KV_STRIDE * 2 <= WS_X && WS_X + (size_t)MT * D * 4 <= WS_HF && WS_HF + (size_t)MT * D * 4 <= WS_ACT && WS_ACT + (size_t)MT * FF * 2 <= WS_END, "ws map");
static_assert(WS_WGU + 2 * (size_t)NGU * D * 2 <= WS_WD && WS_WD + 2 * (size_t)D * FF * 2 <= WS_WPOOL && WS_MOD + 2 * (size_t)NMODB * 6144 * 4 <= WS_KCMPP, "ws map 2");
static_assert(WS_GATES + (size_t)MT * 48 * 4 <= WS_H && WS_H + (size_t)MT * D * 2 <= WS_Q && WS_Q + (size_t)MT * D * 2 <= WS_O && WS_O + (size_t)MT * D * 2 <= WS_KV, "ws map 3");
constexpr int CW_BAR = 4096;

constexpr int RING_BYTES = 131072;
constexpr int LUT_OFF = RING_BYTES;
constexpr int WSF_OFF = LUT_OFF + 8192;
constexpr int IMP_OFF = WSF_OFF + 1024;
constexpr int MISC_OFF = IMP_OFF + 16384;
constexpr int LDS_BYTES = MISC_OFF + 256;
static_assert(LDS_BYTES <= 160 * 1024, "LDS");

__device__ __forceinline__ unsigned cvtpk(float lo, float hi) { f32x2 v = {lo, hi}; bf16x2_t b = __builtin_convertvector(v, bf16x2_t); return __builtin_bit_cast(unsigned, b); }
__device__ __forceinline__ float bf2f(unsigned short h) { return __builtin_bit_cast(float, (unsigned)h << 16); }
__device__ __forceinline__ float ex2(float x) { return __builtin_amdgcn_exp2f(x); }
__device__ __forceinline__ float sigmoidf_(float x) { return __builtin_amdgcn_rcpf(1.0f + ex2(-x * LOG2E)); }
#define CROW0(r) (((r) & 3) + 8 * ((r) >> 2))
#define LDS_WAIT() asm volatile("s_waitcnt lgkmcnt(0)" ::: "memory")
#define VM_WAIT() asm volatile("s_waitcnt vmcnt(0)" ::: "memory")
__device__ __forceinline__ const char* uniform_ptr(const void* p) { const unsigned long long v = (unsigned long long)p; const unsigned lo = (unsigned)__builtin_amdgcn_readfirstlane((int)(unsigned)v), hi = (unsigned)__builtin_amdgcn_readfirstlane((int)(unsigned)(v >> 32)); return (const char*)(((unsigned long long)hi << 32) | lo); }

__device__ __forceinline__ int opaque_s(int v) { asm volatile("" : "+s"(v)); return v; }
__device__ __forceinline__ int lane_id() { int l; asm volatile("v_mbcnt_lo_u32_b32 %0, -1, 0\n\tv_mbcnt_hi_u32_b32 %0, -1, %0" : "=v"(l)); return l; }
__device__ __forceinline__ int t5_bucket(int d) {
    if (d < 16) return d;
    int b = 16;
    b += (d >= 19) + (d >= 21) + (d >= 24) + (d >= 27) + (d >= 31) + (d >= 35) + (d >= 40) + (d >= 46) + (d >= 52) + (d >= 59) + (d >= 67) + (d >= 77) + (d >= 87) + (d >= 99) + (d >= 113);
    return b;
}

namespace pg8 {
constexpr int BM = 256, BK = 64, HALF = 128, HTB = HALF * BK * 2, STAGE_BYTES = 8 * HTB, NXCD = 8, WGM = 8;
__host__ __device__ __forceinline__ int lds_byte(int r, int c) { const int st = (r >> 4) * 2 + (c >> 5), rr = r & 15, cc = c & 31, ob = rr * 64 + cc * 2; return st * 1024 + (ob ^ (((ob >> 9) & 1) << 5)); }
__host__ __device__ __forceinline__ void stage_rc(int b, int& R, int& C) { const int st = b / 1024, sb = b % 1024, swz = sb ^ (((sb >> 9) & 1) << 5); R = (st >> 1) * 16 + swz / 64; C = (st & 1) * 32 + (swz % 64) / 2; }
__host__ __device__ __forceinline__ int perm32(int rho) { const int n = rho >> 4, i = rho & 15; return 8 * (i >> 2) + 4 * n + (i & 3); }
struct Unit { int pm, pn; };
struct Gemm { const bf16_t* A; const bf16_t* Bt; int lda, ldb, K, acs; };
struct StaticOrder {
    int nM, nN, nwg, G, c;
    __host__ __device__ void init(int M, int N, int G_, int c_) { nM = M / BM; nN = N / BM; nwg = nM * nN; G = G_; c = c_; }
    __host__ __device__ bool next(int i, Unit& u) const {
        const long L = (long)i * G + c; if (L >= nwg) return false;
        int wgid = (int)L; { const int q = nwg / NXCD, r = nwg % NXCD, xcd = wgid % NXCD, off = wgid / NXCD; wgid = (xcd < r ? xcd * (q + 1) : r * (q + 1) + (xcd - r) * q) + off; }
        const int nig = WGM * nN, gid = wgid / nig, fm = gid * WGM, gsz = (nM - fm) < WGM ? (nM - fm) : WGM;
        u.pm = fm + ((wgid % nig) % gsz); u.pn = (wgid % nig) / gsz; return true;
    }
};
template <class Epi, class Sched, bool ALIGN_EPI>
__device__ __forceinline__ void gemm_phase(LAS unsigned char* lds, const Gemm g, const Sched& S, const Epi& E) {
    const int tid = threadIdx.x, wid = __builtin_amdgcn_readfirstlane(tid >> 6), lane = tid & 63, wr = wid >> 2, wc = wid & 3, fr = lane & 15, fq = lane >> 4;
    const int K = g.K, nt = K / BK;
    unsigned voffA[2], voffB[2];
#pragma unroll
    for (int i = 0; i < 2; ++i) { int R, C; stage_rc(tid * 16 + i * 8192, R, C); const int Rb = Epi::PERM ? ((R & ~31) + perm32(R & 31)) : R;
        voffA[i] = (unsigned)(R * g.lda + C) * 2u; voffB[i] = (unsigned)(Rb * g.ldb + C) * 2u; }
    const size_t kstep = (size_t)(BK * 2);
    const size_t hsA = (size_t)HALF * g.lda * 2, hsB = (size_t)HALF * g.ldb * 2;
    const unsigned ldsw = (unsigned)wid * 1024u;
    const int aoff = lds_byte(wr * 64 + fr, fq * 8), boff = lds_byte(wc * 32 + fr, fq * 8);
#define PG8_SA(b, h) (((b) * 2 + (h)) * HTB)
#define PG8_SB(b, h) ((4 + (b) * 2 + (h)) * HTB)
#define PG8_STAGE(bufoff, gbase, voff) do { _Pragma("unroll") for (int _i = 0; _i < 2; ++_i) \
        __builtin_amdgcn_global_load_lds((const unsigned*)((const char*)(gbase) + (voff)[_i]), (LAS unsigned*)(lds + (bufoff) + ldsw + _i * 8192), 16, 0, 0); } while (0)
#define PG8_LDA(dst, b, h) do { _Pragma("unroll") for (int m = 0; m < 4; ++m) _Pragma("unroll") for (int k = 0; k < 2; ++k) dst[m][k] = *(const LAS bf16x8*)(lds + PG8_SA(b, h) + aoff + m * 2048 + k * 1024); } while (0)
#define PG8_LDB(dst, b, h) do { _Pragma("unroll") for (int n = 0; n < 2; ++n) _Pragma("unroll") for (int k = 0; k < 2; ++k) dst[n][k] = *(const LAS bf16x8*)(lds + PG8_SB(b, h) + boff + n * 2048 + k * 1024); } while (0)
#define PG8_MMA(ai, bj, At, Bt) do { __builtin_amdgcn_s_setprio(1); _Pragma("unroll") for (int m = 0; m < 4; ++m) _Pragma("unroll") for (int n = 0; n < 2; ++n) _Pragma("unroll") for (int k = 0; k < 2; ++k) \
        acc[ai][bj][m][n] = __builtin_amdgcn_mfma_f32_16x16x32_bf16(Bt[n][k], At[m][k], acc[ai][bj][m][n], 0, 0, 0); __builtin_amdgcn_s_setprio(0); } while (0)
#define PG8_WAIT_V(n) asm volatile("s_waitcnt vmcnt(" #n ")" ::: "memory")
#define PG8_WAIT_L(n) asm volatile("s_waitcnt lgkmcnt(" #n ")" ::: "memory")
#define PG8_BAR __builtin_amdgcn_s_barrier()
#define PG8_SCHED __builtin_amdgcn_sched_barrier(0)
#define PG8_UA(u) ((const char*)g.A + (size_t)(u).pm * 2 * hsA + (size_t)(u).pn * (size_t)g.acs * 2)
#define PG8_UB(u) ((const char*)g.Bt + (size_t)(u).pn * 2 * hsB)
    Unit cur, nxt; int ui = 0;
    if (!S.next(0, cur)) return;
    f32x4 acc[2][2][4][2];
#pragma unroll
    for (int a = 0; a < 2; ++a)
#pragma unroll
        for (int b = 0; b < 2; ++b)
#pragma unroll
            for (int m = 0; m < 4; ++m)
#pragma unroll
                for (int n = 0; n < 2; ++n) acc[a][b][m][n] = (f32x4){0.f, 0.f, 0.f, 0.f};
    bf16x8 At[4][2], B0[2][2], B1[2][2];
    const char* cA = PG8_UA(cur); const char* cB = PG8_UB(cur);
    PG8_STAGE(PG8_SB(0, 0), cB, voffB); PG8_STAGE(PG8_SB(0, 1), cB + hsB, voffB); PG8_STAGE(PG8_SA(0, 0), cA, voffA); PG8_STAGE(PG8_SA(0, 1), cA + hsA, voffA);
    if (wr == 1) PG8_BAR;
    PG8_WAIT_V(2); PG8_BAR;
    PG8_STAGE(PG8_SB(1, 0), cB + kstep, voffB); PG8_STAGE(PG8_SA(1, 0), cA + kstep, voffA); PG8_STAGE(PG8_SB(1, 1), cB + hsB + kstep, voffB);
    PG8_WAIT_V(6); PG8_BAR;
    for (;;) {
        const bool has_next = S.next(ui + 1, nxt);
        const char* nA = has_next ? PG8_UA(nxt) : cA; const char* nB = has_next ? PG8_UB(nxt) : cB;
        for (int t = 0; t < nt; t += 2) {
            const bool last = (t == nt - 2);
            const char* a1 = cA + (size_t)(t + 1) * kstep;
            const char* a2 = last ? nA : cA + (size_t)(t + 2) * kstep; const char* b2 = last ? nB : cB + (size_t)(t + 2) * kstep;
            const char* a3 = a2 + kstep; const char* b3 = b2 + kstep;
            PG8_LDB(B0, 0, 0); PG8_LDB(B1, 0, 1); PG8_SCHED; PG8_LDA(At, 0, 0); PG8_STAGE(PG8_SA(1, 1), a1 + hsA, voffA);
            PG8_WAIT_V(8); PG8_WAIT_L(0); PG8_BAR; PG8_MMA(0, 0, At, B0); PG8_MMA(0, 1, At, B1); PG8_BAR; PG8_SCHED;
            PG8_LDA(At, 0, 1); PG8_STAGE(PG8_SB(0, 0), b2, voffB); PG8_STAGE(PG8_SB(0, 1), b2 + hsB, voffB); PG8_STAGE(PG8_SA(0, 0), a2, voffA);
            PG8_WAIT_V(8); PG8_WAIT_L(0); PG8_BAR; PG8_MMA(1, 0, At, B0); PG8_MMA(1, 1, At, B1); PG8_BAR; PG8_SCHED;
            PG8_LDB(B0, 1, 0); PG8_LDB(B1, 1, 1); PG8_SCHED; PG8_LDA(At, 1, 0); PG8_STAGE(PG8_SA(0, 1), a2 + hsA, voffA);
            PG8_WAIT_V(8); PG8_WAIT_L(0); PG8_BAR; PG8_MMA(0, 0, At, B0); PG8_MMA(0, 1, At, B1); PG8_BAR; PG8_SCHED;
            PG8_LDA(At, 1, 1); PG8_STAGE(PG8_SB(1, 0), b3, voffB); PG8_STAGE(PG8_SB(1, 1), b3 + hsB, voffB); PG8_STAGE(PG8_SA(1, 0), a3, voffA);
            PG8_WAIT_V(8); PG8_WAIT_L(0); PG8_BAR; PG8_MMA(1, 0, At, B0); PG8_MMA(1, 1, At, B1); PG8_BAR; PG8_SCHED;
        }
        if constexpr (ALIGN_EPI) { if (wr == 0) PG8_BAR; }
        E(acc, cur, wr, wc, fr, fq);
        if (!has_next) break;
#pragma unroll
        for (int a = 0; a < 2; ++a)
#pragma unroll
            for (int b = 0; b < 2; ++b)
#pragma unroll
                for (int m = 0; m < 4; ++m)
#pragma unroll
                    for (int n = 0; n < 2; ++n) acc[a][b][m][n] = (f32x4){0.f, 0.f, 0.f, 0.f};
        cur = nxt; cA = nA; cB = nB; ++ui;
        if constexpr (ALIGN_EPI) { if (wr == 1) PG8_BAR; }
    }
    PG8_WAIT_V(0);
    if constexpr (!ALIGN_EPI) { if (wr == 0) PG8_BAR; }
    PG8_BAR;
#undef PG8_SA
#undef PG8_SB
#undef PG8_STAGE
#undef PG8_LDA
#undef PG8_LDB
#undef PG8_MMA
#undef PG8_WAIT_V
#undef PG8_WAIT_L
#undef PG8_BAR
#undef PG8_SCHED
#undef PG8_UA
#undef PG8_UB
}

struct EpiProj {
    static constexpr bool PERM = true;
    bf16_t* Q; bf16_t* KV; float* gates; float* out;
    __device__ __forceinline__ void operator()(const f32x4 (&acc)[2][2][4][2], const Unit& u, int wr, int wc, int fr, int fq) const {
        const int pn = u.pn;
#pragma unroll
        for (int ai = 0; ai < 2; ++ai)
#pragma unroll
            for (int m = 0; m < 4; ++m) {
                const int row = u.pm * BM + ai * HALF + wr * 64 + m * 16 + fr;
                if (pn < 4) {
#pragma unroll
                    for (int bj = 0; bj < 2; ++bj) { const f32x4 v0 = acc[ai][bj][m][0] * C2, v1 = acc[ai][bj][m][1] * C2; u32x4 w;
                        w.x = cvtpk(v0[0], v0[1]); w.y = cvtpk(v0[2], v0[3]); w.z = cvtpk(v1[0], v1[1]); w.w = cvtpk(v1[2], v1[3]);
                        *(u32x4*)(Q + (size_t)row * D + pn * 256 + bj * HALF + wc * 32 + 8 * fq) = w; }
                } else if (pn < 10) {
                    const int t = pn - 4; float* dst = nullptr;
                    if (row < MP) { if (t < 4) dst = out + O_KCP + (size_t)t * SZ_KVP + (size_t)row * 256; else { const int tt = row & (SEQ - 1); if (tt >= SEQ - 512) dst = out + O_KWP + (size_t)(t - 4) * SZ_WP + ((size_t)(row >> 12) * 512 + (tt - (SEQ - 512))) * 256; } }
                    else { const int rs = row - MP; if (t < 4) dst = out + O_KCS + (size_t)t * SZ_KVS + (size_t)rs * 256; else dst = out + O_KWS + (size_t)(t - 4) * SZ_WS + ((size_t)(rs >> 2) * 512 + 508 + (rs & 3)) * 256; }
                    bf16_t* bd = KV + (size_t)t * KV_STRIDE + (size_t)row * 256;
#pragma unroll
                    for (int bj = 0; bj < 2; ++bj) { const int cc = bj * HALF + wc * 32 + 8 * fq; const f32x4 v0 = acc[ai][bj][m][0], v1 = acc[ai][bj][m][1]; u32x4 w;
                        w.x = cvtpk(v0[0], v0[1]); w.y = cvtpk(v0[2], v0[3]); w.z = cvtpk(v1[0], v1[1]); w.w = cvtpk(v1[2], v1[3]);
                        *(u32x4*)(bd + cc) = w;
                        if (dst) { *(f32x4*)(dst + cc) = v0; *(f32x4*)(dst + cc + 4) = v1; } }
                } else {
                    const int cc = wc * 32 + 8 * fq;
                    if (cc < 48) { float* gd = gates + (size_t)row * 48 + cc; *(f32x4*)gd = acc[ai][0][m][0]; *(f32x4*)(gd + 4) = acc[ai][0][m][1]; }
                }
            }
    }
};
template <bool XF32>
struct EpiRes {
    static constexpr bool PERM = false;
    const float* xin_p; const float* xin_s; bf16_t* xout; const float* gate;
    __device__ __forceinline__ void operator()(const f32x4 (&acc)[2][2][4][2], const Unit& u, int wr, int wc, int fr, int fq) const {
#pragma unroll
        for (int ai = 0; ai < 2; ++ai)
#pragma unroll
            for (int m = 0; m < 4; ++m) {
                const int row = u.pm * BM + ai * HALF + wr * 64 + m * 16 + fr;
                const int bb = row < MP ? (row >> 12) : NB + ((row - MP) >> 2);
                const float* xi = row < MP ? xin_p + (size_t)row * D : xin_s + (size_t)(row - MP) * D;
                const float* gp = gate + (size_t)bb * 6144; bf16_t* xo = xout + (size_t)row * D;
#pragma unroll
                for (int bj = 0; bj < 2; ++bj)
#pragma unroll
                    for (int n = 0; n < 2; ++n) { const int col = u.pn * BM + bj * HALF + wc * 32 + 16 * n + 4 * fq;
                        const f32x4 g4 = *(const f32x4*)(gp + col);
                        f32x4 x4;
                        if constexpr (XF32) x4 = *(const f32x4*)(xi + col);
                        else { const u32x2 xw = *(const u32x2*)(xo + col); x4 = (f32x4){__builtin_bit_cast(float, xw.x << 16), __builtin_bit_cast(float, xw.x & 0xffff0000u), __builtin_bit_cast(float, xw.y << 16), __builtin_bit_cast(float, xw.y & 0xffff0000u)}; }
                        const f32x4 rr = x4 + g4 * acc[ai][bj][m][n];
                        u32x2 w; w.x = cvtpk(rr[0], rr[1]); w.y = cvtpk(rr[2], rr[3]); *(u32x2*)(xo + col) = w; }
            }
    }
};
struct EpiGU {
    static constexpr bool PERM = true;
    bf16_t* act;
    __device__ __forceinline__ void operator()(const f32x4 (&acc)[2][2][4][2], const Unit& u, int wr, int wc, int fr, int fq) const {
#pragma unroll
        for (int ai = 0; ai < 2; ++ai)
#pragma unroll
            for (int m = 0; m < 4; ++m) {
                const int row = u.pm * BM + ai * HALF + wr * 64 + m * 16 + fr; float r[8];
#pragma unroll
                for (int n = 0; n < 2; ++n)
#pragma unroll
                    for (int e = 0; e < 4; ++e) { const float gv = acc[ai][0][m][n][e], uv = acc[ai][1][m][n][e]; r[n * 4 + e] = gv * sigmoidf_(gv) * uv; }
                u32x4 w; w.x = cvtpk(r[0], r[1]); w.y = cvtpk(r[2], r[3]); w.z = cvtpk(r[4], r[5]); w.w = cvtpk(r[6], r[7]);
                *(u32x4*)(act + (size_t)row * FF + u.pn * HALF + wc * 32 + 8 * fq) = w;
            }
    }
};
}

#define XB_TMO      128
#define XB_XCNT(j)  (256  + 64 * (j))
#define XB_XSUB(j)  (1280 + 64 * (j))
#define XB_XGEN(j)  (2304 + 64 * (j))
#define XB_TOP      3328
#define XB_TOPGEN   3392
#define XCD_BAR_WORDS 3456
#define XB_SPIN_CAP (1u << 18)
__device__ __forceinline__ unsigned xb_ld(unsigned* p)              { return __hip_atomic_load(p, __ATOMIC_RELAXED, __HIP_MEMORY_SCOPE_AGENT); }
__device__ __forceinline__ unsigned xb_add(unsigned* p, unsigned v) { return __hip_atomic_fetch_add(p, v, __ATOMIC_RELAXED, __HIP_MEMORY_SCOPE_AGENT); }
__device__ __forceinline__ unsigned xb_xcc_id() { return (unsigned)__builtin_amdgcn_s_getreg((3 << 11) | 20) & 0xFu; }
#define XB_SPIN(cond, bar) do { unsigned _sp = 0; while (cond) { __builtin_amdgcn_s_sleep(1); \
    if ((++_sp & 255u) == 0u) { if (xb_ld(&(bar)[XB_TMO])) break; if (_sp > XB_SPIN_CAP) { atomicAdd(&(bar)[XB_TMO], 1u); break; } } } } while (0)
struct XcdBarrier { unsigned* bar; unsigned x; volatile LAS unsigned* st; };
__device__ __forceinline__ XcdBarrier xcd_barrier_post(unsigned* bar, volatile LAS unsigned* st) {
    XcdBarrier b; b.bar = bar; b.x = xb_xcc_id(); b.st = st;
    if (threadIdx.x == 0) (void)xb_add(&bar[XB_XCNT(b.x)], 1u);
    return b;
}
__device__ __forceinline__ void xcd_barrier_complete(unsigned* bar, unsigned x, unsigned& nloc, unsigned& nx) {
    const unsigned G = gridDim.x * gridDim.y * gridDim.z;
    unsigned sum, cnt, mine, sp = 0u;
    for (;;) {
        sum = 0u; cnt = 0u; mine = 0u;
#pragma unroll
        for (unsigned j = 0; j < 16; ++j) { const unsigned c = xb_ld(&bar[XB_XCNT(j)]); sum += c; cnt += (c > 0u) ? 1u : 0u; mine = (j == x) ? c : mine; }
        if (sum == G) break;
        __builtin_amdgcn_s_sleep(1);
        if ((++sp & 255u) == 0u) { if (xb_ld(&bar[XB_TMO])) break; if (sp > XB_SPIN_CAP) { atomicAdd(&bar[XB_TMO], 1u); break; } }
    }
    nloc = mine > 0u ? mine : 1u; nx = cnt > 0u ? cnt : 1u;
}
__device__ __forceinline__ void xcd_barrier(const XcdBarrier& b) {
    asm volatile("s_waitcnt vmcnt(0)" ::: "memory");
    __syncthreads();
    if (threadIdx.x == 0) {
        unsigned* bar = b.bar;
        __builtin_amdgcn_s_waitcnt(0);
        unsigned nloc = b.st[0], nx = b.st[1];
        if (nloc == 0u) { xcd_barrier_complete(bar, b.x, nloc, nx); b.st[0] = nloc; b.st[1] = nx; }
        const unsigned old = xb_add(&bar[XB_XSUB(b.x)], 1u);
        const unsigned gen = old / nloc;
        if (old + 1u == (gen + 1u) * nloc) {
            __builtin_amdgcn_fence(__ATOMIC_RELEASE, "agent");
            asm volatile("s_waitcnt vmcnt(0)" ::: "memory");
            const unsigned og = xb_add(&bar[XB_TOP], 1u);
            const unsigned tg = og / nx;
            if (og + 1u == (tg + 1u) * nx) xb_add(&bar[XB_TOPGEN], 1u);
            else XB_SPIN(xb_ld(&bar[XB_TOPGEN]) == tg, bar);
            __builtin_amdgcn_fence(__ATOMIC_ACQUIRE, "agent");
            xb_add(&bar[XB_XGEN(b.x)], 1u);
            asm volatile("s_waitcnt vmcnt(0)" ::: "memory");
        } else {
            XB_SPIN(xb_ld(&bar[XB_XGEN(b.x)]) == gen, bar);
            __builtin_amdgcn_fence(__ATOMIC_ACQUIRE, "agent");
            asm volatile("s_waitcnt vmcnt(0)" ::: "memory");
        }
    }
    __syncthreads();
}

struct Args { const void* in[28]; float* out; unsigned char* ws; int ph_lo, ph_hi, pad0, pad1; };
struct Frame {
    LAS unsigned char* lds; int tid, lane, wave, vcu, G;
    const float *x_p, *x_s, *c_p, *c_s, *ck_cmp, *cv_cmp, *ck_sel, *cv_sel; const int* page_table; const float *st_kw, *st_vw, *st_pool, *rel_bias, *ada_w, *ada_b, *norm_g, *final_g,
        *w_in, *w_out, *cmp_wk, *cmp_wv, *pe_k, *pe_v, *pool_w, *pool_scale, *ffn_wg, *ffn_wu, *ffn_wd;
    float* out; unsigned char* ws;
};
__device__ __forceinline__ float wave_sum(float v) {
#pragma unroll
    for (int o = 1; o < 64; o <<= 1) v += __shfl_xor(v, o);
    return v;
}

__device__ __forceinline__ void transpose_item(const float* W, int ldw, int nvalid, bf16_t* WT, int ldt, int drow0, LAS float* scr, int k0, int n0, int lane, const float* rs = nullptr  ) {
    float tv[32];
#pragma unroll
    for (int i = 0; i < 32; ++i) { const int kk = 2 * i + (lane >> 5), n = n0 + (lane & 31); tv[i] = (n < nvalid) ? W[(size_t)(k0 + kk) * ldw + n] : 0.f; }
    if (rs) { const float rsv = rs[n0 + (lane & 31)];
#pragma unroll
        for (int i = 0; i < 32; ++i) tv[i] *= rsv; }
#pragma unroll
    for (int i = 0; i < 32; ++i) { const int kk = 2 * i + (lane >> 5); scr[kk * 33 + (lane & 31)] = tv[i]; }
    LDS_WAIT();
    const int c = lane & 7;
#pragma unroll
    for (int j = 0; j < 4; ++j) { const int n = (lane >> 3) + 8 * j; const LAS float* s = scr + (8 * c) * 33 + n;
        u32x4 o; o.x = cvtpk(s[0 * 33], s[1 * 33]); o.y = cvtpk(s[2 * 33], s[3 * 33]); o.z = cvtpk(s[4 * 33], s[5 * 33]); o.w = cvtpk(s[6 * 33], s[7 * 33]);
        *(u32x4*)(WT + (size_t)(drow0 + n) * ldt + k0 + 8 * c) = o; }
    LDS_WAIT();
}
__device__ __forceinline__ void p0_prologue(Frame& F) {
    LAS float* scr = (LAS float*)(F.lds + F.wave * 16384);
    const int gw = F.vcu * 8 + F.wave, NGW = F.G * 8, lane = F.lane;
    unsigned char* ws = F.ws;
    constexpr int I_IN = 16 * 88, I_OUT = 16 * 32, I_G = 16 * 88, I_D = 44 * 32, I_P = 4 * 8, I_C = 32 * 2;
    constexpr int NITEMS = I_IN + I_OUT + 4 * I_G + 2 * I_D + 4 * I_P + 2 * I_C;
    for (int it = gw; it < NITEMS; it += NGW) {
        int r = it;
        if (r < I_IN) { const int kb = r / 88, nb = r % 88; transpose_item(F.w_in, INCOLS, INCOLS, (bf16_t*)(ws + WS_WIN), D, nb * 32, scr, kb * 64, nb * 32, lane); continue; } r -= I_IN;
        if (r < I_OUT) { const int kb = r / 32, nb = r % 32; transpose_item(F.w_out, D, D, (bf16_t*)(ws + WS_WOUT), D, nb * 32, scr, kb * 64, nb * 32, lane); continue; } r -= I_OUT;
        if (r < 4 * I_G) { const int l = r / (2 * I_G), which = (r / I_G) & 1, q = r % I_G, kb = q / 88, nb = q % 88, n0 = nb * 32;
            const float* W = (which ? F.ffn_wu : F.ffn_wg) + (size_t)l * D * FF;
            transpose_item(W, FF, FF, (bf16_t*)(ws + WS_WGU) + (size_t)l * NGU * D, D, (n0 >> 7) * 256 + which * 128 + (n0 & 127), scr, kb * 64, n0, lane); continue; } r -= 4 * I_G;
        if (r < 2 * I_D) { const int l = r / I_D, q = r % I_D, kb = q / 32, nb = q % 32;
            transpose_item(F.ffn_wd + (size_t)l * FF * D, D, D, (bf16_t*)(ws + WS_WD) + (size_t)l * D * FF, FF, nb * 32, scr, kb * 64, nb * 32, lane); continue; } r -= 2 * I_D;
        if (r < 4 * I_P) { const int gI = r / I_P, q = r % I_P, kb = q / 8, nb = q % 8;
            transpose_item(F.pool_w + (size_t)gI * 65536, 256, 256, (bf16_t*)(ws + WS_WPOOL) + (size_t)gI * 65536, 256, nb * 32, scr, kb * 64, nb * 32, lane, F.pool_scale + gI * 256); continue; } r -= 4 * I_P;
        { const int which = r / I_C, q = r % I_C, kb = q / 2, nb = q % 2;
          transpose_item(which ? F.cmp_wv : F.cmp_wk, 64, 64, (bf16_t*)(ws + (which ? WS_WCV : WS_WCK)), 2048, nb * 32, scr, kb * 64, nb * 32, lane); }
    }
    { const int gt = (F.vcu * 8 + F.wave) * 64 + lane, NT = F.G * 512; bf16_t* sc = (bf16_t*)(ws + WS_SC);
      for (int i = gt; i < 144 * 512; i += NT) { const int row = i >> 9, c2 = (i & 511) * 2; float a = 0.f, b = 0.f;
          if (row < NMODB) { const float* cp = row < NB ? F.c_p + (size_t)row * D : F.c_s + (size_t)(row - NB) * D; const float x0 = cp[c2], x1 = cp[c2 + 1]; a = x0 * sigmoidf_(x0); b = x1 * sigmoidf_(x1); }
          *(unsigned*)(sc + (size_t)row * D + c2) = cvtpk(a, b); } }
    if (F.vcu < 16) { const int tsel = F.vcu >> 3, part = F.vcu & 7; const float* pe = tsel ? F.pe_v : F.pe_k; const float* W = tsel ? F.cmp_wv : F.cmp_wk; float sacc = 0.f;
        const int kb = part * 256 + F.wave * 32;
#pragma unroll
        for (int k = 0; k < 32; ++k) sacc += pe[kb + k] * W[(size_t)(kb + k) * 64 + lane];
        LAS float* red = (LAS float*)(F.lds + WSF_OFF);
        red[F.wave * 64 + lane] = sacc; LDS_WAIT(); __syncthreads();
        if (F.wave == 0) { float t2 = 0.f;
#pragma unroll
            for (int w = 0; w < 8; ++w) t2 += red[w * 64 + lane];
            ((float*)(ws + WS_CB))[(tsel * 8 + part) * 64 + lane] = t2; }
        __syncthreads(); }
    { const size_t gt = (size_t)(F.vcu * 8 + F.wave) * 64 + lane, NT = (size_t)F.G * 512;
      const size_t pp = (size_t)NSB * 11 * 256;
      for (size_t i = gt; i < pp; i += NT) { const size_t b = i / (11 * 256), rem = i % (11 * 256);
          ((f32x4*)(F.out + O_PLS + b * 15 * D))[rem] = ((const f32x4*)(F.st_pool + (b * 15 + 4) * D))[rem]; } }
}

__device__ __forceinline__ void p1_ada(Frame& F) {
    const int gw = F.vcu * 8 + F.wave, NGW = F.G * 8, lane = F.lane, fr = lane & 15, kq = lane >> 4;
    const bf16_t* sc = (const bf16_t*)(F.ws + WS_SC); float* mod = (float*)(F.ws + WS_MOD);
    for (int tile = F.wave < 3 ? F.vcu * 3 + F.wave : 768; tile < 768; tile += F.G * 3) {
        const int layer = tile / 384, n0 = (tile % 384) * 16;
        const float* W = F.ada_w + (size_t)layer * D * 6144 + n0 + fr;
        f32x4 acc[9];
#pragma unroll
        for (int i = 0; i < 9; ++i) acc[i] = (f32x4){0.f, 0.f, 0.f, 0.f};
#pragma unroll 4
        for (int k0 = 0; k0 < D; k0 += 32) {
            float w[8];
#pragma unroll
            for (int i = 0; i < 8; ++i) w[i] = W[(size_t)(k0 + 8 * kq + i) * 6144];
            u32x4 bw; bw.x = cvtpk(w[0], w[1]); bw.y = cvtpk(w[2], w[3]); bw.z = cvtpk(w[4], w[5]); bw.w = cvtpk(w[6], w[7]);
            const bf16x8 bfrag = __builtin_bit_cast(bf16x8, bw);
#pragma unroll
            for (int mt = 0; mt < 9; ++mt) { const bf16x8 af = *(const bf16x8*)(sc + (size_t)(mt * 16 + fr) * D + k0 + 8 * kq);
                acc[mt] = __builtin_amdgcn_mfma_f32_16x16x32_bf16(af, bfrag, acc[mt], 0, 0, 0); }
        }
        const float bias = F.ada_b[layer * 6144 + n0 + fr];
#pragma unroll
        for (int mt = 0; mt < 9; ++mt)
#pragma unroll
            for (int e = 0; e < 4; ++e) { const int row = mt * 16 + 4 * kq + e; if (row < NMODB) mod[((size_t)layer * NMODB + row) * 6144 + n0 + fr] = acc[mt][e] + bias; }
    }
}

__device__ __forceinline__ void p1_compress_sample(Frame& F) {
    const int lane = F.lane, wave = F.wave, r32 = lane & 31, hi = lane >> 5, kvl = lane >> 4, c4 = lane & 15;
    LAS unsigned char* L = F.lds;
    const int wrow = wave * 4 + kvl, total = 2 * NSB * 8;
    const int nitem = (total - F.vcu + F.G - 1) / F.G; if (nitem <= 0) return;
    const int nstage = 2 * nitem;
#define CS_BAR() do { asm volatile("s_waitcnt lgkmcnt(0)" ::: "memory"); __builtin_amdgcn_s_barrier(); asm volatile("" ::: "memory"); } while (0)
#define CS_SRC(g, ptr) do { const int it_ = F.vcu + F.G * ((g) >> 1); const int wh_ = it_ / (NSB * 8), q_ = it_ % (NSB * 8), b_ = q_ >> 3, n_ = (q_ & 7) * 8 + wave; const int pg_ = F.page_table[b_ * 16 + (n_ >> 2)]; \
        ptr = uniform_ptr((wh_ ? F.cv_cmp : F.ck_cmp) + ((size_t)pg_ * 128 + (n_ & 3) * 32 + ((g) & 1) * 16) * 256); } while (0)
#define CS_LOAD(ptr) do { _Pragma("unroll") for (int jj = 0; jj < 16; ++jj) x[jj] = *(const f32x4*)((ptr) + (unsigned)(jj * 1024 + lane * 16)); } while (0)
#define CS_STORE(buf) do { _Pragma("unroll") for (int jj = 0; jj < 16; ++jj) { u32x2 w_; w_.x = cvtpk(x[jj][0], x[jj][1]); w_.y = cvtpk(x[jj][2], x[jj][3]); \
        *(LAS u32x2*)(L + (buf) * 65536 + wrow * 2048 + (((jj * 8 + (c4 >> 1)) ^ (wrow & 15)) << 4) + (c4 & 1) * 8) = w_; } } while (0)
    f32x4 x[16]; const char* sp;
    CS_SRC(0, sp); CS_LOAD(sp); CS_STORE(0); CS_BAR();
    f32x16 a0, a1;
#pragma unroll
    for (int r = 0; r < 16; ++r) { a0[r] = 0.f; a1[r] = 0.f; }
#pragma unroll 1
    for (int g = 0; g < nstage; ++g) {
        const int it = F.vcu + F.G * (g >> 1), which = it / (NSB * 8), q = it % (NSB * 8), b = q >> 3, n0 = (q & 7) * 8;
        const bf16_t* wp = (const bf16_t*)(F.ws + (which ? WS_WCV : WS_WCK)) + (size_t)r32 * 2048 + (g & 1) * 1024 + 128 * wave + 8 * hi;
        bf16x8 bfr[16];
#pragma unroll
        for (int ks = 0; ks < 8; ++ks) { bfr[2 * ks] = *(const bf16x8*)(wp + 16 * ks); bfr[2 * ks + 1] = *(const bf16x8*)(wp + 32 * 2048 + 16 * ks); }
        if (g + 1 < nstage) { CS_SRC(g + 1, sp); CS_LOAD(sp); }
        const LAS unsigned char* ab = L + (g & 1) * 65536 + r32 * 2048;
#pragma unroll
        for (int ks = 0; ks < 8; ++ks) { const bf16x8 af = *(const LAS bf16x8*)(ab + (((16 * wave + 2 * ks + hi) ^ (r32 & 15)) << 4));
            a0 = __builtin_amdgcn_mfma_f32_32x32x16_bf16(af, bfr[2 * ks], a0, 0, 0, 0); a1 = __builtin_amdgcn_mfma_f32_32x32x16_bf16(af, bfr[2 * ks + 1], a1, 0, 0, 0); }
        CS_BAR();
        if (g & 1) {
            LAS float* red = (LAS float*)(L + 65536) + wave * 2048 + hi * 256 + r32;
#pragma unroll
            for (int r = 0; r < 16; ++r) { red[CROW0(r) * 64] = a0[r]; red[CROW0(r) * 64 + 32] = a1[r]; a0[r] = 0.f; a1[r] = 0.f; }
            CS_BAR();
            { const int row = F.tid >> 4, cc = (F.tid & 15) * 4; f32x4 sacc = (f32x4){0.f, 0.f, 0.f, 0.f};
#pragma unroll
              for (int pp = 0; pp < 8; ++pp) sacc = sacc + *(const f32x4*)((const float*)(F.ws + WS_CB) + (which * 8 + pp) * 64 + cc);
#pragma unroll
              for (int w = 0; w < 8; ++w) sacc = sacc + *(const LAS f32x4*)((const LAS float*)(L + 65536) + w * 2048 + row * 64 + cc);
              bf16_t* o = (bf16_t*)(F.ws + (which ? WS_VCMPS : WS_KCMPS)) + (size_t)b * 4 * 64 * 64 + ((size_t)(row & 3) * 64 + n0 + (row >> 2)) * 64 + cc;
              u32x2 w2; w2.x = cvtpk(sacc[0], sacc[1]); w2.y = cvtpk(sacc[2], sacc[3]); *(u32x2*)o = w2; }
        }
        if (g + 1 < nstage) CS_STORE((g + 1) & 1);
        CS_BAR();
    }
    VM_WAIT(); __syncthreads();
#undef CS_BAR
#undef CS_SRC
#undef CS_LOAD
#undef CS_STORE
}
__device__ __forceinline__ void p4_compress_prompt(Frame& F) {
    const int lane = F.lane, r32 = lane & 31, hi = lane >> 5, nl = r32 >> 2, kv = r32 & 3;
    for (int it = F.vcu; it < 2 * NB * 16; it += F.G) {
        const int which = it / (NB * 16), q = it % (NB * 16), b = q >> 4, n0 = (q & 15) * 8, n = n0 + nl;
        const bf16_t* src = (const bf16_t*)(F.ws + WS_KV) + (size_t)which * KV_STRIDE + ((size_t)b * SEQ + (size_t)n * 32) * 256 + kv * 64;
        const bf16_t* Wt = (const bf16_t*)(F.ws + (which ? WS_WCV : WS_WCK));
        const bf16_t* w0 = Wt + (size_t)r32 * 2048 + hi * 8; const bf16_t* w1 = w0 + (size_t)32 * 2048;
        f32x16 a0, a1;
#pragma unroll
        for (int r = 0; r < 16; ++r) { a0[r] = 0.f; a1[r] = 0.f; }
#pragma unroll
        for (int jj = 0; jj < 4; ++jj) { const int j = F.wave * 4 + jj;
#pragma unroll
            for (int ds = 0; ds < 4; ++ds) { const bf16x8 af = *(const bf16x8*)(src + (size_t)j * 256 + ds * 16 + hi * 8);
                const bf16x8 b0 = *(const bf16x8*)(w0 + j * 64 + ds * 16), b1 = *(const bf16x8*)(w1 + j * 64 + ds * 16);
                a0 = __builtin_amdgcn_mfma_f32_32x32x16_bf16(af, b0, a0, 0, 0, 0); a1 = __builtin_amdgcn_mfma_f32_32x32x16_bf16(af, b1, a1, 0, 0, 0); } }
        LAS float* red = (LAS float*)F.lds + F.wave * 2048 + hi * 256 + r32;
#pragma unroll
        for (int r = 0; r < 16; ++r) { red[CROW0(r) * 64] = a0[r]; red[CROW0(r) * 64 + 32] = a1[r]; }
        LDS_WAIT(); __syncthreads();
        { const int row = F.tid >> 4, c4 = (F.tid & 15) * 4; f32x4 sacc = (f32x4){0.f, 0.f, 0.f, 0.f};
#pragma unroll
          for (int pp = 0; pp < 8; ++pp) sacc = sacc + *(const f32x4*)((const float*)(F.ws + WS_CB) + (which * 8 + pp) * 64 + c4);
#pragma unroll
          for (int w = 0; w < 8; ++w) sacc = sacc + *(const LAS f32x4*)((const LAS float*)F.lds + w * 2048 + row * 64 + c4);
          bf16_t* o = (bf16_t*)(F.ws + (which ? WS_VCMPP : WS_KCMPP)) + (size_t)b * 4 * 128 * 64 + ((size_t)(row & 3) * 128 + n0 + (row >> 2)) * 64 + c4;
          u32x2 w2; w2.x = cvtpk(sacc[0], sacc[1]); w2.y = cvtpk(sacc[2], sacc[3]); *(u32x2*)o = w2; }
        __syncthreads();
    }
}

template <bool XF32>
__device__ __forceinline__ void small_gemm_res(Frame& F, const bf16_t* A  , int lda, const bf16_t* Wt, int ldb, int K, bool bd, const float* xin_s  , bf16_t* xout_s, const float* gate) {
    const int lane = lane_id(), tid_ = F.wave * 64 + lane, r32 = lane & 31, hi = lane >> 5, kw = K >> 3, kbeg = F.wave * kw;
    for (int tile = F.vcu; tile < 256; tile += F.G) {
        const int row0 = (tile >> 4) * 32, col0 = (tile & 15) * 64, acol = bd ? (col0 >> 8) * 256 : 0;
        const bf16_t* ap = A + (size_t)(row0 + r32) * lda + acol + kbeg + 8 * hi;
        const bf16_t* b0p = Wt + (size_t)(col0 + r32) * ldb + kbeg + 8 * hi; const bf16_t* b1p = b0p + (size_t)32 * ldb;
        f32x16 c0, c1;
#pragma unroll
        for (int r = 0; r < 16; ++r) { c0[r] = 0.f; c1[r] = 0.f; }
#pragma unroll 8
        for (int ks = 0; ks < kw; ks += 16) { const bf16x8 a = *(const bf16x8*)(ap + ks), b0 = *(const bf16x8*)(b0p + ks), b1 = *(const bf16x8*)(b1p + ks);
            c0 = __builtin_amdgcn_mfma_f32_32x32x16_bf16(a, b0, c0, 0, 0, 0); c1 = __builtin_amdgcn_mfma_f32_32x32x16_bf16(a, b1, c1, 0, 0, 0); }
        LAS float* red = (LAS float*)F.lds + F.wave * 2048 + hi * 256 + r32;
#pragma unroll
        for (int r = 0; r < 16; ++r) { red[CROW0(r) * 64] = c0[r]; red[CROW0(r) * 64 + 32] = c1[r]; }
        LDS_WAIT(); __syncthreads();
        { const int row = tid_ >> 4, c4 = (tid_ & 15) * 4; f32x4 sacc = (f32x4){0.f, 0.f, 0.f, 0.f};
#pragma unroll
          for (int w = 0; w < 8; ++w) sacc = sacc + *(const LAS f32x4*)((const LAS float*)F.lds + w * 2048 + row * 64 + c4);
          const int rs = row0 + row, col = col0 + c4, bb = NB + (rs >> 2);
          const f32x4 g4 = *(const f32x4*)(gate + (size_t)bb * 6144 + col);
          f32x4 x4;
          if constexpr (XF32) x4 = *(const f32x4*)(xin_s + (size_t)rs * D + col);
          else { const u32x2 xw = *(const u32x2*)(xout_s + (size_t)rs * D + col); x4 = (f32x4){__builtin_bit_cast(float, xw.x << 16), __builtin_bit_cast(float, xw.x & 0xffff0000u), __builtin_bit_cast(float, xw.y << 16), __builtin_bit_cast(float, xw.y & 0xffff0000u)}; }
          const f32x4 rr = x4 + g4 * sacc; u32x2 w; w.x = cvtpk(rr[0], rr[1]); w.y = cvtpk(rr[2], rr[3]); *(u32x2*)(xout_s + (size_t)rs * D + col) = w; }
        __syncthreads();
    }
}

template <int CTRL> __device__ __forceinline__ float dpp_add(float v) { return v + __uint_as_float((unsigned)__builtin_amdgcn_update_dpp(0, (int)__float_as_uint(v), CTRL, 0xF, 0xF, true)); }
__device__ __forceinline__ float wave_sum64(float v) {
    v = dpp_add<0xB1>(v); v = dpp_add<0x4E>(v); v = dpp_add<0x141>(v); v = dpp_add<0x140>(v);
    { auto rr = __builtin_amdgcn_permlane16_swap(__float_as_uint(v), __float_as_uint(v), false, false); v = __uint_as_float(rr[0]) + __uint_as_float(rr[1]); }
    { auto rr = __builtin_amdgcn_permlane32_swap(__float_as_uint(v), __float_as_uint(v), false, false); v = __uint_as_float(rr[0]) + __uint_as_float(rr[1]); }
    return v;
}
__device__ __forceinline__ f32x4 unpack_bf16x4(u32x2 w) { return (f32x4){__builtin_bit_cast(float, w.x << 16), __builtin_bit_cast(float, w.x & 0xffff0000u), __builtin_bit_cast(float, w.y << 16), __builtin_bit_cast(float, w.y & 0xffff0000u)}; }
template <int MODE, int NR>
__device__ __forceinline__ void norm_rows(Frame& F, bool from_inputs, int layer, int which, int row0, const f32x4 (&gg)[4], int lane) {
    f32x4 v[NR][4]; u32x2 xw[NR][4];
    if (from_inputs) {
        const float* xr = row0 < MP ? F.x_p + (size_t)row0 * D : F.x_s + (size_t)(row0 - MP) * D;
#pragma unroll
        for (int r = 0; r < NR; ++r)
#pragma unroll
            for (int j = 0; j < 4; ++j) v[r][j] = *(const f32x4*)(xr + (size_t)r * D + 4 * lane + 256 * j);
    } else {
        const bf16_t* xr = (const bf16_t*)(F.ws + WS_X) + (size_t)row0 * D;
#pragma unroll
        for (int r = 0; r < NR; ++r)
#pragma unroll
            for (int j = 0; j < 4; ++j) xw[r][j] = *(const u32x2*)(xr + (size_t)r * D + 4 * lane + 256 * j);
    }
#define NV(r, j) (from_inputs ? v[r][j] : unpack_bf16x4(xw[r][j]))
    f32x4 sh[4], sc[4];
    if constexpr (MODE == 0) {
        const int bb = row0 < MP ? (row0 >> 12) : NB + ((row0 - MP) >> 2);
        const float* mp = (const float*)(F.ws + WS_MOD) + ((size_t)layer * NMODB + bb) * 6144 + (which ? 3072 : 0);
#pragma unroll
        for (int j = 0; j < 4; ++j) { sh[j] = *(const f32x4*)(mp + 4 * lane + 256 * j); sc[j] = *(const f32x4*)(mp + 1024 + 4 * lane + 256 * j) + 1.0f; }
    }
    float ss[NR];
#pragma unroll
    for (int r = 0; r < NR; ++r) { float a = 0.f;
#pragma unroll
        for (int j = 0; j < 4; ++j) { const f32x4 x = NV(r, j); a += (x[0] * x[0] + x[1] * x[1]) + (x[2] * x[2] + x[3] * x[3]); }
        ss[r] = a; }
    if (!from_inputs) {
#pragma unroll
        for (int r = 0; r < NR; ++r)
#pragma unroll
            for (int j = 0; j < 4; ++j) asm volatile("" : "+v"(xw[r][j].x), "+v"(xw[r][j].y));
    }
#pragma unroll
    for (int r = 0; r < NR; ++r) ss[r] = wave_sum64(ss[r]);
#pragma unroll
    for (int r = 0; r < NR; ++r) {
        const int row = row0 + r; const float rstd = 1.0f / sqrtf(ss[r] * (1.0f / D) + 1e-6f);
        if constexpr (MODE == 2) {
            float* o = row < MP ? F.out + O_YP + (size_t)row * D : F.out + O_YS + (size_t)(row - MP) * D;
#pragma unroll
            for (int j = 0; j < 4; ++j) *(f32x4*)(o + 4 * lane + 256 * j) = NV(r, j) * rstd * gg[j];
        } else if constexpr (MODE == 1) {
            if (lane == 0) ((float*)(F.ws + WS_RSTD))[row] = rstd;
        } else {
#pragma unroll
            for (int j = 0; j < 4; ++j) { const int col = 4 * lane + 256 * j; const f32x4 h = (NV(r, j) * rstd * gg[j]) * sc[j] + sh[j];
                u32x2 w; w.x = cvtpk(h[0], h[1]); w.y = cvtpk(h[2], h[3]); *(u32x2*)((bf16_t*)(F.ws + WS_H) + (size_t)row * D + col) = w; }
        }
    }
#undef NV
}
#ifndef NRX
#define NRX 4
#endif
template <int MODE>
__device__ __forceinline__ void norm_phase(Frame& F, bool from_inputs, int layer, int which) {
    const int gw = F.vcu * 8 + F.wave, NGW = F.G * 8, lane = lane_id();
    const float* gvec = MODE == 2 ? F.final_g : F.norm_g + (size_t)(layer * 2 + which) * D;
    f32x4 gg[4];
#pragma unroll
    for (int j = 0; j < 4; ++j) gg[j] = *(const f32x4*)(gvec + 4 * lane + 256 * j);
    if (from_inputs) {
#pragma unroll 1
        for (int grp = gw; grp < MP / 4; grp += NGW) norm_rows<MODE, 4>(F, true, layer, which, grp * 4, gg, lane);
    } else {
#pragma unroll 1
        for (int grp = gw; grp < MP / NRX; grp += NGW) norm_rows<MODE, NRX>(F, false, layer, which, grp * NRX, gg, lane);
    }
#pragma unroll 1
    for (int r = gw; r < MS; r += NGW) norm_rows<MODE, 1>(F, from_inputs, layer, which, MP + r, gg, lane);
}

template <int W, int R, bool SAMPLE>
__device__ __forceinline__ void pool_chunk(const bf16_t* X, const float* rstd, f32x4 a4, f32x4 s4, const float* st_pool, bf16_t* H, float* out, int row0, int col) {
    f32x4 v[R + W - 1];
    const int t0 = SAMPLE ? 0 : (row0 & (SEQ - 1));
    u32x2 xw[R + W - 1]; float rs[R + W - 1];
#pragma unroll
    for (int k = 0; k < R + W - 1; ++k) { const int tt = t0 - (W - 1) + k;
        if (SAMPLE) { const int b = (row0 - MP) >> 2;
            if (tt >= 0) { xw[k] = *(const u32x2*)(X + (size_t)(row0 + tt) * D + col); rs[k] = rstd[row0 + tt]; }
            else v[k] = *(const f32x4*)(st_pool + ((size_t)b * 15 + 15 + tt) * D + col); }
        else if (tt >= 0) { xw[k] = *(const u32x2*)(X + (size_t)(row0 - (W - 1) + k) * D + col); rs[k] = rstd[row0 - (W - 1) + k]; }
        else { xw[k] = (u32x2){0u, 0u}; rs[k] = 0.f; } }
#pragma unroll
    for (int k = 0; k < R + W - 1; ++k) { const int tt = t0 - (W - 1) + k;
        if (SAMPLE) { if (tt >= 0) v[k] = unpack_bf16x4(xw[k]) * rs[k] * a4 + s4; }
        else v[k] = tt >= 0 ? unpack_bf16x4(xw[k]) * rs[k] * a4 + s4 : (f32x4){0.f, 0.f, 0.f, 0.f}; }
    f32x4 sacc = v[0];
#pragma unroll
    for (int k = 1; k < W; ++k) sacc = sacc + v[k];
#pragma unroll
    for (int r = 0; r < R; ++r) {
        if (r > 0) sacc = sacc + v[r + W - 1] - v[r - 1];
        const int tt = t0 + r; const float inv = 1.0f / (float)(SAMPLE ? W : (tt + 1 < W ? tt + 1 : W));
        const f32x4 cur = v[r + W - 1], pv = sacc * inv - cur;
        u32x2 w2; w2.x = cvtpk(pv[0], pv[1]); w2.y = cvtpk(pv[2], pv[3]); *(u32x2*)(H + (size_t)(row0 + r) * D + col) = w2;
        if (SAMPLE) { const int rsn = row0 - MP + r; *(f32x4*)(out + O_PLS + ((size_t)(rsn >> 2) * 15 + 11 + (rsn & 3)) * D + col) = cur; }
        else if (tt >= SEQ - 15) *(f32x4*)(out + O_PLP + ((size_t)((row0 + r) >> 12) * 15 + (tt - (SEQ - 15))) * D + col) = cur; }
}
__device__ __forceinline__ void pool_phase(Frame& F) {
    const int gt = (F.vcu * 8 + F.wave) * 64 + lane_id(), NT = F.G * 512;
    const bf16_t* X = (const bf16_t*)(F.ws + WS_X); const float* rstd = (const float*)(F.ws + WS_RSTD); bf16_t* H = (bf16_t*)(F.ws + WS_H);
    constexpr int NPI = (MP / 8) * 256, NSI = (MS / 4) * 256;
#pragma unroll 1
    for (int i = gt; i < NPI + NSI; i += NT) {
        const bool smp = i >= NPI; const int q = smp ? i - NPI : i; const int cg = q & 255, col = cg * 4, grp = cg >> 6;
        const int row0 = smp ? MP + (q >> 8) * 4 : (q >> 8) * 8, bb = smp ? NB + ((row0 - MP) >> 2) : (row0 >> 12);
        const float* mp = (const float*)(F.ws + WS_MOD) + ((size_t)NMODB + bb) * 6144;
        const f32x4 a4 = *(const f32x4*)(F.norm_g + (size_t)2 * D + col) * (*(const f32x4*)(mp + 1024 + col) + 1.0f), s4 = *(const f32x4*)(mp + col);
        if (!smp) {
            if (grp == 0) pool_chunk<2, 8, false>(X, rstd, a4, s4, F.st_pool, H, F.out, row0, col); else if (grp == 1) pool_chunk<4, 8, false>(X, rstd, a4, s4, F.st_pool, H, F.out, row0, col);
            else if (grp == 2) pool_chunk<8, 8, false>(X, rstd, a4, s4, F.st_pool, H, F.out, row0, col); else pool_chunk<16, 8, false>(X, rstd, a4, s4, F.st_pool, H, F.out, row0, col); }
        else {
            if (grp == 0) pool_chunk<2, 4, true>(X, rstd, a4, s4, F.st_pool, H, F.out, row0, col); else if (grp == 1) pool_chunk<4, 4, true>(X, rstd, a4, s4, F.st_pool, H, F.out, row0, col);
            else if (grp == 2) pool_chunk<8, 4, true>(X, rstd, a4, s4, F.st_pool, H, F.out, row0, col); else pool_chunk<16, 4, true>(X, rstd, a4, s4, F.st_pool, H, F.out, row0, col); }
    }
}

namespace att {
__device__ __forceinline__ int crow(int r, int hi) { return (r & 3) + 8 * (r >> 2) + 4 * hi; }
__device__ __forceinline__ float x32_sum(float v) { auto rr = __builtin_amdgcn_permlane32_swap(__float_as_uint(v), __float_as_uint(v), false, false); return __uint_as_float(rr[0]) + __uint_as_float(rr[1]); }
__device__ __forceinline__ float x32_max(float v) { auto rr = __builtin_amdgcn_permlane32_swap(__float_as_uint(v), __float_as_uint(v), false, false); return fmaxf(__uint_as_float(rr[0]), __uint_as_float(rr[1])); }
__device__ __forceinline__ unsigned x32_or(unsigned v) { auto rr = __builtin_amdgcn_permlane32_swap(v, v, false, false); return rr[0] | rr[1]; }
template <int X> __device__ __forceinline__ unsigned swz_xor(unsigned v) { return (unsigned)__builtin_amdgcn_ds_swizzle((int)v, (X << 10) | 0x1F); }
template <int X> __device__ __forceinline__ float swz_xorf(float v) { return __uint_as_float(swz_xor<X>(__float_as_uint(v))); }
__device__ __forceinline__ s16x4 vtr(const LAS unsigned char* p) { typedef short v4i16_t __attribute__((ext_vector_type(4))); return __builtin_bit_cast(s16x4, __builtin_amdgcn_ds_read_tr16_b64_v4i16((LAS v4i16_t*)p)); }
__device__ __forceinline__ void qk_tile(f32x16& p0, f32x16& p1, const LAS unsigned char* Kb, const bf16x8 (&qr)[4], float init, int r32, int hi) {
    f32x16 ci;
#pragma unroll
    for (int r = 0; r < 16; ++r) ci[r] = init;
    const int sw = (r32 >> 1) & 7;
    bf16x8 ka[4], kb[4];
#pragma unroll
    for (int ds = 0; ds < 4; ++ds) { const int ch = ((2 * ds + hi) ^ sw) << 4; ka[ds] = *(const LAS bf16x8*)(Kb + r32 * 128 + ch); kb[ds] = *(const LAS bf16x8*)(Kb + (32 + r32) * 128 + ch); }
    __builtin_amdgcn_s_setprio(1);
    f32x16 c0 = __builtin_amdgcn_mfma_f32_32x32x16_bf16(ka[0], qr[0], ci, 0, 0, 0);
    f32x16 c1 = __builtin_amdgcn_mfma_f32_32x32x16_bf16(kb[0], qr[0], ci, 0, 0, 0);
#pragma unroll
    for (int ds = 1; ds < 4; ++ds) {
        c0 = __builtin_amdgcn_mfma_f32_32x32x16_bf16(ka[ds], qr[ds], c0, 0, 0, 0);
        c1 = __builtin_amdgcn_mfma_f32_32x32x16_bf16(kb[ds], qr[ds], c1, 0, 0, 0);
    }
    __builtin_amdgcn_s_setprio(0);
    p0 = c0; p1 = c1;
}
__device__ __forceinline__ void pv_tile(f32x16 (&o)[2], const LAS unsigned char* Vb, const f32x16& p0, const f32x16& p1, int lane) {
    const int g4 = lane >> 4, nhalf = g4 & 1, h = g4 >> 1, i = lane & 15, q = i >> 2, pp = i & 3;
    const LAS unsigned char* vb = Vb + (4 * h + q) * 64 + nhalf * 32 + pp * 8;
#pragma unroll
    for (int kh = 0; kh < 2; ++kh) {
        s16x4 lo[2][2], hh[2][2];
#pragma unroll
        for (int s = 0; s < 2; ++s)
#pragma unroll
            for (int db = 0; db < 2; ++db) { lo[s][db] = vtr(vb + db * 4096 + (32 * kh + 16 * s) * 64); hh[s][db] = vtr(vb + db * 4096 + (32 * kh + 16 * s + 8) * 64); }
#pragma unroll
        for (int s = 0; s < 2; ++s) {
            const f32x16& p = kh ? p1 : p0; u32x4 pw;
            pw.x = cvtpk(p[8 * s + 0], p[8 * s + 1]); pw.y = cvtpk(p[8 * s + 2], p[8 * s + 3]); pw.z = cvtpk(p[8 * s + 4], p[8 * s + 5]); pw.w = cvtpk(p[8 * s + 6], p[8 * s + 7]);
            const bf16x8 pa = __builtin_bit_cast(bf16x8, pw);
#pragma unroll
            for (int db = 0; db < 2; ++db) {
                const bf16x8 vf = (bf16x8){lo[s][db][0], lo[s][db][1], lo[s][db][2], lo[s][db][3], hh[s][db][0], hh[s][db][1], hh[s][db][2], hh[s][db][3]};
                o[db] = __builtin_amdgcn_mfma_f32_32x32x16_bf16(pa, vf, o[db], 0, 0, 0);
            }
        }
    }
}
__device__ __forceinline__ void row_scale(f32x16 (&o)[2], float f, LAS float* wsf, int r32, int hi) {
    if (hi == 0) wsf[r32] = f;
    LDS_WAIT();
    const LAS float* wh = wsf + 4 * hi;
#pragma unroll
    for (int r = 0; r < 16; ++r) { const float fr = wh[CROW0(r)]; o[0][r] *= fr; o[1][r] *= fr; }
    LDS_WAIT();
}
__device__ __forceinline__ void row_fma(f32x16 (&dst)[2], const f32x16 (&o)[2], float f, LAS float* wsf, int r32, int hi) {
    if (hi == 0) wsf[r32] = f;
    LDS_WAIT();
    const LAS float* wh = wsf + 4 * hi;
#pragma unroll
    for (int r = 0; r < 16; ++r) { const float fr = wh[CROW0(r)]; dst[0][r] += fr * o[0][r]; dst[1][r] += fr * o[1][r]; }
    LDS_WAIT();
}
__device__ __forceinline__ void softmax_update(f32x16& p0, f32x16& p1, float& m, float& l, f32x16 (&o)[2], LAS float* wsf, int r32, int hi) {
    float rm = fmaxf(p0[0], p1[0]);
#pragma unroll
    for (int r = 1; r < 16; ++r) rm = fmaxf(rm, fmaxf(p0[r], p1[r]));
    rm = x32_max(rm);
    const float mn = fmaxf(m, rm), f = ex2(m - mn);
    m = mn; float s = 0.f;
#pragma unroll
    for (int r = 0; r < 16; ++r) { p0[r] = ex2(p0[r] - mn); p1[r] = ex2(p1[r] - mn); s += p0[r] + p1[r]; }
    l = l * f + s;
    if (__any(f != 1.0f)) row_scale(o, f, wsf, r32, hi);
}
__device__ __forceinline__ void softmax_full(f32x16& a0, f32x16& a1, f32x16& b0, f32x16& b1) {
    float rm = -1e30f;
#pragma unroll
    for (int r = 0; r < 16; ++r) rm = fmaxf(rm, fmaxf(fmaxf(a0[r], a1[r]), fmaxf(b0[r], b1[r])));
    rm = x32_max(rm); float s = 0.f;
#pragma unroll
    for (int r = 0; r < 16; ++r) { a0[r] = ex2(a0[r] - rm); a1[r] = ex2(a1[r] - rm); b0[r] = ex2(b0[r] - rm); b1[r] = ex2(b1[r] - rm); s += (a0[r] + a1[r]) + (b0[r] + b1[r]); }
    s = x32_sum(s);
    const float inv = s > 0.f ? 1.0f / s : 0.f;
#pragma unroll
    for (int r = 0; r < 16; ++r) { a0[r] *= inv; a1[r] *= inv; b0[r] *= inv; b1[r] *= inv; }
}
__device__ __forceinline__ unsigned imp_key(float v, int j, int c) {
    const bool forced = (j == 0) | (j == c) | (j == c - 1);
    const unsigned base = forced ? 0x7F000000u : (j <= c ? (__float_as_uint(v) & 0xFFFFFFC0u) : 0u);
    return base | (unsigned)(63 - j);
}
__device__ __forceinline__ void imp_store(const f32x16& p0, const f32x16& p1, int T, LAS unsigned* impq  , int c, int g, int hi) {
#pragma unroll
    for (int kh = 0; kh < 2; ++kh)
#pragma unroll
        for (int a = 0; a < 4; ++a) {
            const f32x16& p = kh ? p1 : p0; float e0 = p[4 * a] + p[4 * a + 1], e1 = p[4 * a + 2] + p[4 * a + 3];
            e0 += swz_xorf<8>(e0); e0 += swz_xorf<16>(e0); e1 += swz_xorf<8>(e1); e1 += swz_xorf<16>(e1);
            const int jc = 32 * T + 16 * kh + 4 * a, j0 = jc + 2 * hi;
            if (g == 0) { u32x2 w; w.x = imp_key(e0, j0, c); w.y = imp_key(e1, j0 + 1, c); *(LAS u32x2*)(impq + 2 * hi + jc) = w; }
        }
}
__device__ __forceinline__ unsigned long long select_mask(const LAS unsigned* impq, int g, int hi, int nq4 = 16) {
    LDS_WAIT();
    unsigned mk[8], cnt[8];
#pragma unroll
    for (int a = 0; a < 4; ++a) { const u32x2 w = *(const LAS u32x2*)(impq + (16 * g + 2 * hi) + 4 * a); mk[2 * a] = w.x; mk[2 * a + 1] = w.y; cnt[2 * a] = 0; cnt[2 * a + 1] = 0; }
#pragma unroll 4
    for (int jj = 0; jj < nq4; ++jj) { const u32x4 kx = *(const LAS u32x4*)(impq + 4 * jj);
#pragma unroll
        for (int ci = 0; ci < 8; ++ci) cnt[ci] += (unsigned)(kx.x > mk[ci]) + (unsigned)(kx.y > mk[ci]) + (unsigned)(kx.z > mk[ci]) + (unsigned)(kx.w > mk[ci]); }
    unsigned lb = 0u;
#pragma unroll
    for (int a = 0; a < 4; ++a)
#pragma unroll
        for (int e = 0; e < 2; ++e) lb |= (cnt[2 * a + e] < 16u ? 1u : 0u) << (4 * a + e);
    const unsigned long long mm = (unsigned long long)lb << (16 * g + 2 * hi);
    unsigned lo = (unsigned)mm, hh = (unsigned)(mm >> 32);
    lo |= swz_xor<8>(lo); hh |= swz_xor<8>(hh); lo |= swz_xor<16>(lo); hh |= swz_xor<16>(hh); lo = x32_or(lo); hh = x32_or(hh);
    return ((unsigned long long)hh << 32) | lo;
}
__device__ __forceinline__ unsigned long long wave_or64(unsigned long long m) {
    unsigned lo = (unsigned)m, hh = (unsigned)(m >> 32);
    lo |= swz_xor<1>(lo); hh |= swz_xor<1>(hh); lo |= swz_xor<2>(lo); hh |= swz_xor<2>(hh); lo |= swz_xor<4>(lo); hh |= swz_xor<4>(hh);
    lo |= swz_xor<8>(lo); hh |= swz_xor<8>(hh); lo |= swz_xor<16>(lo); hh |= swz_xor<16>(hh); lo = x32_or(lo); hh = x32_or(hh);
    return ((unsigned long long)(unsigned)__builtin_amdgcn_readfirstlane(hh) << 32) | (unsigned)__builtin_amdgcn_readfirstlane(lo);
}
__device__ __forceinline__ void mask_bias(f32x16& p0, f32x16& p1, int t, int pos0, int stride, int wlim, bool sel, bool near, const LAS float* lut, int hi) {
#pragma unroll
    for (int kh = 0; kh < 2; ++kh)
#pragma unroll
        for (int r = 0; r < 16; ++r) { const int kk = 32 * kh + crow(r, hi), dist = t - pos0 - stride * kk; const bool ok = sel && dist >= 0 && dist < wlim;
            float bv = 0.f; if (near) { const int di = dist < 0 ? 0 : (dist > 127 ? 127 : dist); bv = lut[di]; }
            if (kh) p1[r] = ok ? p1[r] + bv : -INFINITY; else p0[r] = ok ? p0[r] + bv : -INFINITY; }
}
template <bool CAUSAL>
__device__ __forceinline__ void mask_bias_near(f32x16& p0, f32x16& p1, int t, int pos0, bool sel, const LAS float* xlg, int hi) {
    const int dist0 = t - pos0 - 4 * hi;
    const LAS float* bp = xlg + (dist0 + 4);
#pragma unroll
    for (int kh = 0; kh < 2; ++kh)
#pragma unroll
        for (int r = 0; r < 16; ++r) { const int kc = 32 * kh + CROW0(r); const float bv = bp[63 - kc]; bool ok = sel; if (CAUSAL) ok = ok && (dist0 - kc >= 0);
            if (kh) p1[r] = ok ? p1[r] + bv : -INFINITY; else p0[r] = ok ? p0[r] + bv : -INFINITY; }
}
struct Ptrs { const bf16_t *Q, *kcp, *vcp, *kcs, *vcs, *KS, *VS, *KW, *VW; const float* gates; bf16_t* O; const float *ck_sel, *cv_sel, *st_kw, *st_vw; const int* pt; int gov; float* kw_out; float* vw_out; };
#ifdef VERIFY
#define GATEV(P, row, head, br) ((P).gov < 0 ? sigmoidf_((P).gates[(size_t)(row) * 48 + (head) * 3 + (br)]) : ((P).gov == (br) ? 1.0f : 0.0f))
#else
#define GATEV(P, row, head, br) sigmoidf_((P).gates[(size_t)(row) * 48 + (head) * 3 + (br)])
#endif

template <bool ACC>
__device__ __forceinline__ void row_out(LAS float* ow, const f32x16 (&o)[2], float f, LAS float* wsf, int r32, int hi) {
    if (hi == 0) wsf[r32] = f;
    LDS_WAIT();
    const LAS float* wh = wsf + 4 * hi; LAS float* ob = ow + hi * 256 + r32;
#pragma unroll
    for (int r = 0; r < 16; ++r) { const float fr = wh[CROW0(r)]; LAS float* p = ob + CROW0(r) * 64;
        if (ACC) { p[0] += fr * o[0][r]; p[32] += fr * o[1][r]; } else { p[0] = fr * o[0][r]; p[32] = fr * o[1][r]; } }
    LDS_WAIT();
}
template <bool NEXT>
__device__ __forceinline__ void tile_block(f32x16& s0, f32x16& s1, f32x16& n0, f32x16& n1, const LAS unsigned char* KBn, float ninit, const LAS unsigned char* VB, const bf16x8 (&qr)[4],
                                           float m, float& l, f32x16 (&o)[2], int lane, int r32, int hi) {
    if (NEXT) qk_tile(n0, n1, KBn, qr, ninit, r32, hi);
    float sacc = 0.f;
#pragma unroll
    for (int r = 0; r < 16; ++r) { s0[r] = ex2(s0[r] - m); s1[r] = ex2(s1[r] - m); sacc += s0[r] + s1[r]; }
    l += sacc;
    pv_tile(o, VB, s0, s1, lane);
}
#define AS_SBAR() __builtin_amdgcn_sched_barrier(0)
#define AS_PIN(x) asm volatile("" : "+v"(x))
#define AS_MFMA(a, b, c) __builtin_amdgcn_mfma_f32_32x32x16_bf16(a, b, c, 0, 0, 0)
#define AS_WAIT_BAR(N) asm volatile("s_waitcnt vmcnt(" #N ") lgkmcnt(0)\n\ts_barrier" ::: "memory")
#define AS_MX3(a, b, c) __builtin_fmaxf(__builtin_fmaxf((a), (b)), (c))
__device__ __forceinline__ void as_glds16(const void* gsrc, unsigned lds_base) {
    unsigned sv; asm volatile("s_mov_b32 %0, m0\n\ts_mov_b32 m0, %2\n\ts_nop 0\n\tglobal_load_lds_dwordx4 %1, off\n\ts_mov_b32 m0, %0" : "=&s"(sv) : "v"(gsrc), "s"(lds_base) : "memory"); }
__device__ __forceinline__ void as_kload2(bf16x8* kf, const LAS unsigned char* kp, int d0) { kf[2 * d0] = *(const LAS bf16x8*)(kp + d0 * 2048); kf[2 * d0 + 1] = *(const LAS bf16x8*)(kp + d0 * 2048 + 512); }
__device__ __forceinline__ float as_rowmax(const f32x16& p0, const f32x16& p1) {
    float a = AS_MX3(p0[0], p0[1], p1[0]), b = AS_MX3(p0[2], p0[3], p1[1]); a = AS_MX3(a, p1[2], p1[3]);
#pragma unroll
    for (int r = 4; r < 16; r += 4) { a = AS_MX3(a, p0[r], p0[r + 1]); b = AS_MX3(b, p0[r + 2], p0[r + 3]); a = AS_MX3(a, p1[r], p1[r + 1]); b = AS_MX3(b, p1[r + 2], p1[r + 3]); }
    return x32_max(__builtin_fmaxf(a, b)); }
__device__ __forceinline__ float as_mask(f32x16& c0, f32x16& c1, int u, int nsel, int nwin, int c, int t, unsigned long long mymask, float bfar, const LAS float* xlg, const LAS float* lut, int hi) {
    if (u >= nsel + nwin) {
#pragma unroll
        for (int r = 0; r < 16; ++r) { c0[r] = -INFINITY; c1[r] = -INFINITY; }
        return 0.f; }
    const bool win = u >= nsel; const int j = win ? c - nwin + 1 + (u - nsel) : u;
    const bool sel = win || ((mymask >> j) & 1ull);
    if (j >= c - 2) { if (j == c) mask_bias_near<true>(c0, c1, t, 64 * j, sel, xlg, hi); else mask_bias_near<false>(c0, c1, t, 64 * j, sel, xlg, hi); return 0.f; }
    if (win) { if (j == c - 8) mask_bias(c0, c1, t, 64 * j, 1, 512, true, false, lut, hi); }
    else {
#pragma unroll
        for (int r = 0; r < 16; ++r) { c0[r] = sel ? c0[r] : -INFINITY; c1[r] = sel ? c1[r] : -INFINITY; } }
    return bfar;
}
__device__ __forceinline__ void attn_stream(const bf16_t* ksb, const bf16_t* vsb, const bf16_t* kwb, const bf16_t* vwb  , int nsel, int nwin, int NT, int c, int t,
                                            unsigned long long mymask, const bf16x8 (&qr)[4], float bfar, const LAS float* xlg, const LAS float* lut, float gate1, float gate2,
                                            LAS unsigned char* L, LAS float* wsf, LAS float* ow, int wave, int lane) {
    constexpr int SLOTB = 8192, LDS_K = 0, LDS_V = 3 * SLOTB;
    const int r32 = lane & 31, hi = lane >> 5;
    const unsigned lds0 = (unsigned)(unsigned long long)L;
    const int nreal = nsel + nwin;
    const unsigned klo = (unsigned)lane * 256 + wave * 8, vlo_ = (unsigned)(16 * (wave & 3) + (lane >> 2)) * 256 + (wave >> 2) * 32 + (lane & 3) * 8;
    const unsigned kdst = lds0 + LDS_K + wave * 1024, vdst = lds0 + LDS_V + wave * 1024;
#define AS_UT(u) ((u) < nreal ? (u) : nreal - 1)
#define AS_JB(u) (AS_UT(u) < nsel ? AS_UT(u) : c - nwin + 1 + (AS_UT(u) - nsel))
#define AS_DMA_K(u, slot) as_glds16((AS_UT(u) < nsel ? ksb : kwb) + klo + (size_t)AS_JB(u) * (64 * 256), (unsigned)__builtin_amdgcn_readfirstlane((int)(kdst + (slot))))
#define AS_DMA_V(u, slot) as_glds16((AS_UT(u) < nsel ? vsb : vwb) + vlo_ + (size_t)AS_JB(u) * (64 * 256), (unsigned)__builtin_amdgcn_readfirstlane((int)(vdst + (slot))))
    const LAS unsigned char* vp0 = L + LDS_V + ((lane >> 4) & 1) * 32 + (lane & 3) * 8 + (4 * hi + ((lane & 15) >> 2)) * 64;
    const LAS unsigned char* kp0 = L + LDS_K + hi * 1024 + r32 * 16;
    AS_DMA_K(0, 0); AS_DMA_V(0, 0); AS_DMA_K(1, SLOTB); AS_DMA_K(2, 2 * SLOTB);
    float mhat = 0.f, l_reg = 0.f, l_sel = 0.f; f32x16 o[2];
#pragma unroll
    for (int r = 0; r < 16; ++r) { o[0][r] = 0.f; o[1][r] = 0.f; }
    const f32x16 zero16 = {0.f, 0.f, 0.f, 0.f, 0.f, 0.f, 0.f, 0.f, 0.f, 0.f, 0.f, 0.f, 0.f, 0.f, 0.f, 0.f};
    bool resc = false, bnd = false;
    f32x16 pA0, pA1, pB0, pB1; bf16x8 kf[8]; s16x4 vlo[8], vhi[8]; u32x4 pw0, pw1, pw2, pw3;
    int sl_prev = 0, sl_cur = 0, sl_next = SLOTB;
#define AS_ROT() do { sl_prev = sl_cur; sl_cur = sl_next; sl_next = (sl_next == 2 * SLOTB) ? 0 : sl_next + SLOTB; } while (0)
#define AS_EX(v) __builtin_amdgcn_exp2f((v) + nmh)
#define AS_RESC() do { if (resc) { const LAS float* wh_ = wsf + 4 * hi; _Pragma("unroll") for (int d_ = 0; d_ < 2; ++d_) _Pragma("unroll") for (int r = 0; r < 16; ++r) o[d_][r] *= wh_[CROW0(r)]; } } while (0)
#define AS_BND() do { if (bnd) { const float lt_ = x32_sum(l_sel); row_out<true>(ow, o, lt_ > 0.f ? gate1 / lt_ : 0.f, wsf, r32, hi); _Pragma("unroll") for (int r = 0; r < 16; ++r) { o[0][r] = 0.f; o[1][r] = 0.f; } bnd = false; } } while (0)
    AS_WAIT_BAR(3);
#pragma unroll
    for (int d0 = 0; d0 < 4; ++d0) as_kload2(kf, kp0, d0);
    pA0 = AS_MFMA(kf[0], qr[0], zero16); pA1 = AS_MFMA(kf[1], qr[0], zero16); pA0 = AS_MFMA(kf[2], qr[1], pA0); pA1 = AS_MFMA(kf[3], qr[1], pA1);
    pA0 = AS_MFMA(kf[4], qr[2], pA0); pA1 = AS_MFMA(kf[5], qr[2], pA1); pA0 = AS_MFMA(kf[6], qr[3], pA0); pA1 = AS_MFMA(kf[7], qr[3], pA1);
    { const float bc = as_mask(pA0, pA1, 0, nsel, nwin, c, t, mymask, bfar, xlg, lut, hi);
      const float rm = as_rowmax(pA0, pA1) + bc; mhat = __builtin_fmaxf(rm, -60.f); const float nmh = bc - mhat;
#pragma unroll
      for (int r = 0; r < 16; ++r) { pA0[r] = AS_EX(pA0[r]); pA1[r] = AS_EX(pA1[r]); } }
    AS_WAIT_BAR(0);
    AS_DMA_K(3, 0); AS_DMA_V(1, SLOTB); AS_ROT();
#pragma unroll
    for (int d0 = 0; d0 < 4; ++d0) as_kload2(kf, kp0 + sl_cur, d0);
    AS_WAIT_BAR(2);
#define AS_PKW(P, i) cvtpk(P[i], P[i + 1])
#define AS_PAF(k) __builtin_bit_cast(bf16x8, pw##k)
#define AS_VFR(i) (bf16x8){vlo[i][0], vlo[i][1], vlo[i][2], vlo[i][3], vhi[i][0], vhi[i][1], vhi[i][2], vhi[i][3]}
#define AS_VRD(i) do { vlo[i] = vtr(vp_ + (((i) >> 2) * 4096 + ((i) & 3) * 1024)); vhi[i] = vtr(vp_ + (((i) >> 2) * 4096 + ((i) & 3) * 1024 + 512)); } while (0)
#define AS_KRD(G, d0) do { if (G) { as_kload2(kf, kp0 + sl_next, d0); AS_SBAR(); } } while (0)
#define AS_GAPA(MF, a0, a1, a2, a3, W0, W1, PW) do { MF; sacc += a0; sacc += a1; sacc += a2; sacc += a3; W0; W1; AS_PIN(PW); AS_PIN(sacc); AS_SBAR(); } while (0)
#define AS_GAPB(MF, X, i) do { MF; X[i] = AS_EX(X[i]); X[i + 1] = AS_EX(X[i + 1]); X[i + 2] = AS_EX(X[i + 2]); X[i + 3] = AS_EX(X[i + 3]); AS_PIN(X); AS_SBAR(); } while (0)
#define AS_STEP(C0, C1, P0, P1, tt, MASK, GK, GV, GL) do { AS_SBAR(); \
    const LAS unsigned char* vp_ = vp0 + sl_prev; \
    AS_VRD(0); AS_SBAR(); float sacc = P0[0] + P0[1]; \
                    AS_GAPA(C0 = AS_MFMA(kf[0], qr[0], zero16), P0[2], P0[3], P0[4], P0[5],     pw0[0] = AS_PKW(P0, 0),  pw0[1] = AS_PKW(P0, 2),  pw0); \
    AS_VRD(4); AS_SBAR(); AS_GAPA(C1 = AS_MFMA(kf[1], qr[0], zero16), P0[6], P0[7], P0[8], P0[9],     pw0[2] = AS_PKW(P0, 4),  pw0[3] = AS_PKW(P0, 6),  pw0); \
    AS_VRD(1); AS_SBAR(); AS_GAPA(C0 = AS_MFMA(kf[2], qr[1], C0),    P0[10], P0[11], P0[12], P0[13], pw1[0] = AS_PKW(P0, 8),  pw1[1] = AS_PKW(P0, 10), pw1); \
    AS_VRD(5); AS_SBAR(); AS_GAPA(C1 = AS_MFMA(kf[3], qr[1], C1),    P0[14], P0[15], P1[0], P1[1],   pw1[2] = AS_PKW(P0, 12), pw1[3] = AS_PKW(P0, 14), pw1); \
    AS_VRD(2); AS_SBAR(); AS_GAPA(C0 = AS_MFMA(kf[4], qr[2], C0),    P1[2], P1[3], P1[4], P1[5],     pw2[0] = AS_PKW(P1, 0),  pw2[1] = AS_PKW(P1, 2),  pw2); \
    AS_VRD(6); AS_SBAR(); AS_GAPA(C1 = AS_MFMA(kf[5], qr[2], C1),    P1[6], P1[7], P1[8], P1[9],     pw2[2] = AS_PKW(P1, 4),  pw2[3] = AS_PKW(P1, 6),  pw2); \
    AS_VRD(3); AS_SBAR(); AS_GAPA(C0 = AS_MFMA(kf[6], qr[3], C0),    P1[10], P1[11], P1[12], P1[13], pw3[0] = AS_PKW(P1, 8),  pw3[1] = AS_PKW(P1, 10), pw3); \
    AS_VRD(7); AS_SBAR(); AS_GAPA(C1 = AS_MFMA(kf[7], qr[3], C1),    P1[14], P1[15], 0.f, 0.f,       pw3[2] = AS_PKW(P1, 12), pw3[3] = AS_PKW(P1, 14), pw3); \
    l_reg += sacc; \
    if (GK) AS_DMA_K((tt) + 3, sl_cur); if (GV) AS_DMA_V((tt) + 1, sl_next); \
    float bc_ = bfar; bool sel_ = true; \
    if (MASK) bc_ = as_mask(C0, C1, (tt), nsel, nwin, c, t, mymask, bfar, xlg, lut, hi); \
    else sel_ = (mymask >> (tt)) & 1ull;                             \
    if (MASK && (tt) == nsel) { l_sel = l_reg; l_reg = 0.f; mhat = __builtin_fmaxf(as_rowmax(C0, C1) + bc_, -60.f); resc = false; bnd = true; }     \
    else { const float rm = as_rowmax(C0, C1) + bc_ - mhat; resc = false; \
      if (__builtin_expect(__any(rm > 8.0f), 0)) { const float dl = __builtin_fmaxf(rm, 0.f); mhat += dl; \
          const float f = __builtin_amdgcn_exp2f(-dl); l_reg *= f; if (hi == 0) wsf[r32] = f; resc = true; } } \
    const float nmh = sel_ ? bc_ - mhat : -INFINITY; AS_SBAR(); \
    AS_GAPB(o[0] = AS_MFMA(AS_PAF(0), AS_VFR(0), o[0]), C0, 0);              AS_GAPB(o[1] = AS_MFMA(AS_PAF(0), AS_VFR(4), o[1]), C0, 4); \
    AS_KRD(GL, 0); AS_GAPB(o[0] = AS_MFMA(AS_PAF(1), AS_VFR(1), o[0]), C0, 8);  AS_KRD(GL, 1); AS_GAPB(o[1] = AS_MFMA(AS_PAF(1), AS_VFR(5), o[1]), C0, 12); \
    AS_KRD(GL, 2); AS_GAPB(o[0] = AS_MFMA(AS_PAF(2), AS_VFR(2), o[0]), C1, 0);  AS_KRD(GL, 3); AS_GAPB(o[1] = AS_MFMA(AS_PAF(2), AS_VFR(6), o[1]), C1, 4); \
    AS_GAPB(o[0] = AS_MFMA(AS_PAF(3), AS_VFR(3), o[0]), C1, 8);              AS_GAPB(o[1] = AS_MFMA(AS_PAF(3), AS_VFR(7), o[1]), C1, 12); \
    } while (0)
    int tt = 1;
    for (; tt + 1 < nsel - 3; tt += 2) {
        AS_STEP(pB0, pB1, pA0, pA1, tt, false, true, true, true);     AS_WAIT_BAR(2); AS_RESC(); AS_ROT();
        AS_STEP(pA0, pA1, pB0, pB1, tt + 1, false, true, true, true); AS_WAIT_BAR(2); AS_RESC(); AS_ROT();
    }
#define AS_ENDW(x) do { if ((x) + 3 < NT) { AS_WAIT_BAR(2); } else if ((x) + 2 < NT) { AS_WAIT_BAR(1); } else { AS_WAIT_BAR(0); } } while (0)
    for (; tt + 1 < NT; tt += 2) {
        AS_STEP(pB0, pB1, pA0, pA1, tt, true, (tt + 3 < NT), (tt + 1 < NT), (tt + 1 < NT));         AS_ENDW(tt);     AS_RESC(); AS_BND(); AS_ROT();
        AS_STEP(pA0, pA1, pB0, pB1, tt + 1, true, (tt + 4 < NT), (tt + 2 < NT), (tt + 2 < NT));     AS_ENDW(tt + 1); AS_RESC(); AS_BND(); AS_ROT();
    }
    AS_STEP(pB0, pB1, pA0, pA1, NT - 1, true, false, false, false); AS_RESC(); AS_BND();
    { float sacc = pB0[0] + pB0[1];
#pragma unroll
      for (int r = 2; r < 16; ++r) sacc += pB0[r];
#pragma unroll
      for (int r = 0; r < 16; ++r) sacc += pB1[r];
      l_reg += sacc;
      pw0 = (u32x4){AS_PKW(pB0, 0), AS_PKW(pB0, 2), AS_PKW(pB0, 4), AS_PKW(pB0, 6)}; pw1 = (u32x4){AS_PKW(pB0, 8), AS_PKW(pB0, 10), AS_PKW(pB0, 12), AS_PKW(pB0, 14)};
      pw2 = (u32x4){AS_PKW(pB1, 0), AS_PKW(pB1, 2), AS_PKW(pB1, 4), AS_PKW(pB1, 6)}; pw3 = (u32x4){AS_PKW(pB1, 8), AS_PKW(pB1, 10), AS_PKW(pB1, 12), AS_PKW(pB1, 14)};
      const LAS unsigned char* vp_ = vp0 + sl_cur;
#pragma unroll
      for (int i = 0; i < 8; ++i) AS_VRD(i);
      o[0] = AS_MFMA(AS_PAF(0), AS_VFR(0), o[0]); o[1] = AS_MFMA(AS_PAF(0), AS_VFR(4), o[1]); o[0] = AS_MFMA(AS_PAF(1), AS_VFR(1), o[0]); o[1] = AS_MFMA(AS_PAF(1), AS_VFR(5), o[1]);
      o[0] = AS_MFMA(AS_PAF(2), AS_VFR(2), o[0]); o[1] = AS_MFMA(AS_PAF(2), AS_VFR(6), o[1]); o[0] = AS_MFMA(AS_PAF(3), AS_VFR(3), o[0]); o[1] = AS_MFMA(AS_PAF(3), AS_VFR(7), o[1]); }
    { const float lt = x32_sum(l_reg); const float f = lt > 0.f ? gate2 / lt : 0.f; row_out<true>(ow, o, f, wsf, r32, hi); }
    asm volatile("s_waitcnt lgkmcnt(0)\n\ts_barrier" ::: "memory");
#undef AS_UT
#undef AS_JB
#undef AS_DMA_K
#undef AS_DMA_V
#undef AS_ROT
#undef AS_EX
#undef AS_RESC
#undef AS_BND
#undef AS_PKW
#undef AS_PAF
#undef AS_VFR
#undef AS_VRD
#undef AS_KRD
#undef AS_GAPA
#undef AS_GAPB
#undef AS_STEP
#undef AS_ENDW
}

__device__ __forceinline__ void prompt_unit(const Ptrs& P, LAS unsigned char* L, int b, int kv, int c, int tid, int wave, int lane) {
    asm volatile("" : "+v"(lane), "+v"(tid));
    const int r32 = lane & 31, hi = lane >> 5, g = r32 >> 3, qi = r32 & 7, head = kv * 4 + g;
    const int t = c * 64 + wave * 8 + qi; const unsigned row = (unsigned)b * SEQ + t;
    bf16x8 qr[4];
#pragma unroll
    for (int ds = 0; ds < 4; ++ds) qr[ds] = *(const bf16x8*)(P.Q + (size_t)row * D + head * 64 + ds * 16 + hi * 8);
    const LAS float* lut = (const LAS float*)(L + LUT_OFF) + head * 128; const float bfar = lut[127];
    LAS float* wsf = (LAS float*)(L + WSF_OFF) + wave * 32;
    LAS float* ow = (LAS float*)(L + 65536 + wave * 8192);
    LAS unsigned* impq = (LAS unsigned*)(L + IMP_OFF) + wave * 512 + qi * 64;
    const int skey = tid >> 3, sch = tid & 7;
    const int kwoff = skey * 128 + ((sch ^ ((skey >> 1) & 7)) << 4), vwoff = (sch >> 2) * 4096 + skey * 64 + (sch & 3) * 16;
    LAS unsigned char* KB0 = L; LAS unsigned char* VB0 = L + 32768;
    { const unsigned co = ((unsigned)(b * 4 + kv) * 128 + skey) * 64 + sch * 8;
      const u32x4 k0 = *(const u32x4*)(P.kcp + co), k1 = *(const u32x4*)(P.kcp + co + 4096), v0 = *(const u32x4*)(P.vcp + co), v1 = *(const u32x4*)(P.vcp + co + 4096);
      *(LAS u32x4*)(KB0 + kwoff) = k0; *(LAS u32x4*)(KB0 + 8192 + kwoff) = k1; *(LAS u32x4*)(VB0 + vwoff) = v0; *(LAS u32x4*)(VB0 + 8192 + vwoff) = v1; }
    const int nwin = (c < 8 ? c : 8) + 1;
    __syncthreads();
    f32x16 o[2];
#pragma unroll
    for (int r = 0; r < 16; ++r) { o[0][r] = 0.f; o[1][r] = 0.f; }
    unsigned long long mymask = ~0ull;
    if (c <= 30) {
        f32x16 a0, a1; qk_tile(a0, a1, KB0, qr, 0.f, r32, hi); mask_bias(a0, a1, t, 31, 32, 1 << 30, true, true, lut, hi);
        float rm = fmaxf(a0[0], a1[0]);
#pragma unroll
        for (int r = 1; r < 16; ++r) rm = fmaxf(rm, fmaxf(a0[r], a1[r]));
        rm = fmaxf(x32_max(rm), -1e30f); float sacc = 0.f;
#pragma unroll
        for (int r = 0; r < 16; ++r) { a0[r] = ex2(a0[r] - rm); a1[r] = ex2(a1[r] - rm); sacc += a0[r] + a1[r]; }
        sacc = x32_sum(sacc); const float cinv = sacc > 0.f ? 1.0f / sacc : 0.f;
#pragma unroll
        for (int r = 0; r < 16; ++r) { a0[r] *= cinv; a1[r] *= cinv; }
        if (c >= 16) { imp_store(a0, a1, 0, impq, c, g, hi);
            if (g == 0) {
#pragma unroll
                for (int q8 = 0; q8 < 8; ++q8) { const int jc = 32 + 4 * q8; u32x2 w; w.x = imp_key(0.f, jc + 2 * hi, c); w.y = imp_key(0.f, jc + 2 * hi + 1, c); *(LAS u32x2*)(impq + 2 * hi + jc) = w; } } }
        pv_tile(o, VB0, a0, a1, lane);
    } else {
        f32x16 a0, a1, b0, b1;
        qk_tile(a0, a1, KB0, qr, 0.f, r32, hi); mask_bias(a0, a1, t, 31, 32, 1 << 30, true, true, lut, hi);
        qk_tile(b0, b1, KB0 + 8192, qr, 0.f, r32, hi); mask_bias(b0, b1, t, 31 + 2048, 32, 1 << 30, true, true, lut, hi);
        float rm = fmaxf(fmaxf(a0[0], a1[0]), fmaxf(b0[0], b1[0]));
#pragma unroll
        for (int r = 1; r < 16; ++r) rm = fmaxf(rm, fmaxf(fmaxf(a0[r], a1[r]), fmaxf(b0[r], b1[r])));
        rm = fmaxf(x32_max(rm), -1e30f); float sacc = 0.f;
#pragma unroll
        for (int r = 0; r < 16; ++r) { a0[r] = ex2(a0[r] - rm); a1[r] = ex2(a1[r] - rm); b0[r] = ex2(b0[r] - rm); b1[r] = ex2(b1[r] - rm); sacc += (a0[r] + a1[r]) + (b0[r] + b1[r]); }
        sacc = x32_sum(sacc); const float cinv = sacc > 0.f ? 1.0f / sacc : 0.f;
#pragma unroll
        for (int r = 0; r < 16; ++r) { a0[r] *= cinv; a1[r] *= cinv; b0[r] *= cinv; b1[r] *= cinv; }
        imp_store(a0, a1, 0, impq, c, g, hi); imp_store(b0, b1, 1, impq, c, g, hi);
        pv_tile(o, VB0, a0, a1, lane); pv_tile(o, VB0 + 8192, b0, b1, lane);
    }
    { const float g0 = GATEV(P, row, head, 0); row_out<false>(ow, o, g0, wsf, r32, hi); }
    if (c >= 16) mymask = select_mask(impq, g, hi, (c + 4) >> 2);
    __syncthreads();
    { LAS float* xl = (LAS float*)(L + IMP_OFF);
      for (int u = tid; u < 4 * 272; u += 512) { const int gg = u / 272, ii = u % 272, dd = ii - 67; xl[u] = ((const LAS float*)(L + LUT_OFF))[(kv * 4 + gg) * 128 + (dd < 0 ? 0 : (dd > 127 ? 127 : dd))]; } }
    const LAS float* xlg = (const LAS float*)(L + IMP_OFF) + g * 272;
    { const size_t kvb = ((size_t)b * SEQ) * 256 + kv * 64; const int nsel = c + 1; int NT = (nsel + nwin + 1) & ~1; if (NT < 4) NT = 4;
      attn_stream(P.KS + kvb, P.VS + kvb, P.KW + kvb, P.VW + kvb, nsel, nwin, NT, c, t, mymask, qr, bfar, xlg, lut, GATEV(P, row, head, 1), GATEV(P, row, head, 2), L, wsf, ow, wave, lane); }
    { const int rr = lane >> 1, hf = lane & 1, gg = rr >> 3, qq = rr & 7; const LAS float* src = ow + rr * 64 + hf * 32;
      bf16_t* op = P.O + ((size_t)b * SEQ + c * 64 + wave * 8 + qq) * D + (kv * 4 + gg) * 64 + hf * 32;
#pragma unroll
      for (int q4 = 0; q4 < 4; ++q4) { const f32x4 x0 = *(const LAS f32x4*)(src + q4 * 8), x1 = *(const LAS f32x4*)(src + q4 * 8 + 4); u32x4 w;
          w.x = cvtpk(x0[0], x0[1]); w.y = cvtpk(x0[2], x0[3]); w.z = cvtpk(x1[0], x1[1]); w.w = cvtpk(x1[2], x1[3]); *(u32x4*)(op + q4 * 8) = w; } }
    __syncthreads();
}

template <bool COPY>
__device__ __forceinline__ void stage_f32_pair(const float* ksrc_, const float* vsrc_, LAS unsigned char* Kb, LAS unsigned char* Vb, int lane, float* kdst_ = nullptr, float* vdst_ = nullptr, int first_row = 0) {
    const int c4 = lane & 15; const char* ks = uniform_ptr(ksrc_); const char* vs = uniform_ptr(vsrc_); const unsigned lo = (unsigned)((lane >> 4) * 1024 + c4 * 16);
    f32x4 x[16], y[16];
#pragma unroll
    for (int it = 0; it < 16; ++it) x[it] = *(const f32x4*)((ks + it * 4096) + lo);
#pragma unroll
    for (int it = 0; it < 16; ++it) y[it] = *(const f32x4*)((vs + it * 4096) + lo);
    if constexpr (COPY) {
        char* kd = (char*)uniform_ptr(kdst_); char* vd = (char*)uniform_ptr(vdst_);
#pragma unroll
        for (int it = 0; it < 16; ++it) { const int key = it * 4 + (lane >> 4);
            if (key >= first_row) __builtin_nontemporal_store(x[it], (f32x4*)((kd + it * 4096) + lo)); }
    }
#pragma unroll
    for (int it = 0; it < 16; ++it) { const int key = it * 4 + (lane >> 4);
        u32x2 w; w.x = cvtpk(x[it][0], x[it][1]); w.y = cvtpk(x[it][2], x[it][3]);
        *(LAS u32x2*)(Kb + key * 128 + (((c4 >> 1) ^ ((key >> 1) & 7)) << 4) + (c4 & 1) * 8) = w; }
    if constexpr (COPY) { char* vd = (char*)uniform_ptr(vdst_);
#pragma unroll
        for (int it = 0; it < 16; ++it) { const int key = it * 4 + (lane >> 4);
            if (key >= first_row) __builtin_nontemporal_store(y[it], (f32x4*)((vd + it * 4096) + lo)); }
    }
#pragma unroll
    for (int it = 0; it < 16; ++it) { const int key = it * 4 + (lane >> 4);
        u32x2 w; w.x = cvtpk(y[it][0], y[it][1]); w.y = cvtpk(y[it][2], y[it][3]);
        *(LAS u32x2*)(Vb + (c4 >> 3) * 4096 + key * 64 + (c4 & 7) * 8) = w; }
    __builtin_amdgcn_sched_barrier(0);
}
__device__ __forceinline__ void stage_bf16_tile(const bf16_t* src_  , LAS unsigned char* Kb, bool isV, int lane) {
    const char* src = uniform_ptr(src_);
#pragma unroll
    for (int it = 0; it < 8; ++it) { const int idx = it * 64 + lane, key = idx >> 3, ch = idx & 7; const u32x4 x = *(const u32x4*)(src + (unsigned)idx * 16u);
        const int off = isV ? ((ch >> 2) * 4096 + key * 64 + (ch & 3) * 16) : (key * 128 + ((ch ^ ((key >> 1) & 7)) << 4));
        *(LAS u32x4*)(Kb + off) = x; }
}
__device__ __forceinline__ void stage_new_tile(const bf16_t* src_  , LAS unsigned char* Kb, bool isV, int lane) {
    const char* src = uniform_ptr(src_);
#pragma unroll
    for (int it = 0; it < 8; ++it) *(LAS u32x4*)(Kb + (it * 64 + lane) * 16) = (u32x4){0u, 0u, 0u, 0u};
    if (lane < 32) { const int key = lane >> 3, ch = lane & 7; const u32x4 x = *(const u32x4*)(src + (unsigned)(key * 512 + ch * 16));
        const int off = isV ? ((ch >> 2) * 4096 + key * 64 + (ch & 3) * 16) : (key * 128 + ((ch ^ ((key >> 1) & 7)) << 4));
        *(LAS u32x4*)(Kb + off) = x; }
}
__device__ __forceinline__ void sample_unit(const Ptrs& P, LAS unsigned char* L, int uA, int uB, int tid, int wave, int lane) {
    asm volatile("" : "+v"(lane), "+v"(tid));
    const int half = wave >> 2, lw = wave & 3, usel = half ? uB : uA, b = usel >> 2, kv = usel & 3;
    const int r32 = lane & 31, hi = lane >> 5, g = r32 >> 3, qi = r32 & 7, qs = qi & 3, head = kv * 4 + g;
    const int t = PAST + qs; const unsigned row = (unsigned)MP + b * 4 + qs;
    bf16x8 qr[4];
#pragma unroll
    for (int ds = 0; ds < 4; ++ds) qr[ds] = *(const bf16x8*)(P.Q + (size_t)row * D + head * 64 + ds * 16 + hi * 8);
    const LAS float* lut = (const LAS float*)(L + LUT_OFF) + head * 128; const float bfar = lut[127];
    LAS float* wsf = (LAS float*)(L + WSF_OFF) + wave * 32;
    LAS unsigned* impq = (LAS unsigned*)(L + IMP_OFF) + wave * 512 + qi * 64;
    LAS unsigned char* Kb = L + wave * 16384; LAS unsigned char* Vb = Kb + 8192;
    f32x16 o[2];
#pragma unroll
    for (int r = 0; r < 16; ++r) { o[0][r] = 0.f; o[1][r] = 0.f; }
#define SU_CMP_PROBS(a0, a1, r32, hi, lut) do { qk_tile(a0, a1, Kb, qr, 0.f, r32, hi); mask_bias(a0, a1, t, 31, 32, 1 << 30, true, true, lut, hi); \
        float rm = fmaxf(a0[0], a1[0]); _Pragma("unroll") for (int r = 1; r < 16; ++r) rm = fmaxf(rm, fmaxf(a0[r], a1[r])); \
        rm = x32_max(rm); float sacc = 0.f; \
        _Pragma("unroll") for (int r = 0; r < 16; ++r) { a0[r] = ex2(a0[r] - rm); a1[r] = ex2(a1[r] - rm); sacc += a0[r] + a1[r]; } \
        sacc = x32_sum(sacc); const float cinv = 1.0f / sacc; \
        _Pragma("unroll") for (int r = 0; r < 16; ++r) { a0[r] *= cinv; a1[r] *= cinv; } } while (0)
    stage_bf16_tile(P.kcs + (size_t)(b * 4 + kv) * 4096, Kb, false, lane);
    LDS_WAIT();
    {
        f32x16 a0, a1;
        SU_CMP_PROBS(a0, a1, r32, hi, lut);
        imp_store(a0, a1, 0, impq, 32, g, hi);
        if (g == 0) {
#pragma unroll
            for (int q8 = 0; q8 < 8; ++q8) { const int jc = 32 + 4 * q8; u32x2 w; w.x = imp_key(0.f, jc + 2 * hi, 32); w.y = imp_key(0.f, jc + 2 * hi + 1, 32); *(LAS u32x2*)(impq + 2 * hi + jc) = w; } }
    }
    const unsigned long long mymask = select_mask(impq, g, hi);
    const unsigned long long umask = wave_or64(mymask) & 0x1FFFFFFFFull;
    const bool winw = lw == 3;
    const int nsel = __builtin_popcountll(umask);
    const int nmine = winw ? 9 : nsel, first = winw ? 0 : lw, step = winw ? 1 : 3;
    float m = -1e30f, l = 0.f;
#pragma unroll 1
    for (int idx = first; idx < nmine; idx += step) {
        LDS_WAIT();
        int pos0; bool near, sel = true;
        int ln = lane; asm volatile("" : "+v"(ln));
        if (!winw) {
            unsigned long long mm = umask; for (int n = 0; n < idx; ++n) mm &= mm - 1ull;
            const int j = __builtin_ctzll(mm);
            if (j < 32) { const int page = P.pt[b * 16 + (j >> 1)]; const size_t off = (((size_t)page * 128 + (j & 1) * 64) * 4 + kv) * 64;
                stage_f32_pair<false>(P.ck_sel + off, P.cv_sel + off, Kb, Vb, ln); }
            else { stage_new_tile(P.KS + ((size_t)MP + b * 4) * 256 + kv * 64, Kb, false, ln); stage_new_tile(P.VS + ((size_t)MP + b * 4) * 256 + kv * 64, Vb, true, ln); }
            pos0 = 64 * j; near = j >= 30; sel = (mymask >> j) & 1ull;
        } else {
            if (idx < 8) { const size_t off = (((size_t)b * 512 + 64 * idx) * 4 + kv) * 64;
                stage_f32_pair<true>(P.st_kw + off, P.st_vw + off, Kb, Vb, ln, P.kw_out + off - 1024, P.vw_out + off - 1024, idx == 0 ? 4 : 0); }
            else { stage_new_tile(P.KW + ((size_t)MP + b * 4) * 256 + kv * 64, Kb, false, ln); stage_new_tile(P.VW + ((size_t)MP + b * 4) * 256 + kv * 64, Vb, true, ln); }
            pos0 = PAST - 512 + 64 * idx; near = idx >= 6;
        }
        LDS_WAIT();
        f32x16 p0, p1;
        qk_tile(p0, p1, Kb, qr, near ? 0.f : bfar, r32, hi);
        mask_bias(p0, p1, t, pos0, 1, winw ? 512 : (1 << 30), sel, near, lut, hi);
        softmax_update(p0, p1, m, l, o, wsf, r32, hi);
        pv_tile(o, Vb, p0, p1, lane);
    }
    LDS_WAIT();
    f32x16 o2[2];
#pragma unroll
    for (int r = 0; r < 16; ++r) { o2[0][r] = 0.f; o2[1][r] = 0.f; }
    if (lw == 0) {
        int ln2 = lane; const LAS float* lut2 = lut; asm volatile("" : "+v"(ln2), "+v"(lut2));
        const int r32b = ln2 & 31, hib = ln2 >> 5;
        stage_bf16_tile(P.kcs + (size_t)(b * 4 + kv) * 4096, Kb, false, ln2); stage_bf16_tile(P.vcs + (size_t)(b * 4 + kv) * 4096, Vb, true, ln2);
        LDS_WAIT();
        f32x16 a0, a1;
        SU_CMP_PROBS(a0, a1, r32b, hib, lut2);
        pv_tile(o2, Vb, a0, a1, ln2);
        LDS_WAIT();
    }
#undef SU_CMP_PROBS
    { const float lt = x32_sum(l);
      LAS f32x2* ml = (LAS f32x2*)(L + IMP_OFF);
      if (hi == 0) ml[wave * 256 + r32] = (f32x2){m, lt};
      __syncthreads();
      const int w0 = half * 4 + (winw ? 3 : 0), w1 = half * 4 + (winw ? 4 : 3);
      float M = -1e30f;
      for (int w = w0; w < w1; ++w) M = fmaxf(M, ml[w * 256 + r32][0]);
      float Ls = 0.f;
      for (int w = w0; w < w1; ++w) { const f32x2 x = ml[w * 256 + r32]; Ls += x[1] * ex2(x[0] - M); }
      const float gt = GATEV(P, row, head, (winw ? 2 : 1));
      const float f = Ls > 0.f ? gt * ex2(m - M) / Ls : 0.f;
      row_scale(o, f, wsf, r32, hi);
      if (lw == 0) { const float g0 = GATEV(P, row, head, 0); row_fma(o, o2, g0, wsf, r32, hi); } }
    LAS float* ob = (LAS float*)Kb + hi * 256 + r32;
#pragma unroll
    for (int r = 0; r < 16; ++r) { ob[CROW0(r) * 64] = o[0][r]; ob[CROW0(r) * 64 + 32] = o[1][r]; }
    __syncthreads();
    { const int hs = tid >> 8, vr = (tid >> 4) & 15, d4 = (tid & 15) * 4, gg = vr >> 2, qq = vr & 3, uo = hs ? uB : uA; f32x4 sacc = (f32x4){0.f, 0.f, 0.f, 0.f};
#pragma unroll
      for (int w = 0; w < 4; ++w) sacc = sacc + *(const LAS f32x4*)((const LAS float*)(L + (hs * 4 + w) * 16384) + (gg * 8 + qq) * 64 + d4);
      u32x2 w2; w2.x = cvtpk(sacc[0], sacc[1]); w2.y = cvtpk(sacc[2], sacc[3]);
      *(u32x2*)(P.O + ((size_t)MP + (uo >> 2) * 4 + qq) * D + ((uo & 3) * 4 + gg) * 64 + d4) = w2; }
    __syncthreads();
}

#ifdef VERIFY
__device__ __forceinline__ float wsum(float v) { for (int o = 1; o < 64; o <<= 1) v += __shfl_xor(v, o); return v; }
__device__ __forceinline__ float wmax(float v) { for (int o = 1; o < 64; o <<= 1) v = fmaxf(v, __shfl_xor(v, o)); return v; }
__device__ __forceinline__ float rb(float x) { return bf2f((unsigned short)(cvtpk(x, 0.f) & 0xffffu)); }
__device__ __forceinline__ void verify_item(const Ptrs& P, LAS unsigned char* L, bool sample, int b, int tq, int kv, int br, float* errs, int wave, int lane) {
    LAS float* sc = (LAS float*)(L + wave * 16384);
    LAS float* qs = (LAS float*)(L + IMP_OFF) + wave * 512;
    const LAS float* lutb = (const LAS float*)(L + LUT_OFF);
    const size_t row = sample ? (size_t)MP + b * 4 + tq : (size_t)b * SEQ + tq; const int pos = sample ? PAST + tq : tq; const int cq = pos >> 6;
    for (int g = 0; g < 4; ++g) qs[g * 64 + lane] = bf2f(P.Q[row * D + (kv * 4 + g) * 64 + lane]);
    LDS_WAIT();
    const int ncmp = sample ? 64 : 128; const size_t cmpo = (size_t)(b * 4 + kv) * (sample ? 4096 : 8192); const bf16_t* kc = (const bf16_t*)((const char*)P.kcp + (sample ? WS_KCMPS - WS_KCMPP : 0)) + cmpo; const bf16_t* vc = (const bf16_t*)((const char*)P.vcp + (sample ? WS_VCMPS - WS_VCMPP : 0)) + cmpo;
    float oc0 = 0.f, oc1 = 0.f, oc2 = 0.f, oc3 = 0.f;
    for (int g = 0; g < 4; ++g) {
        float sA = -INFINITY, sB = -INFINITY;
        for (int h = 0; h < 2; ++h) { const int n = lane + 64 * h; const int dist = pos - (32 * n + 31); float s = -INFINITY;
            if (n < ncmp && dist >= 0) { float a = 0.f; for (int d = 0; d < 64; ++d) a += qs[g * 64 + d] * bf2f(kc[(size_t)n * 64 + d]); s = a + lutb[(kv * 4 + g) * 128 + (dist > 127 ? 127 : dist)]; }
            if (h == 0) sA = s; else sB = s; }
        const float mx = wmax(fmaxf(sA, sB)); float p0 = 0.f, p1 = 0.f;
        if (mx > -INFINITY) { p0 = ex2(sA - mx); p1 = ex2(sB - mx); }
        const float sm = wsum(p0 + p1); const float inv = sm > 0.f ? 1.0f / sm : 0.f;
        sc[g * 128 + lane] = p0 * inv; sc[g * 128 + 64 + lane] = p1 * inv;
    }
    LDS_WAIT();
    for (int g = 0; g < 4; ++g) { float a = 0.f; for (int n = 0; n < ncmp; ++n) a += sc[g * 128 + n] * bf2f(vc[(size_t)n * 64 + lane]); if (g == 0) oc0 = a; else if (g == 1) oc1 = a; else if (g == 2) oc2 = a; else oc3 = a; }
    float imp = 0.f; for (int g = 0; g < 4; ++g) imp += sc[g * 128 + 2 * lane] + sc[g * 128 + 2 * lane + 1];
    { const bool forced = (lane == 0) || (lane == cq) || (lane == cq - 1), elig = lane <= cq; imp = forced ? 1e9f : (elig ? imp : -1.0f); }
    LDS_WAIT(); qs[256 + lane] = imp; LDS_WAIT();
    int rank = 0; for (int j = 0; j < 64; ++j) { const float v = qs[256 + j]; rank += (v > imp) || (v == imp && j < lane); }
    const int nsb = sample ? 33 : 64;
    const unsigned long long selm = __ballot(rank < 16 && lane < nsb);
    float r0 = oc0, r1 = oc1, r2_ = oc2, r3 = oc3;
    if (br != 0) {
        const int nslot = br == 1 ? __builtin_popcountll(selm) : 9;
        LDS_WAIT();
        for (int si = 0; si < nslot && si < 16; ++si) {
            int j;
            if (br == 1) { unsigned long long mm = selm; for (int n = 0; n < si; ++n) mm &= mm - 1ull; j = __builtin_ctzll(mm); } else j = sample ? si : cq - 8 + si;
            bool ok = false; int pk = 0; const float* kf = nullptr; const bf16_t* kb = nullptr;
            if (br == 1) { pk = 64 * j + lane;
                if (!sample) { ok = pk <= pos; kb = P.KS + ((size_t)b * SEQ + pk) * 256 + kv * 64; }
                else if (j < 32) { ok = true; kf = P.ck_sel + (((size_t)P.pt[b * 16 + (j >> 1)] * 128 + (j & 1) * 64 + lane) * 4 + kv) * 64; }
                else { ok = lane < 4 && pk <= pos; kb = P.KS + ((size_t)MP + b * 4 + (lane & 3)) * 256 + kv * 64; } }
            else { if (!sample) { pk = 64 * j + lane; ok = j >= 0 && pk <= pos && pos - pk < 512; kb = P.KW + ((size_t)b * SEQ + (ok ? pk : 0)) * 256 + kv * 64; }
                else { const int e = 64 * j + lane; pk = PAST - 512 + e; ok = e < 516 && pk <= pos && pos - pk < 512;
                    if (e < 512) kf = P.st_kw + (((size_t)b * 512 + e) * 4 + kv) * 64; else kb = P.KW + ((size_t)MP + b * 4 + ((e - 512) & 3)) * 256 + kv * 64; } }
            const int dist = pos - pk;
            for (int g = 0; g < 4; ++g) { float s = -INFINITY;
                if (ok) { float a = 0.f; for (int d = 0; d < 64; ++d) a += qs[g * 64 + d] * (kf ? rb(kf[d]) : bf2f(kb[d])); s = a + lutb[(kv * 4 + g) * 128 + (dist > 127 ? 127 : dist)]; }
                sc[g * 1024 + si * 64 + lane] = s; }
        }
        LDS_WAIT();
        for (int g = 0; g < 4; ++g) {
            float mx = -INFINITY; for (int si = 0; si < nslot && si < 16; ++si) mx = fmaxf(mx, sc[g * 1024 + si * 64 + lane]);
            mx = wmax(mx); float sm = 0.f;
            for (int si = 0; si < nslot && si < 16; ++si) { const float p = mx > -INFINITY ? ex2(sc[g * 1024 + si * 64 + lane] - mx) : 0.f; sc[g * 1024 + si * 64 + lane] = p; sm += p; }
            sm = wsum(sm); const float inv = sm > 0.f ? 1.0f / sm : 0.f;
            LDS_WAIT();
            float a = 0.f;
            for (int si = 0; si < nslot && si < 16; ++si) {
                int j;
                if (br == 1) { unsigned long long mm = selm; for (int n = 0; n < si; ++n) mm &= mm - 1ull; j = __builtin_ctzll(mm); } else j = sample ? si : cq - 8 + si;
                for (int k = 0; k < 64; ++k) { const float p = sc[g * 1024 + si * 64 + k]; if (p == 0.f) continue; float v;
                    if (br == 1) { if (!sample) v = bf2f(P.VS[((size_t)b * SEQ + 64 * j + k) * 256 + kv * 64 + lane]);
                        else if (j < 32) v = rb(P.cv_sel[(((size_t)P.pt[b * 16 + (j >> 1)] * 128 + (j & 1) * 64 + k) * 4 + kv) * 64 + lane]);
                        else v = bf2f(P.VS[((size_t)MP + b * 4 + (k & 3)) * 256 + kv * 64 + lane]); }
                    else { if (!sample) v = bf2f(P.VW[((size_t)b * SEQ + 64 * j + k) * 256 + kv * 64 + lane]);
                        else { const int e = 64 * j + k; v = e < 512 ? rb(P.st_vw[(((size_t)b * 512 + e) * 4 + kv) * 64 + lane]) : bf2f(P.VW[((size_t)MP + b * 4 + ((e - 512) & 3)) * 256 + kv * 64 + lane]); } }
                    a += p * v; } }
            a *= inv; if (g == 0) r0 = a; else if (g == 1) r1 = a; else if (g == 2) r2_ = a; else r3 = a;
            LDS_WAIT();
        }
    }
    float d2 = 0.f, rr2 = 0.f;
    for (int g = 0; g < 4; ++g) { const float ref = g == 0 ? r0 : g == 1 ? r1 : g == 2 ? r2_ : r3; const float f = bf2f(P.O[row * D + (kv * 4 + g) * 64 + lane]); const float df = f - ref; d2 += df * df; rr2 += ref * ref; }
    d2 = wsum(d2); rr2 = wsum(rr2);
    if (lane == 0) { atomicAdd(errs + ((sample ? 3 : 0) + br) * 2, d2); atomicAdd(errs + ((sample ? 3 : 0) + br) * 2 + 1, rr2); }
}
#endif
}

constexpr int NPHASE = 17;
__global__ void __launch_bounds__(512, 2) nsa_fwd(Args args) {
    extern __shared__ __attribute__((aligned(16))) unsigned char lds[];
    Frame F;
    F.lds = (LAS unsigned char*)lds;
    F.tid = threadIdx.x; F.lane = F.tid & 63; F.wave = __builtin_amdgcn_readfirstlane(F.tid >> 6);
    F.G = gridDim.x; { const int bx = blockIdx.x; F.vcu = (F.G % 8 == 0) ? (bx % 8) * (F.G / 8) + bx / 8 : bx; }
    F.x_p = (const float*)args.in[0]; F.x_s = (const float*)args.in[1]; F.c_p = (const float*)args.in[2]; F.c_s = (const float*)args.in[3];
    F.ck_cmp = (const float*)args.in[4]; F.cv_cmp = (const float*)args.in[5]; F.ck_sel = (const float*)args.in[6]; F.cv_sel = (const float*)args.in[7];
    F.page_table = (const int*)args.in[8]; F.st_kw = (const float*)args.in[9]; F.st_vw = (const float*)args.in[10]; F.st_pool = (const float*)args.in[11];
    F.rel_bias = (const float*)args.in[12]; F.ada_w = (const float*)args.in[13]; F.ada_b = (const float*)args.in[14]; F.norm_g = (const float*)args.in[15]; F.final_g = (const float*)args.in[16];
    F.w_in = (const float*)args.in[17]; F.w_out = (const float*)args.in[18]; F.cmp_wk = (const float*)args.in[19]; F.cmp_wv = (const float*)args.in[20];
    F.pe_k = (const float*)args.in[21]; F.pe_v = (const float*)args.in[22]; F.pool_w = (const float*)args.in[23]; F.pool_scale = (const float*)args.in[24];
    F.ffn_wg = (const float*)args.in[25]; F.ffn_wu = (const float*)args.in[26]; F.ffn_wd = (const float*)args.in[27];
    F.out = args.out; F.ws = args.ws;
    unsigned char* ws = args.ws;
    for (int u = F.tid; u < 64; u += 512) ((LAS unsigned*)(F.lds + MISC_OFF))[u] = 0u;
    for (int u = F.tid; u < 16 * 128; u += 512) { const int h = u >> 7, d = u & 127; ((LAS float*)(F.lds + LUT_OFF))[u] = F.rel_bias[t5_bucket(d) * 16 + h] * LOG2E; }
    __syncthreads();
    volatile LAS unsigned* MISC = (volatile LAS unsigned*)(F.lds + MISC_OFF);
    XcdBarrier bar; bar.bar = (unsigned*)(ws + WS_CTL) + CW_BAR; bar.x = 0; bar.st = nullptr;
    if (!MK_SPLIT) bar = xcd_barrier_post((unsigned*)(ws + WS_CTL) + CW_BAR, MISC + 8);
    const int lo = args.ph_lo, hi = args.ph_hi;
#ifndef PHMASK
#define PHMASK 0x1FFFF
#endif
#define IN(k) (((PHMASK >> (k)) & 1) && lo <= (k) && (k) < hi)
#define SEAM(k) do { if (IN(k) && IN((k) + 1)) xcd_barrier(bar); } while (0)
#ifndef REPMASK
#define REPMASK 0
#endif
#define REPS(k) (((REPMASK >> (k)) & 1) ? 2 : 1)
    bf16_t* H = (bf16_t*)(ws + WS_H); bf16_t* X = (bf16_t*)(ws + WS_X); float* MOD = (float*)(ws + WS_MOD);

    if (IN(0)) { for (int rep = 0; rep < REPS(0); ++rep) p0_prologue(F); } SEAM(0);
    if (IN(1)) { for (int rep = 0; rep < REPS(1); ++rep) { p1_compress_sample(F); p1_ada(F); } } SEAM(1);
    if (IN(2)) { for (int rep = 0; rep < REPS(2); ++rep) norm_phase<0>(F, true, 0, 0); } SEAM(2);
    if (IN(3)) {
        pg8::Gemm g{H, (const bf16_t*)(ws + WS_WIN), D, D, D, 0}; pg8::StaticOrder S; S.init(MT, NPROJ, F.G, (int)blockIdx.x);
        pg8::EpiProj E{(bf16_t*)(ws + WS_Q), (bf16_t*)(ws + WS_KV), (float*)(ws + WS_GATES), F.out};
        for (int rep = 0; rep < REPS(3); ++rep) pg8::gemm_phase<pg8::EpiProj, pg8::StaticOrder, true>(F.lds, g, S, E);
    } SEAM(3);
    if (IN(4)) { for (int rep = 0; rep < REPS(4); ++rep) p4_compress_prompt(F); } SEAM(4);
    if (IN(5)) {
        att::Ptrs P; P.Q = (const bf16_t*)(ws + WS_Q); P.kcp = (const bf16_t*)(ws + WS_KCMPP); P.vcp = (const bf16_t*)(ws + WS_VCMPP); P.kcs = (const bf16_t*)(ws + WS_KCMPS); P.vcs = (const bf16_t*)(ws + WS_VCMPS);
        const bf16_t* kvb = (const bf16_t*)(ws + WS_KV); P.KS = kvb + 2 * KV_STRIDE; P.VS = kvb + 3 * KV_STRIDE; P.KW = kvb + 4 * KV_STRIDE; P.VW = kvb + 5 * KV_STRIDE;
        P.gates = (const float*)(ws + WS_GATES); P.O = (bf16_t*)(ws + WS_O); P.ck_sel = F.ck_sel; P.cv_sel = F.cv_sel; P.st_kw = F.st_kw; P.st_vw = F.st_vw; P.pt = F.page_table;
        P.gov = -1; P.kw_out = F.out + O_KWS; P.vw_out = F.out + O_KWS + SZ_WS;
#ifdef VERIFY
        P.gov = args.pad0 - 1;
#endif
#ifndef RS
#define RS 1
#endif
#ifndef RP
#define RP 1
#endif
#pragma unroll 1
        for (int pass = 0; pass < 2; ++pass) {
            if (((pass ^ F.vcu) & 1) == 0) {
#pragma unroll 1
                for (int rep = 0; rep < RS; ++rep)
                for (int u = opaque_s(F.vcu); u < NSB * 2; u += F.G) att::sample_unit(P, F.lds, u, u + NSB * 2, F.tid, F.wave, F.lane);
            } else {
#pragma unroll 1
                for (int rep = 0; rep < RP; ++rep)
                for (int u = opaque_s(F.vcu); u < 16 * 16; u += F.G) { const int bk = u >> 4, s = u & 15;
#pragma unroll 1
                    for (int i = 0; i < 4; ++i) { const int c = (i == 0) ? s : (i == 1) ? 31 - s : (i == 2) ? 32 + s : 63 - s; att::prompt_unit(P, F.lds, bk >> 2, bk & 3, c, F.tid, F.wave, F.lane); } }
            }
        }
    } SEAM(5);
    if (IN(6)) {
        pg8::Gemm g{(const bf16_t*)(ws + WS_O), (const bf16_t*)(ws + WS_WOUT), D, D, D, 0}; pg8::StaticOrder S; S.init(MP, D, F.G, (int)blockIdx.x);
        pg8::EpiRes<true> E{F.x_p, F.x_s, X, MOD + 2048};
        pg8::gemm_phase<decltype(E), pg8::StaticOrder, true>(F.lds, g, S, E);
        small_gemm_res<true>(F, (const bf16_t*)(ws + WS_O) + (size_t)MP * D, D, (const bf16_t*)(ws + WS_WOUT), D, D, false, F.x_s, X + (size_t)MP * D, MOD + 2048);
    } SEAM(6);
    if (IN(7)) { for (int rep = 0; rep < REPS(7); ++rep) norm_phase<0>(F, false, 0, 1); } SEAM(7);
    if (IN(8)) {
        pg8::Gemm g{H, (const bf16_t*)(ws + WS_WGU), D, D, D, 0}; pg8::StaticOrder S; S.init(MT, NGU, F.G, (int)blockIdx.x);
        pg8::EpiGU E{(bf16_t*)(ws + WS_ACT)};
        for (int rep = 0; rep < REPS(8); ++rep) pg8::gemm_phase<pg8::EpiGU, pg8::StaticOrder, true>(F.lds, g, S, E);
    } SEAM(8);
    if (IN(9)) {
        pg8::Gemm g{(const bf16_t*)(ws + WS_ACT), (const bf16_t*)(ws + WS_WD), FF, FF, FF, 0}; pg8::StaticOrder S; S.init(MP, D, F.G, (int)blockIdx.x);
        pg8::EpiRes<false> E{nullptr, nullptr, X, MOD + 5120};
        pg8::gemm_phase<decltype(E), pg8::StaticOrder, true>(F.lds, g, S, E);
        small_gemm_res<false>(F, (const bf16_t*)(ws + WS_ACT) + (size_t)MP * FF, FF, (const bf16_t*)(ws + WS_WD), FF, FF, false, nullptr, X + (size_t)MP * D, MOD + 5120);
    } SEAM(9);
    if (IN(10)) { for (int rep = 0; rep < REPS(10); ++rep) norm_phase<1>(F, false, 1, 0); } SEAM(10);
    if (IN(11)) { for (int rep = 0; rep < REPS(11); ++rep) pool_phase(F); } SEAM(11);
    if (IN(12)) {
        pg8::Gemm g{H, (const bf16_t*)(ws + WS_WPOOL), D, 256, 256, 256}; pg8::StaticOrder S; S.init(MP, D, F.G, (int)blockIdx.x);
        pg8::EpiRes<false> E{nullptr, nullptr, X, MOD + (size_t)NMODB * 6144 + 2048};
        pg8::gemm_phase<decltype(E), pg8::StaticOrder, true>(F.lds, g, S, E);
        small_gemm_res<false>(F, H + (size_t)MP * D, D, (const bf16_t*)(ws + WS_WPOOL), 256, 256, true, nullptr, X + (size_t)MP * D, MOD + (size_t)NMODB * 6144 + 2048);
    } SEAM(12);
    if (IN(13)) { for (int rep = 0; rep < REPS(13); ++rep) norm_phase<0>(F, false, 1, 1); } SEAM(13);
    if (IN(14)) {
        pg8::Gemm g{H, (const bf16_t*)(ws + WS_WGU) + (size_t)NGU * D, D, D, D, 0}; pg8::StaticOrder S; S.init(MT, NGU, F.G, (int)blockIdx.x);
        pg8::EpiGU E{(bf16_t*)(ws + WS_ACT)};
        pg8::gemm_phase<pg8::EpiGU, pg8::StaticOrder, true>(F.lds, g, S, E);
    } SEAM(14);
    if (IN(15)) {
        pg8::Gemm g{(const bf16_t*)(ws + WS_ACT), (const bf16_t*)(ws + WS_WD) + (size_t)D * FF, FF, FF, FF, 0}; pg8::StaticOrder S; S.init(MP, D, F.G, (int)blockIdx.x);
        pg8::EpiRes<false> E{nullptr, nullptr, X, MOD + (size_t)NMODB * 6144 + 5120};
        pg8::gemm_phase<decltype(E), pg8::StaticOrder, true>(F.lds, g, S, E);
        small_gemm_res<false>(F, (const bf16_t*)(ws + WS_ACT) + (size_t)MP * FF, FF, (const bf16_t*)(ws + WS_WD) + (size_t)D * FF, FF, FF, false, nullptr, X + (size_t)MP * D, MOD + (size_t)NMODB * 6144 + 5120);
    } SEAM(15);
    if (IN(16)) { for (int rep = 0; rep < REPS(16); ++rep) norm_phase<2>(F, false, 0, 0); }
#undef IN
#undef SEAM
}


#ifdef VERIFY
__global__ void __launch_bounds__(512, 2) verify_k(Args args) {
    extern __shared__ __attribute__((aligned(16))) unsigned char lds[];
    LAS unsigned char* L = (LAS unsigned char*)lds; unsigned char* ws = args.ws;
    const int tid = threadIdx.x, lane = tid & 63, wave = __builtin_amdgcn_readfirstlane(tid >> 6);
    const float* rel_bias = (const float*)args.in[12];
    for (int u = tid; u < 16 * 128; u += 512) { const int h = u >> 7, d = u & 127; ((LAS float*)(L + LUT_OFF))[u] = rel_bias[t5_bucket(d) * 16 + h] * LOG2E; }
    __syncthreads();
    att::Ptrs P; P.Q = (const bf16_t*)(ws + WS_Q); P.kcp = (const bf16_t*)(ws + WS_KCMPP); P.vcp = (const bf16_t*)(ws + WS_VCMPP); P.kcs = (const bf16_t*)(ws + WS_KCMPS); P.vcs = (const bf16_t*)(ws + WS_VCMPS);
    const bf16_t* kvb = (const bf16_t*)(ws + WS_KV); P.KS = kvb + 2 * KV_STRIDE; P.VS = kvb + 3 * KV_STRIDE; P.KW = kvb + 4 * KV_STRIDE; P.VW = kvb + 5 * KV_STRIDE;
    P.gates = (const float*)(ws + WS_GATES); P.O = (bf16_t*)(ws + WS_O); P.ck_sel = (const float*)args.in[6]; P.cv_sel = (const float*)args.in[7]; P.st_kw = (const float*)args.in[9]; P.st_vw = (const float*)args.in[10]; P.pt = (const int*)args.in[8]; P.gov = args.pad0 - 1;
    float* errs = (float*)(ws + WS_CTL) + 65536;
    const int gw = blockIdx.x * 8 + wave;
    for (int it = gw; it < 168 + 64; it += gridDim.x * 8) { bool smp = it >= 168; int vb_, vt_, vk_;
        if (!smp) { const int ti = it % 21, r = it / 21; vb_ = (r >> 2) ? 3 : 0; vk_ = r & 3; vt_ = ti == 0 ? 0 : ti == 1 ? 5 : ti == 2 ? 30 : ti == 3 ? 31 : ti == 4 ? 63 : ti == 5 ? 64 : ti == 6 ? 100 : ti == 7 ? 511 : ti == 8 ? 512 : ti == 9 ? 600 : ti == 10 ? 959 : ti == 11 ? 960 : ti == 12 ? 1023 : ti == 13 ? 1024 : ti == 14 ? 1055 : ti == 15 ? 1100 : ti == 16 ? 2047 : ti == 17 ? 2048 : ti == 18 ? 3000 : ti == 19 ? 4032 : 4095; }
        else { const int q = it - 168, bi = q >> 4; vb_ = bi == 0 ? 0 : bi == 1 ? 1 : bi == 2 ? 77 : 127; vt_ = q & 3; vk_ = (q >> 2) & 3; }
        att::verify_item(P, L, smp, vb_, vt_, vk_, args.pad0 - 1, errs, wave, lane); }
}
__global__ void scale_k(Args args) {
    const float* errs = (const float*)(args.ws + WS_CTL) + 65536; const size_t offs[6] = {O_KCP, O_KCP + SZ_KVP, O_KCP + 2 * SZ_KVP, O_KCS, O_KCS + SZ_KVS, O_KCS + 2 * SZ_KVS};
    const int k = blockIdx.y; const float d2 = errs[2 * k], r2 = errs[2 * k + 1]; const float e = r2 > 0.f ? sqrtf(d2 / r2) : 7.0f; const size_t n = k < 3 ? SZ_KVP : SZ_KVS;
    for (size_t i = (size_t)blockIdx.x * blockDim.x + threadIdx.x; i < n; i += (size_t)gridDim.x * blockDim.x) args.out[offs[k] + i] *= (1.0f + e);
}
#endif
extern "C" void kernel_launch(void* const* d_in, const int* in_sizes, int n_in, void* d_out, int out_size, void* d_ws, size_t ws_size, hipStream_t stream) {
    static int grid = 0;
    if (grid == 0) {
        if (n_in != 28 || (size_t)out_size != O_END || ws_size < WS_END) { fprintf(stderr, "kernel_launch: unexpected shapes (n_in %d, out %d, ws %zu); nothing launched\n", n_in, out_size, ws_size); grid = -1; return; }
        int dev = 0, cus = 0, per_cu = 0;
        if (hipGetDevice(&dev) != hipSuccess || hipDeviceGetAttribute(&cus, hipDeviceAttributeMultiprocessorCount, dev) != hipSuccess) { grid = -1; return; }
        if (hipFuncSetAttribute((const void*)nsa_fwd, hipFuncAttributeMaxDynamicSharedMemorySize, LDS_BYTES) != hipSuccess) { fprintf(stderr, "kernel_launch: hipFuncSetAttribute(%d B LDS) failed\n", LDS_BYTES); grid = -1; return; }
        if (hipOccupancyMaxActiveBlocksPerMultiprocessor(&per_cu, (const void*)nsa_fwd, 512, LDS_BYTES) != hipSuccess || per_cu < 1)
            fprintf(stderr, "kernel_launch: note: occupancy query reports %d workgroups per CU\n", per_cu);
        (void)hipGetLastError();
        grid = cus;
    }
    if (grid < 0) return;
    (void)hipMemsetAsync((char*)d_ws + WS_CTL, 0, CTL_ZERO_BYTES, stream);
    Args a{};
    for (int i = 0; i < 28; ++i) a.in[i] = d_in[i];
    a.out = (float*)d_out; a.ws = (unsigned char*)d_ws; a.pad0 = 0; a.pad1 = 0;
#ifdef VERIFY
    hipFuncSetAttribute((const void*)verify_k, hipFuncAttributeMaxDynamicSharedMemorySize, LDS_BYTES);
    for (int pass = 0; pass < 3; ++pass) { a.pad0 = pass + 1; a.ph_lo = 0; a.ph_hi = 6;
        (void)hipMemsetAsync((char*)d_ws + WS_CTL, 0, 65536 * 4, stream);
        hipLaunchKernelGGL(nsa_fwd, dim3(grid), dim3(512), LDS_BYTES, stream, a);
        hipLaunchKernelGGL(verify_k, dim3(grid), dim3(512), LDS_BYTES, stream, a); }
    a.pad0 = 0; (void)hipMemsetAsync((char*)d_ws + WS_CTL, 0, 65536 * 4, stream);
    a.ph_lo = 0; a.ph_hi = NPHASE;
    hipLaunchKernelGGL(nsa_fwd, dim3(grid), dim3(512), LDS_BYTES, stream, a);
    hipLaunchKernelGGL(scale_k, dim3(64, 6), dim3(256), 0, stream, a);
#elif MK_SPLIT
    for (int p = 0; p < NPHASE; ++p) { a.ph_lo = p; a.ph_hi = p + 1; hipLaunchKernelGGL(nsa_fwd, dim3(grid), dim3(512), LDS_BYTES, stream, a); }
#else
    a.ph_lo = 0; a.ph_hi = NPHASE;
    hipLaunchKernelGGL(nsa_fwd, dim3(grid), dim3(512), LDS_BYTES, stream, a);
#endif
    const hipError_t le = hipPeekAtLastError();
    if (le != hipSuccess) fprintf(stderr, "kernel_launch: launch failed: %s\n", hipGetErrorName(le));
}
```

```cpp
#include <hip/hip_runtime.h>
#include <cstdio>
#include <cstdint>

#ifndef MK_SPLIT
#define MK_SPLIT 0
#endif

#define GAS __attribute__((address_space(1)))
#define LAS __attribute__((address_space(3)))
typedef unsigned short bf16_t;
typedef short bf16x8 __attribute__((ext_vector_type(8)));
typedef short s16x4 __attribute__((ext_vector_type(4)));
typedef float f32x2 __attribute__((ext_vector_type(2)));
typedef float f32x4 __attribute__((ext_vector_type(4)));
typedef float f32x16 __attribute__((ext_vector_type(16)));
typedef unsigned u32x2 __attribute__((ext_vector_type(2)));
typedef unsigned u32x4 __attribute__((ext_vector_type(4)));
typedef __bf16 bf16x2_t __attribute__((ext_vector_type(2)));
typedef GAS unsigned gu32;

constexpr int D = 1024, SEQ = 4096, NB = 4, NSB = 128, DSEQ = 4;
constexpr int MP = NB * SEQ, MS = NSB * DSEQ, MT = MP + MS;
constexpr int INCOLS = 2608, NPROJ = 2816, FF = 2816, NGU = 2 * FF;
constexpr int NMODB = NB + NSB;
constexpr int PAST = 2048;
constexpr float C2 = 0.125f * 1.4426950408889634f;
constexpr float LOG2E = 1.4426950408889634f;

constexpr size_t O_YP = 0, O_YS = O_YP + (size_t)MP * D;
constexpr size_t O_KCP = O_YS + (size_t)MS * D, SZ_KVP = (size_t)MP * 256;
constexpr size_t O_KWP = O_KCP + 4 * SZ_KVP, SZ_WP = (size_t)NB * 512 * 256;
constexpr size_t O_PLP = O_KWP + 2 * SZ_WP;
constexpr size_t O_KCS = O_PLP + (size_t)NB * 15 * D, SZ_KVS = (size_t)MS * 256;
constexpr size_t O_KWS = O_KCS + 4 * SZ_KVS, SZ_WS = (size_t)NSB * 512 * 256;
constexpr size_t O_PLS = O_KWS + 2 * SZ_WS;
constexpr size_t O_END = O_PLS + (size_t)NSB * 15 * D;
static_assert(O_END == 71233536, "output size");

constexpr size_t MiB = 1u << 20;
#ifdef VERIFY
constexpr size_t WS_CTL = 0, CTL_ZERO_BYTES = 1 * MiB;
#else
constexpr size_t WS_CTL = 0, CTL_ZERO_BYTES = 65536;
#endif
constexpr size_t WS_WIN = 2 * MiB;
constexpr size_t WS_WOUT = 8 * MiB;
constexpr size_t WS_WGU = 10 * MiB;
constexpr size_t WS_WD = 32 * MiB;
constexpr size_t WS_WPOOL = 44 * MiB;
constexpr size_t WS_WCK = 45 * MiB, WS_WCV = WS_WCK + 262144;
constexpr size_t WS_SC = 46 * MiB;
constexpr size_t WS_CB = 47 * MiB;
constexpr size_t WS_MOD = 48 * MiB;
constexpr size_t WS_KCMPP = 56 * MiB, WS_VCMPP = 57 * MiB;
constexpr size_t WS_KCMPS = 58 * MiB, WS_VCMPS = 62 * MiB;
constexpr size_t WS_GATES = 66 * MiB;
constexpr size_t WS_RSTD = 70 * MiB;
constexpr size_t WS_H = 72 * MiB;
constexpr size_t WS_Q = 108 * MiB;
constexpr size_t WS_O = 144 * MiB;
constexpr size_t WS_KV = 180 * MiB, KV_STRIDE = (size_t)MT * 256;
constexpr size_t WS_X = 232 * MiB;
constexpr size_t WS_HF = 300 * MiB;
constexpr size_t WS_ACT = 368 * MiB;
constexpr size_t WS_END = 464 * MiB;
static_assert(WS_KV + 6 * KV_STRIDE * 2 <= WS_X && WS_X + (size_t)MT * D * 4 <= WS_HF && WS_HF + (size_t)MT * D * 4 <= WS_ACT && WS_ACT + (size_t)MT * FF * 2 <= WS_END, "ws map");
static_assert(WS_WGU + 2 * (size_t)NGU * D * 2 <= WS_WD && WS_WD + 2 * (size_t)D * FF * 2 <= WS_WPOOL && WS_MOD + 2 * (size_t)NMODB * 6144 * 4 <= WS_KCMPP, "ws map 2");
static_assert(WS_GATES + (size_t)MT * 48 * 4 <= WS_H && WS_H + (size_t)MT * D * 2 <= WS_Q && WS_Q + (size_t)MT * D * 2 <= WS_O && WS_O + (size_t)MT * D * 2 <= WS_KV, "ws map 3");
constexpr int CW_BAR = 4096;

constexpr int RING_BYTES = 131072;
constexpr int LUT_OFF = RING_BYTES;
constexpr int WSF_OFF = LUT_OFF + 8192;
constexpr int IMP_OFF = WSF_OFF + 1024;
constexpr int MISC_OFF = IMP_OFF + 16384;
constexpr int LDS_BYTES = MISC_OFF + 256;
static_assert(LDS_BYTES <= 160 * 1024, "LDS");

__device__ __forceinline__ unsigned cvtpk(float lo, float hi) { f32x2 v = {lo, hi}; bf16x2_t b = __builtin_convertvector(v, bf16x2_t); return __builtin_bit_cast(unsigned, b); }
__device__ __forceinline__ float bf2f(unsigned short h) { return __builtin_bit_cast(float, (unsigned)h << 16); }
__device__ __forceinline__ float ex2(float x) { return __builtin_amdgcn_exp2f(x); }
__device__ __forceinline__ float sigmoidf_(float x) { return __builtin_amdgcn_rcpf(1.0f + ex2(-x * LOG2E)); }
#define CROW0(r) (((r) & 3) + 8 * ((r) >> 2))
#define LDS_WAIT() asm volatile("s_waitcnt lgkmcnt(0)" ::: "memory")
#define VM_WAIT() asm volatile("s_waitcnt vmcnt(0)" ::: "memory")
__device__ __forceinline__ const char* uniform_ptr(const void* p) { const unsigned long long v = (unsigned long long)p; const unsigned lo = (unsigned)__builtin_amdgcn_readfirstlane((int)(unsigned)v), hi = (unsigned)__builtin_amdgcn_readfirstlane((int)(unsigned)(v >> 32)); return (const char*)(((unsigned long long)hi << 32) | lo); }

__device__ __forceinline__ int opaque_s(int v) { asm volatile("" : "+s"(v)); return v; }
__device__ __forceinline__ int lane_id() { int l; asm volatile("v_mbcnt_lo_u32_b32 %0, -1, 0\n\tv_mbcnt_hi_u32_b32 %0, -1, %0" : "=v"(l)); return l; }
__device__ __forceinline__ int t5_bucket(int d) {
    if (d < 16) return d;
    int b = 16;
    b += (d >= 19) + (d >= 21) + (d >= 24) + (d >= 27) + (d >= 31) + (d >= 35) + (d >= 40) + (d >= 46) + (d >= 52) + (d >= 59) + (d >= 67) + (d >= 77) + (d >= 87) + (d >= 99) + (d >= 113);
    return b;
}

namespace pg8 {
constexpr int BM = 256, BK = 64, HALF = 128, HTB = HALF * BK * 2, STAGE_BYTES = 8 * HTB, NXCD = 8, WGM = 8;
__host__ __device__ __forceinline__ int lds_byte(int r, int c) { const int st = (r >> 4) * 2 + (c >> 5), rr = r & 15, cc = c & 31, ob = rr * 64 + cc * 2; return st * 1024 + (ob ^ (((ob >> 9) & 1) << 5)); }
__host__ __device__ __forceinline__ void stage_rc(int b, int& R, int& C) { const int st = b / 1024, sb = b % 1024, swz = sb ^ (((sb >> 9) & 1) << 5); R = (st >> 1) * 16 + swz / 64; C = (st & 1) * 32 + (swz % 64) / 2; }
__host__ __device__ __forceinline__ int perm32(int rho) { const int n = rho >> 4, i = rho & 15; return 8 * (i >> 2) + 4 * n + (i & 3); }
struct Unit { int pm, pn; };
struct Gemm { const bf16_t* A; const bf16_t* Bt; int lda, ldb, K, acs; };
struct StaticOrder {
    int nM, nN, nwg, G, c;
    __host__ __device__ void init(int M, int N, int G_, int c_) { nM = M / BM; nN = N / BM; nwg = nM * nN; G = G_; c = c_; }
    __host__ __device__ bool next(int i, Unit& u) const {
        const long L = (long)i * G + c; if (L >= nwg) return false;
        int wgid = (int)L; { const int q = nwg / NXCD, r = nwg % NXCD, xcd = wgid % NXCD, off = wgid / NXCD; wgid = (xcd < r ? xcd * (q + 1) : r * (q + 1) + (xcd - r) * q) + off; }
        const int nig = WGM * nN, gid = wgid / nig, fm = gid * WGM, gsz = (nM - fm) < WGM ? (nM - fm) : WGM;
        u.pm = fm + ((wgid % nig) % gsz); u.pn = (wgid % nig) / gsz; return true;
    }
};
template <class Epi, class Sched, bool ALIGN_EPI>
__device__ __forceinline__ void gemm_phase(LAS unsigned char* lds, const Gemm g, const Sched& S, const Epi& E) {
    const int tid = threadIdx.x, wid = __builtin_amdgcn_readfirstlane(tid >> 6), lane = tid & 63, wr = wid >> 2, wc = wid & 3, fr = lane & 15, fq = lane >> 4;
    const int K = g.K, nt = K / BK;
    unsigned voffA[2], voffB[2];
#pragma unroll
    for (int i = 0; i < 2; ++i) { int R, C; stage_rc(tid * 16 + i * 8192, R, C); const int Rb = Epi::PERM ? ((R & ~31) + perm32(R & 31)) : R;
        voffA[i] = (unsigned)(R * g.lda + C) * 2u; voffB[i] = (unsigned)(Rb * g.ldb + C) * 2u; }
    const size_t kstep = (size_t)(BK * 2);
    const size_t hsA = (size_t)HALF * g.lda * 2, hsB = (size_t)HALF * g.ldb * 2;
    const unsigned ldsw = (unsigned)wid * 1024u;
    const int aoff = lds_byte(wr * 64 + fr, fq * 8), boff = lds_byte(wc * 32 + fr, fq * 8);
#define PG8_SA(b, h) (((b) * 2 + (h)) * HTB)
#define PG8_SB(b, h) ((4 + (b) * 2 + (h)) * HTB)
#define PG8_STAGE(bufoff, gbase, voff) do { _Pragma("unroll") for (int _i = 0; _i < 2; ++_i) \
        __builtin_amdgcn_global_load_lds((const unsigned*)((const char*)(gbase) + (voff)[_i]), (LAS unsigned*)(lds + (bufoff) + ldsw + _i * 8192), 16, 0, 0); } while (0)
#define PG8_LDA(dst, b, h) do { _Pragma("unroll") for (int m = 0; m < 4; ++m) _Pragma("unroll") for (int k = 0; k < 2; ++k) dst[m][k] = *(const LAS bf16x8*)(lds + PG8_SA(b, h) + aoff + m * 2048 + k * 1024); } while (0)
#define PG8_LDB(dst, b, h) do { _Pragma("unroll") for (int n = 0; n < 2; ++n) _Pragma("unroll") for (int k = 0; k < 2; ++k) dst[n][k] = *(const LAS bf16x8*)(lds + PG8_SB(b, h) + boff + n * 2048 + k * 1024); } while (0)
#define PG8_MMA(ai, bj, At, Bt) do { __builtin_amdgcn_s_setprio(1); _Pragma("unroll") for (int m = 0; m < 4; ++m) _Pragma("unroll") for (int n = 0; n < 2; ++n) _Pragma("unroll") for (int k = 0; k < 2; ++k) \
        acc[ai][bj][m][n] = __builtin_amdgcn_mfma_f32_16x16x32_bf16(Bt[n][k], At[m][k], acc[ai][bj][m][n], 0, 0, 0); __builtin_amdgcn_s_setprio(0); } while (0)
#define PG8_WAIT_V(n) asm volatile("s_waitcnt vmcnt(" #n ")" ::: "memory")
#define PG8_WAIT_L(n) asm volatile("s_waitcnt lgkmcnt(" #n ")" ::: "memory")
#define PG8_BAR __builtin_amdgcn_s_barrier()
#define PG8_SCHED __builtin_amdgcn_sched_barrier(0)
#define PG8_UA(u) ((const char*)g.A + (size_t)(u).pm * 2 * hsA + (size_t)(u).pn * (size_t)g.acs * 2)
#define PG8_UB(u) ((const char*)g.Bt + (size_t)(u).pn * 2 * hsB)
    Unit cur, nxt; int ui = 0;
    if (!S.next(0, cur)) return;
    f32x4 acc[2][2][4][2];
#pragma unroll
    for (int a = 0; a < 2; ++a)
#pragma unroll
        for (int b = 0; b < 2; ++b)
#pragma unroll
            for (int m = 0; m < 4; ++m)
#pragma unroll
                for (int n = 0; n < 2; ++n) acc[a][b][m][n] = (f32x4){0.f, 0.f, 0.f, 0.f};
    bf16x8 At[4][2], B0[2][2], B1[2][2];
    const char* cA = PG8_UA(cur); const char* cB = PG8_UB(cur);
    PG8_STAGE(PG8_SB(0, 0), cB, voffB); PG8_STAGE(PG8_SB(0, 1), cB + hsB, voffB); PG8_STAGE(PG8_SA(0, 0), cA, voffA); PG8_STAGE(PG8_SA(0, 1), cA + hsA, voffA);
    if (wr == 1) PG8_BAR;
    PG8_WAIT_V(2); PG8_BAR;
    PG8_STAGE(PG8_SB(1, 0), cB + kstep, voffB); PG8_STAGE(PG8_SA(1, 0), cA + kstep, voffA); PG8_STAGE(PG8_SB(1, 1), cB + hsB + kstep, voffB);
    PG8_WAIT_V(6); PG8_BAR;
    for (;;) {
        const bool has_next = S.next(ui + 1, nxt);
        const char* nA = has_next ? PG8_UA(nxt) : cA; const char* nB = has_next ? PG8_UB(nxt) : cB;
        for (int t = 0; t < nt; t += 2) {
            const bool last = (t == nt - 2);
            const char* a1 = cA + (size_t)(t + 1) * kstep;
            const char* a2 = last ? nA : cA + (size_t)(t + 2) * kstep; const char* b2 = last ? nB : cB + (size_t)(t + 2) * kstep;
            const char* a3 = a2 + kstep; const char* b3 = b2 + kstep;
            PG8_LDB(B0, 0, 0); PG8_LDB(B1, 0, 1); PG8_SCHED; PG8_LDA(At, 0, 0); PG8_STAGE(PG8_SA(1, 1), a1 + hsA, voffA);
            PG8_WAIT_V(8); PG8_WAIT_L(0); PG8_BAR; PG8_MMA(0, 0, At, B0); PG8_MMA(0, 1, At, B1); PG8_BAR; PG8_SCHED;
            PG8_LDA(At, 0, 1); PG8_STAGE(PG8_SB(0, 0), b2, voffB); PG8_STAGE(PG8_SB(0, 1), b2 + hsB, voffB); PG8_STAGE(PG8_SA(0, 0), a2, voffA);
            PG8_WAIT_V(8); PG8_WAIT_L(0); PG8_BAR; PG8_MMA(1, 0, At, B0); PG8_MMA(1, 1, At, B1); PG8_BAR; PG8_SCHED;
            PG8_LDB(B0, 1, 0); PG8_LDB(B1, 1, 1); PG8_SCHED; PG8_LDA(At, 1, 0); PG8_STAGE(PG8_SA(0, 1), a2 + hsA, voffA);
            PG8_WAIT_V(8); PG8_WAIT_L(0); PG8_BAR; PG8_MMA(0, 0, At, B0); PG8_MMA(0, 1, At, B1); PG8_BAR; PG8_SCHED;
            PG8_LDA(At, 1, 1); PG8_STAGE(PG8_SB(1, 0), b3, voffB); PG8_STAGE(PG8_SB(1, 1), b3 + hsB, voffB); PG8_STAGE(PG8_SA(1, 0), a3, voffA);
            PG8_WAIT_V(8); PG8_WAIT_L(0); PG8_BAR; PG8_MMA(1, 0, At, B0); PG8_MMA(1, 1, At, B1); PG8_BAR; PG8_SCHED;
        }
        if constexpr (ALIGN_EPI) { if (wr == 0) PG8_BAR; }
        E(acc, cur, wr, wc, fr, fq);
        if (!has_next) break;
#pragma unroll
        for (int a = 0; a < 2; ++a)
#pragma unroll
            for (int b = 0; b < 2; ++b)
#pragma unroll
                for (int m = 0; m < 4; ++m)
#pragma unroll
                    for (int n = 0; n < 2; ++n) acc[a][b][m][n] = (f32x4){0.f, 0.f, 0.f, 0.f};
        cur = nxt; cA = nA; cB = nB; ++ui;
        if constexpr (ALIGN_EPI) { if (wr == 1) PG8_BAR; }
    }
    PG8_WAIT_V(0);
    if constexpr (!ALIGN_EPI) { if (wr == 0) PG8_BAR; }
    PG8_BAR;
#undef PG8_SA
#undef PG8_SB
#undef PG8_STAGE
#undef PG8_LDA
#undef PG8_LDB
#undef PG8_MMA
#undef PG8_WAIT_V
#undef PG8_WAIT_L
#undef PG8_BAR
#undef PG8_SCHED
#undef PG8_UA
#undef PG8_UB
}

struct EpiProj {
    static constexpr bool PERM = true;
    bf16_t* Q; bf16_t* KV; float* gates; float* out;
    __device__ __forceinline__ void operator()(const f32x4 (&acc)[2][2][4][2], const Unit& u, int wr, int wc, int fr, int fq) const {
        const int pn = u.pn;
#pragma unroll
        for (int ai = 0; ai < 2; ++ai)
#pragma unroll
            for (int m = 0; m < 4; ++m) {
                const int row = u.pm * BM + ai * HALF + wr * 64 + m * 16 + fr;
                if (pn < 4) {
#pragma unroll
                    for (int bj = 0; bj < 2; ++bj) { const f32x4 v0 = acc[ai][bj][m][0] * C2, v1 = acc[ai][bj][m][1] * C2; u32x4 w;
                        w.x = cvtpk(v0[0], v0[1]); w.y = cvtpk(v0[2], v0[3]); w.z = cvtpk(v1[0], v1[1]); w.w = cvtpk(v1[2], v1[3]);
                        *(u32x4*)(Q + (size_t)row * D + pn * 256 + bj * HALF + wc * 32 + 8 * fq) = w; }
                } else if (pn < 10) {
                    const int t = pn - 4; float* dst = nullptr;
                    if (row < MP) { if (t < 4) dst = out + O_KCP + (size_t)t * SZ_KVP + (size_t)row * 256; else { const int tt = row & (SEQ - 1); if (tt >= SEQ - 512) dst = out + O_KWP + (size_t)(t - 4) * SZ_WP + ((size_t)(row >> 12) * 512 + (tt - (SEQ - 512))) * 256; } }
                    else { const int rs = row - MP; if (t < 4) dst = out + O_KCS + (size_t)t * SZ_KVS + (size_t)rs * 256; else dst = out + O_KWS + (size_t)(t - 4) * SZ_WS + ((size_t)(rs >> 2) * 512 + 508 + (rs & 3)) * 256; }
                    bf16_t* bd = KV + (size_t)t * KV_STRIDE + (size_t)row * 256;
#pragma unroll
                    for (int bj = 0; bj < 2; ++bj) { const int cc = bj * HALF + wc * 32 + 8 * fq; const f32x4 v0 = acc[ai][bj][m][0], v1 = acc[ai][bj][m][1]; u32x4 w;
                        w.x = cvtpk(v0[0], v0[1]); w.y = cvtpk(v0[2], v0[3]); w.z = cvtpk(v1[0], v1[1]); w.w = cvtpk(v1[2], v1[3]);
                        *(u32x4*)(bd + cc) = w;
                        if (dst) { *(f32x4*)(dst + cc) = v0; *(f32x4*)(dst + cc + 4) = v1; } }
                } else {
                    const int cc = wc * 32 + 8 * fq;
                    if (cc < 48) { float* gd = gates + (size_t)row * 48 + cc; *(f32x4*)gd = acc[ai][0][m][0]; *(f32x4*)(gd + 4) = acc[ai][0][m][1]; }
                }
            }
    }
};
template <bool XF32>
struct EpiRes {
    static constexpr bool PERM = false;
    const float* xin_p; const float* xin_s; bf16_t* xout; const float* gate;
    __device__ __forceinline__ void operator()(const f32x4 (&acc)[2][2][4][2], const Unit& u, int wr, int wc, int fr, int fq) const {
#pragma unroll
        for (int ai = 0; ai < 2; ++ai)
#pragma unroll
            for (int m = 0; m < 4; ++m) {
                const int row = u.pm * BM + ai * HALF + wr * 64 + m * 16 + fr;
                const int bb = row < MP ? (row >> 12) : NB + ((row - MP) >> 2);
                const float* xi = row < MP ? xin_p + (size_t)row * D : xin_s + (size_t)(row - MP) * D;
                const float* gp = gate + (size_t)bb * 6144; bf16_t* xo = xout + (size_t)row * D;
#pragma unroll
                for (int bj = 0; bj < 2; ++bj)
#pragma unroll
                    for (int n = 0; n < 2; ++n) { const int col = u.pn * BM + bj * HALF + wc * 32 + 16 * n + 4 * fq;
                        const f32x4 g4 = *(const f32x4*)(gp + col);
                        f32x4 x4;
                        if constexpr (XF32) x4 = *(const f32x4*)(xi + col);
                        else { const u32x2 xw = *(const u32x2*)(xo + col); x4 = (f32x4){__builtin_bit_cast(float, xw.x << 16), __builtin_bit_cast(float, xw.x & 0xffff0000u), __builtin_bit_cast(float, xw.y << 16), __builtin_bit_cast(float, xw.y & 0xffff0000u)}; }
                        const f32x4 rr = x4 + g4 * acc[ai][bj][m][n];
                        u32x2 w; w.x = cvtpk(rr[0], rr[1]); w.y = cvtpk(rr[2], rr[3]); *(u32x2*)(xo + col) = w; }
            }
    }
};
struct EpiGU {
    static constexpr bool PERM = true;
    bf16_t* act;
    __device__ __forceinline__ void operator()(const f32x4 (&acc)[2][2][4][2], const Unit& u, int wr, int wc, int fr, int fq) const {
#pragma unroll
        for (int ai = 0; ai < 2; ++ai)
#pragma unroll
            for (int m = 0; m < 4; ++m) {
                const int row = u.pm * BM + ai * HALF + wr * 64 + m * 16 + fr; float r[8];
#pragma unroll
                for (int n = 0; n < 2; ++n)
#pragma unroll
                    for (int e = 0; e < 4; ++e) { const float gv = acc[ai][0][m][n][e], uv = acc[ai][1][m][n][e]; r[n * 4 + e] = gv * sigmoidf_(gv) * uv; }
                u32x4 w; w.x = cvtpk(r[0], r[1]); w.y = cvtpk(r[2], r[3]); w.z = cvtpk(r[4], r[5]); w.w = cvtpk(r[6], r[7]);
                *(u32x4*)(act + (size_t)row * FF + u.pn * HALF + wc * 32 + 8 * fq) = w;
            }
    }
};
}

#define XB_TMO      128
#define XB_XCNT(j)  (256  + 64 * (j))
#define XB_XSUB(j)  (1280 + 64 * (j))
#define XB_XGEN(j)  (2304 + 64 * (j))
#define XB_TOP      3328
#define XB_TOPGEN   3392
#define XCD_BAR_WORDS 3456
#define XB_SPIN_CAP (1u << 18)
__device__ __forceinline__ unsigned xb_ld(unsigned* p)              { return __hip_atomic_load(p, __ATOMIC_RELAXED, __HIP_MEMORY_SCOPE_AGENT); }
__device__ __forceinline__ unsigned xb_add(unsigned* p, unsigned v) { return __hip_atomic_fetch_add(p, v, __ATOMIC_RELAXED, __HIP_MEMORY_SCOPE_AGENT); }
__device__ __forceinline__ unsigned xb_xcc_id() { return (unsigned)__builtin_amdgcn_s_getreg((3 << 11) | 20) & 0xFu; }
#define XB_SPIN(cond, bar) do { unsigned _sp = 0; while (cond) { __builtin_amdgcn_s_sleep(1); \
    if ((++_sp & 255u) == 0u) { if (xb_ld(&(bar)[XB_TMO])) break; if (_sp > XB_SPIN_CAP) { atomicAdd(&(bar)[XB_TMO], 1u); break; } } } } while (0)
struct XcdBarrier { unsigned* bar; unsigned x; volatile LAS unsigned* st; };
__device__ __forceinline__ XcdBarrier xcd_barrier_post(unsigned* bar, volatile LAS unsigned* st) {
    XcdBarrier b; b.bar = bar; b.x = xb_xcc_id(); b.st = st;
    if (threadIdx.x == 0) (void)xb_add(&bar[XB_XCNT(b.x)], 1u);
    return b;
}
__device__ __forceinline__ void xcd_barrier_complete(unsigned* bar, unsigned x, unsigned& nloc, unsigned& nx) {
    const unsigned G = gridDim.x * gridDim.y * gridDim.z;
    unsigned sum, cnt, mine, sp = 0u;
    for (;;) {
        sum = 0u; cnt = 0u; mine = 0u;
#pragma unroll
        for (unsigned j = 0; j < 16; ++j) { const unsigned c = xb_ld(&bar[XB_XCNT(j)]); sum += c; cnt += (c > 0u) ? 1u : 0u; mine = (j == x) ? c : mine; }
        if (sum == G) break;
        __builtin_amdgcn_s_sleep(1);
        if ((++sp & 255u) == 0u) { if (xb_ld(&bar[XB_TMO])) break; if (sp > XB_SPIN_CAP) { atomicAdd(&bar[XB_TMO], 1u); break; } }
    }
    nloc = mine > 0u ? mine : 1u; nx = cnt > 0u ? cnt : 1u;
}
__device__ __forceinline__ void xcd_barrier(const XcdBarrier& b) {
    asm volatile("s_waitcnt vmcnt(0)" ::: "memory");
    __syncthreads();
    if (threadIdx.x == 0) {
        unsigned* bar = b.bar;
        __builtin_amdgcn_s_waitcnt(0);
        unsigned nloc = b.st[0], nx = b.st[1];
        if (nloc == 0u) { xcd_barrier_complete(bar, b.x, nloc, nx); b.st[0] = nloc; b.st[1] = nx; }
        const unsigned old = xb_add(&bar[XB_XSUB(b.x)], 1u);
        const unsigned gen = old / nloc;
        if (old + 1u == (gen + 1u) * nloc) {
            __builtin_amdgcn_fence(__ATOMIC_RELEASE, "agent");
            asm volatile("s_waitcnt vmcnt(0)" ::: "memory");
            const unsigned og = xb_add(&bar[XB_TOP], 1u);
            const unsigned tg = og / nx;
            if (og + 1u == (tg + 1u) * nx) xb_add(&bar[XB_TOPGEN], 1u);
            else XB_SPIN(xb_ld(&bar[XB_TOPGEN]) == tg, bar);
            __builtin_amdgcn_fence(__ATOMIC_ACQUIRE, "agent");
            xb_add(&bar[XB_XGEN(b.x)], 1u);
            asm volatile("s_waitcnt vmcnt(0)" ::: "memory");
        } else {
            XB_SPIN(xb_ld(&bar[XB_XGEN(b.x)]) == gen, bar);
            __builtin_amdgcn_fence(__ATOMIC_ACQUIRE, "agent");
            asm volatile("s_waitcnt vmcnt(0)" ::: "memory");
        }
    }
    __syncthreads();
}

struct Args { const void* in[28]; float* out; unsigned char* ws; int ph_lo, ph_hi, pad0, pad1; };
struct Frame {
    LAS unsigned char* lds; int tid, lane, wave, vcu, G;
    const float *x_p, *x_s, *c_p, *c_s, *ck_cmp, *cv_cmp, *ck_sel, *cv_sel; const int* page_table; const float *st_kw, *st_vw, *st_pool, *rel_bias, *ada_w, *ada_b, *norm_g, *final_g,
        *w_in, *w_out, *cmp_wk, *cmp_wv, *pe_k, *pe_v, *pool_w, *pool_scale, *ffn_wg, *ffn_wu, *ffn_wd;
    float* out; unsigned char* ws;
};
__device__ __forceinline__ float wave_sum(float v) {
#pragma unroll
    for (int o = 1; o < 64; o <<= 1) v += __shfl_xor(v, o);
    return v;
}

__device__ __forceinline__ void transpose_item(const float* W, int ldw, int nvalid, bf16_t* WT, int ldt, int drow0, LAS float* scr, int k0, int n0, int lane, const float* rs = nullptr  ) {
    float tv[32];
#pragma unroll
    for (int i = 0; i < 32; ++i) { const int kk = 2 * i + (lane >> 5), n = n0 + (lane & 31); tv[i] = (n < nvalid) ? W[(size_t)(k0 + kk) * ldw + n] : 0.f; }
    if (rs) { const float rsv = rs[n0 + (lane & 31)];
#pragma unroll
        for (int i = 0; i < 32; ++i) tv[i] *= rsv; }
#pragma unroll
    for (int i = 0; i < 32; ++i) { const int kk = 2 * i + (lane >> 5); scr[kk * 33 + (lane & 31)] = tv[i]; }
    LDS_WAIT();
    const int c = lane & 7;
#pragma unroll
    for (int j = 0; j < 4; ++j) { const int n = (lane >> 3) + 8 * j; const LAS float* s = scr + (8 * c) * 33 + n;
        u32x4 o; o.x = cvtpk(s[0 * 33], s[1 * 33]); o.y = cvtpk(s[2 * 33], s[3 * 33]); o.z = cvtpk(s[4 * 33], s[5 * 33]); o.w = cvtpk(s[6 * 33], s[7 * 33]);
        *(u32x4*)(WT + (size_t)(drow0 + n) * ldt + k0 + 8 * c) = o; }
    LDS_WAIT();
}
__device__ __forceinline__ void p0_prologue(Frame& F) {
    LAS float* scr = (LAS float*)(F.lds + F.wave * 16384);
    const int gw = F.vcu * 8 + F.wave, NGW = F.G * 8, lane = F.lane;
    unsigned char* ws = F.ws;
    constexpr int I_IN = 16 * 88, I_OUT = 16 * 32, I_G = 16 * 88, I_D = 44 * 32, I_P = 4 * 8, I_C = 32 * 2;
    constexpr int NITEMS = I_IN + I_OUT + 4 * I_G + 2 * I_D + 4 * I_P + 2 * I_C;
    for (int it = gw; it < NITEMS; it += NGW) {
        int r = it;
        if (r < I_IN) { const int kb = r / 88, nb = r % 88; transpose_item(F.w_in, INCOLS, INCOLS, (bf16_t*)(ws + WS_WIN), D, nb * 32, scr, kb * 64, nb * 32, lane); continue; } r -= I_IN;
        if (r < I_OUT) { const int kb = r / 32, nb = r % 32; transpose_item(F.w_out, D, D, (bf16_t*)(ws + WS_WOUT), D, nb * 32, scr, kb * 64, nb * 32, lane); continue; } r -= I_OUT;
        if (r < 4 * I_G) { const int l = r / (2 * I_G), which = (r / I_G) & 1, q = r % I_G, kb = q / 88, nb = q % 88, n0 = nb * 32;
            const float* W = (which ? F.ffn_wu : F.ffn_wg) + (size_t)l * D * FF;
            transpose_item(W, FF, FF, (bf16_t*)(ws + WS_WGU) + (size_t)l * NGU * D, D, (n0 >> 7) * 256 + which * 128 + (n0 & 127), scr, kb * 64, n0, lane); continue; } r -= 4 * I_G;
        if (r < 2 * I_D) { const int l = r / I_D, q = r % I_D, kb = q / 32, nb = q % 32;
            transpose_item(F.ffn_wd + (size_t)l * FF * D, D, D, (bf16_t*)(ws + WS_WD) + (size_t)l * D * FF, FF, nb * 32, scr, kb * 64, nb * 32, lane); continue; } r -= 2 * I_D;
        if (r < 4 * I_P) { const int gI = r / I_P, q = r % I_P, kb = q / 8, nb = q % 8;
            transpose_item(F.pool_w + (size_t)gI * 65536, 256, 256, (bf16_t*)(ws + WS_WPOOL) + (size_t)gI * 65536, 256, nb * 32, scr, kb * 64, nb * 32, lane, F.pool_scale + gI * 256); continue; } r -= 4 * I_P;
        { const int which = r / I_C, q = r % I_C, kb = q / 2, nb = q % 2;
          transpose_item(which ? F.cmp_wv : F.cmp_wk, 64, 64, (bf16_t*)(ws + (which ? WS_WCV : WS_WCK)), 2048, nb * 32, scr, kb * 64, nb * 32, lane); }
    }
    { const int gt = (F.vcu * 8 + F.wave) * 64 + lane, NT = F.G * 512; bf16_t* sc = (bf16_t*)(ws + WS_SC);
      for (int i = gt; i < 144 * 512; i += NT) { const int row = i >> 9, c2 = (i & 511) * 2; float a = 0.f, b = 0.f;
          if (row < NMODB) { const float* cp = row < NB ? F.c_p + (size_t)row * D : F.c_s + (size_t)(row - NB) * D; const float x0 = cp[c2], x1 = cp[c2 + 1]; a = x0 * sigmoidf_(x0); b = x1 * sigmoidf_(x1); }
          *(unsigned*)(sc + (size_t)row * D + c2) = cvtpk(a, b); } }
    if (F.vcu < 16) { const int tsel = F.vcu >> 3, part = F.vcu & 7; const float* pe = tsel ? F.pe_v : F.pe_k; const float* W = tsel ? F.cmp_wv : F.cmp_wk; float sacc = 0.f;
        const int kb = part * 256 + F.wave * 32;
#pragma unroll
        for (int k = 0; k < 32; ++k) sacc += pe[kb + k] * W[(size_t)(kb + k) * 64 + lane];
        LAS float* red = (LAS float*)(F.lds + WSF_OFF);
        red[F.wave * 64 + lane] = sacc; LDS_WAIT(); __syncthreads();
        if (F.wave == 0) { float t2 = 0.f;
#pragma unroll
            for (int w = 0; w < 8; ++w) t2 += red[w * 64 + lane];
            ((float*)(ws + WS_CB))[(tsel * 8 + part) * 64 + lane] = t2; }
        __syncthreads(); }
    { const size_t gt = (size_t)(F.vcu * 8 + F.wave) * 64 + lane, NT = (size_t)F.G * 512;
      const size_t pp = (size_t)NSB * 11 * 256;
      for (size_t i = gt; i < pp; i += NT) { const size_t b = i / (11 * 256), rem = i % (11 * 256);
          ((f32x4*)(F.out + O_PLS + b * 15 * D))[rem] = ((const f32x4*)(F.st_pool + (b * 15 + 4) * D))[rem]; } }
}

__device__ __forceinline__ void p1_ada(Frame& F) {
    const int gw = F.vcu * 8 + F.wave, NGW = F.G * 8, lane = F.lane, fr = lane & 15, kq = lane >> 4;
    const bf16_t* sc = (const bf16_t*)(F.ws + WS_SC); float* mod = (float*)(F.ws + WS_MOD);
    for (int tile = F.wave < 3 ? F.vcu * 3 + F.wave : 768; tile < 768; tile += F.G * 3) {
        const int layer = tile / 384, n0 = (tile % 384) * 16;
        const float* W = F.ada_w + (size_t)layer * D * 6144 + n0 + fr;
        f32x4 acc[9];
#pragma unroll
        for (int i = 0; i < 9; ++i) acc[i] = (f32x4){0.f, 0.f, 0.f, 0.f};
#pragma unroll 4
        for (int k0 = 0; k0 < D; k0 += 32) {
            float w[8];
#pragma unroll
            for (int i = 0; i < 8; ++i) w[i] = W[(size_t)(k0 + 8 * kq + i) * 6144];
            u32x4 bw; bw.x = cvtpk(w[0], w[1]); bw.y = cvtpk(w[2], w[3]); bw.z = cvtpk(w[4], w[5]); bw.w = cvtpk(w[6], w[7]);
            const bf16x8 bfrag = __builtin_bit_cast(bf16x8, bw);
#pragma unroll
            for (int mt = 0; mt < 9; ++mt) { const bf16x8 af = *(const bf16x8*)(sc + (size_t)(mt * 16 + fr) * D + k0 + 8 * kq);
                acc[mt] = __builtin_amdgcn_mfma_f32_16x16x32_bf16(af, bfrag, acc[mt], 0, 0, 0); }
        }
        const float bias = F.ada_b[layer * 6144 + n0 + fr];
#pragma unroll
        for (int mt = 0; mt < 9; ++mt)
#pragma unroll
            for (int e = 0; e < 4; ++e) { const int row = mt * 16 + 4 * kq + e; if (row < NMODB) mod[((size_t)layer * NMODB + row) * 6144 + n0 + fr] = acc[mt][e] + bias; }
    }
}

__device__ __forceinline__ void p1_compress_sample(Frame& F) {
    const int lane = F.lane, wave = F.wave, r32 = lane & 31, hi = lane >> 5, kvl = lane >> 4, c4 = lane & 15;
    LAS unsigned char* L = F.lds;
    const int wrow = wave * 4 + kvl, total = 2 * NSB * 8;
    const int nitem = (total - F.vcu + F.G - 1) / F.G; if (nitem <= 0) return;
    const int nstage = 2 * nitem;
#define CS_BAR() do { asm volatile("s_waitcnt lgkmcnt(0)" ::: "memory"); __builtin_amdgcn_s_barrier(); asm volatile("" ::: "memory"); } while (0)
#define CS_SRC(g, ptr) do { const int it_ = F.vcu + F.G * ((g) >> 1); const int wh_ = it_ / (NSB * 8), q_ = it_ % (NSB * 8), b_ = q_ >> 3, n_ = (q_ & 7) * 8 + wave; const int pg_ = F.page_table[b_ * 16 + (n_ >> 2)]; \
        ptr = uniform_ptr((wh_ ? F.cv_cmp : F.ck_cmp) + ((size_t)pg_ * 128 + (n_ & 3) * 32 + ((g) & 1) * 16) * 256); } while (0)
#define CS_LOAD(ptr) do { _Pragma("unroll") for (int jj = 0; jj < 16; ++jj) x[jj] = *(const f32x4*)((ptr) + (unsigned)(jj * 1024 + lane * 16)); } while (0)
#define CS_STORE(buf) do { _Pragma("unroll") for (int jj = 0; jj < 16; ++jj) { u32x2 w_; w_.x = cvtpk(x[jj][0], x[jj][1]); w_.y = cvtpk(x[jj][2], x[jj][3]); \
        *(LAS u32x2*)(L + (buf) * 65536 + wrow * 2048 + (((jj * 8 + (c4 >> 1)) ^ (wrow & 15)) << 4) + (c4 & 1) * 8) = w_; } } while (0)
    f32x4 x[16]; const char* sp;
    CS_SRC(0, sp); CS_LOAD(sp); CS_STORE(0); CS_BAR();
    f32x16 a0, a1;
#pragma unroll
    for (int r = 0; r < 16; ++r) { a0[r] = 0.f; a1[r] = 0.f; }
#pragma unroll 1
    for (int g = 0; g < nstage; ++g) {
        const int it = F.vcu + F.G * (g >> 1), which = it / (NSB * 8), q = it % (NSB * 8), b = q >> 3, n0 = (q & 7) * 8;
        const bf16_t* wp = (const bf16_t*)(F.ws + (which ? WS_WCV : WS_WCK)) + (size_t)r32 * 2048 + (g & 1) * 1024 + 128 * wave + 8 * hi;
        bf16x8 bfr[16];
#pragma unroll
        for (int ks = 0; ks < 8; ++ks) { bfr[2 * ks] = *(const bf16x8*)(wp + 16 * ks); bfr[2 * ks + 1] = *(const bf16x8*)(wp + 32 * 2048 + 16 * ks); }
        if (g + 1 < nstage) { CS_SRC(g + 1, sp); CS_LOAD(sp); }
        const LAS unsigned char* ab = L + (g & 1) * 65536 + r32 * 2048;
#pragma unroll
        for (int ks = 0; ks < 8; ++ks) { const bf16x8 af = *(const LAS bf16x8*)(ab + (((16 * wave + 2 * ks + hi) ^ (r32 & 15)) << 4));
            a0 = __builtin_amdgcn_mfma_f32_32x32x16_bf16(af, bfr[2 * ks], a0, 0, 0, 0); a1 = __builtin_amdgcn_mfma_f32_32x32x16_bf16(af, bfr[2 * ks + 1], a1, 0, 0, 0); }
        CS_BAR();
        if (g & 1) {
            LAS float* red = (LAS float*)(L + 65536) + wave * 2048 + hi * 256 + r32;
#pragma unroll
            for (int r = 0; r < 16; ++r) { red[CROW0(r) * 64] = a0[r]; red[CROW0(r) * 64 + 32] = a1[r]; a0[r] = 0.f; a1[r] = 0.f; }
            CS_BAR();
            { const int row = F.tid >> 4, cc = (F.tid & 15) * 4; f32x4 sacc = (f32x4){0.f, 0.f, 0.f, 0.f};
#pragma unroll
              for (int pp = 0; pp < 8; ++pp) sacc = sacc + *(const f32x4*)((const float*)(F.ws + WS_CB) + (which * 8 + pp) * 64 + cc);
#pragma unroll
              for (int w = 0; w < 8; ++w) sacc = sacc + *(const LAS f32x4*)((const LAS float*)(L + 65536) + w * 2048 + row * 64 + cc);
              bf16_t* o = (bf16_t*)(F.ws + (which ? WS_VCMPS : WS_KCMPS)) + (size_t)b * 4 * 64 * 64 + ((size_t)(row & 3) * 64 + n0 + (row >> 2)) * 64 + cc;
              u32x2 w2; w2.x = cvtpk(sacc[0], sacc[1]); w2.y = cvtpk(sacc[2], sacc[3]); *(u32x2*)o = w2; }
        }
        if (g + 1 < nstage) CS_STORE((g + 1) & 1);
        CS_BAR();
    }
    VM_WAIT(); __syncthreads();
#undef CS_BAR
#undef CS_SRC
#undef CS_LOAD
#undef CS_STORE
}
__device__ __forceinline__ void p4_compress_prompt(Frame& F) {
    const int lane = F.lane, r32 = lane & 31, hi = lane >> 5, nl = r32 >> 2, kv = r32 & 3;
    for (int it = F.vcu; it < 2 * NB * 16; it += F.G) {
        const int which = it / (NB * 16), q = it % (NB * 16), b = q >> 4, n0 = (q & 15) * 8, n = n0 + nl;
        const bf16_t* src = (const bf16_t*)(F.ws + WS_KV) + (size_t)which * KV_STRIDE + ((size_t)b * SEQ + (size_t)n * 32) * 256 + kv * 64;
        const bf16_t* Wt = (const bf16_t*)(F.ws + (which ? WS_WCV : WS_WCK));
        const bf16_t* w0 = Wt + (size_t)r32 * 2048 + hi * 8; const bf16_t* w1 = w0 + (size_t)32 * 2048;
        f32x16 a0, a1;
#pragma unroll
        for (int r = 0; r < 16; ++r) { a0[r] = 0.f; a1[r] = 0.f; }
#pragma unroll
        for (int jj = 0; jj < 4; ++jj) { const int j = F.wave * 4 + jj;
#pragma unroll
            for (int ds = 0; ds < 4; ++ds) { const bf16x8 af = *(const bf16x8*)(src + (size_t)j * 256 + ds * 16 + hi * 8);
                const bf16x8 b0 = *(const bf16x8*)(w0 + j * 64 + ds * 16), b1 = *(const bf16x8*)(w1 + j * 64 + ds * 16);
                a0 = __builtin_amdgcn_mfma_f32_32x32x16_bf16(af, b0, a0, 0, 0, 0); a1 = __builtin_amdgcn_mfma_f32_32x32x16_bf16(af, b1, a1, 0, 0, 0); } }
        LAS float* red = (LAS float*)F.lds + F.wave * 2048 + hi * 256 + r32;
#pragma unroll
        for (int r = 0; r < 16; ++r) { red[CROW0(r) * 64] = a0[r]; red[CROW0(r) * 64 + 32] = a1[r]; }
        LDS_WAIT(); __syncthreads();
        { const int row = F.tid >> 4, c4 = (F.tid & 15) * 4; f32x4 sacc = (f32x4){0.f, 0.f, 0.f, 0.f};
#pragma unroll
          for (int pp = 0; pp < 8; ++pp) sacc = sacc + *(const f32x4*)((const float*)(F.ws + WS_CB) + (which * 8 + pp) * 64 + c4);
#pragma unroll
          for (int w = 0; w < 8; ++w) sacc = sacc + *(const LAS f32x4*)((const LAS float*)F.lds + w * 2048 + row * 64 + c4);
          bf16_t* o = (bf16_t*)(F.ws + (which ? WS_VCMPP : WS_KCMPP)) + (size_t)b * 4 * 128 * 64 + ((size_t)(row & 3) * 128 + n0 + (row >> 2)) * 64 + c4;
          u32x2 w2; w2.x = cvtpk(sacc[0], sacc[1]); w2.y = cvtpk(sacc[2], sacc[3]); *(u32x2*)o = w2; }
        __syncthreads();
    }
}

template <bool XF32>
__device__ __forceinline__ void small_gemm_res(Frame& F, const bf16_t* A  , int lda, const bf16_t* Wt, int ldb, int K, bool bd, const float* xin_s  , bf16_t* xout_s, const float* gate) {
    const int lane = lane_id(), tid_ = F.wave * 64 + lane, r32 = lane & 31, hi = lane >> 5, kw = K >> 3, kbeg = F.wave * kw;
    for (int tile = F.vcu; tile < 256; tile += F.G) {
        const int row0 = (tile >> 4) * 32, col0 = (tile & 15) * 64, acol = bd ? (col0 >> 8) * 256 : 0;
        const bf16_t* ap = A + (size_t)(row0 + r32) * lda + acol + kbeg + 8 * hi;
        const bf16_t* b0p = Wt + (size_t)(col0 + r32) * ldb + kbeg + 8 * hi; const bf16_t* b1p = b0p + (size_t)32 * ldb;
        f32x16 c0, c1;
#pragma unroll
        for (int r = 0; r < 16; ++r) { c0[r] = 0.f; c1[r] = 0.f; }
#pragma unroll 8
        for (int ks = 0; ks < kw; ks += 16) { const bf16x8 a = *(const bf16x8*)(ap + ks), b0 = *(const bf16x8*)(b0p + ks), b1 = *(const bf16x8*)(b1p + ks);
            c0 = __builtin_amdgcn_mfma_f32_32x32x16_bf16(a, b0, c0, 0, 0, 0); c1 = __builtin_amdgcn_mfma_f32_32x32x16_bf16(a, b1, c1, 0, 0, 0); }
        LAS float* red = (LAS float*)F.lds + F.wave * 2048 + hi * 256 + r32;
#pragma unroll
        for (int r = 0; r < 16; ++r) { red[CROW0(r) * 64] = c0[r]; red[CROW0(r) * 64 + 32] = c1[r]; }
        LDS_WAIT(); __syncthreads();
        { const int row = tid_ >> 4, c4 = (tid_ & 15) * 4; f32x4 sacc = (f32x4){0.f, 0.f, 0.f, 0.f};
#pragma unroll
          for (int w = 0; w < 8; ++w) sacc = sacc + *(const LAS f32x4*)((const LAS float*)F.lds + w * 2048 + row * 64 + c4);
          const int rs = row0 + row, col = col0 + c4, bb = NB + (rs >> 2);
          const f32x4 g4 = *(const f32x4*)(gate + (size_t)bb * 6144 + col);
          f32x4 x4;
          if constexpr (XF32) x4 = *(const f32x4*)(xin_s + (size_t)rs * D + col);
          else { const u32x2 xw = *(const u32x2*)(xout_s + (size_t)rs * D + col); x4 = (f32x4){__builtin_bit_cast(float, xw.x << 16), __builtin_bit_cast(float, xw.x & 0xffff0000u), __builtin_bit_cast(float, xw.y << 16), __builtin_bit_cast(float, xw.y & 0xffff0000u)}; }
          const f32x4 rr = x4 + g4 * sacc; u32x2 w; w.x = cvtpk(rr[0], rr[1]); w.y = cvtpk(rr[2], rr[3]); *(u32x2*)(xout_s + (size_t)rs * D + col) = w; }
        __syncthreads();
    }
}

template <int CTRL> __device__ __forceinline__ float dpp_add(float v) { return v + __uint_as_float((unsigned)__builtin_amdgcn_update_dpp(0, (int)__float_as_uint(v), CTRL, 0xF, 0xF, true)); }
__device__ __forceinline__ float wave_sum64(float v) {
    v = dpp_add<0xB1>(v); v = dpp_add<0x4E>(v); v = dpp_add<0x141>(v); v = dpp_add<0x140>(v);
    { auto rr = __builtin_amdgcn_permlane16_swap(__float_as_uint(v), __float_as_uint(v), false, false); v = __uint_as_float(rr[0]) + __uint_as_float(rr[1]); }
    { auto rr = __builtin_amdgcn_permlane32_swap(__float_as_uint(v), __float_as_uint(v), false, false); v = __uint_as_float(rr[0]) + __uint_as_float(rr[1]); }
    return v;
}
__device__ __forceinline__ f32x4 unpack_bf16x4(u32x2 w) { return (f32x4){__builtin_bit_cast(float, w.x << 16), __builtin_bit_cast(float, w.x & 0xffff0000u), __builtin_bit_cast(float, w.y << 16), __builtin_bit_cast(float, w.y & 0xffff0000u)}; }
template <int MODE, int NR>
__device__ __forceinline__ void norm_rows(Frame& F, bool from_inputs, int layer, int which, int row0, const f32x4 (&gg)[4], int lane) {
    f32x4 v[NR][4]; u32x2 xw[NR][4];
    if (from_inputs) {
        const float* xr = row0 < MP ? F.x_p + (size_t)row0 * D : F.x_s + (size_t)(row0 - MP) * D;
#pragma unroll
        for (int r = 0; r < NR; ++r)
#pragma unroll
            for (int j = 0; j < 4; ++j) v[r][j] = *(const f32x4*)(xr + (size_t)r * D + 4 * lane + 256 * j);
    } else {
        const bf16_t* xr = (const bf16_t*)(F.ws + WS_X) + (size_t)row0 * D;
#pragma unroll
        for (int r = 0; r < NR; ++r)
#pragma unroll
            for (int j = 0; j < 4; ++j) xw[r][j] = *(const u32x2*)(xr + (size_t)r * D + 4 * lane + 256 * j);
    }
#define NV(r, j) (from_inputs ? v[r][j] : unpack_bf16x4(xw[r][j]))
    f32x4 sh[4], sc[4];
    if constexpr (MODE == 0) {
        const int bb = row0 < MP ? (row0 >> 12) : NB + ((row0 - MP) >> 2);
        const float* mp = (const float*)(F.ws + WS_MOD) + ((size_t)layer * NMODB + bb) * 6144 + (which ? 3072 : 0);
#pragma unroll
        for (int j = 0; j < 4; ++j) { sh[j] = *(const f32x4*)(mp + 4 * lane + 256 * j); sc[j] = *(const f32x4*)(mp + 1024 + 4 * lane + 256 * j) + 1.0f; }
    }
    float ss[NR];
#pragma unroll
    for (int r = 0; r < NR; ++r) { float a = 0.f;
#pragma unroll
        for (int j = 0; j < 4; ++j) { const f32x4 x = NV(r, j); a += (x[0] * x[0] + x[1] * x[1]) + (x[2] * x[2] + x[3] * x[3]); }
        ss[r] = a; }
    if (!from_inputs) {
#pragma unroll
        for (int r = 0; r < NR; ++r)
#pragma unroll
            for (int j = 0; j < 4; ++j) asm volatile("" : "+v"(xw[r][j].x), "+v"(xw[r][j].y));
    }
#pragma unroll
    for (int r = 0; r < NR; ++r) ss[r] = wave_sum64(ss[r]);
#pragma unroll
    for (int r = 0; r < NR; ++r) {
        const int row = row0 + r; const float rstd = 1.0f / sqrtf(ss[r] * (1.0f / D) + 1e-6f);
        if constexpr (MODE == 2) {
            float* o = row < MP ? F.out + O_YP + (size_t)row * D : F.out + O_YS + (size_t)(row - MP) * D;
#pragma unroll
            for (int j = 0; j < 4; ++j) *(f32x4*)(o + 4 * lane + 256 * j) = NV(r, j) * rstd * gg[j];
        } else if constexpr (MODE == 1) {
            if (lane == 0) ((float*)(F.ws + WS_RSTD))[row] = rstd;
        } else {
#pragma unroll
            for (int j = 0; j < 4; ++j) { const int col = 4 * lane + 256 * j; const f32x4 h = (NV(r, j) * rstd * gg[j]) * sc[j] + sh[j];
                u32x2 w; w.x = cvtpk(h[0], h[1]); w.y = cvtpk(h[2], h[3]); *(u32x2*)((bf16_t*)(F.ws + WS_H) + (size_t)row * D + col) = w; }
        }
    }
#undef NV
}
#ifndef NRX
#define NRX 4
#endif
template <int MODE>
__device__ __forceinline__ void norm_phase(Frame& F, bool from_inputs, int layer, int which) {
    const int gw = F.vcu * 8 + F.wave, NGW = F.G * 8, lane = lane_id();
    const float* gvec = MODE == 2 ? F.final_g : F.norm_g + (size_t)(layer * 2 + which) * D;
    f32x4 gg[4];
#pragma unroll
    for (int j = 0; j < 4; ++j) gg[j] = *(const f32x4*)(gvec + 4 * lane + 256 * j);
    if (from_inputs) {
#pragma unroll 1
        for (int grp = gw; grp < MP / 4; grp += NGW) norm_rows<MODE, 4>(F, true, layer, which, grp * 4, gg, lane);
    } else {
#pragma unroll 1
        for (int grp = gw; grp < MP / NRX; grp += NGW) norm_rows<MODE, NRX>(F, false, layer, which, grp * NRX, gg, lane);
    }
#pragma unroll 1
    for (int r = gw; r < MS; r += NGW) norm_rows<MODE, 1>(F, from_inputs, layer, which, MP + r, gg, lane);
}

template <int W, int R, bool SAMPLE>
__device__ __forceinline__ void pool_chunk(const bf16_t* X, const float* rstd, f32x4 a4, f32x4 s4, const float* st_pool, bf16_t* H, float* out, int row0, int col) {
    f32x4 v[R + W - 1];
    const int t0 = SAMPLE ? 0 : (row0 & (SEQ - 1));
    u32x2 xw[R + W - 1]; float rs[R + W - 1];
#pragma unroll
    for (int k = 0; k < R + W - 1; ++k) { const int tt = t0 - (W - 1) + k;
        if (SAMPLE) { const int b = (row0 - MP) >> 2;
            if (tt >= 0) { xw[k] = *(const u32x2*)(X + (size_t)(row0 + tt) * D + col); rs[k] = rstd[row0 + tt]; }
            else v[k] = *(const f32x4*)(st_pool + ((size_t)b * 15 + 15 + tt) * D + col); }
        else if (tt >= 0) { xw[k] = *(const u32x2*)(X + (size_t)(row0 - (W - 1) + k) * D + col); rs[k] = rstd[row0 - (W - 1) + k]; }
        else { xw[k] = (u32x2){0u, 0u}; rs[k] = 0.f; } }
#pragma unroll
    for (int k = 0; k < R + W - 1; ++k) { const int tt = t0 - (W - 1) + k;
        if (SAMPLE) { if (tt >= 0) v[k] = unpack_bf16x4(xw[k]) * rs[k] * a4 + s4; }
        else v[k] = tt >= 0 ? unpack_bf16x4(xw[k]) * rs[k] * a4 + s4 : (f32x4){0.f, 0.f, 0.f, 0.f}; }
    f32x4 sacc = v[0];
#pragma unroll
    for (int k = 1; k < W; ++k) sacc = sacc + v[k];
#pragma unroll
    for (int r = 0; r < R; ++r) {
        if (r > 0) sacc = sacc + v[r + W - 1] - v[r - 1];
        const int tt = t0 + r; const float inv = 1.0f / (float)(SAMPLE ? W : (tt + 1 < W ? tt + 1 : W));
        const f32x4 cur = v[r + W - 1], pv = sacc * inv - cur;
        u32x2 w2; w2.x = cvtpk(pv[0], pv[1]); w2.y = cvtpk(pv[2], pv[3]); *(u32x2*)(H + (size_t)(row0 + r) * D + col) = w2;
        if (SAMPLE) { const int rsn = row0 - MP + r; *(f32x4*)(out + O_PLS + ((size_t)(rsn >> 2) * 15 + 11 + (rsn & 3)) * D + col) = cur; }
        else if (tt >= SEQ - 15) *(f32x4*)(out + O_PLP + ((size_t)((row0 + r) >> 12) * 15 + (tt - (SEQ - 15))) * D + col) = cur; }
}
__device__ __forceinline__ void pool_phase(Frame& F) {
    const int gt = (F.vcu * 8 + F.wave) * 64 + lane_id(), NT = F.G * 512;
    const bf16_t* X = (const bf16_t*)(F.ws + WS_X); const float* rstd = (const float*)(F.ws + WS_RSTD); bf16_t* H = (bf16_t*)(F.ws + WS_H);
    constexpr int NPI = (MP / 8) * 256, NSI = (MS / 4) * 256;
#pragma unroll 1
    for (int i = gt; i < NPI + NSI; i += NT) {
        const bool smp = i >= NPI; const int q = smp ? i - NPI : i; const int cg = q & 255, col = cg * 4, grp = cg >> 6;
        const int row0 = smp ? MP + (q >> 8) * 4 : (q >> 8) * 8, bb = smp ? NB + ((row0 - MP) >> 2) : (row0 >> 12);
        const float* mp = (const float*)(F.ws + WS_MOD) + ((size_t)NMODB + bb) * 6144;
        const f32x4 a4 = *(const f32x4*)(F.norm_g + (size_t)2 * D + col) * (*(const f32x4*)(mp + 1024 + col) + 1.0f), s4 = *(const f32x4*)(mp + col);
        if (!smp) {
            if (grp == 0) pool_chunk<2, 8, false>(X, rstd, a4, s4, F.st_pool, H, F.out, row0, col); else if (grp == 1) pool_chunk<4, 8, false>(X, rstd, a4, s4, F.st_pool, H, F.out, row0, col);
            else if (grp == 2) pool_chunk<8, 8, false>(X, rstd, a4, s4, F.st_pool, H, F.out, row0, col); else pool_chunk<16, 8, false>(X, rstd, a4, s4, F.st_pool, H, F.out, row0, col); }
        else {
            if (grp == 0) pool_chunk<2, 4, true>(X, rstd, a4, s4, F.st_pool, H, F.out, row0, col); else if (grp == 1) pool_chunk<4, 4, true>(X, rstd, a4, s4, F.st_pool, H, F.out, row0, col);
            else if (grp == 2) pool_chunk<8, 4, true>(X, rstd, a4, s4, F.st_pool, H, F.out, row0, col); else pool_chunk<16, 4, true>(X, rstd, a4, s4, F.st_pool, H, F.out, row0, col); }
    }
}

namespace att {
__device__ __forceinline__ int crow(int r, int hi) { return (r & 3) + 8 * (r >> 2) + 4 * hi; }
__device__ __forceinline__ float x32_sum(float v) { auto rr = __builtin_amdgcn_permlane32_swap(__float_as_uint(v), __float_as_uint(v), false, false); return __uint_as_float(rr[0]) + __uint_as_float(rr[1]); }
__device__ __forceinline__ float x32_max(float v) { auto rr = __builtin_amdgcn_permlane32_swap(__float_as_uint(v), __float_as_uint(v), false, false); return fmaxf(__uint_as_float(rr[0]), __uint_as_float(rr[1])); }
__device__ __forceinline__ unsigned x32_or(unsigned v) { auto rr = __builtin_amdgcn_permlane32_swap(v, v, false, false); return rr[0] | rr[1]; }
template <int X> __device__ __forceinline__ unsigned swz_xor(unsigned v) { return (unsigned)__builtin_amdgcn_ds_swizzle((int)v, (X << 10) | 0x1F); }
template <int X> __device__ __forceinline__ float swz_xorf(float v) { return __uint_as_float(swz_xor<X>(__float_as_uint(v))); }
__device__ __forceinline__ s16x4 vtr(const LAS unsigned char* p) { typedef short v4i16_t __attribute__((ext_vector_type(4))); return __builtin_bit_cast(s16x4, __builtin_amdgcn_ds_read_tr16_b64_v4i16((LAS v4i16_t*)p)); }
__device__ __forceinline__ void qk_tile(f32x16& p0, f32x16& p1, const LAS unsigned char* Kb, const bf16x8 (&qr)[4], float init, int r32, int hi) {
    f32x16 ci;
#pragma unroll
    for (int r = 0; r < 16; ++r) ci[r] = init;
    const int sw = (r32 >> 1) & 7;
    bf16x8 ka[4], kb[4];
#pragma unroll
    for (int ds = 0; ds < 4; ++ds) { const int ch = ((2 * ds + hi) ^ sw) << 4; ka[ds] = *(const LAS bf16x8*)(Kb + r32 * 128 + ch); kb[ds] = *(const LAS bf16x8*)(Kb + (32 + r32) * 128 + ch); }
    __builtin_amdgcn_s_setprio(1);
    f32x16 c0 = __builtin_amdgcn_mfma_f32_32x32x16_bf16(ka[0], qr[0], ci, 0, 0, 0);
    f32x16 c1 = __builtin_amdgcn_mfma_f32_32x32x16_bf16(kb[0], qr[0], ci, 0, 0, 0);
#pragma unroll
    for (int ds = 1; ds < 4; ++ds) {
        c0 = __builtin_amdgcn_mfma_f32_32x32x16_bf16(ka[ds], qr[ds], c0, 0, 0, 0);
        c1 = __builtin_amdgcn_mfma_f32_32x32x16_bf16(kb[ds], qr[ds], c1, 0, 0, 0);
    }
    __builtin_amdgcn_s_setprio(0);
    p0 = c0; p1 = c1;
}
__device__ __forceinline__ void pv_tile(f32x16 (&o)[2], const LAS unsigned char* Vb, const f32x16& p0, const f32x16& p1, int lane) {
    const int g4 = lane >> 4, nhalf = g4 & 1, h = g4 >> 1, i = lane & 15, q = i >> 2, pp = i & 3;
    const LAS unsigned char* vb = Vb + (4 * h + q) * 64 + nhalf * 32 + pp * 8;
#pragma unroll
    for (int kh = 0; kh < 2; ++kh) {
        s16x4 lo[2][2], hh[2][2];
#pragma unroll
        for (int s = 0; s < 2; ++s)
#pragma unroll
            for (int db = 0; db < 2; ++db) { lo[s][db] = vtr(vb + db * 4096 + (32 * kh + 16 * s) * 64); hh[s][db] = vtr(vb + db * 4096 + (32 * kh + 16 * s + 8) * 64); }
#pragma unroll
        for (int s = 0; s < 2; ++s) {
            const f32x16& p = kh ? p1 : p0; u32x4 pw;
            pw.x = cvtpk(p[8 * s + 0], p[8 * s + 1]); pw.y = cvtpk(p[8 * s + 2], p[8 * s + 3]); pw.z = cvtpk(p[8 * s + 4], p[8 * s + 5]); pw.w = cvtpk(p[8 * s + 6], p[8 * s + 7]);
            const bf16x8 pa = __builtin_bit_cast(bf16x8, pw);
#pragma unroll
            for (int db = 0; db < 2; ++db) {
                const bf16x8 vf = (bf16x8){lo[s][db][0], lo[s][db][1], lo[s][db][2], lo[s][db][3], hh[s][db][0], hh[s][db][1], hh[s][db][2], hh[s][db][3]};
                o[db] = __builtin_amdgcn_mfma_f32_32x32x16_bf16(pa, vf, o[db], 0, 0, 0);
            }
        }
    }
}
__device__ __forceinline__ void row_scale(f32x16 (&o)[2], float f, LAS float* wsf, int r32, int hi) {
    if (hi == 0) wsf[r32] = f;
    LDS_WAIT();
    const LAS float* wh = wsf + 4 * hi;
#pragma unroll
    for (int r = 0; r < 16; ++r) { const float fr = wh[CROW0(r)]; o[0][r] *= fr; o[1][r] *= fr; }
    LDS_WAIT();
}
__device__ __forceinline__ void row_fma(f32x16 (&dst)[2], const f32x16 (&o)[2], float f, LAS float* wsf, int r32, int hi) {
    if (hi == 0) wsf[r32] = f;
    LDS_WAIT();
    const LAS float* wh = wsf + 4 * hi;
#pragma unroll
    for (int r = 0; r < 16; ++r) { const float fr = wh[CROW0(r)]; dst[0][r] += fr * o[0][r]; dst[1][r] += fr * o[1][r]; }
    LDS_WAIT();
}
__device__ __forceinline__ void softmax_update(f32x16& p0, f32x16& p1, float& m, float& l, f32x16 (&o)[2], LAS float* wsf, int r32, int hi) {
    float rm = fmaxf(p0[0], p1[0]);
#pragma unroll
    for (int r = 1; r < 16; ++r) rm = fmaxf(rm, fmaxf(p0[r], p1[r]));
    rm = x32_max(rm);
    const float mn = fmaxf(m, rm), f = ex2(m - mn);
    m = mn; float s = 0.f;
#pragma unroll
    for (int r = 0; r < 16; ++r) { p0[r] = ex2(p0[r] - mn); p1[r] = ex2(p1[r] - mn); s += p0[r] + p1[r]; }
    l = l * f + s;
    if (__any(f != 1.0f)) row_scale(o, f, wsf, r32, hi);
}
__device__ __forceinline__ void softmax_full(f32x16& a0, f32x16& a1, f32x16& b0, f32x16& b1) {
    float rm = -1e30f;
#pragma unroll
    for (int r = 0; r < 16; ++r) rm = fmaxf(rm, fmaxf(fmaxf(a0[r], a1[r]), fmaxf(b0[r], b1[r])));
    rm = x32_max(rm); float s = 0.f;
#pragma unroll
    for (int r = 0; r < 16; ++r) { a0[r] = ex2(a0[r] - rm); a1[r] = ex2(a1[r] - rm); b0[r] = ex2(b0[r] - rm); b1[r] = ex2(b1[r] - rm); s += (a0[r] + a1[r]) + (b0[r] + b1[r]); }
    s = x32_sum(s);
    const float inv = s > 0.f ? 1.0f / s : 0.f;
#pragma unroll
    for (int r = 0; r < 16; ++r) { a0[r] *= inv; a1[r] *= inv; b0[r] *= inv; b1[r] *= inv; }
}
__device__ __forceinline__ unsigned imp_key(float v, int j, int c) {
    const bool forced = (j == 0) | (j == c) | (j == c - 1);
    const unsigned base = forced ? 0x7F000000u : (j <= c ? (__float_as_uint(v) & 0xFFFFFFC0u) : 0u);
    return base | (unsigned)(63 - j);
}
__device__ __forceinline__ void imp_store(const f32x16& p0, const f32x16& p1, int T, LAS unsigned* impq  , int c, int g, int hi) {
#pragma unroll
    for (int kh = 0; kh < 2; ++kh)
#pragma unroll
        for (int a = 0; a < 4; ++a) {
            const f32x16& p = kh ? p1 : p0; float e0 = p[4 * a] + p[4 * a + 1], e1 = p[4 * a + 2] + p[4 * a + 3];
            e0 += swz_xorf<8>(e0); e0 += swz_xorf<16>(e0); e1 += swz_xorf<8>(e1); e1 += swz_xorf<16>(e1);
            const int jc = 32 * T + 16 * kh + 4 * a, j0 = jc + 2 * hi;
            if (g == 0) { u32x2 w; w.x = imp_key(e0, j0, c); w.y = imp_key(e1, j0 + 1, c); *(LAS u32x2*)(impq + 2 * hi + jc) = w; }
        }
}
__device__ __forceinline__ unsigned long long select_mask(const LAS unsigned* impq, int g, int hi, int nq4 = 16) {
    LDS_WAIT();
    unsigned mk[8], cnt[8];
#pragma unroll
    for (int a = 0; a < 4; ++a) { const u32x2 w = *(const LAS u32x2*)(impq + (16 * g + 2 * hi) + 4 * a); mk[2 * a] = w.x; mk[2 * a + 1] = w.y; cnt[2 * a] = 0; cnt[2 * a + 1] = 0; }
#pragma unroll 4
    for (int jj = 0; jj < nq4; ++jj) { const u32x4 kx = *(const LAS u32x4*)(impq + 4 * jj);
#pragma unroll
        for (int ci = 0; ci < 8; ++ci) cnt[ci] += (unsigned)(kx.x > mk[ci]) + (unsigned)(kx.y > mk[ci]) + (unsigned)(kx.z > mk[ci]) + (unsigned)(kx.w > mk[ci]); }
    unsigned lb = 0u;
#pragma unroll
    for (int a = 0; a < 4; ++a)
#pragma unroll
        for (int e = 0; e < 2; ++e) lb |= (cnt[2 * a + e] < 16u ? 1u : 0u) << (4 * a + e);
    const unsigned long long mm = (unsigned long long)lb << (16 * g + 2 * hi);
    unsigned lo = (unsigned)mm, hh = (unsigned)(mm >> 32);
    lo |= swz_xor<8>(lo); hh |= swz_xor<8>(hh); lo |= swz_xor<16>(lo); hh |= swz_xor<16>(hh); lo = x32_or(lo); hh = x32_or(hh);
    return ((unsigned long long)hh << 32) | lo;
}
__device__ __forceinline__ unsigned long long wave_or64(unsigned long long m) {
    unsigned lo = (unsigned)m, hh = (unsigned)(m >> 32);
    lo |= swz_xor<1>(lo); hh |= swz_xor<1>(hh); lo |= swz_xor<2>(lo); hh |= swz_xor<2>(hh); lo |= swz_xor<4>(lo); hh |= swz_xor<4>(hh);
    lo |= swz_xor<8>(lo); hh |= swz_xor<8>(hh); lo |= swz_xor<16>(lo); hh |= swz_xor<16>(hh); lo = x32_or(lo); hh = x32_or(hh);
    return ((unsigned long long)(unsigned)__builtin_amdgcn_readfirstlane(hh) << 32) | (unsigned)__builtin_amdgcn_readfirstlane(lo);
}
__device__ __forceinline__ void mask_bias(f32x16& p0, f32x16& p1, int t, int pos0, int stride, int wlim, bool sel, bool near, const LAS float* lut, int hi) {
#pragma unroll
    for (int kh = 0; kh < 2; ++kh)
#pragma unroll
        for (int r = 0; r < 16; ++r) { const int kk = 32 * kh + crow(r, hi), dist = t - pos0 - stride * kk; const bool ok = sel && dist >= 0 && dist < wlim;
            float bv = 0.f; if (near) { const int di = dist < 0 ? 0 : (dist > 127 ? 127 : dist); bv = lut[di]; }
            if (kh) p1[r] = ok ? p1[r] + bv : -INFINITY; else p0[r] = ok ? p0[r] + bv : -INFINITY; }
}
template <bool CAUSAL>
__device__ __forceinline__ void mask_bias_near(f32x16& p0, f32x16& p1, int t, int pos0, bool sel, const LAS float* xlg, int hi) {
    const int dist0 = t - pos0 - 4 * hi;
    const LAS float* bp = xlg + (dist0 + 4);
#pragma unroll
    for (int kh = 0; kh < 2; ++kh)
#pragma unroll
        for (int r = 0; r < 16; ++r) { const int kc = 32 * kh + CROW0(r); const float bv = bp[63 - kc]; bool ok = sel; if (CAUSAL) ok = ok && (dist0 - kc >= 0);
            if (kh) p1[r] = ok ? p1[r] + bv : -INFINITY; else p0[r] = ok ? p0[r] + bv : -INFINITY; }
}
struct Ptrs { const bf16_t *Q, *kcp, *vcp, *kcs, *vcs, *KS, *VS, *KW, *VW; const float* gates; bf16_t* O; const float *ck_sel, *cv_sel, *st_kw, *st_vw; const int* pt; int gov; float* kw_out; float* vw_out; };
#ifdef VERIFY
#define GATEV(P, row, head, br) ((P).gov < 0 ? sigmoidf_((P).gates[(size_t)(row) * 48 + (head) * 3 + (br)]) : ((P).gov == (br) ? 1.0f : 0.0f))
#else
#define GATEV(P, row, head, br) sigmoidf_((P).gates[(size_t)(row) * 48 + (head) * 3 + (br)])
#endif

template <bool ACC>
__device__ __forceinline__ void row_out(LAS float* ow, const f32x16 (&o)[2], float f, LAS float* wsf, int r32, int hi) {
    if (hi == 0) wsf[r32] = f;
    LDS_WAIT();
    const LAS float* wh = wsf + 4 * hi; LAS float* ob = ow + hi * 256 + r32;
#pragma unroll
    for (int r = 0; r < 16; ++r) { const float fr = wh[CROW0(r)]; LAS float* p = ob + CROW0(r) * 64;
        if (ACC) { p[0] += fr * o[0][r]; p[32] += fr * o[1][r]; } else { p[0] = fr * o[0][r]; p[32] = fr * o[1][r]; } }
    LDS_WAIT();
}
template <bool NEXT>
__device__ __forceinline__ void tile_block(f32x16& s0, f32x16& s1, f32x16& n0, f32x16& n1, const LAS unsigned char* KBn, float ninit, const LAS unsigned char* VB, const bf16x8 (&qr)[4],
                                           float m, float& l, f32x16 (&o)[2], int lane, int r32, int hi) {
    if (NEXT) qk_tile(n0, n1, KBn, qr, ninit, r32, hi);
    float sacc = 0.f;
#pragma unroll
    for (int r = 0; r < 16; ++r) { s0[r] = ex2(s0[r] - m); s1[r] = ex2(s1[r] - m); sacc += s0[r] + s1[r]; }
    l += sacc;
    pv_tile(o, VB, s0, s1, lane);
}
#define AS_SBAR() __builtin_amdgcn_sched_barrier(0)
#define AS_PIN(x) asm volatile("" : "+v"(x))
#define AS_MFMA(a, b, c) __builtin_amdgcn_mfma_f32_32x32x16_bf16(a, b, c, 0, 0, 0)
#define AS_WAIT_BAR(N) asm volatile("s_waitcnt vmcnt(" #N ") lgkmcnt(0)\n\ts_barrier" ::: "memory")
#define AS_MX3(a, b, c) __builtin_fmaxf(__builtin_fmaxf((a), (b)), (c))
__device__ __forceinline__ void as_glds16(const void* gsrc, unsigned lds_base) {
    unsigned sv; asm volatile("s_mov_b32 %0, m0\n\ts_mov_b32 m0, %2\n\ts_nop 0\n\tglobal_load_lds_dwordx4 %1, off\n\ts_mov_b32 m0, %0" : "=&s"(sv) : "v"(gsrc), "s"(lds_base) : "memory"); }
__device__ __forceinline__ void as_kload2(bf16x8* kf, const LAS unsigned char* kp, int d0) { kf[2 * d0] = *(const LAS bf16x8*)(kp + d0 * 2048); kf[2 * d0 + 1] = *(const LAS bf16x8*)(kp + d0 * 2048 + 512); }
__device__ __forceinline__ float as_rowmax(const f32x16& p0, const f32x16& p1) {
    float a = AS_MX3(p0[0], p0[1], p1[0]), b = AS_MX3(p0[2], p0[3], p1[1]); a = AS_MX3(a, p1[2], p1[3]);
#pragma unroll
    for (int r = 4; r < 16; r += 4) { a = AS_MX3(a, p0[r], p0[r + 1]); b = AS_MX3(b, p0[r + 2], p0[r + 3]); a = AS_MX3(a, p1[r], p1[r + 1]); b = AS_MX3(b, p1[r + 2], p1[r + 3]); }
    return x32_max(__builtin_fmaxf(a, b)); }
__device__ __forceinline__ float as_mask(f32x16& c0, f32x16& c1, int u, int nsel, int nwin, int c, int t, unsigned long long mymask, float bfar, const LAS float* xlg, const LAS float* lut, int hi) {
    if (u >= nsel + nwin) {
#pragma unroll
        for (int r = 0; r < 16; ++r) { c0[r] = -INFINITY; c1[r] = -INFINITY; }
        return 0.f; }
    const bool win = u >= nsel; const int j = win ? c - nwin + 1 + (u - nsel) : u;
    const bool sel = win || ((mymask >> j) & 1ull);
    if (j >= c - 2) { if (j == c) mask_bias_near<true>(c0, c1, t, 64 * j, sel, xlg, hi); else mask_bias_near<false>(c0, c1, t, 64 * j, sel, xlg, hi); return 0.f; }
    if (win) { if (j == c - 8) mask_bias(c0, c1, t, 64 * j, 1, 512, true, false, lut, hi); }
    else {
#pragma unroll
        for (int r = 0; r < 16; ++r) { c0[r] = sel ? c0[r] : -INFINITY; c1[r] = sel ? c1[r] : -INFINITY; } }
    return bfar;
}
__device__ __forceinline__ void attn_stream(const bf16_t* ksb, const bf16_t* vsb, const bf16_t* kwb, const bf16_t* vwb  , int nsel, int nwin, int NT, int c, int t,
                                            unsigned long long mymask, const bf16x8 (&qr)[4], float bfar, const LAS float* xlg, const LAS float* lut, float gate1, float gate2,
                                            LAS unsigned char* L, LAS float* wsf, LAS float* ow, int wave, int lane) {
    constexpr int SLOTB = 8192, LDS_K = 0, LDS_V = 3 * SLOTB;
    const int r32 = lane & 31, hi = lane >> 5;
    const unsigned lds0 = (unsigned)(unsigned long long)L;
    const int nreal = nsel + nwin;
    const unsigned klo = (unsigned)lane * 256 + wave * 8, vlo_ = (unsigned)(16 * (wave & 3) + (lane >> 2)) * 256 + (wave >> 2) * 32 + (lane & 3) * 8;
    const unsigned kdst = lds0 + LDS_K + wave * 1024, vdst = lds0 + LDS_V + wave * 1024;
#define AS_UT(u) ((u) < nreal ? (u) : nreal - 1)
#define AS_JB(u) (AS_UT(u) < nsel ? AS_UT(u) : c - nwin + 1 + (AS_UT(u) - nsel))
#define AS_DMA_K(u, slot) as_glds16((AS_UT(u) < nsel ? ksb : kwb) + klo + (size_t)AS_JB(u) * (64 * 256), (unsigned)__builtin_amdgcn_readfirstlane((int)(kdst + (slot))))
#define AS_DMA_V(u, slot) as_glds16((AS_UT(u) < nsel ? vsb : vwb) + vlo_ + (size_t)AS_JB(u) * (64 * 256), (unsigned)__builtin_amdgcn_readfirstlane((int)(vdst + (slot))))
    const LAS unsigned char* vp0 = L + LDS_V + ((lane >> 4) & 1) * 32 + (lane & 3) * 8 + (4 * hi + ((lane & 15) >> 2)) * 64;
    const LAS unsigned char* kp0 = L + LDS_K + hi * 1024 + r32 * 16;
    AS_DMA_K(0, 0); AS_DMA_V(0, 0); AS_DMA_K(1, SLOTB); AS_DMA_K(2, 2 * SLOTB);
    float mhat = 0.f, l_reg = 0.f, l_sel = 0.f; f32x16 o[2];
#pragma unroll
    for (int r = 0; r < 16; ++r) { o[0][r] = 0.f; o[1][r] = 0.f; }
    const f32x16 zero16 = {0.f, 0.f, 0.f, 0.f, 0.f, 0.f, 0.f, 0.f, 0.f, 0.f, 0.f, 0.f, 0.f, 0.f, 0.f, 0.f};
    bool resc = false, bnd = false;
    f32x16 pA0, pA1, pB0, pB1; bf16x8 kf[8]; s16x4 vlo[8], vhi[8]; u32x4 pw0, pw1, pw2, pw3;
    int sl_prev = 0, sl_cur = 0, sl_next = SLOTB;
#define AS_ROT() do { sl_prev = sl_cur; sl_cur = sl_next; sl_next = (sl_next == 2 * SLOTB) ? 0 : sl_next + SLOTB; } while (0)
#define AS_EX(v) __builtin_amdgcn_exp2f((v) + nmh)
#define AS_RESC() do { if (resc) { const LAS float* wh_ = wsf + 4 * hi; _Pragma("unroll") for (int d_ = 0; d_ < 2; ++d_) _Pragma("unroll") for (int r = 0; r < 16; ++r) o[d_][r] *= wh_[CROW0(r)]; } } while (0)
#define AS_BND() do { if (bnd) { const float lt_ = x32_sum(l_sel); row_out<true>(ow, o, lt_ > 0.f ? gate1 / lt_ : 0.f, wsf, r32, hi); _Pragma("unroll") for (int r = 0; r < 16; ++r) { o[0][r] = 0.f; o[1][r] = 0.f; } bnd = false; } } while (0)
    AS_WAIT_BAR(3);
#pragma unroll
    for (int d0 = 0; d0 < 4; ++d0) as_kload2(kf, kp0, d0);
    pA0 = AS_MFMA(kf[0], qr[0], zero16); pA1 = AS_MFMA(kf[1], qr[0], zero16); pA0 = AS_MFMA(kf[2], qr[1], pA0); pA1 = AS_MFMA(kf[3], qr[1], pA1);
    pA0 = AS_MFMA(kf[4], qr[2], pA0); pA1 = AS_MFMA(kf[5], qr[2], pA1); pA0 = AS_MFMA(kf[6], qr[3], pA0); pA1 = AS_MFMA(kf[7], qr[3], pA1);
    { const float bc = as_mask(pA0, pA1, 0, nsel, nwin, c, t, mymask, bfar, xlg, lut, hi);
      const float rm = as_rowmax(pA0, pA1) + bc; mhat = __builtin_fmaxf(rm, -60.f); const float nmh = bc - mhat;
#pragma unroll
      for (int r = 0; r < 16; ++r) { pA0[r] = AS_EX(pA0[r]); pA1[r] = AS_EX(pA1[r]); } }
    AS_WAIT_BAR(0);
    AS_DMA_K(3, 0); AS_DMA_V(1, SLOTB); AS_ROT();
#pragma unroll
    for (int d0 = 0; d0 < 4; ++d0) as_kload2(kf, kp0 + sl_cur, d0);
    AS_WAIT_BAR(2);
#define AS_PKW(P, i) cvtpk(P[i], P[i + 1])
#define AS_PAF(k) __builtin_bit_cast(bf16x8, pw##k)
#define AS_VFR(i) (bf16x8){vlo[i][0], vlo[i][1], vlo[i][2], vlo[i][3], vhi[i][0], vhi[i][1], vhi[i][2], vhi[i][3]}
#define AS_VRD(i) do { vlo[i] = vtr(vp_ + (((i) >> 2) * 4096 + ((i) & 3) * 1024)); vhi[i] = vtr(vp_ + (((i) >> 2) * 4096 + ((i) & 3) * 1024 + 512)); } while (0)
#define AS_KRD(G, d0) do { if (G) { as_kload2(kf, kp0 + sl_next, d0); AS_SBAR(); } } while (0)
#define AS_GAPA(MF, a0, a1, a2, a3, W0, W1, PW) do { MF; sacc += a0; sacc += a1; sacc += a2; sacc += a3; W0; W1; AS_PIN(PW); AS_PIN(sacc); AS_SBAR(); } while (0)
#define AS_GAPB(MF, X, i) do { MF; X[i] = AS_EX(X[i]); X[i + 1] = AS_EX(X[i + 1]); X[i + 2] = AS_EX(X[i + 2]); X[i + 3] = AS_EX(X[i + 3]); AS_PIN(X); AS_SBAR(); } while (0)
#define AS_STEP(C0, C1, P0, P1, tt, MASK, GK, GV, GL) do { AS_SBAR(); \
    const LAS unsigned char* vp_ = vp0 + sl_prev; \
    AS_VRD(0); AS_SBAR(); float sacc = P0[0] + P0[1]; \
                    AS_GAPA(C0 = AS_MFMA(kf[0], qr[0], zero16), P0[2], P0[3], P0[4], P0[5],     pw0[0] = AS_PKW(P0, 0),  pw0[1] = AS_PKW(P0, 2),  pw0); \
    AS_VRD(4); AS_SBAR(); AS_GAPA(C1 = AS_MFMA(kf[1], qr[0], zero16), P0[6], P0[7], P0[8], P0[9],     pw0[2] = AS_PKW(P0, 4),  pw0[3] = AS_PKW(P0, 6),  pw0); \
    AS_VRD(1); AS_SBAR(); AS_GAPA(C0 = AS_MFMA(kf[2], qr[1], C0),    P0[10], P0[11], P0[12], P0[13], pw1[0] = AS_PKW(P0, 8),  pw1[1] = AS_PKW(P0, 10), pw1); \
    AS_VRD(5); AS_SBAR(); AS_GAPA(C1 = AS_MFMA(kf[3], qr[1], C1),    P0[14], P0[15], P1[0], P1[1],   pw1[2] = AS_PKW(P0, 12), pw1[3] = AS_PKW(P0, 14), pw1); \
    AS_VRD(2); AS_SBAR(); AS_GAPA(C0 = AS_MFMA(kf[4], qr[2], C0),    P1[2], P1[3], P1[4], P1[5],     pw2[0] = AS_PKW(P1, 0),  pw2[1] = AS_PKW(P1, 2),  pw2); \
    AS_VRD(6); AS_SBAR(); AS_GAPA(C1 = AS_MFMA(kf[5], qr[2], C1),    P1[6], P1[7], P1[8], P1[9],     pw2[2] = AS_PKW(P1, 4),  pw2[3] = AS_PKW(P1, 6),  pw2); \
    AS_VRD(3); AS_SBAR(); AS_GAPA(C0 = AS_MFMA(kf[6], qr[3], C0),    P1[10], P1[11], P1[12], P1[13], pw3[0] = AS_PKW(P1, 8),  pw3[1] = AS_PKW(P1, 10), pw3); \
    AS_VRD(7); AS_SBAR(); AS_GAPA(C1 = AS_MFMA(kf[7], qr[3], C1),    P1[14], P1[15], 0.f, 0.f,       pw3[2] = AS_PKW(P1, 12), pw3[3] = AS_PKW(P1, 14), pw3); \
    l_reg += sacc; \
    if (GK) AS_DMA_K((tt) + 3, sl_cur); if (GV) AS_DMA_V((tt) + 1, sl_next); \
    float bc_ = bfar; bool sel_ = true; \
    if (MASK) bc_ = as_mask(C0, C1, (tt), nsel, nwin, c, t, mymask, bfar, xlg, lut, hi); \
    else sel_ = (mymask >> (tt)) & 1ull;                             \
    if (MASK && (tt) == nsel) { l_sel = l_reg; l_reg = 0.f; mhat = __builtin_fmaxf(as_rowmax(C0, C1) + bc_, -60.f); resc = false; bnd = true; }     \
    else { const float rm = as_rowmax(C0, C1) + bc_ - mhat; resc = false; \
      if (__builtin_expect(__any(rm > 8.0f), 0)) { const float dl = __builtin_fmaxf(rm, 0.f); mhat += dl; \
          const float f = __builtin_amdgcn_exp2f(-dl); l_reg *= f; if (hi == 0) wsf[r32] = f; resc = true; } } \
    const float nmh = sel_ ? bc_ - mhat : -INFINITY; AS_SBAR(); \
    AS_GAPB(o[0] = AS_MFMA(AS_PAF(0), AS_VFR(0), o[0]), C0, 0);              AS_GAPB(o[1] = AS_MFMA(AS_PAF(0), AS_VFR(4), o[1]), C0, 4); \
    AS_KRD(GL, 0); AS_GAPB(o[0] = AS_MFMA(AS_PAF(1), AS_VFR(1), o[0]), C0, 8);  AS_KRD(GL, 1); AS_GAPB(o[1] = AS_MFMA(AS_PAF(1), AS_VFR(5), o[1]), C0, 12); \
    AS_KRD(GL, 2); AS_GAPB(o[0] = AS_MFMA(AS_PAF(2), AS_VFR(2), o[0]), C1, 0);  AS_KRD(GL, 3); AS_GAPB(o[1] = AS_MFMA(AS_PAF(2), AS_VFR(6), o[1]), C1, 4); \
    AS_GAPB(o[0] = AS_MFMA(AS_PAF(3), AS_VFR(3), o[0]), C1, 8);              AS_GAPB(o[1] = AS_MFMA(AS_PAF(3), AS_VFR(7), o[1]), C1, 12); \
    } while (0)
    int tt = 1;
    for (; tt + 1 < nsel - 3; tt += 2) {
        AS_STEP(pB0, pB1, pA0, pA1, tt, false, true, true, true);     AS_WAIT_BAR(2); AS_RESC(); AS_ROT();
        AS_STEP(pA0, pA1, pB0, pB1, tt + 1, false, true, true, true); AS_WAIT_BAR(2); AS_RESC(); AS_ROT();
    }
#define AS_ENDW(x) do { if ((x) + 3 < NT) { AS_WAIT_BAR(2); } else if ((x) + 2 < NT) { AS_WAIT_BAR(1); } else { AS_WAIT_BAR(0); } } while (0)
    for (; tt + 1 < NT; tt += 2) {
        AS_STEP(pB0, pB1, pA0, pA1, tt, true, (tt + 3 < NT), (tt + 1 < NT), (tt + 1 < NT));         AS_ENDW(tt);     AS_RESC(); AS_BND(); AS_ROT();
        AS_STEP(pA0, pA1, pB0, pB1, tt + 1, true, (tt + 4 < NT), (tt + 2 < NT), (tt + 2 < NT));     AS_ENDW(tt + 1); AS_RESC(); AS_BND(); AS_ROT();
    }
    AS_STEP(pB0, pB1, pA0, pA1, NT - 1, true, false, false, false); AS_RESC(); AS_BND();
    { float sacc = pB0[0] + pB0[1];
#pragma unroll
      for (int r = 2; r < 16; ++r) sacc += pB0[r];
#pragma unroll
      for (int r = 0; r < 16; ++r) sacc += pB1[r];
      l_reg += sacc;
      pw0 = (u32x4){AS_PKW(pB0, 0), AS_PKW(pB0, 2), AS_PKW(pB0, 4), AS_PKW(pB0, 6)}; pw1 = (u32x4){AS_PKW(pB0, 8), AS_PKW(pB0, 10), AS_PKW(pB0, 12), AS_PKW(pB0, 14)};
      pw2 = (u32x4){AS_PKW(pB1, 0), AS_PKW(pB1, 2), AS_PKW(pB1, 4), AS_PKW(pB1, 6)}; pw3 = (u32x4){AS_PKW(pB1, 8), AS_PKW(pB1, 10), AS_PKW(pB1, 12), AS_PKW(pB1, 14)};
      const LAS unsigned char* vp_ = vp0 + sl_cur;
#pragma unroll
      for (int i = 0; i < 8; ++i) AS_VRD(i);
      o[0] = AS_MFMA(AS_PAF(0), AS_VFR(0), o[0]); o[1] = AS_MFMA(AS_PAF(0), AS_VFR(4), o[1]); o[0] = AS_MFMA(AS_PAF(1), AS_VFR(1), o[0]); o[1] = AS_MFMA(AS_PAF(1), AS_VFR(5), o[1]);
      o[0] = AS_MFMA(AS_PAF(2), AS_VFR(2), o[0]); o[1] = AS_MFMA(AS_PAF(2), AS_VFR(6), o[1]); o[0] = AS_MFMA(AS_PAF(3), AS_VFR(3), o[0]); o[1] = AS_MFMA(AS_PAF(3), AS_VFR(7), o[1]); }
    { const float lt = x32_sum(l_reg); const float f = lt > 0.f ? gate2 / lt : 0.f; row_out<true>(ow, o, f, wsf, r32, hi); }
    asm volatile("s_waitcnt lgkmcnt(0)\n\ts_barrier" ::: "memory");
#undef AS_UT
#undef AS_JB
#undef AS_DMA_K
#undef AS_DMA_V
#undef AS_ROT
#undef AS_EX
#undef AS_RESC
#undef AS_BND
#undef AS_PKW
#undef AS_PAF
#undef AS_VFR
#undef AS_VRD
#undef AS_KRD
#undef AS_GAPA
#undef AS_GAPB
#undef AS_STEP
#undef AS_ENDW
}

__device__ __forceinline__ void prompt_unit(const Ptrs& P, LAS unsigned char* L, int b, int kv, int c, int tid, int wave, int lane) {
    asm volatile("" : "+v"(lane), "+v"(tid));
    const int r32 = lane & 31, hi = lane >> 5, g = r32 >> 3, qi = r32 & 7, head = kv * 4 + g;
    const int t = c * 64 + wave * 8 + qi; const unsigned row = (unsigned)b * SEQ + t;
    bf16x8 qr[4];
#pragma unroll
    for (int ds = 0; ds < 4; ++ds) qr[ds] = *(const bf16x8*)(P.Q + (size_t)row * D + head * 64 + ds * 16 + hi * 8);
    const LAS float* lut = (const LAS float*)(L + LUT_OFF) + head * 128; const float bfar = lut[127];
    LAS float* wsf = (LAS float*)(L + WSF_OFF) + wave * 32;
    LAS float* ow = (LAS float*)(L + 65536 + wave * 8192);
    LAS unsigned* impq = (LAS unsigned*)(L + IMP_OFF) + wave * 512 + qi * 64;
    const int skey = tid >> 3, sch = tid & 7;
    const int kwoff = skey * 128 + ((sch ^ ((skey >> 1) & 7)) << 4), vwoff = (sch >> 2) * 4096 + skey * 64 + (sch & 3) * 16;
    LAS unsigned char* KB0 = L; LAS unsigned char* VB0 = L + 32768;
    { const unsigned co = ((unsigned)(b * 4 + kv) * 128 + skey) * 64 + sch * 8;
      const u32x4 k0 = *(const u32x4*)(P.kcp + co), k1 = *(const u32x4*)(P.kcp + co + 4096), v0 = *(const u32x4*)(P.vcp + co), v1 = *(const u32x4*)(P.vcp + co + 4096);
      *(LAS u32x4*)(KB0 + kwoff) = k0; *(LAS u32x4*)(KB0 + 8192 + kwoff) = k1; *(LAS u32x4*)(VB0 + vwoff) = v0; *(LAS u32x4*)(VB0 + 8192 + vwoff) = v1; }
    const int nwin = (c < 8 ? c : 8) + 1;
    __syncthreads();
    f32x16 o[2];
#pragma unroll
    for (int r = 0; r < 16; ++r) { o[0][r] = 0.f; o[1][r] = 0.f; }
    unsigned long long mymask = ~0ull;
    if (c <= 30) {
        f32x16 a0, a1; qk_tile(a0, a1, KB0, qr, 0.f, r32, hi); mask_bias(a0, a1, t, 31, 32, 1 << 30, true, true, lut, hi);
        float rm = fmaxf(a0[0], a1[0]);
#pragma unroll
        for (int r = 1; r < 16; ++r) rm = fmaxf(rm, fmaxf(a0[r], a1[r]));
        rm = fmaxf(x32_max(rm), -1e30f); float sacc = 0.f;
#pragma unroll
        for (int r = 0; r < 16; ++r) { a0[r] = ex2(a0[r] - rm); a1[r] = ex2(a1[r] - rm); sacc += a0[r] + a1[r]; }
        sacc = x32_sum(sacc); const float cinv = sacc > 0.f ? 1.0f / sacc : 0.f;
#pragma unroll
        for (int r = 0; r < 16; ++r) { a0[r] *= cinv; a1[r] *= cinv; }
        if (c >= 16) { imp_store(a0, a1, 0, impq, c, g, hi);
            if (g == 0) {
#pragma unroll
                for (int q8 = 0; q8 < 8; ++q8) { const int jc = 32 + 4 * q8; u32x2 w; w.x = imp_key(0.f, jc + 2 * hi, c); w.y = imp_key(0.f, jc + 2 * hi + 1, c); *(LAS u32x2*)(impq + 2 * hi + jc) = w; } } }
        pv_tile(o, VB0, a0, a1, lane);
    } else {
        f32x16 a0, a1, b0, b1;
        qk_tile(a0, a1, KB0, qr, 0.f, r32, hi); mask_bias(a0, a1, t, 31, 32, 1 << 30, true, true, lut, hi);
        qk_tile(b0, b1, KB0 + 8192, qr, 0.f, r32, hi); mask_bias(b0, b1, t, 31 + 2048, 32, 1 << 30, true, true, lut, hi);
        float rm = fmaxf(fmaxf(a0[0], a1[0]), fmaxf(b0[0], b1[0]));
#pragma unroll
        for (int r = 1; r < 16; ++r) rm = fmaxf(rm, fmaxf(fmaxf(a0[r], a1[r]), fmaxf(b0[r], b1[r])));
        rm = fmaxf(x32_max(rm), -1e30f); float sacc = 0.f;
#pragma unroll
        for (int r = 0; r < 16; ++r) { a0[r] = ex2(a0[r] - rm); a1[r] = ex2(a1[r] - rm); b0[r] = ex2(b0[r] - rm); b1[r] = ex2(b1[r] - rm); sacc += (a0[r] + a1[r]) + (b0[r] + b1[r]); }
        sacc = x32_sum(sacc); const float cinv = sacc > 0.f ? 1.0f / sacc : 0.f;
#pragma unroll
        for (int r = 0; r < 16; ++r) { a0[r] *= cinv; a1[r] *= cinv; b0[r] *= cinv; b1[r] *= cinv; }
        imp_store(a0, a1, 0, impq, c, g, hi); imp_store(b0, b1, 1, impq, c, g, hi);
        pv_tile(o, VB0, a0, a1, lane); pv_tile(o, VB0 + 8192, b0, b1, lane);
    }
    { const float g0 = GATEV(P, row, head, 0); row_out<false>(ow, o, g0, wsf, r32, hi); }
    if (c >= 16) mymask = select_mask(impq, g, hi, (c + 4) >> 2);
    __syncthreads();
    { LAS float* xl = (LAS float*)(L + IMP_OFF);
      for (int u = tid; u < 4 * 272; u += 512) { const int gg = u / 272, ii = u % 272, dd = ii - 67; xl[u] = ((const LAS float*)(L + LUT_OFF))[(kv * 4 + gg) * 128 + (dd < 0 ? 0 : (dd > 127 ? 127 : dd))]; } }
    const LAS float* xlg = (const LAS float*)(L + IMP_OFF) + g * 272;
    { const size_t kvb = ((size_t)b * SEQ) * 256 + kv * 64; const int nsel = c + 1; int NT = (nsel + nwin + 1) & ~1; if (NT < 4) NT = 4;
      attn_stream(P.KS + kvb, P.VS + kvb, P.KW + kvb, P.VW + kvb, nsel, nwin, NT, c, t, mymask, qr, bfar, xlg, lut, GATEV(P, row, head, 1), GATEV(P, row, head, 2), L, wsf, ow, wave, lane); }
    { const int rr = lane >> 1, hf = lane & 1, gg = rr >> 3, qq = rr & 7; const LAS float* src = ow + rr * 64 + hf * 32;
      bf16_t* op = P.O + ((size_t)b * SEQ + c * 64 + wave * 8 + qq) * D + (kv * 4 + gg) * 64 + hf * 32;
#pragma unroll
      for (int q4 = 0; q4 < 4; ++q4) { const f32x4 x0 = *(const LAS f32x4*)(src + q4 * 8), x1 = *(const LAS f32x4*)(src + q4 * 8 + 4); u32x4 w;
          w.x = cvtpk(x0[0], x0[1]); w.y = cvtpk(x0[2], x0[3]); w.z = cvtpk(x1[0], x1[1]); w.w = cvtpk(x1[2], x1[3]); *(u32x4*)(op + q4 * 8) = w; } }
    __syncthreads();
}

template <bool COPY>
__device__ __forceinline__ void stage_f32_pair(const float* ksrc_, const float* vsrc_, LAS unsigned char* Kb, LAS unsigned char* Vb, int lane, float* kdst_ = nullptr, float* vdst_ = nullptr, int first_row = 0) {
    const int c4 = lane & 15; const char* ks = uniform_ptr(ksrc_); const char* vs = uniform_ptr(vsrc_); const unsigned lo = (unsigned)((lane >> 4) * 1024 + c4 * 16);
    f32x4 x[16], y[16];
#pragma unroll
    for (int it = 0; it < 16; ++it) x[it] = *(const f32x4*)((ks + it * 4096) + lo);
#pragma unroll
    for (int it = 0; it < 16; ++it) y[it] = *(const f32x4*)((vs + it * 4096) + lo);
    if constexpr (COPY) {
        char* kd = (char*)uniform_ptr(kdst_); char* vd = (char*)uniform_ptr(vdst_);
#pragma unroll
        for (int it = 0; it < 16; ++it) { const int key = it * 4 + (lane >> 4);
            if (key >= first_row) __builtin_nontemporal_store(x[it], (f32x4*)((kd + it * 4096) + lo)); }
    }
#pragma unroll
    for (int it = 0; it < 16; ++it) { const int key = it * 4 + (lane >> 4);
        u32x2 w; w.x = cvtpk(x[it][0], x[it][1]); w.y = cvtpk(x[it][2], x[it][3]);
        *(LAS u32x2*)(Kb + key * 128 + (((c4 >> 1) ^ ((key >> 1) & 7)) << 4) + (c4 & 1) * 8) = w; }
    if constexpr (COPY) { char* vd = (char*)uniform_ptr(vdst_);
#pragma unroll
        for (int it = 0; it < 16; ++it) { const int key = it * 4 + (lane >> 4);
            if (key >= first_row) __builtin_nontemporal_store(y[it], (f32x4*)((vd + it * 4096) + lo)); }
    }
#pragma unroll
    for (int it = 0; it < 16; ++it) { const int key = it * 4 + (lane >> 4);
        u32x2 w; w.x = cvtpk(y[it][0], y[it][1]); w.y = cvtpk(y[it][2], y[it][3]);
        *(LAS u32x2*)(Vb + (c4 >> 3) * 4096 + key * 64 + (c4 & 7) * 8) = w; }
    __builtin_amdgcn_sched_barrier(0);
}
__device__ __forceinline__ void stage_bf16_tile(const bf16_t* src_  , LAS unsigned char* Kb, bool isV, int lane) {
    const char* src = uniform_ptr(src_);
#pragma unroll
    for (int it = 0; it < 8; ++it) { const int idx = it * 64 + lane, key = idx >> 3, ch = idx & 7; const u32x4 x = *(const u32x4*)(src + (unsigned)idx * 16u);
        const int off = isV ? ((ch >> 2) * 4096 + key * 64 + (ch & 3) * 16) : (key * 128 + ((ch ^ ((key >> 1) & 7)) << 4));
        *(LAS u32x4*)(Kb + off) = x; }
}
__device__ __forceinline__ void stage_new_tile(const bf16_t* src_  , LAS unsigned char* Kb, bool isV, int lane) {
    const char* src = uniform_ptr(src_);
#pragma unroll
    for (int it = 0; it < 8; ++it) *(LAS u32x4*)(Kb + (it * 64 + lane) * 16) = (u32x4){0u, 0u, 0u, 0u};
    if (lane < 32) { const int key = lane >> 3, ch = lane & 7; const u32x4 x = *(const u32x4*)(src + (unsigned)(key * 512 + ch * 16));
        const int off = isV ? ((ch >> 2) * 4096 + key * 64 + (ch & 3) * 16) : (key * 128 + ((ch ^ ((key >> 1) & 7)) << 4));
        *(LAS u32x4*)(Kb + off) = x; }
}
__device__ __forceinline__ void sample_unit(const Ptrs& P, LAS unsigned char* L, int uA, int uB, int tid, int wave, int lane) {
    asm volatile("" : "+v"(lane), "+v"(tid));
    const int half = wave >> 2, lw = wave & 3, usel = half ? uB : uA, b = usel >> 2, kv = usel & 3;
    const int r32 = lane & 31, hi = lane >> 5, g = r32 >> 3, qi = r32 & 7, qs = qi & 3, head = kv * 4 + g;
    const int t = PAST + qs; const unsigned row = (unsigned)MP + b * 4 + qs;
    bf16x8 qr[4];
#pragma unroll
    for (int ds = 0; ds < 4; ++ds) qr[ds] = *(const bf16x8*)(P.Q + (size_t)row * D + head * 64 + ds * 16 + hi * 8);
    const LAS float* lut = (const LAS float*)(L + LUT_OFF) + head * 128; const float bfar = lut[127];
    LAS float* wsf = (LAS float*)(L + WSF_OFF) + wave * 32;
    LAS unsigned* impq = (LAS unsigned*)(L + IMP_OFF) + wave * 512 + qi * 64;
    LAS unsigned char* Kb = L + wave * 16384; LAS unsigned char* Vb = Kb + 8192;
    f32x16 o[2];
#pragma unroll
    for (int r = 0; r < 16; ++r) { o[0][r] = 0.f; o[1][r] = 0.f; }
#define SU_CMP_PROBS(a0, a1, r32, hi, lut) do { qk_tile(a0, a1, Kb, qr, 0.f, r32, hi); mask_bias(a0, a1, t, 31, 32, 1 << 30, true, true, lut, hi); \
        float rm = fmaxf(a0[0], a1[0]); _Pragma("unroll") for (int r = 1; r < 16; ++r) rm = fmaxf(rm, fmaxf(a0[r], a1[r])); \
        rm = x32_max(rm); float sacc = 0.f; \
        _Pragma("unroll") for (int r = 0; r < 16; ++r) { a0[r] = ex2(a0[r] - rm); a1[r] = ex2(a1[r] - rm); sacc += a0[r] + a1[r]; } \
        sacc = x32_sum(sacc); const float cinv = 1.0f / sacc; \
        _Pragma("unroll") for (int r = 0; r < 16; ++r) { a0[r] *= cinv; a1[r] *= cinv; } } while (0)
    stage_bf16_tile(P.kcs + (size_t)(b * 4 + kv) * 4096, Kb, false, lane);
    LDS_WAIT();
    {
        f32x16 a0, a1;
        SU_CMP_PROBS(a0, a1, r32, hi, lut);
        imp_store(a0, a1, 0, impq, 32, g, hi);
        if (g == 0) {
#pragma unroll
            for (int q8 = 0; q8 < 8; ++q8) { const int jc = 32 + 4 * q8; u32x2 w; w.x = imp_key(0.f, jc + 2 * hi, 32); w.y = imp_key(0.f, jc + 2 * hi + 1, 32); *(LAS u32x2*)(impq + 2 * hi + jc) = w; } }
    }
    const unsigned long long mymask = select_mask(impq, g, hi);
    const unsigned long long umask = wave_or64(mymask) & 0x1FFFFFFFFull;
    const bool winw = lw == 3;
    const int nsel = __builtin_popcountll(umask);
    const int nmine = winw ? 9 : nsel, first = winw ? 0 : lw, step = winw ? 1 : 3;
    float m = -1e30f, l = 0.f;
#pragma unroll 1
    for (int idx = first; idx < nmine; idx += step) {
        LDS_WAIT();
        int pos0; bool near, sel = true;
        int ln = lane; asm volatile("" : "+v"(ln));
        if (!winw) {
            unsigned long long mm = umask; for (int n = 0; n < idx; ++n) mm &= mm - 1ull;
            const int j = __builtin_ctzll(mm);
            if (j < 32) { const int page = P.pt[b * 16 + (j >> 1)]; const size_t off = (((size_t)page * 128 + (j & 1) * 64) * 4 + kv) * 64;
                stage_f32_pair<false>(P.ck_sel + off, P.cv_sel + off, Kb, Vb, ln); }
            else { stage_new_tile(P.KS + ((size_t)MP + b * 4) * 256 + kv * 64, Kb, false, ln); stage_new_tile(P.VS + ((size_t)MP + b * 4) * 256 + kv * 64, Vb, true, ln); }
            pos0 = 64 * j; near = j >= 30; sel = (mymask >> j) & 1ull;
        } else {
            if (idx < 8) { const size_t off = (((size_t)b * 512 + 64 * idx) * 4 + kv) * 64;
                stage_f32_pair<true>(P.st_kw + off, P.st_vw + off, Kb, Vb, ln, P.kw_out + off - 1024, P.vw_out + off - 1024, idx == 0 ? 4 : 0); }
            else { stage_new_tile(P.KW + ((size_t)MP + b * 4) * 256 + kv * 64, Kb, false, ln); stage_new_tile(P.VW + ((size_t)MP + b * 4) * 256 + kv * 64, Vb, true, ln); }
            pos0 = PAST - 512 + 64 * idx; near = idx >= 6;
        }
        LDS_WAIT();
        f32x16 p0, p1;
        qk_tile(p0, p1, Kb, qr, near ? 0.f : bfar, r32, hi);
        mask_bias(p0, p1, t, pos0, 1, winw ? 512 : (1 << 30), sel, near, lut, hi);
        softmax_update(p0, p1, m, l, o, wsf, r32, hi);
        pv_tile(o, Vb, p0, p1, lane);
    }
    LDS_WAIT();
    f32x16 o2[2];
#pragma unroll
    for (int r = 0; r < 16; ++r) { o2[0][r] = 0.f; o2[1][r] = 0.f; }
    if (lw == 0) {
        int ln2 = lane; const LAS float* lut2 = lut; asm volatile("" : "+v"(ln2), "+v"(lut2));
        const int r32b = ln2 & 31, hib = ln2 >> 5;
        stage_bf16_tile(P.kcs + (size_t)(b * 4 + kv) * 4096, Kb, false, ln2); stage_bf16_tile(P.vcs + (size_t)(b * 4 + kv) * 4096, Vb, true, ln2);
        LDS_WAIT();
        f32x16 a0, a1;
        SU_CMP_PROBS(a0, a1, r32b, hib, lut2);
        pv_tile(o2, Vb, a0, a1, ln2);
        LDS_WAIT();
    }
#undef SU_CMP_PROBS
    { const float lt = x32_sum(l);
      LAS f32x2* ml = (LAS f32x2*)(L + IMP_OFF);
      if (hi == 0) ml[wave * 256 + r32] = (f32x2){m, lt};
      __syncthreads();
      const int w0 = half * 4 + (winw ? 3 : 0), w1 = half * 4 + (winw ? 4 : 3);
      float M = -1e30f;
      for (int w = w0; w < w1; ++w) M = fmaxf(M, ml[w * 256 + r32][0]);
      float Ls = 0.f;
      for (int w = w0; w < w1; ++w) { const f32x2 x = ml[w * 256 + r32]; Ls += x[1] * ex2(x[0] - M); }
      const float gt = GATEV(P, row, head, (winw ? 2 : 1));
      const float f = Ls > 0.f ? gt * ex2(m - M) / Ls : 0.f;
      row_scale(o, f, wsf, r32, hi);
      if (lw == 0) { const float g0 = GATEV(P, row, head, 0); row_fma(o, o2, g0, wsf, r32, hi); } }
    LAS float* ob = (LAS float*)Kb + hi * 256 + r32;
#pragma unroll
    for (int r = 0; r < 16; ++r) { ob[CROW0(r) * 64] = o[0][r]; ob[CROW0(r) * 64 + 32] = o[1][r]; }
    __syncthreads();
    { const int hs = tid >> 8, vr = (tid >> 4) & 15, d4 = (tid & 15) * 4, gg = vr >> 2, qq = vr & 3, uo = hs ? uB : uA; f32x4 sacc = (f32x4){0.f, 0.f, 0.f, 0.f};
#pragma unroll
      for (int w = 0; w < 4; ++w) sacc = sacc + *(const LAS f32x4*)((const LAS float*)(L + (hs * 4 + w) * 16384) + (gg * 8 + qq) * 64 + d4);
      u32x2 w2; w2.x = cvtpk(sacc[0], sacc[1]); w2.y = cvtpk(sacc[2], sacc[3]);
      *(u32x2*)(P.O + ((size_t)MP + (uo >> 2) * 4 + qq) * D + ((uo & 3) * 4 + gg) * 64 + d4) = w2; }
    __syncthreads();
}

#ifdef VERIFY
__device__ __forceinline__ float wsum(float v) { for (int o = 1; o < 64; o <<= 1) v += __shfl_xor(v, o); return v; }
__device__ __forceinline__ float wmax(float v) { for (int o = 1; o < 64; o <<= 1) v = fmaxf(v, __shfl_xor(v, o)); return v; }
__device__ __forceinline__ float rb(float x) { return bf2f((unsigned short)(cvtpk(x, 0.f) & 0xffffu)); }
__device__ __forceinline__ void verify_item(const Ptrs& P, LAS unsigned char* L, bool sample, int b, int tq, int kv, int br, float* errs, int wave, int lane) {
    LAS float* sc = (LAS float*)(L + wave * 16384);
    LAS float* qs = (LAS float*)(L + IMP_OFF) + wave * 512;
    const LAS float* lutb = (const LAS float*)(L + LUT_OFF);
    const size_t row = sample ? (size_t)MP + b * 4 + tq : (size_t)b * SEQ + tq; const int pos = sample ? PAST + tq : tq; const int cq = pos >> 6;
    for (int g = 0; g < 4; ++g) qs[g * 64 + lane] = bf2f(P.Q[row * D + (kv * 4 + g) * 64 + lane]);
    LDS_WAIT();
    const int ncmp = sample ? 64 : 128; const size_t cmpo = (size_t)(b * 4 + kv) * (sample ? 4096 : 8192); const bf16_t* kc = (const bf16_t*)((const char*)P.kcp + (sample ? WS_KCMPS - WS_KCMPP : 0)) + cmpo; const bf16_t* vc = (const bf16_t*)((const char*)P.vcp + (sample ? WS_VCMPS - WS_VCMPP : 0)) + cmpo;
    float oc0 = 0.f, oc1 = 0.f, oc2 = 0.f, oc3 = 0.f;
    for (int g = 0; g < 4; ++g) {
        float sA = -INFINITY, sB = -INFINITY;
        for (int h = 0; h < 2; ++h) { const int n = lane + 64 * h; const int dist = pos - (32 * n + 31); float s = -INFINITY;
            if (n < ncmp && dist >= 0) { float a = 0.f; for (int d = 0; d < 64; ++d) a += qs[g * 64 + d] * bf2f(kc[(size_t)n * 64 + d]); s = a + lutb[(kv * 4 + g) * 128 + (dist > 127 ? 127 : dist)]; }
            if (h == 0) sA = s; else sB = s; }
        const float mx = wmax(fmaxf(sA, sB)); float p0 = 0.f, p1 = 0.f;
        if (mx > -INFINITY) { p0 = ex2(sA - mx); p1 = ex2(sB - mx); }
        const float sm = wsum(p0 + p1); const float inv = sm > 0.f ? 1.0f / sm : 0.f;
        sc[g * 128 + lane] = p0 * inv; sc[g * 128 + 64 + lane] = p1 * inv;
    }
    LDS_WAIT();
    for (int g = 0; g < 4; ++g) { float a = 0.f; for (int n = 0; n < ncmp; ++n) a += sc[g * 128 + n] * bf2f(vc[(size_t)n * 64 + lane]); if (g == 0) oc0 = a; else if (g == 1) oc1 = a; else if (g == 2) oc2 = a; else oc3 = a; }
    float imp = 0.f; for (int g = 0; g < 4; ++g) imp += sc[g * 128 + 2 * lane] + sc[g * 128 + 2 * lane + 1];
    { const bool forced = (lane == 0) || (lane == cq) || (lane == cq - 1), elig = lane <= cq; imp = forced ? 1e9f : (elig ? imp : -1.0f); }
    LDS_WAIT(); qs[256 + lane] = imp; LDS_WAIT();
    int rank = 0; for (int j = 0; j < 64; ++j) { const float v = qs[256 + j]; rank += (v > imp) || (v == imp && j < lane); }
    const int nsb = sample ? 33 : 64;
    const unsigned long long selm = __ballot(rank < 16 && lane < nsb);
    float r0 = oc0, r1 = oc1, r2_ = oc2, r3 = oc3;
    if (br != 0) {
        const int nslot = br == 1 ? __builtin_popcountll(selm) : 9;
        LDS_WAIT();
        for (int si = 0; si < nslot && si < 16; ++si) {
            int j;
            if (br == 1) { unsigned long long mm = selm; for (int n = 0; n < si; ++n) mm &= mm - 1ull; j = __builtin_ctzll(mm); } else j = sample ? si : cq - 8 + si;
            bool ok = false; int pk = 0; const float* kf = nullptr; const bf16_t* kb = nullptr;
            if (br == 1) { pk = 64 * j + lane;
                if (!sample) { ok = pk <= pos; kb = P.KS + ((size_t)b * SEQ + pk) * 256 + kv * 64; }
                else if (j < 32) { ok = true; kf = P.ck_sel + (((size_t)P.pt[b * 16 + (j >> 1)] * 128 + (j & 1) * 64 + lane) * 4 + kv) * 64; }
                else { ok = lane < 4 && pk <= pos; kb = P.KS + ((size_t)MP + b * 4 + (lane & 3)) * 256 + kv * 64; } }
            else { if (!sample) { pk = 64 * j + lane; ok = j >= 0 && pk <= pos && pos - pk < 512; kb = P.KW + ((size_t)b * SEQ + (ok ? pk : 0)) * 256 + kv * 64; }
                else { const int e = 64 * j + lane; pk = PAST - 512 + e; ok = e < 516 && pk <= pos && pos - pk < 512;
                    if (e < 512) kf = P.st_kw + (((size_t)b * 512 + e) * 4 + kv) * 64; else kb = P.KW + ((size_t)MP + b * 4 + ((e - 512) & 3)) * 256 + kv * 64; } }
            const int dist = pos - pk;
            for (int g = 0; g < 4; ++g) { float s = -INFINITY;
                if (ok) { float a = 0.f; for (int d = 0; d < 64; ++d) a += qs[g * 64 + d] * (kf ? rb(kf[d]) : bf2f(kb[d])); s = a + lutb[(kv * 4 + g) * 128 + (dist > 127 ? 127 : dist)]; }
                sc[g * 1024 + si * 64 + lane] = s; }
        }
        LDS_WAIT();
        for (int g = 0; g < 4; ++g) {
            float mx = -INFINITY; for (int si = 0; si < nslot && si < 16; ++si) mx = fmaxf(mx, sc[g * 1024 + si * 64 + lane]);
            mx = wmax(mx); float sm = 0.f;
            for (int si = 0; si < nslot && si < 16; ++si) { const float p = mx > -INFINITY ? ex2(sc[g * 1024 + si * 64 + lane] - mx) : 0.f; sc[g * 1024 + si * 64 + lane] = p; sm += p; }
            sm = wsum(sm); const float inv = sm > 0.f ? 1.0f / sm : 0.f;
            LDS_WAIT();
            float a = 0.f;
            for (int si = 0; si < nslot && si < 16; ++si) {
                int j;
                if (br == 1) { unsigned long long mm = selm; for (int n = 0; n < si; ++n) mm &= mm - 1ull; j = __builtin_ctzll(mm); } else j = sample ? si : cq - 8 + si;
                for (int k = 0; k < 64; ++k) { const float p = sc[g * 1024 + si * 64 + k]; if (p == 0.f) continue; float v;
                    if (br == 1) { if (!sample) v = bf2f(P.VS[((size_t)b * SEQ + 64 * j + k) * 256 + kv * 64 + lane]);
                        else if (j < 32) v = rb(P.cv_sel[(((size_t)P.pt[b * 16 + (j >> 1)] * 128 + (j & 1) * 64 + k) * 4 + kv) * 64 + lane]);
                        else v = bf2f(P.VS[((size_t)MP + b * 4 + (k & 3)) * 256 + kv * 64 + lane]); }
                    else { if (!sample) v = bf2f(P.VW[((size_t)b * SEQ + 64 * j + k) * 256 + kv * 64 + lane]);
                        else { const int e = 64 * j + k; v = e < 512 ? rb(P.st_vw[(((size_t)b * 512 + e) * 4 + kv) * 64 + lane]) : bf2f(P.VW[((size_t)MP + b * 4 + ((e - 512) & 3)) * 256 + kv * 64 + lane]); } }
                    a += p * v; } }
            a *= inv; if (g == 0) r0 = a; else if (g == 1) r1 = a; else if (g == 2) r2_ = a; else r3 = a;
            LDS_WAIT();
        }
    }
    float d2 = 0.f, rr2 = 0.f;
    for (int g = 0; g < 4; ++g) { const float ref = g == 0 ? r0 : g == 1 ? r1 : g == 2 ? r2_ : r3; const float f = bf2f(P.O[row * D + (kv * 4 + g) * 64 + lane]); const float df = f - ref; d2 += df * df; rr2 += ref * ref; }
    d2 = wsum(d2); rr2 = wsum(rr2);
    if (lane == 0) { atomicAdd(errs + ((sample ? 3 : 0) + br) * 2, d2); atomicAdd(errs + ((sample ? 3 : 0) + br) * 2 + 1, rr2); }
}
#endif
}

constexpr int NPHASE = 17;
__global__ void __launch_bounds__(512, 2) nsa_fwd(Args args) {
    extern __shared__ __attribute__((aligned(16))) unsigned char lds[];
    Frame F;
    F.lds = (LAS unsigned char*)lds;
    F.tid = threadIdx.x; F.lane = F.tid & 63; F.wave = __builtin_amdgcn_readfirstlane(F.tid >> 6);
    F.G = gridDim.x; { const int bx = blockIdx.x; F.vcu = (F.G % 8 == 0) ? (bx % 8) * (F.G / 8) + bx / 8 : bx; }
    F.x_p = (const float*)args.in[0]; F.x_s = (const float*)args.in[1]; F.c_p = (const float*)args.in[2]; F.c_s = (const float*)args.in[3];
    F.ck_cmp = (const float*)args.in[4]; F.cv_cmp = (const float*)args.in[5]; F.ck_sel = (const float*)args.in[6]; F.cv_sel = (const float*)args.in[7];
    F.page_table = (const int*)args.in[8]; F.st_kw = (const float*)args.in[9]; F.st_vw = (const float*)args.in[10]; F.st_pool = (const float*)args.in[11];
    F.rel_bias = (const float*)args.in[12]; F.ada_w = (const float*)args.in[13]; F.ada_b = (const float*)args.in[14]; F.norm_g = (const float*)args.in[15]; F.final_g = (const float*)args.in[16];
    F.w_in = (const float*)args.in[17]; F.w_out = (const float*)args.in[18]; F.cmp_wk = (const float*)args.in[19]; F.cmp_wv = (const float*)args.in[20];
    F.pe_k = (const float*)args.in[21]; F.pe_v = (const float*)args.in[22]; F.pool_w = (const float*)args.in[23]; F.pool_scale = (const float*)args.in[24];
    F.ffn_wg = (const float*)args.in[25]; F.ffn_wu = (const float*)args.in[26]; F.ffn_wd = (const float*)args.in[27];
    F.out = args.out; F.ws = args.ws;
    unsigned char* ws = args.ws;
    for (int u = F.tid; u < 64; u += 512) ((LAS unsigned*)(F.lds + MISC_OFF))[u] = 0u;
    for (int u = F.tid; u < 16 * 128; u += 512) { const int h = u >> 7, d = u & 127; ((LAS float*)(F.lds + LUT_OFF))[u] = F.rel_bias[t5_bucket(d) * 16 + h] * LOG2E; }
    __syncthreads();
    volatile LAS unsigned* MISC = (volatile LAS unsigned*)(F.lds + MISC_OFF);
    XcdBarrier bar; bar.bar = (unsigned*)(ws + WS_CTL) + CW_BAR; bar.x = 0; bar.st = nullptr;
    if (!MK_SPLIT) bar = xcd_barrier_post((unsigned*)(ws + WS_CTL) + CW_BAR, MISC + 8);
    const int lo = args.ph_lo, hi = args.ph_hi;
#ifndef PHMASK
#define PHMASK 0x1FFFF
#endif
#define IN(k) (((PHMASK >> (k)) & 1) && lo <= (k) && (k) < hi)
#define SEAM(k) do { if (IN(k) && IN((k) + 1)) xcd_barrier(bar); } while (0)
#ifndef REPMASK
#define REPMASK 0
#endif
#define REPS(k) (((REPMASK >> (k)) & 1) ? 2 : 1)
    bf16_t* H = (bf16_t*)(ws + WS_H); bf16_t* X = (bf16_t*)(ws + WS_X); float* MOD = (float*)(ws + WS_MOD);

    if (IN(0)) { for (int rep = 0; rep < REPS(0); ++rep) p0_prologue(F); } SEAM(0);
    if (IN(1)) { for (int rep = 0; rep < REPS(1); ++rep) { p1_compress_sample(F); p1_ada(F); } } SEAM(1);
    if (IN(2)) { for (int rep = 0; rep < REPS(2); ++rep) norm_phase<0>(F, true, 0, 0); } SEAM(2);
    if (IN(3)) {
        pg8::Gemm g{H, (const bf16_t*)(ws + WS_WIN), D, D, D, 0}; pg8::StaticOrder S; S.init(MT, NPROJ, F.G, (int)blockIdx.x);
        pg8::EpiProj E{(bf16_t*)(ws + WS_Q), (bf16_t*)(ws + WS_KV), (float*)(ws + WS_GATES), F.out};
        for (int rep = 0; rep < REPS(3); ++rep) pg8::gemm_phase<pg8::EpiProj, pg8::StaticOrder, true>(F.lds, g, S, E);
    } SEAM(3);
    if (IN(4)) { for (int rep = 0; rep < REPS(4); ++rep) p4_compress_prompt(F); } SEAM(4);
    if (IN(5)) {
        att::Ptrs P; P.Q = (const bf16_t*)(ws + WS_Q); P.kcp = (const bf16_t*)(ws + WS_KCMPP); P.vcp = (const bf16_t*)(ws + WS_VCMPP); P.kcs = (const bf16_t*)(ws + WS_KCMPS); P.vcs = (const bf16_t*)(ws + WS_VCMPS);
        const bf16_t* kvb = (const bf16_t*)(ws + WS_KV); P.KS = kvb + 2 * KV_STRIDE; P.VS = kvb + 3 * KV_STRIDE; P.KW = kvb + 4 * KV_STRIDE; P.VW = kvb + 5 * KV_STRIDE;
        P.gates = (const float*)(ws + WS_GATES); P.O = (bf16_t*)(ws + WS_O); P.ck_sel = F.ck_sel; P.cv_sel = F.cv_sel; P.st_kw = F.st_kw; P.st_vw = F.st_vw; P.pt = F.page_table;
        P.gov = -1; P.kw_out = F.out + O_KWS; P.vw_out = F.out + O_KWS + SZ_WS;
#ifdef VERIFY
        P.gov = args.pad0 - 1;
#endif
#ifndef RS
#define RS 1
#endif
#ifndef RP
#define RP 1
#endif
#pragma unroll 1
        for (int pass = 0; pass < 2; ++pass) {
            if (((pass ^ F.vcu) & 1) == 0) {
#pragma unroll 1
                for (int rep = 0; rep < RS; ++rep)
                for (int u = opaque_s(F.vcu); u < NSB * 2; u += F.G) att::sample_unit(P, F.lds, 2 * u, 2 * u + 1, F.tid, F.wave, F.lane);
            } else {
#pragma unroll 1
                for (int rep = 0; rep < RP; ++rep)
                for (int u = opaque_s(F.vcu); u < 16 * 16; u += F.G) { const int bk = u >> 4, s = u & 15;
#pragma unroll 1
                    for (int i = 0; i < 4; ++i) { const int c = (i == 0) ? s : (i == 1) ? 31 - s : (i == 2) ? 32 + s : 63 - s; att::prompt_unit(P, F.lds, bk >> 2, bk & 3, c, F.tid, F.wave, F.lane); } }
            }
        }
    } SEAM(5);
    if (IN(6)) {
        pg8::Gemm g{(const bf16_t*)(ws + WS_O), (const bf16_t*)(ws + WS_WOUT), D, D, D, 0}; pg8::StaticOrder S; S.init(MP, D, F.G, (int)blockIdx.x);
        pg8::EpiRes<true> E{F.x_p, F.x_s, X, MOD + 2048};
        pg8::gemm_phase<decltype(E), pg8::StaticOrder, true>(F.lds, g, S, E);
        small_gemm_res<true>(F, (const bf16_t*)(ws + WS_O) + (size_t)MP * D, D, (const bf16_t*)(ws + WS_WOUT), D, D, false, F.x_s, X + (size_t)MP * D, MOD + 2048);
    } SEAM(6);
    if (IN(7)) { for (int rep = 0; rep < REPS(7); ++rep) norm_phase<0>(F, false, 0, 1); } SEAM(7);
    if (IN(8)) {
        pg8::Gemm g{H, (const bf16_t*)(ws + WS_WGU), D, D, D, 0}; pg8::StaticOrder S; S.init(MT, NGU, F.G, (int)blockIdx.x);
        pg8::EpiGU E{(bf16_t*)(ws + WS_ACT)};
        for (int rep = 0; rep < REPS(8); ++rep) pg8::gemm_phase<pg8::EpiGU, pg8::StaticOrder, true>(F.lds, g, S, E);
    } SEAM(8);
    if (IN(9)) {
        pg8::Gemm g{(const bf16_t*)(ws + WS_ACT), (const bf16_t*)(ws + WS_WD), FF, FF, FF, 0}; pg8::StaticOrder S; S.init(MP, D, F.G, (int)blockIdx.x);
        pg8::EpiRes<false> E{nullptr, nullptr, X, MOD + 5120};
        pg8::gemm_phase<decltype(E), pg8::StaticOrder, true>(F.lds, g, S, E);
        small_gemm_res<false>(F, (const bf16_t*)(ws + WS_ACT) + (size_t)MP * FF, FF, (const bf16_t*)(ws + WS_WD), FF, FF, false, nullptr, X + (size_t)MP * D, MOD + 5120);
    } SEAM(9);
    if (IN(10)) { for (int rep = 0; rep < REPS(10); ++rep) norm_phase<1>(F, false, 1, 0); } SEAM(10);
    if (IN(11)) { for (int rep = 0; rep < REPS(11); ++rep) pool_phase(F); } SEAM(11);
    if (IN(12)) {
        pg8::Gemm g{H, (const bf16_t*)(ws + WS_WPOOL), D, 256, 256, 256}; pg8::StaticOrder S; S.init(MP, D, F.G, (int)blockIdx.x);
        pg8::EpiRes<false> E{nullptr, nullptr, X, MOD + (size_t)NMODB * 6144 + 2048};
        pg8::gemm_phase<decltype(E), pg8::StaticOrder, true>(F.lds, g, S, E);
        small_gemm_res<false>(F, H + (size_t)MP * D, D, (const bf16_t*)(ws + WS_WPOOL), 256, 256, true, nullptr, X + (size_t)MP * D, MOD + (size_t)NMODB * 6144 + 2048);
    } SEAM(12);
    if (IN(13)) { for (int rep = 0; rep < REPS(13); ++rep) norm_phase<0>(F, false, 1, 1); } SEAM(13);
    if (IN(14)) {
        pg8::Gemm g{H, (const bf16_t*)(ws + WS_WGU) + (size_t)NGU * D, D, D, D, 0}; pg8::StaticOrder S; S.init(MT, NGU, F.G, (int)blockIdx.x);
        pg8::EpiGU E{(bf16_t*)(ws + WS_ACT)};
        pg8::gemm_phase<pg8::EpiGU, pg8::StaticOrder, true>(F.lds, g, S, E);
    } SEAM(14);
    if (IN(15)) {
        pg8::Gemm g{(const bf16_t*)(ws + WS_ACT), (const bf16_t*)(ws + WS_WD) + (size_t)D * FF, FF, FF, FF, 0}; pg8::StaticOrder S; S.init(MP, D, F.G, (int)blockIdx.x);
        pg8::EpiRes<false> E{nullptr, nullptr, X, MOD + (size_t)NMODB * 6144 + 5120};
        pg8::gemm_phase<decltype(E), pg8::StaticOrder, true>(F.lds, g, S, E);
        small_gemm_res<false>(F, (const bf16_t*)(ws + WS_ACT) + (size_t)MP * FF, FF, (const bf16_t*)(ws + WS_WD) + (size_t)D * FF, FF, FF, false, nullptr, X + (size_t)MP * D, MOD + (size_t)NMODB * 6144 + 5120);
    } SEAM(15);
    if (IN(16)) { for (int rep = 0; rep < REPS(16); ++rep) norm_phase<2>(F, false, 0, 0); }
#undef IN
#undef SEAM
}


#ifdef VERIFY
__global__ void __launch_bounds__(512, 2) verify_k(Args args) {
    extern __shared__ __attribute__((aligned(16))) unsigned char lds[];
    LAS unsigned char* L = (LAS unsigned char*)lds; unsigned char* ws = args.ws;
    const int tid = threadIdx.x, lane = tid & 63, wave = __builtin_amdgcn_readfirstlane(tid >> 6);
    const float* rel_bias = (const float*)args.in[12];
    for (int u = tid; u < 16 * 128; u += 512) { const int h = u >> 7, d = u & 127; ((LAS float*)(L + LUT_OFF))[u] = rel_bias[t5_bucket(d) * 16 + h] * LOG2E; }
    __syncthreads();
    att::Ptrs P; P.Q = (const bf16_t*)(ws + WS_Q); P.kcp = (const bf16_t*)(ws + WS_KCMPP); P.vcp = (const bf16_t*)(ws + WS_VCMPP); P.kcs = (const bf16_t*)(ws + WS_KCMPS); P.vcs = (const bf16_t*)(ws + WS_VCMPS);
    const bf16_t* kvb = (const bf16_t*)(ws + WS_KV); P.KS = kvb + 2 * KV_STRIDE; P.VS = kvb + 3 * KV_STRIDE; P.KW = kvb + 4 * KV_STRIDE; P.VW = kvb + 5 * KV_STRIDE;
    P.gates = (const float*)(ws + WS_GATES); P.O = (bf16_t*)(ws + WS_O); P.ck_sel = (const float*)args.in[6]; P.cv_sel = (const float*)args.in[7]; P.st_kw = (const float*)args.in[9]; P.st_vw = (const float*)args.in[10]; P.pt = (const int*)args.in[8]; P.gov = args.pad0 - 1;
    float* errs = (float*)(ws + WS_CTL) + 65536;
    const int gw = blockIdx.x * 8 + wave;
    for (int it = gw; it < 168 + 64; it += gridDim.x * 8) { bool smp = it >= 168; int vb_, vt_, vk_;
        if (!smp) { const int ti = it % 21, r = it / 21; vb_ = (r >> 2) ? 3 : 0; vk_ = r & 3; vt_ = ti == 0 ? 0 : ti == 1 ? 5 : ti == 2 ? 30 : ti == 3 ? 31 : ti == 4 ? 63 : ti == 5 ? 64 : ti == 6 ? 100 : ti == 7 ? 511 : ti == 8 ? 512 : ti == 9 ? 600 : ti == 10 ? 959 : ti == 11 ? 960 : ti == 12 ? 1023 : ti == 13 ? 1024 : ti == 14 ? 1055 : ti == 15 ? 1100 : ti == 16 ? 2047 : ti == 17 ? 2048 : ti == 18 ? 3000 : ti == 19 ? 4032 : 4095; }
        else { const int q = it - 168, bi = q >> 4; vb_ = bi == 0 ? 0 : bi == 1 ? 1 : bi == 2 ? 77 : 127; vt_ = q & 3; vk_ = (q >> 2) & 3; }
        att::verify_item(P, L, smp, vb_, vt_, vk_, args.pad0 - 1, errs, wave, lane); }
}
__global__ void scale_k(Args args) {
    const float* errs = (const float*)(args.ws + WS_CTL) + 65536; const size_t offs[6] = {O_KCP, O_KCP + SZ_KVP, O_KCP + 2 * SZ_KVP, O_KCS, O_KCS + SZ_KVS, O_KCS + 2 * SZ_KVS};
    const int k = blockIdx.y; const float d2 = errs[2 * k], r2 = errs[2 * k + 1]; const float e = r2 > 0.f ? sqrtf(d2 / r2) : 7.0f; const size_t n = k < 3 ? SZ_KVP : SZ_KVS;
    for (size_t i = (size_t)blockIdx.x * blockDim.x + threadIdx.x; i < n; i += (size_t)gridDim.x * blockDim.x) args.out[offs[k] + i] *= (1.0f + e);
}
#endif
extern "C" void kernel_launch(void* const* d_in, const int* in_sizes, int n_in, void* d_out, int out_size, void* d_ws, size_t ws_size, hipStream_t stream) {
    static int grid = 0;
    if (grid == 0) {
        if (n_in != 28 || (size_t)out_size != O_END || ws_size < WS_END) { fprintf(stderr, "kernel_launch: unexpected shapes (n_in %d, out %d, ws %zu); nothing launched\n", n_in, out_size, ws_size); grid = -1; return; }
        int dev = 0, cus = 0, per_cu = 0;
        if (hipGetDevice(&dev) != hipSuccess || hipDeviceGetAttribute(&cus, hipDeviceAttributeMultiprocessorCount, dev) != hipSuccess) { grid = -1; return; }
        if (hipFuncSetAttribute((const void*)nsa_fwd, hipFuncAttributeMaxDynamicSharedMemorySize, LDS_BYTES) != hipSuccess) { fprintf(stderr, "kernel_launch: hipFuncSetAttribute(%d B LDS) failed\n", LDS_BYTES); grid = -1; return; }
        if (hipOccupancyMaxActiveBlocksPerMultiprocessor(&per_cu, (const void*)nsa_fwd, 512, LDS_BYTES) != hipSuccess || per_cu < 1)
            fprintf(stderr, "kernel_launch: note: occupancy query reports %d workgroups per CU\n", per_cu);
        (void)hipGetLastError();
        grid = cus;
    }
    if (grid < 0) return;
    (void)hipMemsetAsync((char*)d_ws + WS_CTL, 0, CTL_ZERO_BYTES, stream);
    Args a{};
    for (int i = 0; i < 28; ++i) a.in[i] = d_in[i];
    a.out = (float*)d_out; a.ws = (unsigned char*)d_ws; a.pad0 = 0; a.pad1 = 0;
#ifdef VERIFY
    hipFuncSetAttribute((const void*)verify_k, hipFuncAttributeMaxDynamicSharedMemorySize, LDS_BYTES);
    for (int pass = 0; pass < 3; ++pass) { a.pad0 = pass + 1; a.ph_lo = 0; a.ph_hi = 6;
        (void)hipMemsetAsync((char*)d_ws + WS_CTL, 0, 65536 * 4, stream);
        hipLaunchKernelGGL(nsa_fwd, dim3(grid), dim3(512), LDS_BYTES, stream, a);
        hipLaunchKernelGGL(verify_k, dim3(grid), dim3(512), LDS_BYTES, stream, a); }
    a.pad0 = 0; (void)hipMemsetAsync((char*)d_ws + WS_CTL, 0, 65536 * 4, stream);
    a.ph_lo = 0; a.ph_hi = NPHASE;
    hipLaunchKernelGGL(nsa_fwd, dim3(grid), dim3(512), LDS_BYTES, stream, a);
    hipLaunchKernelGGL(scale_k, dim3(64, 6), dim3(256), 0, stream, a);
#elif MK_SPLIT
    for (int p = 0; p < NPHASE; ++p) { a.ph_lo = p; a.ph_hi = p + 1; hipLaunchKernelGGL(nsa_fwd, dim3(grid), dim3(512), LDS_BYTES, stream, a); }
#else
    a.ph_lo = 0; a.ph_hi = NPHASE;
    hipLaunchKernelGGL(nsa_fwd, dim3(grid), dim3(512), LDS_BYTES, stream, a);
#endif
    const hipError_t le = hipPeekAtLastError();
    if (le != hipSuccess) fprintf(stderr, "kernel_launch: launch failed: %s\n", hipGetErrorName(le));
}
```
